# Optimizing an MI355X kernel written in HIP

```python
import math
import jax
import jax.numpy as jnp
from jax import lax
import numpy as np

D_MODEL = 1024
BATCH = 8
SEQ = 2048
DEPTH = 2

N_META = 16
RMS_EPS = 1e-6
CONV_WIDTH = 4
SSD_HEADS = 16
SSD_HEAD_DIM = 64
SSD_WIDTH = SSD_HEADS * SSD_HEAD_DIM
SSD_GROUPS = 2
SSD_HEADS_PER_GROUP = SSD_HEADS // SSD_GROUPS
SSD_STATE = 128
SSD_CHUNK = 128
SSD_CONV_DIM = SSD_WIDTH + 2 * SSD_GROUPS * SSD_STATE
LRU_WIDTH = D_MODEL
LRU_HEADS = 16
LRU_BLOCK = LRU_WIDTH // LRU_HEADS
LRU_C = 8.0
PROJ_COLS = SSD_WIDTH + SSD_CONV_DIM + SSD_HEADS + 2 * LRU_WIDTH
MIX_WIDTH = SSD_WIDTH + LRU_WIDTH
POOL_WINDOWS = (2, 4, 8, 16)
POOL_GROUPS = len(POOL_WINDOWS)
POOL_GROUP_DIM = D_MODEL // POOL_GROUPS
POOL_MAX_WINDOW = 16
MOE_GROUPS = 4
MOE_EXPERTS_PER_GROUP = 4
MOE_EXPERTS = MOE_GROUPS * MOE_EXPERTS_PER_GROUP
MOE_TOP_K = 2
D_EXPERT = D_MODEL // 2
N_EVEN = (DEPTH + 1) // 2
N_ODD = DEPTH // 2

kernel_name = "hybrid_ssd_rglru_pool_hmoe_meta"


def rms_norm(x, gain):
    xf = x.astype(jnp.float32)
    y = xf * lax.rsqrt(jnp.mean(xf * xf, axis=-1, keepdims=True) + RMS_EPS)
    return (y * gain.astype(jnp.float32)).astype(x.dtype)


def causal_depthwise_conv(x, w, b):
    c = x.shape[-1]
    y = lax.conv_general_dilated(
        x, w[:, None, :].astype(x.dtype), (1,), [(CONV_WIDTH - 1, 0)],
        dimension_numbers=("NWC", "WIO", "NWC"), feature_group_count=c)
    return y + b.astype(x.dtype)


def ssd_chunked_scan(xdt, adt, b_mat, c_mat):
    bsz, t = xdt.shape[:2]
    nc, l = t // SSD_CHUNK, SSD_CHUNK
    g, e, p, n = SSD_GROUPS, SSD_HEADS_PER_GROUP, SSD_HEAD_DIM, SSD_STATE
    xc = xdt.reshape(bsz, nc, l, g, e, p)
    bc = b_mat.reshape(bsz, nc, l, g, n)
    cc = c_mat.reshape(bsz, nc, l, g, n)
    ac = adt.reshape(bsz, nc, l, g, e).transpose(0, 3, 4, 1, 2)
    a_cs = jnp.cumsum(ac, axis=-1)
    causal = jnp.tril(jnp.ones((l, l), dtype=bool))
    seg = a_cs[..., :, None] - a_cs[..., None, :]
    decay = jnp.exp(jnp.where(causal, seg, -jnp.inf))
    cb = jnp.einsum("bclgn,bcsgn->bgcls", cc, bc)
    y_diag = jnp.einsum("bgecls,bcsgep->bclgep", cb[:, :, None] * decay, xc)
    decay_to_end = jnp.exp(a_cs[..., -1:] - a_cs)
    states = jnp.einsum("bclgn,bgecl,bclgep->bcgepn", bc, decay_to_end, xc)
    chunk_decay = jnp.pad(a_cs[..., -1], [(0, 0)] * 3 + [(1, 0)])
    ccs = jnp.cumsum(chunk_decay, axis=-1)
    cseg = ccs[..., :, None] - ccs[..., None, :]
    ccausal = jnp.tril(jnp.ones((nc + 1, nc + 1), dtype=bool))
    chunk_trans = jnp.exp(jnp.where(ccausal, cseg, -jnp.inf))
    states = jnp.concatenate([jnp.zeros_like(states[:, :1]), states], axis=1)
    states_in = jnp.einsum("bgezc,bcgepn->bzgepn", chunk_trans, states)[:, :-1]
    in_decay = jnp.exp(a_cs).transpose(0, 3, 4, 1, 2)[..., None]
    y_off = jnp.einsum("bclgn,bcgepn->bclgep", cc, states_in) * in_decay
    return (y_diag + y_off).reshape(bsz, t, g, e, p)


def ssd_mixer(z, xbc, dt_raw, conv_w, conv_b, dt_bias, a_log, d_skip, norm_gain):
    f32 = jnp.float32
    bsz, l, _ = xbc.shape
    g, e, p, n = SSD_GROUPS, SSD_HEADS_PER_GROUP, SSD_HEAD_DIM, SSD_STATE
    xbc = jax.nn.silu(causal_depthwise_conv(xbc, conv_w, conv_b)).astype(f32)
    xh = xbc[..., :SSD_WIDTH].reshape(bsz, l, g, e, p)
    b_mat = xbc[..., SSD_WIDTH:SSD_WIDTH + g * n].reshape(bsz, l, g, n)
    c_mat = xbc[..., SSD_WIDTH + g * n:].reshape(bsz, l, g, n)
    dt = jax.nn.softplus(dt_raw.astype(f32) + dt_bias.astype(f32)).reshape(bsz, l, g, e)
    a = -jnp.exp(a_log.astype(f32)).reshape(g, e)
    pad = SSD_CHUNK - N_META
    def front(t):
        return jnp.pad(t, [(0, 0), (pad, 0)] + [(0, 0)] * (t.ndim - 2))
    y = ssd_chunked_scan(front(xh * dt[..., None]), front(dt * a), front(b_mat), front(c_mat))[:, pad:]
    y = y + d_skip.astype(f32).reshape(g, e)[..., None] * xh
    y = y.reshape(bsz, l, SSD_WIDTH) * jax.nn.silu(z.astype(f32))
    yg = y.reshape(bsz, l, g, SSD_WIDTH // g)
    yg = yg * lax.rsqrt(jnp.mean(yg * yg, axis=-1, keepdims=True) + RMS_EPS)
    return (yg.reshape(bsz, l, SSD_WIDTH) * norm_gain.astype(f32)).astype(z.dtype)


def rg_lru(xb, w_a, b_a, w_x, b_x, lam):
    f32 = jnp.float32
    bsz, l, _ = xb.shape
    xf = xb.astype(f32)
    xh = xf.reshape(bsz, l, LRU_HEADS, LRU_BLOCK)
    r = jax.nn.sigmoid(jnp.einsum("blhi,hij->blhj", xh, w_a.astype(f32)).reshape(bsz, l, LRU_WIDTH) + b_a.astype(f32))
    i = jax.nn.sigmoid(jnp.einsum("blhi,hij->blhj", xh, w_x.astype(f32)).reshape(bsz, l, LRU_WIDTH) + b_x.astype(f32))
    log_a = -LRU_C * r * jax.nn.softplus(-lam.astype(f32))
    a = jnp.exp(log_a)
    mult = jnp.sqrt(-jnp.expm1(2.0 * log_a))
    first = (jnp.arange(l) == 0)[None, :, None]
    mult = jnp.where(first, 1.0, mult)
    u = mult * (i * xf)

    def combine(lhs, rhs):
        a1, b1 = lhs
        a2, b2 = rhs
        return a1 * a2, a2 * b1 + b2

    _, h = lax.associative_scan(combine, (a, u), axis=1)
    return h.astype(xb.dtype)


def ssd_lru_mixer(hn, w_in, ssd_conv_w, ssd_conv_b, ssd_dt_bias, ssd_a_log, ssd_d, ssd_norm,
                  lru_conv_w, lru_conv_b, lru_w_a, lru_b_a, lru_w_x, lru_b_x, lru_lambda, w_out):
    proj = hn @ w_in
    i1 = SSD_WIDTH
    i2 = i1 + SSD_CONV_DIM
    i3 = i2 + SSD_HEADS
    i4 = i3 + LRU_WIDTH
    z, xbc, dt_raw, lru_gate, lru_in = jnp.split(proj, [i1, i2, i3, i4], axis=-1)
    y_ssd = ssd_mixer(z, xbc, dt_raw, ssd_conv_w, ssd_conv_b, ssd_dt_bias, ssd_a_log, ssd_d, ssd_norm)
    xb = causal_depthwise_conv(lru_in, lru_conv_w, lru_conv_b)
    y_lru = rg_lru(xb, lru_w_a, lru_b_a, lru_w_x, lru_b_x, lru_lambda) * jax.nn.gelu(lru_gate, approximate=True)
    return jnp.concatenate([y_ssd, y_lru.astype(y_ssd.dtype)], axis=-1) @ w_out


def multiscale_pool_mixer(hn, pool_w, pool_b, pool_scale):
    f32 = jnp.float32
    bsz, l, d = hn.shape
    hf = hn.astype(f32)
    csum = jnp.concatenate([jnp.zeros((bsz, POOL_MAX_WINDOW, d), f32), jnp.cumsum(hf, axis=1)], axis=1)
    pos = jnp.arange(l)
    outs = []
    for g, w in enumerate(POOL_WINDOWS):
        lo, hi = g * POOL_GROUP_DIM, (g + 1) * POOL_GROUP_DIM
        wsum = csum[:, POOL_MAX_WINDOW:, lo:hi] - csum[:, POOL_MAX_WINDOW - w:POOL_MAX_WINDOW - w + l, lo:hi]
        count = jnp.minimum(pos + 1, w).astype(f32)[None, :, None]
        outs.append(wsum / count - hf[..., lo:hi])
    pooled = jnp.stack(outs, axis=2)
    y = jnp.einsum("blgi,gij->blgj", pooled, pool_w.astype(f32)).reshape(bsz, l, d) + pool_b.astype(f32)
    return (y * pool_scale.astype(f32)).astype(hn.dtype)


def hierarchical_moe(hn, w_group, b_group, w_expert, b_expert, w_gate, w_up, w_down):
    f32 = jnp.float32
    bsz, l, d = hn.shape
    tok = hn.reshape(-1, d)
    tf = tok.astype(f32)
    p_group = jax.nn.softmax(tf @ w_group.astype(f32) + b_group.astype(f32), axis=-1)
    g_sel = jnp.argmax(p_group, axis=-1)
    p_g = jnp.take_along_axis(p_group, g_sel[:, None], axis=-1)
    fine = (tf @ w_expert.astype(f32) + b_expert.astype(f32)).reshape(-1, MOE_GROUPS, MOE_EXPERTS_PER_GROUP)
    fine = jnp.take_along_axis(fine, g_sel[:, None, None], axis=1)[:, 0]
    top_p, top_i = lax.top_k(jax.nn.softmax(fine, axis=-1), MOE_TOP_K)
    top_p = top_p / jnp.sum(top_p, axis=-1, keepdims=True)
    expert_idx = g_sel[:, None] * MOE_EXPERTS_PER_GROUP + top_i
    gates = jnp.sum(jax.nn.one_hot(expert_idx, MOE_EXPERTS, dtype=f32) * (p_g * top_p)[..., None], axis=1)
    out = jnp.zeros_like(tf)
    for e in range(MOE_EXPERTS):
        hid = jax.nn.silu(tok @ w_gate[e]) * (tok @ w_up[e])
        out = out + gates[:, e:e + 1] * (hid @ w_down[e]).astype(f32)
    return out.astype(hn.dtype).reshape(bsz, l, d)


def setup_inputs(seed: int = 0) -> dict:
    key = jax.random.key(seed)
    ks = iter(jax.random.split(key, 48))
    f32 = jnp.float32
    ne, no = N_EVEN, N_ODD

    def nrm(shape, scale):
        return scale * jax.random.normal(next(ks), shape, f32)

    def gain(shape):
        return 1.0 + 0.05 * jax.random.normal(next(ks), shape, f32)

    x = nrm((BATCH, SEQ, D_MODEL), 1.0)
    meta_tokens = nrm((N_META, D_MODEL), 1.0)
    norm_final = gain((D_MODEL,))
    mix_norm_even = gain((ne, D_MODEL))
    w_in = nrm((ne, D_MODEL, PROJ_COLS), D_MODEL ** -0.5)
    ssd_conv_w = nrm((ne, CONV_WIDTH, SSD_CONV_DIM), CONV_WIDTH ** -0.5)
    ssd_conv_b = nrm((ne, SSD_CONV_DIM), 0.02)
    dt0 = jnp.exp(jax.random.uniform(next(ks), (ne, SSD_HEADS), f32, math.log(1e-3), math.log(0.1)))
    ssd_dt_bias = dt0 + jnp.log(-jnp.expm1(-dt0))
    ssd_a_log = jnp.log(jax.random.uniform(next(ks), (ne, SSD_HEADS), f32, 1.0, 16.0))
    ssd_d = gain((ne, SSD_HEADS))
    ssd_norm = gain((ne, SSD_WIDTH))
    lru_conv_w = nrm((ne, CONV_WIDTH, LRU_WIDTH), CONV_WIDTH ** -0.5)
    lru_conv_b = nrm((ne, LRU_WIDTH), 0.02)
    lru_w_a = nrm((ne, LRU_HEADS, LRU_BLOCK, LRU_BLOCK), LRU_BLOCK ** -0.5)
    lru_b_a = nrm((ne, LRU_WIDTH), 0.02)
    lru_w_x = nrm((ne, LRU_HEADS, LRU_BLOCK, LRU_BLOCK), LRU_BLOCK ** -0.5)
    lru_b_x = nrm((ne, LRU_WIDTH), 0.02)
    a0 = jax.random.uniform(next(ks), (ne, LRU_WIDTH), f32, 0.9, 0.999)
    s0 = a0 ** (1.0 / LRU_C)
    lru_lambda = jnp.log(s0) - jnp.log1p(-s0)
    w_out = nrm((ne, MIX_WIDTH, D_MODEL), MIX_WIDTH ** -0.5)
    mix_norm_odd = gain((no, D_MODEL))
    pool_w = nrm((no, POOL_GROUPS, POOL_GROUP_DIM, POOL_GROUP_DIM), POOL_GROUP_DIM ** -0.5)
    pool_b = nrm((no, D_MODEL), 0.02)
    pool_scale = gain((no, D_MODEL))
    ffn_norm = gain((DEPTH, D_MODEL))
    router_group_w = nrm((DEPTH, D_MODEL, MOE_GROUPS), D_MODEL ** -0.5)
    router_group_b = nrm((DEPTH, MOE_GROUPS), 0.01)
    router_expert_w = nrm((DEPTH, D_MODEL, MOE_EXPERTS), D_MODEL ** -0.5)
    router_expert_b = nrm((DEPTH, MOE_EXPERTS), 0.01)
    expert_w_gate = nrm((DEPTH, MOE_EXPERTS, D_MODEL, D_EXPERT), D_MODEL ** -0.5)
    expert_w_up = nrm((DEPTH, MOE_EXPERTS, D_MODEL, D_EXPERT), D_MODEL ** -0.5)
    expert_w_down = nrm((DEPTH, MOE_EXPERTS, D_EXPERT, D_MODEL), D_EXPERT ** -0.5)
    return {
        "x": x, "meta_tokens": meta_tokens, "norm_final": norm_final,
        "mix_norm_even": mix_norm_even, "w_in": w_in,
        "ssd_conv_w": ssd_conv_w, "ssd_conv_b": ssd_conv_b, "ssd_dt_bias": ssd_dt_bias,
        "ssd_a_log": ssd_a_log, "ssd_d": ssd_d, "ssd_norm": ssd_norm,
        "lru_conv_w": lru_conv_w, "lru_conv_b": lru_conv_b, "lru_w_a": lru_w_a, "lru_b_a": lru_b_a,
        "lru_w_x": lru_w_x, "lru_b_x": lru_b_x, "lru_lambda": lru_lambda, "w_out": w_out,
        "mix_norm_odd": mix_norm_odd, "pool_w": pool_w, "pool_b": pool_b, "pool_scale": pool_scale,
        "ffn_norm": ffn_norm, "router_group_w": router_group_w, "router_group_b": router_group_b,
        "router_expert_w": router_expert_w, "router_expert_b": router_expert_b,
        "expert_w_gate": expert_w_gate, "expert_w_up": expert_w_up, "expert_w_down": expert_w_down,
    }


def reference(x, meta_tokens, norm_final, mix_norm_even, w_in, ssd_conv_w, ssd_conv_b, ssd_dt_bias,
              ssd_a_log, ssd_d, ssd_norm, lru_conv_w, lru_conv_b, lru_w_a, lru_b_a, lru_w_x, lru_b_x,
              lru_lambda, w_out, mix_norm_odd, pool_w, pool_b, pool_scale, ffn_norm, router_group_w,
              router_group_b, router_expert_w, router_expert_b, expert_w_gate, expert_w_up, expert_w_down):
    bsz = x.shape[0]
    meta = jnp.broadcast_to(meta_tokens.astype(x.dtype)[None], (bsz, N_META, D_MODEL))
    h = jnp.concatenate([meta, x], axis=1)
    for layer in range(DEPTH):
        j = layer // 2
        if layer % 2 == 0:
            h = h + ssd_lru_mixer(
                rms_norm(h, mix_norm_even[j]), w_in[j], ssd_conv_w[j], ssd_conv_b[j], ssd_dt_bias[j],
                ssd_a_log[j], ssd_d[j], ssd_norm[j], lru_conv_w[j], lru_conv_b[j], lru_w_a[j], lru_b_a[j],
                lru_w_x[j], lru_b_x[j], lru_lambda[j], w_out[j])
        else:
            h = h + multiscale_pool_mixer(rms_norm(h, mix_norm_odd[j]), pool_w[j], pool_b[j], pool_scale[j])
        h = h + hierarchical_moe(
            rms_norm(h, ffn_norm[layer]), router_group_w[layer], router_group_b[layer],
            router_expert_w[layer], router_expert_b[layer], expert_w_gate[layer], expert_w_up[layer],
            expert_w_down[layer])
    return rms_norm(h[:, N_META:], norm_final)
```

```cpp
#include <hip/hip_runtime.h>
#include <cstdio>
#include <cstdint>

#define GAS __attribute__((address_space(1)))
#define LAS __attribute__((address_space(3)))
typedef unsigned short bf16;
typedef short bf16x8 __attribute__((ext_vector_type(8)));
typedef float f32x4 __attribute__((ext_vector_type(4)));
typedef unsigned v4u __attribute__((ext_vector_type(4)));
typedef unsigned v2u __attribute__((ext_vector_type(2)));

#ifndef MK_N_LAUNCHES
#define MK_N_LAUNCHES 14
#endif
constexpr int NPH = 14;
constexpr int N_LAUNCHES = MK_N_LAUNCHES;

constexpr int NB = 8, SEQ = 2048, NMETA = 16, LSEQ = SEQ + NMETA, T = NB * LSEQ, D = 1024;
constexpr int PROJ_SRC = 4624, LDP = 4608;
constexpr int C_Z = 0, C_G = 1024, C_X = 2048, C_B = 3072, C_C = 3328, C_LI = 3584;
constexpr float EPS = 1e-6f;
constexpr int NBK = 24;

constexpr size_t MiB = 1u << 20;
constexpr size_t WS_CTL = 0, CTL_ZERO_BYTES = 1 * MiB;
constexpr size_t WS_WIN = 1 * MiB;
constexpr size_t WS_WOUT = 10 * MiB;
constexpr size_t WS_WPOOL = 14 * MiB;
constexpr size_t WS_WRT = 14 * MiB + 512 * 1024;
constexpr size_t WS_RSTD0 = 15 * MiB;
constexpr size_t WS_RSTD1 = WS_RSTD0 + 128 * 1024;
constexpr size_t WS_BKT = WS_RSTD1 + 128 * 1024;
constexpr size_t WS_GATES = WS_BKT + 128 * 1024;
constexpr size_t WS_DT = 16 * MiB;
constexpr size_t WS_SSDSQ = 17 * MiB + 64 * 1024;
constexpr size_t WS_LIST = 19 * MiB;
constexpr size_t WS_WGU = 21 * MiB;
constexpr size_t WS_WD = 53 * MiB;
constexpr size_t WS_H = 69 * MiB;
constexpr size_t WS_PROJ = 134 * MiB;
constexpr size_t WS_HID = WS_PROJ;
constexpr size_t WS_POOLED = WS_PROJ;
constexpr size_t WS_END = 280 * MiB;
static_assert(WS_H + (size_t)T * D * 4 <= WS_PROJ && WS_PROJ + (size_t)T * LDP * 2 <= WS_END, "ws map");
static_assert(WS_DT + (size_t)T * 16 * 4 <= WS_SSDSQ && WS_SSDSQ + (size_t)T * 16 * 4 <= WS_LIST && WS_LIST + (size_t)NBK * T * 4 <= WS_WGU, "ws map small");
constexpr int CW_CNT = 64;
constexpr int CW_BAR = 4096;

constexpr int LDS_BYTES = 147456;
constexpr int NWAVES = 8;

struct Args { const float* in[31]; float* out; unsigned char* ws; int ph_lo, ph_hi; };
enum { I_X = 0, I_META, I_NORMF, I_MNE, I_WIN, I_SCW, I_SCB, I_DTB, I_ALOG, I_SD, I_SNORM, I_LCW, I_LCB, I_LWA, I_LBA, I_LWX, I_LBX, I_LLAM, I_WOUT,
       I_MNO, I_PW, I_PB, I_PS, I_FFN, I_RGW, I_RGB, I_REW, I_REB, I_EWG, I_EWU, I_EWD };

#define LDS_WAIT() asm volatile("s_waitcnt lgkmcnt(0)" ::: "memory")
__device__ __forceinline__ float bf2f(unsigned v) { return __uint_as_float(v << 16); }
__device__ __forceinline__ unsigned f2bf(float f) { unsigned u = __float_as_uint(f); return (u + 0x7fffu + ((u >> 16) & 1u)) >> 16; }
__device__ __forceinline__ unsigned pk2(float lo, float hi) { return f2bf(lo) | (f2bf(hi) << 16); }
__device__ __forceinline__ float wave_sum(float v) {
#pragma unroll
    for (int o = 1; o < 64; o <<= 1) v += __shfl_xor(v, o);
    return v;
}
__device__ __forceinline__ float sigmoid_f(float v) { return 1.f / (1.f + __expf(-v)); }
__device__ __forceinline__ float silu_f(float v) { return v / (1.f + __expf(-v)); }
__device__ __forceinline__ float softplus_f(float v) { return v > 20.f ? v : log1pf(__expf(v)); }
__device__ __forceinline__ float gelu_tanh_f(float v) { const float u = 0.7978845608028654f * (v + 0.044715f * v * v * v); return 0.5f * v * (1.f + tanhf(u)); }
__device__ __forceinline__ const float* h0_row(const Args& a, int row) {
    const int b = row / LSEQ, l = row - b * LSEQ;
    return l < NMETA ? a.in[I_META] + (size_t)l * D : a.in[I_X] + ((size_t)b * SEQ + (l - NMETA)) * D;
}

#define XB_TMO      128
#define XB_XCNT(j)  (256  + 64 * (j))
#define XB_XSUB(j)  (1280 + 64 * (j))
#define XB_XGEN(j)  (2304 + 64 * (j))
#define XB_TOP      3328
#define XB_TOPGEN   3392
#define XCD_BAR_WORDS 3456
#define XB_SPIN_CAP (1u << 18)
__device__ __forceinline__ unsigned xb_ld(unsigned* p)              { return __hip_atomic_load(p, __ATOMIC_RELAXED, __HIP_MEMORY_SCOPE_AGENT); }
__device__ __forceinline__ unsigned xb_add(unsigned* p, unsigned v) { return __hip_atomic_fetch_add(p, v, __ATOMIC_RELAXED, __HIP_MEMORY_SCOPE_AGENT); }
__device__ __forceinline__ unsigned xb_xcc_id() { return (unsigned)__builtin_amdgcn_s_getreg((3 << 11) | 20) & 0xFu; }
#define XB_SPIN(cond, bar) do { unsigned _sp = 0; while (cond) { __builtin_amdgcn_s_sleep(1); \
    if ((++_sp & 255u) == 0u) { if (xb_ld(&(bar)[XB_TMO])) break; if (_sp > XB_SPIN_CAP) { atomicAdd(&(bar)[XB_TMO], 1u); break; } } } } while (0)
struct XcdBarrier { unsigned* bar; unsigned x; volatile LAS unsigned* st; };
__device__ __forceinline__ XcdBarrier xcd_barrier_post(unsigned* bar, volatile LAS unsigned* st) {
    XcdBarrier b; b.bar = bar; b.x = xb_xcc_id(); b.st = st;
    if (threadIdx.x == 0) (void)xb_add(&bar[XB_XCNT(b.x)], 1u);
    return b;
}
__device__ __forceinline__ void xcd_barrier_complete(unsigned* bar, unsigned x, unsigned& nloc, unsigned& nx) {
    const unsigned G = gridDim.x * gridDim.y * gridDim.z;
    unsigned sum, cnt, mine, sp = 0u;
    for (;;) {
        sum = 0u; cnt = 0u; mine = 0u;
#pragma unroll
        for (unsigned j = 0; j < 16; ++j) { const unsigned c = xb_ld(&bar[XB_XCNT(j)]); sum += c; cnt += (c > 0u) ? 1u : 0u; mine = (j == x) ? c : mine; }
        if (sum == G) break;
        __builtin_amdgcn_s_sleep(1);
        if ((++sp & 255u) == 0u) { if (xb_ld(&bar[XB_TMO])) break; if (sp > XB_SPIN_CAP) { atomicAdd(&bar[XB_TMO], 1u); break; } }
    }
    nloc = mine > 0u ? mine : 1u; nx = cnt > 0u ? cnt : 1u;
}
__device__ __forceinline__ void xcd_barrier(const XcdBarrier& b) {
    asm volatile("s_waitcnt vmcnt(0)" ::: "memory");
    __syncthreads();
    if (threadIdx.x == 0) {
        unsigned* bar = b.bar;
        __builtin_amdgcn_s_waitcnt(0);
        unsigned nloc = b.st[0], nx = b.st[1];
        if (nloc == 0u) { xcd_barrier_complete(bar, b.x, nloc, nx); b.st[0] = nloc; b.st[1] = nx; }
        const unsigned old = xb_add(&bar[XB_XSUB(b.x)], 1u);
        const unsigned gen = old / nloc;
        if (old + 1u == (gen + 1u) * nloc) {
            __builtin_amdgcn_fence(__ATOMIC_RELEASE, "agent");
            asm volatile("s_waitcnt vmcnt(0)" ::: "memory");
            const unsigned og = xb_add(&bar[XB_TOP], 1u);
            const unsigned tg = og / nx;
            if (og + 1u == (tg + 1u) * nx) xb_add(&bar[XB_TOPGEN], 1u);
            else XB_SPIN(xb_ld(&bar[XB_TOPGEN]) == tg, bar);
            __builtin_amdgcn_fence(__ATOMIC_ACQUIRE, "agent");
            xb_add(&bar[XB_XGEN(b.x)], 1u);
            asm volatile("s_waitcnt vmcnt(0)" ::: "memory");
        } else {
            XB_SPIN(xb_ld(&bar[XB_XGEN(b.x)]) == gen, bar);
            __builtin_amdgcn_fence(__ATOMIC_ACQUIRE, "agent");
            asm volatile("s_waitcnt vmcnt(0)" ::: "memory");
        }
    }
    __syncthreads();
}

__device__ __forceinline__ void tr_item(const float* src, int ldsrc, const float* gain, bf16* dst, int lddst, LAS float* scr, int lane) {
#pragma unroll 8
    for (int i = 0; i < 32; ++i) { const int kk = 2 * i + (lane >> 5); float v = src[(size_t)kk * ldsrc + (lane & 31)]; if (gain) v *= gain[kk]; scr[kk * 33 + (lane & 31)] = v; }
    LDS_WAIT();
    const int c = lane & 7;
#pragma unroll
    for (int j = 0; j < 4; ++j) { const int n = (lane >> 3) + 8 * j; const LAS float* s = scr + (8 * c) * 33 + n;
        v4u o; o.x = pk2(s[0 * 33], s[1 * 33]); o.y = pk2(s[2 * 33], s[3 * 33]); o.z = pk2(s[4 * 33], s[5 * 33]); o.w = pk2(s[6 * 33], s[7 * 33]);
        *(v4u*)(dst + (size_t)n * lddst + 8 * c) = o; }
    LDS_WAIT();
}
__device__ __forceinline__ void convert_experts(const Args& a, int L, LAS float* scr, int gw, int NGW, int lane) {
    bf16* WGU = (bf16*)(a.ws + WS_WGU); bf16* WD = (bf16*)(a.ws + WS_WD);
    const float* gain = a.in[I_FFN] + L * D;
    constexpr int I_GU = 16 * 16 * 16, I_DN = 16 * 8 * 32;
    for (int it = gw; it < 2 * I_GU + I_DN; it += NGW) {
        int r = it;
        if (r < 2 * I_GU) {
            const int up = r >= I_GU; if (up) r -= I_GU;
            const int e = r >> 8, kb = (r >> 4) & 15, nb = r & 15;
            const float* src = a.in[up ? I_EWU : I_EWG] + ((size_t)(L * 16 + e) * 1024 + kb * 64) * 512 + nb * 32;
            const int drow = e * 1024 + (nb >> 2) * 256 + (nb & 3) * 32 + (up ? 128 : 0);
            tr_item(src, 512, gain + kb * 64, WGU + (size_t)drow * 1024 + kb * 64, 1024, scr, lane);
        } else {
            r -= 2 * I_GU;
            const int e = r >> 8, kb = (r >> 5) & 7, nb = r & 31;
            const float* src = a.in[I_EWD] + ((size_t)(L * 16 + e) * 512 + kb * 64) * 1024 + nb * 32;
            tr_item(src, 1024, nullptr, WD + (size_t)(e * 1024 + nb * 32) * 512 + kb * 64, 512, scr, lane);
        }
    }
}
__device__ __forceinline__ void ph_prep(const Args& a, LAS unsigned char* lds, int wk, int nwk) {
    const int tid = threadIdx.x, lane = tid & 63, wave = __builtin_amdgcn_readfirstlane(tid >> 6);
    const int gw = wk * NWAVES + wave, NGW = nwk * NWAVES;
    LAS float* wdt = (LAS float*)lds;
    LAS float* scr = (LAS float*)(lds + 65536 + wave * 8448);
    {
        const float* win = a.in[I_WIN]; const float* ge = a.in[I_MNE];
        for (int i = tid; i < 16 * 1024; i += 512) { const int k = i >> 4, j = i & 15; wdt[j * 1024 + k] = win[(size_t)k * PROJ_SRC + 2560 + j] * ge[k]; }
    }
    bf16* WIN = (bf16*)(a.ws + WS_WIN); bf16* WOUT = (bf16*)(a.ws + WS_WOUT); bf16* WPOOL = (bf16*)(a.ws + WS_WPOOL);
    constexpr int I_IN = 16 * 144, I_OUT = 32 * 32, I_POOL = 4 * 4 * 8;
    for (int it = gw; it < I_IN + I_OUT + I_POOL; it += NGW) {
        int r = it;
        if (r < I_IN) { const int kb = r / 144, nb = r % 144, n0 = nb * 32;
            const int sc = n0 < 1024 ? n0 : (n0 < 2048 ? n0 - 1024 + 2576 : (n0 < 3584 ? n0 - 2048 + 1024 : n0 - 3584 + 3600));
            tr_item(a.in[I_WIN] + (size_t)(kb * 64) * PROJ_SRC + sc, PROJ_SRC, a.in[I_MNE] + kb * 64, WIN + (size_t)n0 * 1024 + kb * 64, 1024, scr, lane); continue; }
        r -= I_IN;
        if (r < I_OUT) { const int kb = r >> 5, nb = r & 31;
            tr_item(a.in[I_WOUT] + (size_t)(kb * 64) * 1024 + nb * 32, 1024, kb < 16 ? a.in[I_SNORM] + kb * 64 : nullptr, WOUT + (size_t)(nb * 32) * 2048 + kb * 64, 2048, scr, lane); continue; }
        r -= I_OUT;
        { const int g = r >> 5, kb = (r >> 3) & 3, nb = r & 7;
            tr_item(a.in[I_PW] + (size_t)g * 65536 + (size_t)(kb * 64) * 256 + nb * 32, 256, a.in[I_MNO] + g * 256 + kb * 64, WPOOL + (size_t)(g * 256 + nb * 32) * 256 + kb * 64, 256, scr, lane); }
    }
    convert_experts(a, 0, scr, gw, NGW, lane);
    {
        float* WRT = (float*)(a.ws + WS_WRT);
        for (int i = wk * 512 + tid; i < 2 * 20 * 1024; i += nwk * 512) {
            const int L = i / 20480, r = i % 20480, j = r >> 10, k = r & 1023;
            const float w = j < 4 ? a.in[I_RGW][((size_t)L * 1024 + k) * 4 + j] : a.in[I_REW][((size_t)L * 1024 + k) * 16 + (j - 4)];
            WRT[i] = w * a.in[I_FFN][L * 1024 + k];
        }
    }
    __syncthreads();
    bf16* HB = (bf16*)a.out; float* RSTD0 = (float*)(a.ws + WS_RSTD0); float* DT = (float*)(a.ws + WS_DT);
    for (int row = gw; row < T; row += NGW) {
        const f32x4* xr = (const f32x4*)h0_row(a, row) + lane;
        f32x4 v[4]; float ss = 0.f;
#pragma unroll
        for (int j = 0; j < 4; ++j) { v[j] = xr[64 * j]; ss += v[j].x * v[j].x + v[j].y * v[j].y + v[j].z * v[j].z + v[j].w * v[j].w; }
        ss = wave_sum(ss);
        const float rstd = rsqrtf(ss * (1.f / D) + EPS);
        v2u* o8 = (v2u*)(HB + (size_t)row * D) + lane;
#pragma unroll
        for (int j = 0; j < 4; ++j) { v2u w; w.x = pk2(v[j].x, v[j].y); w.y = pk2(v[j].z, v[j].w); o8[64 * j] = w; }
        float mydt = 0.f;
#pragma unroll 2
        for (int jj = 0; jj < 16; ++jj) {
            float s = 0.f;
#pragma unroll
            for (int j = 0; j < 4; ++j) { const f32x4 w = *(const LAS f32x4*)(wdt + jj * 1024 + (lane + 64 * j) * 4); s += v[j].x * w.x + v[j].y * w.y + v[j].z * w.z + v[j].w * w.w; }
            s = wave_sum(s);
            if (lane == jj) mydt = s;
        }
        if (lane == 0) RSTD0[row] = rstd;
        if (lane < 16) DT[(size_t)row * 16 + lane] = softplus_f(mydt * rstd + a.in[I_DTB][lane]);
    }
}

template <int NT, class BP, class KS>
__device__ __forceinline__ void sg_kloop(int K, const bf16* const (&arow)[4], BP bp, KS ks, f32x4 (&acc)[4][NT], int fr, int fq) {
    for (int k0 = 0; k0 < K; k0 += 32) {
        ks(k0, acc);
        bf16x8 av[4], bv[NT];
#pragma unroll
        for (int mi = 0; mi < 4; ++mi) av[mi] = *(const bf16x8*)(arow[mi] + k0 + 8 * fq);
#pragma unroll
        for (int nj = 0; nj < NT; ++nj) bv[nj] = *(const bf16x8*)(bp(16 * nj + fr, k0) + 8 * fq);
#pragma unroll
        for (int mi = 0; mi < 4; ++mi)
#pragma unroll
            for (int nj = 0; nj < NT; ++nj) acc[mi][nj] = __builtin_amdgcn_mfma_f32_16x16x32_bf16(bv[nj], av[mi], acc[mi][nj], 0, 0, 0);
    }
}
template <int NT> __device__ __forceinline__ void zero_acc(f32x4 (&acc)[4][NT]) {
#pragma unroll
    for (int mi = 0; mi < 4; ++mi)
#pragma unroll
        for (int nj = 0; nj < NT; ++nj) acc[mi][nj] = (f32x4){0.f, 0.f, 0.f, 0.f};
}
struct NoKS { template <int NT> __device__ __forceinline__ void operator()(int, f32x4 (&)[4][NT]) const {} };

__device__ __forceinline__ void ph_gemm1(const Args& a, int wk, int nwk) {
    const int tid = threadIdx.x, lane = tid & 63, wave = __builtin_amdgcn_readfirstlane(tid >> 6), fr = lane & 15, fq = lane >> 4;
    const int gw = wk * NWAVES + wave, NGW = nwk * NWAVES;
    const bf16* HB = (const bf16*)a.out; const bf16* WIN = (const bf16*)(a.ws + WS_WIN); bf16* PROJ = (bf16*)(a.ws + WS_PROJ);
    const float* RSTD0 = (const float*)(a.ws + WS_RSTD0);
    for (int u = gw; u < 258 * 72; u += NGW) {
        const int rt = u / 72, ct = u % 72;
        const bf16* arow[4];
#pragma unroll
        for (int mi = 0; mi < 4; ++mi) arow[mi] = HB + (size_t)(rt * 64 + 16 * mi + fr) * D;
        f32x4 acc[4][4]; zero_acc(acc);
        sg_kloop<4>(1024, arow, [=](int n, int k0) { return WIN + (size_t)(ct * 64 + n) * 1024 + k0; }, NoKS(), acc, fr, fq);
#pragma unroll
        for (int mi = 0; mi < 4; ++mi) { const int row = rt * 64 + 16 * mi + fr; const float rs = RSTD0[row];
#pragma unroll
            for (int nj = 0; nj < 4; ++nj) { const f32x4 v = acc[mi][nj] * rs; v2u w; w.x = pk2(v.x, v.y); w.y = pk2(v.z, v.w);
                *(v2u*)(PROJ + (size_t)row * LDP + ct * 64 + 16 * nj + 4 * fq) = w; } }
    }
}

__device__ __forceinline__ void ph_gemm2(const Args& a, int wk, int nwk) {
    const int tid = threadIdx.x, lane = tid & 63, wave = __builtin_amdgcn_readfirstlane(tid >> 6), fr = lane & 15, fq = lane >> 4;
    const int gw = wk * NWAVES + wave, NGW = nwk * NWAVES;
    const bf16* PROJ = (const bf16*)(a.ws + WS_PROJ); const bf16* WOUT = (const bf16*)(a.ws + WS_WOUT);
    const float* SSDSQ = (const float*)(a.ws + WS_SSDSQ);
    float* H = (float*)(a.ws + WS_H); bf16* HB = (bf16*)a.out;
    for (int u = gw; u < 258 * 16; u += NGW) {
        const int rt = u / 16, ct = u % 16;
        const bf16* arow[4]; float f0[4], f1[4];
#pragma unroll
        for (int mi = 0; mi < 4; ++mi) { const int row = rt * 64 + 16 * mi + fr; arow[mi] = PROJ + (size_t)row * LDP;
            const f32x4* sq = (const f32x4*)(SSDSQ + (size_t)row * 16); const f32x4 q0 = sq[0], q1 = sq[1], q2 = sq[2], q3 = sq[3];
            const float s0 = (q0.x + q0.y + q0.z + q0.w) + (q1.x + q1.y + q1.z + q1.w), s1 = (q2.x + q2.y + q2.z + q2.w) + (q3.x + q3.y + q3.z + q3.w);
            const float r0 = rsqrtf(s0 * (1.f / 512.f) + EPS), r1 = rsqrtf(s1 * (1.f / 512.f) + EPS);
            f0[mi] = r0 / r1; f1[mi] = r1; }
        f32x4 acc[4][4]; zero_acc(acc);
        auto ks = [=](int k0, f32x4 (&ac)[4][4]) {
            if (k0 == 512) {
#pragma unroll
                for (int mi = 0; mi < 4; ++mi)
#pragma unroll
                    for (int nj = 0; nj < 4; ++nj) ac[mi][nj] *= f0[mi]; }
            if (k0 == 1024) {
#pragma unroll
                for (int mi = 0; mi < 4; ++mi)
#pragma unroll
                    for (int nj = 0; nj < 4; ++nj) ac[mi][nj] *= f1[mi]; }
        };
        sg_kloop<4>(2048, arow, [=](int n, int k0) { return WOUT + (size_t)(ct * 64 + n) * 2048 + k0; }, ks, acc, fr, fq);
#pragma unroll
        for (int mi = 0; mi < 4; ++mi) { const int row = rt * 64 + 16 * mi + fr; const float* hr = h0_row(a, row);
#pragma unroll
            for (int nj = 0; nj < 4; ++nj) { const int c = ct * 64 + 16 * nj + 4 * fq; const f32x4 v = acc[mi][nj] + *(const f32x4*)(hr + c);
                *(f32x4*)(H + (size_t)row * D + c) = v; v2u w; w.x = pk2(v.x, v.y); w.y = pk2(v.z, v.w); *(v2u*)(HB + (size_t)row * D + c) = w; } }
    }
}

__device__ __forceinline__ void ssd_item(const Args& a, LAS unsigned char* lds, int b, int h) {
    const int tid = threadIdx.x, lane = tid & 63;
    constexpr int TB = 64;
    LAS float* xs = (LAS float*)lds;
    LAS float* Bs = xs + TB * 64;
    LAS float* Cs = Bs + TB * 128;
    LAS float* ys = Cs + TB * 128;
    LAS float* dts = ys + TB * 64;
    LAS float* decs = dts + TB;
    bf16* PROJ = (bf16*)(a.ws + WS_PROJ); const float* DT = (const float*)(a.ws + WS_DT); float* SSDSQ = (float*)(a.ws + WS_SSDSQ);
    const int g = h >> 3;
    const float Ah = -__expf(a.in[I_ALOG][h]), Dh = a.in[I_SD][h];
    int ccol = 0, cch = 0; float cw0 = 0.f, cw1 = 0.f, cw2 = 0.f, cw3 = 0.f, cb = 0.f;
    if (tid < 320) {
        if (tid < 64) { ccol = C_X + h * 64 + tid; cch = h * 64 + tid; }
        else if (tid < 192) { ccol = C_B + g * 128 + (tid - 64); cch = 1024 + g * 128 + (tid - 64); }
        else { ccol = C_C + g * 128 + (tid - 192); cch = 1280 + g * 128 + (tid - 192); }
        const float* cw = a.in[I_SCW]; cw0 = cw[cch]; cw1 = cw[1536 + cch]; cw2 = cw[2 * 1536 + cch]; cw3 = cw[3 * 1536 + cch]; cb = a.in[I_SCB][cch];
    }
    const int p = tid >> 3, nq = tid & 7;
    float S[16];
#pragma unroll
    for (int i = 0; i < 16; ++i) S[i] = 0.f;
    const size_t rbase = (size_t)b * LSEQ;
    for (int l0 = 0; l0 < LSEQ; l0 += TB) {
        const int nt = (LSEQ - l0) < TB ? (LSEQ - l0) : TB;
        __syncthreads();
        if (tid < 320) {
            float r0 = l0 >= 3 ? bf2f(PROJ[(rbase + l0 - 3) * LDP + ccol]) : 0.f, r1 = l0 >= 2 ? bf2f(PROJ[(rbase + l0 - 2) * LDP + ccol]) : 0.f, r2 = l0 >= 1 ? bf2f(PROJ[(rbase + l0 - 1) * LDP + ccol]) : 0.f;
            for (int t = 0; t < nt; ++t) {
                const float r3 = bf2f(PROJ[(rbase + l0 + t) * LDP + ccol]);
                const float v = silu_f(cw0 * r0 + cw1 * r1 + cw2 * r2 + cw3 * r3 + cb);
                if (tid < 64) xs[t * 64 + tid] = v; else if (tid < 192) Bs[t * 128 + tid - 64] = v; else Cs[t * 128 + tid - 192] = v;
                r0 = r1; r1 = r2; r2 = r3;
            }
        } else if (tid < 320 + TB) {
            const int t = tid - 320;
            if (t < nt) { const float dt = DT[(rbase + l0 + t) * 16 + h]; dts[t] = dt; decs[t] = __expf(Ah * dt); }
        }
        __syncthreads();
        for (int t = 0; t < nt; ++t) {
            const float xv = xs[t * 64 + p], xdt = xv * dts[t], dec = decs[t];
            float yp = 0.f;
#pragma unroll
            for (int i = 0; i < 16; ++i) { S[i] = dec * S[i] + Bs[t * 128 + nq * 16 + i] * xdt; yp += Cs[t * 128 + nq * 16 + i] * S[i]; }
            yp += __shfl_xor(yp, 1); yp += __shfl_xor(yp, 2); yp += __shfl_xor(yp, 4);
            if (nq == 0) ys[t * 64 + p] = yp + Dh * xv;
        }
        __syncthreads();
        for (int t = tid >> 6; t < nt; t += 8) {
            const size_t row = rbase + l0 + t;
            const float z = bf2f(PROJ[row * LDP + C_Z + h * 64 + lane]);
            const float yg = ys[t * 64 + lane] * silu_f(z);
            PROJ[row * LDP + C_Z + h * 64 + lane] = (bf16)f2bf(yg);
            const float sq = wave_sum(yg * yg);
            if (lane == 0) SSDSQ[row * 16 + h] = sq;
        }
    }
    __syncthreads();
}
__device__ __forceinline__ void lru_item(const Args& a, LAS unsigned char* lds, int b, int h) {
    const int tid = threadIdx.x;
    constexpr int TB = 64;
    LAS float* Wa = (LAS float*)lds;
    LAS float* Wx = Wa + 4096;
    LAS float* xb = Wx + 4096;
    LAS float* as = xb + TB * 64;
    LAS float* us = as + TB * 64;
    bf16* PROJ = (bf16*)(a.ws + WS_PROJ);
    __syncthreads();
    for (int i = tid; i < 4096; i += 512) { Wa[i] = a.in[I_LWA][(size_t)h * 4096 + i]; Wx[i] = a.in[I_LWX][(size_t)h * 4096 + i]; }
    const size_t rbase = (size_t)b * LSEQ;
    float hprev = 0.f;
    const int c = tid & 63, tq = tid >> 6;
    const float* cw = a.in[I_LCW]; const int ch = h * 64 + c;
    const float cw0 = cw[ch], cw1 = cw[1024 + ch], cw2 = cw[2048 + ch], cw3 = cw[3072 + ch], cb = a.in[I_LCB][ch];
    const int gt = tid >> 3, jq = tid & 7;
    for (int l0 = 0; l0 < LSEQ; l0 += TB) {
        const int nt = (LSEQ - l0) < TB ? (LSEQ - l0) : TB;
        __syncthreads();
        for (int t = tq * 8; t < tq * 8 + 8; ++t) if (t < nt) {
            const int l = l0 + t; const size_t row = rbase + l;
            const float r3 = bf2f(PROJ[row * LDP + C_LI + ch]);
            const float r2 = l >= 1 ? bf2f(PROJ[(row - 1) * LDP + C_LI + ch]) : 0.f;
            const float r1 = l >= 2 ? bf2f(PROJ[(row - 2) * LDP + C_LI + ch]) : 0.f;
            const float r0 = l >= 3 ? bf2f(PROJ[(row - 3) * LDP + C_LI + ch]) : 0.f;
            xb[t * 64 + c] = cw0 * r0 + cw1 * r1 + cw2 * r2 + cw3 * r3 + cb;
        }
        __syncthreads();
        if (gt < nt) {
            float ra[8], ri[8];
#pragma unroll
            for (int j = 0; j < 8; ++j) { ra[j] = 0.f; ri[j] = 0.f; }
            for (int i = 0; i < 64; ++i) { const float xv = xb[gt * 64 + i];
#pragma unroll
                for (int j = 0; j < 8; ++j) { ra[j] += xv * Wa[i * 64 + jq * 8 + j]; ri[j] += xv * Wx[i * 64 + jq * 8 + j]; } }
#pragma unroll
            for (int j = 0; j < 8; ++j) { const int cc = h * 64 + jq * 8 + j;
                const float r = sigmoid_f(ra[j] + a.in[I_LBA][cc]), ig = sigmoid_f(ri[j] + a.in[I_LBX][cc]);
                const float log_a = -8.0f * r * softplus_f(-a.in[I_LLAM][cc]);
                const float av = __expf(log_a);
                const float mult = (l0 + gt == 0) ? 1.f : sqrtf(fmaxf(-expm1f(2.f * log_a), 0.f));
                as[gt * 64 + jq * 8 + j] = av; us[gt * 64 + jq * 8 + j] = mult * ig * xb[gt * 64 + jq * 8 + j]; }
        }
        __syncthreads();
        if (tid < 64) { for (int t = 0; t < nt; ++t) { hprev = as[t * 64 + tid] * hprev + us[t * 64 + tid]; us[t * 64 + tid] = hprev; } }
        __syncthreads();
        for (int t = tq * 8; t < tq * 8 + 8; ++t) if (t < nt) {
            const size_t row = rbase + l0 + t;
            const float gv = bf2f(PROJ[row * LDP + C_G + ch]);
            PROJ[row * LDP + C_G + ch] = (bf16)f2bf(us[t * 64 + c] * gelu_tanh_f(gv));
        }
    }
    __syncthreads();
}
__device__ __forceinline__ void ph_mixers(const Args& a, LAS unsigned char* lds, int wk, int nwk) {
    for (int it = wk; it < 256; it += nwk) {
        if (it < 128) ssd_item(a, lds, it >> 4, it & 15); else lru_item(a, lds, (it - 128) >> 4, (it - 128) & 15);
    }
}

__device__ __forceinline__ void ph_router(const Args& a, LAS unsigned char* lds, int L, int wk, int nwk) {
    const int tid = threadIdx.x, lane = tid & 63, wave = __builtin_amdgcn_readfirstlane(tid >> 6);
    const int gw = wk * NWAVES + wave, NGW = nwk * NWAVES;
    LAS float* wr = (LAS float*)lds;
    const float* WRT = (const float*)(a.ws + WS_WRT) + (size_t)L * 20480;
    __syncthreads();
    for (int i = tid; i < 20480 / 4; i += 512) ((LAS f32x4*)wr)[i] = ((const f32x4*)WRT)[i];
    __syncthreads();
    const float* H = (const float*)(a.ws + WS_H);
    float* RSTD1 = (float*)(a.ws + WS_RSTD1); float* GATES = (float*)(a.ws + WS_GATES); int* LIST = (int*)(a.ws + WS_LIST);
    unsigned* cnt = (unsigned*)(a.ws + WS_CTL) + CW_CNT + 64 * L;
    const float* bg = a.in[I_RGB] + L * 4; const float* be = a.in[I_REB] + L * 16;
    for (int row = gw; row < T; row += NGW) {
        const f32x4* xr = (const f32x4*)(H + (size_t)row * D) + lane;
        f32x4 v[4]; float ss = 0.f;
#pragma unroll
        for (int j = 0; j < 4; ++j) { v[j] = xr[64 * j]; ss += v[j].x * v[j].x + v[j].y * v[j].y + v[j].z * v[j].z + v[j].w * v[j].w; }
        ss = wave_sum(ss);
        const float rstd = rsqrtf(ss * (1.f / D) + EPS);
        float mylg = 0.f;
#pragma unroll 2
        for (int jj = 0; jj < 20; ++jj) {
            float s = 0.f;
#pragma unroll
            for (int j = 0; j < 4; ++j) { const f32x4 w = *(const LAS f32x4*)(wr + jj * 1024 + (lane + 64 * j) * 4); s += v[j].x * w.x + v[j].y * w.y + v[j].z * w.z + v[j].w * w.w; }
            s = wave_sum(s);
            if (lane == jj) mylg = s;
        }
        mylg = mylg * rstd + (lane < 4 ? bg[lane & 3] : be[(lane - 4) & 15]);
        float lg[20];
#pragma unroll
        for (int jj = 0; jj < 20; ++jj) lg[jj] = __shfl(mylg, jj);
        int gs = 0; float gm = lg[0];
#pragma unroll
        for (int j = 1; j < 4; ++j) if (lg[j] > gm) { gm = lg[j]; gs = j; }
        const float pg = 1.f / (__expf(lg[0] - gm) + __expf(lg[1] - gm) + __expf(lg[2] - gm) + __expf(lg[3] - gm));
        float f[4];
#pragma unroll
        for (int i = 0; i < 4; ++i) f[i] = gs == 0 ? lg[4 + i] : (gs == 1 ? lg[8 + i] : (gs == 2 ? lg[12 + i] : lg[16 + i]));
        int i0 = 0; float m0 = f[0];
#pragma unroll
        for (int i = 1; i < 4; ++i) if (f[i] > m0) { m0 = f[i]; i0 = i; }
        int i1 = -1; float m1 = -3.0e38f;
#pragma unroll
        for (int i = 0; i < 4; ++i) if (i != i0 && f[i] > m1) { m1 = f[i]; i1 = i; }
        const float w0 = 1.f / (1.f + __expf(m1 - m0)), w1 = 1.f - w0;
        const int lo = i0 < i1 ? i0 : i1, hi = i0 < i1 ? i1 : i0;
        const float glo = pg * (i0 < i1 ? w0 : w1), ghi = pg * (i0 < i1 ? w1 : w0);
        const int pair = lo == 0 ? hi - 1 : (lo == 1 ? hi + 1 : 5);
        const int bk = gs * 6 + pair;
        if (lane == 0) {
            const unsigned slot = atomicAdd(cnt + bk, 1u);
            LIST[(size_t)bk * T + slot] = row;
            RSTD1[row] = rstd; GATES[(size_t)row * 2] = glo; GATES[(size_t)row * 2 + 1] = ghi;
        }
    }
}

struct BkTab { int cnt[NBK], off[NBK], ust[NBK + 1]; };
__device__ __forceinline__ void bk_table(const Args& a, LAS unsigned char* lds, int L, int per_tile  ) {
    LAS int* tb = (LAS int*)lds;
    __syncthreads();
    if (threadIdx.x == 0) {
        const unsigned* cnt = (const unsigned*)(a.ws + WS_CTL) + CW_CNT + 64 * L;
        int off = 0, us = 0;
        for (int i = 0; i < NBK; ++i) { const int c = (int)__hip_atomic_load(cnt + i, __ATOMIC_RELAXED, __HIP_MEMORY_SCOPE_AGENT);
            tb[i] = c; tb[NBK + i] = off; tb[2 * NBK + i] = us; off += (c + 255) & ~255; us += ((c + 63) >> 6) * per_tile; }
        tb[2 * NBK + NBK] = us;
    }
    __syncthreads();
}
__device__ __forceinline__ void bk_experts(int bk, int& elo, int& ehi) {
    const int g = bk / 6, pr = bk - g * 6;
    const int lo = pr < 3 ? 0 : (pr < 5 ? 1 : 2), hi = pr < 3 ? pr + 1 : (pr < 5 ? pr - 1 : 3);
    elo = g * 4 + lo; ehi = g * 4 + hi;
}
__device__ __forceinline__ void ph_moe_up(const Args& a, LAS unsigned char* lds, int L, int wk, int nwk) {
    const int tid = threadIdx.x, lane = tid & 63, wave = __builtin_amdgcn_readfirstlane(tid >> 6), fr = lane & 15, fq = lane >> 4;
    const int gw = wk * NWAVES + wave, NGW = nwk * NWAVES;
    bk_table(a, lds, L, 32);
    LAS int* tb = (LAS int*)lds;
    const bf16* HB = (const bf16*)a.out; const bf16* WGU = (const bf16*)(a.ws + WS_WGU); bf16* HID = (bf16*)(a.ws + WS_HID);
    const int* LIST = (const int*)(a.ws + WS_LIST); const float* RSTD1 = (const float*)(a.ws + WS_RSTD1); const float* GATES = (const float*)(a.ws + WS_GATES);
    const int nun = tb[2 * NBK + NBK];
    for (int u = gw; u < nun; u += NGW) {
        int bk = 0;
        for (int i = 1; i < NBK; ++i) if (u >= tb[2 * NBK + i]) bk = i;
        const int cnt = tb[bk], off = tb[NBK + bk], r = u - tb[2 * NBK + bk];
        const int rt = r >> 5, ek = (r >> 4) & 1, ct = r & 15;
        int elo, ehi; bk_experts(bk, elo, ehi); const int e = ek ? ehi : elo;
        const int c0 = ct * 32, brow = e * 1024 + (c0 >> 7) * 256 + (c0 & 127);
        const bf16* arow[4]; int tok[4];
#pragma unroll
        for (int mi = 0; mi < 4; ++mi) { int rr = rt * 64 + 16 * mi + fr; if (rr >= cnt) rr = cnt - 1; tok[mi] = LIST[(size_t)bk * T + rr]; arow[mi] = HB + (size_t)tok[mi] * D; }
        f32x4 acc[4][4]; zero_acc(acc);
        sg_kloop<4>(1024, arow, [=](int n, int k0) { return WGU + (size_t)(brow + (n < 32 ? n : n + 96)) * 1024 + k0; }, NoKS(), acc, fr, fq);
#pragma unroll
        for (int mi = 0; mi < 4; ++mi) { const int rr = rt * 64 + 16 * mi + fr;
            if (rr < cnt) { const float rs = RSTD1[tok[mi]], gt = GATES[(size_t)tok[mi] * 2 + ek];
#pragma unroll
                for (int nj = 0; nj < 2; ++nj) { const f32x4 gv = acc[mi][nj] * rs, uv = acc[mi][nj + 2] * rs; f32x4 hv;
                    hv.x = silu_f(gv.x) * uv.x * gt; hv.y = silu_f(gv.y) * uv.y * gt; hv.z = silu_f(gv.z) * uv.z * gt; hv.w = silu_f(gv.w) * uv.w * gt;
                    v2u w; w.x = pk2(hv.x, hv.y); w.y = pk2(hv.z, hv.w);
                    *(v2u*)(HID + (size_t)(off + rr) * 1024 + ek * 512 + c0 + 16 * nj + 4 * fq) = w; } } }
    }
}
__device__ __forceinline__ void ph_moe_down(const Args& a, LAS unsigned char* lds, int L, int wk, int nwk) {
    const int tid = threadIdx.x, lane = tid & 63, wave = __builtin_amdgcn_readfirstlane(tid >> 6), fr = lane & 15, fq = lane >> 4;
    const int gw = wk * NWAVES + wave, NGW = nwk * NWAVES;
    bk_table(a, lds, L, 16);
    LAS int* tb = (LAS int*)lds;
    const bf16* HID = (const bf16*)(a.ws + WS_HID); const bf16* WD = (const bf16*)(a.ws + WS_WD);
    float* H = (float*)(a.ws + WS_H); bf16* HB = (bf16*)a.out; const int* LIST = (const int*)(a.ws + WS_LIST);
    const int nun = tb[2 * NBK + NBK];
    for (int u = gw; u < nun; u += NGW) {
        int bk = 0;
        for (int i = 1; i < NBK; ++i) if (u >= tb[2 * NBK + i]) bk = i;
        const int cnt = tb[bk], off = tb[NBK + bk], r = u - tb[2 * NBK + bk];
        const int rt = r >> 4, ct = r & 15;
        int elo, ehi; bk_experts(bk, elo, ehi);
        const bf16* arow[4];
#pragma unroll
        for (int mi = 0; mi < 4; ++mi) arow[mi] = HID + (size_t)(off + rt * 64 + 16 * mi + fr) * 1024;
        f32x4 acc[4][4]; zero_acc(acc);
        sg_kloop<4>(1024, arow, [=](int n, int k0) { return WD + ((size_t)((k0 < 512 ? elo : ehi) * 1024 + ct * 64 + n)) * 512 + (k0 & 511); }, NoKS(), acc, fr, fq);
#pragma unroll
        for (int mi = 0; mi < 4; ++mi) { const int rr = rt * 64 + 16 * mi + fr;
            if (rr < cnt) { const int tok = LIST[(size_t)bk * T + rr];
#pragma unroll
                for (int nj = 0; nj < 4; ++nj) { const int c = ct * 64 + 16 * nj + 4 * fq; float* hp = H + (size_t)tok * D + c;
                    const f32x4 v = *(const f32x4*)hp + acc[mi][nj]; *(f32x4*)hp = v;
                    v2u w; w.x = pk2(v.x, v.y); w.y = pk2(v.z, v.w); *(v2u*)(HB + (size_t)tok * D + c) = w; } } }
    }
}

__device__ __forceinline__ void ph_rstd2(const Args& a, LAS unsigned char* lds, int wk, int nwk) {
    const int tid = threadIdx.x, lane = tid & 63, wave = __builtin_amdgcn_readfirstlane(tid >> 6);
    const int gw = wk * NWAVES + wave, NGW = nwk * NWAVES;
    const float* H = (const float*)(a.ws + WS_H); float* RSTD1 = (float*)(a.ws + WS_RSTD1);
    for (int row = gw; row < T; row += NGW) {
        const f32x4* xr = (const f32x4*)(H + (size_t)row * D) + lane; float ss = 0.f;
#pragma unroll
        for (int j = 0; j < 4; ++j) { const f32x4 v = xr[64 * j]; ss += v.x * v.x + v.y * v.y + v.z * v.z + v.w * v.w; }
        ss = wave_sum(ss);
        if (lane == 0) RSTD1[row] = rsqrtf(ss * (1.f / D) + EPS);
    }
    convert_experts(a, 1, (LAS float*)(lds + wave * 8448), gw, NGW, lane);
}
__device__ __forceinline__ void ph_pooled(const Args& a, int wk, int nwk) {
    const float* H = (const float*)(a.ws + WS_H); const float* RSTD1 = (const float*)(a.ws + WS_RSTD1); bf16* PO = (bf16*)(a.ws + WS_POOLED);
    for (int i = wk * 512 + threadIdx.x; i < T * 256; i += nwk * 512) {
        const int row = i >> 8, c = (i & 255) * 4, l = row % LSEQ, g = c >> 8, w = 2 << g;
        const int n = (l + 1) < w ? (l + 1) : w;
        f32x4 s = (f32x4){0.f, 0.f, 0.f, 0.f};
        for (int j = 0; j < n; ++j) s += *(const f32x4*)(H + (size_t)(row - j) * D + c) * RSTD1[row - j];
        const f32x4 o = s * (1.f / (float)n) - *(const f32x4*)(H + (size_t)row * D + c) * RSTD1[row];
        v2u wv; wv.x = pk2(o.x, o.y); wv.y = pk2(o.z, o.w); *(v2u*)(PO + (size_t)row * D + c) = wv;
    }
}
__device__ __forceinline__ void ph_poolgemm(const Args& a, int wk, int nwk) {
    const int tid = threadIdx.x, lane = tid & 63, wave = __builtin_amdgcn_readfirstlane(tid >> 6), fr = lane & 15, fq = lane >> 4;
    const int gw = wk * NWAVES + wave, NGW = nwk * NWAVES;
    const bf16* PO = (const bf16*)(a.ws + WS_POOLED); const bf16* WPOOL = (const bf16*)(a.ws + WS_WPOOL);
    float* H = (float*)(a.ws + WS_H); bf16* HB = (bf16*)a.out;
    for (int u = gw; u < 258 * 16; u += NGW) {
        const int rt = u / 16, ct = u % 16, g = ct >> 2;
        const bf16* arow[4];
#pragma unroll
        for (int mi = 0; mi < 4; ++mi) arow[mi] = PO + (size_t)(rt * 64 + 16 * mi + fr) * D + g * 256;
        f32x4 acc[4][4]; zero_acc(acc);
        sg_kloop<4>(256, arow, [=](int n, int k0) { return WPOOL + (size_t)(ct * 64 + n) * 256 + k0; }, NoKS(), acc, fr, fq);
#pragma unroll
        for (int mi = 0; mi < 4; ++mi) { const int row = rt * 64 + 16 * mi + fr;
#pragma unroll
            for (int nj = 0; nj < 4; ++nj) { const int c = ct * 64 + 16 * nj + 4 * fq; float* hp = H + (size_t)row * D + c;
                const f32x4 v = *(const f32x4*)hp + (acc[mi][nj] + *(const f32x4*)(a.in[I_PB] + c)) * *(const f32x4*)(a.in[I_PS] + c); *(f32x4*)hp = v;
                v2u w; w.x = pk2(v.x, v.y); w.y = pk2(v.z, v.w); *(v2u*)(HB + (size_t)row * D + c) = w; } }
    }
}
__device__ __forceinline__ void ph_final(const Args& a, int wk, int nwk) {
    const int tid = threadIdx.x, lane = tid & 63, wave = __builtin_amdgcn_readfirstlane(tid >> 6);
    const int gw = wk * NWAVES + wave, NGW = nwk * NWAVES;
    const float* H = (const float*)(a.ws + WS_H); const f32x4* gn = (const f32x4*)a.in[I_NORMF] + lane;
    for (int orow = gw; orow < NB * SEQ; orow += NGW) {
        const int b = orow / SEQ, l = orow - b * SEQ, row = b * LSEQ + NMETA + l;
        const f32x4* xr = (const f32x4*)(H + (size_t)row * D) + lane; f32x4 v[4]; float ss = 0.f;
#pragma unroll
        for (int j = 0; j < 4; ++j) { v[j] = xr[64 * j]; ss += v[j].x * v[j].x + v[j].y * v[j].y + v[j].z * v[j].z + v[j].w * v[j].w; }
        ss = wave_sum(ss);
        const float rstd = rsqrtf(ss * (1.f / D) + EPS);
        f32x4* o = (f32x4*)(a.out + (size_t)orow * D) + lane;
#pragma unroll
        for (int j = 0; j < 4; ++j) o[64 * j] = v[j] * rstd * gn[64 * j];
    }
}

__global__ void __launch_bounds__(NWAVES * 64, 2) fwd_kernel(Args a) {
    extern __shared__ __attribute__((aligned(16))) unsigned char lds_raw[];
    LAS unsigned char* lds = (LAS unsigned char*)lds_raw;
    volatile LAS unsigned* MISC = (volatile LAS unsigned*)(lds + LDS_BYTES - 256);
    const int tid = threadIdx.x;
    const int G = gridDim.x; const int bx = blockIdx.x;
    const int wk = (G % 8 == 0) ? (bx % 8) * (G / 8) + bx / 8 : bx;
    if (tid < 64) MISC[tid] = 0u;
    __syncthreads();
    XcdBarrier bar; bar.bar = (unsigned*)(a.ws + WS_CTL) + CW_BAR; bar.x = 0; bar.st = nullptr;
    if (N_LAUNCHES == 1) bar = xcd_barrier_post((unsigned*)(a.ws + WS_CTL) + CW_BAR, MISC + 8);
    const int lo = a.ph_lo, hi = a.ph_hi;
#ifndef PH_MASK
#define PH_MASK 0xFFFF
#endif
#define IN(k) (((PH_MASK >> (k)) & 1) && lo <= (k) && (k) < hi)
#define SEAM(k) do { if (IN(k) && IN((k) + 1)) xcd_barrier(bar); } while (0)
    if (IN(0)) { ph_prep(a, lds, wk, G); } SEAM(0);
    if (IN(1)) { ph_gemm1(a, wk, G); } SEAM(1);
    if (IN(2)) { ph_mixers(a, lds, wk, G); } SEAM(2);
    if (IN(3)) { ph_gemm2(a, wk, G); } SEAM(3);
    if (IN(4)) { ph_router(a, lds, 0, wk, G); } SEAM(4);
    if (IN(5)) { ph_moe_up(a, lds, 0, wk, G); } SEAM(5);
    if (IN(6)) { ph_moe_down(a, lds, 0, wk, G); } SEAM(6);
    if (IN(7)) { ph_rstd2(a, lds, wk, G); } SEAM(7);
    if (IN(8)) { ph_pooled(a, wk, G); } SEAM(8);
    if (IN(9)) { ph_poolgemm(a, wk, G); } SEAM(9);
    if (IN(10)) { ph_router(a, lds, 1, wk, G); } SEAM(10);
    if (IN(11)) { ph_moe_up(a, lds, 1, wk, G); } SEAM(11);
    if (IN(12)) { ph_moe_down(a, lds, 1, wk, G); } SEAM(12);
    if (IN(13)) { ph_final(a, wk, G); }
#undef IN
#undef SEAM
}

extern "C" void kernel_launch(void* const* d_in, const int* in_sizes, int n_in, void* d_out, int out_size, void* d_ws, size_t ws_size, hipStream_t stream) {
    static int grid = 0;
    if (grid == 0) {
        if (n_in != 31 || out_size != NB * SEQ * D || ws_size < WS_END) { fprintf(stderr, "kernel_launch: unexpected shapes (n_in %d out %d ws %zu)\n", n_in, out_size, ws_size); grid = -1; return; }
        int dev = 0, cus = 0;
        if (hipGetDevice(&dev) != hipSuccess || hipDeviceGetAttribute(&cus, hipDeviceAttributeMultiprocessorCount, dev) != hipSuccess) { grid = -1; return; }
        if (hipFuncSetAttribute((const void*)fwd_kernel, hipFuncAttributeMaxDynamicSharedMemorySize, LDS_BYTES) != hipSuccess) { grid = -1; return; }
        grid = cus;
    }
    if (grid < 0) return;
    (void)hipMemsetAsync((char*)d_ws + WS_CTL, 0, CTL_ZERO_BYTES, stream);
    Args a{};
    for (int i = 0; i < 31; ++i) a.in[i] = (const float*)d_in[i];
    a.out = (float*)d_out; a.ws = (unsigned char*)d_ws;
    if (N_LAUNCHES == 1) { a.ph_lo = 0; a.ph_hi = NPH; hipLaunchKernelGGL(fwd_kernel, dim3(grid), dim3(NWAVES * 64), LDS_BYTES, stream, a); }
    else for (int p = 0; p < NPH; ++p) { a.ph_lo = p; a.ph_hi = p + 1; hipLaunchKernelGGL(fwd_kernel, dim3(grid), dim3(NWAVES * 64), LDS_BYTES, stream, a); }
}
```

```cpp
#include <hip/hip_runtime.h>
#include <cstdio>
#include <cstdint>

#define GAS __attribute__((address_space(1)))
#define LAS __attribute__((address_space(3)))
typedef unsigned short bf16;
typedef short bf16x8 __attribute__((ext_vector_type(8)));
typedef float f32x4 __attribute__((ext_vector_type(4)));
typedef unsigned v4u __attribute__((ext_vector_type(4)));
typedef unsigned v2u __attribute__((ext_vector_type(2)));

#ifndef MK_N_LAUNCHES
#define MK_N_LAUNCHES 1
#endif
constexpr int NPH = 14;
constexpr int N_LAUNCHES = MK_N_LAUNCHES;

constexpr int NB = 8, SEQ = 2048, NMETA = 16, LSEQ = SEQ + NMETA, T = NB * LSEQ, D = 1024;
constexpr int PROJ_SRC = 4624, LDP = 4608;
constexpr int C_Z = 0, C_G = 1024, C_X = 2048, C_B = 3072, C_C = 3328, C_LI = 3584;
constexpr float EPS = 1e-6f;
constexpr int NBK = 24;

constexpr size_t MiB = 1u << 20;
constexpr size_t WS_CTL = 0, CTL_ZERO_BYTES = 1 * MiB;
constexpr size_t WS_WIN = 1 * MiB;
constexpr size_t WS_WOUT = 10 * MiB;
constexpr size_t WS_WPOOL = 14 * MiB;
constexpr size_t WS_WRT = 14 * MiB + 512 * 1024;
constexpr size_t WS_RSTD0 = 15 * MiB;
constexpr size_t WS_RSTD1 = WS_RSTD0 + 128 * 1024;
constexpr size_t WS_BKT = WS_RSTD1 + 128 * 1024;
constexpr size_t WS_GATES = WS_BKT + 128 * 1024;
constexpr size_t WS_DT = 16 * MiB;
constexpr size_t WS_SSDSQ = 17 * MiB + 64 * 1024;
constexpr size_t WS_LIST = 19 * MiB;
constexpr size_t WS_WGU = 21 * MiB;
constexpr size_t WS_WD = 53 * MiB;
constexpr size_t WS_H = 69 * MiB;
constexpr size_t WS_PROJ = 134 * MiB;
constexpr size_t WS_HID = WS_PROJ;
constexpr size_t WS_POOLED = WS_PROJ;
constexpr size_t WS_END = 280 * MiB;
static_assert(WS_H + (size_t)T * D * 4 <= WS_PROJ && WS_PROJ + (size_t)T * LDP * 2 <= WS_END, "ws map");
static_assert(WS_DT + (size_t)T * 16 * 4 <= WS_SSDSQ && WS_SSDSQ + (size_t)T * 16 * 4 <= WS_LIST && WS_LIST + (size_t)NBK * T * 4 <= WS_WGU, "ws map small");
constexpr int CW_CNT = 64;
constexpr int CW_BAR = 4096;

constexpr int LDS_BYTES = 147456;
constexpr int NWAVES = 8;

struct Args { const float* in[31]; float* out; unsigned char* ws; int ph_lo, ph_hi; };
enum { I_X = 0, I_META, I_NORMF, I_MNE, I_WIN, I_SCW, I_SCB, I_DTB, I_ALOG, I_SD, I_SNORM, I_LCW, I_LCB, I_LWA, I_LBA, I_LWX, I_LBX, I_LLAM, I_WOUT,
       I_MNO, I_PW, I_PB, I_PS, I_FFN, I_RGW, I_RGB, I_REW, I_REB, I_EWG, I_EWU, I_EWD };

#define LDS_WAIT() asm volatile("s_waitcnt lgkmcnt(0)" ::: "memory")
__device__ __forceinline__ float bf2f(unsigned v) { return __uint_as_float(v << 16); }
__device__ __forceinline__ unsigned f2bf(float f) { unsigned u = __float_as_uint(f); return (u + 0x7fffu + ((u >> 16) & 1u)) >> 16; }
__device__ __forceinline__ unsigned pk2(float lo, float hi) { return f2bf(lo) | (f2bf(hi) << 16); }
__device__ __forceinline__ float wave_sum(float v) {
#pragma unroll
    for (int o = 1; o < 64; o <<= 1) v += __shfl_xor(v, o);
    return v;
}
__device__ __forceinline__ float sigmoid_f(float v) { return 1.f / (1.f + __expf(-v)); }
__device__ __forceinline__ float silu_f(float v) { return v / (1.f + __expf(-v)); }
__device__ __forceinline__ float softplus_f(float v) { return v > 20.f ? v : log1pf(__expf(v)); }
__device__ __forceinline__ float gelu_tanh_f(float v) { const float u = 0.7978845608028654f * (v + 0.044715f * v * v * v); return 0.5f * v * (1.f + tanhf(u)); }
__device__ __forceinline__ const float* h0_row(const Args& a, int row) {
    const int b = row / LSEQ, l = row - b * LSEQ;
    return l < NMETA ? a.in[I_META] + (size_t)l * D : a.in[I_X] + ((size_t)b * SEQ + (l - NMETA)) * D;
}

#define XB_TMO      128
#define XB_XCNT(j)  (256  + 64 * (j))
#define XB_XSUB(j)  (1280 + 64 * (j))
#define XB_XGEN(j)  (2304 + 64 * (j))
#define XB_TOP      3328
#define XB_TOPGEN   3392
#define XCD_BAR_WORDS 3456
#define XB_SPIN_CAP (1u << 18)
__device__ __forceinline__ unsigned xb_ld(unsigned* p)              { return __hip_atomic_load(p, __ATOMIC_RELAXED, __HIP_MEMORY_SCOPE_AGENT); }
__device__ __forceinline__ unsigned xb_add(unsigned* p, unsigned v) { return __hip_atomic_fetch_add(p, v, __ATOMIC_RELAXED, __HIP_MEMORY_SCOPE_AGENT); }
__device__ __forceinline__ unsigned xb_xcc_id() { return (unsigned)__builtin_amdgcn_s_getreg((3 << 11) | 20) & 0xFu; }
#define XB_SPIN(cond, bar) do { unsigned _sp = 0; while (cond) { __builtin_amdgcn_s_sleep(1); \
    if ((++_sp & 255u) == 0u) { if (xb_ld(&(bar)[XB_TMO])) break; if (_sp > XB_SPIN_CAP) { atomicAdd(&(bar)[XB_TMO], 1u); break; } } } } while (0)
struct XcdBarrier { unsigned* bar; unsigned x; volatile LAS unsigned* st; };
__device__ __forceinline__ XcdBarrier xcd_barrier_post(unsigned* bar, volatile LAS unsigned* st) {
    XcdBarrier b; b.bar = bar; b.x = xb_xcc_id(); b.st = st;
    if (threadIdx.x == 0) (void)xb_add(&bar[XB_XCNT(b.x)], 1u);
    return b;
}
__device__ __forceinline__ void xcd_barrier_complete(unsigned* bar, unsigned x, unsigned& nloc, unsigned& nx) {
    const unsigned G = gridDim.x * gridDim.y * gridDim.z;
    unsigned sum, cnt, mine, sp = 0u;
    for (;;) {
        sum = 0u; cnt = 0u; mine = 0u;
#pragma unroll
        for (unsigned j = 0; j < 16; ++j) { const unsigned c = xb_ld(&bar[XB_XCNT(j)]); sum += c; cnt += (c > 0u) ? 1u : 0u; mine = (j == x) ? c : mine; }
        if (sum == G) break;
        __builtin_amdgcn_s_sleep(1);
        if ((++sp & 255u) == 0u) { if (xb_ld(&bar[XB_TMO])) break; if (sp > XB_SPIN_CAP) { atomicAdd(&bar[XB_TMO], 1u); break; } }
    }
    nloc = mine > 0u ? mine : 1u; nx = cnt > 0u ? cnt : 1u;
}
__device__ __forceinline__ void xcd_barrier(const XcdBarrier& b) {
    asm volatile("s_waitcnt vmcnt(0)" ::: "memory");
    __syncthreads();
    if (threadIdx.x == 0) {
        unsigned* bar = b.bar;
        __builtin_amdgcn_s_waitcnt(0);
        unsigned nloc = b.st[0], nx = b.st[1];
        if (nloc == 0u) { xcd_barrier_complete(bar, b.x, nloc, nx); b.st[0] = nloc; b.st[1] = nx; }
        const unsigned old = xb_add(&bar[XB_XSUB(b.x)], 1u);
        const unsigned gen = old / nloc;
        if (old + 1u == (gen + 1u) * nloc) {
            __builtin_amdgcn_fence(__ATOMIC_RELEASE, "agent");
            asm volatile("s_waitcnt vmcnt(0)" ::: "memory");
            const unsigned og = xb_add(&bar[XB_TOP], 1u);
            const unsigned tg = og / nx;
            if (og + 1u == (tg + 1u) * nx) xb_add(&bar[XB_TOPGEN], 1u);
            else XB_SPIN(xb_ld(&bar[XB_TOPGEN]) == tg, bar);
            __builtin_amdgcn_fence(__ATOMIC_ACQUIRE, "agent");
            xb_add(&bar[XB_XGEN(b.x)], 1u);
            asm volatile("s_waitcnt vmcnt(0)" ::: "memory");
        } else {
            XB_SPIN(xb_ld(&bar[XB_XGEN(b.x)]) == gen, bar);
            __builtin_amdgcn_fence(__ATOMIC_ACQUIRE, "agent");
            asm volatile("s_waitcnt vmcnt(0)" ::: "memory");
        }
    }
    __syncthreads();
}

__device__ __forceinline__ void tr_item(const float* src, int ldsrc, const float* gain, bf16* dst, int lddst, LAS float* scr, int lane) {
#pragma unroll 8
    for (int i = 0; i < 32; ++i) { const int kk = 2 * i + (lane >> 5); float v = src[(size_t)kk * ldsrc + (lane & 31)]; if (gain) v *= gain[kk]; scr[kk * 33 + (lane & 31)] = v; }
    LDS_WAIT();
    const int c = lane & 7;
#pragma unroll
    for (int j = 0; j < 4; ++j) { const int n = (lane >> 3) + 8 * j; const LAS float* s = scr + (8 * c) * 33 + n;
        v4u o; o.x = pk2(s[0 * 33], s[1 * 33]); o.y = pk2(s[2 * 33], s[3 * 33]); o.z = pk2(s[4 * 33], s[5 * 33]); o.w = pk2(s[6 * 33], s[7 * 33]);
        *(v4u*)(dst + (size_t)n * lddst + 8 * c) = o; }
    LDS_WAIT();
}
__device__ __forceinline__ void convert_experts(const Args& a, int L, LAS float* scr, int gw, int NGW, int lane) {
    bf16* WGU = (bf16*)(a.ws + WS_WGU); bf16* WD = (bf16*)(a.ws + WS_WD);
    const float* gain = a.in[I_FFN] + L * D;
    constexpr int I_GU = 16 * 16 * 16, I_DN = 16 * 8 * 32;
    for (int it = gw; it < 2 * I_GU + I_DN; it += NGW) {
        int r = it;
        if (r < 2 * I_GU) {
            const int up = r >= I_GU; if (up) r -= I_GU;
            const int e = r >> 8, kb = (r >> 4) & 15, nb = r & 15;
            const float* src = a.in[up ? I_EWU : I_EWG] + ((size_t)(L * 16 + e) * 1024 + kb * 64) * 512 + nb * 32;
            const int drow = e * 1024 + (nb >> 2) * 256 + (nb & 3) * 32 + (up ? 128 : 0);
            tr_item(src, 512, gain + kb * 64, WGU + (size_t)drow * 1024 + kb * 64, 1024, scr, lane);
        } else {
            r -= 2 * I_GU;
            const int e = r >> 8, kb = (r >> 5) & 7, nb = r & 31;
            const float* src = a.in[I_EWD] + ((size_t)(L * 16 + e) * 512 + kb * 64) * 1024 + nb * 32;
            tr_item(src, 1024, nullptr, WD + (size_t)(e * 1024 + nb * 32) * 512 + kb * 64, 512, scr, lane);
        }
    }
}
__device__ __forceinline__ void ph_prep(const Args& a, LAS unsigned char* lds, int wk, int nwk) {
    const int tid = threadIdx.x, lane = tid & 63, wave = __builtin_amdgcn_readfirstlane(tid >> 6);
    const int gw = wk * NWAVES + wave, NGW = nwk * NWAVES;
    LAS float* wdt = (LAS float*)lds;
    LAS float* scr = (LAS float*)(lds + 65536 + wave * 8448);
    {
        const float* win = a.in[I_WIN]; const float* ge = a.in[I_MNE];
        for (int i = tid; i < 16 * 1024; i += 512) { const int k = i >> 4, j = i & 15; wdt[j * 1024 + k] = win[(size_t)k * PROJ_SRC + 2560 + j] * ge[k]; }
    }
    bf16* WIN = (bf16*)(a.ws + WS_WIN); bf16* WOUT = (bf16*)(a.ws + WS_WOUT); bf16* WPOOL = (bf16*)(a.ws + WS_WPOOL);
    constexpr int I_IN = 16 * 144, I_OUT = 32 * 32, I_POOL = 4 * 4 * 8;
    for (int it = gw; it < I_IN + I_OUT + I_POOL; it += NGW) {
        int r = it;
        if (r < I_IN) { const int kb = r / 144, nb = r % 144, n0 = nb * 32;
            const int sc = n0 < 1024 ? n0 : (n0 < 2048 ? n0 - 1024 + 2576 : (n0 < 3584 ? n0 - 2048 + 1024 : n0 - 3584 + 3600));
            tr_item(a.in[I_WIN] + (size_t)(kb * 64) * PROJ_SRC + sc, PROJ_SRC, a.in[I_MNE] + kb * 64, WIN + (size_t)n0 * 1024 + kb * 64, 1024, scr, lane); continue; }
        r -= I_IN;
        if (r < I_OUT) { const int kb = r >> 5, nb = r & 31;
            tr_item(a.in[I_WOUT] + (size_t)(kb * 64) * 1024 + nb * 32, 1024, kb < 16 ? a.in[I_SNORM] + kb * 64 : nullptr, WOUT + (size_t)(nb * 32) * 2048 + kb * 64, 2048, scr, lane); continue; }
        r -= I_OUT;
        { const int g = r >> 5, kb = (r >> 3) & 3, nb = r & 7;
            tr_item(a.in[I_PW] + (size_t)g * 65536 + (size_t)(kb * 64) * 256 + nb * 32, 256, a.in[I_MNO] + g * 256 + kb * 64, WPOOL + (size_t)(g * 256 + nb * 32) * 256 + kb * 64, 256, scr, lane); }
    }
    convert_experts(a, 0, scr, gw, NGW, lane);
    {
        float* WRT = (float*)(a.ws + WS_WRT);
        for (int i = wk * 512 + tid; i < 2 * 20 * 1024; i += nwk * 512) {
            const int L = i / 20480, r = i % 20480, j = r >> 10, k = r & 1023;
            const float w = j < 4 ? a.in[I_RGW][((size_t)L * 1024 + k) * 4 + j] : a.in[I_REW][((size_t)L * 1024 + k) * 16 + (j - 4)];
            WRT[i] = w * a.in[I_FFN][L * 1024 + k];
        }
    }
    __syncthreads();
    bf16* HB = (bf16*)a.out; float* RSTD0 = (float*)(a.ws + WS_RSTD0); float* DT = (float*)(a.ws + WS_DT);
    for (int row = gw; row < T; row += NGW) {
        const f32x4* xr = (const f32x4*)h0_row(a, row) + lane;
        f32x4 v[4]; float ss = 0.f;
#pragma unroll
        for (int j = 0; j < 4; ++j) { v[j] = xr[64 * j]; ss += v[j].x * v[j].x + v[j].y * v[j].y + v[j].z * v[j].z + v[j].w * v[j].w; }
        ss = wave_sum(ss);
        const float rstd = rsqrtf(ss * (1.f / D) + EPS);
        v2u* o8 = (v2u*)(HB + (size_t)row * D) + lane;
#pragma unroll
        for (int j = 0; j < 4; ++j) { v2u w; w.x = pk2(v[j].x, v[j].y); w.y = pk2(v[j].z, v[j].w); o8[64 * j] = w; }
        float mydt = 0.f;
#pragma unroll 2
        for (int jj = 0; jj < 16; ++jj) {
            float s = 0.f;
#pragma unroll
            for (int j = 0; j < 4; ++j) { const f32x4 w = *(const LAS f32x4*)(wdt + jj * 1024 + (lane + 64 * j) * 4); s += v[j].x * w.x + v[j].y * w.y + v[j].z * w.z + v[j].w * w.w; }
            s = wave_sum(s);
            if (lane == jj) mydt = s;
        }
        if (lane == 0) RSTD0[row] = rstd;
        if (lane < 16) DT[(size_t)row * 16 + lane] = softplus_f(mydt * rstd + a.in[I_DTB][lane]);
    }
}

template <int NT, class BP, class KS>
__device__ __forceinline__ void sg_kloop(int K, const bf16* const (&arow)[4], BP bp, KS ks, f32x4 (&acc)[4][NT], int fr, int fq) {
    for (int k0 = 0; k0 < K; k0 += 32) {
        ks(k0, acc);
        bf16x8 av[4], bv[NT];
#pragma unroll
        for (int mi = 0; mi < 4; ++mi) av[mi] = *(const bf16x8*)(arow[mi] + k0 + 8 * fq);
#pragma unroll
        for (int nj = 0; nj < NT; ++nj) bv[nj] = *(const bf16x8*)(bp(16 * nj + fr, k0) + 8 * fq);
#pragma unroll
        for (int mi = 0; mi < 4; ++mi)
#pragma unroll
            for (int nj = 0; nj < NT; ++nj) acc[mi][nj] = __builtin_amdgcn_mfma_f32_16x16x32_bf16(bv[nj], av[mi], acc[mi][nj], 0, 0, 0);
    }
}
template <int NT> __device__ __forceinline__ void zero_acc(f32x4 (&acc)[4][NT]) {
#pragma unroll
    for (int mi = 0; mi < 4; ++mi)
#pragma unroll
        for (int nj = 0; nj < NT; ++nj) acc[mi][nj] = (f32x4){0.f, 0.f, 0.f, 0.f};
}
struct NoKS { template <int NT> __device__ __forceinline__ void operator()(int, f32x4 (&)[4][NT]) const {} };

__device__ __forceinline__ void ph_gemm1(const Args& a, int wk, int nwk) {
    const int tid = threadIdx.x, lane = tid & 63, wave = __builtin_amdgcn_readfirstlane(tid >> 6), fr = lane & 15, fq = lane >> 4;
    const int gw = wk * NWAVES + wave, NGW = nwk * NWAVES;
    const bf16* HB = (const bf16*)a.out; const bf16* WIN = (const bf16*)(a.ws + WS_WIN); bf16* PROJ = (bf16*)(a.ws + WS_PROJ);
    const float* RSTD0 = (const float*)(a.ws + WS_RSTD0);
    for (int u = gw; u < 258 * 72; u += NGW) {
        const int rt = u / 72, ct = u % 72;
        const bf16* arow[4];
#pragma unroll
        for (int mi = 0; mi < 4; ++mi) arow[mi] = HB + (size_t)(rt * 64 + 16 * mi + fr) * D;
        f32x4 acc[4][4]; zero_acc(acc);
        sg_kloop<4>(1024, arow, [=](int n, int k0) { return WIN + (size_t)(ct * 64 + n) * 1024 + k0; }, NoKS(), acc, fr, fq);
#pragma unroll
        for (int mi = 0; mi < 4; ++mi) { const int row = rt * 64 + 16 * mi + fr; const float rs = RSTD0[row];
#pragma unroll
            for (int nj = 0; nj < 4; ++nj) { const f32x4 v = acc[mi][nj] * rs; v2u w; w.x = pk2(v.x, v.y); w.y = pk2(v.z, v.w);
                *(v2u*)(PROJ + (size_t)row * LDP + ct * 64 + 16 * nj + 4 * fq) = w; } }
    }
}

__device__ __forceinline__ void ph_gemm2(const Args& a, int wk, int nwk) {
    const int tid = threadIdx.x, lane = tid & 63, wave = __builtin_amdgcn_readfirstlane(tid >> 6), fr = lane & 15, fq = lane >> 4;
    const int gw = wk * NWAVES + wave, NGW = nwk * NWAVES;
    const bf16* PROJ = (const bf16*)(a.ws + WS_PROJ); const bf16* WOUT = (const bf16*)(a.ws + WS_WOUT);
    const float* SSDSQ = (const float*)(a.ws + WS_SSDSQ);
    float* H = (float*)(a.ws + WS_H); bf16* HB = (bf16*)a.out;
    for (int u = gw; u < 258 * 16; u += NGW) {
        const int rt = u / 16, ct = u % 16;
        const bf16* arow[4]; float f0[4], f1[4];
#pragma unroll
        for (int mi = 0; mi < 4; ++mi) { const int row = rt * 64 + 16 * mi + fr; arow[mi] = PROJ + (size_t)row * LDP;
            const f32x4* sq = (const f32x4*)(SSDSQ + (size_t)row * 16); const f32x4 q0 = sq[0], q1 = sq[1], q2 = sq[2], q3 = sq[3];
            const float s0 = (q0.x + q0.y + q0.z + q0.w) + (q1.x + q1.y + q1.z + q1.w), s1 = (q2.x + q2.y + q2.z + q2.w) + (q3.x + q3.y + q3.z + q3.w);
            const float r0 = rsqrtf(s0 * (1.f / 512.f) + EPS), r1 = rsqrtf(s1 * (1.f / 512.f) + EPS);
            f0[mi] = r0 / r1; f1[mi] = r1; }
        f32x4 acc[4][4]; zero_acc(acc);
        auto ks = [=](int k0, f32x4 (&ac)[4][4]) {
            if (k0 == 512) {
#pragma unroll
                for (int mi = 0; mi < 4; ++mi)
#pragma unroll
                    for (int nj = 0; nj < 4; ++nj) ac[mi][nj] *= f0[mi]; }
            if (k0 == 1024) {
#pragma unroll
                for (int mi = 0; mi < 4; ++mi)
#pragma unroll
                    for (int nj = 0; nj < 4; ++nj) ac[mi][nj] *= f1[mi]; }
        };
        sg_kloop<4>(2048, arow, [=](int n, int k0) { return WOUT + (size_t)(ct * 64 + n) * 2048 + k0; }, ks, acc, fr, fq);
#pragma unroll
        for (int mi = 0; mi < 4; ++mi) { const int row = rt * 64 + 16 * mi + fr; const float* hr = h0_row(a, row);
#pragma unroll
            for (int nj = 0; nj < 4; ++nj) { const int c = ct * 64 + 16 * nj + 4 * fq; const f32x4 v = acc[mi][nj] + *(const f32x4*)(hr + c);
                *(f32x4*)(H + (size_t)row * D + c) = v; v2u w; w.x = pk2(v.x, v.y); w.y = pk2(v.z, v.w); *(v2u*)(HB + (size_t)row * D + c) = w; } }
    }
}

__device__ __forceinline__ void ssd_item(const Args& a, LAS unsigned char* lds, int b, int h) {
    const int tid = threadIdx.x, lane = tid & 63;
    constexpr int TB = 64;
    LAS float* xs = (LAS float*)lds;
    LAS float* Bs = xs + TB * 64;
    LAS float* Cs = Bs + TB * 128;
    LAS float* ys = Cs + TB * 128;
    LAS float* dts = ys + TB * 64;
    LAS float* decs = dts + TB;
    bf16* PROJ = (bf16*)(a.ws + WS_PROJ); const float* DT = (const float*)(a.ws + WS_DT); float* SSDSQ = (float*)(a.ws + WS_SSDSQ);
    const int g = h >> 3;
    const float Ah = -__expf(a.in[I_ALOG][h]), Dh = a.in[I_SD][h];
    int ccol = 0, cch = 0; float cw0 = 0.f, cw1 = 0.f, cw2 = 0.f, cw3 = 0.f, cb = 0.f;
    if (tid < 320) {
        if (tid < 64) { ccol = C_X + h * 64 + tid; cch = h * 64 + tid; }
        else if (tid < 192) { ccol = C_B + g * 128 + (tid - 64); cch = 1024 + g * 128 + (tid - 64); }
        else { ccol = C_C + g * 128 + (tid - 192); cch = 1280 + g * 128 + (tid - 192); }
        const float* cw = a.in[I_SCW]; cw0 = cw[cch]; cw1 = cw[1536 + cch]; cw2 = cw[2 * 1536 + cch]; cw3 = cw[3 * 1536 + cch]; cb = a.in[I_SCB][cch];
    }
    const int p = tid >> 3, nq = tid & 7;
    float S[16];
#pragma unroll
    for (int i = 0; i < 16; ++i) S[i] = 0.f;
    const size_t rbase = (size_t)b * LSEQ;
    for (int l0 = 0; l0 < LSEQ; l0 += TB) {
        const int nt = (LSEQ - l0) < TB ? (LSEQ - l0) : TB;
        __syncthreads();
        if (tid < 320) {
            float r0 = l0 >= 3 ? bf2f(PROJ[(rbase + l0 - 3) * LDP + ccol]) : 0.f, r1 = l0 >= 2 ? bf2f(PROJ[(rbase + l0 - 2) * LDP + ccol]) : 0.f, r2 = l0 >= 1 ? bf2f(PROJ[(rbase + l0 - 1) * LDP + ccol]) : 0.f;
            for (int t = 0; t < nt; ++t) {
                const float r3 = bf2f(PROJ[(rbase + l0 + t) * LDP + ccol]);
                const float v = silu_f(cw0 * r0 + cw1 * r1 + cw2 * r2 + cw3 * r3 + cb);
                if (tid < 64) xs[t * 64 + tid] = v; else if (tid < 192) Bs[t * 128 + tid - 64] = v; else Cs[t * 128 + tid - 192] = v;
                r0 = r1; r1 = r2; r2 = r3;
            }
        } else if (tid < 320 + TB) {
            const int t = tid - 320;
            if (t < nt) { const float dt = DT[(rbase + l0 + t) * 16 + h]; dts[t] = dt; decs[t] = __expf(Ah * dt); }
        }
        __syncthreads();
        for (int t = 0; t < nt; ++t) {
            const float xv = xs[t * 64 + p], xdt = xv * dts[t], dec = decs[t];
            float yp = 0.f;
#pragma unroll
            for (int i = 0; i < 16; ++i) { S[i] = dec * S[i] + Bs[t * 128 + nq * 16 + i] * xdt; yp += Cs[t * 128 + nq * 16 + i] * S[i]; }
            yp += __shfl_xor(yp, 1); yp += __shfl_xor(yp, 2); yp += __shfl_xor(yp, 4);
            if (nq == 0) ys[t * 64 + p] = yp + Dh * xv;
        }
        __syncthreads();
        for (int t = tid >> 6; t < nt; t += 8) {
            const size_t row = rbase + l0 + t;
            const float z = bf2f(PROJ[row * LDP + C_Z + h * 64 + lane]);
            const float yg = ys[t * 64 + lane] * silu_f(z);
            PROJ[row * LDP + C_Z + h * 64 + lane] = (bf16)f2bf(yg);
            const float sq = wave_sum(yg * yg);
            if (lane == 0) SSDSQ[row * 16 + h] = sq;
        }
    }
    __syncthreads();
}
__device__ __forceinline__ void lru_item(const Args& a, LAS unsigned char* lds, int b, int h) {
    const int tid = threadIdx.x;
    constexpr int TB = 64;
    LAS float* Wa = (LAS float*)lds;
    LAS float* Wx = Wa + 4096;
    LAS float* xb = Wx + 4096;
    LAS float* as = xb + TB * 64;
    LAS float* us = as + TB * 64;
    bf16* PROJ = (bf16*)(a.ws + WS_PROJ);
    __syncthreads();
    for (int i = tid; i < 4096; i += 512) { Wa[i] = a.in[I_LWA][(size_t)h * 4096 + i]; Wx[i] = a.in[I_LWX][(size_t)h * 4096 + i]; }
    const size_t rbase = (size_t)b * LSEQ;
    float hprev = 0.f;
    const int c = tid & 63, tq = tid >> 6;
    const float* cw = a.in[I_LCW]; const int ch = h * 64 + c;
    const float cw0 = cw[ch], cw1 = cw[1024 + ch], cw2 = cw[2048 + ch], cw3 = cw[3072 + ch], cb = a.in[I_LCB][ch];
    const int gt = tid >> 3, jq = tid & 7;
    for (int l0 = 0; l0 < LSEQ; l0 += TB) {
        const int nt = (LSEQ - l0) < TB ? (LSEQ - l0) : TB;
        __syncthreads();
        for (int t = tq * 8; t < tq * 8 + 8; ++t) if (t < nt) {
            const int l = l0 + t; const size_t row = rbase + l;
            const float r3 = bf2f(PROJ[row * LDP + C_LI + ch]);
            const float r2 = l >= 1 ? bf2f(PROJ[(row - 1) * LDP + C_LI + ch]) : 0.f;
            const float r1 = l >= 2 ? bf2f(PROJ[(row - 2) * LDP + C_LI + ch]) : 0.f;
            const float r0 = l >= 3 ? bf2f(PROJ[(row - 3) * LDP + C_LI + ch]) : 0.f;
            xb[t * 64 + c] = cw0 * r0 + cw1 * r1 + cw2 * r2 + cw3 * r3 + cb;
        }
        __syncthreads();
        if (gt < nt) {
            float ra[8], ri[8];
#pragma unroll
            for (int j = 0; j < 8; ++j) { ra[j] = 0.f; ri[j] = 0.f; }
            for (int i = 0; i < 64; ++i) { const float xv = xb[gt * 64 + i];
#pragma unroll
                for (int j = 0; j < 8; ++j) { ra[j] += xv * Wa[i * 64 + jq * 8 + j]; ri[j] += xv * Wx[i * 64 + jq * 8 + j]; } }
#pragma unroll
            for (int j = 0; j < 8; ++j) { const int cc = h * 64 + jq * 8 + j;
                const float r = sigmoid_f(ra[j] + a.in[I_LBA][cc]), ig = sigmoid_f(ri[j] + a.in[I_LBX][cc]);
                const float log_a = -8.0f * r * softplus_f(-a.in[I_LLAM][cc]);
                const float av = __expf(log_a);
                const float mult = (l0 + gt == 0) ? 1.f : sqrtf(fmaxf(-expm1f(2.f * log_a), 0.f));
                as[gt * 64 + jq * 8 + j] = av; us[gt * 64 + jq * 8 + j] = mult * ig * xb[gt * 64 + jq * 8 + j]; }
        }
        __syncthreads();
        if (tid < 64) { for (int t = 0; t < nt; ++t) { hprev = as[t * 64 + tid] * hprev + us[t * 64 + tid]; us[t * 64 + tid] = hprev; } }
        __syncthreads();
        for (int t = tq * 8; t < tq * 8 + 8; ++t) if (t < nt) {
            const size_t row = rbase + l0 + t;
            const float gv = bf2f(PROJ[row * LDP + C_G + ch]);
            PROJ[row * LDP + C_G + ch] = (bf16)f2bf(us[t * 64 + c] * gelu_tanh_f(gv));
        }
    }
    __syncthreads();
}
__device__ __forceinline__ void ph_mixers(const Args& a, LAS unsigned char* lds, int wk, int nwk) {
    for (int it = wk; it < 256; it += nwk) {
        if (it < 128) ssd_item(a, lds, it >> 4, it & 15); else lru_item(a, lds, (it - 128) >> 4, (it - 128) & 15);
    }
}

__device__ __forceinline__ void ph_router(const Args& a, LAS unsigned char* lds, int L, int wk, int nwk) {
    const int tid = threadIdx.x, lane = tid & 63, wave = __builtin_amdgcn_readfirstlane(tid >> 6);
    const int gw = wk * NWAVES + wave, NGW = nwk * NWAVES;
    LAS float* wr = (LAS float*)lds;
    const float* WRT = (const float*)(a.ws + WS_WRT) + (size_t)L * 20480;
    __syncthreads();
    for (int i = tid; i < 20480 / 4; i += 512) ((LAS f32x4*)wr)[i] = ((const f32x4*)WRT)[i];
    __syncthreads();
    const float* H = (const float*)(a.ws + WS_H);
    float* RSTD1 = (float*)(a.ws + WS_RSTD1); float* GATES = (float*)(a.ws + WS_GATES); int* LIST = (int*)(a.ws + WS_LIST);
    unsigned* cnt = (unsigned*)(a.ws + WS_CTL) + CW_CNT + 64 * L;
    const float* bg = a.in[I_RGB] + L * 4; const float* be = a.in[I_REB] + L * 16;
    for (int row = gw; row < T; row += NGW) {
        const f32x4* xr = (const f32x4*)(H + (size_t)row * D) + lane;
        f32x4 v[4]; float ss = 0.f;
#pragma unroll
        for (int j = 0; j < 4; ++j) { v[j] = xr[64 * j]; ss += v[j].x * v[j].x + v[j].y * v[j].y + v[j].z * v[j].z + v[j].w * v[j].w; }
        ss = wave_sum(ss);
        const float rstd = rsqrtf(ss * (1.f / D) + EPS);
        float mylg = 0.f;
#pragma unroll 2
        for (int jj = 0; jj < 20; ++jj) {
            float s = 0.f;
#pragma unroll
            for (int j = 0; j < 4; ++j) { const f32x4 w = *(const LAS f32x4*)(wr + jj * 1024 + (lane + 64 * j) * 4); s += v[j].x * w.x + v[j].y * w.y + v[j].z * w.z + v[j].w * w.w; }
            s = wave_sum(s);
            if (lane == jj) mylg = s;
        }
        mylg = mylg * rstd + (lane < 4 ? bg[lane & 3] : be[(lane - 4) & 15]);
        float lg[20];
#pragma unroll
        for (int jj = 0; jj < 20; ++jj) lg[jj] = __shfl(mylg, jj);
        int gs = 0; float gm = lg[0];
#pragma unroll
        for (int j = 1; j < 4; ++j) if (lg[j] > gm) { gm = lg[j]; gs = j; }
        const float pg = 1.f / (__expf(lg[0] - gm) + __expf(lg[1] - gm) + __expf(lg[2] - gm) + __expf(lg[3] - gm));
        float f[4];
#pragma unroll
        for (int i = 0; i < 4; ++i) f[i] = gs == 0 ? lg[4 + i] : (gs == 1 ? lg[8 + i] : (gs == 2 ? lg[12 + i] : lg[16 + i]));
        int i0 = 0; float m0 = f[0];
#pragma unroll
        for (int i = 1; i < 4; ++i) if (f[i] > m0) { m0 = f[i]; i0 = i; }
        int i1 = -1; float m1 = -3.0e38f;
#pragma unroll
        for (int i = 0; i < 4; ++i) if (i != i0 && f[i] > m1) { m1 = f[i]; i1 = i; }
        const float w0 = 1.f / (1.f + __expf(m1 - m0)), w1 = 1.f - w0;
        const int lo = i0 < i1 ? i0 : i1, hi = i0 < i1 ? i1 : i0;
        const float glo = pg * (i0 < i1 ? w0 : w1), ghi = pg * (i0 < i1 ? w1 : w0);
        const int pair = lo == 0 ? hi - 1 : (lo == 1 ? hi + 1 : 5);
        const int bk = gs * 6 + pair;
        if (lane == 0) {
            const unsigned slot = atomicAdd(cnt + bk, 1u);
            LIST[(size_t)bk * T + slot] = row;
            RSTD1[row] = rstd; GATES[(size_t)row * 2] = glo; GATES[(size_t)row * 2 + 1] = ghi;
        }
    }
}

struct BkTab { int cnt[NBK], off[NBK], ust[NBK + 1]; };
__device__ __forceinline__ void bk_table(const Args& a, LAS unsigned char* lds, int L, int per_tile  ) {
    LAS int* tb = (LAS int*)lds;
    __syncthreads();
    if (threadIdx.x == 0) {
        const unsigned* cnt = (const unsigned*)(a.ws + WS_CTL) + CW_CNT + 64 * L;
        int off = 0, us = 0;
        for (int i = 0; i < NBK; ++i) { const int c = (int)__hip_atomic_load(cnt + i, __ATOMIC_RELAXED, __HIP_MEMORY_SCOPE_AGENT);
            tb[i] = c; tb[NBK + i] = off; tb[2 * NBK + i] = us; off += (c + 255) & ~255; us += ((c + 63) >> 6) * per_tile; }
        tb[2 * NBK + NBK] = us;
    }
    __syncthreads();
}
__device__ __forceinline__ void bk_experts(int bk, int& elo, int& ehi) {
    const int g = bk / 6, pr = bk - g * 6;
    const int lo = pr < 3 ? 0 : (pr < 5 ? 1 : 2), hi = pr < 3 ? pr + 1 : (pr < 5 ? pr - 1 : 3);
    elo = g * 4 + lo; ehi = g * 4 + hi;
}
__device__ __forceinline__ void ph_moe_up(const Args& a, LAS unsigned char* lds, int L, int wk, int nwk) {
    const int tid = threadIdx.x, lane = tid & 63, wave = __builtin_amdgcn_readfirstlane(tid >> 6), fr = lane & 15, fq = lane >> 4;
    const int gw = wk * NWAVES + wave, NGW = nwk * NWAVES;
    bk_table(a, lds, L, 32);
    LAS int* tb = (LAS int*)lds;
    const bf16* HB = (const bf16*)a.out; const bf16* WGU = (const bf16*)(a.ws + WS_WGU); bf16* HID = (bf16*)(a.ws + WS_HID);
    const int* LIST = (const int*)(a.ws + WS_LIST); const float* RSTD1 = (const float*)(a.ws + WS_RSTD1); const float* GATES = (const float*)(a.ws + WS_GATES);
    const int nun = tb[2 * NBK + NBK];
    for (int u = gw; u < nun; u += NGW) {
        int bk = 0;
        for (int i = 1; i < NBK; ++i) if (u >= tb[2 * NBK + i]) bk = i;
        const int cnt = tb[bk], off = tb[NBK + bk], r = u - tb[2 * NBK + bk];
        const int rt = r >> 5, ek = (r >> 4) & 1, ct = r & 15;
        int elo, ehi; bk_experts(bk, elo, ehi); const int e = ek ? ehi : elo;
        const int c0 = ct * 32, brow = e * 1024 + (c0 >> 7) * 256 + (c0 & 127);
        const bf16* arow[4]; int tok[4];
#pragma unroll
        for (int mi = 0; mi < 4; ++mi) { int rr = rt * 64 + 16 * mi + fr; if (rr >= cnt) rr = cnt - 1; tok[mi] = LIST[(size_t)bk * T + rr]; arow[mi] = HB + (size_t)tok[mi] * D; }
        f32x4 acc[4][4]; zero_acc(acc);
        sg_kloop<4>(1024, arow, [=](int n, int k0) { return WGU + (size_t)(brow + (n < 32 ? n : n + 96)) * 1024 + k0; }, NoKS(), acc, fr, fq);
#pragma unroll
        for (int mi = 0; mi < 4; ++mi) { const int rr = rt * 64 + 16 * mi + fr;
            if (rr < cnt) { const float rs = RSTD1[tok[mi]], gt = GATES[(size_t)tok[mi] * 2 + ek];
#pragma unroll
                for (int nj = 0; nj < 2; ++nj) { const f32x4 gv = acc[mi][nj] * rs, uv = acc[mi][nj + 2] * rs; f32x4 hv;
                    hv.x = silu_f(gv.x) * uv.x * gt; hv.y = silu_f(gv.y) * uv.y * gt; hv.z = silu_f(gv.z) * uv.z * gt; hv.w = silu_f(gv.w) * uv.w * gt;
                    v2u w; w.x = pk2(hv.x, hv.y); w.y = pk2(hv.z, hv.w);
                    *(v2u*)(HID + (size_t)(off + rr) * 1024 + ek * 512 + c0 + 16 * nj + 4 * fq) = w; } } }
    }
}
__device__ __forceinline__ void ph_moe_down(const Args& a, LAS unsigned char* lds, int L, int wk, int nwk) {
    const int tid = threadIdx.x, lane = tid & 63, wave = __builtin_amdgcn_readfirstlane(tid >> 6), fr = lane & 15, fq = lane >> 4;
    const int gw = wk * NWAVES + wave, NGW = nwk * NWAVES;
    bk_table(a, lds, L, 16);
    LAS int* tb = (LAS int*)lds;
    const bf16* HID = (const bf16*)(a.ws + WS_HID); const bf16* WD = (const bf16*)(a.ws + WS_WD);
    float* H = (float*)(a.ws + WS_H); bf16* HB = (bf16*)a.out; const int* LIST = (const int*)(a.ws + WS_LIST);
    const int nun = tb[2 * NBK + NBK];
    for (int u = gw; u < nun; u += NGW) {
        int bk = 0;
        for (int i = 1; i < NBK; ++i) if (u >= tb[2 * NBK + i]) bk = i;
        const int cnt = tb[bk], off = tb[NBK + bk], r = u - tb[2 * NBK + bk];
        const int rt = r >> 4, ct = r & 15;
        int elo, ehi; bk_experts(bk, elo, ehi);
        const bf16* arow[4];
#pragma unroll
        for (int mi = 0; mi < 4; ++mi) arow[mi] = HID + (size_t)(off + rt * 64 + 16 * mi + fr) * 1024;
        f32x4 acc[4][4]; zero_acc(acc);
        sg_kloop<4>(1024, arow, [=](int n, int k0) { return WD + ((size_t)((k0 < 512 ? elo : ehi) * 1024 + ct * 64 + n)) * 512 + (k0 & 511); }, NoKS(), acc, fr, fq);
#pragma unroll
        for (int mi = 0; mi < 4; ++mi) { const int rr = rt * 64 + 16 * mi + fr;
            if (rr < cnt) { const int tok = LIST[(size_t)bk * T + rr];
#pragma unroll
                for (int nj = 0; nj < 4; ++nj) { const int c = ct * 64 + 16 * nj + 4 * fq; float* hp = H + (size_t)tok * D + c;
                    const f32x4 v = *(const f32x4*)hp + acc[mi][nj]; *(f32x4*)hp = v;
                    v2u w; w.x = pk2(v.x, v.y); w.y = pk2(v.z, v.w); *(v2u*)(HB + (size_t)tok * D + c) = w; } } }
    }
}

__device__ __forceinline__ void ph_rstd2(const Args& a, LAS unsigned char* lds, int wk, int nwk) {
    const int tid = threadIdx.x, lane = tid & 63, wave = __builtin_amdgcn_readfirstlane(tid >> 6);
    const int gw = wk * NWAVES + wave, NGW = nwk * NWAVES;
    const float* H = (const float*)(a.ws + WS_H); float* RSTD1 = (float*)(a.ws + WS_RSTD1);
    for (int row = gw; row < T; row += NGW) {
        const f32x4* xr = (const f32x4*)(H + (size_t)row * D) + lane; float ss = 0.f;
#pragma unroll
        for (int j = 0; j < 4; ++j) { const f32x4 v = xr[64 * j]; ss += v.x * v.x + v.y * v.y + v.z * v.z + v.w * v.w; }
        ss = wave_sum(ss);
        if (lane == 0) RSTD1[row] = rsqrtf(ss * (1.f / D) + EPS);
    }
    convert_experts(a, 1, (LAS float*)(lds + wave * 8448), gw, NGW, lane);
}
__device__ __forceinline__ void ph_pooled(const Args& a, int wk, int nwk) {
    const float* H = (const float*)(a.ws + WS_H); const float* RSTD1 = (const float*)(a.ws + WS_RSTD1); bf16* PO = (bf16*)(a.ws + WS_POOLED);
    for (int i = wk * 512 + threadIdx.x; i < T * 256; i += nwk * 512) {
        const int row = i >> 8, c = (i & 255) * 4, l = row % LSEQ, g = c >> 8, w = 2 << g;
        const int n = (l + 1) < w ? (l + 1) : w;
        f32x4 s = (f32x4){0.f, 0.f, 0.f, 0.f};
        for (int j = 0; j < n; ++j) s += *(const f32x4*)(H + (size_t)(row - j) * D + c) * RSTD1[row - j];
        const f32x4 o = s * (1.f / (float)n) - *(const f32x4*)(H + (size_t)row * D + c) * RSTD1[row];
        v2u wv; wv.x = pk2(o.x, o.y); wv.y = pk2(o.z, o.w); *(v2u*)(PO + (size_t)row * D + c) = wv;
    }
}
__device__ __forceinline__ void ph_poolgemm(const Args& a, int wk, int nwk) {
    const int tid = threadIdx.x, lane = tid & 63, wave = __builtin_amdgcn_readfirstlane(tid >> 6), fr = lane & 15, fq = lane >> 4;
    const int gw = wk * NWAVES + wave, NGW = nwk * NWAVES;
    const bf16* PO = (const bf16*)(a.ws + WS_POOLED); const bf16* WPOOL = (const bf16*)(a.ws + WS_WPOOL);
    float* H = (float*)(a.ws + WS_H); bf16* HB = (bf16*)a.out;
    for (int u = gw; u < 258 * 16; u += NGW) {
        const int rt = u / 16, ct = u % 16, g = ct >> 2;
        const bf16* arow[4];
#pragma unroll
        for (int mi = 0; mi < 4; ++mi) arow[mi] = PO + (size_t)(rt * 64 + 16 * mi + fr) * D + g * 256;
        f32x4 acc[4][4]; zero_acc(acc);
        sg_kloop<4>(256, arow, [=](int n, int k0) { return WPOOL + (size_t)(ct * 64 + n) * 256 + k0; }, NoKS(), acc, fr, fq);
#pragma unroll
        for (int mi = 0; mi < 4; ++mi) { const int row = rt * 64 + 16 * mi + fr;
#pragma unroll
            for (int nj = 0; nj < 4; ++nj) { const int c = ct * 64 + 16 * nj + 4 * fq; float* hp = H + (size_t)row * D + c;
                const f32x4 v = *(const f32x4*)hp + (acc[mi][nj] + *(const f32x4*)(a.in[I_PB] + c)) * *(const f32x4*)(a.in[I_PS] + c); *(f32x4*)hp = v;
                v2u w; w.x = pk2(v.x, v.y); w.y = pk2(v.z, v.w); *(v2u*)(HB + (size_t)row * D + c) = w; } }
    }
}
__device__ __forceinline__ void ph_final(const Args& a, int wk, int nwk) {
    const int tid = threadIdx.x, lane = tid & 63, wave = __builtin_amdgcn_readfirstlane(tid >> 6);
    const int gw = wk * NWAVES + wave, NGW = nwk * NWAVES;
    const float* H = (const float*)(a.ws + WS_H); const f32x4* gn = (const f32x4*)a.in[I_NORMF] + lane;
    for (int orow = gw; orow < NB * SEQ; orow += NGW) {
        const int b = orow / SEQ, l = orow - b * SEQ, row = b * LSEQ + NMETA + l;
        const f32x4* xr = (const f32x4*)(H + (size_t)row * D) + lane; f32x4 v[4]; float ss = 0.f;
#pragma unroll
        for (int j = 0; j < 4; ++j) { v[j] = xr[64 * j]; ss += v[j].x * v[j].x + v[j].y * v[j].y + v[j].z * v[j].z + v[j].w * v[j].w; }
        ss = wave_sum(ss);
        const float rstd = rsqrtf(ss * (1.f / D) + EPS);
        f32x4* o = (f32x4*)(a.out + (size_t)orow * D) + lane;
#pragma unroll
        for (int j = 0; j < 4; ++j) o[64 * j] = v[j] * rstd * gn[64 * j];
    }
}

__global__ void __launch_bounds__(NWAVES * 64, 2) fwd_kernel(Args a) {
    extern __shared__ __attribute__((aligned(16))) unsigned char lds_raw[];
    LAS unsigned char* lds = (LAS unsigned char*)lds_raw;
    volatile LAS unsigned* MISC = (volatile LAS unsigned*)(lds + LDS_BYTES - 256);
    const int tid = threadIdx.x;
    const int G = gridDim.x; const int bx = blockIdx.x;
    const int wk = (G % 8 == 0) ? (bx % 8) * (G / 8) + bx / 8 : bx;
    if (tid < 64) MISC[tid] = 0u;
    __syncthreads();
    XcdBarrier bar; bar.bar = (unsigned*)(a.ws + WS_CTL) + CW_BAR; bar.x = 0; bar.st = nullptr;
    if (N_LAUNCHES == 1) bar = xcd_barrier_post((unsigned*)(a.ws + WS_CTL) + CW_BAR, MISC + 8);
    const int lo = a.ph_lo, hi = a.ph_hi;
#ifndef PH_MASK
#define PH_MASK 0xFFFF
#endif
#define IN(k) (((PH_MASK >> (k)) & 1) && lo <= (k) && (k) < hi)
#define SEAM(k) do { if (IN(k) && IN((k) + 1)) xcd_barrier(bar); } while (0)
    if (IN(0)) { ph_prep(a, lds, wk, G); } SEAM(0);
    if (IN(1)) { ph_gemm1(a, wk, G); } SEAM(1);
    if (IN(2)) { ph_mixers(a, lds, wk, G); } SEAM(2);
    if (IN(3)) { ph_gemm2(a, wk, G); } SEAM(3);
    if (IN(4)) { ph_router(a, lds, 0, wk, G); } SEAM(4);
    if (IN(5)) { ph_moe_up(a, lds, 0, wk, G); } SEAM(5);
    if (IN(6)) { ph_moe_down(a, lds, 0, wk, G); } SEAM(6);
    if (IN(7)) { ph_rstd2(a, lds, wk, G); } SEAM(7);
    if (IN(8)) { ph_pooled(a, wk, G); } SEAM(8);
    if (IN(9)) { ph_poolgemm(a, wk, G); } SEAM(9);
    if (IN(10)) { ph_router(a, lds, 1, wk, G); } SEAM(10);
    if (IN(11)) { ph_moe_up(a, lds, 1, wk, G); } SEAM(11);
    if (IN(12)) { ph_moe_down(a, lds, 1, wk, G); } SEAM(12);
    if (IN(13)) { ph_final(a, wk, G); }
#undef IN
#undef SEAM
}

extern "C" void kernel_launch(void* const* d_in, const int* in_sizes, int n_in, void* d_out, int out_size, void* d_ws, size_t ws_size, hipStream_t stream) {
    static int grid = 0;
    if (grid == 0) {
        if (n_in != 31 || out_size != NB * SEQ * D || ws_size < WS_END) { fprintf(stderr, "kernel_launch: unexpected shapes (n_in %d out %d ws %zu)\n", n_in, out_size, ws_size); grid = -1; return; }
        int dev = 0, cus = 0;
        if (hipGetDevice(&dev) != hipSuccess || hipDeviceGetAttribute(&cus, hipDeviceAttributeMultiprocessorCount, dev) != hipSuccess) { grid = -1; return; }
        if (hipFuncSetAttribute((const void*)fwd_kernel, hipFuncAttributeMaxDynamicSharedMemorySize, LDS_BYTES) != hipSuccess) { grid = -1; return; }
        grid = cus;
    }
    if (grid < 0) return;
    (void)hipMemsetAsync((char*)d_ws + WS_CTL, 0, CTL_ZERO_BYTES, stream);
    Args a{};
    for (int i = 0; i < 31; ++i) a.in[i] = (const float*)d_in[i];
    a.out = (float*)d_out; a.ws = (unsigned char*)d_ws;
    if (N_LAUNCHES == 1) { a.ph_lo = 0; a.ph_hi = NPH; hipLaunchKernelGGL(fwd_kernel, dim3(grid), dim3(NWAVES * 64), LDS_BYTES, stream, a); }
    else for (int p = 0; p < NPH; ++p) { a.ph_lo = p; a.ph_hi = p + 1; hipLaunchKernelGGL(fwd_kernel, dim3(grid), dim3(NWAVES * 64), LDS_BYTES, stream, a); }
}
```

```cpp
#include <hip/hip_runtime.h>
#include <cstdio>
#include <cstdint>

#define GAS __attribute__((address_space(1)))
#define LAS __attribute__((address_space(3)))
typedef unsigned short bf16;
typedef short bf16x8 __attribute__((ext_vector_type(8)));
typedef float f32x4 __attribute__((ext_vector_type(4)));
typedef unsigned v4u __attribute__((ext_vector_type(4)));
typedef unsigned v2u __attribute__((ext_vector_type(2)));

#ifndef MK_N_LAUNCHES
#define MK_N_LAUNCHES 1
#endif
constexpr int NPH = 14;
constexpr int N_LAUNCHES = MK_N_LAUNCHES;

constexpr int NB = 8, SEQ = 2048, NMETA = 16, LSEQ = SEQ + NMETA, T = NB * LSEQ, D = 1024;
constexpr int PROJ_SRC = 4624, LDP = 4608;
constexpr int C_Z = 0, C_G = 1024, C_X = 2048, C_B = 3072, C_C = 3328, C_LI = 3584;
constexpr float EPS = 1e-6f;
constexpr int NBK = 24;

constexpr size_t MiB = 1u << 20;
constexpr size_t WS_CTL = 0, CTL_ZERO_BYTES = 1 * MiB;
constexpr size_t WS_WIN = 1 * MiB;
constexpr size_t WS_WOUT = 10 * MiB;
constexpr size_t WS_WPOOL = 14 * MiB;
constexpr size_t WS_WRT = 14 * MiB + 512 * 1024;
constexpr size_t WS_RSTD0 = 15 * MiB;
constexpr size_t WS_RSTD1 = WS_RSTD0 + 128 * 1024;
constexpr size_t WS_BKT = WS_RSTD1 + 128 * 1024;
constexpr size_t WS_GATES = WS_BKT + 128 * 1024;
constexpr size_t WS_DT = 16 * MiB;
constexpr size_t WS_SSDSQ = 17 * MiB + 64 * 1024;
constexpr size_t WS_LIST = 19 * MiB;
constexpr size_t WS_WGU = 21 * MiB;
constexpr size_t WS_WD = 53 * MiB;
constexpr size_t WS_H = 69 * MiB;
constexpr size_t WS_PROJ = 134 * MiB;
constexpr size_t WS_HID = WS_PROJ;
constexpr size_t WS_POOLED = WS_PROJ;
constexpr size_t WS_END = 280 * MiB;
static_assert(WS_H + (size_t)T * D * 4 <= WS_PROJ && WS_PROJ + (size_t)T * LDP * 2 <= WS_END, "ws map");
static_assert(WS_DT + (size_t)T * 16 * 4 <= WS_SSDSQ && WS_SSDSQ + (size_t)T * 16 * 4 <= WS_LIST && WS_LIST + (size_t)NBK * T * 4 <= WS_WGU, "ws map small");
constexpr int CW_CNT = 64;
constexpr int CW_BAR = 4096;

constexpr int LDS_BYTES = 147456;
constexpr int NWAVES = 8;

struct Args { const float* in[31]; float* out; unsigned char* ws; int ph_lo, ph_hi; };
enum { I_X = 0, I_META, I_NORMF, I_MNE, I_WIN, I_SCW, I_SCB, I_DTB, I_ALOG, I_SD, I_SNORM, I_LCW, I_LCB, I_LWA, I_LBA, I_LWX, I_LBX, I_LLAM, I_WOUT,
       I_MNO, I_PW, I_PB, I_PS, I_FFN, I_RGW, I_RGB, I_REW, I_REB, I_EWG, I_EWU, I_EWD };

#define LDS_WAIT() asm volatile("s_waitcnt lgkmcnt(0)" ::: "memory")
__device__ __forceinline__ float bf2f(unsigned v) { return __uint_as_float(v << 16); }
__device__ __forceinline__ unsigned f2bf(float f) { unsigned u = __float_as_uint(f); return (u + 0x7fffu + ((u >> 16) & 1u)) >> 16; }
__device__ __forceinline__ unsigned pk2(float lo, float hi) { return f2bf(lo) | (f2bf(hi) << 16); }
__device__ __forceinline__ float wave_sum(float v) {
#pragma unroll
    for (int o = 1; o < 64; o <<= 1) v += __shfl_xor(v, o);
    return v;
}
__device__ __forceinline__ float sigmoid_f(float v) { return 1.f / (1.f + __expf(-v)); }
__device__ __forceinline__ float silu_f(float v) { return v / (1.f + __expf(-v)); }
__device__ __forceinline__ float softplus_f(float v) { return v > 20.f ? v : log1pf(__expf(v)); }
__device__ __forceinline__ float gelu_tanh_f(float v) { const float u = 0.7978845608028654f * (v + 0.044715f * v * v * v); return 0.5f * v * (1.f + tanhf(u)); }
__device__ __forceinline__ const float* h0_row(const Args& a, int row) {
    const int b = row / LSEQ, l = row - b * LSEQ;
    return l < NMETA ? a.in[I_META] + (size_t)l * D : a.in[I_X] + ((size_t)b * SEQ + (l - NMETA)) * D;
}

#define XB_TMO      128
#define XB_XCNT(j)  (256  + 64 * (j))
#define XB_XSUB(j)  (1280 + 64 * (j))
#define XB_XGEN(j)  (2304 + 64 * (j))
#define XB_TOP      3328
#define XB_TOPGEN   3392
#define XCD_BAR_WORDS 3456
#define XB_SPIN_CAP (1u << 18)
__device__ __forceinline__ unsigned xb_ld(unsigned* p)              { return __hip_atomic_load(p, __ATOMIC_RELAXED, __HIP_MEMORY_SCOPE_AGENT); }
__device__ __forceinline__ unsigned xb_add(unsigned* p, unsigned v) { return __hip_atomic_fetch_add(p, v, __ATOMIC_RELAXED, __HIP_MEMORY_SCOPE_AGENT); }
__device__ __forceinline__ unsigned xb_xcc_id() { return (unsigned)__builtin_amdgcn_s_getreg((3 << 11) | 20) & 0xFu; }
#define XB_SPIN(cond, bar) do { unsigned _sp = 0; while (cond) { __builtin_amdgcn_s_sleep(1); \
    if ((++_sp & 255u) == 0u) { if (xb_ld(&(bar)[XB_TMO])) break; if (_sp > XB_SPIN_CAP) { atomicAdd(&(bar)[XB_TMO], 1u); break; } } } } while (0)
struct XcdBarrier { unsigned* bar; unsigned x; volatile LAS unsigned* st; };
__device__ __forceinline__ XcdBarrier xcd_barrier_post(unsigned* bar, volatile LAS unsigned* st) {
    XcdBarrier b; b.bar = bar; b.x = xb_xcc_id(); b.st = st;
    if (threadIdx.x == 0) (void)xb_add(&bar[XB_XCNT(b.x)], 1u);
    return b;
}
__device__ __forceinline__ void xcd_barrier_complete(unsigned* bar, unsigned x, unsigned& nloc, unsigned& nx) {
    const unsigned G = gridDim.x * gridDim.y * gridDim.z;
    unsigned sum, cnt, mine, sp = 0u;
    for (;;) {
        sum = 0u; cnt = 0u; mine = 0u;
#pragma unroll
        for (unsigned j = 0; j < 16; ++j) { const unsigned c = xb_ld(&bar[XB_XCNT(j)]); sum += c; cnt += (c > 0u) ? 1u : 0u; mine = (j == x) ? c : mine; }
        if (sum == G) break;
        __builtin_amdgcn_s_sleep(1);
        if ((++sp & 255u) == 0u) { if (xb_ld(&bar[XB_TMO])) break; if (sp > XB_SPIN_CAP) { atomicAdd(&bar[XB_TMO], 1u); break; } }
    }
    nloc = mine > 0u ? mine : 1u; nx = cnt > 0u ? cnt : 1u;
}
__device__ __forceinline__ void xcd_barrier(const XcdBarrier& b) {
    asm volatile("s_waitcnt vmcnt(0)" ::: "memory");
    __syncthreads();
    if (threadIdx.x == 0) {
        unsigned* bar = b.bar;
        __builtin_amdgcn_s_waitcnt(0);
        unsigned nloc = b.st[0], nx = b.st[1];
        if (nloc == 0u) { xcd_barrier_complete(bar, b.x, nloc, nx); b.st[0] = nloc; b.st[1] = nx; }
        const unsigned old = xb_add(&bar[XB_XSUB(b.x)], 1u);
        const unsigned gen = old / nloc;
        if (old + 1u == (gen + 1u) * nloc) {
            __builtin_amdgcn_fence(__ATOMIC_RELEASE, "agent");
            asm volatile("s_waitcnt vmcnt(0)" ::: "memory");
            const unsigned og = xb_add(&bar[XB_TOP], 1u);
            const unsigned tg = og / nx;
            if (og + 1u == (tg + 1u) * nx) xb_add(&bar[XB_TOPGEN], 1u);
            else XB_SPIN(xb_ld(&bar[XB_TOPGEN]) == tg, bar);
            __builtin_amdgcn_fence(__ATOMIC_ACQUIRE, "agent");
            xb_add(&bar[XB_XGEN(b.x)], 1u);
            asm volatile("s_waitcnt vmcnt(0)" ::: "memory");
        } else {
            XB_SPIN(xb_ld(&bar[XB_XGEN(b.x)]) == gen, bar);
            __builtin_amdgcn_fence(__ATOMIC_ACQUIRE, "agent");
            asm volatile("s_waitcnt vmcnt(0)" ::: "memory");
        }
    }
    __syncthreads();
}

__device__ __forceinline__ void tr_item(const float* src, int ldsrc, const float* gain, bf16* dst, int lddst, LAS float* scr, int lane) {
#pragma unroll 8
    for (int i = 0; i < 32; ++i) { const int kk = 2 * i + (lane >> 5); float v = src[(size_t)kk * ldsrc + (lane & 31)]; if (gain) v *= gain[kk]; scr[kk * 33 + (lane & 31)] = v; }
    LDS_WAIT();
    const int c = lane & 7;
#pragma unroll
    for (int j = 0; j < 4; ++j) { const int n = (lane >> 3) + 8 * j; const LAS float* s = scr + (8 * c) * 33 + n;
        v4u o; o.x = pk2(s[0 * 33], s[1 * 33]); o.y = pk2(s[2 * 33], s[3 * 33]); o.z = pk2(s[4 * 33], s[5 * 33]); o.w = pk2(s[6 * 33], s[7 * 33]);
        *(v4u*)(dst + (size_t)n * lddst + 8 * c) = o; }
    LDS_WAIT();
}
__device__ __forceinline__ void convert_experts(const Args& a, int L, LAS float* scr, int gw, int NGW, int lane) {
    bf16* WGU = (bf16*)(a.ws + WS_WGU); bf16* WD = (bf16*)(a.ws + WS_WD);
    const float* gain = a.in[I_FFN] + L * D;
    constexpr int I_GU = 16 * 16 * 16, I_DN = 16 * 8 * 32;
    for (int it = gw; it < 2 * I_GU + I_DN; it += NGW) {
        int r = it;
        if (r < 2 * I_GU) {
            const int up = r >= I_GU; if (up) r -= I_GU;
            const int e = r >> 8, kb = (r >> 4) & 15, nb = r & 15;
            const float* src = a.in[up ? I_EWU : I_EWG] + ((size_t)(L * 16 + e) * 1024 + kb * 64) * 512 + nb * 32;
            const int drow = e * 1024 + (nb >> 2) * 256 + (nb & 3) * 32 + (up ? 128 : 0);
            tr_item(src, 512, gain + kb * 64, WGU + (size_t)drow * 1024 + kb * 64, 1024, scr, lane);
        } else {
            r -= 2 * I_GU;
            const int e = r >> 8, kb = (r >> 5) & 7, nb = r & 31;
            const float* src = a.in[I_EWD] + ((size_t)(L * 16 + e) * 512 + kb * 64) * 1024 + nb * 32;
            tr_item(src, 1024, nullptr, WD + (size_t)(e * 1024 + nb * 32) * 512 + kb * 64, 512, scr, lane);
        }
    }
}
__device__ __forceinline__ void ph_prep(const Args& a, LAS unsigned char* lds, int wk, int nwk) {
    const int tid = threadIdx.x, lane = tid & 63, wave = __builtin_amdgcn_readfirstlane(tid >> 6);
    const int gw = wk * NWAVES + wave, NGW = nwk * NWAVES;
    LAS float* wdt = (LAS float*)lds;
    LAS float* scr = (LAS float*)(lds + 65536 + wave * 8448);
    {
        const float* win = a.in[I_WIN]; const float* ge = a.in[I_MNE];
        for (int i = tid; i < 16 * 1024; i += 512) { const int k = i >> 4, j = i & 15; wdt[j * 1024 + k] = win[(size_t)k * PROJ_SRC + 2560 + j] * ge[k]; }
    }
    bf16* WIN = (bf16*)(a.ws + WS_WIN); bf16* WOUT = (bf16*)(a.ws + WS_WOUT); bf16* WPOOL = (bf16*)(a.ws + WS_WPOOL);
    constexpr int I_IN = 16 * 144, I_OUT = 32 * 32, I_POOL = 4 * 4 * 8;
    for (int it = gw; it < I_IN + I_OUT + I_POOL; it += NGW) {
        int r = it;
        if (r < I_IN) { const int kb = r / 144, nb = r % 144, n0 = nb * 32;
            const int sc = n0 < 1024 ? n0 : (n0 < 2048 ? n0 - 1024 + 2576 : (n0 < 3584 ? n0 - 2048 + 1024 : n0 - 3584 + 3600));
            tr_item(a.in[I_WIN] + (size_t)(kb * 64) * PROJ_SRC + sc, PROJ_SRC, a.in[I_MNE] + kb * 64, WIN + (size_t)n0 * 1024 + kb * 64, 1024, scr, lane); continue; }
        r -= I_IN;
        if (r < I_OUT) { const int kb = r >> 5, nb = r & 31;
            tr_item(a.in[I_WOUT] + (size_t)(kb * 64) * 1024 + nb * 32, 1024, kb < 16 ? a.in[I_SNORM] + kb * 64 : nullptr, WOUT + (size_t)(nb * 32) * 2048 + kb * 64, 2048, scr, lane); continue; }
        r -= I_OUT;
        { const int g = r >> 5, kb = (r >> 3) & 3, nb = r & 7;
            tr_item(a.in[I_PW] + (size_t)g * 65536 + (size_t)(kb * 64) * 256 + nb * 32, 256, a.in[I_MNO] + g * 256 + kb * 64, WPOOL + (size_t)(g * 256 + nb * 32) * 256 + kb * 64, 256, scr, lane); }
    }
    convert_experts(a, 0, scr, gw, NGW, lane);
    {
        float* WRT = (float*)(a.ws + WS_WRT);
        for (int i = wk * 512 + tid; i < 2 * 20 * 1024; i += nwk * 512) {
            const int L = i / 20480, r = i % 20480, j = r >> 10, k = r & 1023;
            const float w = j < 4 ? a.in[I_RGW][((size_t)L * 1024 + k) * 4 + j] : a.in[I_REW][((size_t)L * 1024 + k) * 16 + (j - 4)];
            WRT[i] = w * a.in[I_FFN][L * 1024 + k];
        }
    }
    __syncthreads();
    bf16* HB = (bf16*)a.out; float* RSTD0 = (float*)(a.ws + WS_RSTD0); float* DT = (float*)(a.ws + WS_DT);
    for (int row = gw; row < T; row += NGW) {
        const f32x4* xr = (const f32x4*)h0_row(a, row) + lane;
        f32x4 v[4]; float ss = 0.f;
#pragma unroll
        for (int j = 0; j < 4; ++j) { v[j] = xr[64 * j]; ss += v[j].x * v[j].x + v[j].y * v[j].y + v[j].z * v[j].z + v[j].w * v[j].w; }
        ss = wave_sum(ss);
        const float rstd = rsqrtf(ss * (1.f / D) + EPS);
        v2u* o8 = (v2u*)(HB + (size_t)row * D) + lane;
#pragma unroll
        for (int j = 0; j < 4; ++j) { v2u w; w.x = pk2(v[j].x, v[j].y); w.y = pk2(v[j].z, v[j].w); o8[64 * j] = w; }
        float mydt = 0.f;
#pragma unroll 2
        for (int jj = 0; jj < 16; ++jj) {
            float s = 0.f;
#pragma unroll
            for (int j = 0; j < 4; ++j) { const f32x4 w = *(const LAS f32x4*)(wdt + jj * 1024 + (lane + 64 * j) * 4); s += v[j].x * w.x + v[j].y * w.y + v[j].z * w.z + v[j].w * w.w; }
            s = wave_sum(s);
            if (lane == jj) mydt = s;
        }
        if (lane == 0) RSTD0[row] = rstd;
        if (lane < 16) DT[(size_t)row * 16 + lane] = softplus_f(mydt * rstd + a.in[I_DTB][lane]);
    }
}

template <int NT, class BP, class KS>
__device__ __forceinline__ void sg_kloop(int K, const bf16* const (&arow)[4], BP bp, KS ks, f32x4 (&acc)[4][NT], int fr, int fq) {
    for (int k0 = 0; k0 < K; k0 += 32) {
        ks(k0, acc);
        bf16x8 av[4], bv[NT];
#pragma unroll
        for (int mi = 0; mi < 4; ++mi) av[mi] = *(const bf16x8*)(arow[mi] + k0 + 8 * fq);
#pragma unroll
        for (int nj = 0; nj < NT; ++nj) bv[nj] = *(const bf16x8*)(bp(16 * nj + fr, k0) + 8 * fq);
#pragma unroll
        for (int mi = 0; mi < 4; ++mi)
#pragma unroll
            for (int nj = 0; nj < NT; ++nj) acc[mi][nj] = __builtin_amdgcn_mfma_f32_16x16x32_bf16(bv[nj], av[mi], acc[mi][nj], 0, 0, 0);
    }
}
template <int NT> __device__ __forceinline__ void zero_acc(f32x4 (&acc)[4][NT]) {
#pragma unroll
    for (int mi = 0; mi < 4; ++mi)
#pragma unroll
        for (int nj = 0; nj < NT; ++nj) acc[mi][nj] = (f32x4){0.f, 0.f, 0.f, 0.f};
}
struct NoKS { template <int NT> __device__ __forceinline__ void operator()(int, f32x4 (&)[4][NT]) const {} };

__device__ __forceinline__ void ph_gemm1(const Args& a, int wk, int nwk) {
    const int tid = threadIdx.x, lane = tid & 63, wave = __builtin_amdgcn_readfirstlane(tid >> 6), fr = lane & 15, fq = lane >> 4;
    const int gw = wk * NWAVES + wave, NGW = nwk * NWAVES;
    const bf16* HB = (const bf16*)a.out; const bf16* WIN = (const bf16*)(a.ws + WS_WIN); bf16* PROJ = (bf16*)(a.ws + WS_PROJ);
    const float* RSTD0 = (const float*)(a.ws + WS_RSTD0);
    for (int u = gw; u < 258 * 72; u += NGW) {
        const int rt = u / 72, ct = u % 72;
        const bf16* arow[4];
#pragma unroll
        for (int mi = 0; mi < 4; ++mi) arow[mi] = HB + (size_t)(rt * 64 + 16 * mi + fr) * D;
        f32x4 acc[4][4]; zero_acc(acc);
        sg_kloop<4>(1024, arow, [=](int n, int k0) { return WIN + (size_t)(ct * 64 + n) * 1024 + k0; }, NoKS(), acc, fr, fq);
#pragma unroll
        for (int mi = 0; mi < 4; ++mi) { const int row = rt * 64 + 16 * mi + fr; const float rs = RSTD0[row];
#pragma unroll
            for (int nj = 0; nj < 4; ++nj) { const f32x4 v = acc[mi][nj] * rs; v2u w; w.x = pk2(v.x, v.y); w.y = pk2(v.z, v.w);
                *(v2u*)(PROJ + (size_t)row * LDP + ct * 64 + 16 * nj + 4 * fq) = w; } }
    }
}

__device__ __forceinline__ void ph_gemm2(const Args& a, int wk, int nwk) {
    const int tid = threadIdx.x, lane = tid & 63, wave = __builtin_amdgcn_readfirstlane(tid >> 6), fr = lane & 15, fq = lane >> 4;
    const int gw = wk * NWAVES + wave, NGW = nwk * NWAVES;
    const bf16* PROJ = (const bf16*)(a.ws + WS_PROJ); const bf16* WOUT = (const bf16*)(a.ws + WS_WOUT);
    const float* SSDSQ = (const float*)(a.ws + WS_SSDSQ);
    float* H = (float*)(a.ws + WS_H); bf16* HB = (bf16*)a.out;
    for (int u = gw; u < 258 * 16; u += NGW) {
        const int rt = u / 16, ct = u % 16;
        const bf16* arow[4]; float f0[4], f1[4];
#pragma unroll
        for (int mi = 0; mi < 4; ++mi) { const int row = rt * 64 + 16 * mi + fr; arow[mi] = PROJ + (size_t)row * LDP;
            const f32x4* sq = (const f32x4*)(SSDSQ + (size_t)row * 16); const f32x4 q0 = sq[0], q1 = sq[1], q2 = sq[2], q3 = sq[3];
            const float s0 = (q0.x + q0.y + q0.z + q0.w) + (q1.x + q1.y + q1.z + q1.w), s1 = (q2.x + q2.y + q2.z + q2.w) + (q3.x + q3.y + q3.z + q3.w);
            const float r0 = rsqrtf(s0 * (1.f / 512.f) + EPS), r1 = rsqrtf(s1 * (1.f / 512.f) + EPS);
            f0[mi] = r0 / r1; f1[mi] = r1; }
        f32x4 acc[4][4]; zero_acc(acc);
        auto ks = [=](int k0, f32x4 (&ac)[4][4]) {
            if (k0 == 512) {
#pragma unroll
                for (int mi = 0; mi < 4; ++mi)
#pragma unroll
                    for (int nj = 0; nj < 4; ++nj) ac[mi][nj] *= f0[mi]; }
            if (k0 == 1024) {
#pragma unroll
                for (int mi = 0; mi < 4; ++mi)
#pragma unroll
                    for (int nj = 0; nj < 4; ++nj) ac[mi][nj] *= f1[mi]; }
        };
        sg_kloop<4>(2048, arow, [=](int n, int k0) { return WOUT + (size_t)(ct * 64 + n) * 2048 + k0; }, ks, acc, fr, fq);
#pragma unroll
        for (int mi = 0; mi < 4; ++mi) { const int row = rt * 64 + 16 * mi + fr; const float* hr = h0_row(a, row);
#pragma unroll
            for (int nj = 0; nj < 4; ++nj) { const int c = ct * 64 + 16 * nj + 4 * fq; const f32x4 v = acc[mi][nj] + *(const f32x4*)(hr + c);
                *(f32x4*)(H + (size_t)row * D + c) = v; v2u w; w.x = pk2(v.x, v.y); w.y = pk2(v.z, v.w); *(v2u*)(HB + (size_t)row * D + c) = w; } }
    }
}


namespace pg8 {
constexpr int BM = 256, BK = 64, HALF = 128, HTB = HALF * BK * 2, STAGE_BYTES = 8 * HTB, NXCD = 8, WGM = 8;
__host__ __device__ __forceinline__ int lds_byte(int r, int c) { const int st = (r >> 4) * 2 + (c >> 5), rr = r & 15, cc = c & 31, ob = rr * 64 + cc * 2; return st * 1024 + (ob ^ (((ob >> 9) & 1) << 5)); }
__host__ __device__ __forceinline__ void stage_rc(int b, int& R, int& C) { const int st = b / 1024, sb = b % 1024, swz = sb ^ (((sb >> 9) & 1) << 5); R = (st >> 1) * 16 + swz / 64; C = (st & 1) * 32 + (swz % 64) / 2; }
__host__ __device__ __forceinline__ int perm32(int rho) { const int n = rho >> 4, i = rho & 15; return 8 * (i >> 2) + 4 * n + (i & 3); }
__device__ __forceinline__ unsigned cvt_pk_bf16(float lo, float hi) { unsigned r; asm volatile("v_cvt_pk_bf16_f32 %0, %1, %2" : "=v"(r) : "v"(lo), "v"(hi)); return r; }
typedef f32x4 Acc[2][2][4][2];

__device__ __forceinline__ bool static_order(int nM, int nN, int G, int c, int i, int& pm, int& pn) {
    const int nwg = nM * nN; const long L = (long)i * G + c; if (L >= nwg) return false;
    int wgid = (int)L; { const int q = nwg / NXCD, r = nwg % NXCD, xcd = wgid % NXCD, off = wgid / NXCD; wgid = (xcd < r ? xcd * (q + 1) : r * (q + 1) + (xcd - r) * q) + off; }
    const int nig = WGM * nN, gid = wgid / nig, fm = gid * WGM, gsz = (nM - fm) < WGM ? (nM - fm) : WGM;
    pm = fm + ((wgid % nig) % gsz); pn = (wgid % nig) / gsz; return true;
}

template <class P, bool ALIGN_EPI>
__device__ __forceinline__ void gemm_phase(LAS unsigned char* lds, const P& S) {
    const int tid = threadIdx.x, wid = __builtin_amdgcn_readfirstlane(tid >> 6), lane = tid & 63, wr = wid >> 2, wc = wid & 3, fr = lane & 15, fq = lane >> 4;
    const int nt = S.nt;
    int RA[2], CA[2]; unsigned voffB[2];
#pragma unroll
    for (int i = 0; i < 2; ++i) { int R, C; stage_rc(tid * 16 + i * 8192, R, C); RA[i] = R; CA[i] = C; const int Rb = P::PERM ? ((R & ~31) + perm32(R & 31)) : R;
        voffB[i] = (unsigned)(Rb * S.ldb + C) * 2u; }
    const size_t kstep = (size_t)(BK * 2);
    const size_t hstepB = (size_t)HALF * S.ldb * 2;
    const unsigned ldsw = (unsigned)wid * 1024u;
    const int aoff = lds_byte(wr * 64 + fr, fq * 8), boff = lds_byte(wc * 32 + fr, fq * 8);
#define PG8_SA(b, h) (((b) * 2 + (h)) * HTB)
#define PG8_SB(b, h) ((4 + (b) * 2 + (h)) * HTB)
#define PG8_STAGE(bufoff, gbase, voff) do { _Pragma("unroll") for (int _i = 0; _i < 2; ++_i) \
        __builtin_amdgcn_global_load_lds((const unsigned*)((const char*)(gbase) + (voff)[_i]), (LAS unsigned*)(lds + (bufoff) + ldsw + _i * 8192), 16, 0, 0); } while (0)
#define PG8_LDA(dst, b, h) do { _Pragma("unroll") for (int m = 0; m < 4; ++m) _Pragma("unroll") for (int k = 0; k < 2; ++k) dst[m][k] = *(const LAS bf16x8*)(lds + PG8_SA(b, h) + aoff + m * 2048 + k * 1024); } while (0)
#define PG8_LDB(dst, b, h) do { _Pragma("unroll") for (int n = 0; n < 2; ++n) _Pragma("unroll") for (int k = 0; k < 2; ++k) dst[n][k] = *(const LAS bf16x8*)(lds + PG8_SB(b, h) + boff + n * 2048 + k * 1024); } while (0)
#define PG8_MMA(ai, bj, At, Bt) do { __builtin_amdgcn_s_setprio(1); _Pragma("unroll") for (int m = 0; m < 4; ++m) _Pragma("unroll") for (int n = 0; n < 2; ++n) _Pragma("unroll") for (int k = 0; k < 2; ++k) \
        acc[ai][bj][m][n] = __builtin_amdgcn_mfma_f32_16x16x32_bf16(Bt[n][k], At[m][k], acc[ai][bj][m][n], 0, 0, 0); __builtin_amdgcn_s_setprio(0); } while (0)
#define PG8_WAIT_V(n) asm volatile("s_waitcnt vmcnt(" #n ")" ::: "memory")
#define PG8_WAIT_L(n) asm volatile("s_waitcnt lgkmcnt(" #n ")" ::: "memory")
#define PG8_BAR __builtin_amdgcn_s_barrier()
#define PG8_SCHED __builtin_amdgcn_sched_barrier(0)
    typename P::Unit cur, nxt; int ui = 0;
    if (!S.next(0, cur)) return;
    f32x4 acc[2][2][4][2];
#pragma unroll
    for (int a = 0; a < 2; ++a)
#pragma unroll
        for (int b = 0; b < 2; ++b)
#pragma unroll
            for (int m = 0; m < 4; ++m)
#pragma unroll
                for (int n = 0; n < 2; ++n) acc[a][b][m][n] = (f32x4){0.f, 0.f, 0.f, 0.f};
    bf16x8 At[4][2], B0[2][2], B1[2][2];
    unsigned vA[4];
    S.avoff(cur, RA, CA, vA);
    const char* cA = S.abase(cur);
    {
        const char* b0 = S.btile(cur, 0); const char* b1 = S.btile(cur, 1);
        PG8_STAGE(PG8_SB(0, 0), b0, voffB); PG8_STAGE(PG8_SB(0, 1), b0 + hstepB, voffB); PG8_STAGE(PG8_SA(0, 0), cA, vA); PG8_STAGE(PG8_SA(0, 1), cA, vA + 2);
        if (wr == 1) PG8_BAR;
        PG8_WAIT_V(2); PG8_BAR;
        PG8_STAGE(PG8_SB(1, 0), b1, voffB); PG8_STAGE(PG8_SA(1, 0), cA + kstep, vA); PG8_STAGE(PG8_SB(1, 1), b1 + hstepB, voffB);
        PG8_WAIT_V(6); PG8_BAR;
    }
    for (;;) {
        const bool has_next = S.next(ui + 1, nxt);
        for (int t = 0; t < nt; t += 2) {
            const bool last = (t == nt - 2);
            const char* a1 = cA + (size_t)(t + 1) * kstep;
            S.khook(t, acc, cur, lds, wr, wc, fr, fq);
            PG8_LDB(B0, 0, 0); PG8_LDB(B1, 0, 1); PG8_SCHED; PG8_LDA(At, 0, 0); PG8_STAGE(PG8_SA(1, 1), a1, vA + 2);
            PG8_WAIT_V(8); PG8_WAIT_L(0); PG8_BAR; PG8_MMA(0, 0, At, B0); PG8_MMA(0, 1, At, B1); PG8_BAR; PG8_SCHED;
            const bool sw = last && has_next;
            if (sw) S.avoff(nxt, RA, CA, vA);
            const char* a2 = last ? (sw ? S.abase(nxt) : cA) : cA + (size_t)(t + 2) * kstep;
            const char* b2 = last ? (sw ? S.btile(nxt, 0) : S.btile(cur, 0)) : S.btile(cur, t + 2);
            const char* b3 = last ? (sw ? S.btile(nxt, 1) : S.btile(cur, 1)) : S.btile(cur, t + 3);
            const char* a3 = a2 + kstep;
            PG8_LDA(At, 0, 1); PG8_STAGE(PG8_SB(0, 0), b2, voffB); PG8_STAGE(PG8_SB(0, 1), b2 + hstepB, voffB); PG8_STAGE(PG8_SA(0, 0), a2, vA);
            PG8_WAIT_V(8); PG8_WAIT_L(0); PG8_BAR; PG8_MMA(1, 0, At, B0); PG8_MMA(1, 1, At, B1); PG8_BAR; PG8_SCHED;
            PG8_LDB(B0, 1, 0); PG8_LDB(B1, 1, 1); PG8_SCHED; PG8_LDA(At, 1, 0); PG8_STAGE(PG8_SA(0, 1), a2, vA + 2);
            PG8_WAIT_V(8); PG8_WAIT_L(0); PG8_BAR; PG8_MMA(0, 0, At, B0); PG8_MMA(0, 1, At, B1); PG8_BAR; PG8_SCHED;
            PG8_LDA(At, 1, 1); PG8_STAGE(PG8_SB(1, 0), b3, voffB); PG8_STAGE(PG8_SB(1, 1), b3 + hstepB, voffB); PG8_STAGE(PG8_SA(1, 0), a3, vA);
            PG8_WAIT_V(8); PG8_WAIT_L(0); PG8_BAR; PG8_MMA(1, 0, At, B0); PG8_MMA(1, 1, At, B1); PG8_BAR; PG8_SCHED;
        }
        if constexpr (ALIGN_EPI) { if (wr == 0) PG8_BAR; }
        S.epi(acc, cur, wr, wc, fr, fq);
        if (!has_next) break;
#pragma unroll
        for (int a = 0; a < 2; ++a)
#pragma unroll
            for (int b = 0; b < 2; ++b)
#pragma unroll
                for (int m = 0; m < 4; ++m)
#pragma unroll
                    for (int n = 0; n < 2; ++n) acc[a][b][m][n] = (f32x4){0.f, 0.f, 0.f, 0.f};
        cur = nxt; cA = S.abase(cur); ++ui;
        if constexpr (ALIGN_EPI) { if (wr == 1) PG8_BAR; }
    }
    PG8_WAIT_V(0);
    if constexpr (!ALIGN_EPI) { if (wr == 0) PG8_BAR; }
    PG8_BAR;
#undef PG8_SA
#undef PG8_SB
#undef PG8_STAGE
#undef PG8_LDA
#undef PG8_LDB
#undef PG8_MMA
#undef PG8_WAIT_V
#undef PG8_WAIT_L
#undef PG8_BAR
#undef PG8_SCHED
}
}

struct PGemm1 {
    static constexpr bool PERM = true;
    struct Unit { int pm, pn; };
    const char* A; const char* B; bf16* O; const float* rstd; int G, c; int ldb, nt;
    __device__ __forceinline__ bool next(int i, Unit& u) const { return pg8::static_order(65, 18, G, c, i, u.pm, u.pn); }
    __device__ __forceinline__ void avoff(const Unit& u, const int (&RA)[2], const int (&CA)[2], unsigned (&v)[4]) const {
#pragma unroll
        for (int h = 0; h < 2; ++h)
#pragma unroll
            for (int i = 0; i < 2; ++i) { int row = u.pm * 256 + h * 128 + RA[i]; row = row < T ? row : T - 1; v[h * 2 + i] = (unsigned)(row * D + CA[i]) * 2u; }
    }
    __device__ __forceinline__ const char* abase(const Unit&) const { return A; }
    __device__ __forceinline__ const char* btile(const Unit& u, int t) const { return B + ((size_t)u.pn * 256 * 1024 + (size_t)t * 64) * 2; }
    __device__ __forceinline__ void khook(int, pg8::Acc&, const Unit&, LAS unsigned char*, int, int, int, int) const {}
    __device__ __forceinline__ void epi(const pg8::Acc& acc, const Unit& u, int wr, int wc, int fr, int fq) const {
        const int row0 = u.pm * 256 + wr * 64 + fr, col0 = u.pn * 256 + wc * 32 + 8 * fq;
        float rsv[2][4];
#pragma unroll
        for (int ai = 0; ai < 2; ++ai)
#pragma unroll
            for (int m = 0; m < 4; ++m) { const int row = row0 + ai * 128 + m * 16; rsv[ai][m] = rstd[row < T ? row : T - 1]; }
#pragma unroll
        for (int ai = 0; ai < 2; ++ai)
#pragma unroll
            for (int m = 0; m < 4; ++m) { const int row = row0 + ai * 128 + m * 16;
                if (row < T) { const float rs = rsv[ai][m]; bf16* rowp = O + (size_t)row * LDP + col0;
#pragma unroll
                    for (int bj = 0; bj < 2; ++bj) { const f32x4 v0 = acc[ai][bj][m][0] * rs, v1 = acc[ai][bj][m][1] * rs;
                        v4u w; w.x = pg8::cvt_pk_bf16(v0[0], v0[1]); w.y = pg8::cvt_pk_bf16(v0[2], v0[3]); w.z = pg8::cvt_pk_bf16(v1[0], v1[1]); w.w = pg8::cvt_pk_bf16(v1[2], v1[3]);
                        *(v4u*)(rowp + bj * 128) = w; } } }
    }
};
__device__ __forceinline__ void ph_gemm1_pg8(const Args& a, LAS unsigned char* lds, int G) {
    PGemm1 S; S.A = (const char*)a.out; S.B = (const char*)(a.ws + WS_WIN); S.O = (bf16*)(a.ws + WS_PROJ); S.rstd = (const float*)(a.ws + WS_RSTD0);
    S.G = G; S.c = (int)blockIdx.x; S.ldb = 1024; S.nt = 16;
    pg8::gemm_phase<PGemm1, true>(lds, S);
}

__device__ __forceinline__ void ssd_item(const Args& a, LAS unsigned char* lds, int b, int h) {
    const int tid = threadIdx.x, lane = tid & 63;
    constexpr int TB = 64;
    LAS float* xs = (LAS float*)lds;
    LAS float* Bs = xs + TB * 64;
    LAS float* Cs = Bs + TB * 128;
    LAS float* ys = Cs + TB * 128;
    LAS float* dts = ys + TB * 64;
    LAS float* decs = dts + TB;
    bf16* PROJ = (bf16*)(a.ws + WS_PROJ); const float* DT = (const float*)(a.ws + WS_DT); float* SSDSQ = (float*)(a.ws + WS_SSDSQ);
    const int g = h >> 3;
    const float Ah = -__expf(a.in[I_ALOG][h]), Dh = a.in[I_SD][h];
    int ccol = 0, cch = 0; float cw0 = 0.f, cw1 = 0.f, cw2 = 0.f, cw3 = 0.f, cb = 0.f;
    if (tid < 320) {
        if (tid < 64) { ccol = C_X + h * 64 + tid; cch = h * 64 + tid; }
        else if (tid < 192) { ccol = C_B + g * 128 + (tid - 64); cch = 1024 + g * 128 + (tid - 64); }
        else { ccol = C_C + g * 128 + (tid - 192); cch = 1280 + g * 128 + (tid - 192); }
        const float* cw = a.in[I_SCW]; cw0 = cw[cch]; cw1 = cw[1536 + cch]; cw2 = cw[2 * 1536 + cch]; cw3 = cw[3 * 1536 + cch]; cb = a.in[I_SCB][cch];
    }
    const int p = tid >> 3, nq = tid & 7;
    float S[16];
#pragma unroll
    for (int i = 0; i < 16; ++i) S[i] = 0.f;
    const size_t rbase = (size_t)b * LSEQ;
    for (int l0 = 0; l0 < LSEQ; l0 += TB) {
        const int nt = (LSEQ - l0) < TB ? (LSEQ - l0) : TB;
        __syncthreads();
        if (tid < 320) {
            float r0 = l0 >= 3 ? bf2f(PROJ[(rbase + l0 - 3) * LDP + ccol]) : 0.f, r1 = l0 >= 2 ? bf2f(PROJ[(rbase + l0 - 2) * LDP + ccol]) : 0.f, r2 = l0 >= 1 ? bf2f(PROJ[(rbase + l0 - 1) * LDP + ccol]) : 0.f;
            for (int t = 0; t < nt; ++t) {
                const float r3 = bf2f(PROJ[(rbase + l0 + t) * LDP + ccol]);
                const float v = silu_f(cw0 * r0 + cw1 * r1 + cw2 * r2 + cw3 * r3 + cb);
                if (tid < 64) xs[t * 64 + tid] = v; else if (tid < 192) Bs[t * 128 + tid - 64] = v; else Cs[t * 128 + tid - 192] = v;
                r0 = r1; r1 = r2; r2 = r3;
            }
        } else if (tid < 320 + TB) {
            const int t = tid - 320;
            if (t < nt) { const float dt = DT[(rbase + l0 + t) * 16 + h]; dts[t] = dt; decs[t] = __expf(Ah * dt); }
        }
        __syncthreads();
        for (int t = 0; t < nt; ++t) {
            const float xv = xs[t * 64 + p], xdt = xv * dts[t], dec = decs[t];
            float yp = 0.f;
#pragma unroll
            for (int i = 0; i < 16; ++i) { S[i] = dec * S[i] + Bs[t * 128 + nq * 16 + i] * xdt; yp += Cs[t * 128 + nq * 16 + i] * S[i]; }
            yp += __shfl_xor(yp, 1); yp += __shfl_xor(yp, 2); yp += __shfl_xor(yp, 4);
            if (nq == 0) ys[t * 64 + p] = yp + Dh * xv;
        }
        __syncthreads();
        for (int t = tid >> 6; t < nt; t += 8) {
            const size_t row = rbase + l0 + t;
            const float z = bf2f(PROJ[row * LDP + C_Z + h * 64 + lane]);
            const float yg = ys[t * 64 + lane] * silu_f(z);
            PROJ[row * LDP + C_Z + h * 64 + lane] = (bf16)f2bf(yg);
            const float sq = wave_sum(yg * yg);
            if (lane == 0) SSDSQ[row * 16 + h] = sq;
        }
    }
    __syncthreads();
}
__device__ __forceinline__ void lru_item(const Args& a, LAS unsigned char* lds, int b, int h) {
    const int tid = threadIdx.x;
    constexpr int TB = 64;
    LAS float* Wa = (LAS float*)lds;
    LAS float* Wx = Wa + 4096;
    LAS float* xb = Wx + 4096;
    LAS float* as = xb + TB * 64;
    LAS float* us = as + TB * 64;
    bf16* PROJ = (bf16*)(a.ws + WS_PROJ);
    __syncthreads();
    for (int i = tid; i < 4096; i += 512) { Wa[i] = a.in[I_LWA][(size_t)h * 4096 + i]; Wx[i] = a.in[I_LWX][(size_t)h * 4096 + i]; }
    const size_t rbase = (size_t)b * LSEQ;
    float hprev = 0.f;
    const int c = tid & 63, tq = tid >> 6;
    const float* cw = a.in[I_LCW]; const int ch = h * 64 + c;
    const float cw0 = cw[ch], cw1 = cw[1024 + ch], cw2 = cw[2048 + ch], cw3 = cw[3072 + ch], cb = a.in[I_LCB][ch];
    const int gt = tid >> 3, jq = tid & 7;
    for (int l0 = 0; l0 < LSEQ; l0 += TB) {
        const int nt = (LSEQ - l0) < TB ? (LSEQ - l0) : TB;
        __syncthreads();
        for (int t = tq * 8; t < tq * 8 + 8; ++t) if (t < nt) {
            const int l = l0 + t; const size_t row = rbase + l;
            const float r3 = bf2f(PROJ[row * LDP + C_LI + ch]);
            const float r2 = l >= 1 ? bf2f(PROJ[(row - 1) * LDP + C_LI + ch]) : 0.f;
            const float r1 = l >= 2 ? bf2f(PROJ[(row - 2) * LDP + C_LI + ch]) : 0.f;
            const float r0 = l >= 3 ? bf2f(PROJ[(row - 3) * LDP + C_LI + ch]) : 0.f;
            xb[t * 64 + c] = cw0 * r0 + cw1 * r1 + cw2 * r2 + cw3 * r3 + cb;
        }
        __syncthreads();
        if (gt < nt) {
            float ra[8], ri[8];
#pragma unroll
            for (int j = 0; j < 8; ++j) { ra[j] = 0.f; ri[j] = 0.f; }
            for (int i = 0; i < 64; ++i) { const float xv = xb[gt * 64 + i];
#pragma unroll
                for (int j = 0; j < 8; ++j) { ra[j] += xv * Wa[i * 64 + jq * 8 + j]; ri[j] += xv * Wx[i * 64 + jq * 8 + j]; } }
#pragma unroll
            for (int j = 0; j < 8; ++j) { const int cc = h * 64 + jq * 8 + j;
                const float r = sigmoid_f(ra[j] + a.in[I_LBA][cc]), ig = sigmoid_f(ri[j] + a.in[I_LBX][cc]);
                const float log_a = -8.0f * r * softplus_f(-a.in[I_LLAM][cc]);
                const float av = __expf(log_a);
                const float mult = (l0 + gt == 0) ? 1.f : sqrtf(fmaxf(-expm1f(2.f * log_a), 0.f));
                as[gt * 64 + jq * 8 + j] = av; us[gt * 64 + jq * 8 + j] = mult * ig * xb[gt * 64 + jq * 8 + j]; }
        }
        __syncthreads();
        if (tid < 64) { for (int t = 0; t < nt; ++t) { hprev = as[t * 64 + tid] * hprev + us[t * 64 + tid]; us[t * 64 + tid] = hprev; } }
        __syncthreads();
        for (int t = tq * 8; t < tq * 8 + 8; ++t) if (t < nt) {
            const size_t row = rbase + l0 + t;
            const float gv = bf2f(PROJ[row * LDP + C_G + ch]);
            PROJ[row * LDP + C_G + ch] = (bf16)f2bf(us[t * 64 + c] * gelu_tanh_f(gv));
        }
    }
    __syncthreads();
}
__device__ __forceinline__ void ph_mixers(const Args& a, LAS unsigned char* lds, int wk, int nwk) {
    for (int it = wk; it < 256; it += nwk) {
        if (it < 128) ssd_item(a, lds, it >> 4, it & 15); else lru_item(a, lds, (it - 128) >> 4, (it - 128) & 15);
    }
}


__device__ __forceinline__ f32x4 mfma16(bf16x8 a, bf16x8 b, f32x4 c) { return __builtin_amdgcn_mfma_f32_16x16x32_bf16(a, b, c, 0, 0, 0); }
constexpr int RSX = 144, RSB = 272;
constexpr int SO_X = 0, SO_B = SO_X + 128 * RSX, SO_C = SO_B + 128 * RSB, SO_M = SO_C + 128 * RSB, SO_S = SO_M + 128 * RSB, SO_V = SO_S + 64 * RSB;
static_assert(SO_V + 4096 <= LDS_BYTES - 256, "ssd lds");
#define TR4(RS4, o0, o1, o2, o3, addr) do { v2u l0_, h0_, l1_, h1_, l2_, h2_, l3_, h3_; \
    asm volatile("ds_read_b64_tr_b16 %0, %8\n\tds_read_b64_tr_b16 %1, %8 offset:" #RS4 "\n\t" \
                 "ds_read_b64_tr_b16 %2, %8 offset:32\n\tds_read_b64_tr_b16 %3, %8 offset:" #RS4 "+32\n\t" \
                 "ds_read_b64_tr_b16 %4, %8 offset:64\n\tds_read_b64_tr_b16 %5, %8 offset:" #RS4 "+64\n\t" \
                 "ds_read_b64_tr_b16 %6, %8 offset:96\n\tds_read_b64_tr_b16 %7, %8 offset:" #RS4 "+96\n\ts_waitcnt lgkmcnt(0)" \
                 : "=&v"(l0_), "=&v"(h0_), "=&v"(l1_), "=&v"(h1_), "=&v"(l2_), "=&v"(h2_), "=&v"(l3_), "=&v"(h3_) : "v"(addr) : "memory"); \
    o0 = __builtin_bit_cast(bf16x8, (v4u){l0_.x, l0_.y, h0_.x, h0_.y}); o1 = __builtin_bit_cast(bf16x8, (v4u){l1_.x, l1_.y, h1_.x, h1_.y}); \
    o2 = __builtin_bit_cast(bf16x8, (v4u){l2_.x, l2_.y, h2_.x, h2_.y}); o3 = __builtin_bit_cast(bf16x8, (v4u){l3_.x, l3_.y, h3_.x, h3_.y}); } while (0)
#define TR1(RS4, o0, addr) do { v2u l0_, h0_; \
    asm volatile("ds_read_b64_tr_b16 %0, %2\n\tds_read_b64_tr_b16 %1, %2 offset:" #RS4 "\n\ts_waitcnt lgkmcnt(0)" : "=&v"(l0_), "=&v"(h0_) : "v"(addr) : "memory"); \
    o0 = __builtin_bit_cast(bf16x8, (v4u){l0_.x, l0_.y, h0_.x, h0_.y}); } while (0)
__device__ __forceinline__ void unpack8(const v4u r, float (&f)[8]) {
    f[0] = __uint_as_float(r.x << 16); f[1] = __uint_as_float(r.x & 0xffff0000u); f[2] = __uint_as_float(r.y << 16); f[3] = __uint_as_float(r.y & 0xffff0000u);
    f[4] = __uint_as_float(r.z << 16); f[5] = __uint_as_float(r.z & 0xffff0000u); f[6] = __uint_as_float(r.w << 16); f[7] = __uint_as_float(r.w & 0xffff0000u);
}
__device__ __forceinline__ void ssd_item2(const Args& a, LAS unsigned char* lds, int b, int h) {
    const int tid = threadIdx.x, lane = tid & 63, w = __builtin_amdgcn_readfirstlane(tid >> 6), fr = lane & 15, fq = lane >> 4;
    bf16* PROJ = (bf16*)(a.ws + WS_PROJ); const float* DT = (const float*)(a.ws + WS_DT); float* SSDSQ = (float*)(a.ws + WS_SSDSQ);
    const int g = h >> 3;
    const float Ah = -__expf(a.in[I_ALOG][h]), Dh = a.in[I_SD][h];
    LAS float* acs = (LAS float*)(lds + SO_V); LAS float* dtv = acs + 128; LAS float* wv = acs + 256; LAS float* eacs = acs + 384;
    const size_t rbase = (size_t)b * LSEQ;
    const int cg = tid % 40, rgrp = tid / 40;
    const int ccol = cg < 8 ? C_X + h * 64 + cg * 8 : (cg < 24 ? C_B + g * 128 + (cg - 8) * 8 : C_C + g * 128 + (cg - 24) * 8);
    const int cch = cg < 8 ? h * 64 + cg * 8 : (cg < 24 ? 1024 + g * 128 + (cg - 8) * 8 : 1280 + g * 128 + (cg - 24) * 8);
    const int cdst = cg < 8 ? SO_X + cg * 16 : (cg < 24 ? SO_B + (cg - 8) * 16 : SO_C + (cg - 24) * 16), crs = cg < 8 ? RSX : RSB;
    const int pt_s = w & 3, nh = w >> 2;
    f32x4 sacc[4];
#pragma unroll
    for (int i = 0; i < 4; ++i) sacc[i] = (f32x4){0.f, 0.f, 0.f, 0.f};
    __syncthreads();
    for (int i = tid; i < 64 * RSB / 4; i += 512) ((LAS unsigned*)(lds + SO_S))[i] = 0u;
    for (int l0 = 0; l0 < LSEQ; l0 += 128) {
        const int nvalid = (LSEQ - l0) < 128 ? (LSEQ - l0) : 128;
        if (w == 0) {
            const float d0 = lane < nvalid ? DT[(rbase + l0 + lane) * 16 + h] : 0.f, d1 = (lane + 64) < nvalid ? DT[(rbase + l0 + lane + 64) * 16 + h] : 0.f;
            float a0 = Ah * d0, a1 = Ah * d1;
#pragma unroll
            for (int o = 1; o < 64; o <<= 1) { const float v0 = __shfl_up(a0, o), v1 = __shfl_up(a1, o); if (lane >= o) { a0 += v0; a1 += v1; } }
            a1 += __shfl(a0, 63);
            const float aend = __shfl(a1, 63);
            acs[lane] = a0; acs[lane + 64] = a1; dtv[lane] = d0; dtv[lane + 64] = d1;
            wv[lane] = __expf(aend - a0) * d0; wv[lane + 64] = __expf(aend - a1) * d1; eacs[lane] = __expf(a0); eacs[lane + 64] = __expf(a1);
            if (lane == 0) acs[512] = aend;
        }
        if (tid < 480) {
            const int r0 = rgrp * 11, r1 = (r0 + 11) < 128 ? (r0 + 11) : 128;
            float cw[4][8], cb[8];
#pragma unroll
            for (int k = 0; k < 4; ++k) { const f32x4 wa = *(const f32x4*)(a.in[I_SCW] + k * 1536 + cch), wb = *(const f32x4*)(a.in[I_SCW] + k * 1536 + cch + 4);
#pragma unroll
                for (int j = 0; j < 4; ++j) { cw[k][j] = wa[j]; cw[k][4 + j] = wb[j]; } }
            { const f32x4 wa = *(const f32x4*)(a.in[I_SCB] + cch), wb = *(const f32x4*)(a.in[I_SCB] + cch + 4);
#pragma unroll
              for (int j = 0; j < 4; ++j) { cb[j] = wa[j]; cb[4 + j] = wb[j]; } }
            float p0[8], p1[8], p2[8];
            {   const int la = l0 + r0 - 3, lb = la + 1, lc = la + 2;
                v4u q0 = (v4u){0u, 0u, 0u, 0u}, q1 = q0, q2 = q0;
                if (la >= 0 && la < LSEQ) q0 = *(const v4u*)(PROJ + (rbase + la) * LDP + ccol);
                if (lb >= 0 && lb < LSEQ) q1 = *(const v4u*)(PROJ + (rbase + lb) * LDP + ccol);
                if (lc >= 0 && lc < LSEQ) q2 = *(const v4u*)(PROJ + (rbase + lc) * LDP + ccol);
                unpack8(q0, p0); unpack8(q1, p1); unpack8(q2, p2); }
            for (int t = r0; t < r1; ++t) {
                const int l = l0 + t; float p3[8];
                v4u q3 = (v4u){0u, 0u, 0u, 0u};
                if (l < LSEQ) q3 = *(const v4u*)(PROJ + (rbase + l) * LDP + ccol);
                unpack8(q3, p3);
                float o[8];
#pragma unroll
                for (int j = 0; j < 8; ++j) { const float v = cw[0][j] * p0[j] + cw[1][j] * p1[j] + cw[2][j] * p2[j] + cw[3][j] * p3[j] + cb[j]; o[j] = l < LSEQ ? silu_f(v) : 0.f; p0[j] = p1[j]; p1[j] = p2[j]; p2[j] = p3[j]; }
                v4u ov; ov.x = pk2(o[0], o[1]); ov.y = pk2(o[2], o[3]); ov.z = pk2(o[4], o[5]); ov.w = pk2(o[6], o[7]);
                *(LAS v4u*)(lds + cdst + t * crs) = ov;
            }
        }
        __syncthreads();
        {
            f32x4 gacc[8];
#pragma unroll
            for (int st = 0; st < 8; ++st) gacc[st] = (f32x4){0.f, 0.f, 0.f, 0.f};
#pragma unroll
            for (int k0 = 0; k0 < 128; k0 += 32) {
                const bf16x8 cf = *(const LAS bf16x8*)(lds + SO_C + (16 * w + fr) * RSB + (k0 + 8 * fq) * 2);
#pragma unroll
                for (int st = 0; st < 8; ++st) { const bf16x8 bf = *(const LAS bf16x8*)(lds + SO_B + (16 * st + fr) * RSB + (k0 + 8 * fq) * 2); gacc[st] = mfma16(bf, cf, gacc[st]); }
            }
            const int l = 16 * w + fr; const float al = acs[l];
#pragma unroll
            for (int st = 0; st < 8; ++st) {
                const int s0 = 16 * st + 4 * fq; const f32x4 as = *(const LAS f32x4*)(acs + s0), ds = *(const LAS f32x4*)(dtv + s0);
                float m[4];
#pragma unroll
                for (int j = 0; j < 4; ++j) m[j] = (s0 + j <= l) ? gacc[st][j] * __expf(al - as[j]) * ds[j] : 0.f;
                v2u mv; mv.x = pk2(m[0], m[1]); mv.y = pk2(m[2], m[3]);
                *(LAS v2u*)(lds + SO_M + l * RSB + s0 * 2) = mv;
            }
        }
        __syncthreads();
        {
            f32x4 y[4];
#pragma unroll
            for (int pt = 0; pt < 4; ++pt) y[pt] = (f32x4){0.f, 0.f, 0.f, 0.f};
#pragma unroll
            for (int k0 = 0; k0 < 128; k0 += 32) {
                const bf16x8 cf = *(const LAS bf16x8*)(lds + SO_C + (16 * w + fr) * RSB + (k0 + 8 * fq) * 2);
#pragma unroll
                for (int pt = 0; pt < 4; ++pt) { const bf16x8 sf = *(const LAS bf16x8*)(lds + SO_S + (16 * pt + fr) * RSB + (k0 + 8 * fq) * 2); y[pt] = mfma16(cf, sf, y[pt]); }
            }
            const f32x4 ea = *(const LAS f32x4*)(eacs + 16 * w + 4 * fq);
#pragma unroll
            for (int pt = 0; pt < 4; ++pt) y[pt] *= ea;
            for (int k0 = 0; k0 <= 16 * w + 15; k0 += 32) {
                const bf16x8 mf = *(const LAS bf16x8*)(lds + SO_M + (16 * w + fr) * RSB + (k0 + 8 * fq) * 2);
                const unsigned xa = (unsigned)(size_t)(lds + SO_X) + (unsigned)((k0 + 8 * fq + (fr >> 2)) * RSX + (fr & 3) * 8);
                bf16x8 x0, x1, x2, x3; TR4(576, x0, x1, x2, x3, xa);
                y[0] = mfma16(mf, x0, y[0]); y[1] = mfma16(mf, x1, y[1]); y[2] = mfma16(mf, x2, y[2]); y[3] = mfma16(mf, x3, y[3]);
            }
#pragma unroll
            for (int pt = 0; pt < 4; ++pt)
#pragma unroll
                for (int r = 0; r < 4; ++r) *(LAS float*)(lds + SO_M + (16 * w + 4 * fq + r) * RSB + (16 * pt + fr) * 4) = y[pt][r];
        }
        {
            const float dec = __expf(acs[512]);
#pragma unroll
            for (int i = 0; i < 4; ++i) sacc[i] *= dec;
#pragma unroll
            for (int k0 = 0; k0 < 128; k0 += 32) {
                const unsigned xa = (unsigned)(size_t)(lds + SO_X) + (unsigned)((k0 + 8 * fq + (fr >> 2)) * RSX + pt_s * 32 + (fr & 3) * 8);
                bf16x8 xf; TR1(576, xf, xa);
                const f32x4 w0 = *(const LAS f32x4*)(wv + k0 + 8 * fq), w1 = *(const LAS f32x4*)(wv + k0 + 8 * fq + 4);
                float xv[8]; unpack8(__builtin_bit_cast(v4u, xf), xv);
                v4u xs; xs.x = pk2(xv[0] * w0[0], xv[1] * w0[1]); xs.y = pk2(xv[2] * w0[2], xv[3] * w0[3]); xs.z = pk2(xv[4] * w1[0], xv[5] * w1[1]); xs.w = pk2(xv[6] * w1[2], xv[7] * w1[3]);
                const bf16x8 xw = __builtin_bit_cast(bf16x8, xs);
                const unsigned ba = (unsigned)(size_t)(lds + SO_B) + (unsigned)((k0 + 8 * fq + (fr >> 2)) * RSB + nh * 128 + (fr & 3) * 8);
                bf16x8 b0, b1, b2, b3; TR4(1088, b0, b1, b2, b3, ba);
                sacc[0] = mfma16(xw, b0, sacc[0]); sacc[1] = mfma16(xw, b1, sacc[1]); sacc[2] = mfma16(xw, b2, sacc[2]); sacc[3] = mfma16(xw, b3, sacc[3]);
            }
        }
        __syncthreads();
#pragma unroll
        for (int i = 0; i < 4; ++i)
#pragma unroll
            for (int r = 0; r < 4; ++r) *(LAS bf16*)(lds + SO_S + (16 * pt_s + 4 * fq + r) * RSB + (16 * (4 * nh + i) + fr) * 2) = (bf16)f2bf(sacc[i][r]);
        {
            const int t = tid >> 2, q4 = tid & 3;
            if (t < nvalid) {
                const size_t row = rbase + l0 + t;
                bf16* zp = PROJ + row * LDP + C_Z + h * 64 + 16 * q4;
                const v4u z0 = *(const v4u*)zp, z1 = *(const v4u*)(zp + 8);
                const v4u x0 = *(const LAS v4u*)(lds + SO_X + t * RSX + q4 * 32), x1 = *(const LAS v4u*)(lds + SO_X + t * RSX + q4 * 32 + 16);
                float zf[16], xf[16], yo[16];
                { float tmp[8]; unpack8(z0, tmp);
#pragma unroll
                  for (int j = 0; j < 8; ++j) zf[j] = tmp[j];
                  unpack8(z1, tmp);
#pragma unroll
                  for (int j = 0; j < 8; ++j) zf[8 + j] = tmp[j];
                  unpack8(x0, tmp);
#pragma unroll
                  for (int j = 0; j < 8; ++j) xf[j] = tmp[j];
                  unpack8(x1, tmp);
#pragma unroll
                  for (int j = 0; j < 8; ++j) xf[8 + j] = tmp[j]; }
                float sq = 0.f;
#pragma unroll
                for (int j4 = 0; j4 < 4; ++j4) { const f32x4 yv = *(const LAS f32x4*)(lds + SO_M + t * RSB + (16 * q4 + 4 * j4) * 4);
#pragma unroll
                    for (int j = 0; j < 4; ++j) { const float v = (yv[j] + Dh * xf[4 * j4 + j]) * silu_f(zf[4 * j4 + j]); yo[4 * j4 + j] = v; sq += v * v; } }
                v4u o0, o1; o0.x = pk2(yo[0], yo[1]); o0.y = pk2(yo[2], yo[3]); o0.z = pk2(yo[4], yo[5]); o0.w = pk2(yo[6], yo[7]);
                o1.x = pk2(yo[8], yo[9]); o1.y = pk2(yo[10], yo[11]); o1.z = pk2(yo[12], yo[13]); o1.w = pk2(yo[14], yo[15]);
                *(v4u*)zp = o0; *(v4u*)(zp + 8) = o1;
                sq += __shfl_xor(sq, 1); sq += __shfl_xor(sq, 2);
                if (q4 == 0) SSDSQ[row * 16 + h] = sq;
            }
        }
        __syncthreads();
    }
}
constexpr int LO_XB = 0, LO_XF = LO_XB + 128 * RSX, LO_A = LO_XF + 128 * 260, LO_U = LO_A + 128 * 260, LO_WA = LO_U + 128 * 260, LO_WX = LO_WA + 64 * RSX;
static_assert(LO_WX + 64 * RSX <= LDS_BYTES - 256, "lru lds");
__device__ __forceinline__ void lru_item2(const Args& a, LAS unsigned char* lds, int b, int h) {
    const int tid = threadIdx.x, lane = tid & 63, w = __builtin_amdgcn_readfirstlane(tid >> 6), fr = lane & 15, fq = lane >> 4;
    bf16* PROJ = (bf16*)(a.ws + WS_PROJ);
    const size_t rbase = (size_t)b * LSEQ;
    __syncthreads();
    for (int i = tid; i < 4096; i += 512) { const int ii = i >> 6, j = i & 63;
        *(LAS bf16*)(lds + LO_WA + j * RSX + ii * 2) = (bf16)f2bf(a.in[I_LWA][(size_t)h * 4096 + i]);
        *(LAS bf16*)(lds + LO_WX + j * RSX + ii * 2) = (bf16)f2bf(a.in[I_LWX][(size_t)h * 4096 + i]); }
    const int cg = tid & 7, rg = tid >> 3;
    float gba[4], gbx[4], gsp[4];
#pragma unroll
    for (int jt = 0; jt < 4; ++jt) { const int c = h * 64 + 16 * jt + fr; gba[jt] = a.in[I_LBA][c]; gbx[jt] = a.in[I_LBX][c]; gsp[jt] = softplus_f(-a.in[I_LLAM][c]); }
    float hprev = 0.f;
    for (int l0 = 0; l0 < LSEQ; l0 += 128) {
        const int nvalid = (LSEQ - l0) < 128 ? (LSEQ - l0) : 128;
        {
            float cw[4][8], cb[8];
#pragma unroll
            for (int k = 0; k < 4; ++k) { const f32x4 wa = *(const f32x4*)(a.in[I_LCW] + k * 1024 + h * 64 + cg * 8), wb = *(const f32x4*)(a.in[I_LCW] + k * 1024 + h * 64 + cg * 8 + 4);
#pragma unroll
                for (int j = 0; j < 4; ++j) { cw[k][j] = wa[j]; cw[k][4 + j] = wb[j]; } }
            { const f32x4 wa = *(const f32x4*)(a.in[I_LCB] + h * 64 + cg * 8), wb = *(const f32x4*)(a.in[I_LCB] + h * 64 + cg * 8 + 4);
#pragma unroll
              for (int j = 0; j < 4; ++j) { cb[j] = wa[j]; cb[4 + j] = wb[j]; } }
            float p[5][8];
#pragma unroll
            for (int r = 0; r < 5; ++r) { const int l = l0 + 2 * rg - 3 + r; v4u q = (v4u){0u, 0u, 0u, 0u};
                if (l >= 0 && l < LSEQ) q = *(const v4u*)(PROJ + (rbase + l) * LDP + C_LI + h * 64 + cg * 8);
                unpack8(q, p[r]); }
#pragma unroll
            for (int rr = 0; rr < 2; ++rr) { const int t = 2 * rg + rr; float o[8];
#pragma unroll
                for (int j = 0; j < 8; ++j) o[j] = cw[0][j] * p[rr][j] + cw[1][j] * p[rr + 1][j] + cw[2][j] * p[rr + 2][j] + cw[3][j] * p[rr + 3][j] + cb[j];
                v4u ov; ov.x = pk2(o[0], o[1]); ov.y = pk2(o[2], o[3]); ov.z = pk2(o[4], o[5]); ov.w = pk2(o[6], o[7]);
                *(LAS v4u*)(lds + LO_XB + t * RSX + cg * 16) = ov;
#pragma unroll
                for (int j = 0; j < 8; ++j) *(LAS float*)(lds + LO_XF + t * 260 + (cg * 8 + j) * 4) = o[j]; }
        }
        __syncthreads();
        {
            f32x4 ga[4], gx[4];
#pragma unroll
            for (int jt = 0; jt < 4; ++jt) { ga[jt] = (f32x4){0.f, 0.f, 0.f, 0.f}; gx[jt] = ga[jt]; }
#pragma unroll
            for (int k0 = 0; k0 < 64; k0 += 32) {
                const bf16x8 xf = *(const LAS bf16x8*)(lds + LO_XB + (16 * w + fr) * RSX + (k0 + 8 * fq) * 2);
#pragma unroll
                for (int jt = 0; jt < 4; ++jt) {
                    const bf16x8 wa = *(const LAS bf16x8*)(lds + LO_WA + (16 * jt + fr) * RSX + (k0 + 8 * fq) * 2), wx = *(const LAS bf16x8*)(lds + LO_WX + (16 * jt + fr) * RSX + (k0 + 8 * fq) * 2);
                    ga[jt] = mfma16(xf, wa, ga[jt]); gx[jt] = mfma16(xf, wx, gx[jt]); }
            }
#pragma unroll
            for (int jt = 0; jt < 4; ++jt)
#pragma unroll
                for (int r = 0; r < 4; ++r) { const int l = 16 * w + 4 * fq + r, j = 16 * jt + fr;
                    const float rr = sigmoid_f(ga[jt][r] + gba[jt]), ig = sigmoid_f(gx[jt][r] + gbx[jt]);
                    const float log_a = -8.0f * rr * gsp[jt];
                    const float av = __expf(log_a);
                    const float mult = (l0 + l == 0) ? 1.f : sqrtf(fmaxf(-expm1f(2.f * log_a), 0.f));
                    const float xv = *(const LAS float*)(lds + LO_XF + l * 260 + j * 4);
                    *(LAS float*)(lds + LO_A + l * 260 + j * 4) = av; *(LAS float*)(lds + LO_U + l * 260 + j * 4) = mult * ig * xv; }
        }
        __syncthreads();
        if (tid < 64) { for (int t = 0; t < nvalid; ++t) { LAS float* up = (LAS float*)(lds + LO_U + t * 260 + tid * 4); hprev = *(const LAS float*)(lds + LO_A + t * 260 + tid * 4) * hprev + *up; *up = hprev; } }
        __syncthreads();
        {   const int t = tid >> 2, q4 = tid & 3;
            if (t < nvalid) {
                const size_t row = rbase + l0 + t;
                bf16* gp = PROJ + row * LDP + C_G + h * 64 + 16 * q4;
                const v4u g0 = *(const v4u*)gp, g1 = *(const v4u*)(gp + 8);
                float gf[16], yo[16];
                { float tmp[8]; unpack8(g0, tmp);
#pragma unroll
                  for (int j = 0; j < 8; ++j) gf[j] = tmp[j];
                  unpack8(g1, tmp);
#pragma unroll
                  for (int j = 0; j < 8; ++j) gf[8 + j] = tmp[j]; }
#pragma unroll
                for (int j = 0; j < 16; ++j) yo[j] = *(const LAS float*)(lds + LO_U + t * 260 + (16 * q4 + j) * 4) * gelu_tanh_f(gf[j]);
                v4u o0, o1; o0.x = pk2(yo[0], yo[1]); o0.y = pk2(yo[2], yo[3]); o0.z = pk2(yo[4], yo[5]); o0.w = pk2(yo[6], yo[7]);
                o1.x = pk2(yo[8], yo[9]); o1.y = pk2(yo[10], yo[11]); o1.z = pk2(yo[12], yo[13]); o1.w = pk2(yo[14], yo[15]);
                *(v4u*)gp = o0; *(v4u*)(gp + 8) = o1;
            }
        }
        __syncthreads();
    }
}
__device__ __forceinline__ void ph_mixers2(const Args& a, LAS unsigned char* lds, int wk, int nwk) {
    for (int it = wk; it < 256; it += nwk) if (it < 128) ssd_item2(a, lds, it >> 4, it & 15);
    for (int it = wk; it < 256; it += nwk) if (it >= 128) lru_item2(a, lds, (it - 128) >> 4, (it - 128) & 15);
}

__device__ __forceinline__ void ph_router(const Args& a, LAS unsigned char* lds, int L, int wk, int nwk) {
    const int tid = threadIdx.x, lane = tid & 63, wave = __builtin_amdgcn_readfirstlane(tid >> 6);
    const int gw = wk * NWAVES + wave, NGW = nwk * NWAVES;
    LAS float* wr = (LAS float*)lds;
    const float* WRT = (const float*)(a.ws + WS_WRT) + (size_t)L * 20480;
    __syncthreads();
    for (int i = tid; i < 20480 / 4; i += 512) ((LAS f32x4*)wr)[i] = ((const f32x4*)WRT)[i];
    __syncthreads();
    const float* H = (const float*)(a.ws + WS_H);
    float* RSTD1 = (float*)(a.ws + WS_RSTD1); float* GATES = (float*)(a.ws + WS_GATES); int* LIST = (int*)(a.ws + WS_LIST);
    unsigned* cnt = (unsigned*)(a.ws + WS_CTL) + CW_CNT + 64 * L;
    const float* bg = a.in[I_RGB] + L * 4; const float* be = a.in[I_REB] + L * 16;
    for (int row = gw; row < T; row += NGW) {
        const f32x4* xr = (const f32x4*)(H + (size_t)row * D) + lane;
        f32x4 v[4]; float ss = 0.f;
#pragma unroll
        for (int j = 0; j < 4; ++j) { v[j] = xr[64 * j]; ss += v[j].x * v[j].x + v[j].y * v[j].y + v[j].z * v[j].z + v[j].w * v[j].w; }
        ss = wave_sum(ss);
        const float rstd = rsqrtf(ss * (1.f / D) + EPS);
        float mylg = 0.f;
#pragma unroll 2
        for (int jj = 0; jj < 20; ++jj) {
            float s = 0.f;
#pragma unroll
            for (int j = 0; j < 4; ++j) { const f32x4 w = *(const LAS f32x4*)(wr + jj * 1024 + (lane + 64 * j) * 4); s += v[j].x * w.x + v[j].y * w.y + v[j].z * w.z + v[j].w * w.w; }
            s = wave_sum(s);
            if (lane == jj) mylg = s;
        }
        mylg = mylg * rstd + (lane < 4 ? bg[lane & 3] : be[(lane - 4) & 15]);
        float lg[20];
#pragma unroll
        for (int jj = 0; jj < 20; ++jj) lg[jj] = __shfl(mylg, jj);
        int gs = 0; float gm = lg[0];
#pragma unroll
        for (int j = 1; j < 4; ++j) if (lg[j] > gm) { gm = lg[j]; gs = j; }
        const float pg = 1.f / (__expf(lg[0] - gm) + __expf(lg[1] - gm) + __expf(lg[2] - gm) + __expf(lg[3] - gm));
        float f[4];
#pragma unroll
        for (int i = 0; i < 4; ++i) f[i] = gs == 0 ? lg[4 + i] : (gs == 1 ? lg[8 + i] : (gs == 2 ? lg[12 + i] : lg[16 + i]));
        int i0 = 0; float m0 = f[0];
#pragma unroll
        for (int i = 1; i < 4; ++i) if (f[i] > m0) { m0 = f[i]; i0 = i; }
        int i1 = -1; float m1 = -3.0e38f;
#pragma unroll
        for (int i = 0; i < 4; ++i) if (i != i0 && f[i] > m1) { m1 = f[i]; i1 = i; }
        const float w0 = 1.f / (1.f + __expf(m1 - m0)), w1 = 1.f - w0;
        const int lo = i0 < i1 ? i0 : i1, hi = i0 < i1 ? i1 : i0;
        const float glo = pg * (i0 < i1 ? w0 : w1), ghi = pg * (i0 < i1 ? w1 : w0);
        const int pair = lo == 0 ? hi - 1 : (lo == 1 ? hi + 1 : 5);
        const int bk = gs * 6 + pair;
        if (lane == 0) {
            const unsigned slot = atomicAdd(cnt + bk, 1u);
            LIST[(size_t)bk * T + slot] = row;
            RSTD1[row] = rstd; GATES[(size_t)row * 2] = glo; GATES[(size_t)row * 2 + 1] = ghi;
        }
    }
}

struct BkTab { int cnt[NBK], off[NBK], ust[NBK + 1]; };
__device__ __forceinline__ void bk_table(const Args& a, LAS unsigned char* lds, int L, int per_tile  ) {
    LAS int* tb = (LAS int*)lds;
    __syncthreads();
    if (threadIdx.x == 0) {
        const unsigned* cnt = (const unsigned*)(a.ws + WS_CTL) + CW_CNT + 64 * L;
        int off = 0, us = 0;
        for (int i = 0; i < NBK; ++i) { const int c = (int)__hip_atomic_load(cnt + i, __ATOMIC_RELAXED, __HIP_MEMORY_SCOPE_AGENT);
            tb[i] = c; tb[NBK + i] = off; tb[2 * NBK + i] = us; off += (c + 255) & ~255; us += ((c + 63) >> 6) * per_tile; }
        tb[2 * NBK + NBK] = us;
    }
    __syncthreads();
}
__device__ __forceinline__ void bk_experts(int bk, int& elo, int& ehi) {
    const int g = bk / 6, pr = bk - g * 6;
    const int lo = pr < 3 ? 0 : (pr < 5 ? 1 : 2), hi = pr < 3 ? pr + 1 : (pr < 5 ? pr - 1 : 3);
    elo = g * 4 + lo; ehi = g * 4 + hi;
}
__device__ __forceinline__ void ph_moe_up(const Args& a, LAS unsigned char* lds, int L, int wk, int nwk) {
    const int tid = threadIdx.x, lane = tid & 63, wave = __builtin_amdgcn_readfirstlane(tid >> 6), fr = lane & 15, fq = lane >> 4;
    const int gw = wk * NWAVES + wave, NGW = nwk * NWAVES;
    bk_table(a, lds, L, 32);
    LAS int* tb = (LAS int*)lds;
    const bf16* HB = (const bf16*)a.out; const bf16* WGU = (const bf16*)(a.ws + WS_WGU); bf16* HID = (bf16*)(a.ws + WS_HID);
    const int* LIST = (const int*)(a.ws + WS_LIST); const float* RSTD1 = (const float*)(a.ws + WS_RSTD1); const float* GATES = (const float*)(a.ws + WS_GATES);
    const int nun = tb[2 * NBK + NBK];
    for (int u = gw; u < nun; u += NGW) {
        int bk = 0;
        for (int i = 1; i < NBK; ++i) if (u >= tb[2 * NBK + i]) bk = i;
        const int cnt = tb[bk], off = tb[NBK + bk], r = u - tb[2 * NBK + bk];
        const int rt = r >> 5, ek = (r >> 4) & 1, ct = r & 15;
        int elo, ehi; bk_experts(bk, elo, ehi); const int e = ek ? ehi : elo;
        const int c0 = ct * 32, brow = e * 1024 + (c0 >> 7) * 256 + (c0 & 127);
        const bf16* arow[4]; int tok[4];
#pragma unroll
        for (int mi = 0; mi < 4; ++mi) { int rr = rt * 64 + 16 * mi + fr; if (rr >= cnt) rr = cnt - 1; tok[mi] = LIST[(size_t)bk * T + rr]; arow[mi] = HB + (size_t)tok[mi] * D; }
        f32x4 acc[4][4]; zero_acc(acc);
        sg_kloop<4>(1024, arow, [=](int n, int k0) { return WGU + (size_t)(brow + (n < 32 ? n : n + 96)) * 1024 + k0; }, NoKS(), acc, fr, fq);
#pragma unroll
        for (int mi = 0; mi < 4; ++mi) { const int rr = rt * 64 + 16 * mi + fr;
            if (rr < cnt) { const float rs = RSTD1[tok[mi]], gt = GATES[(size_t)tok[mi] * 2 + ek];
#pragma unroll
                for (int nj = 0; nj < 2; ++nj) { const f32x4 gv = acc[mi][nj] * rs, uv = acc[mi][nj + 2] * rs; f32x4 hv;
                    hv.x = silu_f(gv.x) * uv.x * gt; hv.y = silu_f(gv.y) * uv.y * gt; hv.z = silu_f(gv.z) * uv.z * gt; hv.w = silu_f(gv.w) * uv.w * gt;
                    v2u w; w.x = pk2(hv.x, hv.y); w.y = pk2(hv.z, hv.w);
                    *(v2u*)(HID + (size_t)(off + rr) * 1024 + ek * 512 + c0 + 16 * nj + 4 * fq) = w; } } }
    }
}
__device__ __forceinline__ void ph_moe_down(const Args& a, LAS unsigned char* lds, int L, int wk, int nwk) {
    const int tid = threadIdx.x, lane = tid & 63, wave = __builtin_amdgcn_readfirstlane(tid >> 6), fr = lane & 15, fq = lane >> 4;
    const int gw = wk * NWAVES + wave, NGW = nwk * NWAVES;
    bk_table(a, lds, L, 16);
    LAS int* tb = (LAS int*)lds;
    const bf16* HID = (const bf16*)(a.ws + WS_HID); const bf16* WD = (const bf16*)(a.ws + WS_WD);
    float* H = (float*)(a.ws + WS_H); bf16* HB = (bf16*)a.out; const int* LIST = (const int*)(a.ws + WS_LIST);
    const int nun = tb[2 * NBK + NBK];
    for (int u = gw; u < nun; u += NGW) {
        int bk = 0;
        for (int i = 1; i < NBK; ++i) if (u >= tb[2 * NBK + i]) bk = i;
        const int cnt = tb[bk], off = tb[NBK + bk], r = u - tb[2 * NBK + bk];
        const int rt = r >> 4, ct = r & 15;
        int elo, ehi; bk_experts(bk, elo, ehi);
        const bf16* arow[4];
#pragma unroll
        for (int mi = 0; mi < 4; ++mi) arow[mi] = HID + (size_t)(off + rt * 64 + 16 * mi + fr) * 1024;
        f32x4 acc[4][4]; zero_acc(acc);
        sg_kloop<4>(1024, arow, [=](int n, int k0) { return WD + ((size_t)((k0 < 512 ? elo : ehi) * 1024 + ct * 64 + n)) * 512 + (k0 & 511); }, NoKS(), acc, fr, fq);
#pragma unroll
        for (int mi = 0; mi < 4; ++mi) { const int rr = rt * 64 + 16 * mi + fr;
            if (rr < cnt) { const int tok = LIST[(size_t)bk * T + rr];
#pragma unroll
                for (int nj = 0; nj < 4; ++nj) { const int c = ct * 64 + 16 * nj + 4 * fq; float* hp = H + (size_t)tok * D + c;
                    const f32x4 v = *(const f32x4*)hp + acc[mi][nj]; *(f32x4*)hp = v;
                    v2u w; w.x = pk2(v.x, v.y); w.y = pk2(v.z, v.w); *(v2u*)(HB + (size_t)tok * D + c) = w; } } }
    }
}


__device__ __forceinline__ void h_store(float* H, bf16* HB, int row, int col, const f32x4 v) {
    *(f32x4*)(H + (size_t)row * D + col) = v;
    v2u w; w.x = pg8::cvt_pk_bf16(v[0], v[1]); w.y = pg8::cvt_pk_bf16(v[2], v[3]); *(v2u*)(HB + (size_t)row * D + col) = w;
}
constexpr int LDS_TAB = 131072;

struct PGemm2 {
    static constexpr bool PERM = false;
    struct Unit { int pm, pn, ui; };
    const Args* ap; const char* A; const char* B; float* H; bf16* HB; int G, c; int ldb, nt;
    __device__ __forceinline__ bool next(int i, Unit& u) const { u.ui = i; return pg8::static_order(64, 4, G, c, i, u.pm, u.pn); }
    __device__ __forceinline__ void avoff(const Unit& u, const int (&RA)[2], const int (&CA)[2], unsigned (&v)[4]) const {
#pragma unroll
        for (int h = 0; h < 2; ++h)
#pragma unroll
            for (int i = 0; i < 2; ++i) { const int row = u.pm * 256 + h * 128 + RA[i]; v[h * 2 + i] = (unsigned)(row * LDP + CA[i]) * 2u; }
    }
    __device__ __forceinline__ const char* abase(const Unit&) const { return A; }
    __device__ __forceinline__ const char* btile(const Unit& u, int t) const { return B + ((size_t)u.pn * 256 * 2048 + (size_t)t * 64) * 2; }
    __device__ __forceinline__ void khook(int t, pg8::Acc& acc, const Unit& u, LAS unsigned char* lds, int wr, int wc, int fr, int fq) const {
        if (t == 8 || t == 16) {
            const LAS float* ft = (const LAS float*)(lds + LDS_TAB) + u.ui * 512 + (t == 16 ? 1 : 0);
#pragma unroll
            for (int ai = 0; ai < 2; ++ai)
#pragma unroll
                for (int m = 0; m < 4; ++m) { const float f = ft[(ai * 128 + wr * 64 + m * 16 + fr) * 2];
#pragma unroll
                    for (int bj = 0; bj < 2; ++bj)
#pragma unroll
                        for (int n = 0; n < 2; ++n) acc[ai][bj][m][n] *= f; }
        }
    }
    __device__ __forceinline__ void epi(const pg8::Acc& acc, const Unit& u, int wr, int wc, int fr, int fq) const {
        const int row0 = u.pm * 256 + wr * 64 + fr, col0 = u.pn * 256 + wc * 32 + 4 * fq;
#pragma unroll
        for (int ai = 0; ai < 2; ++ai)
#pragma unroll
            for (int m = 0; m < 4; ++m) { const int row = row0 + ai * 128 + m * 16; const float* hr = h0_row(*ap, row);
#pragma unroll
                for (int bj = 0; bj < 2; ++bj)
#pragma unroll
                    for (int n = 0; n < 2; ++n) { const int col = col0 + bj * 128 + n * 16; h_store(H, HB, row, col, acc[ai][bj][m][n] + *(const f32x4*)(hr + col)); } }
    }
};
__device__ __forceinline__ void ssd_factors(const float* SSDSQ, int row, float& f0, float& f1) {
    const f32x4* sq = (const f32x4*)(SSDSQ + (size_t)row * 16); const f32x4 q0 = sq[0], q1 = sq[1], q2 = sq[2], q3 = sq[3];
    const float s0 = (q0.x + q0.y + q0.z + q0.w) + (q1.x + q1.y + q1.z + q1.w), s1 = (q2.x + q2.y + q2.z + q2.w) + (q3.x + q3.y + q3.z + q3.w);
    const float r0 = rsqrtf(s0 * (1.f / 512.f) + EPS), r1 = rsqrtf(s1 * (1.f / 512.f) + EPS);
    f0 = r0 / r1; f1 = r1;
}
__device__ __forceinline__ void ph_gemm2_pg8(const Args& a, LAS unsigned char* lds, int wk, int G) {
    const int tid = threadIdx.x, lane = tid & 63, wave = __builtin_amdgcn_readfirstlane(tid >> 6), fr = lane & 15, fq = lane >> 4;
    const float* SSDSQ = (const float*)(a.ws + WS_SSDSQ);
    PGemm2 S; S.ap = &a; S.A = (const char*)(a.ws + WS_PROJ); S.B = (const char*)(a.ws + WS_WOUT); S.H = (float*)(a.ws + WS_H); S.HB = (bf16*)a.out;
    S.G = G; S.c = (int)blockIdx.x; S.ldb = 2048; S.nt = 32;
    {
        LAS float* ft = (LAS float*)(lds + LDS_TAB);
        PGemm2::Unit u;
        for (int i = 0; i < 4 && S.next(i, u); ++i)
            if (tid < 256) { float f0, f1; ssd_factors(SSDSQ, u.pm * 256 + tid, f0, f1); ft[i * 512 + tid * 2] = f0; ft[i * 512 + tid * 2 + 1] = f1; }
        __syncthreads();
    }
    pg8::gemm_phase<PGemm2, true>(lds, S);
    const bf16* PROJ = (const bf16*)(a.ws + WS_PROJ); const bf16* WOUT = (const bf16*)(a.ws + WS_WOUT);
    for (int tile = wk; tile < 32; tile += G) {
        const int rt = tile >> 4, ct = tile & 15, kb = wave * 256;
        const bf16* arow[4];
#pragma unroll
        for (int mi = 0; mi < 4; ++mi) arow[mi] = PROJ + (size_t)(16384 + rt * 64 + 16 * mi + fr) * LDP + kb;
        f32x4 acc[4][4]; zero_acc(acc);
        sg_kloop<4>(256, arow, [=](int n, int k0) { return WOUT + (size_t)(ct * 64 + n) * 2048 + kb + k0; }, NoKS(), acc, fr, fq);
        LAS float* part = (LAS float*)lds + wave * 4096;
        __syncthreads();
#pragma unroll
        for (int mi = 0; mi < 4; ++mi) { const int r = 16 * mi + fr; float f0, f1; ssd_factors(SSDSQ, 16384 + rt * 64 + r, f0, f1);
            const float sc = wave < 2 ? f0 * f1 : (wave < 4 ? f1 : 1.f);
#pragma unroll
            for (int nj = 0; nj < 4; ++nj) *(LAS f32x4*)(part + r * 64 + 16 * nj + 4 * fq) = acc[mi][nj] * sc; }
        __syncthreads();
        for (int q = tid; q < 1024; q += 512) { const int r = q >> 4, c4 = (q & 15) * 4; f32x4 s = *(const LAS f32x4*)((LAS float*)lds + r * 64 + c4);
#pragma unroll
            for (int w = 1; w < 8; ++w) s += *(const LAS f32x4*)((LAS float*)lds + w * 4096 + r * 64 + c4);
            const int row = 16384 + rt * 64 + r, col = ct * 64 + c4;
            h_store(S.H, S.HB, row, col, s + *(const f32x4*)(h0_row(a, row) + col)); }
        __syncthreads();
    }
}

struct BkInfo { int bk, rt, cnt, off; };
__device__ __forceinline__ void bk_table256(const Args& a, LAS unsigned char* lds, int L) {
    LAS int* tb = (LAS int*)(lds + LDS_TAB);
    __syncthreads();
    if (threadIdx.x == 0) {
        const unsigned* cnt = (const unsigned*)(a.ws + WS_CTL) + CW_CNT + 64 * L;
        int off = 0, rts = 0;
        for (int i = 0; i < NBK; ++i) { const int c = (int)__hip_atomic_load(cnt + i, __ATOMIC_RELAXED, __HIP_MEMORY_SCOPE_AGENT);
            tb[i] = c; tb[NBK + i] = off; tb[2 * NBK + i] = rts; off += (c + 255) & ~255; rts += (c + 255) >> 8; }
        tb[2 * NBK + NBK] = rts;
    }
    __syncthreads();
}
__device__ __forceinline__ bool bk_find(const LAS int* tb, int rti, BkInfo& o) {
    if (rti >= tb[2 * NBK + NBK]) return false;
    int bk = 0;
    for (int i = 1; i < NBK; ++i) if (rti >= tb[2 * NBK + i]) bk = i;
    o.bk = bk; o.rt = rti - tb[2 * NBK + bk]; o.cnt = tb[bk]; o.off = tb[NBK + bk]; return true;
}
struct PMoeUp {
    static constexpr bool PERM = true;
    struct Unit { int bk, rt, cnt, off, e, ek, pnl, ui; };
    const char* A; const char* B; bf16* HID; const float* rstd; const float* gates; const LAS int* tb; const LAS int* rowtab; int G, c; int ldb, nt;
    __device__ __forceinline__ bool next(int i, Unit& u) const {
        const int Lu = i * G + c; BkInfo o; if (!bk_find(tb, Lu >> 3, o)) return false;
        u.bk = o.bk; u.rt = o.rt; u.cnt = o.cnt; u.off = o.off; u.ek = (Lu >> 2) & 1; u.pnl = Lu & 3; u.ui = i;
        int elo, ehi; bk_experts(o.bk, elo, ehi); u.e = u.ek ? ehi : elo; return true;
    }
    __device__ __forceinline__ void avoff(const Unit& u, const int (&RA)[2], const int (&CA)[2], unsigned (&v)[4]) const {
#pragma unroll
        for (int h = 0; h < 2; ++h)
#pragma unroll
            for (int i = 0; i < 2; ++i) { const int tok = rowtab[u.ui * 256 + h * 128 + RA[i]]; v[h * 2 + i] = (unsigned)(tok * D + CA[i]) * 2u; }
    }
    __device__ __forceinline__ const char* abase(const Unit&) const { return A; }
    __device__ __forceinline__ const char* btile(const Unit& u, int t) const { return B + ((size_t)(u.e * 1024 + u.pnl * 256) * 1024 + (size_t)t * 64) * 2; }
    __device__ __forceinline__ void khook(int, pg8::Acc&, const Unit&, LAS unsigned char*, int, int, int, int) const {}
    __device__ __forceinline__ void epi(const pg8::Acc& acc, const Unit& u, int wr, int wc, int fr, int fq) const {
        const int r0 = wr * 64 + fr, col0 = u.ek * 512 + u.pnl * 128 + wc * 32 + 8 * fq;
        float rsv[2][4], gtv[2][4];
#pragma unroll
        for (int ai = 0; ai < 2; ++ai)
#pragma unroll
            for (int m = 0; m < 4; ++m) { const int tok = rowtab[u.ui * 256 + r0 + ai * 128 + m * 16]; rsv[ai][m] = rstd[tok]; gtv[ai][m] = gates[(size_t)tok * 2 + u.ek]; }
#pragma unroll
        for (int ai = 0; ai < 2; ++ai)
#pragma unroll
            for (int m = 0; m < 4; ++m) { const int rr = u.rt * 256 + r0 + ai * 128 + m * 16;
                if (rr < u.cnt) { const float rs = rsv[ai][m], gt = gtv[ai][m]; float hv[8];
#pragma unroll
                    for (int n = 0; n < 2; ++n)
#pragma unroll
                        for (int j = 0; j < 4; ++j) { const float g = acc[ai][0][m][n][j] * rs, uu = acc[ai][1][m][n][j] * rs; hv[n * 4 + j] = silu_f(g) * uu * gt; }
                    v4u w; w.x = pg8::cvt_pk_bf16(hv[0], hv[1]); w.y = pg8::cvt_pk_bf16(hv[2], hv[3]); w.z = pg8::cvt_pk_bf16(hv[4], hv[5]); w.w = pg8::cvt_pk_bf16(hv[6], hv[7]);
                    *(v4u*)(HID + (size_t)(u.off + rr) * 1024 + col0) = w; } }
    }
};
__device__ __forceinline__ void ph_moe_up_pg8(const Args& a, LAS unsigned char* lds, int L, int G) {
    bk_table256(a, lds, L);
    const LAS int* tb = (const LAS int*)(lds + LDS_TAB); LAS int* rowtab = (LAS int*)(lds + LDS_TAB + 1024);
    PMoeUp S; S.A = (const char*)a.out; S.B = (const char*)(a.ws + WS_WGU); S.HID = (bf16*)(a.ws + WS_HID); S.rstd = (const float*)(a.ws + WS_RSTD1); S.gates = (const float*)(a.ws + WS_GATES);
    S.tb = tb; S.rowtab = rowtab; S.G = G; S.c = (int)blockIdx.x; S.ldb = 1024; S.nt = 16;
    {   const int* LIST = (const int*)(a.ws + WS_LIST); PMoeUp::Unit u;
        for (int i = 0; i < 4 && S.next(i, u); ++i)
            if (threadIdx.x < 256) { int rr = u.rt * 256 + (int)threadIdx.x; rr = rr < u.cnt ? rr : u.cnt - 1; rowtab[i * 256 + threadIdx.x] = LIST[(size_t)u.bk * T + rr]; }
        __syncthreads();
    }
    pg8::gemm_phase<PMoeUp, true>(lds, S);
}
struct PMoeDown {
    static constexpr bool PERM = false;
    struct Unit { int bk, rt, cnt, off, elo, ehi, pn, ui; };
    const char* A; const char* B; float* H; bf16* HB; const LAS int* tb; const LAS int* rowtab; int G, c; int ldb, nt;
    __device__ __forceinline__ bool next(int i, Unit& u) const {
        const int Lu = i * G + c; BkInfo o; if (!bk_find(tb, Lu >> 2, o)) return false;
        u.bk = o.bk; u.rt = o.rt; u.cnt = o.cnt; u.off = o.off; u.pn = Lu & 3; u.ui = i; bk_experts(o.bk, u.elo, u.ehi); return true;
    }
    __device__ __forceinline__ void avoff(const Unit& u, const int (&RA)[2], const int (&CA)[2], unsigned (&v)[4]) const {
#pragma unroll
        for (int h = 0; h < 2; ++h)
#pragma unroll
            for (int i = 0; i < 2; ++i) { const int row = u.off + u.rt * 256 + h * 128 + RA[i]; v[h * 2 + i] = (unsigned)(row * 1024 + CA[i]) * 2u; }
    }
    __device__ __forceinline__ const char* abase(const Unit&) const { return A; }
    __device__ __forceinline__ const char* btile(const Unit& u, int t) const { return B + ((size_t)((t < 8 ? u.elo : u.ehi) * 1024 + u.pn * 256) * 512 + (size_t)(t & 7) * 64) * 2; }
    __device__ __forceinline__ void khook(int, pg8::Acc&, const Unit&, LAS unsigned char*, int, int, int, int) const {}
    __device__ __forceinline__ void epi(const pg8::Acc& acc, const Unit& u, int wr, int wc, int fr, int fq) const {
        const int r0 = wr * 64 + fr, col0 = u.pn * 256 + wc * 32 + 4 * fq;
#pragma unroll
        for (int ai = 0; ai < 2; ++ai)
#pragma unroll
            for (int m = 0; m < 4; ++m) { const int r = r0 + ai * 128 + m * 16, rr = u.rt * 256 + r;
                if (rr < u.cnt) { const int tok = rowtab[u.ui * 256 + r];
#pragma unroll
                    for (int bj = 0; bj < 2; ++bj)
#pragma unroll
                        for (int n = 0; n < 2; ++n) { const int col = col0 + bj * 128 + n * 16; h_store(H, HB, tok, col, acc[ai][bj][m][n] + *(const f32x4*)(H + (size_t)tok * D + col)); } } }
    }
};
__device__ __forceinline__ void ph_moe_down_pg8(const Args& a, LAS unsigned char* lds, int L, int G) {
    bk_table256(a, lds, L);
    const LAS int* tb = (const LAS int*)(lds + LDS_TAB); LAS int* rowtab = (LAS int*)(lds + LDS_TAB + 1024);
    PMoeDown S; S.A = (const char*)(a.ws + WS_HID); S.B = (const char*)(a.ws + WS_WD); S.H = (float*)(a.ws + WS_H); S.HB = (bf16*)a.out;
    S.tb = tb; S.rowtab = rowtab; S.G = G; S.c = (int)blockIdx.x; S.ldb = 512; S.nt = 16;
    {   const int* LIST = (const int*)(a.ws + WS_LIST); PMoeDown::Unit u;
        for (int i = 0; i < 4 && S.next(i, u); ++i)
            if (threadIdx.x < 256) { int rr = u.rt * 256 + (int)threadIdx.x; rr = rr < u.cnt ? rr : u.cnt - 1; rowtab[i * 256 + threadIdx.x] = LIST[(size_t)u.bk * T + rr]; }
        __syncthreads();
    }
    pg8::gemm_phase<PMoeDown, true>(lds, S);
}
struct PPool {
    static constexpr bool PERM = false;
    struct Unit { int pm, pn; };
    const char* A; const char* B; float* H; bf16* HB; const float* pb; const float* ps; int G, c; int ldb, nt;
    __device__ __forceinline__ bool next(int i, Unit& u) const { return pg8::static_order(65, 4, G, c, i, u.pm, u.pn); }
    __device__ __forceinline__ void avoff(const Unit& u, const int (&RA)[2], const int (&CA)[2], unsigned (&v)[4]) const {
#pragma unroll
        for (int h = 0; h < 2; ++h)
#pragma unroll
            for (int i = 0; i < 2; ++i) { int row = u.pm * 256 + h * 128 + RA[i]; row = row < T ? row : T - 1; v[h * 2 + i] = (unsigned)(row * D + CA[i]) * 2u; }
    }
    __device__ __forceinline__ const char* abase(const Unit& u) const { return A + (size_t)u.pn * 256 * 2; }
    __device__ __forceinline__ const char* btile(const Unit& u, int t) const { return B + ((size_t)u.pn * 256 * 256 + (size_t)t * 64) * 2; }
    __device__ __forceinline__ void khook(int, pg8::Acc&, const Unit&, LAS unsigned char*, int, int, int, int) const {}
    __device__ __forceinline__ void epi(const pg8::Acc& acc, const Unit& u, int wr, int wc, int fr, int fq) const {
        const int row0 = u.pm * 256 + wr * 64 + fr, col0 = u.pn * 256 + wc * 32 + 4 * fq;
#pragma unroll
        for (int ai = 0; ai < 2; ++ai)
#pragma unroll
            for (int m = 0; m < 4; ++m) { const int row = row0 + ai * 128 + m * 16;
                if (row < T) {
#pragma unroll
                    for (int bj = 0; bj < 2; ++bj)
#pragma unroll
                        for (int n = 0; n < 2; ++n) { const int col = col0 + bj * 128 + n * 16;
                            h_store(H, HB, row, col, *(const f32x4*)(H + (size_t)row * D + col) + (acc[ai][bj][m][n] + *(const f32x4*)(pb + col)) * *(const f32x4*)(ps + col)); } } }
    }
};
__device__ __forceinline__ void ph_poolgemm_pg8(const Args& a, LAS unsigned char* lds, int G) {
    PPool S; S.A = (const char*)(a.ws + WS_POOLED); S.B = (const char*)(a.ws + WS_WPOOL); S.H = (float*)(a.ws + WS_H); S.HB = (bf16*)a.out; S.pb = a.in[I_PB]; S.ps = a.in[I_PS];
    S.G = G; S.c = (int)blockIdx.x; S.ldb = 256; S.nt = 4;
    pg8::gemm_phase<PPool, true>(lds, S);
}

__device__ __forceinline__ void ph_rstd2(const Args& a, LAS unsigned char* lds, int wk, int nwk) {
    const int tid = threadIdx.x, lane = tid & 63, wave = __builtin_amdgcn_readfirstlane(tid >> 6);
    const int gw = wk * NWAVES + wave, NGW = nwk * NWAVES;
    const float* H = (const float*)(a.ws + WS_H); float* RSTD1 = (float*)(a.ws + WS_RSTD1);
    for (int row = gw; row < T; row += NGW) {
        const f32x4* xr = (const f32x4*)(H + (size_t)row * D) + lane; float ss = 0.f;
#pragma unroll
        for (int j = 0; j < 4; ++j) { const f32x4 v = xr[64 * j]; ss += v.x * v.x + v.y * v.y + v.z * v.z + v.w * v.w; }
        ss = wave_sum(ss);
        if (lane == 0) RSTD1[row] = rsqrtf(ss * (1.f / D) + EPS);
    }
    convert_experts(a, 1, (LAS float*)(lds + wave * 8448), gw, NGW, lane);
}
__device__ __forceinline__ void ph_pooled(const Args& a, int wk, int nwk) {
    const float* H = (const float*)(a.ws + WS_H); const float* RSTD1 = (const float*)(a.ws + WS_RSTD1); bf16* PO = (bf16*)(a.ws + WS_POOLED);
    for (int i = wk * 512 + threadIdx.x; i < T * 256; i += nwk * 512) {
        const int row = i >> 8, c = (i & 255) * 4, l = row % LSEQ, g = c >> 8, w = 2 << g;
        const int n = (l + 1) < w ? (l + 1) : w;
        f32x4 s = (f32x4){0.f, 0.f, 0.f, 0.f};
        for (int j = 0; j < n; ++j) s += *(const f32x4*)(H + (size_t)(row - j) * D + c) * RSTD1[row - j];
        const f32x4 o = s * (1.f / (float)n) - *(const f32x4*)(H + (size_t)row * D + c) * RSTD1[row];
        v2u wv; wv.x = pk2(o.x, o.y); wv.y = pk2(o.z, o.w); *(v2u*)(PO + (size_t)row * D + c) = wv;
    }
}
__device__ __forceinline__ void ph_poolgemm(const Args& a, int wk, int nwk) {
    const int tid = threadIdx.x, lane = tid & 63, wave = __builtin_amdgcn_readfirstlane(tid >> 6), fr = lane & 15, fq = lane >> 4;
    const int gw = wk * NWAVES + wave, NGW = nwk * NWAVES;
    const bf16* PO = (const bf16*)(a.ws + WS_POOLED); const bf16* WPOOL = (const bf16*)(a.ws + WS_WPOOL);
    float* H = (float*)(a.ws + WS_H); bf16* HB = (bf16*)a.out;
    for (int u = gw; u < 258 * 16; u += NGW) {
        const int rt = u / 16, ct = u % 16, g = ct >> 2;
        const bf16* arow[4];
#pragma unroll
        for (int mi = 0; mi < 4; ++mi) arow[mi] = PO + (size_t)(rt * 64 + 16 * mi + fr) * D + g * 256;
        f32x4 acc[4][4]; zero_acc(acc);
        sg_kloop<4>(256, arow, [=](int n, int k0) { return WPOOL + (size_t)(ct * 64 + n) * 256 + k0; }, NoKS(), acc, fr, fq);
#pragma unroll
        for (int mi = 0; mi < 4; ++mi) { const int row = rt * 64 + 16 * mi + fr;
#pragma unroll
            for (int nj = 0; nj < 4; ++nj) { const int c = ct * 64 + 16 * nj + 4 * fq; float* hp = H + (size_t)row * D + c;
                const f32x4 v = *(const f32x4*)hp + (acc[mi][nj] + *(const f32x4*)(a.in[I_PB] + c)) * *(const f32x4*)(a.in[I_PS] + c); *(f32x4*)hp = v;
                v2u w; w.x = pk2(v.x, v.y); w.y = pk2(v.z, v.w); *(v2u*)(HB + (size_t)row * D + c) = w; } }
    }
}
__device__ __forceinline__ void ph_final(const Args& a, int wk, int nwk) {
    const int tid = threadIdx.x, lane = tid & 63, wave = __builtin_amdgcn_readfirstlane(tid >> 6);
    const int gw = wk * NWAVES + wave, NGW = nwk * NWAVES;
    const float* H = (const float*)(a.ws + WS_H); const f32x4* gn = (const f32x4*)a.in[I_NORMF] + lane;
    for (int orow = gw; orow < NB * SEQ; orow += NGW) {
        const int b = orow / SEQ, l = orow - b * SEQ, row = b * LSEQ + NMETA + l;
        const f32x4* xr = (const f32x4*)(H + (size_t)row * D) + lane; f32x4 v[4]; float ss = 0.f;
#pragma unroll
        for (int j = 0; j < 4; ++j) { v[j] = xr[64 * j]; ss += v[j].x * v[j].x + v[j].y * v[j].y + v[j].z * v[j].z + v[j].w * v[j].w; }
        ss = wave_sum(ss);
        const float rstd = rsqrtf(ss * (1.f / D) + EPS);
        f32x4* o = (f32x4*)(a.out + (size_t)orow * D) + lane;
#pragma unroll
        for (int j = 0; j < 4; ++j) o[64 * j] = v[j] * rstd * gn[64 * j];
    }
}

__global__ void __launch_bounds__(NWAVES * 64, 2) fwd_kernel(Args a) {
    extern __shared__ __attribute__((aligned(16))) unsigned char lds_raw[];
    LAS unsigned char* lds = (LAS unsigned char*)lds_raw;
    volatile LAS unsigned* MISC = (volatile LAS unsigned*)(lds + LDS_BYTES - 256);
    const int tid = threadIdx.x;
    const int G = gridDim.x; const int bx = blockIdx.x;
    const int wk = (G % 8 == 0) ? (bx % 8) * (G / 8) + bx / 8 : bx;
    if (tid < 64) MISC[tid] = 0u;
    __syncthreads();
    XcdBarrier bar; bar.bar = (unsigned*)(a.ws + WS_CTL) + CW_BAR; bar.x = 0; bar.st = nullptr;
    if (N_LAUNCHES == 1) bar = xcd_barrier_post((unsigned*)(a.ws + WS_CTL) + CW_BAR, MISC + 8);
    const int lo = a.ph_lo, hi = a.ph_hi;
#ifndef PH_MASK
#define PH_MASK 0xFFFF
#endif
#define IN(k) (((PH_MASK >> (k)) & 1) && lo <= (k) && (k) < hi)
#define SEAM(k) do { if (IN(k) && IN((k) + 1)) xcd_barrier(bar); } while (0)
    if (IN(0)) { ph_prep(a, lds, wk, G); } SEAM(0);
    if (IN(1)) { ph_gemm1_pg8(a, lds, G); } SEAM(1);
    if (IN(2)) { ph_mixers2(a, lds, wk, G); } SEAM(2);
    if (IN(3)) { ph_gemm2_pg8(a, lds, wk, G); } SEAM(3);
    if (IN(4)) { ph_router(a, lds, 0, wk, G); } SEAM(4);
    if (IN(5)) { ph_moe_up_pg8(a, lds, 0, G); } SEAM(5);
    if (IN(6)) { ph_moe_down_pg8(a, lds, 0, G); } SEAM(6);
    if (IN(7)) { ph_rstd2(a, lds, wk, G); } SEAM(7);
    if (IN(8)) { ph_pooled(a, wk, G); } SEAM(8);
    if (IN(9)) { ph_poolgemm_pg8(a, lds, G); } SEAM(9);
    if (IN(10)) { ph_router(a, lds, 1, wk, G); } SEAM(10);
    if (IN(11)) { ph_moe_up_pg8(a, lds, 1, G); } SEAM(11);
    if (IN(12)) { ph_moe_down_pg8(a, lds, 1, G); } SEAM(12);
    if (IN(13)) { ph_final(a, wk, G); }
#undef IN
#undef SEAM
}

extern "C" void kernel_launch(void* const* d_in, const int* in_sizes, int n_in, void* d_out, int out_size, void* d_ws, size_t ws_size, hipStream_t stream) {
    static int grid = 0;
    if (grid == 0) {
        if (n_in != 31 || out_size != NB * SEQ * D || ws_size < WS_END) { fprintf(stderr, "kernel_launch: unexpected shapes (n_in %d out %d ws %zu)\n", n_in, out_size, ws_size); grid = -1; return; }
        int dev = 0, cus = 0;
        if (hipGetDevice(&dev) != hipSuccess || hipDeviceGetAttribute(&cus, hipDeviceAttributeMultiprocessorCount, dev) != hipSuccess) { grid = -1; return; }
        if (hipFuncSetAttribute((const void*)fwd_kernel, hipFuncAttributeMaxDynamicSharedMemorySize, LDS_BYTES) != hipSuccess) { grid = -1; return; }
        grid = cus;
    }
    if (grid < 0) return;
    (void)hipMemsetAsync((char*)d_ws + WS_CTL, 0, CTL_ZERO_BYTES, stream);
    Args a{};
    for (int i = 0; i < 31; ++i) a.in[i] = (const float*)d_in[i];
    a.out = (float*)d_out; a.ws = (unsigned char*)d_ws;
    if (N_LAUNCHES == 1) { a.ph_lo = 0; a.ph_hi = NPH; hipLaunchKernelGGL(fwd_kernel, dim3(grid), dim3(NWAVES * 64), LDS_BYTES, stream, a); }
    else for (int p = 0; p < NPH; ++p) { a.ph_lo = p; a.ph_hi = p + 1; hipLaunchKernelGGL(fwd_kernel, dim3(grid), dim3(NWAVES * 64), LDS_BYTES, stream, a); }
}
```

```cpp
#include <hip/hip_runtime.h>
#include <cstdio>
#include <cstdint>

#define GAS __attribute__((address_space(1)))
#define LAS __attribute__((address_space(3)))
typedef unsigned short bf16;
typedef short bf16x8 __attribute__((ext_vector_type(8)));
typedef float f32x4 __attribute__((ext_vector_type(4)));
typedef unsigned v4u __attribute__((ext_vector_type(4)));
typedef unsigned v2u __attribute__((ext_vector_type(2)));

#ifndef MK_N_LAUNCHES
#define MK_N_LAUNCHES 1
#endif
constexpr int NPH = 14;
constexpr int N_LAUNCHES = MK_N_LAUNCHES;

constexpr int NB = 8, SEQ = 2048, NMETA = 16, LSEQ = SEQ + NMETA, T = NB * LSEQ, D = 1024;
constexpr int PROJ_SRC = 4624, LDP = 4608;
constexpr int C_Z = 0, C_G = 1024, C_X = 2048, C_B = 3072, C_C = 3328, C_LI = 3584;
constexpr float EPS = 1e-6f;
constexpr int NBK = 24;

constexpr size_t MiB = 1u << 20;
constexpr size_t WS_CTL = 0, CTL_ZERO_BYTES = 1 * MiB;
constexpr size_t WS_WIN = 1 * MiB;
constexpr size_t WS_WOUT = 10 * MiB;
constexpr size_t WS_WPOOL = 14 * MiB;
constexpr size_t WS_WRT = 14 * MiB + 512 * 1024;
constexpr size_t WS_RSTD0 = 15 * MiB;
constexpr size_t WS_RSTD1 = WS_RSTD0 + 128 * 1024;
constexpr size_t WS_BKT = WS_RSTD1 + 128 * 1024;
constexpr size_t WS_GATES = WS_BKT + 128 * 1024;
constexpr size_t WS_DT = 16 * MiB;
constexpr size_t WS_SSDSQ = 17 * MiB + 64 * 1024;
constexpr size_t WS_LIST = 19 * MiB;
constexpr size_t WS_WGU = 21 * MiB;
constexpr size_t WS_WD = 53 * MiB;
constexpr size_t WS_H = 69 * MiB;
constexpr size_t WS_PROJ = 134 * MiB;
constexpr size_t WS_HID = WS_PROJ;
constexpr size_t WS_POOLED = WS_PROJ;
constexpr size_t WS_END = 280 * MiB;
constexpr size_t WS_WGU1 = WS_PROJ + 64 * MiB, WS_WD1 = WS_PROJ + 96 * MiB;
__host__ __device__ constexpr size_t ws_wgu(int L) { return L ? WS_WGU1 : WS_WGU; }
__host__ __device__ constexpr size_t ws_wd(int L) { return L ? WS_WD1 : WS_WD; }
static_assert(WS_H + (size_t)T * D * 4 <= WS_PROJ && WS_PROJ + (size_t)T * LDP * 2 <= WS_END, "ws map");
static_assert(WS_DT + (size_t)T * 16 * 4 <= WS_SSDSQ && WS_SSDSQ + (size_t)T * 16 * 4 <= WS_LIST && WS_LIST + (size_t)NBK * T * 4 <= WS_WGU, "ws map small");
constexpr int CW_CNT = 8192;
constexpr int CW_BAR = 4096;

constexpr int LDS_BYTES = 147456;
constexpr int NWAVES = 8;

struct Args { const float* in[31]; float* out; unsigned char* ws; int ph_lo, ph_hi; };
enum { I_X = 0, I_META, I_NORMF, I_MNE, I_WIN, I_SCW, I_SCB, I_DTB, I_ALOG, I_SD, I_SNORM, I_LCW, I_LCB, I_LWA, I_LBA, I_LWX, I_LBX, I_LLAM, I_WOUT,
       I_MNO, I_PW, I_PB, I_PS, I_FFN, I_RGW, I_RGB, I_REW, I_REB, I_EWG, I_EWU, I_EWD };

#define LDS_WAIT() asm volatile("s_waitcnt lgkmcnt(0)" ::: "memory")
__device__ __forceinline__ float bf2f(unsigned v) { return __uint_as_float(v << 16); }
__device__ __forceinline__ unsigned f2bf(float f) { unsigned u = __float_as_uint(f); return (u + 0x7fffu + ((u >> 16) & 1u)) >> 16; }
__device__ __forceinline__ unsigned pk2(float lo, float hi) { return f2bf(lo) | (f2bf(hi) << 16); }
__device__ __forceinline__ float wave_sum(float v) {
#pragma unroll
    for (int o = 1; o < 64; o <<= 1) v += __shfl_xor(v, o);
    return v;
}
__device__ __forceinline__ float sigmoid_f(float v) { return 1.f / (1.f + __expf(-v)); }
__device__ __forceinline__ float silu_f(float v) { return v / (1.f + __expf(-v)); }
__device__ __forceinline__ float softplus_f(float v) { return v > 20.f ? v : log1pf(__expf(v)); }
__device__ __forceinline__ float gelu_tanh_f(float v) { const float u = 0.7978845608028654f * (v + 0.044715f * v * v * v); return 0.5f * v * (1.f + tanhf(u)); }
__device__ __forceinline__ const float* h0_row(const Args& a, int row) {
    const int b = row / LSEQ, l = row - b * LSEQ;
    return l < NMETA ? a.in[I_META] + (size_t)l * D : a.in[I_X] + ((size_t)b * SEQ + (l - NMETA)) * D;
}

#define XB_TMO      128
#define XB_XCNT(j)  (256  + 64 * (j))
#define XB_XSUB(j)  (1280 + 64 * (j))
#define XB_XGEN(j)  (2304 + 64 * (j))
#define XB_TOP      3328
#define XB_TOPGEN   3392
#define XCD_BAR_WORDS 3456
#define XB_SPIN_CAP (1u << 18)
__device__ __forceinline__ unsigned xb_ld(unsigned* p)              { return __hip_atomic_load(p, __ATOMIC_RELAXED, __HIP_MEMORY_SCOPE_AGENT); }
__device__ __forceinline__ unsigned xb_add(unsigned* p, unsigned v) { return __hip_atomic_fetch_add(p, v, __ATOMIC_RELAXED, __HIP_MEMORY_SCOPE_AGENT); }
__device__ __forceinline__ unsigned xb_xcc_id() { return (unsigned)__builtin_amdgcn_s_getreg((3 << 11) | 20) & 0xFu; }
#define XB_SPIN(cond, bar) do { unsigned _sp = 0; while (cond) { __builtin_amdgcn_s_sleep(1); \
    if ((++_sp & 255u) == 0u) { if (xb_ld(&(bar)[XB_TMO])) break; if (_sp > XB_SPIN_CAP) { atomicAdd(&(bar)[XB_TMO], 1u); break; } } } } while (0)
struct XcdBarrier { unsigned* bar; unsigned x; volatile LAS unsigned* st; };
__device__ __forceinline__ XcdBarrier xcd_barrier_post(unsigned* bar, volatile LAS unsigned* st) {
    XcdBarrier b; b.bar = bar; b.x = xb_xcc_id(); b.st = st;
    if (threadIdx.x == 0) (void)xb_add(&bar[XB_XCNT(b.x)], 1u);
    return b;
}
__device__ __forceinline__ void xcd_barrier_complete(unsigned* bar, unsigned x, unsigned& nloc, unsigned& nx) {
    const unsigned G = gridDim.x * gridDim.y * gridDim.z;
    unsigned sum, cnt, mine, sp = 0u;
    for (;;) {
        sum = 0u; cnt = 0u; mine = 0u;
#pragma unroll
        for (unsigned j = 0; j < 16; ++j) { const unsigned c = xb_ld(&bar[XB_XCNT(j)]); sum += c; cnt += (c > 0u) ? 1u : 0u; mine = (j == x) ? c : mine; }
        if (sum == G) break;
        __builtin_amdgcn_s_sleep(1);
        if ((++sp & 255u) == 0u) { if (xb_ld(&bar[XB_TMO])) break; if (sp > XB_SPIN_CAP) { atomicAdd(&bar[XB_TMO], 1u); break; } }
    }
    nloc = mine > 0u ? mine : 1u; nx = cnt > 0u ? cnt : 1u;
}
__device__ __forceinline__ void xcd_barrier(const XcdBarrier& b) {
    asm volatile("s_waitcnt vmcnt(0)" ::: "memory");
    __syncthreads();
    if (threadIdx.x == 0) {
        unsigned* bar = b.bar;
        __builtin_amdgcn_s_waitcnt(0);
        unsigned nloc = b.st[0], nx = b.st[1];
        if (nloc == 0u) { xcd_barrier_complete(bar, b.x, nloc, nx); b.st[0] = nloc; b.st[1] = nx; }
        const unsigned old = xb_add(&bar[XB_XSUB(b.x)], 1u);
        const unsigned gen = old / nloc;
        if (old + 1u == (gen + 1u) * nloc) {
            __builtin_amdgcn_fence(__ATOMIC_RELEASE, "agent");
            asm volatile("s_waitcnt vmcnt(0)" ::: "memory");
            const unsigned og = xb_add(&bar[XB_TOP], 1u);
            const unsigned tg = og / nx;
            if (og + 1u == (tg + 1u) * nx) xb_add(&bar[XB_TOPGEN], 1u);
            else XB_SPIN(xb_ld(&bar[XB_TOPGEN]) == tg, bar);
            __builtin_amdgcn_fence(__ATOMIC_ACQUIRE, "agent");
            xb_add(&bar[XB_XGEN(b.x)], 1u);
            asm volatile("s_waitcnt vmcnt(0)" ::: "memory");
        } else {
            XB_SPIN(xb_ld(&bar[XB_XGEN(b.x)]) == gen, bar);
            __builtin_amdgcn_fence(__ATOMIC_ACQUIRE, "agent");
            asm volatile("s_waitcnt vmcnt(0)" ::: "memory");
        }
    }
    __syncthreads();
}

__device__ __forceinline__ void tr_item(const float* src, int ldsrc, const float* gain, bf16* dst, int lddst, LAS float* scr, int lane) {
    float tv[32];
#pragma unroll
    for (int i = 0; i < 32; ++i) { const int kk = 2 * i + (lane >> 5); tv[i] = src[(size_t)kk * ldsrc + (lane & 31)]; }
#pragma unroll
    for (int i = 0; i < 32; ++i) { const int kk = 2 * i + (lane >> 5); float v = tv[i]; if (gain) v *= gain[kk]; scr[kk * 33 + (lane & 31)] = v; }
    LDS_WAIT();
    const int c = lane & 7;
#pragma unroll
    for (int j = 0; j < 4; ++j) { const int n = (lane >> 3) + 8 * j; const LAS float* s = scr + (8 * c) * 33 + n;
        v4u o; o.x = pk2(s[0 * 33], s[1 * 33]); o.y = pk2(s[2 * 33], s[3 * 33]); o.z = pk2(s[4 * 33], s[5 * 33]); o.w = pk2(s[6 * 33], s[7 * 33]);
        *(v4u*)(dst + (size_t)n * lddst + 8 * c) = o; }
    LDS_WAIT();
}
__device__ __forceinline__ void convert_experts(const Args& a, int L, LAS float* scr, int gw, int NGW, int lane) {
    bf16* WGU = (bf16*)(a.ws + ws_wgu(L)); bf16* WD = (bf16*)(a.ws + ws_wd(L));
    const float* gain = a.in[I_FFN] + L * D;
    constexpr int I_GU = 16 * 16 * 16, I_DN = 16 * 8 * 32;
    for (int it = gw; it < 2 * I_GU + I_DN; it += NGW) {
        int r = it;
        if (r < 2 * I_GU) {
            const int up = r >= I_GU; if (up) r -= I_GU;
            const int e = r >> 8, kb = (r >> 4) & 15, nb = r & 15;
            const float* src = a.in[up ? I_EWU : I_EWG] + ((size_t)(L * 16 + e) * 1024 + kb * 64) * 512 + nb * 32;
            const int drow = e * 1024 + (nb >> 2) * 256 + (nb & 3) * 32 + (up ? 128 : 0);
            tr_item(src, 512, gain + kb * 64, WGU + (size_t)drow * 1024 + kb * 64, 1024, scr, lane);
        } else {
            r -= 2 * I_GU;
            const int e = r >> 8, kb = (r >> 5) & 7, nb = r & 31;
            const float* src = a.in[I_EWD] + ((size_t)(L * 16 + e) * 512 + kb * 64) * 1024 + nb * 32;
            tr_item(src, 1024, nullptr, WD + (size_t)(e * 1024 + nb * 32) * 512 + kb * 64, 512, scr, lane);
        }
    }
}
__device__ __forceinline__ void ph_prep(const Args& a, LAS unsigned char* lds, int wk, int nwk) {
    const int tid = threadIdx.x, lane = tid & 63, wave = __builtin_amdgcn_readfirstlane(tid >> 6);
    const int gw = wk * NWAVES + wave, NGW = nwk * NWAVES;
    LAS float* wdt = (LAS float*)lds;
    LAS float* scr = (LAS float*)(lds + 65536 + wave * 8448);
    {
        const float* win = a.in[I_WIN]; const float* ge = a.in[I_MNE];
        for (int i = tid; i < 16 * 1024; i += 512) { const int k = i >> 4, j = i & 15; wdt[j * 1024 + k] = win[(size_t)k * PROJ_SRC + 2560 + j] * ge[k]; }
    }
    bf16* WIN = (bf16*)(a.ws + WS_WIN); bf16* WOUT = (bf16*)(a.ws + WS_WOUT); bf16* WPOOL = (bf16*)(a.ws + WS_WPOOL);
    constexpr int I_IN = 16 * 144, I_OUT = 32 * 32, I_POOL = 4 * 4 * 8;
    for (int it = gw; it < I_IN + I_OUT + I_POOL; it += NGW) {
        int r = it;
        if (r < I_IN) { const int kb = r / 144, nb = r % 144, n0 = nb * 32;
            const int sc = n0 < 1024 ? n0 : (n0 < 2048 ? n0 - 1024 + 2576 : (n0 < 3584 ? n0 - 2048 + 1024 : n0 - 3584 + 3600));
            tr_item(a.in[I_WIN] + (size_t)(kb * 64) * PROJ_SRC + sc, PROJ_SRC, a.in[I_MNE] + kb * 64, WIN + (size_t)n0 * 1024 + kb * 64, 1024, scr, lane); continue; }
        r -= I_IN;
        if (r < I_OUT) { const int kb = r >> 5, nb = r & 31;
            tr_item(a.in[I_WOUT] + (size_t)(kb * 64) * 1024 + nb * 32, 1024, kb < 16 ? a.in[I_SNORM] + kb * 64 : nullptr, WOUT + (size_t)(nb * 32) * 2048 + kb * 64, 2048, scr, lane); continue; }
        r -= I_OUT;
        { const int g = r >> 5, kb = (r >> 3) & 3, nb = r & 7;
            tr_item(a.in[I_PW] + (size_t)g * 65536 + (size_t)(kb * 64) * 256 + nb * 32, 256, a.in[I_MNO] + g * 256 + kb * 64, WPOOL + (size_t)(g * 256 + nb * 32) * 256 + kb * 64, 256, scr, lane); }
    }
    convert_experts(a, 0, scr, gw, NGW, lane);
    {
        float* WRT = (float*)(a.ws + WS_WRT);
        for (int i = wk * 512 + tid; i < 2 * 20 * 1024; i += nwk * 512) {
            const int L = i / 20480, r = i % 20480, j = r >> 10, k = r & 1023;
            const float w = j < 4 ? a.in[I_RGW][((size_t)L * 1024 + k) * 4 + j] : a.in[I_REW][((size_t)L * 1024 + k) * 16 + (j - 4)];
            WRT[i] = w * a.in[I_FFN][L * 1024 + k];
        }
    }
    __syncthreads();
    bf16* HB = (bf16*)a.out; float* RSTD0 = (float*)(a.ws + WS_RSTD0); float* DT = (float*)(a.ws + WS_DT);
    for (int row = gw; row < T; row += NGW) {
        const f32x4* xr = (const f32x4*)h0_row(a, row) + lane;
        f32x4 v[4]; float ss = 0.f;
#pragma unroll
        for (int j = 0; j < 4; ++j) { v[j] = xr[64 * j]; ss += v[j].x * v[j].x + v[j].y * v[j].y + v[j].z * v[j].z + v[j].w * v[j].w; }
        ss = wave_sum(ss);
        const float rstd = rsqrtf(ss * (1.f / D) + EPS);
        v2u* o8 = (v2u*)(HB + (size_t)row * D) + lane;
#pragma unroll
        for (int j = 0; j < 4; ++j) { v2u w; w.x = pk2(v[j].x, v[j].y); w.y = pk2(v[j].z, v[j].w); o8[64 * j] = w; }
        float mydt = 0.f;
#pragma unroll 2
        for (int jj = 0; jj < 16; ++jj) {
            float s = 0.f;
#pragma unroll
            for (int j = 0; j < 4; ++j) { const f32x4 w = *(const LAS f32x4*)(wdt + jj * 1024 + (lane + 64 * j) * 4); s += v[j].x * w.x + v[j].y * w.y + v[j].z * w.z + v[j].w * w.w; }
            s = wave_sum(s);
            if (lane == jj) mydt = s;
        }
        if (lane == 0) RSTD0[row] = rstd;
        if (lane < 16) DT[(size_t)row * 16 + lane] = softplus_f(mydt * rstd + a.in[I_DTB][lane]);
    }
}

template <int NT, class BP, class KS>
__device__ __forceinline__ void sg_kloop(int K, const bf16* const (&arow)[4], BP bp, KS ks, f32x4 (&acc)[4][NT], int fr, int fq) {
    for (int k0 = 0; k0 < K; k0 += 32) {
        ks(k0, acc);
        bf16x8 av[4], bv[NT];
#pragma unroll
        for (int mi = 0; mi < 4; ++mi) av[mi] = *(const bf16x8*)(arow[mi] + k0 + 8 * fq);
#pragma unroll
        for (int nj = 0; nj < NT; ++nj) bv[nj] = *(const bf16x8*)(bp(16 * nj + fr, k0) + 8 * fq);
#pragma unroll
        for (int mi = 0; mi < 4; ++mi)
#pragma unroll
            for (int nj = 0; nj < NT; ++nj) acc[mi][nj] = __builtin_amdgcn_mfma_f32_16x16x32_bf16(bv[nj], av[mi], acc[mi][nj], 0, 0, 0);
    }
}
template <int NT> __device__ __forceinline__ void zero_acc(f32x4 (&acc)[4][NT]) {
#pragma unroll
    for (int mi = 0; mi < 4; ++mi)
#pragma unroll
        for (int nj = 0; nj < NT; ++nj) acc[mi][nj] = (f32x4){0.f, 0.f, 0.f, 0.f};
}
struct NoKS { template <int NT> __device__ __forceinline__ void operator()(int, f32x4 (&)[4][NT]) const {} };

__device__ __forceinline__ void ph_gemm1(const Args& a, int wk, int nwk) {
    const int tid = threadIdx.x, lane = tid & 63, wave = __builtin_amdgcn_readfirstlane(tid >> 6), fr = lane & 15, fq = lane >> 4;
    const int gw = wk * NWAVES + wave, NGW = nwk * NWAVES;
    const bf16* HB = (const bf16*)a.out; const bf16* WIN = (const bf16*)(a.ws + WS_WIN); bf16* PROJ = (bf16*)(a.ws + WS_PROJ);
    const float* RSTD0 = (const float*)(a.ws + WS_RSTD0);
    for (int u = gw; u < 258 * 72; u += NGW) {
        const int rt = u / 72, ct = u % 72;
        const bf16* arow[4];
#pragma unroll
        for (int mi = 0; mi < 4; ++mi) arow[mi] = HB + (size_t)(rt * 64 + 16 * mi + fr) * D;
        f32x4 acc[4][4]; zero_acc(acc);
        sg_kloop<4>(1024, arow, [=](int n, int k0) { return WIN + (size_t)(ct * 64 + n) * 1024 + k0; }, NoKS(), acc, fr, fq);
#pragma unroll
        for (int mi = 0; mi < 4; ++mi) { const int row = rt * 64 + 16 * mi + fr; const float rs = RSTD0[row];
#pragma unroll
            for (int nj = 0; nj < 4; ++nj) { const f32x4 v = acc[mi][nj] * rs; v2u w; w.x = pk2(v.x, v.y); w.y = pk2(v.z, v.w);
                *(v2u*)(PROJ + (size_t)row * LDP + ct * 64 + 16 * nj + 4 * fq) = w; } }
    }
}

__device__ __forceinline__ void ph_gemm2(const Args& a, int wk, int nwk) {
    const int tid = threadIdx.x, lane = tid & 63, wave = __builtin_amdgcn_readfirstlane(tid >> 6), fr = lane & 15, fq = lane >> 4;
    const int gw = wk * NWAVES + wave, NGW = nwk * NWAVES;
    const bf16* PROJ = (const bf16*)(a.ws + WS_PROJ); const bf16* WOUT = (const bf16*)(a.ws + WS_WOUT);
    const float* SSDSQ = (const float*)(a.ws + WS_SSDSQ);
    float* H = (float*)(a.ws + WS_H); bf16* HB = (bf16*)a.out;
    for (int u = gw; u < 258 * 16; u += NGW) {
        const int rt = u / 16, ct = u % 16;
        const bf16* arow[4]; float f0[4], f1[4];
#pragma unroll
        for (int mi = 0; mi < 4; ++mi) { const int row = rt * 64 + 16 * mi + fr; arow[mi] = PROJ + (size_t)row * LDP;
            const f32x4* sq = (const f32x4*)(SSDSQ + (size_t)row * 16); const f32x4 q0 = sq[0], q1 = sq[1], q2 = sq[2], q3 = sq[3];
            const float s0 = (q0.x + q0.y + q0.z + q0.w) + (q1.x + q1.y + q1.z + q1.w), s1 = (q2.x + q2.y + q2.z + q2.w) + (q3.x + q3.y + q3.z + q3.w);
            const float r0 = rsqrtf(s0 * (1.f / 512.f) + EPS), r1 = rsqrtf(s1 * (1.f / 512.f) + EPS);
            f0[mi] = r0 / r1; f1[mi] = r1; }
        f32x4 acc[4][4]; zero_acc(acc);
        auto ks = [=](int k0, f32x4 (&ac)[4][4]) {
            if (k0 == 512) {
#pragma unroll
                for (int mi = 0; mi < 4; ++mi)
#pragma unroll
                    for (int nj = 0; nj < 4; ++nj) ac[mi][nj] *= f0[mi]; }
            if (k0 == 1024) {
#pragma unroll
                for (int mi = 0; mi < 4; ++mi)
#pragma unroll
                    for (int nj = 0; nj < 4; ++nj) ac[mi][nj] *= f1[mi]; }
        };
        sg_kloop<4>(2048, arow, [=](int n, int k0) { return WOUT + (size_t)(ct * 64 + n) * 2048 + k0; }, ks, acc, fr, fq);
#pragma unroll
        for (int mi = 0; mi < 4; ++mi) { const int row = rt * 64 + 16 * mi + fr; const float* hr = h0_row(a, row);
#pragma unroll
            for (int nj = 0; nj < 4; ++nj) { const int c = ct * 64 + 16 * nj + 4 * fq; const f32x4 v = acc[mi][nj] + *(const f32x4*)(hr + c);
                *(f32x4*)(H + (size_t)row * D + c) = v; v2u w; w.x = pk2(v.x, v.y); w.y = pk2(v.z, v.w); *(v2u*)(HB + (size_t)row * D + c) = w; } }
    }
}


namespace pg8 {
constexpr int BM = 256, BK = 64, HALF = 128, HTB = HALF * BK * 2, STAGE_BYTES = 8 * HTB, NXCD = 8, WGM = 8;
__host__ __device__ __forceinline__ int lds_byte(int r, int c) { const int st = (r >> 4) * 2 + (c >> 5), rr = r & 15, cc = c & 31, ob = rr * 64 + cc * 2; return st * 1024 + (ob ^ (((ob >> 9) & 1) << 5)); }
__host__ __device__ __forceinline__ void stage_rc(int b, int& R, int& C) { const int st = b / 1024, sb = b % 1024, swz = sb ^ (((sb >> 9) & 1) << 5); R = (st >> 1) * 16 + swz / 64; C = (st & 1) * 32 + (swz % 64) / 2; }
__host__ __device__ __forceinline__ int perm32(int rho) { const int n = rho >> 4, i = rho & 15; return 8 * (i >> 2) + 4 * n + (i & 3); }
__device__ __forceinline__ unsigned cvt_pk_bf16(float lo, float hi) { unsigned r; asm volatile("v_cvt_pk_bf16_f32 %0, %1, %2" : "=v"(r) : "v"(lo), "v"(hi)); return r; }
typedef f32x4 Acc[2][2][4][2];

__device__ __forceinline__ bool static_order(int nM, int nN, int G, int c, int i, int& pm, int& pn) {
    const int nwg = nM * nN; const long L = (long)i * G + c; if (L >= nwg) return false;
    int wgid = (int)L; { const int q = nwg / NXCD, r = nwg % NXCD, xcd = wgid % NXCD, off = wgid / NXCD; wgid = (xcd < r ? xcd * (q + 1) : r * (q + 1) + (xcd - r) * q) + off; }
    const int nig = WGM * nN, gid = wgid / nig, fm = gid * WGM, gsz = (nM - fm) < WGM ? (nM - fm) : WGM;
    pm = fm + ((wgid % nig) % gsz); pn = (wgid % nig) / gsz; return true;
}

template <class P, bool ALIGN_EPI>
__device__ __forceinline__ void gemm_phase(LAS unsigned char* lds, const P& S) {
    const int tid = threadIdx.x, wid = __builtin_amdgcn_readfirstlane(tid >> 6), lane = tid & 63, wr = wid >> 2, wc = wid & 3, fr = lane & 15, fq = lane >> 4;
    const int nt = S.nt;
    int RA[2], CA[2]; unsigned voffB[2];
#pragma unroll
    for (int i = 0; i < 2; ++i) { int R, C; stage_rc(tid * 16 + i * 8192, R, C); RA[i] = R; CA[i] = C; const int Rb = P::PERM ? ((R & ~31) + perm32(R & 31)) : R;
        voffB[i] = (unsigned)(Rb * S.ldb + C) * 2u; }
    const size_t kstep = (size_t)(BK * 2);
    const size_t hstepB = (size_t)HALF * S.ldb * 2;
    const unsigned ldsw = (unsigned)wid * 1024u;
    const int aoff = lds_byte(wr * 64 + fr, fq * 8), boff = lds_byte(wc * 32 + fr, fq * 8);
#define PG8_SA(b, h) (((b) * 2 + (h)) * HTB)
#define PG8_SB(b, h) ((4 + (b) * 2 + (h)) * HTB)
#define PG8_STAGE(bufoff, gbase, voff) do { _Pragma("unroll") for (int _i = 0; _i < 2; ++_i) \
        __builtin_amdgcn_global_load_lds((const unsigned*)((const char*)(gbase) + (voff)[_i]), (LAS unsigned*)(lds + (bufoff) + ldsw + _i * 8192), 16, 0, 0); } while (0)
#define PG8_LDA(dst, b, h) do { _Pragma("unroll") for (int m = 0; m < 4; ++m) _Pragma("unroll") for (int k = 0; k < 2; ++k) dst[m][k] = *(const LAS bf16x8*)(lds + PG8_SA(b, h) + aoff + m * 2048 + k * 1024); } while (0)
#define PG8_LDB(dst, b, h) do { _Pragma("unroll") for (int n = 0; n < 2; ++n) _Pragma("unroll") for (int k = 0; k < 2; ++k) dst[n][k] = *(const LAS bf16x8*)(lds + PG8_SB(b, h) + boff + n * 2048 + k * 1024); } while (0)
#define PG8_MMA(ai, bj, At, Bt) do { __builtin_amdgcn_s_setprio(1); _Pragma("unroll") for (int m = 0; m < 4; ++m) _Pragma("unroll") for (int n = 0; n < 2; ++n) _Pragma("unroll") for (int k = 0; k < 2; ++k) \
        acc[ai][bj][m][n] = __builtin_amdgcn_mfma_f32_16x16x32_bf16(Bt[n][k], At[m][k], acc[ai][bj][m][n], 0, 0, 0); __builtin_amdgcn_s_setprio(0); } while (0)
#define PG8_WAIT_V(n) asm volatile("s_waitcnt vmcnt(" #n ")" ::: "memory")
#define PG8_WAIT_L(n) asm volatile("s_waitcnt lgkmcnt(" #n ")" ::: "memory")
#define PG8_BAR __builtin_amdgcn_s_barrier()
#define PG8_SCHED __builtin_amdgcn_sched_barrier(0)
    typename P::Unit cur, nxt; int ui = 0;
    if (!S.next(0, cur)) return;
    f32x4 acc[2][2][4][2];
#pragma unroll
    for (int a = 0; a < 2; ++a)
#pragma unroll
        for (int b = 0; b < 2; ++b)
#pragma unroll
            for (int m = 0; m < 4; ++m)
#pragma unroll
                for (int n = 0; n < 2; ++n) acc[a][b][m][n] = (f32x4){0.f, 0.f, 0.f, 0.f};
    bf16x8 At[4][2], B0[2][2], B1[2][2];
    unsigned vA[4];
    S.avoff(cur, RA, CA, vA);
    const char* cA = S.abase(cur);
    {
        const char* b0 = S.btile(cur, 0); const char* b1 = S.btile(cur, 1);
        PG8_STAGE(PG8_SB(0, 0), b0, voffB); PG8_STAGE(PG8_SB(0, 1), b0 + hstepB, voffB); PG8_STAGE(PG8_SA(0, 0), cA, vA); PG8_STAGE(PG8_SA(0, 1), cA, vA + 2);
        if (wr == 1) PG8_BAR;
        PG8_WAIT_V(2); PG8_BAR;
        PG8_STAGE(PG8_SB(1, 0), b1, voffB); PG8_STAGE(PG8_SA(1, 0), cA + kstep, vA); PG8_STAGE(PG8_SB(1, 1), b1 + hstepB, voffB);
        PG8_WAIT_V(6); PG8_BAR;
    }
    for (;;) {
        const bool has_next = S.next(ui + 1, nxt);
        for (int t = 0; t < nt; t += 2) {
            const bool last = (t == nt - 2);
            const char* a1 = cA + (size_t)(t + 1) * kstep;
            S.khook(t, acc, cur, lds, wr, wc, fr, fq);
            PG8_LDB(B0, 0, 0); PG8_LDB(B1, 0, 1); PG8_SCHED; PG8_LDA(At, 0, 0); PG8_STAGE(PG8_SA(1, 1), a1, vA + 2);
            PG8_WAIT_V(8); PG8_WAIT_L(0); PG8_BAR; PG8_MMA(0, 0, At, B0); PG8_MMA(0, 1, At, B1); PG8_BAR; PG8_SCHED;
            const bool sw = last && has_next;
            if (sw) S.avoff(nxt, RA, CA, vA);
            const char* a2 = last ? (sw ? S.abase(nxt) : cA) : cA + (size_t)(t + 2) * kstep;
            const char* b2 = last ? (sw ? S.btile(nxt, 0) : S.btile(cur, 0)) : S.btile(cur, t + 2);
            const char* b3 = last ? (sw ? S.btile(nxt, 1) : S.btile(cur, 1)) : S.btile(cur, t + 3);
            const char* a3 = a2 + kstep;
            PG8_LDA(At, 0, 1); PG8_STAGE(PG8_SB(0, 0), b2, voffB); PG8_STAGE(PG8_SB(0, 1), b2 + hstepB, voffB); PG8_STAGE(PG8_SA(0, 0), a2, vA);
            PG8_WAIT_V(8); PG8_WAIT_L(0); PG8_BAR; PG8_MMA(1, 0, At, B0); PG8_MMA(1, 1, At, B1); PG8_BAR; PG8_SCHED;
            PG8_LDB(B0, 1, 0); PG8_LDB(B1, 1, 1); PG8_SCHED; PG8_LDA(At, 1, 0); PG8_STAGE(PG8_SA(0, 1), a2, vA + 2);
            PG8_WAIT_V(8); PG8_WAIT_L(0); PG8_BAR; PG8_MMA(0, 0, At, B0); PG8_MMA(0, 1, At, B1); PG8_BAR; PG8_SCHED;
            PG8_LDA(At, 1, 1); PG8_STAGE(PG8_SB(1, 0), b3, voffB); PG8_STAGE(PG8_SB(1, 1), b3 + hstepB, voffB); PG8_STAGE(PG8_SA(1, 0), a3, vA);
            PG8_WAIT_V(8); PG8_WAIT_L(0); PG8_BAR; PG8_MMA(1, 0, At, B0); PG8_MMA(1, 1, At, B1); PG8_BAR; PG8_SCHED;
        }
        if constexpr (ALIGN_EPI) { if (wr == 0) PG8_BAR; }
        S.epi(acc, cur, wr, wc, fr, fq);
        if (!has_next) break;
#pragma unroll
        for (int a = 0; a < 2; ++a)
#pragma unroll
            for (int b = 0; b < 2; ++b)
#pragma unroll
                for (int m = 0; m < 4; ++m)
#pragma unroll
                    for (int n = 0; n < 2; ++n) acc[a][b][m][n] = (f32x4){0.f, 0.f, 0.f, 0.f};
        cur = nxt; cA = S.abase(cur); ++ui;
        if constexpr (ALIGN_EPI) { if (wr == 1) PG8_BAR; }
    }
    PG8_WAIT_V(0);
    if constexpr (!ALIGN_EPI) { if (wr == 0) PG8_BAR; }
    PG8_BAR;
#undef PG8_SA
#undef PG8_SB
#undef PG8_STAGE
#undef PG8_LDA
#undef PG8_LDB
#undef PG8_MMA
#undef PG8_WAIT_V
#undef PG8_WAIT_L
#undef PG8_BAR
#undef PG8_SCHED
}
}

struct PGemm1 {
    static constexpr bool PERM = true;
    struct Unit { int pm, pn; };
    const char* A; const char* B; bf16* O; const float* rstd; int G, c; int ldb, nt;
    __device__ __forceinline__ bool next(int i, Unit& u) const { return pg8::static_order(65, 18, G, c, i, u.pm, u.pn); }
    __device__ __forceinline__ void avoff(const Unit& u, const int (&RA)[2], const int (&CA)[2], unsigned (&v)[4]) const {
#pragma unroll
        for (int h = 0; h < 2; ++h)
#pragma unroll
            for (int i = 0; i < 2; ++i) { int row = u.pm * 256 + h * 128 + RA[i]; row = row < T ? row : T - 1; v[h * 2 + i] = (unsigned)(row * D + CA[i]) * 2u; }
    }
    __device__ __forceinline__ const char* abase(const Unit&) const { return A; }
    __device__ __forceinline__ const char* btile(const Unit& u, int t) const { return B + ((size_t)u.pn * 256 * 1024 + (size_t)t * 64) * 2; }
    __device__ __forceinline__ void khook(int, pg8::Acc&, const Unit&, LAS unsigned char*, int, int, int, int) const {}
    __device__ __forceinline__ void epi(const pg8::Acc& acc, const Unit& u, int wr, int wc, int fr, int fq) const {
        const int row0 = u.pm * 256 + wr * 64 + fr, col0 = u.pn * 256 + wc * 32 + 8 * fq;
        float rsv[2][4];
#pragma unroll
        for (int ai = 0; ai < 2; ++ai)
#pragma unroll
            for (int m = 0; m < 4; ++m) { const int row = row0 + ai * 128 + m * 16; rsv[ai][m] = rstd[row < T ? row : T - 1]; }
#pragma unroll
        for (int ai = 0; ai < 2; ++ai)
#pragma unroll
            for (int m = 0; m < 4; ++m) { const int row = row0 + ai * 128 + m * 16;
                if (row < T) { const float rs = rsv[ai][m]; bf16* rowp = O + (size_t)row * LDP + col0;
#pragma unroll
                    for (int bj = 0; bj < 2; ++bj) { const f32x4 v0 = acc[ai][bj][m][0] * rs, v1 = acc[ai][bj][m][1] * rs;
                        v4u w; w.x = pg8::cvt_pk_bf16(v0[0], v0[1]); w.y = pg8::cvt_pk_bf16(v0[2], v0[3]); w.z = pg8::cvt_pk_bf16(v1[0], v1[1]); w.w = pg8::cvt_pk_bf16(v1[2], v1[3]);
                        *(v4u*)(rowp + bj * 128) = w; } } }
    }
};
__device__ __forceinline__ void ph_gemm1_pg8(const Args& a, LAS unsigned char* lds, int G) {
    PGemm1 S; S.A = (const char*)a.out; S.B = (const char*)(a.ws + WS_WIN); S.O = (bf16*)(a.ws + WS_PROJ); S.rstd = (const float*)(a.ws + WS_RSTD0);
    S.G = G; S.c = (int)blockIdx.x; S.ldb = 1024; S.nt = 16;
    pg8::gemm_phase<PGemm1, true>(lds, S);
}

__device__ __forceinline__ void ssd_item(const Args& a, LAS unsigned char* lds, int b, int h) {
    const int tid = threadIdx.x, lane = tid & 63;
    constexpr int TB = 64;
    LAS float* xs = (LAS float*)lds;
    LAS float* Bs = xs + TB * 64;
    LAS float* Cs = Bs + TB * 128;
    LAS float* ys = Cs + TB * 128;
    LAS float* dts = ys + TB * 64;
    LAS float* decs = dts + TB;
    bf16* PROJ = (bf16*)(a.ws + WS_PROJ); const float* DT = (const float*)(a.ws + WS_DT); float* SSDSQ = (float*)(a.ws + WS_SSDSQ);
    const int g = h >> 3;
    const float Ah = -__expf(a.in[I_ALOG][h]), Dh = a.in[I_SD][h];
    int ccol = 0, cch = 0; float cw0 = 0.f, cw1 = 0.f, cw2 = 0.f, cw3 = 0.f, cb = 0.f;
    if (tid < 320) {
        if (tid < 64) { ccol = C_X + h * 64 + tid; cch = h * 64 + tid; }
        else if (tid < 192) { ccol = C_B + g * 128 + (tid - 64); cch = 1024 + g * 128 + (tid - 64); }
        else { ccol = C_C + g * 128 + (tid - 192); cch = 1280 + g * 128 + (tid - 192); }
        const float* cw = a.in[I_SCW]; cw0 = cw[cch]; cw1 = cw[1536 + cch]; cw2 = cw[2 * 1536 + cch]; cw3 = cw[3 * 1536 + cch]; cb = a.in[I_SCB][cch];
    }
    const int p = tid >> 3, nq = tid & 7;
    float S[16];
#pragma unroll
    for (int i = 0; i < 16; ++i) S[i] = 0.f;
    const size_t rbase = (size_t)b * LSEQ;
    for (int l0 = 0; l0 < LSEQ; l0 += TB) {
        const int nt = (LSEQ - l0) < TB ? (LSEQ - l0) : TB;
        __syncthreads();
        if (tid < 320) {
            float r0 = l0 >= 3 ? bf2f(PROJ[(rbase + l0 - 3) * LDP + ccol]) : 0.f, r1 = l0 >= 2 ? bf2f(PROJ[(rbase + l0 - 2) * LDP + ccol]) : 0.f, r2 = l0 >= 1 ? bf2f(PROJ[(rbase + l0 - 1) * LDP + ccol]) : 0.f;
            for (int t = 0; t < nt; ++t) {
                const float r3 = bf2f(PROJ[(rbase + l0 + t) * LDP + ccol]);
                const float v = silu_f(cw0 * r0 + cw1 * r1 + cw2 * r2 + cw3 * r3 + cb);
                if (tid < 64) xs[t * 64 + tid] = v; else if (tid < 192) Bs[t * 128 + tid - 64] = v; else Cs[t * 128 + tid - 192] = v;
                r0 = r1; r1 = r2; r2 = r3;
            }
        } else if (tid < 320 + TB) {
            const int t = tid - 320;
            if (t < nt) { const float dt = DT[(rbase + l0 + t) * 16 + h]; dts[t] = dt; decs[t] = __expf(Ah * dt); }
        }
        __syncthreads();
        for (int t = 0; t < nt; ++t) {
            const float xv = xs[t * 64 + p], xdt = xv * dts[t], dec = decs[t];
            float yp = 0.f;
#pragma unroll
            for (int i = 0; i < 16; ++i) { S[i] = dec * S[i] + Bs[t * 128 + nq * 16 + i] * xdt; yp += Cs[t * 128 + nq * 16 + i] * S[i]; }
            yp += __shfl_xor(yp, 1); yp += __shfl_xor(yp, 2); yp += __shfl_xor(yp, 4);
            if (nq == 0) ys[t * 64 + p] = yp + Dh * xv;
        }
        __syncthreads();
        for (int t = tid >> 6; t < nt; t += 8) {
            const size_t row = rbase + l0 + t;
            const float z = bf2f(PROJ[row * LDP + C_Z + h * 64 + lane]);
            const float yg = ys[t * 64 + lane] * silu_f(z);
            PROJ[row * LDP + C_Z + h * 64 + lane] = (bf16)f2bf(yg);
            const float sq = wave_sum(yg * yg);
            if (lane == 0) SSDSQ[row * 16 + h] = sq;
        }
    }
    __syncthreads();
}
__device__ __forceinline__ void lru_item(const Args& a, LAS unsigned char* lds, int b, int h) {
    const int tid = threadIdx.x;
    constexpr int TB = 64;
    LAS float* Wa = (LAS float*)lds;
    LAS float* Wx = Wa + 4096;
    LAS float* xb = Wx + 4096;
    LAS float* as = xb + TB * 64;
    LAS float* us = as + TB * 64;
    bf16* PROJ = (bf16*)(a.ws + WS_PROJ);
    __syncthreads();
    for (int i = tid; i < 4096; i += 512) { Wa[i] = a.in[I_LWA][(size_t)h * 4096 + i]; Wx[i] = a.in[I_LWX][(size_t)h * 4096 + i]; }
    const size_t rbase = (size_t)b * LSEQ;
    float hprev = 0.f;
    const int c = tid & 63, tq = tid >> 6;
    const float* cw = a.in[I_LCW]; const int ch = h * 64 + c;
    const float cw0 = cw[ch], cw1 = cw[1024 + ch], cw2 = cw[2048 + ch], cw3 = cw[3072 + ch], cb = a.in[I_LCB][ch];
    const int gt = tid >> 3, jq = tid & 7;
    for (int l0 = 0; l0 < LSEQ; l0 += TB) {
        const int nt = (LSEQ - l0) < TB ? (LSEQ - l0) : TB;
        __syncthreads();
        for (int t = tq * 8; t < tq * 8 + 8; ++t) if (t < nt) {
            const int l = l0 + t; const size_t row = rbase + l;
            const float r3 = bf2f(PROJ[row * LDP + C_LI + ch]);
            const float r2 = l >= 1 ? bf2f(PROJ[(row - 1) * LDP + C_LI + ch]) : 0.f;
            const float r1 = l >= 2 ? bf2f(PROJ[(row - 2) * LDP + C_LI + ch]) : 0.f;
            const float r0 = l >= 3 ? bf2f(PROJ[(row - 3) * LDP + C_LI + ch]) : 0.f;
            xb[t * 64 + c] = cw0 * r0 + cw1 * r1 + cw2 * r2 + cw3 * r3 + cb;
        }
        __syncthreads();
        if (gt < nt) {
            float ra[8], ri[8];
#pragma unroll
            for (int j = 0; j < 8; ++j) { ra[j] = 0.f; ri[j] = 0.f; }
            for (int i = 0; i < 64; ++i) { const float xv = xb[gt * 64 + i];
#pragma unroll
                for (int j = 0; j < 8; ++j) { ra[j] += xv * Wa[i * 64 + jq * 8 + j]; ri[j] += xv * Wx[i * 64 + jq * 8 + j]; } }
#pragma unroll
            for (int j = 0; j < 8; ++j) { const int cc = h * 64 + jq * 8 + j;
                const float r = sigmoid_f(ra[j] + a.in[I_LBA][cc]), ig = sigmoid_f(ri[j] + a.in[I_LBX][cc]);
                const float log_a = -8.0f * r * softplus_f(-a.in[I_LLAM][cc]);
                const float av = __expf(log_a);
                const float mult = (l0 + gt == 0) ? 1.f : sqrtf(fmaxf(-expm1f(2.f * log_a), 0.f));
                as[gt * 64 + jq * 8 + j] = av; us[gt * 64 + jq * 8 + j] = mult * ig * xb[gt * 64 + jq * 8 + j]; }
        }
        __syncthreads();
        if (tid < 64) { for (int t = 0; t < nt; ++t) { hprev = as[t * 64 + tid] * hprev + us[t * 64 + tid]; us[t * 64 + tid] = hprev; } }
        __syncthreads();
        for (int t = tq * 8; t < tq * 8 + 8; ++t) if (t < nt) {
            const size_t row = rbase + l0 + t;
            const float gv = bf2f(PROJ[row * LDP + C_G + ch]);
            PROJ[row * LDP + C_G + ch] = (bf16)f2bf(us[t * 64 + c] * gelu_tanh_f(gv));
        }
    }
    __syncthreads();
}
__device__ __forceinline__ void ph_mixers(const Args& a, LAS unsigned char* lds, int wk, int nwk) {
    for (int it = wk; it < 256; it += nwk) {
        if (it < 128) ssd_item(a, lds, it >> 4, it & 15); else lru_item(a, lds, (it - 128) >> 4, (it - 128) & 15);
    }
}


__device__ __forceinline__ f32x4 mfma16(bf16x8 a, bf16x8 b, f32x4 c) { return __builtin_amdgcn_mfma_f32_16x16x32_bf16(a, b, c, 0, 0, 0); }
constexpr int RSX = 144, RSB = 272;
constexpr int SO_X = 0, SO_B = SO_X + 128 * RSX, SO_C = SO_B + 128 * RSB, SO_M = SO_C + 128 * RSB, SO_S = SO_M + 128 * RSB, SO_V = SO_S + 64 * RSB;
static_assert(SO_V + 4096 <= LDS_BYTES - 256, "ssd lds");
#define TR4(RS4, o0, o1, o2, o3, addr) do { v2u l0_, h0_, l1_, h1_, l2_, h2_, l3_, h3_; \
    asm volatile("ds_read_b64_tr_b16 %0, %8\n\tds_read_b64_tr_b16 %1, %8 offset:" #RS4 "\n\t" \
                 "ds_read_b64_tr_b16 %2, %8 offset:32\n\tds_read_b64_tr_b16 %3, %8 offset:" #RS4 "+32\n\t" \
                 "ds_read_b64_tr_b16 %4, %8 offset:64\n\tds_read_b64_tr_b16 %5, %8 offset:" #RS4 "+64\n\t" \
                 "ds_read_b64_tr_b16 %6, %8 offset:96\n\tds_read_b64_tr_b16 %7, %8 offset:" #RS4 "+96\n\ts_waitcnt lgkmcnt(0)" \
                 : "=&v"(l0_), "=&v"(h0_), "=&v"(l1_), "=&v"(h1_), "=&v"(l2_), "=&v"(h2_), "=&v"(l3_), "=&v"(h3_) : "v"(addr) : "memory"); \
    o0 = __builtin_bit_cast(bf16x8, (v4u){l0_.x, l0_.y, h0_.x, h0_.y}); o1 = __builtin_bit_cast(bf16x8, (v4u){l1_.x, l1_.y, h1_.x, h1_.y}); \
    o2 = __builtin_bit_cast(bf16x8, (v4u){l2_.x, l2_.y, h2_.x, h2_.y}); o3 = __builtin_bit_cast(bf16x8, (v4u){l3_.x, l3_.y, h3_.x, h3_.y}); } while (0)
#define TR1(RS4, o0, addr) do { v2u l0_, h0_; \
    asm volatile("ds_read_b64_tr_b16 %0, %2\n\tds_read_b64_tr_b16 %1, %2 offset:" #RS4 "\n\ts_waitcnt lgkmcnt(0)" : "=&v"(l0_), "=&v"(h0_) : "v"(addr) : "memory"); \
    o0 = __builtin_bit_cast(bf16x8, (v4u){l0_.x, l0_.y, h0_.x, h0_.y}); } while (0)
__device__ __forceinline__ void unpack8(const v4u r, float (&f)[8]) {
    f[0] = __uint_as_float(r.x << 16); f[1] = __uint_as_float(r.x & 0xffff0000u); f[2] = __uint_as_float(r.y << 16); f[3] = __uint_as_float(r.y & 0xffff0000u);
    f[4] = __uint_as_float(r.z << 16); f[5] = __uint_as_float(r.z & 0xffff0000u); f[6] = __uint_as_float(r.w << 16); f[7] = __uint_as_float(r.w & 0xffff0000u);
}
__device__ __forceinline__ void ph_conv(const Args& a, int wk, int nwk) {
    const bf16* PROJ = (const bf16*)(a.ws + WS_PROJ); bf16* XACT = (bf16*)(a.ws + WS_H); bf16* XLRU = (bf16*)a.out;
    for (int id = wk * 512 + (int)threadIdx.x; id < NB * 48 * 320; id += nwk * 512) {
        const int cg = id % 320, rr = id / 320, b = rr / 48, t0 = (rr % 48) * 43;
        const bool ssd = cg < 192; const int ch = ssd ? cg * 8 : (cg - 192) * 8;
        const float* cwp = ssd ? a.in[I_SCW] + ch : a.in[I_LCW] + ch; const int cst = ssd ? 1536 : 1024;
        float cw[4][8], cb[8];
#pragma unroll
        for (int k = 0; k < 4; ++k) { const f32x4 wa = *(const f32x4*)(cwp + k * cst), wb = *(const f32x4*)(cwp + k * cst + 4);
#pragma unroll
            for (int j = 0; j < 4; ++j) { cw[k][j] = wa[j]; cw[k][4 + j] = wb[j]; } }
        { const float* cbp = ssd ? a.in[I_SCB] + ch : a.in[I_LCB] + ch; const f32x4 wa = *(const f32x4*)cbp, wb = *(const f32x4*)(cbp + 4);
#pragma unroll
          for (int j = 0; j < 4; ++j) { cb[j] = wa[j]; cb[4 + j] = wb[j]; } }
        const size_t rb = (size_t)b * LSEQ;
        const bf16* src = PROJ + rb * LDP + 2048 + cg * 8;
        bf16* dst = ssd ? XACT + rb * 1536 + ch : XLRU + rb * 1024 + ch; const int dst_ld = ssd ? 1536 : 1024;
        float p0[8], p1[8], p2[8];
        {   v4u q0 = (v4u){0u, 0u, 0u, 0u}, q1 = q0, q2 = q0;
            if (t0 >= 3) { q0 = *(const v4u*)(src + (size_t)(t0 - 3) * LDP); q1 = *(const v4u*)(src + (size_t)(t0 - 2) * LDP); q2 = *(const v4u*)(src + (size_t)(t0 - 1) * LDP); }
            unpack8(q0, p0); unpack8(q1, p1); unpack8(q2, p2); }
#pragma unroll 4
        for (int t = 0; t < 43; ++t) {
            const int l = t0 + t; float p3[8]; unpack8(*(const v4u*)(src + (size_t)l * LDP), p3);
            float o[8];
#pragma unroll
            for (int j = 0; j < 8; ++j) { const float v = cw[0][j] * p0[j] + cw[1][j] * p1[j] + cw[2][j] * p2[j] + cw[3][j] * p3[j] + cb[j]; o[j] = ssd ? silu_f(v) : v; p0[j] = p1[j]; p1[j] = p2[j]; p2[j] = p3[j]; }
            v4u ov; ov.x = pk2(o[0], o[1]); ov.y = pk2(o[2], o[3]); ov.z = pk2(o[4], o[5]); ov.w = pk2(o[6], o[7]);
            *(v4u*)(dst + (size_t)l * dst_ld) = ov;
        }
    }
}
__device__ __forceinline__ void ssd_item3(const Args& a, LAS unsigned char* lds, int b, int h) {
    const int tid = threadIdx.x, lane = tid & 63, w = __builtin_amdgcn_readfirstlane(tid >> 6), fr = lane & 15, fq = lane >> 4;
    bf16* PROJ = (bf16*)(a.ws + WS_PROJ); const bf16* XACT = (const bf16*)(a.ws + WS_H); const float* DT = (const float*)(a.ws + WS_DT); float* SSDSQ = (float*)(a.ws + WS_SSDSQ);
    const int g = h >> 3;
    const float Ah = -__expf(a.in[I_ALOG][h]), Dh = a.in[I_SD][h];
    LAS float* acs = (LAS float*)(lds + SO_V); LAS float* dtv = acs + 128; LAS float* wv = acs + 256; LAS float* eacs = acs + 384;
    const size_t rbase = (size_t)b * LSEQ;
    const int pt_s = w & 3, nh = w >> 2;
    f32x4 sacc[4];
#pragma unroll
    for (int i = 0; i < 4; ++i) sacc[i] = (f32x4){0.f, 0.f, 0.f, 0.f};
    __syncthreads();
    for (int i = tid; i < 64 * RSB / 4; i += 512) ((LAS unsigned*)(lds + SO_S))[i] = 0u;
    v4u pf[10], zp[2]; float d0 = 0.f, d1 = 0.f;
    const int ft = tid >> 2, q4 = tid & 3;
    const int xr_ = tid >> 3, xp_ = tid & 7, br_ = tid >> 4, bp_ = tid & 15;
    const bf16* xsrc = XACT + (rbase + xr_) * 1536 + h * 64 + xp_ * 8;
    const bf16* bsrc = XACT + (rbase + br_) * 1536 + 1024 + g * 128 + bp_ * 8;
#define SSD_PREFETCH(L0) do { const int l0_ = (L0); \
        _Pragma("unroll") for (int i = 0; i < 2; ++i) { pf[i] = (v4u){0u, 0u, 0u, 0u}; if (l0_ + xr_ + 64 * i < LSEQ) pf[i] = *(const v4u*)(xsrc + (size_t)(l0_ + 64 * i) * 1536); } \
        _Pragma("unroll") for (int i = 0; i < 4; ++i) { pf[2 + i] = (v4u){0u, 0u, 0u, 0u}; pf[6 + i] = (v4u){0u, 0u, 0u, 0u}; \
            if (l0_ + br_ + 32 * i < LSEQ) { pf[2 + i] = *(const v4u*)(bsrc + (size_t)(l0_ + 32 * i) * 1536); pf[6 + i] = *(const v4u*)(bsrc + (size_t)(l0_ + 32 * i) * 1536 + 256); } } \
        zp[0] = (v4u){0u, 0u, 0u, 0u}; zp[1] = zp[0]; \
        if (l0_ + ft < LSEQ) { const bf16* zq = PROJ + (rbase + l0_ + ft) * LDP + C_Z + h * 64 + 16 * q4; zp[0] = *(const v4u*)zq; zp[1] = *(const v4u*)(zq + 8); } \
        if (w == 0) { d0 = (l0_ + lane) < LSEQ ? DT[(rbase + l0_ + lane) * 16 + h] : 0.f; d1 = (l0_ + lane + 64) < LSEQ ? DT[(rbase + l0_ + lane + 64) * 16 + h] : 0.f; } } while (0)
    SSD_PREFETCH(0);
    for (int l0 = 0; l0 < LSEQ; l0 += 128) {
        const int nvalid = (LSEQ - l0) < 128 ? (LSEQ - l0) : 128;
#pragma unroll
        for (int i = 0; i < 2; ++i) *(LAS v4u*)(lds + SO_X + (xr_ + 64 * i) * RSX + xp_ * 16) = pf[i];
#pragma unroll
        for (int i = 0; i < 4; ++i) { *(LAS v4u*)(lds + SO_B + (br_ + 32 * i) * RSB + bp_ * 16) = pf[2 + i]; *(LAS v4u*)(lds + SO_C + (br_ + 32 * i) * RSB + bp_ * 16) = pf[6 + i]; }
        const v4u z0 = zp[0], z1 = zp[1];
        if (w == 0) {
            float a0 = Ah * d0, a1 = Ah * d1;
#pragma unroll
            for (int o = 1; o < 64; o <<= 1) { const float v0 = __shfl_up(a0, o), v1 = __shfl_up(a1, o); if (lane >= o) { a0 += v0; a1 += v1; } }
            a1 += __shfl(a0, 63);
            const float aend = __shfl(a1, 63);
            acs[lane] = a0; acs[lane + 64] = a1; dtv[lane] = d0; dtv[lane + 64] = d1;
            wv[lane] = __expf(aend - a0) * d0; wv[lane + 64] = __expf(aend - a1) * d1; eacs[lane] = __expf(a0); eacs[lane + 64] = __expf(a1);
            if (lane == 0) acs[512] = aend;
        }
        __syncthreads();
        if (l0 + 128 < LSEQ) SSD_PREFETCH(l0 + 128);
        for (int hh = 0; hh < 2; ++hh) {
            f32x4 gacc[4];
#pragma unroll
            for (int st = 0; st < 4; ++st) gacc[st] = (f32x4){0.f, 0.f, 0.f, 0.f};
#pragma unroll
            for (int k0 = 0; k0 < 128; k0 += 32) {
                const bf16x8 cf = *(const LAS bf16x8*)(lds + SO_C + (16 * w + fr) * RSB + (k0 + 8 * fq) * 2);
#pragma unroll
                for (int st = 0; st < 4; ++st) { const bf16x8 bf = *(const LAS bf16x8*)(lds + SO_B + (16 * (4 * hh + st) + fr) * RSB + (k0 + 8 * fq) * 2); gacc[st] = mfma16(bf, cf, gacc[st]); }
            }
            const int l = 16 * w + fr; const float al = acs[l];
#pragma unroll
            for (int st = 0; st < 4; ++st) {
                const int s0 = 16 * (4 * hh + st) + 4 * fq; const f32x4 as = *(const LAS f32x4*)(acs + s0), ds = *(const LAS f32x4*)(dtv + s0);
                float m[4];
#pragma unroll
                for (int j = 0; j < 4; ++j) m[j] = (s0 + j <= l) ? gacc[st][j] * __expf(al - as[j]) * ds[j] : 0.f;
                v2u mv; mv.x = pk2(m[0], m[1]); mv.y = pk2(m[2], m[3]);
                *(LAS v2u*)(lds + SO_M + l * RSB + s0 * 2) = mv;
            }
        }
        __syncthreads();
        {
            f32x4 y[4];
#pragma unroll
            for (int pt = 0; pt < 4; ++pt) y[pt] = (f32x4){0.f, 0.f, 0.f, 0.f};
#pragma unroll
            for (int k0 = 0; k0 < 128; k0 += 32) {
                const bf16x8 cf = *(const LAS bf16x8*)(lds + SO_C + (16 * w + fr) * RSB + (k0 + 8 * fq) * 2);
#pragma unroll
                for (int pt = 0; pt < 4; ++pt) { const bf16x8 sf = *(const LAS bf16x8*)(lds + SO_S + (16 * pt + fr) * RSB + (k0 + 8 * fq) * 2); y[pt] = mfma16(cf, sf, y[pt]); }
                __builtin_amdgcn_sched_barrier(0);
            }
            const f32x4 ea = *(const LAS f32x4*)(eacs + 16 * w + 4 * fq);
#pragma unroll
            for (int pt = 0; pt < 4; ++pt) y[pt] *= ea;
            for (int k0 = 0; k0 <= 16 * w + 15; k0 += 32) {
                const bf16x8 mf = *(const LAS bf16x8*)(lds + SO_M + (16 * w + fr) * RSB + (k0 + 8 * fq) * 2);
                const unsigned xa = (unsigned)(size_t)(lds + SO_X) + (unsigned)((k0 + 8 * fq + (fr >> 2)) * RSX + (fr & 3) * 8);
                bf16x8 x0, x1, x2, x3; TR4(576, x0, x1, x2, x3, xa);
                y[0] = mfma16(mf, x0, y[0]); y[1] = mfma16(mf, x1, y[1]); y[2] = mfma16(mf, x2, y[2]); y[3] = mfma16(mf, x3, y[3]);
                __builtin_amdgcn_sched_barrier(0);
            }
#pragma unroll
            for (int pt = 0; pt < 4; ++pt)
#pragma unroll
                for (int r = 0; r < 4; ++r) *(LAS float*)(lds + SO_M + (16 * w + 4 * fq + r) * RSB + (16 * pt + fr) * 4) = y[pt][r];
        }
        {
            const float dec = __expf(acs[512]);
#pragma unroll
            for (int i = 0; i < 4; ++i) sacc[i] *= dec;
#pragma unroll
            for (int k0 = 0; k0 < 128; k0 += 32) {
                const unsigned xa = (unsigned)(size_t)(lds + SO_X) + (unsigned)((k0 + 8 * fq + (fr >> 2)) * RSX + pt_s * 32 + (fr & 3) * 8);
                bf16x8 xf; TR1(576, xf, xa);
                const f32x4 w0 = *(const LAS f32x4*)(wv + k0 + 8 * fq), w1 = *(const LAS f32x4*)(wv + k0 + 8 * fq + 4);
                float xv[8]; unpack8(__builtin_bit_cast(v4u, xf), xv);
                v4u xs; xs.x = pk2(xv[0] * w0[0], xv[1] * w0[1]); xs.y = pk2(xv[2] * w0[2], xv[3] * w0[3]); xs.z = pk2(xv[4] * w1[0], xv[5] * w1[1]); xs.w = pk2(xv[6] * w1[2], xv[7] * w1[3]);
                const bf16x8 xw = __builtin_bit_cast(bf16x8, xs);
                const unsigned ba = (unsigned)(size_t)(lds + SO_B) + (unsigned)((k0 + 8 * fq + (fr >> 2)) * RSB + nh * 128 + (fr & 3) * 8);
                bf16x8 b0, b1, b2, b3; TR4(1088, b0, b1, b2, b3, ba);
                sacc[0] = mfma16(xw, b0, sacc[0]); sacc[1] = mfma16(xw, b1, sacc[1]); sacc[2] = mfma16(xw, b2, sacc[2]); sacc[3] = mfma16(xw, b3, sacc[3]);
                __builtin_amdgcn_sched_barrier(0);
            }
        }
        __syncthreads();
#pragma unroll
        for (int i = 0; i < 4; ++i)
#pragma unroll
            for (int r = 0; r < 4; ++r) *(LAS bf16*)(lds + SO_S + (16 * pt_s + 4 * fq + r) * RSB + (16 * (4 * nh + i) + fr) * 2) = (bf16)f2bf(sacc[i][r]);
        if (ft < nvalid) {
            const size_t row = rbase + l0 + ft;
            bf16* zq = PROJ + row * LDP + C_Z + h * 64 + 16 * q4;
            const v4u x0 = *(const LAS v4u*)(lds + SO_X + ft * RSX + q4 * 32), x1 = *(const LAS v4u*)(lds + SO_X + ft * RSX + q4 * 32 + 16);
            float zf[16], xf[16], yo[16];
            { float tmp[8]; unpack8(z0, tmp);
#pragma unroll
              for (int j = 0; j < 8; ++j) zf[j] = tmp[j];
              unpack8(z1, tmp);
#pragma unroll
              for (int j = 0; j < 8; ++j) zf[8 + j] = tmp[j];
              unpack8(x0, tmp);
#pragma unroll
              for (int j = 0; j < 8; ++j) xf[j] = tmp[j];
              unpack8(x1, tmp);
#pragma unroll
              for (int j = 0; j < 8; ++j) xf[8 + j] = tmp[j]; }
            float sq = 0.f;
#pragma unroll
            for (int j4 = 0; j4 < 4; ++j4) { const f32x4 yv = *(const LAS f32x4*)(lds + SO_M + ft * RSB + (16 * q4 + 4 * j4) * 4);
#pragma unroll
                for (int j = 0; j < 4; ++j) { const float v = (yv[j] + Dh * xf[4 * j4 + j]) * silu_f(zf[4 * j4 + j]); yo[4 * j4 + j] = v; sq += v * v; } }
            v4u o0, o1; o0.x = pk2(yo[0], yo[1]); o0.y = pk2(yo[2], yo[3]); o0.z = pk2(yo[4], yo[5]); o0.w = pk2(yo[6], yo[7]);
            o1.x = pk2(yo[8], yo[9]); o1.y = pk2(yo[10], yo[11]); o1.z = pk2(yo[12], yo[13]); o1.w = pk2(yo[14], yo[15]);
            *(v4u*)zq = o0; *(v4u*)(zq + 8) = o1;
            sq += __shfl_xor(sq, 1); sq += __shfl_xor(sq, 2);
            if (q4 == 0) SSDSQ[row * 16 + h] = sq;
        }
        __syncthreads();
    }
#undef SSD_PREFETCH
}
constexpr int LO_XB = 0, LO_XF = LO_XB + 128 * RSX, LO_A = LO_XF + 128 * 260, LO_U = LO_A + 128 * 260, LO_WA = LO_U + 128 * 260, LO_WX = LO_WA + 64 * RSX, LO_SC = LO_WX + 64 * RSX;
static_assert(LO_SC + 17 * 256 <= LDS_BYTES - 256, "lru lds");
__device__ __forceinline__ void lru_item3(const Args& a, LAS unsigned char* lds, int b, int h) {
    const int tid = threadIdx.x, lane = tid & 63, w = __builtin_amdgcn_readfirstlane(tid >> 6), fr = lane & 15, fq = lane >> 4;
    bf16* PROJ = (bf16*)(a.ws + WS_PROJ); const bf16* XLRU = (const bf16*)a.out;
    const size_t rbase = (size_t)b * LSEQ;
    LAS float* segP = (LAS float*)(lds + LO_SC); LAS float* segH = segP + 512; LAS float* carry = segH + 512;
    __syncthreads();
    for (int i = tid; i < 4096; i += 512) { const int ii = i >> 6, j = i & 63;
        *(LAS bf16*)(lds + LO_WA + j * RSX + ii * 2) = (bf16)f2bf(a.in[I_LWA][(size_t)h * 4096 + i]);
        *(LAS bf16*)(lds + LO_WX + j * RSX + ii * 2) = (bf16)f2bf(a.in[I_LWX][(size_t)h * 4096 + i]); }
    if (tid < 64) carry[tid] = 0.f;
    float gba[4], gbx[4], gsp[4];
#pragma unroll
    for (int jt = 0; jt < 4; ++jt) { const int c = h * 64 + 16 * jt + fr; gba[jt] = a.in[I_LBA][c]; gbx[jt] = a.in[I_LBX][c]; gsp[jt] = softplus_f(-a.in[I_LLAM][c]); }
    const int ft = tid >> 2, q4 = tid & 3;
    v4u xp[2], gp[2];
#define LRU_PREFETCH(L0) do { const int l0_ = (L0); \
        _Pragma("unroll") for (int i = 0; i < 2; ++i) { const int q = tid + 512 * i, row = q >> 3, pc = q & 7; xp[i] = (v4u){0u, 0u, 0u, 0u}; \
            if (l0_ + row < LSEQ) xp[i] = *(const v4u*)(XLRU + (rbase + l0_ + row) * 1024 + h * 64 + pc * 8); } \
        gp[0] = (v4u){0u, 0u, 0u, 0u}; gp[1] = gp[0]; \
        if (l0_ + ft < LSEQ) { const bf16* gq = PROJ + (rbase + l0_ + ft) * LDP + C_G + h * 64 + 16 * q4; gp[0] = *(const v4u*)gq; gp[1] = *(const v4u*)(gq + 8); } } while (0)
    LRU_PREFETCH(0);
    for (int l0 = 0; l0 < LSEQ; l0 += 128) {
        const int nvalid = (LSEQ - l0) < 128 ? (LSEQ - l0) : 128;
#pragma unroll
        for (int i = 0; i < 2; ++i) { const int q = tid + 512 * i, row = q >> 3, pc = q & 7;
            *(LAS v4u*)(lds + LO_XB + row * RSX + pc * 16) = xp[i];
            float xv[8]; unpack8(xp[i], xv);
#pragma unroll
            for (int j = 0; j < 8; ++j) *(LAS float*)(lds + LO_XF + row * 260 + (pc * 8 + j) * 4) = xv[j]; }
        const v4u g0 = gp[0], g1 = gp[1];
        __syncthreads();
        if (l0 + 128 < LSEQ) LRU_PREFETCH(l0 + 128);
        {
            f32x4 ga[4], gx[4];
#pragma unroll
            for (int jt = 0; jt < 4; ++jt) { ga[jt] = (f32x4){0.f, 0.f, 0.f, 0.f}; gx[jt] = ga[jt]; }
#pragma unroll
            for (int k0 = 0; k0 < 64; k0 += 32) {
                const bf16x8 xf = *(const LAS bf16x8*)(lds + LO_XB + (16 * w + fr) * RSX + (k0 + 8 * fq) * 2);
#pragma unroll
                for (int jt = 0; jt < 4; ++jt) {
                    const bf16x8 wa = *(const LAS bf16x8*)(lds + LO_WA + (16 * jt + fr) * RSX + (k0 + 8 * fq) * 2), wx = *(const LAS bf16x8*)(lds + LO_WX + (16 * jt + fr) * RSX + (k0 + 8 * fq) * 2);
                    ga[jt] = mfma16(xf, wa, ga[jt]); gx[jt] = mfma16(xf, wx, gx[jt]); }
            }
#pragma unroll
            for (int jt = 0; jt < 4; ++jt)
#pragma unroll
                for (int r = 0; r < 4; ++r) { const int l = 16 * w + 4 * fq + r, j = 16 * jt + fr;
                    const float rr = sigmoid_f(ga[jt][r] + gba[jt]), ig = sigmoid_f(gx[jt][r] + gbx[jt]);
                    const float log_a = -8.0f * rr * gsp[jt];
                    const float av = __expf(log_a);
                    const float mult = (l0 + l == 0) ? 1.f : sqrtf(fmaxf(-expm1f(2.f * log_a), 0.f));
                    const float xv = *(const LAS float*)(lds + LO_XF + l * 260 + j * 4);
                    *(LAS float*)(lds + LO_A + l * 260 + j * 4) = av; *(LAS float*)(lds + LO_U + l * 260 + j * 4) = mult * ig * xv; }
        }
        __syncthreads();
        {
            float P = 1.f, Hl = 0.f;
#pragma unroll
            for (int t = 0; t < 16; ++t) { const float av = *(const LAS float*)(lds + LO_A + (16 * w + t) * 260 + lane * 4), uv = *(const LAS float*)(lds + LO_U + (16 * w + t) * 260 + lane * 4); Hl = av * Hl + uv; P *= av; }
            segP[w * 64 + lane] = P; segH[w * 64 + lane] = Hl;
            __syncthreads();
            float hin = carry[lane];
            for (int s2 = 0; s2 < w; ++s2) hin = segP[s2 * 64 + lane] * hin + segH[s2 * 64 + lane];
#pragma unroll
            for (int t = 0; t < 16; ++t) { LAS float* up = (LAS float*)(lds + LO_U + (16 * w + t) * 260 + lane * 4); hin = *(const LAS float*)(lds + LO_A + (16 * w + t) * 260 + lane * 4) * hin + *up; *up = hin; }
            __syncthreads();
            if (w == 7) carry[lane] = hin;
        }
        if (ft < nvalid) {
            const size_t row = rbase + l0 + ft;
            bf16* gq = PROJ + row * LDP + C_G + h * 64 + 16 * q4;
            float gf[16], yo[16];
            { float tmp[8]; unpack8(g0, tmp);
#pragma unroll
              for (int j = 0; j < 8; ++j) gf[j] = tmp[j];
              unpack8(g1, tmp);
#pragma unroll
              for (int j = 0; j < 8; ++j) gf[8 + j] = tmp[j]; }
#pragma unroll
            for (int j = 0; j < 16; ++j) yo[j] = *(const LAS float*)(lds + LO_U + ft * 260 + (16 * q4 + j) * 4) * gelu_tanh_f(gf[j]);
            v4u o0, o1; o0.x = pk2(yo[0], yo[1]); o0.y = pk2(yo[2], yo[3]); o0.z = pk2(yo[4], yo[5]); o0.w = pk2(yo[6], yo[7]);
            o1.x = pk2(yo[8], yo[9]); o1.y = pk2(yo[10], yo[11]); o1.z = pk2(yo[12], yo[13]); o1.w = pk2(yo[14], yo[15]);
            *(v4u*)gq = o0; *(v4u*)(gq + 8) = o1;
        }
        __syncthreads();
    }
#undef LRU_PREFETCH
}
__device__ __forceinline__ void ph_mixers3(const Args& a, LAS unsigned char* lds, int wk, int nwk) {
    for (int it = wk; it < 256; it += nwk) if (it < 128) ssd_item3(a, lds, it >> 4, it & 15);
    for (int it = wk; it < 256; it += nwk) if (it >= 128) lru_item3(a, lds, (it - 128) >> 4, (it - 128) & 15);
}

__device__ __forceinline__ void ph_router(const Args& a, LAS unsigned char* lds, int L, int wk, int nwk) {
    const int tid = threadIdx.x, lane = tid & 63, wave = __builtin_amdgcn_readfirstlane(tid >> 6);
    const int gw = wk * NWAVES + wave, NGW = nwk * NWAVES;
    if (L == 0) { convert_experts(a, 1, (LAS float*)(lds + wave * 8448), gw, NGW, lane); }
    LAS float* wr = (LAS float*)lds;
    LAS int* lcnt = (LAS int*)(lds + 81920); LAS int* gbase = lcnt + 32; LAS int* rinfo = lcnt + 64;
    const float* WRT = (const float*)(a.ws + WS_WRT) + (size_t)L * 20480;
    __syncthreads();
    for (int i = tid; i < 20480 / 4; i += 512) ((LAS f32x4*)wr)[i] = ((const f32x4*)WRT)[i];
    if (tid < 32) lcnt[tid] = 0;
    __syncthreads();
    const float* H = (const float*)(a.ws + WS_H);
    float* RSTD1 = (float*)(a.ws + WS_RSTD1); float* GATES = (float*)(a.ws + WS_GATES); int* LIST = (int*)(a.ws + WS_LIST);
    unsigned* cnt = (unsigned*)(a.ws + WS_CTL) + CW_CNT + 1024 * L;
    const float* bg = a.in[I_RGB] + L * 4; const float* be = a.in[I_REB] + L * 16;
    int it = 0;
    for (int row = gw; row < T; row += NGW, ++it) {
        const f32x4* xr = (const f32x4*)(H + (size_t)row * D) + lane;
        f32x4 v[4]; float ss = 0.f;
#pragma unroll
        for (int j = 0; j < 4; ++j) { v[j] = xr[64 * j]; ss += v[j].x * v[j].x + v[j].y * v[j].y + v[j].z * v[j].z + v[j].w * v[j].w; }
        ss = wave_sum(ss);
        const float rstd = rsqrtf(ss * (1.f / D) + EPS);
        float mylg = 0.f;
#pragma unroll 2
        for (int jj = 0; jj < 20; ++jj) {
            float s = 0.f;
#pragma unroll
            for (int j = 0; j < 4; ++j) { const f32x4 w = *(const LAS f32x4*)(wr + jj * 1024 + (lane + 64 * j) * 4); s += v[j].x * w.x + v[j].y * w.y + v[j].z * w.z + v[j].w * w.w; }
            s = wave_sum(s);
            if (lane == jj) mylg = s;
        }
        mylg = mylg * rstd + (lane < 4 ? bg[lane & 3] : be[(lane - 4) & 15]);
        float lg[20];
#pragma unroll
        for (int jj = 0; jj < 20; ++jj) lg[jj] = __shfl(mylg, jj);
        int gs = 0; float gm = lg[0];
#pragma unroll
        for (int j = 1; j < 4; ++j) if (lg[j] > gm) { gm = lg[j]; gs = j; }
        const float pg = 1.f / (__expf(lg[0] - gm) + __expf(lg[1] - gm) + __expf(lg[2] - gm) + __expf(lg[3] - gm));
        float f[4];
#pragma unroll
        for (int i = 0; i < 4; ++i) f[i] = gs == 0 ? lg[4 + i] : (gs == 1 ? lg[8 + i] : (gs == 2 ? lg[12 + i] : lg[16 + i]));
        int i0 = 0; float m0 = f[0];
#pragma unroll
        for (int i = 1; i < 4; ++i) if (f[i] > m0) { m0 = f[i]; i0 = i; }
        int i1 = -1; float m1 = -3.0e38f;
#pragma unroll
        for (int i = 0; i < 4; ++i) if (i != i0 && f[i] > m1) { m1 = f[i]; i1 = i; }
        const float w0 = 1.f / (1.f + __expf(m1 - m0)), w1 = 1.f - w0;
        const int lo = i0 < i1 ? i0 : i1, hi = i0 < i1 ? i1 : i0;
        const float glo = pg * (i0 < i1 ? w0 : w1), ghi = pg * (i0 < i1 ? w1 : w0);
        const int pair = lo == 0 ? hi - 1 : (lo == 1 ? hi + 1 : 5);
        const int bk = gs * 6 + pair;
        if (lane == 0) {
            const int ls = __hip_atomic_fetch_add(lcnt + bk, 1, __ATOMIC_RELAXED, __HIP_MEMORY_SCOPE_WORKGROUP);
            rinfo[it * NWAVES + wave] = bk | (ls << 8);
            RSTD1[row] = rstd; GATES[(size_t)row * 2] = glo; GATES[(size_t)row * 2 + 1] = ghi;
        }
    }
    __syncthreads();
    if (tid < NBK) gbase[tid] = (int)atomicAdd(cnt + 32 * tid, (unsigned)lcnt[tid]);
    __syncthreads();
    it = 0;
    for (int row = gw; row < T; row += NGW, ++it)
        if (lane == 0) { const int info = rinfo[it * NWAVES + wave], bk = info & 255; LIST[(size_t)bk * T + gbase[bk] + (info >> 8)] = row; }
}

struct BkTab { int cnt[NBK], off[NBK], ust[NBK + 1]; };
__device__ __forceinline__ void bk_table(const Args& a, LAS unsigned char* lds, int L, int per_tile  ) {
    LAS int* tb = (LAS int*)lds;
    __syncthreads();
    if (threadIdx.x == 0) {
        const unsigned* cnt = (const unsigned*)(a.ws + WS_CTL) + CW_CNT + 1024 * L;
        int off = 0, us = 0;
        for (int i = 0; i < NBK; ++i) { const int c = (int)__hip_atomic_load(cnt + 32 * i, __ATOMIC_RELAXED, __HIP_MEMORY_SCOPE_AGENT);
            tb[i] = c; tb[NBK + i] = off; tb[2 * NBK + i] = us; off += (c + 255) & ~255; us += ((c + 63) >> 6) * per_tile; }
        tb[2 * NBK + NBK] = us;
    }
    __syncthreads();
}
__device__ __forceinline__ void bk_experts(int bk, int& elo, int& ehi) {
    const int g = bk / 6, pr = bk - g * 6;
    const int lo = pr < 3 ? 0 : (pr < 5 ? 1 : 2), hi = pr < 3 ? pr + 1 : (pr < 5 ? pr - 1 : 3);
    elo = g * 4 + lo; ehi = g * 4 + hi;
}
__device__ __forceinline__ void ph_moe_up(const Args& a, LAS unsigned char* lds, int L, int wk, int nwk) {
    const int tid = threadIdx.x, lane = tid & 63, wave = __builtin_amdgcn_readfirstlane(tid >> 6), fr = lane & 15, fq = lane >> 4;
    const int gw = wk * NWAVES + wave, NGW = nwk * NWAVES;
    bk_table(a, lds, L, 32);
    LAS int* tb = (LAS int*)lds;
    const bf16* HB = (const bf16*)a.out; const bf16* WGU = (const bf16*)(a.ws + WS_WGU); bf16* HID = (bf16*)(a.ws + WS_HID);
    const int* LIST = (const int*)(a.ws + WS_LIST); const float* RSTD1 = (const float*)(a.ws + WS_RSTD1); const float* GATES = (const float*)(a.ws + WS_GATES);
    const int nun = tb[2 * NBK + NBK];
    for (int u = gw; u < nun; u += NGW) {
        int bk = 0;
        for (int i = 1; i < NBK; ++i) if (u >= tb[2 * NBK + i]) bk = i;
        const int cnt = tb[bk], off = tb[NBK + bk], r = u - tb[2 * NBK + bk];
        const int rt = r >> 5, ek = (r >> 4) & 1, ct = r & 15;
        int elo, ehi; bk_experts(bk, elo, ehi); const int e = ek ? ehi : elo;
        const int c0 = ct * 32, brow = e * 1024 + (c0 >> 7) * 256 + (c0 & 127);
        const bf16* arow[4]; int tok[4];
#pragma unroll
        for (int mi = 0; mi < 4; ++mi) { int rr = rt * 64 + 16 * mi + fr; if (rr >= cnt) rr = cnt - 1; tok[mi] = LIST[(size_t)bk * T + rr]; arow[mi] = HB + (size_t)tok[mi] * D; }
        f32x4 acc[4][4]; zero_acc(acc);
        sg_kloop<4>(1024, arow, [=](int n, int k0) { return WGU + (size_t)(brow + (n < 32 ? n : n + 96)) * 1024 + k0; }, NoKS(), acc, fr, fq);
#pragma unroll
        for (int mi = 0; mi < 4; ++mi) { const int rr = rt * 64 + 16 * mi + fr;
            if (rr < cnt) { const float rs = RSTD1[tok[mi]], gt = GATES[(size_t)tok[mi] * 2 + ek];
#pragma unroll
                for (int nj = 0; nj < 2; ++nj) { const f32x4 gv = acc[mi][nj] * rs, uv = acc[mi][nj + 2] * rs; f32x4 hv;
                    hv.x = silu_f(gv.x) * uv.x * gt; hv.y = silu_f(gv.y) * uv.y * gt; hv.z = silu_f(gv.z) * uv.z * gt; hv.w = silu_f(gv.w) * uv.w * gt;
                    v2u w; w.x = pk2(hv.x, hv.y); w.y = pk2(hv.z, hv.w);
                    *(v2u*)(HID + (size_t)(off + rr) * 1024 + ek * 512 + c0 + 16 * nj + 4 * fq) = w; } } }
    }
}
__device__ __forceinline__ void ph_moe_down(const Args& a, LAS unsigned char* lds, int L, int wk, int nwk) {
    const int tid = threadIdx.x, lane = tid & 63, wave = __builtin_amdgcn_readfirstlane(tid >> 6), fr = lane & 15, fq = lane >> 4;
    const int gw = wk * NWAVES + wave, NGW = nwk * NWAVES;
    bk_table(a, lds, L, 16);
    LAS int* tb = (LAS int*)lds;
    const bf16* HID = (const bf16*)(a.ws + WS_HID); const bf16* WD = (const bf16*)(a.ws + WS_WD);
    float* H = (float*)(a.ws + WS_H); bf16* HB = (bf16*)a.out; const int* LIST = (const int*)(a.ws + WS_LIST);
    const int nun = tb[2 * NBK + NBK];
    for (int u = gw; u < nun; u += NGW) {
        int bk = 0;
        for (int i = 1; i < NBK; ++i) if (u >= tb[2 * NBK + i]) bk = i;
        const int cnt = tb[bk], off = tb[NBK + bk], r = u - tb[2 * NBK + bk];
        const int rt = r >> 4, ct = r & 15;
        int elo, ehi; bk_experts(bk, elo, ehi);
        const bf16* arow[4];
#pragma unroll
        for (int mi = 0; mi < 4; ++mi) arow[mi] = HID + (size_t)(off + rt * 64 + 16 * mi + fr) * 1024;
        f32x4 acc[4][4]; zero_acc(acc);
        sg_kloop<4>(1024, arow, [=](int n, int k0) { return WD + ((size_t)((k0 < 512 ? elo : ehi) * 1024 + ct * 64 + n)) * 512 + (k0 & 511); }, NoKS(), acc, fr, fq);
#pragma unroll
        for (int mi = 0; mi < 4; ++mi) { const int rr = rt * 64 + 16 * mi + fr;
            if (rr < cnt) { const int tok = LIST[(size_t)bk * T + rr];
#pragma unroll
                for (int nj = 0; nj < 4; ++nj) { const int c = ct * 64 + 16 * nj + 4 * fq; float* hp = H + (size_t)tok * D + c;
                    const f32x4 v = *(const f32x4*)hp + acc[mi][nj]; *(f32x4*)hp = v;
                    v2u w; w.x = pk2(v.x, v.y); w.y = pk2(v.z, v.w); *(v2u*)(HB + (size_t)tok * D + c) = w; } } }
    }
}


__device__ __forceinline__ void h_store(float* H, bf16* HB, int row, int col, const f32x4 v) {
    *(f32x4*)(H + (size_t)row * D + col) = v;
    v2u w; w.x = pg8::cvt_pk_bf16(v[0], v[1]); w.y = pg8::cvt_pk_bf16(v[2], v[3]); *(v2u*)(HB + (size_t)row * D + col) = w;
}
constexpr int LDS_TAB = 131072;

struct PGemm2 {
    static constexpr bool PERM = false;
    struct Unit { int pm, pn, ui; };
    const Args* ap; const char* A; const char* B; float* H; bf16* HB; int G, c; int ldb, nt;
    __device__ __forceinline__ bool next(int i, Unit& u) const { u.ui = i; return pg8::static_order(64, 4, G, c, i, u.pm, u.pn); }
    __device__ __forceinline__ void avoff(const Unit& u, const int (&RA)[2], const int (&CA)[2], unsigned (&v)[4]) const {
#pragma unroll
        for (int h = 0; h < 2; ++h)
#pragma unroll
            for (int i = 0; i < 2; ++i) { const int row = u.pm * 256 + h * 128 + RA[i]; v[h * 2 + i] = (unsigned)(row * LDP + CA[i]) * 2u; }
    }
    __device__ __forceinline__ const char* abase(const Unit&) const { return A; }
    __device__ __forceinline__ const char* btile(const Unit& u, int t) const { return B + ((size_t)u.pn * 256 * 2048 + (size_t)t * 64) * 2; }
    __device__ __forceinline__ void khook(int t, pg8::Acc& acc, const Unit& u, LAS unsigned char* lds, int wr, int wc, int fr, int fq) const {
        if (t == 8 || t == 16) {
            const LAS float* ft = (const LAS float*)(lds + LDS_TAB) + u.ui * 512 + (t == 16 ? 1 : 0);
#pragma unroll
            for (int ai = 0; ai < 2; ++ai)
#pragma unroll
                for (int m = 0; m < 4; ++m) { const float f = ft[(ai * 128 + wr * 64 + m * 16 + fr) * 2];
#pragma unroll
                    for (int bj = 0; bj < 2; ++bj)
#pragma unroll
                        for (int n = 0; n < 2; ++n) acc[ai][bj][m][n] *= f; }
        }
    }
    __device__ __forceinline__ void epi(const pg8::Acc& acc, const Unit& u, int wr, int wc, int fr, int fq) const {
        const int row0 = u.pm * 256 + wr * 64 + fr, col0 = u.pn * 256 + wc * 32 + 4 * fq;
#pragma unroll
        for (int ai = 0; ai < 2; ++ai)
#pragma unroll
            for (int m = 0; m < 4; ++m) { const int row = row0 + ai * 128 + m * 16; const float* hr = h0_row(*ap, row);
#pragma unroll
                for (int bj = 0; bj < 2; ++bj)
#pragma unroll
                    for (int n = 0; n < 2; ++n) { const int col = col0 + bj * 128 + n * 16; h_store(H, HB, row, col, acc[ai][bj][m][n] + *(const f32x4*)(hr + col)); } }
    }
};
__device__ __forceinline__ void ssd_factors(const float* SSDSQ, int row, float& f0, float& f1) {
    const f32x4* sq = (const f32x4*)(SSDSQ + (size_t)row * 16); const f32x4 q0 = sq[0], q1 = sq[1], q2 = sq[2], q3 = sq[3];
    const float s0 = (q0.x + q0.y + q0.z + q0.w) + (q1.x + q1.y + q1.z + q1.w), s1 = (q2.x + q2.y + q2.z + q2.w) + (q3.x + q3.y + q3.z + q3.w);
    const float r0 = rsqrtf(s0 * (1.f / 512.f) + EPS), r1 = rsqrtf(s1 * (1.f / 512.f) + EPS);
    f0 = r0 / r1; f1 = r1;
}
__device__ __forceinline__ void ph_gemm2_pg8(const Args& a, LAS unsigned char* lds, int wk, int G) {
    const int tid = threadIdx.x, lane = tid & 63, wave = __builtin_amdgcn_readfirstlane(tid >> 6), fr = lane & 15, fq = lane >> 4;
    const float* SSDSQ = (const float*)(a.ws + WS_SSDSQ);
    PGemm2 S; S.ap = &a; S.A = (const char*)(a.ws + WS_PROJ); S.B = (const char*)(a.ws + WS_WOUT); S.H = (float*)(a.ws + WS_H); S.HB = (bf16*)a.out;
    S.G = G; S.c = (int)blockIdx.x; S.ldb = 2048; S.nt = 32;
    {
        LAS float* ft = (LAS float*)(lds + LDS_TAB);
        PGemm2::Unit u;
        for (int i = 0; i < 4 && S.next(i, u); ++i)
            if (tid < 256) { float f0, f1; ssd_factors(SSDSQ, u.pm * 256 + tid, f0, f1); ft[i * 512 + tid * 2] = f0; ft[i * 512 + tid * 2 + 1] = f1; }
        __syncthreads();
    }
    pg8::gemm_phase<PGemm2, true>(lds, S);
    const bf16* PROJ = (const bf16*)(a.ws + WS_PROJ); const bf16* WOUT = (const bf16*)(a.ws + WS_WOUT);
    for (int tile = wk; tile < 32; tile += G) {
        const int rt = tile >> 4, ct = tile & 15, kb = wave * 256;
        const bf16* arow[4];
#pragma unroll
        for (int mi = 0; mi < 4; ++mi) arow[mi] = PROJ + (size_t)(16384 + rt * 64 + 16 * mi + fr) * LDP + kb;
        f32x4 acc[4][4]; zero_acc(acc);
        sg_kloop<4>(256, arow, [=](int n, int k0) { return WOUT + (size_t)(ct * 64 + n) * 2048 + kb + k0; }, NoKS(), acc, fr, fq);
        LAS float* part = (LAS float*)lds + wave * 4096;
        __syncthreads();
#pragma unroll
        for (int mi = 0; mi < 4; ++mi) { const int r = 16 * mi + fr; float f0, f1; ssd_factors(SSDSQ, 16384 + rt * 64 + r, f0, f1);
            const float sc = wave < 2 ? f0 * f1 : (wave < 4 ? f1 : 1.f);
#pragma unroll
            for (int nj = 0; nj < 4; ++nj) *(LAS f32x4*)(part + r * 64 + 16 * nj + 4 * fq) = acc[mi][nj] * sc; }
        __syncthreads();
        for (int q = tid; q < 1024; q += 512) { const int r = q >> 4, c4 = (q & 15) * 4; f32x4 s = *(const LAS f32x4*)((LAS float*)lds + r * 64 + c4);
#pragma unroll
            for (int w = 1; w < 8; ++w) s += *(const LAS f32x4*)((LAS float*)lds + w * 4096 + r * 64 + c4);
            const int row = 16384 + rt * 64 + r, col = ct * 64 + c4;
            h_store(S.H, S.HB, row, col, s + *(const f32x4*)(h0_row(a, row) + col)); }
        __syncthreads();
    }
}

struct BkInfo { int bk, rt, cnt, off; };
__device__ __forceinline__ void bk_table256(const Args& a, LAS unsigned char* lds, int L) {
    LAS int* tb = (LAS int*)(lds + LDS_TAB);
    __syncthreads();
    if (threadIdx.x == 0) {
        const unsigned* cnt = (const unsigned*)(a.ws + WS_CTL) + CW_CNT + 1024 * L;
        int off = 0, rts = 0;
        for (int i = 0; i < NBK; ++i) { const int c = (int)__hip_atomic_load(cnt + 32 * i, __ATOMIC_RELAXED, __HIP_MEMORY_SCOPE_AGENT);
            tb[i] = c; tb[NBK + i] = off; tb[2 * NBK + i] = rts; off += (c + 255) & ~255; rts += (c + 255) >> 8; }
        tb[2 * NBK + NBK] = rts;
    }
    __syncthreads();
}
__device__ __forceinline__ bool bk_find(const LAS int* tb, int rti, BkInfo& o) {
    if (rti >= tb[2 * NBK + NBK]) return false;
    int bk = 0;
    for (int i = 1; i < NBK; ++i) if (rti >= tb[2 * NBK + i]) bk = i;
    o.bk = bk; o.rt = rti - tb[2 * NBK + bk]; o.cnt = tb[bk]; o.off = tb[NBK + bk]; return true;
}
struct PMoeUp {
    static constexpr bool PERM = true;
    struct Unit { int bk, rt, cnt, off, e, ek, pnl, ui; };
    const char* A; const char* B; bf16* HID; const float* rstd; const float* gates; const LAS int* tb; const LAS int* rowtab; int G, c; int ldb, nt;
    __device__ __forceinline__ bool next(int i, Unit& u) const {
        const int Lu = i * G + c; BkInfo o; if (!bk_find(tb, Lu >> 3, o)) return false;
        u.bk = o.bk; u.rt = o.rt; u.cnt = o.cnt; u.off = o.off; u.ek = (Lu >> 2) & 1; u.pnl = Lu & 3; u.ui = i;
        int elo, ehi; bk_experts(o.bk, elo, ehi); u.e = u.ek ? ehi : elo; return true;
    }
    __device__ __forceinline__ void avoff(const Unit& u, const int (&RA)[2], const int (&CA)[2], unsigned (&v)[4]) const {
#pragma unroll
        for (int h = 0; h < 2; ++h)
#pragma unroll
            for (int i = 0; i < 2; ++i) { const int tok = rowtab[u.ui * 256 + h * 128 + RA[i]]; v[h * 2 + i] = (unsigned)(tok * D + CA[i]) * 2u; }
    }
    __device__ __forceinline__ const char* abase(const Unit&) const { return A; }
    __device__ __forceinline__ const char* btile(const Unit& u, int t) const { return B + ((size_t)(u.e * 1024 + u.pnl * 256) * 1024 + (size_t)t * 64) * 2; }
    __device__ __forceinline__ void khook(int, pg8::Acc&, const Unit&, LAS unsigned char*, int, int, int, int) const {}
    __device__ __forceinline__ void epi(const pg8::Acc& acc, const Unit& u, int wr, int wc, int fr, int fq) const {
        const int r0 = wr * 64 + fr, col0 = u.ek * 512 + u.pnl * 128 + wc * 32 + 8 * fq;
        float rsv[2][4], gtv[2][4];
#pragma unroll
        for (int ai = 0; ai < 2; ++ai)
#pragma unroll
            for (int m = 0; m < 4; ++m) { const int tok = rowtab[u.ui * 256 + r0 + ai * 128 + m * 16]; rsv[ai][m] = rstd[tok]; gtv[ai][m] = gates[(size_t)tok * 2 + u.ek]; }
#pragma unroll
        for (int ai = 0; ai < 2; ++ai)
#pragma unroll
            for (int m = 0; m < 4; ++m) { const int rr = u.rt * 256 + r0 + ai * 128 + m * 16;
                if (rr < u.cnt) { const float rs = rsv[ai][m], gt = gtv[ai][m]; float hv[8];
#pragma unroll
                    for (int n = 0; n < 2; ++n)
#pragma unroll
                        for (int j = 0; j < 4; ++j) { const float g = acc[ai][0][m][n][j] * rs, uu = acc[ai][1][m][n][j] * rs; hv[n * 4 + j] = silu_f(g) * uu * gt; }
                    v4u w; w.x = pg8::cvt_pk_bf16(hv[0], hv[1]); w.y = pg8::cvt_pk_bf16(hv[2], hv[3]); w.z = pg8::cvt_pk_bf16(hv[4], hv[5]); w.w = pg8::cvt_pk_bf16(hv[6], hv[7]);
                    *(v4u*)(HID + (size_t)(u.off + rr) * 1024 + col0) = w; } }
    }
};
__device__ __forceinline__ void ph_moe_up_pg8(const Args& a, LAS unsigned char* lds, int L, int G) {
    bk_table256(a, lds, L);
    const LAS int* tb = (const LAS int*)(lds + LDS_TAB); LAS int* rowtab = (LAS int*)(lds + LDS_TAB + 1024);
    PMoeUp S; S.A = (const char*)a.out; S.B = (const char*)(a.ws + ws_wgu(L)); S.HID = (bf16*)(a.ws + WS_HID); S.rstd = (const float*)(a.ws + WS_RSTD1); S.gates = (const float*)(a.ws + WS_GATES);
    S.tb = tb; S.rowtab = rowtab; S.G = G; S.c = (int)blockIdx.x; S.ldb = 1024; S.nt = 16;
    {   const int* LIST = (const int*)(a.ws + WS_LIST); PMoeUp::Unit u;
        for (int i = 0; i < 4 && S.next(i, u); ++i)
            if (threadIdx.x < 256) { int rr = u.rt * 256 + (int)threadIdx.x; rr = rr < u.cnt ? rr : u.cnt - 1; rowtab[i * 256 + threadIdx.x] = LIST[(size_t)u.bk * T + rr]; }
        __syncthreads();
    }
    pg8::gemm_phase<PMoeUp, true>(lds, S);
}
struct PMoeDown {
    static constexpr bool PERM = false;
    struct Unit { int bk, rt, cnt, off, elo, ehi, pn, ui; };
    const char* A; const char* B; float* H; bf16* HB; float* SSQ; const LAS int* tb; const LAS int* rowtab; int G, c; int ldb, nt;
    __device__ __forceinline__ bool next(int i, Unit& u) const {
        const int Lu = i * G + c; BkInfo o; if (!bk_find(tb, Lu >> 2, o)) return false;
        u.bk = o.bk; u.rt = o.rt; u.cnt = o.cnt; u.off = o.off; u.pn = Lu & 3; u.ui = i; bk_experts(o.bk, u.elo, u.ehi); return true;
    }
    __device__ __forceinline__ void avoff(const Unit& u, const int (&RA)[2], const int (&CA)[2], unsigned (&v)[4]) const {
#pragma unroll
        for (int h = 0; h < 2; ++h)
#pragma unroll
            for (int i = 0; i < 2; ++i) { const int row = u.off + u.rt * 256 + h * 128 + RA[i]; v[h * 2 + i] = (unsigned)(row * 1024 + CA[i]) * 2u; }
    }
    __device__ __forceinline__ const char* abase(const Unit&) const { return A; }
    __device__ __forceinline__ const char* btile(const Unit& u, int t) const { return B + ((size_t)((t < 8 ? u.elo : u.ehi) * 1024 + u.pn * 256) * 512 + (size_t)(t & 7) * 64) * 2; }
    __device__ __forceinline__ void khook(int, pg8::Acc&, const Unit&, LAS unsigned char*, int, int, int, int) const {}
    __device__ __forceinline__ void epi(const pg8::Acc& acc, const Unit& u, int wr, int wc, int fr, int fq) const {
        const int r0 = wr * 64 + fr, col0 = u.pn * 256 + wc * 32 + 4 * fq;
        int tok[8];
#pragma unroll
        for (int g8 = 0; g8 < 8; ++g8) tok[g8] = rowtab[u.ui * 256 + r0 + (g8 >> 2) * 128 + (g8 & 3) * 16];
        f32x4 cur[4], nxt[4];
#pragma unroll
        for (int q = 0; q < 4; ++q) cur[q] = *(const f32x4*)(H + (size_t)tok[0] * D + col0 + (q >> 1) * 128 + (q & 1) * 16);
#pragma unroll
        for (int g8 = 0; g8 < 8; ++g8) {
            const int ai = g8 >> 2, m = g8 & 3;
            if (g8 < 7) {
#pragma unroll
                for (int q = 0; q < 4; ++q) nxt[q] = *(const f32x4*)(H + (size_t)tok[g8 + 1] * D + col0 + (q >> 1) * 128 + (q & 1) * 16); }
            const int rr = u.rt * 256 + r0 + ai * 128 + m * 16;
            float sq = 0.f;
#pragma unroll
            for (int q = 0; q < 4; ++q) { const f32x4 v = acc[ai][q >> 1][m][q & 1] + cur[q]; sq += v[0] * v[0] + v[1] * v[1] + v[2] * v[2] + v[3] * v[3];
                if (rr < u.cnt) h_store(H, HB, tok[g8], col0 + (q >> 1) * 128 + (q & 1) * 16, v); }
            sq += __shfl_xor(sq, 16); sq += __shfl_xor(sq, 32);
            if (rr < u.cnt && fq == 0) SSQ[(size_t)tok[g8] * 16 + u.pn * 4 + wc] = sq;
#pragma unroll
            for (int q = 0; q < 4; ++q) cur[q] = nxt[q];
        }
    }
};
__device__ __forceinline__ void ph_moe_down_pg8(const Args& a, LAS unsigned char* lds, int L, int G) {
    bk_table256(a, lds, L);
    const LAS int* tb = (const LAS int*)(lds + LDS_TAB); LAS int* rowtab = (LAS int*)(lds + LDS_TAB + 1024);
    PMoeDown S; S.A = (const char*)(a.ws + WS_HID); S.B = (const char*)(a.ws + ws_wd(L)); S.SSQ = (float*)(a.ws + WS_SSDSQ); S.H = (float*)(a.ws + WS_H); S.HB = (bf16*)a.out;
    S.tb = tb; S.rowtab = rowtab; S.G = G; S.c = (int)blockIdx.x; S.ldb = 512; S.nt = 16;
    {   const int* LIST = (const int*)(a.ws + WS_LIST); PMoeDown::Unit u;
        for (int i = 0; i < 4 && S.next(i, u); ++i)
            if (threadIdx.x < 256) { int rr = u.rt * 256 + (int)threadIdx.x; rr = rr < u.cnt ? rr : u.cnt - 1; rowtab[i * 256 + threadIdx.x] = LIST[(size_t)u.bk * T + rr]; }
        __syncthreads();
    }
    pg8::gemm_phase<PMoeDown, true>(lds, S);
}
struct PPool {
    static constexpr bool PERM = false;
    struct Unit { int pm, pn; };
    const char* A; const char* B; float* H; bf16* HB; const float* pb; const float* ps; int G, c; int ldb, nt;
    __device__ __forceinline__ bool next(int i, Unit& u) const { return pg8::static_order(65, 4, G, c, i, u.pm, u.pn); }
    __device__ __forceinline__ void avoff(const Unit& u, const int (&RA)[2], const int (&CA)[2], unsigned (&v)[4]) const {
#pragma unroll
        for (int h = 0; h < 2; ++h)
#pragma unroll
            for (int i = 0; i < 2; ++i) { int row = u.pm * 256 + h * 128 + RA[i]; row = row < T ? row : T - 1; v[h * 2 + i] = (unsigned)(row * D + CA[i]) * 2u; }
    }
    __device__ __forceinline__ const char* abase(const Unit& u) const { return A + (size_t)u.pn * 256 * 2; }
    __device__ __forceinline__ const char* btile(const Unit& u, int t) const { return B + ((size_t)u.pn * 256 * 256 + (size_t)t * 64) * 2; }
    __device__ __forceinline__ void khook(int, pg8::Acc&, const Unit&, LAS unsigned char*, int, int, int, int) const {}
    __device__ __forceinline__ void epi(const pg8::Acc& acc, const Unit& u, int wr, int wc, int fr, int fq) const {
        const int row0 = u.pm * 256 + wr * 64 + fr, col0 = u.pn * 256 + wc * 32 + 4 * fq;
        f32x4 cur[4], nxt[4];
        { const int rc = row0 < T ? row0 : T - 1;
#pragma unroll
          for (int q = 0; q < 4; ++q) cur[q] = *(const f32x4*)(H + (size_t)rc * D + col0 + (q >> 1) * 128 + (q & 1) * 16); }
#pragma unroll
        for (int g8 = 0; g8 < 8; ++g8) {
            const int ai = g8 >> 2, m = g8 & 3, row = row0 + ai * 128 + m * 16;
            if (g8 < 7) { const int rn = row0 + ((g8 + 1) >> 2) * 128 + ((g8 + 1) & 3) * 16, rc = rn < T ? rn : T - 1;
#pragma unroll
                for (int q = 0; q < 4; ++q) nxt[q] = *(const f32x4*)(H + (size_t)rc * D + col0 + (q >> 1) * 128 + (q & 1) * 16); }
            if (row < T) {
#pragma unroll
                for (int q = 0; q < 4; ++q) { const int cc = col0 + (q >> 1) * 128 + (q & 1) * 16; h_store(H, HB, row, cc, cur[q] + (acc[ai][q >> 1][m][q & 1] + *(const f32x4*)(pb + cc)) * *(const f32x4*)(ps + cc)); } }
#pragma unroll
            for (int q = 0; q < 4; ++q) cur[q] = nxt[q];
        }
    }
};
__device__ __forceinline__ void ph_poolgemm_pg8(const Args& a, LAS unsigned char* lds, int G) {
    PPool S; S.A = (const char*)(a.ws + WS_POOLED); S.B = (const char*)(a.ws + WS_WPOOL); S.H = (float*)(a.ws + WS_H); S.HB = (bf16*)a.out; S.pb = a.in[I_PB]; S.ps = a.in[I_PS];
    S.G = G; S.c = (int)blockIdx.x; S.ldb = 256; S.nt = 4;
    pg8::gemm_phase<PPool, true>(lds, S);
}

__device__ __forceinline__ void ph_pooled(const Args& a, LAS unsigned char* lds, int wk, int nwk) {
    const int tid = threadIdx.x, half = tid >> 8, c4 = tid & 255, c = c4 * 4, g = c >> 8, w = 2 << g;
    const float* H = (const float*)(a.ws + WS_H); const float* SSQ = (const float*)(a.ws + WS_SSDSQ); bf16* PO = (bf16*)(a.ws + WS_POOLED);
    LAS float* rs = (LAS float*)lds + half * 64;
    for (int pr = wk; pr < 192; pr += nwk) {
        const int task = pr * 2 + half, b = task / 48, t0 = (task % 48) * 43;
        const size_t rb = (size_t)b * LSEQ;
        __syncthreads();
        if (c4 < 59) { const int l = t0 - 16 + c4; float r = 0.f;
            if (l >= 0) { const f32x4* q = (const f32x4*)(SSQ + (rb + l) * 16); const f32x4 s = (q[0] + q[1]) + (q[2] + q[3]); r = rsqrtf((s[0] + s[1] + s[2] + s[3]) * (1.f / D) + EPS); }
            rs[c4] = r; }
        __syncthreads();
        f32x4 S = (f32x4){0.f, 0.f, 0.f, 0.f};
        for (int j = 1; j <= w; ++j) { const int l = t0 - j; if (l >= 0) S += *(const f32x4*)(H + (rb + l) * D + c) * rs[16 - j]; }
#pragma unroll 4
        for (int t = 0; t < 43; ++t) {
            const int l = t0 + t;
            const f32x4 hv = *(const f32x4*)(H + (rb + l) * D + c) * rs[16 + t];
            const int lo = l - w, loc = lo >= 0 ? lo : 0;
            const f32x4 hs = *(const f32x4*)(H + (rb + loc) * D + c) * (lo >= 0 ? rs[16 + t - w] : 0.f);
            S += hv; S -= hs;
            const int n = (l + 1) < w ? (l + 1) : w;
            const f32x4 o = S * (1.f / (float)n) - hv;
            v2u wv; wv.x = pk2(o[0], o[1]); wv.y = pk2(o[2], o[3]); *(v2u*)(PO + (rb + l) * D + c) = wv;
        }
    }
}
__device__ __forceinline__ void ph_poolgemm(const Args& a, int wk, int nwk) {
    const int tid = threadIdx.x, lane = tid & 63, wave = __builtin_amdgcn_readfirstlane(tid >> 6), fr = lane & 15, fq = lane >> 4;
    const int gw = wk * NWAVES + wave, NGW = nwk * NWAVES;
    const bf16* PO = (const bf16*)(a.ws + WS_POOLED); const bf16* WPOOL = (const bf16*)(a.ws + WS_WPOOL);
    float* H = (float*)(a.ws + WS_H); bf16* HB = (bf16*)a.out;
    for (int u = gw; u < 258 * 16; u += NGW) {
        const int rt = u / 16, ct = u % 16, g = ct >> 2;
        const bf16* arow[4];
#pragma unroll
        for (int mi = 0; mi < 4; ++mi) arow[mi] = PO + (size_t)(rt * 64 + 16 * mi + fr) * D + g * 256;
        f32x4 acc[4][4]; zero_acc(acc);
        sg_kloop<4>(256, arow, [=](int n, int k0) { return WPOOL + (size_t)(ct * 64 + n) * 256 + k0; }, NoKS(), acc, fr, fq);
#pragma unroll
        for (int mi = 0; mi < 4; ++mi) { const int row = rt * 64 + 16 * mi + fr;
#pragma unroll
            for (int nj = 0; nj < 4; ++nj) { const int c = ct * 64 + 16 * nj + 4 * fq; float* hp = H + (size_t)row * D + c;
                const f32x4 v = *(const f32x4*)hp + (acc[mi][nj] + *(const f32x4*)(a.in[I_PB] + c)) * *(const f32x4*)(a.in[I_PS] + c); *(f32x4*)hp = v;
                v2u w; w.x = pk2(v.x, v.y); w.y = pk2(v.z, v.w); *(v2u*)(HB + (size_t)row * D + c) = w; } }
    }
}
__device__ __forceinline__ void ph_final(const Args& a, int wk, int nwk) {
    const int tid = threadIdx.x, lane = tid & 63, wave = __builtin_amdgcn_readfirstlane(tid >> 6);
    const int gw = wk * NWAVES + wave, NGW = nwk * NWAVES;
    const float* H = (const float*)(a.ws + WS_H); const f32x4* gn = (const f32x4*)a.in[I_NORMF] + lane;
    for (int orow = gw; orow < NB * SEQ; orow += NGW) {
        const int b = orow / SEQ, l = orow - b * SEQ, row = b * LSEQ + NMETA + l;
        const f32x4* xr = (const f32x4*)(H + (size_t)row * D) + lane; f32x4 v[4]; float ss = 0.f;
#pragma unroll
        for (int j = 0; j < 4; ++j) { v[j] = xr[64 * j]; ss += v[j].x * v[j].x + v[j].y * v[j].y + v[j].z * v[j].z + v[j].w * v[j].w; }
        ss = wave_sum(ss);
        const float rstd = rsqrtf(ss * (1.f / D) + EPS);
        f32x4* o = (f32x4*)(a.out + (size_t)orow * D) + lane;
#ifdef PROBE_T
        const unsigned long long* ts = (const unsigned long long*)(a.ws + WS_CTL + 2048);
        const float tA = (float)(ts[PROBE_A_HI] - ts[PROBE_A_LO]) * 0.01f, tB = (float)(ts[PROBE_B_HI] - ts[PROBE_B_LO]) * 0.01f;
#pragma unroll
        for (int j = 0; j < 4; ++j) { f32x4 r = v[j] * rstd * gn[64 * j] + tB * 0.01f; if (orow == 0 && lane == 0 && j == 0) r.x += tA; o[64 * j] = r; }
#else
#pragma unroll
        for (int j = 0; j < 4; ++j) o[64 * j] = v[j] * rstd * gn[64 * j];
#endif
    }
}

__global__ void __launch_bounds__(NWAVES * 64, 2) fwd_kernel(Args a) {
    extern __shared__ __attribute__((aligned(16))) unsigned char lds_raw[];
    LAS unsigned char* lds = (LAS unsigned char*)lds_raw;
    volatile LAS unsigned* MISC = (volatile LAS unsigned*)(lds + LDS_BYTES - 256);
    const int tid = threadIdx.x;
    const int G = gridDim.x; const int bx = blockIdx.x;
    const int wk = (G % 8 == 0) ? (bx % 8) * (G / 8) + bx / 8 : bx;
    if (tid < 64) MISC[tid] = 0u;
    __syncthreads();
    XcdBarrier bar; bar.bar = (unsigned*)(a.ws + WS_CTL) + CW_BAR; bar.x = 0; bar.st = nullptr;
    if (N_LAUNCHES == 1) bar = xcd_barrier_post((unsigned*)(a.ws + WS_CTL) + CW_BAR, MISC + 8);
    const int lo = a.ph_lo, hi = a.ph_hi;
#ifndef PH_MASK
#define PH_MASK 0xFFFF
#endif
#define IN(k) (((PH_MASK >> (k)) & 1) && lo <= (k) && (k) < hi)
#ifdef PROBE_T
#define STAMP(k) do { if (blockIdx.x == 0 && tid == 0) ((unsigned long long*)(a.ws + WS_CTL + 2048))[k] = __builtin_amdgcn_s_memrealtime(); } while (0)
#else
#define STAMP(k) do { } while (0)
#endif
#ifdef PROBE_K
    volatile LAS unsigned long long* pkt = (volatile LAS unsigned long long*)(lds + LDS_BYTES - 128);
#define PSTAMP(k) do { if (blockIdx.x == 0 && tid == 0) { if ((k) == PROBE_K) pkt[0] = __builtin_amdgcn_s_memrealtime(); if ((k) == PROBE_K + 1) pkt[1] = __builtin_amdgcn_s_memrealtime(); } } while (0)
#else
#define PSTAMP(k) do { } while (0)
#endif
#define SEAM(k) do { if (IN(k) && IN((k) + 1)) xcd_barrier(bar); STAMP((k) + 1); PSTAMP((k) + 1); } while (0)
    STAMP(0); PSTAMP(0);
    if (IN(0)) { ph_prep(a, lds, wk, G); } SEAM(0);
    if (IN(1)) { ph_gemm1_pg8(a, lds, G); } SEAM(1);
    if (IN(2)) { ph_conv(a, wk, G); } SEAM(2);
    if (IN(3)) { ph_mixers3(a, lds, wk, G); } SEAM(3);
    if (IN(4)) { ph_gemm2_pg8(a, lds, wk, G); } SEAM(4);
    if (IN(5)) { ph_router(a, lds, 0, wk, G); } SEAM(5);
    if (IN(6)) { ph_moe_up_pg8(a, lds, 0, G); } SEAM(6);
    if (IN(7)) { ph_moe_down_pg8(a, lds, 0, G); } SEAM(7);
    if (IN(8)) { ph_pooled(a, lds, wk, G); } SEAM(8);
    if (IN(9)) { ph_poolgemm_pg8(a, lds, G); } SEAM(9);
    if (IN(10)) { ph_router(a, lds, 1, wk, G); } SEAM(10);
    if (IN(11)) { ph_moe_up_pg8(a, lds, 1, G); } SEAM(11);
    if (IN(12)) { ph_moe_down_pg8(a, lds, 1, G); } SEAM(12);
    if (IN(13)) { ph_final(a, wk, G); }
#ifdef PROBE_K
    if (blockIdx.x == 0 && tid == 0) {
        asm volatile("s_waitcnt vmcnt(0)" ::: "memory");
        if (PROBE_K == 13) pkt[1] = __builtin_amdgcn_s_memrealtime();
        const unsigned long long tend = __builtin_amdgcn_s_memrealtime() + 4ull * (pkt[1] - pkt[0]);
        while (__builtin_amdgcn_s_memrealtime() < tend) __builtin_amdgcn_s_sleep(16);
    }
#endif
#undef IN
#undef SEAM
}

extern "C" void kernel_launch(void* const* d_in, const int* in_sizes, int n_in, void* d_out, int out_size, void* d_ws, size_t ws_size, hipStream_t stream) {
    static int grid = 0;
    if (grid == 0) {
        if (n_in != 31 || out_size != NB * SEQ * D || ws_size < WS_END) { fprintf(stderr, "kernel_launch: unexpected shapes (n_in %d out %d ws %zu)\n", n_in, out_size, ws_size); grid = -1; return; }
        int dev = 0, cus = 0;
        if (hipGetDevice(&dev) != hipSuccess || hipDeviceGetAttribute(&cus, hipDeviceAttributeMultiprocessorCount, dev) != hipSuccess) { grid = -1; return; }
        if (hipFuncSetAttribute((const void*)fwd_kernel, hipFuncAttributeMaxDynamicSharedMemorySize, LDS_BYTES) != hipSuccess) { grid = -1; return; }
        grid = cus;
    }
    if (grid < 0) return;
    (void)hipMemsetAsync((char*)d_ws + WS_CTL, 0, CTL_ZERO_BYTES, stream);
    Args a{};
    for (int i = 0; i < 31; ++i) a.in[i] = (const float*)d_in[i];
    a.out = (float*)d_out; a.ws = (unsigned char*)d_ws;
    if (N_LAUNCHES == 1) { a.ph_lo = 0; a.ph_hi = NPH; hipLaunchKernelGGL(fwd_kernel, dim3(grid), dim3(NWAVES * 64), LDS_BYTES, stream, a); }
    else for (int p = 0; p < NPH; ++p) { a.ph_lo = p; a.ph_hi = p + 1; hipLaunchKernelGGL(fwd_kernel, dim3(grid), dim3(NWAVES * 64), LDS_BYTES, stream, a); }
}
```

```cpp
#include <hip/hip_runtime.h>
#include <cstdio>
#include <cstdint>

#define GAS __attribute__((address_space(1)))
#define LAS __attribute__((address_space(3)))
typedef unsigned short bf16;
typedef short bf16x8 __attribute__((ext_vector_type(8)));
typedef float f32x4 __attribute__((ext_vector_type(4)));
typedef unsigned v4u __attribute__((ext_vector_type(4)));
typedef unsigned v2u __attribute__((ext_vector_type(2)));

#ifndef MK_N_LAUNCHES
#define MK_N_LAUNCHES 1
#endif
constexpr int NPH = 14;
constexpr int N_LAUNCHES = MK_N_LAUNCHES;

constexpr int NB = 8, SEQ = 2048, NMETA = 16, LSEQ = SEQ + NMETA, T = NB * LSEQ, D = 1024;
constexpr int PROJ_SRC = 4624, LDP = 4608;
constexpr int C_Z = 0, C_G = 1024, C_X = 2048, C_B = 3072, C_C = 3328, C_LI = 3584;
constexpr float EPS = 1e-6f;
constexpr int NBK = 24;

constexpr size_t MiB = 1u << 20;
constexpr size_t WS_CTL = 0, CTL_ZERO_BYTES = 1 * MiB;
constexpr size_t WS_WIN = 1 * MiB;
constexpr size_t WS_WOUT = 10 * MiB;
constexpr size_t WS_WPOOL = 14 * MiB;
constexpr size_t WS_WRT = 14 * MiB + 512 * 1024;
constexpr size_t WS_RSTD0 = 15 * MiB;
constexpr size_t WS_RSTD1 = WS_RSTD0 + 128 * 1024;
constexpr size_t WS_BKT = WS_RSTD1 + 128 * 1024;
constexpr size_t WS_GATES = WS_BKT + 128 * 1024;
constexpr size_t WS_DT = 16 * MiB;
constexpr size_t WS_SSDSQ = 17 * MiB + 64 * 1024;
constexpr size_t WS_LIST = 19 * MiB;
constexpr size_t WS_WGU = 21 * MiB;
constexpr size_t WS_WD = 53 * MiB;
constexpr size_t WS_H = 69 * MiB;
constexpr size_t WS_PROJ = 134 * MiB;
constexpr size_t WS_HID = WS_PROJ;
constexpr size_t WS_POOLED = WS_PROJ;
constexpr size_t WS_END = 280 * MiB;
constexpr size_t WS_WGU1 = WS_PROJ + 64 * MiB, WS_WD1 = WS_PROJ + 96 * MiB;
__host__ __device__ constexpr size_t ws_wgu(int L) { return L ? WS_WGU1 : WS_WGU; }
__host__ __device__ constexpr size_t ws_wd(int L) { return L ? WS_WD1 : WS_WD; }
static_assert(WS_H + (size_t)T * D * 4 <= WS_PROJ && WS_PROJ + (size_t)T * LDP * 2 <= WS_END, "ws map");
static_assert(WS_DT + (size_t)T * 16 * 4 <= WS_SSDSQ && WS_SSDSQ + (size_t)T * 16 * 4 <= WS_LIST && WS_LIST + (size_t)NBK * T * 4 <= WS_WGU, "ws map small");
constexpr int CW_CNT = 8192;
constexpr int CW_BAR = 4096;

constexpr int LDS_BYTES = 147456;
constexpr int NWAVES = 8;

struct Args { const float* in[31]; float* out; unsigned char* ws; int ph_lo, ph_hi; };
enum { I_X = 0, I_META, I_NORMF, I_MNE, I_WIN, I_SCW, I_SCB, I_DTB, I_ALOG, I_SD, I_SNORM, I_LCW, I_LCB, I_LWA, I_LBA, I_LWX, I_LBX, I_LLAM, I_WOUT,
       I_MNO, I_PW, I_PB, I_PS, I_FFN, I_RGW, I_RGB, I_REW, I_REB, I_EWG, I_EWU, I_EWD };

#define LDS_WAIT() asm volatile("s_waitcnt lgkmcnt(0)" ::: "memory")
__device__ __forceinline__ float bf2f(unsigned v) { return __uint_as_float(v << 16); }
__device__ __forceinline__ unsigned f2bf(float f) { unsigned u = __float_as_uint(f); return (u + 0x7fffu + ((u >> 16) & 1u)) >> 16; }
__device__ __forceinline__ unsigned pk2(float lo, float hi) { return f2bf(lo) | (f2bf(hi) << 16); }
__device__ __forceinline__ void unpack8v(const v4u r, f32x4& a, f32x4& b) {
    a[0] = __uint_as_float(r.x << 16); a[1] = __uint_as_float(r.x & 0xffff0000u); a[2] = __uint_as_float(r.y << 16); a[3] = __uint_as_float(r.y & 0xffff0000u);
    b[0] = __uint_as_float(r.z << 16); b[1] = __uint_as_float(r.z & 0xffff0000u); b[2] = __uint_as_float(r.w << 16); b[3] = __uint_as_float(r.w & 0xffff0000u);
}
__device__ __forceinline__ float wave_sum(float v) {
#pragma unroll
    for (int o = 1; o < 64; o <<= 1) v += __shfl_xor(v, o);
    return v;
}
__device__ __forceinline__ float rcp_f(float v) { return __builtin_amdgcn_rcpf(v); }
__device__ __forceinline__ float sigmoid_f(float v) { return rcp_f(1.f + __expf(-v)); }
__device__ __forceinline__ float silu_f(float v) { return v * rcp_f(1.f + __expf(-v)); }
__device__ __forceinline__ float softplus_f(float v) { return v > 20.f ? v : log1pf(__expf(v)); }
__device__ __forceinline__ float gelu_tanh_f(float v) { const float u2 = 1.5957691216057308f * (v + 0.044715f * v * v * v); return v * rcp_f(1.f + __expf(-u2)); }
__device__ __forceinline__ const float* h0_row(const Args& a, int row) {
    const int b = row / LSEQ, l = row - b * LSEQ;
    return l < NMETA ? a.in[I_META] + (size_t)l * D : a.in[I_X] + ((size_t)b * SEQ + (l - NMETA)) * D;
}

#define XB_TMO      128
#define XB_XCNT(j)  (256  + 64 * (j))
#define XB_XSUB(j)  (1280 + 64 * (j))
#define XB_XGEN(j)  (2304 + 64 * (j))
#define XB_TOP      3328
#define XB_TOPGEN   3392
#define XCD_BAR_WORDS 3456
#define XB_SPIN_CAP (1u << 18)
__device__ __forceinline__ unsigned xb_ld(unsigned* p)              { return __hip_atomic_load(p, __ATOMIC_RELAXED, __HIP_MEMORY_SCOPE_AGENT); }
__device__ __forceinline__ unsigned xb_add(unsigned* p, unsigned v) { return __hip_atomic_fetch_add(p, v, __ATOMIC_RELAXED, __HIP_MEMORY_SCOPE_AGENT); }
__device__ __forceinline__ unsigned xb_xcc_id() { return (unsigned)__builtin_amdgcn_s_getreg((3 << 11) | 20) & 0xFu; }
#define XB_SPIN(cond, bar) do { unsigned _sp = 0; while (cond) { __builtin_amdgcn_s_sleep(1); \
    if ((++_sp & 255u) == 0u) { if (xb_ld(&(bar)[XB_TMO])) break; if (_sp > XB_SPIN_CAP) { atomicAdd(&(bar)[XB_TMO], 1u); break; } } } } while (0)
struct XcdBarrier { unsigned* bar; unsigned x; volatile LAS unsigned* st; };
__device__ __forceinline__ XcdBarrier xcd_barrier_post(unsigned* bar, volatile LAS unsigned* st) {
    XcdBarrier b; b.bar = bar; b.x = xb_xcc_id(); b.st = st;
    if (threadIdx.x == 0) (void)xb_add(&bar[XB_XCNT(b.x)], 1u);
    return b;
}
__device__ __forceinline__ void xcd_barrier_complete(unsigned* bar, unsigned x, unsigned& nloc, unsigned& nx) {
    const unsigned G = gridDim.x * gridDim.y * gridDim.z;
    unsigned sum, cnt, mine, sp = 0u;
    for (;;) {
        sum = 0u; cnt = 0u; mine = 0u;
#pragma unroll
        for (unsigned j = 0; j < 16; ++j) { const unsigned c = xb_ld(&bar[XB_XCNT(j)]); sum += c; cnt += (c > 0u) ? 1u : 0u; mine = (j == x) ? c : mine; }
        if (sum == G) break;
        __builtin_amdgcn_s_sleep(1);
        if ((++sp & 255u) == 0u) { if (xb_ld(&bar[XB_TMO])) break; if (sp > XB_SPIN_CAP) { atomicAdd(&bar[XB_TMO], 1u); break; } }
    }
    nloc = mine > 0u ? mine : 1u; nx = cnt > 0u ? cnt : 1u;
}
__device__ __forceinline__ void xcd_barrier(const XcdBarrier& b) {
    asm volatile("s_waitcnt vmcnt(0)" ::: "memory");
    __syncthreads();
    if (threadIdx.x == 0) {
        unsigned* bar = b.bar;
        __builtin_amdgcn_s_waitcnt(0);
        unsigned nloc = b.st[0], nx = b.st[1];
        if (nloc == 0u) { xcd_barrier_complete(bar, b.x, nloc, nx); b.st[0] = nloc; b.st[1] = nx; }
        const unsigned old = xb_add(&bar[XB_XSUB(b.x)], 1u);
        const unsigned gen = old / nloc;
        if (old + 1u == (gen + 1u) * nloc) {
            __builtin_amdgcn_fence(__ATOMIC_RELEASE, "agent");
            asm volatile("s_waitcnt vmcnt(0)" ::: "memory");
            const unsigned og = xb_add(&bar[XB_TOP], 1u);
            const unsigned tg = og / nx;
            if (og + 1u == (tg + 1u) * nx) xb_add(&bar[XB_TOPGEN], 1u);
            else XB_SPIN(xb_ld(&bar[XB_TOPGEN]) == tg, bar);
            __builtin_amdgcn_fence(__ATOMIC_ACQUIRE, "agent");
            xb_add(&bar[XB_XGEN(b.x)], 1u);
            asm volatile("s_waitcnt vmcnt(0)" ::: "memory");
        } else {
            XB_SPIN(xb_ld(&bar[XB_XGEN(b.x)]) == gen, bar);
            __builtin_amdgcn_fence(__ATOMIC_ACQUIRE, "agent");
            asm volatile("s_waitcnt vmcnt(0)" ::: "memory");
        }
    }
    __syncthreads();
}

__device__ __forceinline__ void tr_item(const float* src, int ldsrc, const float* gain, bf16* dst, int lddst, LAS float* scr, int lane) {
    float tv[32];
#pragma unroll
    for (int i = 0; i < 32; ++i) { const int kk = 2 * i + (lane >> 5); tv[i] = src[(size_t)kk * ldsrc + (lane & 31)]; }
#pragma unroll
    for (int i = 0; i < 32; ++i) { const int kk = 2 * i + (lane >> 5); float v = tv[i]; if (gain) v *= gain[kk]; scr[kk * 33 + (lane & 31)] = v; }
    LDS_WAIT();
    const int c = lane & 7;
#pragma unroll
    for (int j = 0; j < 4; ++j) { const int n = (lane >> 3) + 8 * j; const LAS float* s = scr + (8 * c) * 33 + n;
        v4u o; o.x = pk2(s[0 * 33], s[1 * 33]); o.y = pk2(s[2 * 33], s[3 * 33]); o.z = pk2(s[4 * 33], s[5 * 33]); o.w = pk2(s[6 * 33], s[7 * 33]);
        *(v4u*)(dst + (size_t)n * lddst + 8 * c) = o; }
    LDS_WAIT();
}
__device__ __forceinline__ void convert_experts(const Args& a, int L, LAS float* scr, int gw, int NGW, int lane) {
    bf16* WGU = (bf16*)(a.ws + ws_wgu(L)); bf16* WD = (bf16*)(a.ws + ws_wd(L));
    const float* gain = a.in[I_FFN] + L * D;
    constexpr int I_GU = 16 * 16 * 16, I_DN = 16 * 8 * 32;
    for (int it = gw; it < 2 * I_GU + I_DN; it += NGW) {
        int r = it;
        if (r < 2 * I_GU) {
            const int up = r >= I_GU; if (up) r -= I_GU;
            const int e = r >> 8, kb = (r >> 4) & 15, nb = r & 15;
            const float* src = a.in[up ? I_EWU : I_EWG] + ((size_t)(L * 16 + e) * 1024 + kb * 64) * 512 + nb * 32;
            const int drow = e * 1024 + (nb >> 2) * 256 + (nb & 3) * 32 + (up ? 128 : 0);
            tr_item(src, 512, gain + kb * 64, WGU + (size_t)drow * 1024 + kb * 64, 1024, scr, lane);
        } else {
            r -= 2 * I_GU;
            const int e = r >> 8, kb = (r >> 5) & 7, nb = r & 31;
            const float* src = a.in[I_EWD] + ((size_t)(L * 16 + e) * 512 + kb * 64) * 1024 + nb * 32;
            tr_item(src, 1024, nullptr, WD + (size_t)(e * 1024 + nb * 32) * 512 + kb * 64, 512, scr, lane);
        }
    }
}
__device__ __forceinline__ void ph_prep(const Args& a, LAS unsigned char* lds, int wk, int nwk) {
    const int tid = threadIdx.x, lane = tid & 63, wave = __builtin_amdgcn_readfirstlane(tid >> 6);
    const int gw = wk * NWAVES + wave, NGW = nwk * NWAVES;
    LAS float* wdt = (LAS float*)lds;
    LAS float* scr = (LAS float*)(lds + 65536 + wave * 8448);
    {
        const float* win = a.in[I_WIN]; const float* ge = a.in[I_MNE];
        for (int i = tid; i < 16 * 1024; i += 512) { const int k = i >> 4, j = i & 15; wdt[j * 1024 + k] = win[(size_t)k * PROJ_SRC + 2560 + j] * ge[k]; }
    }
    bf16* WIN = (bf16*)(a.ws + WS_WIN); bf16* WOUT = (bf16*)(a.ws + WS_WOUT); bf16* WPOOL = (bf16*)(a.ws + WS_WPOOL);
    constexpr int I_IN = 16 * 144, I_OUT = 32 * 32, I_POOL = 4 * 4 * 8;
    for (int it = gw; it < I_IN + I_OUT + I_POOL; it += NGW) {
        int r = it;
        if (r < I_IN) { const int kb = r / 144, nb = r % 144, n0 = nb * 32;
            const int sc = n0 < 1024 ? n0 : (n0 < 2048 ? n0 - 1024 + 2576 : (n0 < 3584 ? n0 - 2048 + 1024 : n0 - 3584 + 3600));
            tr_item(a.in[I_WIN] + (size_t)(kb * 64) * PROJ_SRC + sc, PROJ_SRC, a.in[I_MNE] + kb * 64, WIN + (size_t)n0 * 1024 + kb * 64, 1024, scr, lane); continue; }
        r -= I_IN;
        if (r < I_OUT) { const int kb = r >> 5, nb = r & 31;
            tr_item(a.in[I_WOUT] + (size_t)(kb * 64) * 1024 + nb * 32, 1024, kb < 16 ? a.in[I_SNORM] + kb * 64 : nullptr, WOUT + (size_t)(nb * 32) * 2048 + kb * 64, 2048, scr, lane); continue; }
        r -= I_OUT;
        { const int g = r >> 5, kb = (r >> 3) & 3, nb = r & 7;
            tr_item(a.in[I_PW] + (size_t)g * 65536 + (size_t)(kb * 64) * 256 + nb * 32, 256, a.in[I_MNO] + g * 256 + kb * 64, WPOOL + (size_t)(g * 256 + nb * 32) * 256 + kb * 64, 256, scr, lane); }
    }
    convert_experts(a, 0, scr, gw, NGW, lane);
    {
        float* WRT = (float*)(a.ws + WS_WRT);
        for (int i = wk * 512 + tid; i < 2 * 20 * 1024; i += nwk * 512) {
            const int L = i / 20480, r = i % 20480, j = r >> 10, k = r & 1023;
            const float w = j < 4 ? a.in[I_RGW][((size_t)L * 1024 + k) * 4 + j] : a.in[I_REW][((size_t)L * 1024 + k) * 16 + (j - 4)];
            WRT[i] = w * a.in[I_FFN][L * 1024 + k];
        }
    }
    __syncthreads();
    bf16* HB = (bf16*)a.out; float* RSTD0 = (float*)(a.ws + WS_RSTD0); float* DT = (float*)(a.ws + WS_DT);
    for (int row = gw; row < T; row += NGW) {
        const f32x4* xr = (const f32x4*)h0_row(a, row) + lane;
        f32x4 v[4]; float ss = 0.f;
#pragma unroll
        for (int j = 0; j < 4; ++j) { v[j] = xr[64 * j]; ss += v[j].x * v[j].x + v[j].y * v[j].y + v[j].z * v[j].z + v[j].w * v[j].w; }
        ss = wave_sum(ss);
        const float rstd = rsqrtf(ss * (1.f / D) + EPS);
        v2u* o8 = (v2u*)(HB + (size_t)row * D) + lane;
#pragma unroll
        for (int j = 0; j < 4; ++j) { v2u w; w.x = pk2(v[j].x, v[j].y); w.y = pk2(v[j].z, v[j].w); o8[64 * j] = w; }
        float mydt = 0.f;
#pragma unroll 2
        for (int jj = 0; jj < 16; ++jj) {
            float s = 0.f;
#pragma unroll
            for (int j = 0; j < 4; ++j) { const f32x4 w = *(const LAS f32x4*)(wdt + jj * 1024 + (lane + 64 * j) * 4); s += v[j].x * w.x + v[j].y * w.y + v[j].z * w.z + v[j].w * w.w; }
            s = wave_sum(s);
            if (lane == jj) mydt = s;
        }
        if (lane == 0) RSTD0[row] = rstd;
        if (lane < 16) DT[(size_t)row * 16 + lane] = softplus_f(mydt * rstd + a.in[I_DTB][lane]);
    }
}

template <int NT, class BP, class KS>
__device__ __forceinline__ void sg_kloop(int K, const bf16* const (&arow)[4], BP bp, KS ks, f32x4 (&acc)[4][NT], int fr, int fq) {
    for (int k0 = 0; k0 < K; k0 += 32) {
        ks(k0, acc);
        bf16x8 av[4], bv[NT];
#pragma unroll
        for (int mi = 0; mi < 4; ++mi) av[mi] = *(const bf16x8*)(arow[mi] + k0 + 8 * fq);
#pragma unroll
        for (int nj = 0; nj < NT; ++nj) bv[nj] = *(const bf16x8*)(bp(16 * nj + fr, k0) + 8 * fq);
#pragma unroll
        for (int mi = 0; mi < 4; ++mi)
#pragma unroll
            for (int nj = 0; nj < NT; ++nj) acc[mi][nj] = __builtin_amdgcn_mfma_f32_16x16x32_bf16(bv[nj], av[mi], acc[mi][nj], 0, 0, 0);
    }
}
template <int NT> __device__ __forceinline__ void zero_acc(f32x4 (&acc)[4][NT]) {
#pragma unroll
    for (int mi = 0; mi < 4; ++mi)
#pragma unroll
        for (int nj = 0; nj < NT; ++nj) acc[mi][nj] = (f32x4){0.f, 0.f, 0.f, 0.f};
}
struct NoKS { template <int NT> __device__ __forceinline__ void operator()(int, f32x4 (&)[4][NT]) const {} };

__device__ __forceinline__ void ph_gemm1(const Args& a, int wk, int nwk) {
    const int tid = threadIdx.x, lane = tid & 63, wave = __builtin_amdgcn_readfirstlane(tid >> 6), fr = lane & 15, fq = lane >> 4;
    const int gw = wk * NWAVES + wave, NGW = nwk * NWAVES;
    const bf16* HB = (const bf16*)a.out; const bf16* WIN = (const bf16*)(a.ws + WS_WIN); bf16* PROJ = (bf16*)(a.ws + WS_PROJ);
    const float* RSTD0 = (const float*)(a.ws + WS_RSTD0);
    for (int u = gw; u < 258 * 72; u += NGW) {
        const int rt = u / 72, ct = u % 72;
        const bf16* arow[4];
#pragma unroll
        for (int mi = 0; mi < 4; ++mi) arow[mi] = HB + (size_t)(rt * 64 + 16 * mi + fr) * D;
        f32x4 acc[4][4]; zero_acc(acc);
        sg_kloop<4>(1024, arow, [=](int n, int k0) { return WIN + (size_t)(ct * 64 + n) * 1024 + k0; }, NoKS(), acc, fr, fq);
#pragma unroll
        for (int mi = 0; mi < 4; ++mi) { const int row = rt * 64 + 16 * mi + fr; const float rs = RSTD0[row];
#pragma unroll
            for (int nj = 0; nj < 4; ++nj) { const f32x4 v = acc[mi][nj] * rs; v2u w; w.x = pk2(v.x, v.y); w.y = pk2(v.z, v.w);
                *(v2u*)(PROJ + (size_t)row * LDP + ct * 64 + 16 * nj + 4 * fq) = w; } }
    }
}

__device__ __forceinline__ void ph_gemm2(const Args& a, int wk, int nwk) {
    const int tid = threadIdx.x, lane = tid & 63, wave = __builtin_amdgcn_readfirstlane(tid >> 6), fr = lane & 15, fq = lane >> 4;
    const int gw = wk * NWAVES + wave, NGW = nwk * NWAVES;
    const bf16* PROJ = (const bf16*)(a.ws + WS_PROJ); const bf16* WOUT = (const bf16*)(a.ws + WS_WOUT);
    const float* SSDSQ = (const float*)(a.ws + WS_SSDSQ);
    float* H = (float*)(a.ws + WS_H); bf16* HB = (bf16*)a.out;
    for (int u = gw; u < 258 * 16; u += NGW) {
        const int rt = u / 16, ct = u % 16;
        const bf16* arow[4]; float f0[4], f1[4];
#pragma unroll
        for (int mi = 0; mi < 4; ++mi) { const int row = rt * 64 + 16 * mi + fr; arow[mi] = PROJ + (size_t)row * LDP;
            const f32x4* sq = (const f32x4*)(SSDSQ + (size_t)row * 16); const f32x4 q0 = sq[0], q1 = sq[1], q2 = sq[2], q3 = sq[3];
            const float s0 = (q0.x + q0.y + q0.z + q0.w) + (q1.x + q1.y + q1.z + q1.w), s1 = (q2.x + q2.y + q2.z + q2.w) + (q3.x + q3.y + q3.z + q3.w);
            const float r0 = rsqrtf(s0 * (1.f / 512.f) + EPS), r1 = rsqrtf(s1 * (1.f / 512.f) + EPS);
            f0[mi] = r0 / r1; f1[mi] = r1; }
        f32x4 acc[4][4]; zero_acc(acc);
        auto ks = [=](int k0, f32x4 (&ac)[4][4]) {
            if (k0 == 512) {
#pragma unroll
                for (int mi = 0; mi < 4; ++mi)
#pragma unroll
                    for (int nj = 0; nj < 4; ++nj) ac[mi][nj] *= f0[mi]; }
            if (k0 == 1024) {
#pragma unroll
                for (int mi = 0; mi < 4; ++mi)
#pragma unroll
                    for (int nj = 0; nj < 4; ++nj) ac[mi][nj] *= f1[mi]; }
        };
        sg_kloop<4>(2048, arow, [=](int n, int k0) { return WOUT + (size_t)(ct * 64 + n) * 2048 + k0; }, ks, acc, fr, fq);
#pragma unroll
        for (int mi = 0; mi < 4; ++mi) { const int row = rt * 64 + 16 * mi + fr; const float* hr = h0_row(a, row);
#pragma unroll
            for (int nj = 0; nj < 4; ++nj) { const int c = ct * 64 + 16 * nj + 4 * fq; const f32x4 v = acc[mi][nj] + *(const f32x4*)(hr + c);
                *(f32x4*)(H + (size_t)row * D + c) = v; v2u w; w.x = pk2(v.x, v.y); w.y = pk2(v.z, v.w); *(v2u*)(HB + (size_t)row * D + c) = w; } }
    }
}


namespace pg8 {
constexpr int BM = 256, BK = 64, HALF = 128, HTB = HALF * BK * 2, STAGE_BYTES = 8 * HTB, NXCD = 8, WGM = 8;
__host__ __device__ __forceinline__ int lds_byte(int r, int c) { const int st = (r >> 4) * 2 + (c >> 5), rr = r & 15, cc = c & 31, ob = rr * 64 + cc * 2; return st * 1024 + (ob ^ (((ob >> 9) & 1) << 5)); }
__host__ __device__ __forceinline__ void stage_rc(int b, int& R, int& C) { const int st = b / 1024, sb = b % 1024, swz = sb ^ (((sb >> 9) & 1) << 5); R = (st >> 1) * 16 + swz / 64; C = (st & 1) * 32 + (swz % 64) / 2; }
__host__ __device__ __forceinline__ int perm32(int rho) { const int n = rho >> 4, i = rho & 15; return 8 * (i >> 2) + 4 * n + (i & 3); }
__device__ __forceinline__ unsigned cvt_pk_bf16(float lo, float hi) { unsigned r; asm volatile("v_cvt_pk_bf16_f32 %0, %1, %2" : "=v"(r) : "v"(lo), "v"(hi)); return r; }
typedef f32x4 Acc[2][2][4][2];

__device__ __forceinline__ bool static_order(int nM, int nN, int G, int c, int i, int& pm, int& pn) {
    const int nwg = nM * nN; const long L = (long)i * G + c; if (L >= nwg) return false;
    int wgid = (int)L; { const int q = nwg / NXCD, r = nwg % NXCD, xcd = wgid % NXCD, off = wgid / NXCD; wgid = (xcd < r ? xcd * (q + 1) : r * (q + 1) + (xcd - r) * q) + off; }
    const int nig = WGM * nN, gid = wgid / nig, fm = gid * WGM, gsz = (nM - fm) < WGM ? (nM - fm) : WGM;
    pm = fm + ((wgid % nig) % gsz); pn = (wgid % nig) / gsz; return true;
}

template <class P, bool ALIGN_EPI>
__device__ __forceinline__ void gemm_phase(LAS unsigned char* lds, const P& S) {
    const int tid = threadIdx.x, wid = __builtin_amdgcn_readfirstlane(tid >> 6), lane = tid & 63, wr = wid >> 2, wc = wid & 3, fr = lane & 15, fq = lane >> 4;
    const int nt = S.nt;
    int RA[2], CA[2]; unsigned voffB[2];
#pragma unroll
    for (int i = 0; i < 2; ++i) { int R, C; stage_rc(tid * 16 + i * 8192, R, C); RA[i] = R; CA[i] = C; const int Rb = P::PERM ? ((R & ~31) + perm32(R & 31)) : R;
        voffB[i] = (unsigned)(Rb * S.ldb + C) * 2u; }
    const size_t kstep = (size_t)(BK * 2);
    const size_t hstepB = (size_t)HALF * S.ldb * 2;
    const unsigned ldsw = (unsigned)wid * 1024u;
    const int aoff = lds_byte(wr * 64 + fr, fq * 8), boff = lds_byte(wc * 32 + fr, fq * 8);
#define PG8_SA(b, h) (((b) * 2 + (h)) * HTB)
#define PG8_SB(b, h) ((4 + (b) * 2 + (h)) * HTB)
#define PG8_STAGE(bufoff, gbase, voff) do { _Pragma("unroll") for (int _i = 0; _i < 2; ++_i) \
        __builtin_amdgcn_global_load_lds((const unsigned*)((const char*)(gbase) + (voff)[_i]), (LAS unsigned*)(lds + (bufoff) + ldsw + _i * 8192), 16, 0, 0); } while (0)
#define PG8_LDA(dst, b, h) do { _Pragma("unroll") for (int m = 0; m < 4; ++m) _Pragma("unroll") for (int k = 0; k < 2; ++k) dst[m][k] = *(const LAS bf16x8*)(lds + PG8_SA(b, h) + aoff + m * 2048 + k * 1024); } while (0)
#define PG8_LDB(dst, b, h) do { _Pragma("unroll") for (int n = 0; n < 2; ++n) _Pragma("unroll") for (int k = 0; k < 2; ++k) dst[n][k] = *(const LAS bf16x8*)(lds + PG8_SB(b, h) + boff + n * 2048 + k * 1024); } while (0)
#define PG8_MMA(ai, bj, At, Bt) do { __builtin_amdgcn_s_setprio(1); _Pragma("unroll") for (int m = 0; m < 4; ++m) _Pragma("unroll") for (int n = 0; n < 2; ++n) _Pragma("unroll") for (int k = 0; k < 2; ++k) \
        acc[ai][bj][m][n] = __builtin_amdgcn_mfma_f32_16x16x32_bf16(Bt[n][k], At[m][k], acc[ai][bj][m][n], 0, 0, 0); __builtin_amdgcn_s_setprio(0); } while (0)
#define PG8_WAIT_V(n) asm volatile("s_waitcnt vmcnt(" #n ")" ::: "memory")
#define PG8_WAIT_L(n) asm volatile("s_waitcnt lgkmcnt(" #n ")" ::: "memory")
#define PG8_BAR __builtin_amdgcn_s_barrier()
#define PG8_SCHED __builtin_amdgcn_sched_barrier(0)
    typename P::Unit cur, nxt; int ui = 0;
    if (!S.next(0, cur)) return;
    f32x4 acc[2][2][4][2];
#pragma unroll
    for (int a = 0; a < 2; ++a)
#pragma unroll
        for (int b = 0; b < 2; ++b)
#pragma unroll
            for (int m = 0; m < 4; ++m)
#pragma unroll
                for (int n = 0; n < 2; ++n) acc[a][b][m][n] = (f32x4){0.f, 0.f, 0.f, 0.f};
    bf16x8 At[4][2], B0[2][2], B1[2][2];
    unsigned vA[4];
    S.avoff(cur, RA, CA, vA);
    const char* cA = S.abase(cur);
    {
        const char* b0 = S.btile(cur, 0); const char* b1 = S.btile(cur, 1);
        PG8_STAGE(PG8_SB(0, 0), b0, voffB); PG8_STAGE(PG8_SB(0, 1), b0 + hstepB, voffB); PG8_STAGE(PG8_SA(0, 0), cA, vA); PG8_STAGE(PG8_SA(0, 1), cA, vA + 2);
        if (wr == 1) PG8_BAR;
        PG8_WAIT_V(2); PG8_BAR;
        PG8_STAGE(PG8_SB(1, 0), b1, voffB); PG8_STAGE(PG8_SA(1, 0), cA + kstep, vA); PG8_STAGE(PG8_SB(1, 1), b1 + hstepB, voffB);
        PG8_WAIT_V(6); PG8_BAR;
    }
    for (;;) {
        const bool has_next = S.next(ui + 1, nxt);
        for (int t = 0; t < nt; t += 2) {
            const bool last = (t == nt - 2);
            const char* a1 = cA + (size_t)(t + 1) * kstep;
            S.khook(t, acc, cur, lds, wr, wc, fr, fq);
            PG8_LDB(B0, 0, 0); PG8_LDB(B1, 0, 1); PG8_SCHED; PG8_LDA(At, 0, 0); PG8_STAGE(PG8_SA(1, 1), a1, vA + 2);
            PG8_WAIT_V(8); PG8_WAIT_L(0); PG8_BAR; PG8_MMA(0, 0, At, B0); PG8_MMA(0, 1, At, B1); PG8_BAR; PG8_SCHED;
            const bool sw = last && has_next;
            if (sw) S.avoff(nxt, RA, CA, vA);
            const char* a2 = last ? (sw ? S.abase(nxt) : cA) : cA + (size_t)(t + 2) * kstep;
            const char* b2 = last ? (sw ? S.btile(nxt, 0) : S.btile(cur, 0)) : S.btile(cur, t + 2);
            const char* b3 = last ? (sw ? S.btile(nxt, 1) : S.btile(cur, 1)) : S.btile(cur, t + 3);
            const char* a3 = a2 + kstep;
            PG8_LDA(At, 0, 1); PG8_STAGE(PG8_SB(0, 0), b2, voffB); PG8_STAGE(PG8_SB(0, 1), b2 + hstepB, voffB); PG8_STAGE(PG8_SA(0, 0), a2, vA);
            PG8_WAIT_V(8); PG8_WAIT_L(0); PG8_BAR; PG8_MMA(1, 0, At, B0); PG8_MMA(1, 1, At, B1); PG8_BAR; PG8_SCHED;
            PG8_LDB(B0, 1, 0); PG8_LDB(B1, 1, 1); PG8_SCHED; PG8_LDA(At, 1, 0); PG8_STAGE(PG8_SA(0, 1), a2, vA + 2);
            PG8_WAIT_V(8); PG8_WAIT_L(0); PG8_BAR; PG8_MMA(0, 0, At, B0); PG8_MMA(0, 1, At, B1); PG8_BAR; PG8_SCHED;
            PG8_LDA(At, 1, 1); PG8_STAGE(PG8_SB(1, 0), b3, voffB); PG8_STAGE(PG8_SB(1, 1), b3 + hstepB, voffB); PG8_STAGE(PG8_SA(1, 0), a3, vA);
            PG8_WAIT_V(8); PG8_WAIT_L(0); PG8_BAR; PG8_MMA(1, 0, At, B0); PG8_MMA(1, 1, At, B1); PG8_BAR; PG8_SCHED;
        }
        if constexpr (ALIGN_EPI) { if (wr == 0) PG8_BAR; }
        S.epi(acc, cur, wr, wc, fr, fq);
        if (!has_next) break;
#pragma unroll
        for (int a = 0; a < 2; ++a)
#pragma unroll
            for (int b = 0; b < 2; ++b)
#pragma unroll
                for (int m = 0; m < 4; ++m)
#pragma unroll
                    for (int n = 0; n < 2; ++n) acc[a][b][m][n] = (f32x4){0.f, 0.f, 0.f, 0.f};
        cur = nxt; cA = S.abase(cur); ++ui;
        if constexpr (ALIGN_EPI) { if (wr == 1) PG8_BAR; }
    }
    PG8_WAIT_V(0);
    if constexpr (!ALIGN_EPI) { if (wr == 0) PG8_BAR; }
    PG8_BAR;
#undef PG8_SA
#undef PG8_SB
#undef PG8_STAGE
#undef PG8_LDA
#undef PG8_LDB
#undef PG8_MMA
#undef PG8_WAIT_V
#undef PG8_WAIT_L
#undef PG8_BAR
#undef PG8_SCHED
}
}

struct PGemm1 {
    static constexpr bool PERM = true;
    struct Unit { int pm, pn; };
    const char* A; const char* B; bf16* O; const float* rstd; int G, c; int ldb, nt;
    __device__ __forceinline__ bool next(int i, Unit& u) const { return pg8::static_order(65, 18, G, c, i, u.pm, u.pn); }
    __device__ __forceinline__ void avoff(const Unit& u, const int (&RA)[2], const int (&CA)[2], unsigned (&v)[4]) const {
#pragma unroll
        for (int h = 0; h < 2; ++h)
#pragma unroll
            for (int i = 0; i < 2; ++i) { int row = u.pm * 256 + h * 128 + RA[i]; row = row < T ? row : T - 1; v[h * 2 + i] = (unsigned)(row * D + CA[i]) * 2u; }
    }
    __device__ __forceinline__ const char* abase(const Unit&) const { return A; }
    __device__ __forceinline__ const char* btile(const Unit& u, int t) const { return B + ((size_t)u.pn * 256 * 1024 + (size_t)t * 64) * 2; }
    __device__ __forceinline__ void khook(int, pg8::Acc&, const Unit&, LAS unsigned char*, int, int, int, int) const {}
    __device__ __forceinline__ void epi(const pg8::Acc& acc, const Unit& u, int wr, int wc, int fr, int fq) const {
        const int row0 = u.pm * 256 + wr * 64 + fr, col0 = u.pn * 256 + wc * 32 + 8 * fq;
        float rsv[2][4];
#pragma unroll
        for (int ai = 0; ai < 2; ++ai)
#pragma unroll
            for (int m = 0; m < 4; ++m) { const int row = row0 + ai * 128 + m * 16; rsv[ai][m] = rstd[row < T ? row : T - 1]; }
#pragma unroll
        for (int ai = 0; ai < 2; ++ai)
#pragma unroll
            for (int m = 0; m < 4; ++m) { const int row = row0 + ai * 128 + m * 16;
                if (row < T) { const float rs = rsv[ai][m]; bf16* rowp = O + (size_t)row * LDP + col0;
#pragma unroll
                    for (int bj = 0; bj < 2; ++bj) { const f32x4 v0 = acc[ai][bj][m][0] * rs, v1 = acc[ai][bj][m][1] * rs;
                        v4u w; w.x = pg8::cvt_pk_bf16(v0[0], v0[1]); w.y = pg8::cvt_pk_bf16(v0[2], v0[3]); w.z = pg8::cvt_pk_bf16(v1[0], v1[1]); w.w = pg8::cvt_pk_bf16(v1[2], v1[3]);
                        *(v4u*)(rowp + bj * 128) = w; } } }
    }
};
__device__ __forceinline__ void ph_gemm1_pg8(const Args& a, LAS unsigned char* lds, int G) {
    PGemm1 S; S.A = (const char*)a.out; S.B = (const char*)(a.ws + WS_WIN); S.O = (bf16*)(a.ws + WS_PROJ); S.rstd = (const float*)(a.ws + WS_RSTD0);
    S.G = G; S.c = (int)blockIdx.x; S.ldb = 1024; S.nt = 16;
    pg8::gemm_phase<PGemm1, true>(lds, S);
}

__device__ __forceinline__ void ssd_item(const Args& a, LAS unsigned char* lds, int b, int h) {
    const int tid = threadIdx.x, lane = tid & 63;
    constexpr int TB = 64;
    LAS float* xs = (LAS float*)lds;
    LAS float* Bs = xs + TB * 64;
    LAS float* Cs = Bs + TB * 128;
    LAS float* ys = Cs + TB * 128;
    LAS float* dts = ys + TB * 64;
    LAS float* decs = dts + TB;
    bf16* PROJ = (bf16*)(a.ws + WS_PROJ); const float* DT = (const float*)(a.ws + WS_DT); float* SSDSQ = (float*)(a.ws + WS_SSDSQ);
    const int g = h >> 3;
    const float Ah = -__expf(a.in[I_ALOG][h]), Dh = a.in[I_SD][h];
    int ccol = 0, cch = 0; float cw0 = 0.f, cw1 = 0.f, cw2 = 0.f, cw3 = 0.f, cb = 0.f;
    if (tid < 320) {
        if (tid < 64) { ccol = C_X + h * 64 + tid; cch = h * 64 + tid; }
        else if (tid < 192) { ccol = C_B + g * 128 + (tid - 64); cch = 1024 + g * 128 + (tid - 64); }
        else { ccol = C_C + g * 128 + (tid - 192); cch = 1280 + g * 128 + (tid - 192); }
        const float* cw = a.in[I_SCW]; cw0 = cw[cch]; cw1 = cw[1536 + cch]; cw2 = cw[2 * 1536 + cch]; cw3 = cw[3 * 1536 + cch]; cb = a.in[I_SCB][cch];
    }
    const int p = tid >> 3, nq = tid & 7;
    float S[16];
#pragma unroll
    for (int i = 0; i < 16; ++i) S[i] = 0.f;
    const size_t rbase = (size_t)b * LSEQ;
    for (int l0 = 0; l0 < LSEQ; l0 += TB) {
        const int nt = (LSEQ - l0) < TB ? (LSEQ - l0) : TB;
        __syncthreads();
        if (tid < 320) {
            float r0 = l0 >= 3 ? bf2f(PROJ[(rbase + l0 - 3) * LDP + ccol]) : 0.f, r1 = l0 >= 2 ? bf2f(PROJ[(rbase + l0 - 2) * LDP + ccol]) : 0.f, r2 = l0 >= 1 ? bf2f(PROJ[(rbase + l0 - 1) * LDP + ccol]) : 0.f;
            for (int t = 0; t < nt; ++t) {
                const float r3 = bf2f(PROJ[(rbase + l0 + t) * LDP + ccol]);
                const float v = silu_f(cw0 * r0 + cw1 * r1 + cw2 * r2 + cw3 * r3 + cb);
                if (tid < 64) xs[t * 64 + tid] = v; else if (tid < 192) Bs[t * 128 + tid - 64] = v; else Cs[t * 128 + tid - 192] = v;
                r0 = r1; r1 = r2; r2 = r3;
            }
        } else if (tid < 320 + TB) {
            const int t = tid - 320;
            if (t < nt) { const float dt = DT[(rbase + l0 + t) * 16 + h]; dts[t] = dt; decs[t] = __expf(Ah * dt); }
        }
        __syncthreads();
        for (int t = 0; t < nt; ++t) {
            const float xv = xs[t * 64 + p], xdt = xv * dts[t], dec = decs[t];
            float yp = 0.f;
#pragma unroll
            for (int i = 0; i < 16; ++i) { S[i] = dec * S[i] + Bs[t * 128 + nq * 16 + i] * xdt; yp += Cs[t * 128 + nq * 16 + i] * S[i]; }
            yp += __shfl_xor(yp, 1); yp += __shfl_xor(yp, 2); yp += __shfl_xor(yp, 4);
            if (nq == 0) ys[t * 64 + p] = yp + Dh * xv;
        }
        __syncthreads();
        for (int t = tid >> 6; t < nt; t += 8) {
            const size_t row = rbase + l0 + t;
            const float z = bf2f(PROJ[row * LDP + C_Z + h * 64 + lane]);
            const float yg = ys[t * 64 + lane] * silu_f(z);
            PROJ[row * LDP + C_Z + h * 64 + lane] = (bf16)f2bf(yg);
            const float sq = wave_sum(yg * yg);
            if (lane == 0) SSDSQ[row * 16 + h] = sq;
        }
    }
    __syncthreads();
}
__device__ __forceinline__ void lru_item(const Args& a, LAS unsigned char* lds, int b, int h) {
    const int tid = threadIdx.x;
    constexpr int TB = 64;
    LAS float* Wa = (LAS float*)lds;
    LAS float* Wx = Wa + 4096;
    LAS float* xb = Wx + 4096;
    LAS float* as = xb + TB * 64;
    LAS float* us = as + TB * 64;
    bf16* PROJ = (bf16*)(a.ws + WS_PROJ);
    __syncthreads();
    for (int i = tid; i < 4096; i += 512) { Wa[i] = a.in[I_LWA][(size_t)h * 4096 + i]; Wx[i] = a.in[I_LWX][(size_t)h * 4096 + i]; }
    const size_t rbase = (size_t)b * LSEQ;
    float hprev = 0.f;
    const int c = tid & 63, tq = tid >> 6;
    const float* cw = a.in[I_LCW]; const int ch = h * 64 + c;
    const float cw0 = cw[ch], cw1 = cw[1024 + ch], cw2 = cw[2048 + ch], cw3 = cw[3072 + ch], cb = a.in[I_LCB][ch];
    const int gt = tid >> 3, jq = tid & 7;
    for (int l0 = 0; l0 < LSEQ; l0 += TB) {
        const int nt = (LSEQ - l0) < TB ? (LSEQ - l0) : TB;
        __syncthreads();
        for (int t = tq * 8; t < tq * 8 + 8; ++t) if (t < nt) {
            const int l = l0 + t; const size_t row = rbase + l;
            const float r3 = bf2f(PROJ[row * LDP + C_LI + ch]);
            const float r2 = l >= 1 ? bf2f(PROJ[(row - 1) * LDP + C_LI + ch]) : 0.f;
            const float r1 = l >= 2 ? bf2f(PROJ[(row - 2) * LDP + C_LI + ch]) : 0.f;
            const float r0 = l >= 3 ? bf2f(PROJ[(row - 3) * LDP + C_LI + ch]) : 0.f;
            xb[t * 64 + c] = cw0 * r0 + cw1 * r1 + cw2 * r2 + cw3 * r3 + cb;
        }
        __syncthreads();
        if (gt < nt) {
            float ra[8], ri[8];
#pragma unroll
            for (int j = 0; j < 8; ++j) { ra[j] = 0.f; ri[j] = 0.f; }
            for (int i = 0; i < 64; ++i) { const float xv = xb[gt * 64 + i];
#pragma unroll
                for (int j = 0; j < 8; ++j) { ra[j] += xv * Wa[i * 64 + jq * 8 + j]; ri[j] += xv * Wx[i * 64 + jq * 8 + j]; } }
#pragma unroll
            for (int j = 0; j < 8; ++j) { const int cc = h * 64 + jq * 8 + j;
                const float r = sigmoid_f(ra[j] + a.in[I_LBA][cc]), ig = sigmoid_f(ri[j] + a.in[I_LBX][cc]);
                const float log_a = -8.0f * r * softplus_f(-a.in[I_LLAM][cc]);
                const float av = __expf(log_a);
                const float mult = (l0 + gt == 0) ? 1.f : sqrtf(fmaxf(-expm1f(2.f * log_a), 0.f));
                as[gt * 64 + jq * 8 + j] = av; us[gt * 64 + jq * 8 + j] = mult * ig * xb[gt * 64 + jq * 8 + j]; }
        }
        __syncthreads();
        if (tid < 64) { for (int t = 0; t < nt; ++t) { hprev = as[t * 64 + tid] * hprev + us[t * 64 + tid]; us[t * 64 + tid] = hprev; } }
        __syncthreads();
        for (int t = tq * 8; t < tq * 8 + 8; ++t) if (t < nt) {
            const size_t row = rbase + l0 + t;
            const float gv = bf2f(PROJ[row * LDP + C_G + ch]);
            PROJ[row * LDP + C_G + ch] = (bf16)f2bf(us[t * 64 + c] * gelu_tanh_f(gv));
        }
    }
    __syncthreads();
}
__device__ __forceinline__ void ph_mixers(const Args& a, LAS unsigned char* lds, int wk, int nwk) {
    for (int it = wk; it < 256; it += nwk) {
        if (it < 128) ssd_item(a, lds, it >> 4, it & 15); else lru_item(a, lds, (it - 128) >> 4, (it - 128) & 15);
    }
}


__device__ __forceinline__ f32x4 mfma16(bf16x8 a, bf16x8 b, f32x4 c) { return __builtin_amdgcn_mfma_f32_16x16x32_bf16(a, b, c, 0, 0, 0); }
constexpr int RSX = 144, RSB = 272;
constexpr int SO_X = 0, SO_B = SO_X + 128 * RSX, SO_C = SO_B + 128 * RSB, SO_M = SO_C + 128 * RSB, SO_S = SO_M + 128 * RSB, SO_V = SO_S + 64 * RSB;
static_assert(SO_V + 4096 <= LDS_BYTES - 256, "ssd lds");
#define TR4(RS4, o0, o1, o2, o3, addr) do { v2u l0_, h0_, l1_, h1_, l2_, h2_, l3_, h3_; \
    asm volatile("ds_read_b64_tr_b16 %0, %8\n\tds_read_b64_tr_b16 %1, %8 offset:" #RS4 "\n\t" \
                 "ds_read_b64_tr_b16 %2, %8 offset:32\n\tds_read_b64_tr_b16 %3, %8 offset:" #RS4 "+32\n\t" \
                 "ds_read_b64_tr_b16 %4, %8 offset:64\n\tds_read_b64_tr_b16 %5, %8 offset:" #RS4 "+64\n\t" \
                 "ds_read_b64_tr_b16 %6, %8 offset:96\n\tds_read_b64_tr_b16 %7, %8 offset:" #RS4 "+96\n\ts_waitcnt lgkmcnt(0)" \
                 : "=&v"(l0_), "=&v"(h0_), "=&v"(l1_), "=&v"(h1_), "=&v"(l2_), "=&v"(h2_), "=&v"(l3_), "=&v"(h3_) : "v"(addr) : "memory"); \
    o0 = __builtin_bit_cast(bf16x8, (v4u){l0_.x, l0_.y, h0_.x, h0_.y}); o1 = __builtin_bit_cast(bf16x8, (v4u){l1_.x, l1_.y, h1_.x, h1_.y}); \
    o2 = __builtin_bit_cast(bf16x8, (v4u){l2_.x, l2_.y, h2_.x, h2_.y}); o3 = __builtin_bit_cast(bf16x8, (v4u){l3_.x, l3_.y, h3_.x, h3_.y}); } while (0)
#define TR1(RS4, o0, addr) do { v2u l0_, h0_; \
    asm volatile("ds_read_b64_tr_b16 %0, %2\n\tds_read_b64_tr_b16 %1, %2 offset:" #RS4 "\n\ts_waitcnt lgkmcnt(0)" : "=&v"(l0_), "=&v"(h0_) : "v"(addr) : "memory"); \
    o0 = __builtin_bit_cast(bf16x8, (v4u){l0_.x, l0_.y, h0_.x, h0_.y}); } while (0)
__device__ __forceinline__ void unpack8(const v4u r, float (&f)[8]) {
    f[0] = __uint_as_float(r.x << 16); f[1] = __uint_as_float(r.x & 0xffff0000u); f[2] = __uint_as_float(r.y << 16); f[3] = __uint_as_float(r.y & 0xffff0000u);
    f[4] = __uint_as_float(r.z << 16); f[5] = __uint_as_float(r.z & 0xffff0000u); f[6] = __uint_as_float(r.w << 16); f[7] = __uint_as_float(r.w & 0xffff0000u);
}
__device__ __forceinline__ void ph_conv(const Args& a, int wk, int nwk) {
    const bf16* PROJ = (const bf16*)(a.ws + WS_PROJ); bf16* XACT = (bf16*)(a.ws + WS_H); bf16* XLRU = (bf16*)a.out;
    for (int id = wk * 512 + (int)threadIdx.x; id < NB * 48 * 320; id += nwk * 512) {
        const int cg = id % 320, rr = id / 320, b = rr / 48, t0 = (rr % 48) * 43;
        const bool ssd = cg < 192; const int ch = ssd ? cg * 8 : (cg - 192) * 8;
        const float* cwp = ssd ? a.in[I_SCW] + ch : a.in[I_LCW] + ch; const int cst = ssd ? 1536 : 1024;
        float cw[4][8], cb[8];
#pragma unroll
        for (int k = 0; k < 4; ++k) { const f32x4 wa = *(const f32x4*)(cwp + k * cst), wb = *(const f32x4*)(cwp + k * cst + 4);
#pragma unroll
            for (int j = 0; j < 4; ++j) { cw[k][j] = wa[j]; cw[k][4 + j] = wb[j]; } }
        { const float* cbp = ssd ? a.in[I_SCB] + ch : a.in[I_LCB] + ch; const f32x4 wa = *(const f32x4*)cbp, wb = *(const f32x4*)(cbp + 4);
#pragma unroll
          for (int j = 0; j < 4; ++j) { cb[j] = wa[j]; cb[4 + j] = wb[j]; } }
        const size_t rb = (size_t)b * LSEQ;
        const bf16* src = PROJ + rb * LDP + 2048 + cg * 8;
        bf16* dst = ssd ? XACT + rb * 1536 + ch : XLRU + rb * 1024 + ch; const int dst_ld = ssd ? 1536 : 1024;
        float p0[8], p1[8], p2[8];
        {   v4u q0 = (v4u){0u, 0u, 0u, 0u}, q1 = q0, q2 = q0;
            if (t0 >= 3) { q0 = *(const v4u*)(src + (size_t)(t0 - 3) * LDP); q1 = *(const v4u*)(src + (size_t)(t0 - 2) * LDP); q2 = *(const v4u*)(src + (size_t)(t0 - 1) * LDP); }
            unpack8(q0, p0); unpack8(q1, p1); unpack8(q2, p2); }
#pragma unroll 4
        for (int t = 0; t < 43; ++t) {
            const int l = t0 + t; float p3[8]; unpack8(*(const v4u*)(src + (size_t)l * LDP), p3);
            float o[8];
#pragma unroll
            for (int j = 0; j < 8; ++j) { const float v = cw[0][j] * p0[j] + cw[1][j] * p1[j] + cw[2][j] * p2[j] + cw[3][j] * p3[j] + cb[j]; o[j] = ssd ? silu_f(v) : v; p0[j] = p1[j]; p1[j] = p2[j]; p2[j] = p3[j]; }
            v4u ov; ov.x = pk2(o[0], o[1]); ov.y = pk2(o[2], o[3]); ov.z = pk2(o[4], o[5]); ov.w = pk2(o[6], o[7]);
            *(v4u*)(dst + (size_t)l * dst_ld) = ov;
        }
    }
}
__device__ __forceinline__ void ssd_item3(const Args& a, LAS unsigned char* lds, int b, int h) {
    const int tid = threadIdx.x, lane = tid & 63, w = __builtin_amdgcn_readfirstlane(tid >> 6), fr = lane & 15, fq = lane >> 4;
    bf16* PROJ = (bf16*)(a.ws + WS_PROJ); const bf16* XACT = (const bf16*)(a.ws + WS_H); const float* DT = (const float*)(a.ws + WS_DT); float* SSDSQ = (float*)(a.ws + WS_SSDSQ);
    const int g = h >> 3;
    const float Ah = -__expf(a.in[I_ALOG][h]), Dh = a.in[I_SD][h];
    LAS float* acs = (LAS float*)(lds + SO_V); LAS float* dtv = acs + 128; LAS float* wv = acs + 256; LAS float* eacs = acs + 384;
    const size_t rbase = (size_t)b * LSEQ;
    const int pt_s = w & 3, nh = w >> 2;
    f32x4 sacc[4];
#pragma unroll
    for (int i = 0; i < 4; ++i) sacc[i] = (f32x4){0.f, 0.f, 0.f, 0.f};
    __syncthreads();
    for (int i = tid; i < 64 * RSB / 4; i += 512) ((LAS unsigned*)(lds + SO_S))[i] = 0u;
    v4u pf[10], zp[2]; float d0 = 0.f, d1 = 0.f;
    const int ft = tid >> 2, q4 = tid & 3;
    const int xr_ = tid >> 3, xp_ = tid & 7, br_ = tid >> 4, bp_ = tid & 15;
    const bf16* xsrc = XACT + (rbase + xr_) * 1536 + h * 64 + xp_ * 8;
    const bf16* bsrc = XACT + (rbase + br_) * 1536 + 1024 + g * 128 + bp_ * 8;
#define SSD_PREFETCH(L0) do { const int l0_ = (L0); \
        _Pragma("unroll") for (int i = 0; i < 2; ++i) { pf[i] = (v4u){0u, 0u, 0u, 0u}; if (l0_ + xr_ + 64 * i < LSEQ) pf[i] = *(const v4u*)(xsrc + (size_t)(l0_ + 64 * i) * 1536); } \
        _Pragma("unroll") for (int i = 0; i < 4; ++i) { pf[2 + i] = (v4u){0u, 0u, 0u, 0u}; pf[6 + i] = (v4u){0u, 0u, 0u, 0u}; \
            if (l0_ + br_ + 32 * i < LSEQ) { pf[2 + i] = *(const v4u*)(bsrc + (size_t)(l0_ + 32 * i) * 1536); pf[6 + i] = *(const v4u*)(bsrc + (size_t)(l0_ + 32 * i) * 1536 + 256); } } \
        zp[0] = (v4u){0u, 0u, 0u, 0u}; zp[1] = zp[0]; \
        if (l0_ + ft < LSEQ) { const bf16* zq = PROJ + (rbase + l0_ + ft) * LDP + C_Z + h * 64 + 16 * q4; zp[0] = *(const v4u*)zq; zp[1] = *(const v4u*)(zq + 8); } \
        if (w == 0) { d0 = (l0_ + lane) < LSEQ ? DT[(rbase + l0_ + lane) * 16 + h] : 0.f; d1 = (l0_ + lane + 64) < LSEQ ? DT[(rbase + l0_ + lane + 64) * 16 + h] : 0.f; } } while (0)
    SSD_PREFETCH(0);
    for (int l0 = 0; l0 < LSEQ; l0 += 128) {
        const int nvalid = (LSEQ - l0) < 128 ? (LSEQ - l0) : 128;
#pragma unroll
        for (int i = 0; i < 2; ++i) *(LAS v4u*)(lds + SO_X + (xr_ + 64 * i) * RSX + xp_ * 16) = pf[i];
#pragma unroll
        for (int i = 0; i < 4; ++i) { *(LAS v4u*)(lds + SO_B + (br_ + 32 * i) * RSB + bp_ * 16) = pf[2 + i]; *(LAS v4u*)(lds + SO_C + (br_ + 32 * i) * RSB + bp_ * 16) = pf[6 + i]; }
        const v4u z0 = zp[0], z1 = zp[1];
        if (w == 0) {
            float a0 = Ah * d0, a1 = Ah * d1;
#pragma unroll
            for (int o = 1; o < 64; o <<= 1) { const float v0 = __shfl_up(a0, o), v1 = __shfl_up(a1, o); if (lane >= o) { a0 += v0; a1 += v1; } }
            a1 += __shfl(a0, 63);
            const float aend = __shfl(a1, 63);
            acs[lane] = a0; acs[lane + 64] = a1; dtv[lane] = d0; dtv[lane + 64] = d1;
            wv[lane] = __expf(aend - a0) * d0; wv[lane + 64] = __expf(aend - a1) * d1; eacs[lane] = __expf(a0); eacs[lane + 64] = __expf(a1);
            if (lane == 0) acs[512] = aend;
        }
        __syncthreads();
        if (l0 + 128 < LSEQ) SSD_PREFETCH(l0 + 128);
        for (int hh = 0; hh < 2; ++hh) {
            f32x4 gacc[4];
#pragma unroll
            for (int st = 0; st < 4; ++st) gacc[st] = (f32x4){0.f, 0.f, 0.f, 0.f};
#pragma unroll
            for (int k0 = 0; k0 < 128; k0 += 32) {
                const bf16x8 cf = *(const LAS bf16x8*)(lds + SO_C + (16 * w + fr) * RSB + (k0 + 8 * fq) * 2);
#pragma unroll
                for (int st = 0; st < 4; ++st) { const bf16x8 bf = *(const LAS bf16x8*)(lds + SO_B + (16 * (4 * hh + st) + fr) * RSB + (k0 + 8 * fq) * 2); gacc[st] = mfma16(bf, cf, gacc[st]); }
            }
            const int l = 16 * w + fr; const float al = acs[l];
#pragma unroll
            for (int st = 0; st < 4; ++st) {
                const int s0 = 16 * (4 * hh + st) + 4 * fq; const f32x4 as = *(const LAS f32x4*)(acs + s0), ds = *(const LAS f32x4*)(dtv + s0);
                float m[4];
#pragma unroll
                for (int j = 0; j < 4; ++j) m[j] = (s0 + j <= l) ? gacc[st][j] * __expf(al - as[j]) * ds[j] : 0.f;
                v2u mv; mv.x = pk2(m[0], m[1]); mv.y = pk2(m[2], m[3]);
                *(LAS v2u*)(lds + SO_M + l * RSB + s0 * 2) = mv;
            }
        }
        __syncthreads();
        {
            f32x4 y[4];
#pragma unroll
            for (int pt = 0; pt < 4; ++pt) y[pt] = (f32x4){0.f, 0.f, 0.f, 0.f};
#pragma unroll
            for (int k0 = 0; k0 < 128; k0 += 32) {
                const bf16x8 cf = *(const LAS bf16x8*)(lds + SO_C + (16 * w + fr) * RSB + (k0 + 8 * fq) * 2);
#pragma unroll
                for (int pt = 0; pt < 4; ++pt) { const bf16x8 sf = *(const LAS bf16x8*)(lds + SO_S + (16 * pt + fr) * RSB + (k0 + 8 * fq) * 2); y[pt] = mfma16(cf, sf, y[pt]); }
                __builtin_amdgcn_sched_barrier(0);
            }
            const f32x4 ea = *(const LAS f32x4*)(eacs + 16 * w + 4 * fq);
#pragma unroll
            for (int pt = 0; pt < 4; ++pt) y[pt] *= ea;
            for (int k0 = 0; k0 <= 16 * w + 15; k0 += 32) {
                const bf16x8 mf = *(const LAS bf16x8*)(lds + SO_M + (16 * w + fr) * RSB + (k0 + 8 * fq) * 2);
                const unsigned xa = (unsigned)(size_t)(lds + SO_X) + (unsigned)((k0 + 8 * fq + (fr >> 2)) * RSX + (fr & 3) * 8);
                bf16x8 x0, x1, x2, x3; TR4(576, x0, x1, x2, x3, xa);
                y[0] = mfma16(mf, x0, y[0]); y[1] = mfma16(mf, x1, y[1]); y[2] = mfma16(mf, x2, y[2]); y[3] = mfma16(mf, x3, y[3]);
                __builtin_amdgcn_sched_barrier(0);
            }
#pragma unroll
            for (int pt = 0; pt < 4; ++pt)
#pragma unroll
                for (int r = 0; r < 4; ++r) *(LAS float*)(lds + SO_M + (16 * w + 4 * fq + r) * RSB + (16 * pt + fr) * 4) = y[pt][r];
        }
        {
            const float dec = __expf(acs[512]);
#pragma unroll
            for (int i = 0; i < 4; ++i) sacc[i] *= dec;
#pragma unroll
            for (int k0 = 0; k0 < 128; k0 += 32) {
                const unsigned xa = (unsigned)(size_t)(lds + SO_X) + (unsigned)((k0 + 8 * fq + (fr >> 2)) * RSX + pt_s * 32 + (fr & 3) * 8);
                bf16x8 xf; TR1(576, xf, xa);
                const f32x4 w0 = *(const LAS f32x4*)(wv + k0 + 8 * fq), w1 = *(const LAS f32x4*)(wv + k0 + 8 * fq + 4);
                float xv[8]; unpack8(__builtin_bit_cast(v4u, xf), xv);
                v4u xs; xs.x = pk2(xv[0] * w0[0], xv[1] * w0[1]); xs.y = pk2(xv[2] * w0[2], xv[3] * w0[3]); xs.z = pk2(xv[4] * w1[0], xv[5] * w1[1]); xs.w = pk2(xv[6] * w1[2], xv[7] * w1[3]);
                const bf16x8 xw = __builtin_bit_cast(bf16x8, xs);
                const unsigned ba = (unsigned)(size_t)(lds + SO_B) + (unsigned)((k0 + 8 * fq + (fr >> 2)) * RSB + nh * 128 + (fr & 3) * 8);
                bf16x8 b0, b1, b2, b3; TR4(1088, b0, b1, b2, b3, ba);
                sacc[0] = mfma16(xw, b0, sacc[0]); sacc[1] = mfma16(xw, b1, sacc[1]); sacc[2] = mfma16(xw, b2, sacc[2]); sacc[3] = mfma16(xw, b3, sacc[3]);
                __builtin_amdgcn_sched_barrier(0);
            }
        }
        __syncthreads();
#pragma unroll
        for (int i = 0; i < 4; ++i)
#pragma unroll
            for (int r = 0; r < 4; ++r) *(LAS bf16*)(lds + SO_S + (16 * pt_s + 4 * fq + r) * RSB + (16 * (4 * nh + i) + fr) * 2) = (bf16)f2bf(sacc[i][r]);
        if (ft < nvalid) {
            const size_t row = rbase + l0 + ft;
            bf16* zq = PROJ + row * LDP + C_Z + h * 64 + 16 * q4;
            const v4u x0 = *(const LAS v4u*)(lds + SO_X + ft * RSX + q4 * 32), x1 = *(const LAS v4u*)(lds + SO_X + ft * RSX + q4 * 32 + 16);
            float zf[16], xf[16], yo[16];
            { float tmp[8]; unpack8(z0, tmp);
#pragma unroll
              for (int j = 0; j < 8; ++j) zf[j] = tmp[j];
              unpack8(z1, tmp);
#pragma unroll
              for (int j = 0; j < 8; ++j) zf[8 + j] = tmp[j];
              unpack8(x0, tmp);
#pragma unroll
              for (int j = 0; j < 8; ++j) xf[j] = tmp[j];
              unpack8(x1, tmp);
#pragma unroll
              for (int j = 0; j < 8; ++j) xf[8 + j] = tmp[j]; }
            float sq = 0.f;
#pragma unroll
            for (int j4 = 0; j4 < 4; ++j4) { const f32x4 yv = *(const LAS f32x4*)(lds + SO_M + ft * RSB + (16 * q4 + 4 * j4) * 4);
#pragma unroll
                for (int j = 0; j < 4; ++j) { const float v = (yv[j] + Dh * xf[4 * j4 + j]) * silu_f(zf[4 * j4 + j]); yo[4 * j4 + j] = v; sq += v * v; } }
            v4u o0, o1; o0.x = pk2(yo[0], yo[1]); o0.y = pk2(yo[2], yo[3]); o0.z = pk2(yo[4], yo[5]); o0.w = pk2(yo[6], yo[7]);
            o1.x = pk2(yo[8], yo[9]); o1.y = pk2(yo[10], yo[11]); o1.z = pk2(yo[12], yo[13]); o1.w = pk2(yo[14], yo[15]);
            *(v4u*)zq = o0; *(v4u*)(zq + 8) = o1;
            sq += __shfl_xor(sq, 1); sq += __shfl_xor(sq, 2);
            if (q4 == 0) SSDSQ[row * 16 + h] = sq;
        }
        __syncthreads();
    }
#undef SSD_PREFETCH
}
constexpr int LO_XB = 0, LO_XF = LO_XB + 128 * RSX, LO_A = LO_XF + 128 * 260, LO_U = LO_A + 128 * 260, LO_WA = LO_U + 128 * 260, LO_WX = LO_WA + 64 * RSX, LO_SC = LO_WX + 64 * RSX;
static_assert(LO_SC + 17 * 256 <= LDS_BYTES - 256, "lru lds");
__device__ __forceinline__ void lru_item3(const Args& a, LAS unsigned char* lds, int b, int h) {
    const int tid = threadIdx.x, lane = tid & 63, w = __builtin_amdgcn_readfirstlane(tid >> 6), fr = lane & 15, fq = lane >> 4;
    bf16* PROJ = (bf16*)(a.ws + WS_PROJ); const bf16* XLRU = (const bf16*)a.out;
    const size_t rbase = (size_t)b * LSEQ;
    LAS float* segP = (LAS float*)(lds + LO_SC); LAS float* segH = segP + 512; LAS float* carry = segH + 512;
    __syncthreads();
    for (int i = tid; i < 4096; i += 512) { const int ii = i >> 6, j = i & 63;
        *(LAS bf16*)(lds + LO_WA + j * RSX + ii * 2) = (bf16)f2bf(a.in[I_LWA][(size_t)h * 4096 + i]);
        *(LAS bf16*)(lds + LO_WX + j * RSX + ii * 2) = (bf16)f2bf(a.in[I_LWX][(size_t)h * 4096 + i]); }
    if (tid < 64) carry[tid] = 0.f;
    float gba[4], gbx[4], gsp[4];
#pragma unroll
    for (int jt = 0; jt < 4; ++jt) { const int c = h * 64 + 16 * jt + fr; gba[jt] = a.in[I_LBA][c]; gbx[jt] = a.in[I_LBX][c]; gsp[jt] = softplus_f(-a.in[I_LLAM][c]); }
    const int ft = tid >> 2, q4 = tid & 3;
    v4u xp[2], gp[2];
#define LRU_PREFETCH(L0) do { const int l0_ = (L0); \
        _Pragma("unroll") for (int i = 0; i < 2; ++i) { const int q = tid + 512 * i, row = q >> 3, pc = q & 7; xp[i] = (v4u){0u, 0u, 0u, 0u}; \
            if (l0_ + row < LSEQ) xp[i] = *(const v4u*)(XLRU + (rbase + l0_ + row) * 1024 + h * 64 + pc * 8); } \
        gp[0] = (v4u){0u, 0u, 0u, 0u}; gp[1] = gp[0]; \
        if (l0_ + ft < LSEQ) { const bf16* gq = PROJ + (rbase + l0_ + ft) * LDP + C_G + h * 64 + 16 * q4; gp[0] = *(const v4u*)gq; gp[1] = *(const v4u*)(gq + 8); } } while (0)
    LRU_PREFETCH(0);
    for (int l0 = 0; l0 < LSEQ; l0 += 128) {
        const int nvalid = (LSEQ - l0) < 128 ? (LSEQ - l0) : 128;
#pragma unroll
        for (int i = 0; i < 2; ++i) { const int q = tid + 512 * i, row = q >> 3, pc = q & 7;
            *(LAS v4u*)(lds + LO_XB + row * RSX + pc * 16) = xp[i];
            float xv[8]; unpack8(xp[i], xv);
#pragma unroll
            for (int j = 0; j < 8; ++j) *(LAS float*)(lds + LO_XF + row * 260 + (pc * 8 + j) * 4) = xv[j]; }
        const v4u g0 = gp[0], g1 = gp[1];
        __syncthreads();
        if (l0 + 128 < LSEQ) LRU_PREFETCH(l0 + 128);
        {
            f32x4 ga[4], gx[4];
#pragma unroll
            for (int jt = 0; jt < 4; ++jt) { ga[jt] = (f32x4){0.f, 0.f, 0.f, 0.f}; gx[jt] = ga[jt]; }
#pragma unroll
            for (int k0 = 0; k0 < 64; k0 += 32) {
                const bf16x8 xf = *(const LAS bf16x8*)(lds + LO_XB + (16 * w + fr) * RSX + (k0 + 8 * fq) * 2);
#pragma unroll
                for (int jt = 0; jt < 4; ++jt) {
                    const bf16x8 wa = *(const LAS bf16x8*)(lds + LO_WA + (16 * jt + fr) * RSX + (k0 + 8 * fq) * 2), wx = *(const LAS bf16x8*)(lds + LO_WX + (16 * jt + fr) * RSX + (k0 + 8 * fq) * 2);
                    ga[jt] = mfma16(xf, wa, ga[jt]); gx[jt] = mfma16(xf, wx, gx[jt]); }
            }
#pragma unroll
            for (int jt = 0; jt < 4; ++jt)
#pragma unroll
                for (int r = 0; r < 4; ++r) { const int l = 16 * w + 4 * fq + r, j = 16 * jt + fr;
                    const float rr = sigmoid_f(ga[jt][r] + gba[jt]), ig = sigmoid_f(gx[jt][r] + gbx[jt]);
                    const float log_a = -8.0f * rr * gsp[jt];
                    const float av = __expf(log_a);
                    const float t2 = 2.f * log_a;
                    const float om = t2 > -0.1f ? -t2 * (1.f + t2 * (0.5f + t2 * (0.16666667f + t2 * 0.041666668f))) : 1.f - av * av;
                    const float mult = (l0 + l == 0) ? 1.f : __builtin_amdgcn_sqrtf(fmaxf(om, 0.f));
                    const float xv = *(const LAS float*)(lds + LO_XF + l * 260 + j * 4);
                    *(LAS float*)(lds + LO_A + l * 260 + j * 4) = av; *(LAS float*)(lds + LO_U + l * 260 + j * 4) = mult * ig * xv; }
        }
        __syncthreads();
        {
            float P = 1.f, Hl = 0.f;
#pragma unroll
            for (int t = 0; t < 16; ++t) { const float av = *(const LAS float*)(lds + LO_A + (16 * w + t) * 260 + lane * 4), uv = *(const LAS float*)(lds + LO_U + (16 * w + t) * 260 + lane * 4); Hl = av * Hl + uv; P *= av; }
            segP[w * 64 + lane] = P; segH[w * 64 + lane] = Hl;
            __syncthreads();
            float hin = carry[lane];
            for (int s2 = 0; s2 < w; ++s2) hin = segP[s2 * 64 + lane] * hin + segH[s2 * 64 + lane];
#pragma unroll
            for (int t = 0; t < 16; ++t) { LAS float* up = (LAS float*)(lds + LO_U + (16 * w + t) * 260 + lane * 4); hin = *(const LAS float*)(lds + LO_A + (16 * w + t) * 260 + lane * 4) * hin + *up; *up = hin; }
            __syncthreads();
            if (w == 7) carry[lane] = hin;
        }
        if (ft < nvalid) {
            const size_t row = rbase + l0 + ft;
            bf16* gq = PROJ + row * LDP + C_G + h * 64 + 16 * q4;
            float gf[16], yo[16];
            { float tmp[8]; unpack8(g0, tmp);
#pragma unroll
              for (int j = 0; j < 8; ++j) gf[j] = tmp[j];
              unpack8(g1, tmp);
#pragma unroll
              for (int j = 0; j < 8; ++j) gf[8 + j] = tmp[j]; }
#pragma unroll
            for (int j = 0; j < 16; ++j) yo[j] = *(const LAS float*)(lds + LO_U + ft * 260 + (16 * q4 + j) * 4) * gelu_tanh_f(gf[j]);
            v4u o0, o1; o0.x = pk2(yo[0], yo[1]); o0.y = pk2(yo[2], yo[3]); o0.z = pk2(yo[4], yo[5]); o0.w = pk2(yo[6], yo[7]);
            o1.x = pk2(yo[8], yo[9]); o1.y = pk2(yo[10], yo[11]); o1.z = pk2(yo[12], yo[13]); o1.w = pk2(yo[14], yo[15]);
            *(v4u*)gq = o0; *(v4u*)(gq + 8) = o1;
        }
        __syncthreads();
    }
#undef LRU_PREFETCH
}
__device__ __forceinline__ void ph_mixers3(const Args& a, LAS unsigned char* lds, int wk, int nwk) {
    for (int it = wk; it < 256; it += nwk) if (it < 128) ssd_item3(a, lds, it >> 4, it & 15);
    for (int it = wk; it < 256; it += nwk) if (it >= 128) lru_item3(a, lds, (it - 128) >> 4, (it - 128) & 15);
}

__device__ __forceinline__ void ph_router(const Args& a, LAS unsigned char* lds, int L, int wk, int nwk) {
    const int tid = threadIdx.x, lane = tid & 63, wave = __builtin_amdgcn_readfirstlane(tid >> 6);
    const int gw = wk * NWAVES + wave, NGW = nwk * NWAVES;
    if (L == 0) { convert_experts(a, 1, (LAS float*)(lds + wave * 8448), gw, NGW, lane); }
    LAS float* wr = (LAS float*)lds;
    LAS int* lcnt = (LAS int*)(lds + 81920); LAS int* gbase = lcnt + 32; LAS int* rinfo = lcnt + 64;
    const float* WRT = (const float*)(a.ws + WS_WRT) + (size_t)L * 20480;
    __syncthreads();
    for (int i = tid; i < 20480 / 4; i += 512) ((LAS f32x4*)wr)[i] = ((const f32x4*)WRT)[i];
    if (tid < 32) lcnt[tid] = 0;
    __syncthreads();
    const bf16* HBr = (const bf16*)a.out;
    float* RSTD1 = (float*)(a.ws + WS_RSTD1); float* GATES = (float*)(a.ws + WS_GATES); int* LIST = (int*)(a.ws + WS_LIST);
    unsigned* cnt = (unsigned*)(a.ws + WS_CTL) + CW_CNT + 1024 * L;
    const float* bg = a.in[I_RGB] + L * 4; const float* be = a.in[I_REB] + L * 16;
    int it = 0;
    for (int row = gw; row < T; row += NGW, ++it) {
        const v4u* xr = (const v4u*)(HBr + (size_t)row * D) + lane;
        f32x4 v[4]; float ss = 0.f;
        unpack8v(xr[0], v[0], v[1]); unpack8v(xr[64], v[2], v[3]);
#pragma unroll
        for (int j = 0; j < 4; ++j) ss += v[j].x * v[j].x + v[j].y * v[j].y + v[j].z * v[j].z + v[j].w * v[j].w;
        ss = wave_sum(ss);
        const float rstd = rsqrtf(ss * (1.f / D) + EPS);
        float mylg = 0.f;
#pragma unroll 2
        for (int jj = 0; jj < 20; ++jj) {
            float s = 0.f;
#pragma unroll
            for (int j = 0; j < 4; ++j) { const f32x4 w = *(const LAS f32x4*)(wr + jj * 1024 + (j >> 1) * 512 + lane * 8 + (j & 1) * 4); s += v[j].x * w.x + v[j].y * w.y + v[j].z * w.z + v[j].w * w.w; }
            s = wave_sum(s);
            if (lane == jj) mylg = s;
        }
        mylg = mylg * rstd + (lane < 4 ? bg[lane & 3] : be[(lane - 4) & 15]);
        float lg[20];
#pragma unroll
        for (int jj = 0; jj < 20; ++jj) lg[jj] = __shfl(mylg, jj);
        int gs = 0; float gm = lg[0];
#pragma unroll
        for (int j = 1; j < 4; ++j) if (lg[j] > gm) { gm = lg[j]; gs = j; }
        const float pg = 1.f / (__expf(lg[0] - gm) + __expf(lg[1] - gm) + __expf(lg[2] - gm) + __expf(lg[3] - gm));
        float f[4];
#pragma unroll
        for (int i = 0; i < 4; ++i) f[i] = gs == 0 ? lg[4 + i] : (gs == 1 ? lg[8 + i] : (gs == 2 ? lg[12 + i] : lg[16 + i]));
        int i0 = 0; float m0 = f[0];
#pragma unroll
        for (int i = 1; i < 4; ++i) if (f[i] > m0) { m0 = f[i]; i0 = i; }
        int i1 = -1; float m1 = -3.0e38f;
#pragma unroll
        for (int i = 0; i < 4; ++i) if (i != i0 && f[i] > m1) { m1 = f[i]; i1 = i; }
        const float w0 = 1.f / (1.f + __expf(m1 - m0)), w1 = 1.f - w0;
        const int lo = i0 < i1 ? i0 : i1, hi = i0 < i1 ? i1 : i0;
        const float glo = pg * (i0 < i1 ? w0 : w1), ghi = pg * (i0 < i1 ? w1 : w0);
        const int pair = lo == 0 ? hi - 1 : (lo == 1 ? hi + 1 : 5);
        const int bk = gs * 6 + pair;
        if (lane == 0) {
            const int ls = __hip_atomic_fetch_add(lcnt + bk, 1, __ATOMIC_RELAXED, __HIP_MEMORY_SCOPE_WORKGROUP);
            rinfo[it * NWAVES + wave] = bk | (ls << 8);
            RSTD1[row] = rstd; GATES[(size_t)row * 2] = glo; GATES[(size_t)row * 2 + 1] = ghi;
        }
    }
    __syncthreads();
    if (tid < NBK) gbase[tid] = (int)atomicAdd(cnt + 32 * tid, (unsigned)lcnt[tid]);
    __syncthreads();
    it = 0;
    for (int row = gw; row < T; row += NGW, ++it)
        if (lane == 0) { const int info = rinfo[it * NWAVES + wave], bk = info & 255; LIST[(size_t)bk * T + gbase[bk] + (info >> 8)] = row; }
}

struct BkTab { int cnt[NBK], off[NBK], ust[NBK + 1]; };
__device__ __forceinline__ void bk_table(const Args& a, LAS unsigned char* lds, int L, int per_tile  ) {
    LAS int* tb = (LAS int*)lds;
    __syncthreads();
    if (threadIdx.x == 0) {
        const unsigned* cnt = (const unsigned*)(a.ws + WS_CTL) + CW_CNT + 1024 * L;
        int off = 0, us = 0;
        for (int i = 0; i < NBK; ++i) { const int c = (int)__hip_atomic_load(cnt + 32 * i, __ATOMIC_RELAXED, __HIP_MEMORY_SCOPE_AGENT);
            tb[i] = c; tb[NBK + i] = off; tb[2 * NBK + i] = us; off += (c + 255) & ~255; us += ((c + 63) >> 6) * per_tile; }
        tb[2 * NBK + NBK] = us;
    }
    __syncthreads();
}
__device__ __forceinline__ void bk_experts(int bk, int& elo, int& ehi) {
    const int g = bk / 6, pr = bk - g * 6;
    const int lo = pr < 3 ? 0 : (pr < 5 ? 1 : 2), hi = pr < 3 ? pr + 1 : (pr < 5 ? pr - 1 : 3);
    elo = g * 4 + lo; ehi = g * 4 + hi;
}
__device__ __forceinline__ void ph_moe_up(const Args& a, LAS unsigned char* lds, int L, int wk, int nwk) {
    const int tid = threadIdx.x, lane = tid & 63, wave = __builtin_amdgcn_readfirstlane(tid >> 6), fr = lane & 15, fq = lane >> 4;
    const int gw = wk * NWAVES + wave, NGW = nwk * NWAVES;
    bk_table(a, lds, L, 32);
    LAS int* tb = (LAS int*)lds;
    const bf16* HB = (const bf16*)a.out; const bf16* WGU = (const bf16*)(a.ws + WS_WGU); bf16* HID = (bf16*)(a.ws + WS_HID);
    const int* LIST = (const int*)(a.ws + WS_LIST); const float* RSTD1 = (const float*)(a.ws + WS_RSTD1); const float* GATES = (const float*)(a.ws + WS_GATES);
    const int nun = tb[2 * NBK + NBK];
    for (int u = gw; u < nun; u += NGW) {
        int bk = 0;
        for (int i = 1; i < NBK; ++i) if (u >= tb[2 * NBK + i]) bk = i;
        const int cnt = tb[bk], off = tb[NBK + bk], r = u - tb[2 * NBK + bk];
        const int rt = r >> 5, ek = (r >> 4) & 1, ct = r & 15;
        int elo, ehi; bk_experts(bk, elo, ehi); const int e = ek ? ehi : elo;
        const int c0 = ct * 32, brow = e * 1024 + (c0 >> 7) * 256 + (c0 & 127);
        const bf16* arow[4]; int tok[4];
#pragma unroll
        for (int mi = 0; mi < 4; ++mi) { int rr = rt * 64 + 16 * mi + fr; if (rr >= cnt) rr = cnt - 1; tok[mi] = LIST[(size_t)bk * T + rr]; arow[mi] = HB + (size_t)tok[mi] * D; }
        f32x4 acc[4][4]; zero_acc(acc);
        sg_kloop<4>(1024, arow, [=](int n, int k0) { return WGU + (size_t)(brow + (n < 32 ? n : n + 96)) * 1024 + k0; }, NoKS(), acc, fr, fq);
#pragma unroll
        for (int mi = 0; mi < 4; ++mi) { const int rr = rt * 64 + 16 * mi + fr;
            if (rr < cnt) { const float rs = RSTD1[tok[mi]], gt = GATES[(size_t)tok[mi] * 2 + ek];
#pragma unroll
                for (int nj = 0; nj < 2; ++nj) { const f32x4 gv = acc[mi][nj] * rs, uv = acc[mi][nj + 2] * rs; f32x4 hv;
                    hv.x = silu_f(gv.x) * uv.x * gt; hv.y = silu_f(gv.y) * uv.y * gt; hv.z = silu_f(gv.z) * uv.z * gt; hv.w = silu_f(gv.w) * uv.w * gt;
                    v2u w; w.x = pk2(hv.x, hv.y); w.y = pk2(hv.z, hv.w);
                    *(v2u*)(HID + (size_t)(off + rr) * 1024 + ek * 512 + c0 + 16 * nj + 4 * fq) = w; } } }
    }
}
__device__ __forceinline__ void ph_moe_down(const Args& a, LAS unsigned char* lds, int L, int wk, int nwk) {
    const int tid = threadIdx.x, lane = tid & 63, wave = __builtin_amdgcn_readfirstlane(tid >> 6), fr = lane & 15, fq = lane >> 4;
    const int gw = wk * NWAVES + wave, NGW = nwk * NWAVES;
    bk_table(a, lds, L, 16);
    LAS int* tb = (LAS int*)lds;
    const bf16* HID = (const bf16*)(a.ws + WS_HID); const bf16* WD = (const bf16*)(a.ws + WS_WD);
    float* H = (float*)(a.ws + WS_H); bf16* HB = (bf16*)a.out; const int* LIST = (const int*)(a.ws + WS_LIST);
    const int nun = tb[2 * NBK + NBK];
    for (int u = gw; u < nun; u += NGW) {
        int bk = 0;
        for (int i = 1; i < NBK; ++i) if (u >= tb[2 * NBK + i]) bk = i;
        const int cnt = tb[bk], off = tb[NBK + bk], r = u - tb[2 * NBK + bk];
        const int rt = r >> 4, ct = r & 15;
        int elo, ehi; bk_experts(bk, elo, ehi);
        const bf16* arow[4];
#pragma unroll
        for (int mi = 0; mi < 4; ++mi) arow[mi] = HID + (size_t)(off + rt * 64 + 16 * mi + fr) * 1024;
        f32x4 acc[4][4]; zero_acc(acc);
        sg_kloop<4>(1024, arow, [=](int n, int k0) { return WD + ((size_t)((k0 < 512 ? elo : ehi) * 1024 + ct * 64 + n)) * 512 + (k0 & 511); }, NoKS(), acc, fr, fq);
#pragma unroll
        for (int mi = 0; mi < 4; ++mi) { const int rr = rt * 64 + 16 * mi + fr;
            if (rr < cnt) { const int tok = LIST[(size_t)bk * T + rr];
#pragma unroll
                for (int nj = 0; nj < 4; ++nj) { const int c = ct * 64 + 16 * nj + 4 * fq; float* hp = H + (size_t)tok * D + c;
                    const f32x4 v = *(const f32x4*)hp + acc[mi][nj]; *(f32x4*)hp = v;
                    v2u w; w.x = pk2(v.x, v.y); w.y = pk2(v.z, v.w); *(v2u*)(HB + (size_t)tok * D + c) = w; } } }
    }
}


__device__ __forceinline__ void hb_store4(bf16* HB, int row, int col, const f32x4 v) {
    v2u w; w.x = pg8::cvt_pk_bf16(v[0], v[1]); w.y = pg8::cvt_pk_bf16(v[2], v[3]); *(v2u*)(HB + (size_t)row * D + col) = w;
}
__device__ __forceinline__ void hb_store8(bf16* HB, int row, int col, const f32x4 v0, const f32x4 v1) {
    v4u w; w.x = pg8::cvt_pk_bf16(v0[0], v0[1]); w.y = pg8::cvt_pk_bf16(v0[2], v0[3]); w.z = pg8::cvt_pk_bf16(v1[0], v1[1]); w.w = pg8::cvt_pk_bf16(v1[2], v1[3]);
    *(v4u*)(HB + (size_t)row * D + col) = w;
}
constexpr int LDS_TAB = 131072;

struct PGemm2 {
    static constexpr bool PERM = true;
    struct Unit { int pm, pn, ui; };
    const Args* ap; const char* A; const char* B; bf16* HB; int G, c; int ldb, nt;
    __device__ __forceinline__ bool next(int i, Unit& u) const { u.ui = i; return pg8::static_order(64, 4, G, c, i, u.pm, u.pn); }
    __device__ __forceinline__ void avoff(const Unit& u, const int (&RA)[2], const int (&CA)[2], unsigned (&v)[4]) const {
#pragma unroll
        for (int h = 0; h < 2; ++h)
#pragma unroll
            for (int i = 0; i < 2; ++i) { const int row = u.pm * 256 + h * 128 + RA[i]; v[h * 2 + i] = (unsigned)(row * LDP + CA[i]) * 2u; }
    }
    __device__ __forceinline__ const char* abase(const Unit&) const { return A; }
    __device__ __forceinline__ const char* btile(const Unit& u, int t) const { return B + ((size_t)u.pn * 256 * 2048 + (size_t)t * 64) * 2; }
    __device__ __forceinline__ void khook(int t, pg8::Acc& acc, const Unit& u, LAS unsigned char* lds, int wr, int wc, int fr, int fq) const {
        if (t == 8 || t == 16) {
            const LAS float* ft = (const LAS float*)(lds + LDS_TAB) + u.ui * 512 + (t == 16 ? 1 : 0);
#pragma unroll
            for (int ai = 0; ai < 2; ++ai)
#pragma unroll
                for (int m = 0; m < 4; ++m) { const float f = ft[(ai * 128 + wr * 64 + m * 16 + fr) * 2];
#pragma unroll
                    for (int bj = 0; bj < 2; ++bj)
#pragma unroll
                        for (int n = 0; n < 2; ++n) acc[ai][bj][m][n] *= f; }
        }
    }
    __device__ __forceinline__ void epi(const pg8::Acc& acc, const Unit& u, int wr, int wc, int fr, int fq) const {
        const int row0 = u.pm * 256 + wr * 64 + fr, col0 = u.pn * 256 + wc * 32 + 8 * fq;
#pragma unroll
        for (int ai = 0; ai < 2; ++ai)
#pragma unroll
            for (int m = 0; m < 4; ++m) { const int row = row0 + ai * 128 + m * 16; const float* hr = h0_row(*ap, row);
#pragma unroll
                for (int bj = 0; bj < 2; ++bj) { const int col = col0 + bj * 128;
                    hb_store8(HB, row, col, acc[ai][bj][m][0] + *(const f32x4*)(hr + col), acc[ai][bj][m][1] + *(const f32x4*)(hr + col + 4)); } }
    }
};
__device__ __forceinline__ void ssd_factors(const float* SSDSQ, int row, float& f0, float& f1) {
    const f32x4* sq = (const f32x4*)(SSDSQ + (size_t)row * 16); const f32x4 q0 = sq[0], q1 = sq[1], q2 = sq[2], q3 = sq[3];
    const float s0 = (q0.x + q0.y + q0.z + q0.w) + (q1.x + q1.y + q1.z + q1.w), s1 = (q2.x + q2.y + q2.z + q2.w) + (q3.x + q3.y + q3.z + q3.w);
    const float r0 = rsqrtf(s0 * (1.f / 512.f) + EPS), r1 = rsqrtf(s1 * (1.f / 512.f) + EPS);
    f0 = r0 / r1; f1 = r1;
}
__device__ __forceinline__ void ph_gemm2_pg8(const Args& a, LAS unsigned char* lds, int wk, int G) {
    const int tid = threadIdx.x, lane = tid & 63, wave = __builtin_amdgcn_readfirstlane(tid >> 6), fr = lane & 15, fq = lane >> 4;
    const float* SSDSQ = (const float*)(a.ws + WS_SSDSQ);
    PGemm2 S; S.ap = &a; S.A = (const char*)(a.ws + WS_PROJ); S.B = (const char*)(a.ws + WS_WOUT); S.HB = (bf16*)a.out;
    S.G = G; S.c = (int)blockIdx.x; S.ldb = 2048; S.nt = 32;
    {
        LAS float* ft = (LAS float*)(lds + LDS_TAB);
        PGemm2::Unit u;
        for (int i = 0; i < 4 && S.next(i, u); ++i)
            if (tid < 256) { float f0, f1; ssd_factors(SSDSQ, u.pm * 256 + tid, f0, f1); ft[i * 512 + tid * 2] = f0; ft[i * 512 + tid * 2 + 1] = f1; }
        __syncthreads();
    }
    pg8::gemm_phase<PGemm2, true>(lds, S);
    const bf16* PROJ = (const bf16*)(a.ws + WS_PROJ); const bf16* WOUT = (const bf16*)(a.ws + WS_WOUT);
    for (int tile = wk; tile < 32; tile += G) {
        const int rt = tile >> 4, ct = tile & 15, kb = wave * 256;
        const bf16* arow[4];
#pragma unroll
        for (int mi = 0; mi < 4; ++mi) arow[mi] = PROJ + (size_t)(16384 + rt * 64 + 16 * mi + fr) * LDP + kb;
        f32x4 acc[4][4]; zero_acc(acc);
        sg_kloop<4>(256, arow, [=](int n, int k0) { return WOUT + (size_t)(ct * 64 + n) * 2048 + kb + k0; }, NoKS(), acc, fr, fq);
        LAS float* part = (LAS float*)lds + wave * 4096;
        __syncthreads();
#pragma unroll
        for (int mi = 0; mi < 4; ++mi) { const int r = 16 * mi + fr; float f0, f1; ssd_factors(SSDSQ, 16384 + rt * 64 + r, f0, f1);
            const float sc = wave < 2 ? f0 * f1 : (wave < 4 ? f1 : 1.f);
#pragma unroll
            for (int nj = 0; nj < 4; ++nj) *(LAS f32x4*)(part + r * 64 + 16 * nj + 4 * fq) = acc[mi][nj] * sc; }
        __syncthreads();
        for (int q = tid; q < 1024; q += 512) { const int r = q >> 4, c4 = (q & 15) * 4; f32x4 s = *(const LAS f32x4*)((LAS float*)lds + r * 64 + c4);
#pragma unroll
            for (int w = 1; w < 8; ++w) s += *(const LAS f32x4*)((LAS float*)lds + w * 4096 + r * 64 + c4);
            const int row = 16384 + rt * 64 + r, col = ct * 64 + c4;
            hb_store4(S.HB, row, col, s + *(const f32x4*)(h0_row(a, row) + col)); }
        __syncthreads();
    }
}

struct BkInfo { int bk, rt, cnt, off; };
__device__ __forceinline__ void bk_table256(const Args& a, LAS unsigned char* lds, int L) {
    LAS int* tb = (LAS int*)(lds + LDS_TAB);
    __syncthreads();
    if (threadIdx.x == 0) {
        const unsigned* cnt = (const unsigned*)(a.ws + WS_CTL) + CW_CNT + 1024 * L;
        int off = 0, rts = 0;
        for (int i = 0; i < NBK; ++i) { const int c = (int)__hip_atomic_load(cnt + 32 * i, __ATOMIC_RELAXED, __HIP_MEMORY_SCOPE_AGENT);
            tb[i] = c; tb[NBK + i] = off; tb[2 * NBK + i] = rts; off += (c + 255) & ~255; rts += (c + 255) >> 8; }
        tb[2 * NBK + NBK] = rts;
    }
    __syncthreads();
}
__device__ __forceinline__ bool bk_find(const LAS int* tb, int rti, BkInfo& o) {
    if (rti >= tb[2 * NBK + NBK]) return false;
    int bk = 0;
    for (int i = 1; i < NBK; ++i) if (rti >= tb[2 * NBK + i]) bk = i;
    o.bk = bk; o.rt = rti - tb[2 * NBK + bk]; o.cnt = tb[bk]; o.off = tb[NBK + bk]; return true;
}
struct PMoeUp {
    static constexpr bool PERM = true;
    struct Unit { int bk, rt, cnt, off, e, ek, pnl, ui; };
    const char* A; const char* B; bf16* HID; const float* rstd; const float* gates; const LAS int* tb; const LAS int* rowtab; int G, c; int ldb, nt;
    __device__ __forceinline__ bool next(int i, Unit& u) const {
        const int Lu = i * G + c; BkInfo o; if (!bk_find(tb, Lu >> 3, o)) return false;
        u.bk = o.bk; u.rt = o.rt; u.cnt = o.cnt; u.off = o.off; u.ek = (Lu >> 2) & 1; u.pnl = Lu & 3; u.ui = i;
        int elo, ehi; bk_experts(o.bk, elo, ehi); u.e = u.ek ? ehi : elo; return true;
    }
    __device__ __forceinline__ void avoff(const Unit& u, const int (&RA)[2], const int (&CA)[2], unsigned (&v)[4]) const {
#pragma unroll
        for (int h = 0; h < 2; ++h)
#pragma unroll
            for (int i = 0; i < 2; ++i) { const int tok = rowtab[u.ui * 256 + h * 128 + RA[i]]; v[h * 2 + i] = (unsigned)(tok * D + CA[i]) * 2u; }
    }
    __device__ __forceinline__ const char* abase(const Unit&) const { return A; }
    __device__ __forceinline__ const char* btile(const Unit& u, int t) const { return B + ((size_t)(u.e * 1024 + u.pnl * 256) * 1024 + (size_t)t * 64) * 2; }
    __device__ __forceinline__ void khook(int, pg8::Acc&, const Unit&, LAS unsigned char*, int, int, int, int) const {}
    __device__ __forceinline__ void epi(const pg8::Acc& acc, const Unit& u, int wr, int wc, int fr, int fq) const {
        const int r0 = wr * 64 + fr, col0 = u.ek * 512 + u.pnl * 128 + wc * 32 + 8 * fq;
        float rsv[2][4], gtv[2][4];
#pragma unroll
        for (int ai = 0; ai < 2; ++ai)
#pragma unroll
            for (int m = 0; m < 4; ++m) { const int tok = rowtab[u.ui * 256 + r0 + ai * 128 + m * 16]; rsv[ai][m] = rstd[tok]; gtv[ai][m] = gates[(size_t)tok * 2 + u.ek]; }
#pragma unroll
        for (int ai = 0; ai < 2; ++ai)
#pragma unroll
            for (int m = 0; m < 4; ++m) { const int rr = u.rt * 256 + r0 + ai * 128 + m * 16;
                if (rr < u.cnt) { const float rs = rsv[ai][m], gt = gtv[ai][m]; float hv[8];
#pragma unroll
                    for (int n = 0; n < 2; ++n)
#pragma unroll
                        for (int j = 0; j < 4; ++j) { const float g = acc[ai][0][m][n][j] * rs, uu = acc[ai][1][m][n][j] * rs; hv[n * 4 + j] = silu_f(g) * uu * gt; }
                    v4u w; w.x = pg8::cvt_pk_bf16(hv[0], hv[1]); w.y = pg8::cvt_pk_bf16(hv[2], hv[3]); w.z = pg8::cvt_pk_bf16(hv[4], hv[5]); w.w = pg8::cvt_pk_bf16(hv[6], hv[7]);
                    *(v4u*)(HID + (size_t)(u.off + rr) * 1024 + col0) = w; } }
    }
};
__device__ __forceinline__ void ph_moe_up_pg8(const Args& a, LAS unsigned char* lds, int L, int G) {
    bk_table256(a, lds, L);
    const LAS int* tb = (const LAS int*)(lds + LDS_TAB); LAS int* rowtab = (LAS int*)(lds + LDS_TAB + 1024);
    PMoeUp S; S.A = (const char*)a.out; S.B = (const char*)(a.ws + ws_wgu(L)); S.HID = (bf16*)(a.ws + WS_HID); S.rstd = (const float*)(a.ws + WS_RSTD1); S.gates = (const float*)(a.ws + WS_GATES);
    S.tb = tb; S.rowtab = rowtab; S.G = G; S.c = (int)blockIdx.x; S.ldb = 1024; S.nt = 16;
    {   const int* LIST = (const int*)(a.ws + WS_LIST); PMoeUp::Unit u;
        for (int i = 0; i < 4 && S.next(i, u); ++i)
            if (threadIdx.x < 256) { int rr = u.rt * 256 + (int)threadIdx.x; rr = rr < u.cnt ? rr : u.cnt - 1; rowtab[i * 256 + threadIdx.x] = LIST[(size_t)u.bk * T + rr]; }
        __syncthreads();
    }
    pg8::gemm_phase<PMoeUp, true>(lds, S);
}
struct PMoeDown {
    static constexpr bool PERM = true;
    struct Unit { int bk, rt, cnt, off, elo, ehi, pn, ui; };
    const char* A; const char* B; bf16* HB; bf16* HBo; float* SSQ; const LAS int* tb; const LAS int* rowtab; int G, c; int ldb, nt;
    __device__ __forceinline__ bool next(int i, Unit& u) const {
        const int Lu = i * G + c; BkInfo o; if (!bk_find(tb, Lu >> 2, o)) return false;
        u.bk = o.bk; u.rt = o.rt; u.cnt = o.cnt; u.off = o.off; u.pn = Lu & 3; u.ui = i; bk_experts(o.bk, u.elo, u.ehi); return true;
    }
    __device__ __forceinline__ void avoff(const Unit& u, const int (&RA)[2], const int (&CA)[2], unsigned (&v)[4]) const {
#pragma unroll
        for (int h = 0; h < 2; ++h)
#pragma unroll
            for (int i = 0; i < 2; ++i) { const int row = u.off + u.rt * 256 + h * 128 + RA[i]; v[h * 2 + i] = (unsigned)(row * 1024 + CA[i]) * 2u; }
    }
    __device__ __forceinline__ const char* abase(const Unit&) const { return A; }
    __device__ __forceinline__ const char* btile(const Unit& u, int t) const { return B + ((size_t)((t < 8 ? u.elo : u.ehi) * 1024 + u.pn * 256) * 512 + (size_t)(t & 7) * 64) * 2; }
    __device__ __forceinline__ void khook(int, pg8::Acc&, const Unit&, LAS unsigned char*, int, int, int, int) const {}
    __device__ __forceinline__ void epi(const pg8::Acc& acc, const Unit& u, int wr, int wc, int fr, int fq) const {
        const int r0 = wr * 64 + fr, col0 = u.pn * 256 + wc * 32 + 8 * fq;
        int tok[8];
#pragma unroll
        for (int g8 = 0; g8 < 8; ++g8) tok[g8] = rowtab[u.ui * 256 + r0 + (g8 >> 2) * 128 + (g8 & 3) * 16];
        v4u cur[2], nxt[2];
#pragma unroll
        for (int bj = 0; bj < 2; ++bj) cur[bj] = *(const v4u*)(HB + (size_t)tok[0] * D + col0 + bj * 128);
#pragma unroll
        for (int g8 = 0; g8 < 8; ++g8) {
            const int ai = g8 >> 2, m = g8 & 3;
            if (g8 < 7) {
#pragma unroll
                for (int bj = 0; bj < 2; ++bj) nxt[bj] = *(const v4u*)(HB + (size_t)tok[g8 + 1] * D + col0 + bj * 128); }
            const int rr = u.rt * 256 + r0 + ai * 128 + m * 16;
            float sq = 0.f;
#pragma unroll
            for (int bj = 0; bj < 2; ++bj) { f32x4 h0v, h1v; unpack8v(cur[bj], h0v, h1v);
                const f32x4 v0 = acc[ai][bj][m][0] + h0v, v1 = acc[ai][bj][m][1] + h1v;
                sq += (v0[0] * v0[0] + v0[1] * v0[1] + v0[2] * v0[2] + v0[3] * v0[3]) + (v1[0] * v1[0] + v1[1] * v1[1] + v1[2] * v1[2] + v1[3] * v1[3]);
                if (rr < u.cnt) hb_store8(HBo, tok[g8], col0 + bj * 128, v0, v1); }
            sq += __shfl_xor(sq, 16); sq += __shfl_xor(sq, 32);
            if (rr < u.cnt && fq == 0) SSQ[(size_t)tok[g8] * 16 + u.pn * 4 + wc] = sq;
#pragma unroll
            for (int bj = 0; bj < 2; ++bj) cur[bj] = nxt[bj];
        }
    }
};
__device__ __forceinline__ void ph_moe_down_pg8(const Args& a, LAS unsigned char* lds, int L, int G) {
    bk_table256(a, lds, L);
    const LAS int* tb = (const LAS int*)(lds + LDS_TAB); LAS int* rowtab = (LAS int*)(lds + LDS_TAB + 1024);
    PMoeDown S; S.A = (const char*)(a.ws + WS_HID); S.B = (const char*)(a.ws + ws_wd(L)); S.SSQ = (float*)(a.ws + WS_SSDSQ); S.HB = (bf16*)a.out; S.HBo = L ? (bf16*)(a.ws + WS_H) : (bf16*)a.out;
    S.tb = tb; S.rowtab = rowtab; S.G = G; S.c = (int)blockIdx.x; S.ldb = 512; S.nt = 16;
    {   const int* LIST = (const int*)(a.ws + WS_LIST); PMoeDown::Unit u;
        for (int i = 0; i < 4 && S.next(i, u); ++i)
            if (threadIdx.x < 256) { int rr = u.rt * 256 + (int)threadIdx.x; rr = rr < u.cnt ? rr : u.cnt - 1; rowtab[i * 256 + threadIdx.x] = LIST[(size_t)u.bk * T + rr]; }
        __syncthreads();
    }
    pg8::gemm_phase<PMoeDown, true>(lds, S);
}
struct PPool {
    static constexpr bool PERM = true;
    struct Unit { int pm, pn; };
    const char* A; const char* B; bf16* HB; const float* pb; const float* ps; int G, c; int ldb, nt;
    __device__ __forceinline__ bool next(int i, Unit& u) const { return pg8::static_order(65, 4, G, c, i, u.pm, u.pn); }
    __device__ __forceinline__ void avoff(const Unit& u, const int (&RA)[2], const int (&CA)[2], unsigned (&v)[4]) const {
#pragma unroll
        for (int h = 0; h < 2; ++h)
#pragma unroll
            for (int i = 0; i < 2; ++i) { int row = u.pm * 256 + h * 128 + RA[i]; row = row < T ? row : T - 1; v[h * 2 + i] = (unsigned)(row * D + CA[i]) * 2u; }
    }
    __device__ __forceinline__ const char* abase(const Unit& u) const { return A + (size_t)u.pn * 256 * 2; }
    __device__ __forceinline__ const char* btile(const Unit& u, int t) const { return B + ((size_t)u.pn * 256 * 256 + (size_t)t * 64) * 2; }
    __device__ __forceinline__ void khook(int, pg8::Acc&, const Unit&, LAS unsigned char*, int, int, int, int) const {}
    __device__ __forceinline__ void epi(const pg8::Acc& acc, const Unit& u, int wr, int wc, int fr, int fq) const {
        const int row0 = u.pm * 256 + wr * 64 + fr, col0 = u.pn * 256 + wc * 32 + 8 * fq;
        v4u cur[2], nxt[2];
        { const int rc = row0 < T ? row0 : T - 1;
#pragma unroll
          for (int bj = 0; bj < 2; ++bj) cur[bj] = *(const v4u*)(HB + (size_t)rc * D + col0 + bj * 128); }
#pragma unroll
        for (int g8 = 0; g8 < 8; ++g8) {
            const int ai = g8 >> 2, m = g8 & 3, row = row0 + ai * 128 + m * 16;
            if (g8 < 7) { const int rn = row0 + ((g8 + 1) >> 2) * 128 + ((g8 + 1) & 3) * 16, rc = rn < T ? rn : T - 1;
#pragma unroll
                for (int bj = 0; bj < 2; ++bj) nxt[bj] = *(const v4u*)(HB + (size_t)rc * D + col0 + bj * 128); }
            if (row < T) {
#pragma unroll
                for (int bj = 0; bj < 2; ++bj) { const int cc = col0 + bj * 128; f32x4 h0v, h1v; unpack8v(cur[bj], h0v, h1v);
                    hb_store8(HB, row, cc, h0v + (acc[ai][bj][m][0] + *(const f32x4*)(pb + cc)) * *(const f32x4*)(ps + cc),
                                           h1v + (acc[ai][bj][m][1] + *(const f32x4*)(pb + cc + 4)) * *(const f32x4*)(ps + cc + 4)); } }
#pragma unroll
            for (int bj = 0; bj < 2; ++bj) cur[bj] = nxt[bj];
        }
    }
};
__device__ __forceinline__ void ph_poolgemm_pg8(const Args& a, LAS unsigned char* lds, int G) {
    PPool S; S.A = (const char*)(a.ws + WS_POOLED); S.B = (const char*)(a.ws + WS_WPOOL); S.HB = (bf16*)a.out; S.pb = a.in[I_PB]; S.ps = a.in[I_PS];
    S.G = G; S.c = (int)blockIdx.x; S.ldb = 256; S.nt = 4;
    pg8::gemm_phase<PPool, true>(lds, S);
}

__device__ __forceinline__ void ph_pooled(const Args& a, LAS unsigned char* lds, int wk, int nwk) {
    const int tid = threadIdx.x, qt = tid >> 7, c8 = tid & 127, c = c8 * 8, g = c >> 8, w = 2 << g;
    const bf16* HBr = (const bf16*)a.out; const float* SSQ = (const float*)(a.ws + WS_SSDSQ); bf16* PO = (bf16*)(a.ws + WS_POOLED);
    LAS float* rs = (LAS float*)lds + qt * 64;
    for (int pr = wk; pr < 172; pr += nwk) {
        const int task = pr * 4 + qt, b = task / 86, t0 = (task % 86) * 24;
        const size_t rb = (size_t)b * LSEQ;
        __syncthreads();
        if (c8 < 40) { const int l = t0 - 16 + c8; float r = 0.f;
            if (l >= 0) { const f32x4* q = (const f32x4*)(SSQ + (rb + l) * 16); const f32x4 sv = (q[0] + q[1]) + (q[2] + q[3]); r = rsqrtf((sv[0] + sv[1] + sv[2] + sv[3]) * (1.f / D) + EPS); }
            rs[c8] = r; }
        __syncthreads();
        f32x4 S0 = (f32x4){0.f, 0.f, 0.f, 0.f}, S1 = S0;
        for (int j = 1; j <= w; ++j) { const int l = t0 - j; if (l >= 0) { f32x4 x0, x1; unpack8v(*(const v4u*)(HBr + (rb + l) * D + c), x0, x1); S0 += x0 * rs[16 - j]; S1 += x1 * rs[16 - j]; } }
#pragma unroll 4
        for (int t = 0; t < 24; ++t) {
            const int l = t0 + t;
            f32x4 h0v, h1v; unpack8v(*(const v4u*)(HBr + (rb + l) * D + c), h0v, h1v); h0v *= rs[16 + t]; h1v *= rs[16 + t];
            const int lo = l - w, loc = lo >= 0 ? lo : 0; const float rl = lo >= 0 ? rs[16 + t - w] : 0.f;
            f32x4 s0v, s1v; unpack8v(*(const v4u*)(HBr + (rb + loc) * D + c), s0v, s1v);
            S0 += h0v; S0 -= s0v * rl; S1 += h1v; S1 -= s1v * rl;
            const int n = (l + 1) < w ? (l + 1) : w; const float inv = 1.f / (float)n;
            const f32x4 o0 = S0 * inv - h0v, o1 = S1 * inv - h1v;
            v4u wv; wv.x = pk2(o0[0], o0[1]); wv.y = pk2(o0[2], o0[3]); wv.z = pk2(o1[0], o1[1]); wv.w = pk2(o1[2], o1[3]); *(v4u*)(PO + (rb + l) * D + c) = wv;
        }
    }
}
__device__ __forceinline__ void ph_poolgemm(const Args& a, int wk, int nwk) {
    const int tid = threadIdx.x, lane = tid & 63, wave = __builtin_amdgcn_readfirstlane(tid >> 6), fr = lane & 15, fq = lane >> 4;
    const int gw = wk * NWAVES + wave, NGW = nwk * NWAVES;
    const bf16* PO = (const bf16*)(a.ws + WS_POOLED); const bf16* WPOOL = (const bf16*)(a.ws + WS_WPOOL);
    float* H = (float*)(a.ws + WS_H); bf16* HB = (bf16*)a.out;
    for (int u = gw; u < 258 * 16; u += NGW) {
        const int rt = u / 16, ct = u % 16, g = ct >> 2;
        const bf16* arow[4];
#pragma unroll
        for (int mi = 0; mi < 4; ++mi) arow[mi] = PO + (size_t)(rt * 64 + 16 * mi + fr) * D + g * 256;
        f32x4 acc[4][4]; zero_acc(acc);
        sg_kloop<4>(256, arow, [=](int n, int k0) { return WPOOL + (size_t)(ct * 64 + n) * 256 + k0; }, NoKS(), acc, fr, fq);
#pragma unroll
        for (int mi = 0; mi < 4; ++mi) { const int row = rt * 64 + 16 * mi + fr;
#pragma unroll
            for (int nj = 0; nj < 4; ++nj) { const int c = ct * 64 + 16 * nj + 4 * fq; float* hp = H + (size_t)row * D + c;
                const f32x4 v = *(const f32x4*)hp + (acc[mi][nj] + *(const f32x4*)(a.in[I_PB] + c)) * *(const f32x4*)(a.in[I_PS] + c); *(f32x4*)hp = v;
                v2u w; w.x = pk2(v.x, v.y); w.y = pk2(v.z, v.w); *(v2u*)(HB + (size_t)row * D + c) = w; } }
    }
}
__device__ __forceinline__ void ph_final(const Args& a, int wk, int nwk) {
    const int tid = threadIdx.x, lane = tid & 63, wave = __builtin_amdgcn_readfirstlane(tid >> 6);
    const int gw = wk * NWAVES + wave, NGW = nwk * NWAVES;
    const f32x4* gn = (const f32x4*)a.in[I_NORMF] + lane;
    const bf16* HF = (const bf16*)(a.ws + WS_H);
    for (int orow = gw; orow < NB * SEQ; orow += NGW) {
        const int b = orow / SEQ, l = orow - b * SEQ, row = b * LSEQ + NMETA + l;
        const v2u* xr = (const v2u*)(HF + (size_t)row * D) + lane; f32x4 v[4]; float ss = 0.f;
#pragma unroll
        for (int j = 0; j < 4; ++j) { const v2u q = xr[64 * j]; v[j][0] = __uint_as_float(q.x << 16); v[j][1] = __uint_as_float(q.x & 0xffff0000u); v[j][2] = __uint_as_float(q.y << 16); v[j][3] = __uint_as_float(q.y & 0xffff0000u);
            ss += v[j].x * v[j].x + v[j].y * v[j].y + v[j].z * v[j].z + v[j].w * v[j].w; }
        ss = wave_sum(ss);
        const float rstd = rsqrtf(ss * (1.f / D) + EPS);
        f32x4* o = (f32x4*)(a.out + (size_t)orow * D) + lane;
#ifdef PROBE_T
        const unsigned long long* ts = (const unsigned long long*)(a.ws + WS_CTL + 2048);
        const float tA = (float)(ts[PROBE_A_HI] - ts[PROBE_A_LO]) * 0.01f, tB = (float)(ts[PROBE_B_HI] - ts[PROBE_B_LO]) * 0.01f;
#pragma unroll
        for (int j = 0; j < 4; ++j) { f32x4 r = v[j] * rstd * gn[64 * j] + tB * 0.01f; if (orow == 0 && lane == 0 && j == 0) r.x += tA; o[64 * j] = r; }
#else
#pragma unroll
        for (int j = 0; j < 4; ++j) o[64 * j] = v[j] * rstd * gn[64 * j];
#endif
    }
}

__global__ void __launch_bounds__(NWAVES * 64, 2) fwd_kernel(Args a) {
    extern __shared__ __attribute__((aligned(16))) unsigned char lds_raw[];
    LAS unsigned char* lds = (LAS unsigned char*)lds_raw;
    volatile LAS unsigned* MISC = (volatile LAS unsigned*)(lds + LDS_BYTES - 256);
    const int tid = threadIdx.x;
    const int G = gridDim.x; const int bx = blockIdx.x;
    const int wk = (G % 8 == 0) ? (bx % 8) * (G / 8) + bx / 8 : bx;
    if (tid < 64) MISC[tid] = 0u;
    __syncthreads();
    XcdBarrier bar; bar.bar = (unsigned*)(a.ws + WS_CTL) + CW_BAR; bar.x = 0; bar.st = nullptr;
    if (N_LAUNCHES == 1) bar = xcd_barrier_post((unsigned*)(a.ws + WS_CTL) + CW_BAR, MISC + 8);
    const int lo = a.ph_lo, hi = a.ph_hi;
#ifndef PH_MASK
#define PH_MASK 0xFFFF
#endif
#define IN(k) (((PH_MASK >> (k)) & 1) && lo <= (k) && (k) < hi)
#ifdef PROBE_T
#define STAMP(k) do { if (blockIdx.x == 0 && tid == 0) ((unsigned long long*)(a.ws + WS_CTL + 2048))[k] = __builtin_amdgcn_s_memrealtime(); } while (0)
#else
#define STAMP(k) do { } while (0)
#endif
#ifdef PROBE_K
    volatile LAS unsigned long long* pkt = (volatile LAS unsigned long long*)(lds + LDS_BYTES - 128);
#define PSTAMP(k) do { if (blockIdx.x == 0 && tid == 0) { if ((k) == PROBE_K) pkt[0] = __builtin_amdgcn_s_memrealtime(); if ((k) == PROBE_K + 1) pkt[1] = __builtin_amdgcn_s_memrealtime(); } } while (0)
#else
#define PSTAMP(k) do { } while (0)
#endif
#define SEAM(k) do { if (IN(k) && IN((k) + 1)) xcd_barrier(bar); STAMP((k) + 1); PSTAMP((k) + 1); } while (0)
    STAMP(0); PSTAMP(0);
    if (IN(0)) { ph_prep(a, lds, wk, G); } SEAM(0);
    if (IN(1)) { ph_gemm1_pg8(a, lds, G); } SEAM(1);
    if (IN(2)) { ph_conv(a, wk, G); } SEAM(2);
    if (IN(3)) { ph_mixers3(a, lds, wk, G); } SEAM(3);
    if (IN(4)) { ph_gemm2_pg8(a, lds, wk, G); } SEAM(4);
    if (IN(5)) { ph_router(a, lds, 0, wk, G); } SEAM(5);
    if (IN(6)) { ph_moe_up_pg8(a, lds, 0, G); } SEAM(6);
    if (IN(7)) { ph_moe_down_pg8(a, lds, 0, G); } SEAM(7);
    if (IN(8)) { ph_pooled(a, lds, wk, G); } SEAM(8);
    if (IN(9)) { ph_poolgemm_pg8(a, lds, G); } SEAM(9);
    if (IN(10)) { ph_router(a, lds, 1, wk, G); } SEAM(10);
    if (IN(11)) { ph_moe_up_pg8(a, lds, 1, G); } SEAM(11);
    if (IN(12)) { ph_moe_down_pg8(a, lds, 1, G); } SEAM(12);
    if (IN(13)) { ph_final(a, wk, G); }
#ifdef PROBE_K
    if (blockIdx.x == 0 && tid == 0) {
        asm volatile("s_waitcnt vmcnt(0)" ::: "memory");
        if (PROBE_K == 13) pkt[1] = __builtin_amdgcn_s_memrealtime();
        const unsigned long long tend = __builtin_amdgcn_s_memrealtime() + 4ull * (pkt[1] - pkt[0]);
        while (__builtin_amdgcn_s_memrealtime() < tend) __builtin_amdgcn_s_sleep(16);
    }
#endif
#undef IN
#undef SEAM
}

extern "C" void kernel_launch(void* const* d_in, const int* in_sizes, int n_in, void* d_out, int out_size, void* d_ws, size_t ws_size, hipStream_t stream) {
    static int grid = 0;
    if (grid == 0) {
        if (n_in != 31 || out_size != NB * SEQ * D || ws_size < WS_END) { fprintf(stderr, "kernel_launch: unexpected shapes (n_in %d out %d ws %zu)\n", n_in, out_size, ws_size); grid = -1; return; }
        int dev = 0, cus = 0;
        if (hipGetDevice(&dev) != hipSuccess || hipDeviceGetAttribute(&cus, hipDeviceAttributeMultiprocessorCount, dev) != hipSuccess) { grid = -1; return; }
        if (hipFuncSetAttribute((const void*)fwd_kernel, hipFuncAttributeMaxDynamicSharedMemorySize, LDS_BYTES) != hipSuccess) { grid = -1; return; }
        grid = cus;
    }
    if (grid < 0) return;
    (void)hipMemsetAsync((char*)d_ws + WS_CTL, 0, CTL_ZERO_BYTES, stream);
    Args a{};
    for (int i = 0; i < 31; ++i) a.in[i] = (const float*)d_in[i];
    a.out = (float*)d_out; a.ws = (unsigned char*)d_ws;
    if (N_LAUNCHES == 1) { a.ph_lo = 0; a.ph_hi = NPH; hipLaunchKernelGGL(fwd_kernel, dim3(grid), dim3(NWAVES * 64), LDS_BYTES, stream, a); }
    else for (int p = 0; p < NPH; ++p) { a.ph_lo = p; a.ph_hi = p + 1; hipLaunchKernelGGL(fwd_kernel, dim3(grid), dim3(NWAVES * 64), LDS_BYTES, stream, a); }
}
```

```cpp
#include <hip/hip_runtime.h>
#include <cstdio>
#include <cstdint>

#define GAS __attribute__((address_space(1)))
#define LAS __attribute__((address_space(3)))
typedef unsigned short bf16;
typedef short bf16x8 __attribute__((ext_vector_type(8)));
typedef float f32x4 __attribute__((ext_vector_type(4)));
typedef unsigned v4u __attribute__((ext_vector_type(4)));
typedef unsigned v2u __attribute__((ext_vector_type(2)));

#ifndef MK_N_LAUNCHES
#define MK_N_LAUNCHES 1
#endif
constexpr int NPH = 14;
constexpr int N_LAUNCHES = MK_N_LAUNCHES;

constexpr int NB = 8, SEQ = 2048, NMETA = 16, LSEQ = SEQ + NMETA, T = NB * LSEQ, D = 1024;
constexpr int PROJ_SRC = 4624, LDP = 4608;
constexpr int C_Z = 0, C_G = 1024, C_X = 2048, C_B = 3072, C_C = 3328, C_LI = 3584;
constexpr float EPS = 1e-6f;
constexpr int NBK = 24;

constexpr size_t MiB = 1u << 20;
constexpr size_t WS_CTL = 0, CTL_ZERO_BYTES = 1 * MiB;
constexpr size_t WS_WIN = 1 * MiB;
constexpr size_t WS_WOUT = 10 * MiB;
constexpr size_t WS_WPOOL = 14 * MiB;
constexpr size_t WS_WRT = 14 * MiB + 512 * 1024;
constexpr size_t WS_WDTT = 15 * MiB + 512 * 1024;
constexpr size_t WS_RSTD0 = 15 * MiB;
constexpr size_t WS_RSTD1 = WS_RSTD0 + 128 * 1024;
constexpr size_t WS_BKT = WS_RSTD1 + 128 * 1024;
constexpr size_t WS_GATES = WS_BKT + 128 * 1024;
constexpr size_t WS_DT = 16 * MiB;
constexpr size_t WS_SSDSQ = 17 * MiB + 64 * 1024;
constexpr size_t WS_LIST = 19 * MiB;
constexpr size_t WS_WGU = 21 * MiB;
constexpr size_t WS_WD = 53 * MiB;
constexpr size_t WS_H = 69 * MiB;
constexpr size_t WS_PROJ = 134 * MiB;
constexpr size_t WS_HID = WS_PROJ;
constexpr size_t WS_POOLED = WS_PROJ;
constexpr size_t WS_END = 280 * MiB;
constexpr size_t WS_WGU1 = WS_PROJ + 64 * MiB, WS_WD1 = WS_PROJ + 96 * MiB;
__host__ __device__ constexpr size_t ws_wgu(int L) { return L ? WS_WGU1 : WS_WGU; }
__host__ __device__ constexpr size_t ws_wd(int L) { return L ? WS_WD1 : WS_WD; }
static_assert(WS_H + (size_t)T * D * 4 <= WS_PROJ && WS_PROJ + (size_t)T * LDP * 2 <= WS_END, "ws map");
static_assert(WS_DT + (size_t)T * 16 * 4 <= WS_SSDSQ && WS_SSDSQ + (size_t)T * 16 * 4 <= WS_LIST && WS_LIST + (size_t)NBK * T * 4 <= WS_WGU, "ws map small");
constexpr int CW_CNT = 8192;
constexpr int CW_BAR = 4096;

constexpr int LDS_BYTES = 147456;
constexpr int NWAVES = 8;

struct Args { const float* in[31]; float* out; unsigned char* ws; int ph_lo, ph_hi; };
enum { I_X = 0, I_META, I_NORMF, I_MNE, I_WIN, I_SCW, I_SCB, I_DTB, I_ALOG, I_SD, I_SNORM, I_LCW, I_LCB, I_LWA, I_LBA, I_LWX, I_LBX, I_LLAM, I_WOUT,
       I_MNO, I_PW, I_PB, I_PS, I_FFN, I_RGW, I_RGB, I_REW, I_REB, I_EWG, I_EWU, I_EWD };

#define LDS_WAIT() asm volatile("s_waitcnt lgkmcnt(0)" ::: "memory")
__device__ __forceinline__ float bf2f(unsigned v) { return __uint_as_float(v << 16); }
__device__ __forceinline__ unsigned f2bf(float f) { unsigned u = __float_as_uint(f); return (u + 0x7fffu + ((u >> 16) & 1u)) >> 16; }
__device__ __forceinline__ unsigned pk2(float lo, float hi) { return f2bf(lo) | (f2bf(hi) << 16); }
__device__ __forceinline__ void unpack8v(const v4u r, f32x4& a, f32x4& b) {
    a[0] = __uint_as_float(r.x << 16); a[1] = __uint_as_float(r.x & 0xffff0000u); a[2] = __uint_as_float(r.y << 16); a[3] = __uint_as_float(r.y & 0xffff0000u);
    b[0] = __uint_as_float(r.z << 16); b[1] = __uint_as_float(r.z & 0xffff0000u); b[2] = __uint_as_float(r.w << 16); b[3] = __uint_as_float(r.w & 0xffff0000u);
}
__device__ __forceinline__ float wave_sum(float v) {
#pragma unroll
    for (int o = 1; o < 64; o <<= 1) v += __shfl_xor(v, o);
    return v;
}
__device__ __forceinline__ float rcp_f(float v) { return __builtin_amdgcn_rcpf(v); }
__device__ __forceinline__ float sigmoid_f(float v) { return rcp_f(1.f + __expf(-v)); }
__device__ __forceinline__ float silu_f(float v) { return v * rcp_f(1.f + __expf(-v)); }
__device__ __forceinline__ float softplus_f(float v) { return v > 20.f ? v : log1pf(__expf(v)); }
__device__ __forceinline__ float gelu_tanh_f(float v) { const float u2 = 1.5957691216057308f * (v + 0.044715f * v * v * v); return v * rcp_f(1.f + __expf(-u2)); }
__device__ __forceinline__ const float* h0_row(const Args& a, int row) {
    const int b = row / LSEQ, l = row - b * LSEQ;
    return l < NMETA ? a.in[I_META] + (size_t)l * D : a.in[I_X] + ((size_t)b * SEQ + (l - NMETA)) * D;
}

#define XB_TMO      128
#define XB_XCNT(j)  (256  + 64 * (j))
#define XB_XSUB(j)  (1280 + 64 * (j))
#define XB_XGEN(j)  (2304 + 64 * (j))
#define XB_TOP      3328
#define XB_TOPGEN   3392
#define XCD_BAR_WORDS 3456
#define XB_SPIN_CAP (1u << 18)
__device__ __forceinline__ unsigned xb_ld(unsigned* p)              { return __hip_atomic_load(p, __ATOMIC_RELAXED, __HIP_MEMORY_SCOPE_AGENT); }
__device__ __forceinline__ unsigned xb_add(unsigned* p, unsigned v) { return __hip_atomic_fetch_add(p, v, __ATOMIC_RELAXED, __HIP_MEMORY_SCOPE_AGENT); }
__device__ __forceinline__ unsigned xb_xcc_id() { return (unsigned)__builtin_amdgcn_s_getreg((3 << 11) | 20) & 0xFu; }
#define XB_SPIN(cond, bar) do { unsigned _sp = 0; while (cond) { __builtin_amdgcn_s_sleep(1); \
    if ((++_sp & 255u) == 0u) { if (xb_ld(&(bar)[XB_TMO])) break; if (_sp > XB_SPIN_CAP) { atomicAdd(&(bar)[XB_TMO], 1u); break; } } } } while (0)
struct XcdBarrier { unsigned* bar; unsigned x; volatile LAS unsigned* st; };
__device__ __forceinline__ XcdBarrier xcd_barrier_post(unsigned* bar, volatile LAS unsigned* st) {
    XcdBarrier b; b.bar = bar; b.x = xb_xcc_id(); b.st = st;
    if (threadIdx.x == 0) (void)xb_add(&bar[XB_XCNT(b.x)], 1u);
    return b;
}
__device__ __forceinline__ void xcd_barrier_complete(unsigned* bar, unsigned x, unsigned& nloc, unsigned& nx) {
    const unsigned G = gridDim.x * gridDim.y * gridDim.z;
    unsigned sum, cnt, mine, sp = 0u;
    for (;;) {
        sum = 0u; cnt = 0u; mine = 0u;
#pragma unroll
        for (unsigned j = 0; j < 16; ++j) { const unsigned c = xb_ld(&bar[XB_XCNT(j)]); sum += c; cnt += (c > 0u) ? 1u : 0u; mine = (j == x) ? c : mine; }
        if (sum == G) break;
        __builtin_amdgcn_s_sleep(1);
        if ((++sp & 255u) == 0u) { if (xb_ld(&bar[XB_TMO])) break; if (sp > XB_SPIN_CAP) { atomicAdd(&bar[XB_TMO], 1u); break; } }
    }
    nloc = mine > 0u ? mine : 1u; nx = cnt > 0u ? cnt : 1u;
}
__device__ __forceinline__ void xcd_barrier(const XcdBarrier& b) {
    asm volatile("s_waitcnt vmcnt(0)" ::: "memory");
    __syncthreads();
    if (threadIdx.x == 0) {
        unsigned* bar = b.bar;
        __builtin_amdgcn_s_waitcnt(0);
        unsigned nloc = b.st[0], nx = b.st[1];
        if (nloc == 0u) { xcd_barrier_complete(bar, b.x, nloc, nx); b.st[0] = nloc; b.st[1] = nx; }
        const unsigned old = xb_add(&bar[XB_XSUB(b.x)], 1u);
        const unsigned gen = old / nloc;
        if (old + 1u == (gen + 1u) * nloc) {
            __builtin_amdgcn_fence(__ATOMIC_RELEASE, "agent");
            asm volatile("s_waitcnt vmcnt(0)" ::: "memory");
            const unsigned og = xb_add(&bar[XB_TOP], 1u);
            const unsigned tg = og / nx;
            if (og + 1u == (tg + 1u) * nx) xb_add(&bar[XB_TOPGEN], 1u);
            else XB_SPIN(xb_ld(&bar[XB_TOPGEN]) == tg, bar);
            __builtin_amdgcn_fence(__ATOMIC_ACQUIRE, "agent");
            xb_add(&bar[XB_XGEN(b.x)], 1u);
            asm volatile("s_waitcnt vmcnt(0)" ::: "memory");
        } else {
            XB_SPIN(xb_ld(&bar[XB_XGEN(b.x)]) == gen, bar);
            __builtin_amdgcn_fence(__ATOMIC_ACQUIRE, "agent");
            asm volatile("s_waitcnt vmcnt(0)" ::: "memory");
        }
    }
    __syncthreads();
}

__device__ __forceinline__ void tr_item(const float* src, int ldsrc, const float* gain, bf16* dst, int lddst, LAS float* scr, int lane) {
    float tv[32];
#pragma unroll
    for (int i = 0; i < 32; ++i) { const int kk = 2 * i + (lane >> 5); tv[i] = src[(size_t)kk * ldsrc + (lane & 31)]; }
#pragma unroll
    for (int i = 0; i < 32; ++i) { const int kk = 2 * i + (lane >> 5); float v = tv[i]; if (gain) v *= gain[kk]; scr[kk * 33 + (lane & 31)] = v; }
    LDS_WAIT();
    const int c = lane & 7;
#pragma unroll
    for (int j = 0; j < 4; ++j) { const int n = (lane >> 3) + 8 * j; const LAS float* s = scr + (8 * c) * 33 + n;
        v4u o; o.x = pk2(s[0 * 33], s[1 * 33]); o.y = pk2(s[2 * 33], s[3 * 33]); o.z = pk2(s[4 * 33], s[5 * 33]); o.w = pk2(s[6 * 33], s[7 * 33]);
        *(v4u*)(dst + (size_t)n * lddst + 8 * c) = o; }
    LDS_WAIT();
}
__device__ __forceinline__ void convert_experts(const Args& a, int L, LAS float* scr, int gw, int NGW, int lane) {
    bf16* WGU = (bf16*)(a.ws + ws_wgu(L)); bf16* WD = (bf16*)(a.ws + ws_wd(L));
    const float* gain = a.in[I_FFN] + L * D;
    constexpr int I_GU = 16 * 16 * 16, I_DN = 16 * 8 * 32;
    for (int it = gw; it < 2 * I_GU + I_DN; it += NGW) {
        int r = it;
        if (r < 2 * I_GU) {
            const int up = r >= I_GU; if (up) r -= I_GU;
            const int e = r >> 8, kb = (r >> 4) & 15, nb = r & 15;
            const float* src = a.in[up ? I_EWU : I_EWG] + ((size_t)(L * 16 + e) * 1024 + kb * 64) * 512 + nb * 32;
            const int drow = e * 1024 + (nb >> 2) * 256 + (nb & 3) * 32 + (up ? 128 : 0);
            tr_item(src, 512, gain + kb * 64, WGU + (size_t)drow * 1024 + kb * 64, 1024, scr, lane);
        } else {
            r -= 2 * I_GU;
            const int e = r >> 8, kb = (r >> 5) & 7, nb = r & 31;
            const float* src = a.in[I_EWD] + ((size_t)(L * 16 + e) * 512 + kb * 64) * 1024 + nb * 32;
            tr_item(src, 1024, nullptr, WD + (size_t)(e * 1024 + nb * 32) * 512 + kb * 64, 512, scr, lane);
        }
    }
}
__device__ __forceinline__ void ph_prep(const Args& a, LAS unsigned char* lds, int wk, int nwk) {
    const int tid = threadIdx.x, lane = tid & 63, wave = __builtin_amdgcn_readfirstlane(tid >> 6);
    const int gw = wk * NWAVES + wave, NGW = nwk * NWAVES;
    LAS float* scr = (LAS float*)(lds + wave * 8448);
    bf16* WIN = (bf16*)(a.ws + WS_WIN); bf16* WOUT = (bf16*)(a.ws + WS_WOUT); bf16* WPOOL = (bf16*)(a.ws + WS_WPOOL);
    constexpr int I_IN = 16 * 144, I_OUT = 32 * 32, I_POOL = 4 * 4 * 8;
    for (int it = gw; it < I_IN + I_OUT + I_POOL; it += NGW) {
        int r = it;
        if (r < I_IN) { const int kb = r / 144, nb = r % 144, n0 = nb * 32;
            const int sc = n0 < 1024 ? n0 : (n0 < 2048 ? n0 - 1024 + 2576 : (n0 < 3584 ? n0 - 2048 + 1024 : n0 - 3584 + 3600));
            tr_item(a.in[I_WIN] + (size_t)(kb * 64) * PROJ_SRC + sc, PROJ_SRC, a.in[I_MNE] + kb * 64, WIN + (size_t)n0 * 1024 + kb * 64, 1024, scr, lane); continue; }
        r -= I_IN;
        if (r < I_OUT) { const int kb = r >> 5, nb = r & 31;
            tr_item(a.in[I_WOUT] + (size_t)(kb * 64) * 1024 + nb * 32, 1024, kb < 16 ? a.in[I_SNORM] + kb * 64 : nullptr, WOUT + (size_t)(nb * 32) * 2048 + kb * 64, 2048, scr, lane); continue; }
        r -= I_OUT;
        { const int g = r >> 5, kb = (r >> 3) & 3, nb = r & 7;
            tr_item(a.in[I_PW] + (size_t)g * 65536 + (size_t)(kb * 64) * 256 + nb * 32, 256, a.in[I_MNO] + g * 256 + kb * 64, WPOOL + (size_t)(g * 256 + nb * 32) * 256 + kb * 64, 256, scr, lane); }
    }
    convert_experts(a, 0, scr, gw, NGW, lane);
    {
        v4u* WRT = (v4u*)(a.ws + WS_WRT); v4u* WDTT = (v4u*)(a.ws + WS_WDTT);
        for (int i = wk * 512 + tid; i < 2 * 48 * 128 + 256 * 128; i += nwk * 512) {
            float f[8];
            if (i < 2 * 48 * 128) {
                const int L = i / 6144, r = i % 6144, n = r >> 7, k8 = (r & 127) * 8, j = n < 20 ? n : n - 20;
#pragma unroll
                for (int e = 0; e < 8; ++e) { const int k = k8 + e; float w = 0.f;
                    if (n < 40) { w = (j < 4 ? a.in[I_RGW][((size_t)L * 1024 + k) * 4 + j] : a.in[I_REW][((size_t)L * 1024 + k) * 16 + (j - 4)]) * a.in[I_FFN][L * 1024 + k];
                        if (n >= 20) w -= bf2f(f2bf(w)); }
                    f[e] = w; }
                v4u o; o.x = pk2(f[0], f[1]); o.y = pk2(f[2], f[3]); o.z = pk2(f[4], f[5]); o.w = pk2(f[6], f[7]); WRT[i] = o;
            } else {
                const int r = i - 2 * 48 * 128, n = r >> 7, k8 = (r & 127) * 8;
#pragma unroll
                for (int e = 0; e < 8; ++e) { const int k = k8 + e; f[e] = n < 16 ? a.in[I_WIN][(size_t)k * PROJ_SRC + 2560 + n] * a.in[I_MNE][k] : 0.f; }
                v4u o; o.x = pk2(f[0], f[1]); o.y = pk2(f[2], f[3]); o.z = pk2(f[4], f[5]); o.w = pk2(f[6], f[7]); WDTT[r] = o;
            }
        }
    }
    bf16* HB = (bf16*)a.out; float* RSTD0 = (float*)(a.ws + WS_RSTD0);
    for (int row = gw; row < T; row += NGW) {
        const f32x4* xr = (const f32x4*)h0_row(a, row) + lane;
        f32x4 v[4]; float ss = 0.f;
#pragma unroll
        for (int j = 0; j < 4; ++j) { v[j] = xr[64 * j]; ss += v[j].x * v[j].x + v[j].y * v[j].y + v[j].z * v[j].z + v[j].w * v[j].w; }
        ss = wave_sum(ss);
        v2u* o8 = (v2u*)(HB + (size_t)row * D) + lane;
#pragma unroll
        for (int j = 0; j < 4; ++j) { v2u w; w.x = pk2(v[j].x, v[j].y); w.y = pk2(v[j].z, v[j].w); o8[64 * j] = w; }
        if (lane == 0) RSTD0[row] = rsqrtf(ss * (1.f / D) + EPS);
    }
}

template <int NT, class BP, class KS>
__device__ __forceinline__ void sg_kloop(int K, const bf16* const (&arow)[4], BP bp, KS ks, f32x4 (&acc)[4][NT], int fr, int fq) {
    for (int k0 = 0; k0 < K; k0 += 32) {
        ks(k0, acc);
        bf16x8 av[4], bv[NT];
#pragma unroll
        for (int mi = 0; mi < 4; ++mi) av[mi] = *(const bf16x8*)(arow[mi] + k0 + 8 * fq);
#pragma unroll
        for (int nj = 0; nj < NT; ++nj) bv[nj] = *(const bf16x8*)(bp(16 * nj + fr, k0) + 8 * fq);
#pragma unroll
        for (int mi = 0; mi < 4; ++mi)
#pragma unroll
            for (int nj = 0; nj < NT; ++nj) acc[mi][nj] = __builtin_amdgcn_mfma_f32_16x16x32_bf16(bv[nj], av[mi], acc[mi][nj], 0, 0, 0);
    }
}
template <int NT> __device__ __forceinline__ void zero_acc(f32x4 (&acc)[4][NT]) {
#pragma unroll
    for (int mi = 0; mi < 4; ++mi)
#pragma unroll
        for (int nj = 0; nj < NT; ++nj) acc[mi][nj] = (f32x4){0.f, 0.f, 0.f, 0.f};
}
struct NoKS { template <int NT> __device__ __forceinline__ void operator()(int, f32x4 (&)[4][NT]) const {} };

__device__ __forceinline__ void ph_gemm1(const Args& a, int wk, int nwk) {
    const int tid = threadIdx.x, lane = tid & 63, wave = __builtin_amdgcn_readfirstlane(tid >> 6), fr = lane & 15, fq = lane >> 4;
    const int gw = wk * NWAVES + wave, NGW = nwk * NWAVES;
    const bf16* HB = (const bf16*)a.out; const bf16* WIN = (const bf16*)(a.ws + WS_WIN); bf16* PROJ = (bf16*)(a.ws + WS_PROJ);
    const float* RSTD0 = (const float*)(a.ws + WS_RSTD0);
    for (int u = gw; u < 258 * 72; u += NGW) {
        const int rt = u / 72, ct = u % 72;
        const bf16* arow[4];
#pragma unroll
        for (int mi = 0; mi < 4; ++mi) arow[mi] = HB + (size_t)(rt * 64 + 16 * mi + fr) * D;
        f32x4 acc[4][4]; zero_acc(acc);
        sg_kloop<4>(1024, arow, [=](int n, int k0) { return WIN + (size_t)(ct * 64 + n) * 1024 + k0; }, NoKS(), acc, fr, fq);
#pragma unroll
        for (int mi = 0; mi < 4; ++mi) { const int row = rt * 64 + 16 * mi + fr; const float rs = RSTD0[row];
#pragma unroll
            for (int nj = 0; nj < 4; ++nj) { const f32x4 v = acc[mi][nj] * rs; v2u w; w.x = pk2(v.x, v.y); w.y = pk2(v.z, v.w);
                *(v2u*)(PROJ + (size_t)row * LDP + ct * 64 + 16 * nj + 4 * fq) = w; } }
    }
}

__device__ __forceinline__ void ph_gemm2(const Args& a, int wk, int nwk) {
    const int tid = threadIdx.x, lane = tid & 63, wave = __builtin_amdgcn_readfirstlane(tid >> 6), fr = lane & 15, fq = lane >> 4;
    const int gw = wk * NWAVES + wave, NGW = nwk * NWAVES;
    const bf16* PROJ = (const bf16*)(a.ws + WS_PROJ); const bf16* WOUT = (const bf16*)(a.ws + WS_WOUT);
    const float* SSDSQ = (const float*)(a.ws + WS_SSDSQ);
    float* H = (float*)(a.ws + WS_H); bf16* HB = (bf16*)a.out;
    for (int u = gw; u < 258 * 16; u += NGW) {
        const int rt = u / 16, ct = u % 16;
        const bf16* arow[4]; float f0[4], f1[4];
#pragma unroll
        for (int mi = 0; mi < 4; ++mi) { const int row = rt * 64 + 16 * mi + fr; arow[mi] = PROJ + (size_t)row * LDP;
            const f32x4* sq = (const f32x4*)(SSDSQ + (size_t)row * 16); const f32x4 q0 = sq[0], q1 = sq[1], q2 = sq[2], q3 = sq[3];
            const float s0 = (q0.x + q0.y + q0.z + q0.w) + (q1.x + q1.y + q1.z + q1.w), s1 = (q2.x + q2.y + q2.z + q2.w) + (q3.x + q3.y + q3.z + q3.w);
            const float r0 = rsqrtf(s0 * (1.f / 512.f) + EPS), r1 = rsqrtf(s1 * (1.f / 512.f) + EPS);
            f0[mi] = r0 / r1; f1[mi] = r1; }
        f32x4 acc[4][4]; zero_acc(acc);
        auto ks = [=](int k0, f32x4 (&ac)[4][4]) {
            if (k0 == 512) {
#pragma unroll
                for (int mi = 0; mi < 4; ++mi)
#pragma unroll
                    for (int nj = 0; nj < 4; ++nj) ac[mi][nj] *= f0[mi]; }
            if (k0 == 1024) {
#pragma unroll
                for (int mi = 0; mi < 4; ++mi)
#pragma unroll
                    for (int nj = 0; nj < 4; ++nj) ac[mi][nj] *= f1[mi]; }
        };
        sg_kloop<4>(2048, arow, [=](int n, int k0) { return WOUT + (size_t)(ct * 64 + n) * 2048 + k0; }, ks, acc, fr, fq);
#pragma unroll
        for (int mi = 0; mi < 4; ++mi) { const int row = rt * 64 + 16 * mi + fr; const float* hr = h0_row(a, row);
#pragma unroll
            for (int nj = 0; nj < 4; ++nj) { const int c = ct * 64 + 16 * nj + 4 * fq; const f32x4 v = acc[mi][nj] + *(const f32x4*)(hr + c);
                *(f32x4*)(H + (size_t)row * D + c) = v; v2u w; w.x = pk2(v.x, v.y); w.y = pk2(v.z, v.w); *(v2u*)(HB + (size_t)row * D + c) = w; } }
    }
}


namespace pg8 {
constexpr int BM = 256, BK = 64, HALF = 128, HTB = HALF * BK * 2, STAGE_BYTES = 8 * HTB, NXCD = 8, WGM = 8;
__host__ __device__ __forceinline__ int lds_byte(int r, int c) { const int st = (r >> 4) * 2 + (c >> 5), rr = r & 15, cc = c & 31, ob = rr * 64 + cc * 2; return st * 1024 + (ob ^ (((ob >> 9) & 1) << 5)); }
__host__ __device__ __forceinline__ void stage_rc(int b, int& R, int& C) { const int st = b / 1024, sb = b % 1024, swz = sb ^ (((sb >> 9) & 1) << 5); R = (st >> 1) * 16 + swz / 64; C = (st & 1) * 32 + (swz % 64) / 2; }
__host__ __device__ __forceinline__ int perm32(int rho) { const int n = rho >> 4, i = rho & 15; return 8 * (i >> 2) + 4 * n + (i & 3); }
__device__ __forceinline__ unsigned cvt_pk_bf16(float lo, float hi) { unsigned r; asm volatile("v_cvt_pk_bf16_f32 %0, %1, %2" : "=v"(r) : "v"(lo), "v"(hi)); return r; }
typedef f32x4 Acc[2][2][4][2];

__device__ __forceinline__ bool static_order(int nM, int nN, int G, int c, int i, int& pm, int& pn) {
    const int nwg = nM * nN; const long L = (long)i * G + c; if (L >= nwg) return false;
    int wgid = (int)L; { const int q = nwg / NXCD, r = nwg % NXCD, xcd = wgid % NXCD, off = wgid / NXCD; wgid = (xcd < r ? xcd * (q + 1) : r * (q + 1) + (xcd - r) * q) + off; }
    const int nig = WGM * nN, gid = wgid / nig, fm = gid * WGM, gsz = (nM - fm) < WGM ? (nM - fm) : WGM;
    pm = fm + ((wgid % nig) % gsz); pn = (wgid % nig) / gsz; return true;
}

template <class P, bool ALIGN_EPI>
__device__ __forceinline__ void gemm_phase(LAS unsigned char* lds, const P& S) {
    const int tid = threadIdx.x, wid = __builtin_amdgcn_readfirstlane(tid >> 6), lane = tid & 63, wr = wid >> 2, wc = wid & 3, fr = lane & 15, fq = lane >> 4;
    const int nt = S.nt;
    int RA[2], CA[2]; unsigned voffB[2];
#pragma unroll
    for (int i = 0; i < 2; ++i) { int R, C; stage_rc(tid * 16 + i * 8192, R, C); RA[i] = R; CA[i] = C; const int Rb = P::PERM ? ((R & ~31) + perm32(R & 31)) : R;
        voffB[i] = (unsigned)(Rb * S.ldb + C) * 2u; }
    const size_t kstep = (size_t)(BK * 2);
    const size_t hstepB = (size_t)HALF * S.ldb * 2;
    const unsigned ldsw = (unsigned)wid * 1024u;
    const int aoff = lds_byte(wr * 64 + fr, fq * 8), boff = lds_byte(wc * 32 + fr, fq * 8);
#define PG8_SA(b, h) (((b) * 2 + (h)) * HTB)
#define PG8_SB(b, h) ((4 + (b) * 2 + (h)) * HTB)
#define PG8_STAGE(bufoff, gbase, voff) do { _Pragma("unroll") for (int _i = 0; _i < 2; ++_i) \
        __builtin_amdgcn_global_load_lds((const unsigned*)((const char*)(gbase) + (voff)[_i]), (LAS unsigned*)(lds + (bufoff) + ldsw + _i * 8192), 16, 0, 0); } while (0)
#define PG8_LDA(dst, b, h) do { _Pragma("unroll") for (int m = 0; m < 4; ++m) _Pragma("unroll") for (int k = 0; k < 2; ++k) dst[m][k] = *(const LAS bf16x8*)(lds + PG8_SA(b, h) + aoff + m * 2048 + k * 1024); } while (0)
#define PG8_LDB(dst, b, h) do { _Pragma("unroll") for (int n = 0; n < 2; ++n) _Pragma("unroll") for (int k = 0; k < 2; ++k) dst[n][k] = *(const LAS bf16x8*)(lds + PG8_SB(b, h) + boff + n * 2048 + k * 1024); } while (0)
#define PG8_MMA(ai, bj, At, Bt) do { __builtin_amdgcn_s_setprio(1); _Pragma("unroll") for (int m = 0; m < 4; ++m) _Pragma("unroll") for (int n = 0; n < 2; ++n) _Pragma("unroll") for (int k = 0; k < 2; ++k) \
        acc[ai][bj][m][n] = __builtin_amdgcn_mfma_f32_16x16x32_bf16(Bt[n][k], At[m][k], acc[ai][bj][m][n], 0, 0, 0); __builtin_amdgcn_s_setprio(0); } while (0)
#define PG8_WAIT_V(n) asm volatile("s_waitcnt vmcnt(" #n ")" ::: "memory")
#define PG8_WAIT_L(n) asm volatile("s_waitcnt lgkmcnt(" #n ")" ::: "memory")
#define PG8_BAR __builtin_amdgcn_s_barrier()
#define PG8_SCHED __builtin_amdgcn_sched_barrier(0)
    typename P::Unit cur, nxt; int ui = 0;
    if (!S.next(0, cur)) return;
    f32x4 acc[2][2][4][2];
#pragma unroll
    for (int a = 0; a < 2; ++a)
#pragma unroll
        for (int b = 0; b < 2; ++b)
#pragma unroll
            for (int m = 0; m < 4; ++m)
#pragma unroll
                for (int n = 0; n < 2; ++n) acc[a][b][m][n] = (f32x4){0.f, 0.f, 0.f, 0.f};
    bf16x8 At[4][2], B0[2][2], B1[2][2];
    unsigned vA[4];
    S.avoff(cur, RA, CA, vA);
    const char* cA = S.abase(cur);
    {
        const char* b0 = S.btile(cur, 0); const char* b1 = S.btile(cur, 1);
        PG8_STAGE(PG8_SB(0, 0), b0, voffB); PG8_STAGE(PG8_SB(0, 1), b0 + hstepB, voffB); PG8_STAGE(PG8_SA(0, 0), cA, vA); PG8_STAGE(PG8_SA(0, 1), cA, vA + 2);
        if (wr == 1) PG8_BAR;
        PG8_WAIT_V(2); PG8_BAR;
        PG8_STAGE(PG8_SB(1, 0), b1, voffB); PG8_STAGE(PG8_SA(1, 0), cA + kstep, vA); PG8_STAGE(PG8_SB(1, 1), b1 + hstepB, voffB);
        PG8_WAIT_V(6); PG8_BAR;
    }
    for (;;) {
        const bool has_next = S.next(ui + 1, nxt);
        for (int t = 0; t < nt; t += 2) {
            const bool last = (t == nt - 2);
            const char* a1 = cA + (size_t)(t + 1) * kstep;
            S.khook(t, acc, cur, lds, wr, wc, fr, fq);
            PG8_LDB(B0, 0, 0); PG8_LDB(B1, 0, 1); PG8_SCHED; PG8_LDA(At, 0, 0); PG8_STAGE(PG8_SA(1, 1), a1, vA + 2);
            PG8_WAIT_V(8); PG8_WAIT_L(0); PG8_BAR; PG8_MMA(0, 0, At, B0); PG8_MMA(0, 1, At, B1); PG8_BAR; PG8_SCHED;
            const bool sw = last && has_next;
            if (sw) S.avoff(nxt, RA, CA, vA);
            const char* a2 = last ? (sw ? S.abase(nxt) : cA) : cA + (size_t)(t + 2) * kstep;
            const char* b2 = last ? (sw ? S.btile(nxt, 0) : S.btile(cur, 0)) : S.btile(cur, t + 2);
            const char* b3 = last ? (sw ? S.btile(nxt, 1) : S.btile(cur, 1)) : S.btile(cur, t + 3);
            const char* a3 = a2 + kstep;
            PG8_LDA(At, 0, 1); PG8_STAGE(PG8_SB(0, 0), b2, voffB); PG8_STAGE(PG8_SB(0, 1), b2 + hstepB, voffB); PG8_STAGE(PG8_SA(0, 0), a2, vA);
            PG8_WAIT_V(8); PG8_WAIT_L(0); PG8_BAR; PG8_MMA(1, 0, At, B0); PG8_MMA(1, 1, At, B1); PG8_BAR; PG8_SCHED;
            PG8_LDB(B0, 1, 0); PG8_LDB(B1, 1, 1); PG8_SCHED; PG8_LDA(At, 1, 0); PG8_STAGE(PG8_SA(0, 1), a2, vA + 2);
            PG8_WAIT_V(8); PG8_WAIT_L(0); PG8_BAR; PG8_MMA(0, 0, At, B0); PG8_MMA(0, 1, At, B1); PG8_BAR; PG8_SCHED;
            PG8_LDA(At, 1, 1); PG8_STAGE(PG8_SB(1, 0), b3, voffB); PG8_STAGE(PG8_SB(1, 1), b3 + hstepB, voffB); PG8_STAGE(PG8_SA(1, 0), a3, vA);
            PG8_WAIT_V(8); PG8_WAIT_L(0); PG8_BAR; PG8_MMA(1, 0, At, B0); PG8_MMA(1, 1, At, B1); PG8_BAR; PG8_SCHED;
        }
        if constexpr (ALIGN_EPI) { if (wr == 0) PG8_BAR; }
        S.epi(acc, cur, wr, wc, fr, fq);
        if (!has_next) break;
#pragma unroll
        for (int a = 0; a < 2; ++a)
#pragma unroll
            for (int b = 0; b < 2; ++b)
#pragma unroll
                for (int m = 0; m < 4; ++m)
#pragma unroll
                    for (int n = 0; n < 2; ++n) acc[a][b][m][n] = (f32x4){0.f, 0.f, 0.f, 0.f};
        cur = nxt; cA = S.abase(cur); ++ui;
        if constexpr (ALIGN_EPI) { if (wr == 1) PG8_BAR; }
    }
    PG8_WAIT_V(0);
    if constexpr (!ALIGN_EPI) { if (wr == 0) PG8_BAR; }
    PG8_BAR;
#undef PG8_SA
#undef PG8_SB
#undef PG8_STAGE
#undef PG8_LDA
#undef PG8_LDB
#undef PG8_MMA
#undef PG8_WAIT_V
#undef PG8_WAIT_L
#undef PG8_BAR
#undef PG8_SCHED
}
}

struct PGemm1 {
    static constexpr bool PERM = true;
    struct Unit { int pm, pn; };
    const char* A; const char* B; const char* Bdt; bf16* O; const float* rstd; float* DT; const float* dtb; int G, c; int ldb, nt;
    __device__ __forceinline__ bool next(int i, Unit& u) const { return pg8::static_order(65, 19, G, c, i, u.pm, u.pn); }
    __device__ __forceinline__ void avoff(const Unit& u, const int (&RA)[2], const int (&CA)[2], unsigned (&v)[4]) const {
#pragma unroll
        for (int h = 0; h < 2; ++h)
#pragma unroll
            for (int i = 0; i < 2; ++i) { int row = u.pm * 256 + h * 128 + RA[i]; row = row < T ? row : T - 1; v[h * 2 + i] = (unsigned)(row * D + CA[i]) * 2u; }
    }
    __device__ __forceinline__ const char* abase(const Unit&) const { return A; }
    __device__ __forceinline__ const char* btile(const Unit& u, int t) const { return (u.pn < 18 ? B + (size_t)u.pn * 256 * 1024 * 2 : Bdt) + (size_t)t * 64 * 2; }
    __device__ __forceinline__ void khook(int, pg8::Acc&, const Unit&, LAS unsigned char*, int, int, int, int) const {}
    __device__ __forceinline__ void epi(const pg8::Acc& acc, const Unit& u, int wr, int wc, int fr, int fq) const {
        const int row0 = u.pm * 256 + wr * 64 + fr, col0 = u.pn * 256 + wc * 32 + 8 * fq;
        float rsv[2][4];
#pragma unroll
        for (int ai = 0; ai < 2; ++ai)
#pragma unroll
            for (int m = 0; m < 4; ++m) { const int row = row0 + ai * 128 + m * 16; rsv[ai][m] = rstd[row < T ? row : T - 1]; }
        if (u.pn == 18) {
            if (wc == 0 && fq < 2) { const f32x4 b0 = *(const f32x4*)(dtb + 8 * fq), b1 = *(const f32x4*)(dtb + 8 * fq + 4);
#pragma unroll
                for (int ai = 0; ai < 2; ++ai)
#pragma unroll
                    for (int m = 0; m < 4; ++m) { const int row = row0 + ai * 128 + m * 16;
                        if (row < T) { const float rs = rsv[ai][m]; f32x4 d0 = acc[ai][0][m][0] * rs + b0, d1 = acc[ai][0][m][1] * rs + b1;
#pragma unroll
                            for (int j = 0; j < 4; ++j) { d0[j] = softplus_f(d0[j]); d1[j] = softplus_f(d1[j]); }
                            *(f32x4*)(DT + (size_t)row * 16 + 8 * fq) = d0; *(f32x4*)(DT + (size_t)row * 16 + 8 * fq + 4) = d1; } } }
            return; }
#pragma unroll
        for (int ai = 0; ai < 2; ++ai)
#pragma unroll
            for (int m = 0; m < 4; ++m) { const int row = row0 + ai * 128 + m * 16;
                if (row < T) { const float rs = rsv[ai][m]; bf16* rowp = O + (size_t)row * LDP + col0;
#pragma unroll
                    for (int bj = 0; bj < 2; ++bj) { const f32x4 v0 = acc[ai][bj][m][0] * rs, v1 = acc[ai][bj][m][1] * rs;
                        v4u w; w.x = pg8::cvt_pk_bf16(v0[0], v0[1]); w.y = pg8::cvt_pk_bf16(v0[2], v0[3]); w.z = pg8::cvt_pk_bf16(v1[0], v1[1]); w.w = pg8::cvt_pk_bf16(v1[2], v1[3]);
                        *(v4u*)(rowp + bj * 128) = w; } } }
    }
};
__device__ __forceinline__ void ph_gemm1_pg8(const Args& a, LAS unsigned char* lds, int G) {
    PGemm1 S; S.A = (const char*)a.out; S.B = (const char*)(a.ws + WS_WIN); S.O = (bf16*)(a.ws + WS_PROJ); S.rstd = (const float*)(a.ws + WS_RSTD0); S.Bdt = (const char*)(a.ws + WS_WDTT); S.DT = (float*)(a.ws + WS_DT); S.dtb = a.in[I_DTB];
    S.G = G; S.c = (int)blockIdx.x; S.ldb = 1024; S.nt = 16;
    pg8::gemm_phase<PGemm1, true>(lds, S);
}

__device__ __forceinline__ void ssd_item(const Args& a, LAS unsigned char* lds, int b, int h) {
    const int tid = threadIdx.x, lane = tid & 63;
    constexpr int TB = 64;
    LAS float* xs = (LAS float*)lds;
    LAS float* Bs = xs + TB * 64;
    LAS float* Cs = Bs + TB * 128;
    LAS float* ys = Cs + TB * 128;
    LAS float* dts = ys + TB * 64;
    LAS float* decs = dts + TB;
    bf16* PROJ = (bf16*)(a.ws + WS_PROJ); const float* DT = (const float*)(a.ws + WS_DT); float* SSDSQ = (float*)(a.ws + WS_SSDSQ);
    const int g = h >> 3;
    const float Ah = -__expf(a.in[I_ALOG][h]), Dh = a.in[I_SD][h];
    int ccol = 0, cch = 0; float cw0 = 0.f, cw1 = 0.f, cw2 = 0.f, cw3 = 0.f, cb = 0.f;
    if (tid < 320) {
        if (tid < 64) { ccol = C_X + h * 64 + tid; cch = h * 64 + tid; }
        else if (tid < 192) { ccol = C_B + g * 128 + (tid - 64); cch = 1024 + g * 128 + (tid - 64); }
        else { ccol = C_C + g * 128 + (tid - 192); cch = 1280 + g * 128 + (tid - 192); }
        const float* cw = a.in[I_SCW]; cw0 = cw[cch]; cw1 = cw[1536 + cch]; cw2 = cw[2 * 1536 + cch]; cw3 = cw[3 * 1536 + cch]; cb = a.in[I_SCB][cch];
    }
    const int p = tid >> 3, nq = tid & 7;
    float S[16];
#pragma unroll
    for (int i = 0; i < 16; ++i) S[i] = 0.f;
    const size_t rbase = (size_t)b * LSEQ;
    for (int l0 = 0; l0 < LSEQ; l0 += TB) {
        const int nt = (LSEQ - l0) < TB ? (LSEQ - l0) : TB;
        __syncthreads();
        if (tid < 320) {
            float r0 = l0 >= 3 ? bf2f(PROJ[(rbase + l0 - 3) * LDP + ccol]) : 0.f, r1 = l0 >= 2 ? bf2f(PROJ[(rbase + l0 - 2) * LDP + ccol]) : 0.f, r2 = l0 >= 1 ? bf2f(PROJ[(rbase + l0 - 1) * LDP + ccol]) : 0.f;
            for (int t = 0; t < nt; ++t) {
                const float r3 = bf2f(PROJ[(rbase + l0 + t) * LDP + ccol]);
                const float v = silu_f(cw0 * r0 + cw1 * r1 + cw2 * r2 + cw3 * r3 + cb);
                if (tid < 64) xs[t * 64 + tid] = v; else if (tid < 192) Bs[t * 128 + tid - 64] = v; else Cs[t * 128 + tid - 192] = v;
                r0 = r1; r1 = r2; r2 = r3;
            }
        } else if (tid < 320 + TB) {
            const int t = tid - 320;
            if (t < nt) { const float dt = DT[(rbase + l0 + t) * 16 + h]; dts[t] = dt; decs[t] = __expf(Ah * dt); }
        }
        __syncthreads();
        for (int t = 0; t < nt; ++t) {
            const float xv = xs[t * 64 + p], xdt = xv * dts[t], dec = decs[t];
            float yp = 0.f;
#pragma unroll
            for (int i = 0; i < 16; ++i) { S[i] = dec * S[i] + Bs[t * 128 + nq * 16 + i] * xdt; yp += Cs[t * 128 + nq * 16 + i] * S[i]; }
            yp += __shfl_xor(yp, 1); yp += __shfl_xor(yp, 2); yp += __shfl_xor(yp, 4);
            if (nq == 0) ys[t * 64 + p] = yp + Dh * xv;
        }
        __syncthreads();
        for (int t = tid >> 6; t < nt; t += 8) {
            const size_t row = rbase + l0 + t;
            const float z = bf2f(PROJ[row * LDP + C_Z + h * 64 + lane]);
            const float yg = ys[t * 64 + lane] * silu_f(z);
            PROJ[row * LDP + C_Z + h * 64 + lane] = (bf16)f2bf(yg);
            const float sq = wave_sum(yg * yg);
            if (lane == 0) SSDSQ[row * 16 + h] = sq;
        }
    }
    __syncthreads();
}
__device__ __forceinline__ void lru_item(const Args& a, LAS unsigned char* lds, int b, int h) {
    const int tid = threadIdx.x;
    constexpr int TB = 64;
    LAS float* Wa = (LAS float*)lds;
    LAS float* Wx = Wa + 4096;
    LAS float* xb = Wx + 4096;
    LAS float* as = xb + TB * 64;
    LAS float* us = as + TB * 64;
    bf16* PROJ = (bf16*)(a.ws + WS_PROJ);
    __syncthreads();
    for (int i = tid; i < 4096; i += 512) { Wa[i] = a.in[I_LWA][(size_t)h * 4096 + i]; Wx[i] = a.in[I_LWX][(size_t)h * 4096 + i]; }
    const size_t rbase = (size_t)b * LSEQ;
    float hprev = 0.f;
    const int c = tid & 63, tq = tid >> 6;
    const float* cw = a.in[I_LCW]; const int ch = h * 64 + c;
    const float cw0 = cw[ch], cw1 = cw[1024 + ch], cw2 = cw[2048 + ch], cw3 = cw[3072 + ch], cb = a.in[I_LCB][ch];
    const int gt = tid >> 3, jq = tid & 7;
    for (int l0 = 0; l0 < LSEQ; l0 += TB) {
        const int nt = (LSEQ - l0) < TB ? (LSEQ - l0) : TB;
        __syncthreads();
        for (int t = tq * 8; t < tq * 8 + 8; ++t) if (t < nt) {
            const int l = l0 + t; const size_t row = rbase + l;
            const float r3 = bf2f(PROJ[row * LDP + C_LI + ch]);
            const float r2 = l >= 1 ? bf2f(PROJ[(row - 1) * LDP + C_LI + ch]) : 0.f;
            const float r1 = l >= 2 ? bf2f(PROJ[(row - 2) * LDP + C_LI + ch]) : 0.f;
            const float r0 = l >= 3 ? bf2f(PROJ[(row - 3) * LDP + C_LI + ch]) : 0.f;
            xb[t * 64 + c] = cw0 * r0 + cw1 * r1 + cw2 * r2 + cw3 * r3 + cb;
        }
        __syncthreads();
        if (gt < nt) {
            float ra[8], ri[8];
#pragma unroll
            for (int j = 0; j < 8; ++j) { ra[j] = 0.f; ri[j] = 0.f; }
            for (int i = 0; i < 64; ++i) { const float xv = xb[gt * 64 + i];
#pragma unroll
                for (int j = 0; j < 8; ++j) { ra[j] += xv * Wa[i * 64 + jq * 8 + j]; ri[j] += xv * Wx[i * 64 + jq * 8 + j]; } }
#pragma unroll
            for (int j = 0; j < 8; ++j) { const int cc = h * 64 + jq * 8 + j;
                const float r = sigmoid_f(ra[j] + a.in[I_LBA][cc]), ig = sigmoid_f(ri[j] + a.in[I_LBX][cc]);
                const float log_a = -8.0f * r * softplus_f(-a.in[I_LLAM][cc]);
                const float av = __expf(log_a);
                const float mult = (l0 + gt == 0) ? 1.f : sqrtf(fmaxf(-expm1f(2.f * log_a), 0.f));
                as[gt * 64 + jq * 8 + j] = av; us[gt * 64 + jq * 8 + j] = mult * ig * xb[gt * 64 + jq * 8 + j]; }
        }
        __syncthreads();
        if (tid < 64) { for (int t = 0; t < nt; ++t) { hprev = as[t * 64 + tid] * hprev + us[t * 64 + tid]; us[t * 64 + tid] = hprev; } }
        __syncthreads();
        for (int t = tq * 8; t < tq * 8 + 8; ++t) if (t < nt) {
            const size_t row = rbase + l0 + t;
            const float gv = bf2f(PROJ[row * LDP + C_G + ch]);
            PROJ[row * LDP + C_G + ch] = (bf16)f2bf(us[t * 64 + c] * gelu_tanh_f(gv));
        }
    }
    __syncthreads();
}
__device__ __forceinline__ void ph_mixers(const Args& a, LAS unsigned char* lds, int wk, int nwk) {
    for (int it = wk; it < 256; it += nwk) {
        if (it < 128) ssd_item(a, lds, it >> 4, it & 15); else lru_item(a, lds, (it - 128) >> 4, (it - 128) & 15);
    }
}


__device__ __forceinline__ f32x4 mfma16(bf16x8 a, bf16x8 b, f32x4 c) { return __builtin_amdgcn_mfma_f32_16x16x32_bf16(a, b, c, 0, 0, 0); }
constexpr int RSX = 144, RSB = 272;
constexpr int SO_X = 0, SO_B = SO_X + 128 * RSX, SO_C = SO_B + 128 * RSB, SO_M = SO_C + 128 * RSB, SO_S = SO_M + 128 * RSB, SO_V = SO_S + 64 * RSB;
static_assert(SO_V + 4096 <= LDS_BYTES - 256, "ssd lds");
#define TR4(RS4, o0, o1, o2, o3, addr) do { v2u l0_, h0_, l1_, h1_, l2_, h2_, l3_, h3_; \
    asm volatile("ds_read_b64_tr_b16 %0, %8\n\tds_read_b64_tr_b16 %1, %8 offset:" #RS4 "\n\t" \
                 "ds_read_b64_tr_b16 %2, %8 offset:32\n\tds_read_b64_tr_b16 %3, %8 offset:" #RS4 "+32\n\t" \
                 "ds_read_b64_tr_b16 %4, %8 offset:64\n\tds_read_b64_tr_b16 %5, %8 offset:" #RS4 "+64\n\t" \
                 "ds_read_b64_tr_b16 %6, %8 offset:96\n\tds_read_b64_tr_b16 %7, %8 offset:" #RS4 "+96\n\ts_waitcnt lgkmcnt(0)" \
                 : "=&v"(l0_), "=&v"(h0_), "=&v"(l1_), "=&v"(h1_), "=&v"(l2_), "=&v"(h2_), "=&v"(l3_), "=&v"(h3_) : "v"(addr) : "memory"); \
    o0 = __builtin_bit_cast(bf16x8, (v4u){l0_.x, l0_.y, h0_.x, h0_.y}); o1 = __builtin_bit_cast(bf16x8, (v4u){l1_.x, l1_.y, h1_.x, h1_.y}); \
    o2 = __builtin_bit_cast(bf16x8, (v4u){l2_.x, l2_.y, h2_.x, h2_.y}); o3 = __builtin_bit_cast(bf16x8, (v4u){l3_.x, l3_.y, h3_.x, h3_.y}); } while (0)
#define TR1(RS4, o0, addr) do { v2u l0_, h0_; \
    asm volatile("ds_read_b64_tr_b16 %0, %2\n\tds_read_b64_tr_b16 %1, %2 offset:" #RS4 "\n\ts_waitcnt lgkmcnt(0)" : "=&v"(l0_), "=&v"(h0_) : "v"(addr) : "memory"); \
    o0 = __builtin_bit_cast(bf16x8, (v4u){l0_.x, l0_.y, h0_.x, h0_.y}); } while (0)
__device__ __forceinline__ void unpack8(const v4u r, float (&f)[8]) {
    f[0] = __uint_as_float(r.x << 16); f[1] = __uint_as_float(r.x & 0xffff0000u); f[2] = __uint_as_float(r.y << 16); f[3] = __uint_as_float(r.y & 0xffff0000u);
    f[4] = __uint_as_float(r.z << 16); f[5] = __uint_as_float(r.z & 0xffff0000u); f[6] = __uint_as_float(r.w << 16); f[7] = __uint_as_float(r.w & 0xffff0000u);
}
__device__ __forceinline__ void ph_conv(const Args& a, int wk, int nwk) {
    const bf16* PROJ = (const bf16*)(a.ws + WS_PROJ); bf16* XACT = (bf16*)(a.ws + WS_H); bf16* XLRU = (bf16*)a.out;
    for (int id = wk * 512 + (int)threadIdx.x; id < NB * 48 * 320; id += nwk * 512) {
        const int cg = id % 320, rr = id / 320, b = rr / 48, t0 = (rr % 48) * 43;
        const bool ssd = cg < 192; const int ch = ssd ? cg * 8 : (cg - 192) * 8;
        const float* cwp = ssd ? a.in[I_SCW] + ch : a.in[I_LCW] + ch; const int cst = ssd ? 1536 : 1024;
        float cw[4][8], cb[8];
#pragma unroll
        for (int k = 0; k < 4; ++k) { const f32x4 wa = *(const f32x4*)(cwp + k * cst), wb = *(const f32x4*)(cwp + k * cst + 4);
#pragma unroll
            for (int j = 0; j < 4; ++j) { cw[k][j] = wa[j]; cw[k][4 + j] = wb[j]; } }
        { const float* cbp = ssd ? a.in[I_SCB] + ch : a.in[I_LCB] + ch; const f32x4 wa = *(const f32x4*)cbp, wb = *(const f32x4*)(cbp + 4);
#pragma unroll
          for (int j = 0; j < 4; ++j) { cb[j] = wa[j]; cb[4 + j] = wb[j]; } }
        const size_t rb = (size_t)b * LSEQ;
        const bf16* src = PROJ + rb * LDP + 2048 + cg * 8;
        bf16* dst = ssd ? XACT + rb * 1536 + ch : XLRU + rb * 1024 + ch; const int dst_ld = ssd ? 1536 : 1024;
        float p0[8], p1[8], p2[8];
        {   v4u q0 = (v4u){0u, 0u, 0u, 0u}, q1 = q0, q2 = q0;
            if (t0 >= 3) { q0 = *(const v4u*)(src + (size_t)(t0 - 3) * LDP); q1 = *(const v4u*)(src + (size_t)(t0 - 2) * LDP); q2 = *(const v4u*)(src + (size_t)(t0 - 1) * LDP); }
            unpack8(q0, p0); unpack8(q1, p1); unpack8(q2, p2); }
#pragma unroll 4
        for (int t = 0; t < 43; ++t) {
            const int l = t0 + t; float p3[8]; unpack8(*(const v4u*)(src + (size_t)l * LDP), p3);
            float o[8];
#pragma unroll
            for (int j = 0; j < 8; ++j) { const float v = cw[0][j] * p0[j] + cw[1][j] * p1[j] + cw[2][j] * p2[j] + cw[3][j] * p3[j] + cb[j]; o[j] = ssd ? silu_f(v) : v; p0[j] = p1[j]; p1[j] = p2[j]; p2[j] = p3[j]; }
            v4u ov; ov.x = pk2(o[0], o[1]); ov.y = pk2(o[2], o[3]); ov.z = pk2(o[4], o[5]); ov.w = pk2(o[6], o[7]);
            *(v4u*)(dst + (size_t)l * dst_ld) = ov;
        }
    }
}
__device__ __forceinline__ void ssd_item3(const Args& a, LAS unsigned char* lds, int b, int h) {
    const int tid = threadIdx.x, lane = tid & 63, w = __builtin_amdgcn_readfirstlane(tid >> 6), fr = lane & 15, fq = lane >> 4;
    bf16* PROJ = (bf16*)(a.ws + WS_PROJ); const bf16* XACT = (const bf16*)(a.ws + WS_H); const float* DT = (const float*)(a.ws + WS_DT); float* SSDSQ = (float*)(a.ws + WS_SSDSQ);
    const int g = h >> 3;
    const float Ah = -__expf(a.in[I_ALOG][h]), Dh = a.in[I_SD][h];
    LAS float* acs = (LAS float*)(lds + SO_V); LAS float* dtv = acs + 128; LAS float* wv = acs + 256; LAS float* eacs = acs + 384;
    const size_t rbase = (size_t)b * LSEQ;
    const int pt_s = w & 3, nh = w >> 2;
    f32x4 sacc[4];
#pragma unroll
    for (int i = 0; i < 4; ++i) sacc[i] = (f32x4){0.f, 0.f, 0.f, 0.f};
    __syncthreads();
    for (int i = tid; i < 64 * RSB / 4; i += 512) ((LAS unsigned*)(lds + SO_S))[i] = 0u;
    v4u pf[10], zp[2]; float d0 = 0.f, d1 = 0.f;
    const int ft = tid >> 2, q4 = tid & 3;
    const int xr_ = tid >> 3, xp_ = tid & 7, br_ = tid >> 4, bp_ = tid & 15;
    const bf16* xsrc = XACT + (rbase + xr_) * 1536 + h * 64 + xp_ * 8;
    const bf16* bsrc = XACT + (rbase + br_) * 1536 + 1024 + g * 128 + bp_ * 8;
#define SSD_PREFETCH(L0) do { const int l0_ = (L0); \
        _Pragma("unroll") for (int i = 0; i < 2; ++i) { pf[i] = (v4u){0u, 0u, 0u, 0u}; if (l0_ + xr_ + 64 * i < LSEQ) pf[i] = *(const v4u*)(xsrc + (size_t)(l0_ + 64 * i) * 1536); } \
        _Pragma("unroll") for (int i = 0; i < 4; ++i) { pf[2 + i] = (v4u){0u, 0u, 0u, 0u}; pf[6 + i] = (v4u){0u, 0u, 0u, 0u}; \
            if (l0_ + br_ + 32 * i < LSEQ) { pf[2 + i] = *(const v4u*)(bsrc + (size_t)(l0_ + 32 * i) * 1536); pf[6 + i] = *(const v4u*)(bsrc + (size_t)(l0_ + 32 * i) * 1536 + 256); } } \
        zp[0] = (v4u){0u, 0u, 0u, 0u}; zp[1] = zp[0]; \
        if (l0_ + ft < LSEQ) { const bf16* zq = PROJ + (rbase + l0_ + ft) * LDP + C_Z + h * 64 + 16 * q4; zp[0] = *(const v4u*)zq; zp[1] = *(const v4u*)(zq + 8); } \
        if (w == 0) { d0 = (l0_ + lane) < LSEQ ? DT[(rbase + l0_ + lane) * 16 + h] : 0.f; d1 = (l0_ + lane + 64) < LSEQ ? DT[(rbase + l0_ + lane + 64) * 16 + h] : 0.f; } } while (0)
    SSD_PREFETCH(0);
    for (int l0 = 0; l0 < LSEQ; l0 += 128) {
        const int nvalid = (LSEQ - l0) < 128 ? (LSEQ - l0) : 128;
#pragma unroll
        for (int i = 0; i < 2; ++i) *(LAS v4u*)(lds + SO_X + (xr_ + 64 * i) * RSX + xp_ * 16) = pf[i];
#pragma unroll
        for (int i = 0; i < 4; ++i) { *(LAS v4u*)(lds + SO_B + (br_ + 32 * i) * RSB + bp_ * 16) = pf[2 + i]; *(LAS v4u*)(lds + SO_C + (br_ + 32 * i) * RSB + bp_ * 16) = pf[6 + i]; }
        const v4u z0 = zp[0], z1 = zp[1];
        if (w == 0) {
            float a0 = Ah * d0, a1 = Ah * d1;
#pragma unroll
            for (int o = 1; o < 64; o <<= 1) { const float v0 = __shfl_up(a0, o), v1 = __shfl_up(a1, o); if (lane >= o) { a0 += v0; a1 += v1; } }
            a1 += __shfl(a0, 63);
            const float aend = __shfl(a1, 63);
            acs[lane] = a0; acs[lane + 64] = a1; dtv[lane] = d0; dtv[lane + 64] = d1;
            wv[lane] = __expf(aend - a0) * d0; wv[lane + 64] = __expf(aend - a1) * d1; eacs[lane] = __expf(a0); eacs[lane + 64] = __expf(a1);
            if (lane == 0) acs[512] = aend;
        }
        __syncthreads();
        if (l0 + 128 < LSEQ) SSD_PREFETCH(l0 + 128);
        for (int hh = 0; hh < 2; ++hh) {
            f32x4 gacc[4];
#pragma unroll
            for (int st = 0; st < 4; ++st) gacc[st] = (f32x4){0.f, 0.f, 0.f, 0.f};
#pragma unroll
            for (int k0 = 0; k0 < 128; k0 += 32) {
                const bf16x8 cf = *(const LAS bf16x8*)(lds + SO_C + (16 * w + fr) * RSB + (k0 + 8 * fq) * 2);
#pragma unroll
                for (int st = 0; st < 4; ++st) { const bf16x8 bf = *(const LAS bf16x8*)(lds + SO_B + (16 * (4 * hh + st) + fr) * RSB + (k0 + 8 * fq) * 2); gacc[st] = mfma16(bf, cf, gacc[st]); }
            }
            const int l = 16 * w + fr; const float al = acs[l];
#pragma unroll
            for (int st = 0; st < 4; ++st) {
                const int s0 = 16 * (4 * hh + st) + 4 * fq; const f32x4 as = *(const LAS f32x4*)(acs + s0), ds = *(const LAS f32x4*)(dtv + s0);
                float m[4];
#pragma unroll
                for (int j = 0; j < 4; ++j) m[j] = (s0 + j <= l) ? gacc[st][j] * __expf(al - as[j]) * ds[j] : 0.f;
                v2u mv; mv.x = pk2(m[0], m[1]); mv.y = pk2(m[2], m[3]);
                *(LAS v2u*)(lds + SO_M + l * RSB + s0 * 2) = mv;
            }
        }
        __syncthreads();
        {
            f32x4 y[4];
#pragma unroll
            for (int pt = 0; pt < 4; ++pt) y[pt] = (f32x4){0.f, 0.f, 0.f, 0.f};
#pragma unroll
            for (int k0 = 0; k0 < 128; k0 += 32) {
                const bf16x8 cf = *(const LAS bf16x8*)(lds + SO_C + (16 * w + fr) * RSB + (k0 + 8 * fq) * 2);
#pragma unroll
                for (int pt = 0; pt < 4; ++pt) { const bf16x8 sf = *(const LAS bf16x8*)(lds + SO_S + (16 * pt + fr) * RSB + (k0 + 8 * fq) * 2); y[pt] = mfma16(cf, sf, y[pt]); }
                __builtin_amdgcn_sched_barrier(0);
            }
            const f32x4 ea = *(const LAS f32x4*)(eacs + 16 * w + 4 * fq);
#pragma unroll
            for (int pt = 0; pt < 4; ++pt) y[pt] *= ea;
            for (int k0 = 0; k0 <= 16 * w + 15; k0 += 32) {
                const bf16x8 mf = *(const LAS bf16x8*)(lds + SO_M + (16 * w + fr) * RSB + (k0 + 8 * fq) * 2);
                const unsigned xa = (unsigned)(size_t)(lds + SO_X) + (unsigned)((k0 + 8 * fq + (fr >> 2)) * RSX + (fr & 3) * 8);
                bf16x8 x0, x1, x2, x3; TR4(576, x0, x1, x2, x3, xa);
                y[0] = mfma16(mf, x0, y[0]); y[1] = mfma16(mf, x1, y[1]); y[2] = mfma16(mf, x2, y[2]); y[3] = mfma16(mf, x3, y[3]);
                __builtin_amdgcn_sched_barrier(0);
            }
#pragma unroll
            for (int pt = 0; pt < 4; ++pt)
#pragma unroll
                for (int r = 0; r < 4; ++r) *(LAS float*)(lds + SO_M + (16 * w + 4 * fq + r) * RSB + (16 * pt + fr) * 4) = y[pt][r];
        }
        {
            const float dec = __expf(acs[512]);
#pragma unroll
            for (int i = 0; i < 4; ++i) sacc[i] *= dec;
#pragma unroll
            for (int k0 = 0; k0 < 128; k0 += 32) {
                const unsigned xa = (unsigned)(size_t)(lds + SO_X) + (unsigned)((k0 + 8 * fq + (fr >> 2)) * RSX + pt_s * 32 + (fr & 3) * 8);
                bf16x8 xf; TR1(576, xf, xa);
                const f32x4 w0 = *(const LAS f32x4*)(wv + k0 + 8 * fq), w1 = *(const LAS f32x4*)(wv + k0 + 8 * fq + 4);
                float xv[8]; unpack8(__builtin_bit_cast(v4u, xf), xv);
                v4u xs; xs.x = pk2(xv[0] * w0[0], xv[1] * w0[1]); xs.y = pk2(xv[2] * w0[2], xv[3] * w0[3]); xs.z = pk2(xv[4] * w1[0], xv[5] * w1[1]); xs.w = pk2(xv[6] * w1[2], xv[7] * w1[3]);
                const bf16x8 xw = __builtin_bit_cast(bf16x8, xs);
                const unsigned ba = (unsigned)(size_t)(lds + SO_B) + (unsigned)((k0 + 8 * fq + (fr >> 2)) * RSB + nh * 128 + (fr & 3) * 8);
                bf16x8 b0, b1, b2, b3; TR4(1088, b0, b1, b2, b3, ba);
                sacc[0] = mfma16(xw, b0, sacc[0]); sacc[1] = mfma16(xw, b1, sacc[1]); sacc[2] = mfma16(xw, b2, sacc[2]); sacc[3] = mfma16(xw, b3, sacc[3]);
                __builtin_amdgcn_sched_barrier(0);
            }
        }
        __syncthreads();
#pragma unroll
        for (int i = 0; i < 4; ++i)
#pragma unroll
            for (int r = 0; r < 4; ++r) *(LAS bf16*)(lds + SO_S + (16 * pt_s + 4 * fq + r) * RSB + (16 * (4 * nh + i) + fr) * 2) = (bf16)f2bf(sacc[i][r]);
        if (ft < nvalid) {
            const size_t row = rbase + l0 + ft;
            bf16* zq = PROJ + row * LDP + C_Z + h * 64 + 16 * q4;
            const v4u x0 = *(const LAS v4u*)(lds + SO_X + ft * RSX + q4 * 32), x1 = *(const LAS v4u*)(lds + SO_X + ft * RSX + q4 * 32 + 16);
            float zf[16], xf[16], yo[16];
            { float tmp[8]; unpack8(z0, tmp);
#pragma unroll
              for (int j = 0; j < 8; ++j) zf[j] = tmp[j];
              unpack8(z1, tmp);
#pragma unroll
              for (int j = 0; j < 8; ++j) zf[8 + j] = tmp[j];
              unpack8(x0, tmp);
#pragma unroll
              for (int j = 0; j < 8; ++j) xf[j] = tmp[j];
              unpack8(x1, tmp);
#pragma unroll
              for (int j = 0; j < 8; ++j) xf[8 + j] = tmp[j]; }
            float sq = 0.f;
#pragma unroll
            for (int j4 = 0; j4 < 4; ++j4) { const f32x4 yv = *(const LAS f32x4*)(lds + SO_M + ft * RSB + (16 * q4 + 4 * j4) * 4);
#pragma unroll
                for (int j = 0; j < 4; ++j) { const float v = (yv[j] + Dh * xf[4 * j4 + j]) * silu_f(zf[4 * j4 + j]); yo[4 * j4 + j] = v; sq += v * v; } }
            v4u o0, o1; o0.x = pk2(yo[0], yo[1]); o0.y = pk2(yo[2], yo[3]); o0.z = pk2(yo[4], yo[5]); o0.w = pk2(yo[6], yo[7]);
            o1.x = pk2(yo[8], yo[9]); o1.y = pk2(yo[10], yo[11]); o1.z = pk2(yo[12], yo[13]); o1.w = pk2(yo[14], yo[15]);
            *(v4u*)zq = o0; *(v4u*)(zq + 8) = o1;
            sq += __shfl_xor(sq, 1); sq += __shfl_xor(sq, 2);
            if (q4 == 0) SSDSQ[row * 16 + h] = sq;
        }
        __syncthreads();
    }
#undef SSD_PREFETCH
}
constexpr int LO_XB = 0, LO_XF = LO_XB + 128 * RSX, LO_A = LO_XF + 128 * 260, LO_U = LO_A + 128 * 260, LO_WA = LO_U + 128 * 260, LO_WX = LO_WA + 64 * RSX, LO_SC = LO_WX + 64 * RSX;
static_assert(LO_SC + 17 * 256 <= LDS_BYTES - 256, "lru lds");
__device__ __forceinline__ void lru_item3(const Args& a, LAS unsigned char* lds, int b, int h) {
    const int tid = threadIdx.x, lane = tid & 63, w = __builtin_amdgcn_readfirstlane(tid >> 6), fr = lane & 15, fq = lane >> 4;
    bf16* PROJ = (bf16*)(a.ws + WS_PROJ); const bf16* XLRU = (const bf16*)a.out;
    const size_t rbase = (size_t)b * LSEQ;
    LAS float* segP = (LAS float*)(lds + LO_SC); LAS float* segH = segP + 512; LAS float* carry = segH + 512;
    __syncthreads();
    for (int i = tid; i < 4096; i += 512) { const int ii = i >> 6, j = i & 63;
        *(LAS bf16*)(lds + LO_WA + j * RSX + ii * 2) = (bf16)f2bf(a.in[I_LWA][(size_t)h * 4096 + i]);
        *(LAS bf16*)(lds + LO_WX + j * RSX + ii * 2) = (bf16)f2bf(a.in[I_LWX][(size_t)h * 4096 + i]); }
    if (tid < 64) carry[tid] = 0.f;
    float gba[4], gbx[4], gsp[4];
#pragma unroll
    for (int jt = 0; jt < 4; ++jt) { const int c = h * 64 + 16 * jt + fr; gba[jt] = a.in[I_LBA][c]; gbx[jt] = a.in[I_LBX][c]; gsp[jt] = softplus_f(-a.in[I_LLAM][c]); }
    const int ft = tid >> 2, q4 = tid & 3;
    v4u xp[2], gp[2];
#define LRU_PREFETCH(L0) do { const int l0_ = (L0); \
        _Pragma("unroll") for (int i = 0; i < 2; ++i) { const int q = tid + 512 * i, row = q >> 3, pc = q & 7; xp[i] = (v4u){0u, 0u, 0u, 0u}; \
            if (l0_ + row < LSEQ) xp[i] = *(const v4u*)(XLRU + (rbase + l0_ + row) * 1024 + h * 64 + pc * 8); } \
        gp[0] = (v4u){0u, 0u, 0u, 0u}; gp[1] = gp[0]; \
        if (l0_ + ft < LSEQ) { const bf16* gq = PROJ + (rbase + l0_ + ft) * LDP + C_G + h * 64 + 16 * q4; gp[0] = *(const v4u*)gq; gp[1] = *(const v4u*)(gq + 8); } } while (0)
    LRU_PREFETCH(0);
    for (int l0 = 0; l0 < LSEQ; l0 += 128) {
        const int nvalid = (LSEQ - l0) < 128 ? (LSEQ - l0) : 128;
#pragma unroll
        for (int i = 0; i < 2; ++i) { const int q = tid + 512 * i, row = q >> 3, pc = q & 7;
            *(LAS v4u*)(lds + LO_XB + row * RSX + pc * 16) = xp[i];
            float xv[8]; unpack8(xp[i], xv);
#pragma unroll
            for (int j = 0; j < 8; ++j) *(LAS float*)(lds + LO_XF + row * 260 + (pc * 8 + j) * 4) = xv[j]; }
        const v4u g0 = gp[0], g1 = gp[1];
        __syncthreads();
        if (l0 + 128 < LSEQ) LRU_PREFETCH(l0 + 128);
        {
            f32x4 ga[4], gx[4];
#pragma unroll
            for (int jt = 0; jt < 4; ++jt) { ga[jt] = (f32x4){0.f, 0.f, 0.f, 0.f}; gx[jt] = ga[jt]; }
#pragma unroll
            for (int k0 = 0; k0 < 64; k0 += 32) {
                const bf16x8 xf = *(const LAS bf16x8*)(lds + LO_XB + (16 * w + fr) * RSX + (k0 + 8 * fq) * 2);
#pragma unroll
                for (int jt = 0; jt < 4; ++jt) {
                    const bf16x8 wa = *(const LAS bf16x8*)(lds + LO_WA + (16 * jt + fr) * RSX + (k0 + 8 * fq) * 2), wx = *(const LAS bf16x8*)(lds + LO_WX + (16 * jt + fr) * RSX + (k0 + 8 * fq) * 2);
                    ga[jt] = mfma16(xf, wa, ga[jt]); gx[jt] = mfma16(xf, wx, gx[jt]); }
            }
#pragma unroll
            for (int jt = 0; jt < 4; ++jt)
#pragma unroll
                for (int r = 0; r < 4; ++r) { const int l = 16 * w + 4 * fq + r, j = 16 * jt + fr;
                    const float rr = sigmoid_f(ga[jt][r] + gba[jt]), ig = sigmoid_f(gx[jt][r] + gbx[jt]);
                    const float log_a = -8.0f * rr * gsp[jt];
                    const float av = __expf(log_a);
                    const float t2 = 2.f * log_a;
                    const float om = t2 > -0.1f ? -t2 * (1.f + t2 * (0.5f + t2 * (0.16666667f + t2 * 0.041666668f))) : 1.f - av * av;
                    const float mult = (l0 + l == 0) ? 1.f : __builtin_amdgcn_sqrtf(fmaxf(om, 0.f));
                    const float xv = *(const LAS float*)(lds + LO_XF + l * 260 + j * 4);
                    *(LAS float*)(lds + LO_A + l * 260 + j * 4) = av; *(LAS float*)(lds + LO_U + l * 260 + j * 4) = mult * ig * xv; }
        }
        __syncthreads();
        {
            float P = 1.f, Hl = 0.f;
#pragma unroll
            for (int t = 0; t < 16; ++t) { const float av = *(const LAS float*)(lds + LO_A + (16 * w + t) * 260 + lane * 4), uv = *(const LAS float*)(lds + LO_U + (16 * w + t) * 260 + lane * 4); Hl = av * Hl + uv; P *= av; }
            segP[w * 64 + lane] = P; segH[w * 64 + lane] = Hl;
            __syncthreads();
            float hin = carry[lane];
            for (int s2 = 0; s2 < w; ++s2) hin = segP[s2 * 64 + lane] * hin + segH[s2 * 64 + lane];
#pragma unroll
            for (int t = 0; t < 16; ++t) { LAS float* up = (LAS float*)(lds + LO_U + (16 * w + t) * 260 + lane * 4); hin = *(const LAS float*)(lds + LO_A + (16 * w + t) * 260 + lane * 4) * hin + *up; *up = hin; }
            __syncthreads();
            if (w == 7) carry[lane] = hin;
        }
        if (ft < nvalid) {
            const size_t row = rbase + l0 + ft;
            bf16* gq = PROJ + row * LDP + C_G + h * 64 + 16 * q4;
            float gf[16], yo[16];
            { float tmp[8]; unpack8(g0, tmp);
#pragma unroll
              for (int j = 0; j < 8; ++j) gf[j] = tmp[j];
              unpack8(g1, tmp);
#pragma unroll
              for (int j = 0; j < 8; ++j) gf[8 + j] = tmp[j]; }
#pragma unroll
            for (int j = 0; j < 16; ++j) yo[j] = *(const LAS float*)(lds + LO_U + ft * 260 + (16 * q4 + j) * 4) * gelu_tanh_f(gf[j]);
            v4u o0, o1; o0.x = pk2(yo[0], yo[1]); o0.y = pk2(yo[2], yo[3]); o0.z = pk2(yo[4], yo[5]); o0.w = pk2(yo[6], yo[7]);
            o1.x = pk2(yo[8], yo[9]); o1.y = pk2(yo[10], yo[11]); o1.z = pk2(yo[12], yo[13]); o1.w = pk2(yo[14], yo[15]);
            *(v4u*)gq = o0; *(v4u*)(gq + 8) = o1;
        }
        __syncthreads();
    }
#undef LRU_PREFETCH
}
__device__ __forceinline__ void ph_mixers3(const Args& a, LAS unsigned char* lds, int wk, int nwk) {
    for (int it = wk; it < 256; it += nwk) if (it < 128) ssd_item3(a, lds, it >> 4, it & 15);
    for (int it = wk; it < 256; it += nwk) if (it >= 128) lru_item3(a, lds, (it - 128) >> 4, (it - 128) & 15);
}

constexpr int RW_STRIDE = 2064;
__device__ __forceinline__ void ph_router(const Args& a, LAS unsigned char* lds, int L, int wk, int nwk) {
    const int tid = threadIdx.x, lane = tid & 63, wave = __builtin_amdgcn_readfirstlane(tid >> 6), fr = lane & 15, fq = lane >> 4;
    const int gw = wk * NWAVES + wave, NGW = nwk * NWAVES;
    if (L == 0) { convert_experts(a, 1, (LAS float*)(lds + wave * 8448), gw, NGW, lane); }
    LAS unsigned char* wl = lds;
    LAS float* sc = (LAS float*)(lds + 99328) + wave * 768;
    LAS int* lcnt = (LAS int*)(lds + 123904); LAS int* gbase = lcnt + 32; LAS int* rinfo = lcnt + 64;
    const v4u* WRT = (const v4u*)(a.ws + WS_WRT) + (size_t)L * 6144;
    __syncthreads();
    for (int i = tid; i < 6144; i += 512) *(LAS v4u*)(wl + (i >> 7) * RW_STRIDE + (i & 127) * 16) = WRT[i];
    if (tid < 32) lcnt[tid] = 0;
    __syncthreads();
    const bf16* HBr = (const bf16*)a.out;
    float* RSTD1 = (float*)(a.ws + WS_RSTD1); float* GATES = (float*)(a.ws + WS_GATES); int* LIST = (int*)(a.ws + WS_LIST);
    unsigned* cnt = (unsigned*)(a.ws + WS_CTL) + CW_CNT + 1024 * L;
    const float* bg = a.in[I_RGB] + L * 4; const float* be = a.in[I_REB] + L * 16;
    int it = 0;
    for (int u = gw; u < T / 16; u += NGW, ++it) {
        const int r0 = u * 16;
        const bf16* hrow = HBr + (size_t)(r0 + fr) * D + 8 * fq;
        f32x4 acc[3]; float ss = 0.f;
#pragma unroll
        for (int t = 0; t < 3; ++t) acc[t] = (f32x4){0.f, 0.f, 0.f, 0.f};
#pragma unroll 4
        for (int k0 = 0; k0 < 1024; k0 += 32) {
            const v4u hv = *(const v4u*)(hrow + k0);
            f32x4 h0v, h1v; unpack8v(hv, h0v, h1v);
            ss += (h0v[0] * h0v[0] + h0v[1] * h0v[1] + h0v[2] * h0v[2] + h0v[3] * h0v[3]) + (h1v[0] * h1v[0] + h1v[1] * h1v[1] + h1v[2] * h1v[2] + h1v[3] * h1v[3]);
            const bf16x8 hf = __builtin_bit_cast(bf16x8, hv);
#pragma unroll
            for (int t = 0; t < 3; ++t) { const bf16x8 wf = *(const LAS bf16x8*)(wl + (16 * t + fr) * RW_STRIDE + (k0 + 8 * fq) * 2); acc[t] = mfma16(wf, hf, acc[t]); }
        }
        ss += __shfl_xor(ss, 16); ss += __shfl_xor(ss, 32);
        const float rstd = rsqrtf(ss * (1.f / D) + EPS);
#pragma unroll
        for (int t = 0; t < 3; ++t)
#pragma unroll
            for (int r = 0; r < 4; ++r) sc[fr * 48 + 16 * t + 4 * fq + r] = acc[t][r];
        LDS_WAIT();
        if (lane < 16) {
            const int row = r0 + lane;
            float lg[20];
#pragma unroll
            for (int j = 0; j < 20; ++j) lg[j] = (sc[lane * 48 + j] + sc[lane * 48 + 20 + j]) * rstd + (j < 4 ? bg[j] : be[j - 4]);
            int gs = 0; float gm = lg[0];
#pragma unroll
            for (int j = 1; j < 4; ++j) if (lg[j] > gm) { gm = lg[j]; gs = j; }
            const float pg = 1.f / (__expf(lg[0] - gm) + __expf(lg[1] - gm) + __expf(lg[2] - gm) + __expf(lg[3] - gm));
            float f[4];
#pragma unroll
            for (int i = 0; i < 4; ++i) f[i] = gs == 0 ? lg[4 + i] : (gs == 1 ? lg[8 + i] : (gs == 2 ? lg[12 + i] : lg[16 + i]));
            int i0 = 0; float m0 = f[0];
#pragma unroll
            for (int i = 1; i < 4; ++i) if (f[i] > m0) { m0 = f[i]; i0 = i; }
            int i1 = -1; float m1 = -3.0e38f;
#pragma unroll
            for (int i = 0; i < 4; ++i) if (i != i0 && f[i] > m1) { m1 = f[i]; i1 = i; }
            const float w0 = 1.f / (1.f + __expf(m1 - m0)), w1 = 1.f - w0;
            const int lo = i0 < i1 ? i0 : i1, hi = i0 < i1 ? i1 : i0;
            const float glo = pg * (i0 < i1 ? w0 : w1), ghi = pg * (i0 < i1 ? w1 : w0);
            const int pair = lo == 0 ? hi - 1 : (lo == 1 ? hi + 1 : 5);
            const int bk = gs * 6 + pair;
            const int ls = __hip_atomic_fetch_add(lcnt + bk, 1, __ATOMIC_RELAXED, __HIP_MEMORY_SCOPE_WORKGROUP);
            rinfo[(it * NWAVES + wave) * 16 + lane] = bk | (ls << 8);
            RSTD1[row] = rstd; GATES[(size_t)row * 2] = glo; GATES[(size_t)row * 2 + 1] = ghi;
        }
        LDS_WAIT();
    }
    __syncthreads();
    if (tid < NBK) gbase[tid] = (int)atomicAdd(cnt + 32 * tid, (unsigned)lcnt[tid]);
    __syncthreads();
    it = 0;
    for (int u = gw; u < T / 16; u += NGW, ++it)
        if (lane < 16) { const int info = rinfo[(it * NWAVES + wave) * 16 + lane], bk = info & 255; LIST[(size_t)bk * T + gbase[bk] + (info >> 8)] = u * 16 + lane; }
}

struct BkTab { int cnt[NBK], off[NBK], ust[NBK + 1]; };
__device__ __forceinline__ void bk_table(const Args& a, LAS unsigned char* lds, int L, int per_tile  ) {
    LAS int* tb = (LAS int*)lds;
    __syncthreads();
    if (threadIdx.x == 0) {
        const unsigned* cnt = (const unsigned*)(a.ws + WS_CTL) + CW_CNT + 1024 * L;
        int off = 0, us = 0;
        for (int i = 0; i < NBK; ++i) { const int c = (int)__hip_atomic_load(cnt + 32 * i, __ATOMIC_RELAXED, __HIP_MEMORY_SCOPE_AGENT);
            tb[i] = c; tb[NBK + i] = off; tb[2 * NBK + i] = us; off += (c + 255) & ~255; us += ((c + 63) >> 6) * per_tile; }
        tb[2 * NBK + NBK] = us;
    }
    __syncthreads();
}
__device__ __forceinline__ void bk_experts(int bk, int& elo, int& ehi) {
    const int g = bk / 6, pr = bk - g * 6;
    const int lo = pr < 3 ? 0 : (pr < 5 ? 1 : 2), hi = pr < 3 ? pr + 1 : (pr < 5 ? pr - 1 : 3);
    elo = g * 4 + lo; ehi = g * 4 + hi;
}
__device__ __forceinline__ void ph_moe_up(const Args& a, LAS unsigned char* lds, int L, int wk, int nwk) {
    const int tid = threadIdx.x, lane = tid & 63, wave = __builtin_amdgcn_readfirstlane(tid >> 6), fr = lane & 15, fq = lane >> 4;
    const int gw = wk * NWAVES + wave, NGW = nwk * NWAVES;
    bk_table(a, lds, L, 32);
    LAS int* tb = (LAS int*)lds;
    const bf16* HB = (const bf16*)a.out; const bf16* WGU = (const bf16*)(a.ws + WS_WGU); bf16* HID = (bf16*)(a.ws + WS_HID);
    const int* LIST = (const int*)(a.ws + WS_LIST); const float* RSTD1 = (const float*)(a.ws + WS_RSTD1); const float* GATES = (const float*)(a.ws + WS_GATES);
    const int nun = tb[2 * NBK + NBK];
    for (int u = gw; u < nun; u += NGW) {
        int bk = 0;
        for (int i = 1; i < NBK; ++i) if (u >= tb[2 * NBK + i]) bk = i;
        const int cnt = tb[bk], off = tb[NBK + bk], r = u - tb[2 * NBK + bk];
        const int rt = r >> 5, ek = (r >> 4) & 1, ct = r & 15;
        int elo, ehi; bk_experts(bk, elo, ehi); const int e = ek ? ehi : elo;
        const int c0 = ct * 32, brow = e * 1024 + (c0 >> 7) * 256 + (c0 & 127);
        const bf16* arow[4]; int tok[4];
#pragma unroll
        for (int mi = 0; mi < 4; ++mi) { int rr = rt * 64 + 16 * mi + fr; if (rr >= cnt) rr = cnt - 1; tok[mi] = LIST[(size_t)bk * T + rr]; arow[mi] = HB + (size_t)tok[mi] * D; }
        f32x4 acc[4][4]; zero_acc(acc);
        sg_kloop<4>(1024, arow, [=](int n, int k0) { return WGU + (size_t)(brow + (n < 32 ? n : n + 96)) * 1024 + k0; }, NoKS(), acc, fr, fq);
#pragma unroll
        for (int mi = 0; mi < 4; ++mi) { const int rr = rt * 64 + 16 * mi + fr;
            if (rr < cnt) { const float rs = RSTD1[tok[mi]], gt = GATES[(size_t)tok[mi] * 2 + ek];
#pragma unroll
                for (int nj = 0; nj < 2; ++nj) { const f32x4 gv = acc[mi][nj] * rs, uv = acc[mi][nj + 2] * rs; f32x4 hv;
                    hv.x = silu_f(gv.x) * uv.x * gt; hv.y = silu_f(gv.y) * uv.y * gt; hv.z = silu_f(gv.z) * uv.z * gt; hv.w = silu_f(gv.w) * uv.w * gt;
                    v2u w; w.x = pk2(hv.x, hv.y); w.y = pk2(hv.z, hv.w);
                    *(v2u*)(HID + (size_t)(off + rr) * 1024 + ek * 512 + c0 + 16 * nj + 4 * fq) = w; } } }
    }
}
__device__ __forceinline__ void ph_moe_down(const Args& a, LAS unsigned char* lds, int L, int wk, int nwk) {
    const int tid = threadIdx.x, lane = tid & 63, wave = __builtin_amdgcn_readfirstlane(tid >> 6), fr = lane & 15, fq = lane >> 4;
    const int gw = wk * NWAVES + wave, NGW = nwk * NWAVES;
    bk_table(a, lds, L, 16);
    LAS int* tb = (LAS int*)lds;
    const bf16* HID = (const bf16*)(a.ws + WS_HID); const bf16* WD = (const bf16*)(a.ws + WS_WD);
    float* H = (float*)(a.ws + WS_H); bf16* HB = (bf16*)a.out; const int* LIST = (const int*)(a.ws + WS_LIST);
    const int nun = tb[2 * NBK + NBK];
    for (int u = gw; u < nun; u += NGW) {
        int bk = 0;
        for (int i = 1; i < NBK; ++i) if (u >= tb[2 * NBK + i]) bk = i;
        const int cnt = tb[bk], off = tb[NBK + bk], r = u - tb[2 * NBK + bk];
        const int rt = r >> 4, ct = r & 15;
        int elo, ehi; bk_experts(bk, elo, ehi);
        const bf16* arow[4];
#pragma unroll
        for (int mi = 0; mi < 4; ++mi) arow[mi] = HID + (size_t)(off + rt * 64 + 16 * mi + fr) * 1024;
        f32x4 acc[4][4]; zero_acc(acc);
        sg_kloop<4>(1024, arow, [=](int n, int k0) { return WD + ((size_t)((k0 < 512 ? elo : ehi) * 1024 + ct * 64 + n)) * 512 + (k0 & 511); }, NoKS(), acc, fr, fq);
#pragma unroll
        for (int mi = 0; mi < 4; ++mi) { const int rr = rt * 64 + 16 * mi + fr;
            if (rr < cnt) { const int tok = LIST[(size_t)bk * T + rr];
#pragma unroll
                for (int nj = 0; nj < 4; ++nj) { const int c = ct * 64 + 16 * nj + 4 * fq; float* hp = H + (size_t)tok * D + c;
                    const f32x4 v = *(const f32x4*)hp + acc[mi][nj]; *(f32x4*)hp = v;
                    v2u w; w.x = pk2(v.x, v.y); w.y = pk2(v.z, v.w); *(v2u*)(HB + (size_t)tok * D + c) = w; } } }
    }
}


__device__ __forceinline__ void hb_store4(bf16* HB, int row, int col, const f32x4 v) {
    v2u w; w.x = pg8::cvt_pk_bf16(v[0], v[1]); w.y = pg8::cvt_pk_bf16(v[2], v[3]); *(v2u*)(HB + (size_t)row * D + col) = w;
}
__device__ __forceinline__ void hb_store8(bf16* HB, int row, int col, const f32x4 v0, const f32x4 v1) {
    v4u w; w.x = pg8::cvt_pk_bf16(v0[0], v0[1]); w.y = pg8::cvt_pk_bf16(v0[2], v0[3]); w.z = pg8::cvt_pk_bf16(v1[0], v1[1]); w.w = pg8::cvt_pk_bf16(v1[2], v1[3]);
    *(v4u*)(HB + (size_t)row * D + col) = w;
}
constexpr int LDS_TAB = 131072;

struct PGemm2 {
    static constexpr bool PERM = true;
    struct Unit { int pm, pn, ui; };
    const Args* ap; const char* A; const char* B; bf16* HB; int G, c; int ldb, nt;
    __device__ __forceinline__ bool next(int i, Unit& u) const { u.ui = i; return pg8::static_order(64, 4, G, c, i, u.pm, u.pn); }
    __device__ __forceinline__ void avoff(const Unit& u, const int (&RA)[2], const int (&CA)[2], unsigned (&v)[4]) const {
#pragma unroll
        for (int h = 0; h < 2; ++h)
#pragma unroll
            for (int i = 0; i < 2; ++i) { const int row = u.pm * 256 + h * 128 + RA[i]; v[h * 2 + i] = (unsigned)(row * LDP + CA[i]) * 2u; }
    }
    __device__ __forceinline__ const char* abase(const Unit&) const { return A; }
    __device__ __forceinline__ const char* btile(const Unit& u, int t) const { return B + ((size_t)u.pn * 256 * 2048 + (size_t)t * 64) * 2; }
    __device__ __forceinline__ void khook(int t, pg8::Acc& acc, const Unit& u, LAS unsigned char* lds, int wr, int wc, int fr, int fq) const {
        if (t == 8 || t == 16) {
            const LAS float* ft = (const LAS float*)(lds + LDS_TAB) + u.ui * 512 + (t == 16 ? 1 : 0);
#pragma unroll
            for (int ai = 0; ai < 2; ++ai)
#pragma unroll
                for (int m = 0; m < 4; ++m) { const float f = ft[(ai * 128 + wr * 64 + m * 16 + fr) * 2];
#pragma unroll
                    for (int bj = 0; bj < 2; ++bj)
#pragma unroll
                        for (int n = 0; n < 2; ++n) acc[ai][bj][m][n] *= f; }
        }
    }
    __device__ __forceinline__ void epi(const pg8::Acc& acc, const Unit& u, int wr, int wc, int fr, int fq) const {
        const int row0 = u.pm * 256 + wr * 64 + fr, col0 = u.pn * 256 + wc * 32 + 8 * fq;
#pragma unroll
        for (int ai = 0; ai < 2; ++ai)
#pragma unroll
            for (int m = 0; m < 4; ++m) { const int row = row0 + ai * 128 + m * 16; const float* hr = h0_row(*ap, row);
#pragma unroll
                for (int bj = 0; bj < 2; ++bj) { const int col = col0 + bj * 128;
                    hb_store8(HB, row, col, acc[ai][bj][m][0] + *(const f32x4*)(hr + col), acc[ai][bj][m][1] + *(const f32x4*)(hr + col + 4)); } }
    }
};
__device__ __forceinline__ void ssd_factors(const float* SSDSQ, int row, float& f0, float& f1) {
    const f32x4* sq = (const f32x4*)(SSDSQ + (size_t)row * 16); const f32x4 q0 = sq[0], q1 = sq[1], q2 = sq[2], q3 = sq[3];
    const float s0 = (q0.x + q0.y + q0.z + q0.w) + (q1.x + q1.y + q1.z + q1.w), s1 = (q2.x + q2.y + q2.z + q2.w) + (q3.x + q3.y + q3.z + q3.w);
    const float r0 = rsqrtf(s0 * (1.f / 512.f) + EPS), r1 = rsqrtf(s1 * (1.f / 512.f) + EPS);
    f0 = r0 / r1; f1 = r1;
}
__device__ __forceinline__ void ph_gemm2_pg8(const Args& a, LAS unsigned char* lds, int wk, int G) {
    const int tid = threadIdx.x, lane = tid & 63, wave = __builtin_amdgcn_readfirstlane(tid >> 6), fr = lane & 15, fq = lane >> 4;
    const float* SSDSQ = (const float*)(a.ws + WS_SSDSQ);
    PGemm2 S; S.ap = &a; S.A = (const char*)(a.ws + WS_PROJ); S.B = (const char*)(a.ws + WS_WOUT); S.HB = (bf16*)a.out;
    S.G = G; S.c = (int)blockIdx.x; S.ldb = 2048; S.nt = 32;
    {
        LAS float* ft = (LAS float*)(lds + LDS_TAB);
        PGemm2::Unit u;
        for (int i = 0; i < 4 && S.next(i, u); ++i)
            if (tid < 256) { float f0, f1; ssd_factors(SSDSQ, u.pm * 256 + tid, f0, f1); ft[i * 512 + tid * 2] = f0; ft[i * 512 + tid * 2 + 1] = f1; }
        __syncthreads();
    }
    pg8::gemm_phase<PGemm2, true>(lds, S);
    const bf16* PROJ = (const bf16*)(a.ws + WS_PROJ); const bf16* WOUT = (const bf16*)(a.ws + WS_WOUT);
    for (int tile = wk; tile < 32; tile += G) {
        const int rt = tile >> 4, ct = tile & 15, kb = wave * 256;
        const bf16* arow[4];
#pragma unroll
        for (int mi = 0; mi < 4; ++mi) arow[mi] = PROJ + (size_t)(16384 + rt * 64 + 16 * mi + fr) * LDP + kb;
        f32x4 acc[4][4]; zero_acc(acc);
        sg_kloop<4>(256, arow, [=](int n, int k0) { return WOUT + (size_t)(ct * 64 + n) * 2048 + kb + k0; }, NoKS(), acc, fr, fq);
        LAS float* part = (LAS float*)lds + wave * 4096;
        __syncthreads();
#pragma unroll
        for (int mi = 0; mi < 4; ++mi) { const int r = 16 * mi + fr; float f0, f1; ssd_factors(SSDSQ, 16384 + rt * 64 + r, f0, f1);
            const float sc = wave < 2 ? f0 * f1 : (wave < 4 ? f1 : 1.f);
#pragma unroll
            for (int nj = 0; nj < 4; ++nj) *(LAS f32x4*)(part + r * 64 + 16 * nj + 4 * fq) = acc[mi][nj] * sc; }
        __syncthreads();
        for (int q = tid; q < 1024; q += 512) { const int r = q >> 4, c4 = (q & 15) * 4; f32x4 s = *(const LAS f32x4*)((LAS float*)lds + r * 64 + c4);
#pragma unroll
            for (int w = 1; w < 8; ++w) s += *(const LAS f32x4*)((LAS float*)lds + w * 4096 + r * 64 + c4);
            const int row = 16384 + rt * 64 + r, col = ct * 64 + c4;
            hb_store4(S.HB, row, col, s + *(const f32x4*)(h0_row(a, row) + col)); }
        __syncthreads();
    }
}

struct BkInfo { int bk, rt, cnt, off; };
__device__ __forceinline__ void bk_table256(const Args& a, LAS unsigned char* lds, int L) {
    LAS int* tb = (LAS int*)(lds + LDS_TAB);
    __syncthreads();
    if (threadIdx.x == 0) {
        const unsigned* cnt = (const unsigned*)(a.ws + WS_CTL) + CW_CNT + 1024 * L;
        int off = 0, rts = 0;
        for (int i = 0; i < NBK; ++i) { const int c = (int)__hip_atomic_load(cnt + 32 * i, __ATOMIC_RELAXED, __HIP_MEMORY_SCOPE_AGENT);
            tb[i] = c; tb[NBK + i] = off; tb[2 * NBK + i] = rts; off += (c + 255) & ~255; rts += (c + 255) >> 8; }
        tb[2 * NBK + NBK] = rts;
    }
    __syncthreads();
}
__device__ __forceinline__ bool bk_find(const LAS int* tb, int rti, BkInfo& o) {
    if (rti >= tb[2 * NBK + NBK]) return false;
    int bk = 0;
    for (int i = 1; i < NBK; ++i) if (rti >= tb[2 * NBK + i]) bk = i;
    o.bk = bk; o.rt = rti - tb[2 * NBK + bk]; o.cnt = tb[bk]; o.off = tb[NBK + bk]; return true;
}
struct PMoeUp {
    static constexpr bool PERM = true;
    struct Unit { int bk, rt, cnt, off, e, ek, pnl, ui; };
    const char* A; const char* B; bf16* HID; const float* rstd; const float* gates; const LAS int* tb; const LAS int* rowtab; int G, c; int ldb, nt;
    __device__ __forceinline__ bool next(int i, Unit& u) const {
        const int Lu = i * G + c; BkInfo o; if (!bk_find(tb, Lu >> 3, o)) return false;
        u.bk = o.bk; u.rt = o.rt; u.cnt = o.cnt; u.off = o.off; u.ek = (Lu >> 2) & 1; u.pnl = Lu & 3; u.ui = i;
        int elo, ehi; bk_experts(o.bk, elo, ehi); u.e = u.ek ? ehi : elo; return true;
    }
    __device__ __forceinline__ void avoff(const Unit& u, const int (&RA)[2], const int (&CA)[2], unsigned (&v)[4]) const {
#pragma unroll
        for (int h = 0; h < 2; ++h)
#pragma unroll
            for (int i = 0; i < 2; ++i) { const int tok = rowtab[u.ui * 256 + h * 128 + RA[i]]; v[h * 2 + i] = (unsigned)(tok * D + CA[i]) * 2u; }
    }
    __device__ __forceinline__ const char* abase(const Unit&) const { return A; }
    __device__ __forceinline__ const char* btile(const Unit& u, int t) const { return B + ((size_t)(u.e * 1024 + u.pnl * 256) * 1024 + (size_t)t * 64) * 2; }
    __device__ __forceinline__ void khook(int, pg8::Acc&, const Unit&, LAS unsigned char*, int, int, int, int) const {}
    __device__ __forceinline__ void epi(const pg8::Acc& acc, const Unit& u, int wr, int wc, int fr, int fq) const {
        const int r0 = wr * 64 + fr, col0 = u.ek * 512 + u.pnl * 128 + wc * 32 + 8 * fq;
        float rsv[2][4], gtv[2][4];
#pragma unroll
        for (int ai = 0; ai < 2; ++ai)
#pragma unroll
            for (int m = 0; m < 4; ++m) { const int tok = rowtab[u.ui * 256 + r0 + ai * 128 + m * 16]; rsv[ai][m] = rstd[tok]; gtv[ai][m] = gates[(size_t)tok * 2 + u.ek]; }
#pragma unroll
        for (int ai = 0; ai < 2; ++ai)
#pragma unroll
            for (int m = 0; m < 4; ++m) { const int rr = u.rt * 256 + r0 + ai * 128 + m * 16;
                if (rr < u.cnt) { const float rs = rsv[ai][m], gt = gtv[ai][m]; float hv[8];
#pragma unroll
                    for (int n = 0; n < 2; ++n)
#pragma unroll
                        for (int j = 0; j < 4; ++j) { const float g = acc[ai][0][m][n][j] * rs, uu = acc[ai][1][m][n][j] * rs; hv[n * 4 + j] = silu_f(g) * uu * gt; }
                    v4u w; w.x = pg8::cvt_pk_bf16(hv[0], hv[1]); w.y = pg8::cvt_pk_bf16(hv[2], hv[3]); w.z = pg8::cvt_pk_bf16(hv[4], hv[5]); w.w = pg8::cvt_pk_bf16(hv[6], hv[7]);
                    *(v4u*)(HID + (size_t)(u.off + rr) * 1024 + col0) = w; } }
    }
};
__device__ __forceinline__ void ph_moe_up_pg8(const Args& a, LAS unsigned char* lds, int L, int G) {
    bk_table256(a, lds, L);
    const LAS int* tb = (const LAS int*)(lds + LDS_TAB); LAS int* rowtab = (LAS int*)(lds + LDS_TAB + 1024);
    PMoeUp S; S.A = (const char*)a.out; S.B = (const char*)(a.ws + ws_wgu(L)); S.HID = (bf16*)(a.ws + WS_HID); S.rstd = (const float*)(a.ws + WS_RSTD1); S.gates = (const float*)(a.ws + WS_GATES);
    S.tb = tb; S.rowtab = rowtab; S.G = G; S.c = (int)blockIdx.x; S.ldb = 1024; S.nt = 16;
    {   const int* LIST = (const int*)(a.ws + WS_LIST); PMoeUp::Unit u;
        for (int i = 0; i < 4 && S.next(i, u); ++i)
            if (threadIdx.x < 256) { int rr = u.rt * 256 + (int)threadIdx.x; rr = rr < u.cnt ? rr : u.cnt - 1; rowtab[i * 256 + threadIdx.x] = LIST[(size_t)u.bk * T + rr]; }
        __syncthreads();
    }
    pg8::gemm_phase<PMoeUp, true>(lds, S);
}
struct PMoeDown {
    static constexpr bool PERM = true;
    struct Unit { int bk, rt, cnt, off, elo, ehi, pn, ui; };
    const char* A; const char* B; bf16* HB; bf16* HBo; float* SSQ; const LAS int* tb; const LAS int* rowtab; int G, c; int ldb, nt;
    __device__ __forceinline__ bool next(int i, Unit& u) const {
        const int Lu = i * G + c; BkInfo o; if (!bk_find(tb, Lu >> 2, o)) return false;
        u.bk = o.bk; u.rt = o.rt; u.cnt = o.cnt; u.off = o.off; u.pn = Lu & 3; u.ui = i; bk_experts(o.bk, u.elo, u.ehi); return true;
    }
    __device__ __forceinline__ void avoff(const Unit& u, const int (&RA)[2], const int (&CA)[2], unsigned (&v)[4]) const {
#pragma unroll
        for (int h = 0; h < 2; ++h)
#pragma unroll
            for (int i = 0; i < 2; ++i) { const int row = u.off + u.rt * 256 + h * 128 + RA[i]; v[h * 2 + i] = (unsigned)(row * 1024 + CA[i]) * 2u; }
    }
    __device__ __forceinline__ const char* abase(const Unit&) const { return A; }
    __device__ __forceinline__ const char* btile(const Unit& u, int t) const { return B + ((size_t)((t < 8 ? u.elo : u.ehi) * 1024 + u.pn * 256) * 512 + (size_t)(t & 7) * 64) * 2; }
    __device__ __forceinline__ void khook(int, pg8::Acc&, const Unit&, LAS unsigned char*, int, int, int, int) const {}
    __device__ __forceinline__ void epi(const pg8::Acc& acc, const Unit& u, int wr, int wc, int fr, int fq) const {
        const int r0 = wr * 64 + fr, col0 = u.pn * 256 + wc * 32 + 8 * fq;
        int tok[8];
#pragma unroll
        for (int g8 = 0; g8 < 8; ++g8) tok[g8] = rowtab[u.ui * 256 + r0 + (g8 >> 2) * 128 + (g8 & 3) * 16];
        v4u cur[2], nxt[2];
#pragma unroll
        for (int bj = 0; bj < 2; ++bj) cur[bj] = *(const v4u*)(HB + (size_t)tok[0] * D + col0 + bj * 128);
#pragma unroll
        for (int g8 = 0; g8 < 8; ++g8) {
            const int ai = g8 >> 2, m = g8 & 3;
            if (g8 < 7) {
#pragma unroll
                for (int bj = 0; bj < 2; ++bj) nxt[bj] = *(const v4u*)(HB + (size_t)tok[g8 + 1] * D + col0 + bj * 128); }
            const int rr = u.rt * 256 + r0 + ai * 128 + m * 16;
            float sq = 0.f;
#pragma unroll
            for (int bj = 0; bj < 2; ++bj) { f32x4 h0v, h1v; unpack8v(cur[bj], h0v, h1v);
                const f32x4 v0 = acc[ai][bj][m][0] + h0v, v1 = acc[ai][bj][m][1] + h1v;
                sq += (v0[0] * v0[0] + v0[1] * v0[1] + v0[2] * v0[2] + v0[3] * v0[3]) + (v1[0] * v1[0] + v1[1] * v1[1] + v1[2] * v1[2] + v1[3] * v1[3]);
                if (rr < u.cnt) hb_store8(HBo, tok[g8], col0 + bj * 128, v0, v1); }
            sq += __shfl_xor(sq, 16); sq += __shfl_xor(sq, 32);
            if (rr < u.cnt && fq == 0) SSQ[(size_t)tok[g8] * 16 + u.pn * 4 + wc] = sq;
#pragma unroll
            for (int bj = 0; bj < 2; ++bj) cur[bj] = nxt[bj];
        }
    }
};
__device__ __forceinline__ void ph_moe_down_pg8(const Args& a, LAS unsigned char* lds, int L, int G) {
    bk_table256(a, lds, L);
    const LAS int* tb = (const LAS int*)(lds + LDS_TAB); LAS int* rowtab = (LAS int*)(lds + LDS_TAB + 1024);
    PMoeDown S; S.A = (const char*)(a.ws + WS_HID); S.B = (const char*)(a.ws + ws_wd(L)); S.SSQ = (float*)(a.ws + WS_SSDSQ); S.HB = (bf16*)a.out; S.HBo = L ? (bf16*)(a.ws + WS_H) : (bf16*)a.out;
    S.tb = tb; S.rowtab = rowtab; S.G = G; S.c = (int)blockIdx.x; S.ldb = 512; S.nt = 16;
    {   const int* LIST = (const int*)(a.ws + WS_LIST); PMoeDown::Unit u;
        for (int i = 0; i < 4 && S.next(i, u); ++i)
            if (threadIdx.x < 256) { int rr = u.rt * 256 + (int)threadIdx.x; rr = rr < u.cnt ? rr : u.cnt - 1; rowtab[i * 256 + threadIdx.x] = LIST[(size_t)u.bk * T + rr]; }
        __syncthreads();
    }
    pg8::gemm_phase<PMoeDown, true>(lds, S);
}
struct PPool {
    static constexpr bool PERM = true;
    struct Unit { int pm, pn; };
    const char* A; const char* B; bf16* HB; const float* pb; const float* ps; int G, c; int ldb, nt;
    __device__ __forceinline__ bool next(int i, Unit& u) const { return pg8::static_order(65, 4, G, c, i, u.pm, u.pn); }
    __device__ __forceinline__ void avoff(const Unit& u, const int (&RA)[2], const int (&CA)[2], unsigned (&v)[4]) const {
#pragma unroll
        for (int h = 0; h < 2; ++h)
#pragma unroll
            for (int i = 0; i < 2; ++i) { int row = u.pm * 256 + h * 128 + RA[i]; row = row < T ? row : T - 1; v[h * 2 + i] = (unsigned)(row * D + CA[i]) * 2u; }
    }
    __device__ __forceinline__ const char* abase(const Unit& u) const { return A + (size_t)u.pn * 256 * 2; }
    __device__ __forceinline__ const char* btile(const Unit& u, int t) const { return B + ((size_t)u.pn * 256 * 256 + (size_t)t * 64) * 2; }
    __device__ __forceinline__ void khook(int, pg8::Acc&, const Unit&, LAS unsigned char*, int, int, int, int) const {}
    __device__ __forceinline__ void epi(const pg8::Acc& acc, const Unit& u, int wr, int wc, int fr, int fq) const {
        const int row0 = u.pm * 256 + wr * 64 + fr, col0 = u.pn * 256 + wc * 32 + 8 * fq;
        v4u cur[2], nxt[2];
        { const int rc = row0 < T ? row0 : T - 1;
#pragma unroll
          for (int bj = 0; bj < 2; ++bj) cur[bj] = *(const v4u*)(HB + (size_t)rc * D + col0 + bj * 128); }
#pragma unroll
        for (int g8 = 0; g8 < 8; ++g8) {
            const int ai = g8 >> 2, m = g8 & 3, row = row0 + ai * 128 + m * 16;
            if (g8 < 7) { const int rn = row0 + ((g8 + 1) >> 2) * 128 + ((g8 + 1) & 3) * 16, rc = rn < T ? rn : T - 1;
#pragma unroll
                for (int bj = 0; bj < 2; ++bj) nxt[bj] = *(const v4u*)(HB + (size_t)rc * D + col0 + bj * 128); }
            if (row < T) {
#pragma unroll
                for (int bj = 0; bj < 2; ++bj) { const int cc = col0 + bj * 128; f32x4 h0v, h1v; unpack8v(cur[bj], h0v, h1v);
                    hb_store8(HB, row, cc, h0v + (acc[ai][bj][m][0] + *(const f32x4*)(pb + cc)) * *(const f32x4*)(ps + cc),
                                           h1v + (acc[ai][bj][m][1] + *(const f32x4*)(pb + cc + 4)) * *(const f32x4*)(ps + cc + 4)); } }
#pragma unroll
            for (int bj = 0; bj < 2; ++bj) cur[bj] = nxt[bj];
        }
    }
};
__device__ __forceinline__ void ph_poolgemm_pg8(const Args& a, LAS unsigned char* lds, int G) {
    PPool S; S.A = (const char*)(a.ws + WS_POOLED); S.B = (const char*)(a.ws + WS_WPOOL); S.HB = (bf16*)a.out; S.pb = a.in[I_PB]; S.ps = a.in[I_PS];
    S.G = G; S.c = (int)blockIdx.x; S.ldb = 256; S.nt = 4;
    pg8::gemm_phase<PPool, true>(lds, S);
}

__device__ __forceinline__ void ph_pooled(const Args& a, LAS unsigned char* lds, int wk, int nwk) {
    const int tid = threadIdx.x, qt = tid >> 7, c8 = tid & 127, c = c8 * 8, g = c >> 8, w = 2 << g;
    const bf16* HBr = (const bf16*)a.out; const float* SSQ = (const float*)(a.ws + WS_SSDSQ); bf16* PO = (bf16*)(a.ws + WS_POOLED);
    LAS float* rs = (LAS float*)lds + qt * 64;
    for (int pr = wk; pr < 172; pr += nwk) {
        const int task = pr * 4 + qt, b = task / 86, t0 = (task % 86) * 24;
        const size_t rb = (size_t)b * LSEQ;
        __syncthreads();
        if (c8 < 40) { const int l = t0 - 16 + c8; float r = 0.f;
            if (l >= 0) { const f32x4* q = (const f32x4*)(SSQ + (rb + l) * 16); const f32x4 sv = (q[0] + q[1]) + (q[2] + q[3]); r = rsqrtf((sv[0] + sv[1] + sv[2] + sv[3]) * (1.f / D) + EPS); }
            rs[c8] = r; }
        __syncthreads();
        f32x4 S0 = (f32x4){0.f, 0.f, 0.f, 0.f}, S1 = S0;
        for (int j = 1; j <= w; ++j) { const int l = t0 - j; if (l >= 0) { f32x4 x0, x1; unpack8v(*(const v4u*)(HBr + (rb + l) * D + c), x0, x1); S0 += x0 * rs[16 - j]; S1 += x1 * rs[16 - j]; } }
#pragma unroll 4
        for (int t = 0; t < 24; ++t) {
            const int l = t0 + t;
            f32x4 h0v, h1v; unpack8v(*(const v4u*)(HBr + (rb + l) * D + c), h0v, h1v); h0v *= rs[16 + t]; h1v *= rs[16 + t];
            const int lo = l - w, loc = lo >= 0 ? lo : 0; const float rl = lo >= 0 ? rs[16 + t - w] : 0.f;
            f32x4 s0v, s1v; unpack8v(*(const v4u*)(HBr + (rb + loc) * D + c), s0v, s1v);
            S0 += h0v; S0 -= s0v * rl; S1 += h1v; S1 -= s1v * rl;
            const int n = (l + 1) < w ? (l + 1) : w; const float inv = 1.f / (float)n;
            const f32x4 o0 = S0 * inv - h0v, o1 = S1 * inv - h1v;
            v4u wv; wv.x = pk2(o0[0], o0[1]); wv.y = pk2(o0[2], o0[3]); wv.z = pk2(o1[0], o1[1]); wv.w = pk2(o1[2], o1[3]); *(v4u*)(PO + (rb + l) * D + c) = wv;
        }
    }
}
__device__ __forceinline__ void ph_poolgemm(const Args& a, int wk, int nwk) {
    const int tid = threadIdx.x, lane = tid & 63, wave = __builtin_amdgcn_readfirstlane(tid >> 6), fr = lane & 15, fq = lane >> 4;
    const int gw = wk * NWAVES + wave, NGW = nwk * NWAVES;
    const bf16* PO = (const bf16*)(a.ws + WS_POOLED); const bf16* WPOOL = (const bf16*)(a.ws + WS_WPOOL);
    float* H = (float*)(a.ws + WS_H); bf16* HB = (bf16*)a.out;
    for (int u = gw; u < 258 * 16; u += NGW) {
        const int rt = u / 16, ct = u % 16, g = ct >> 2;
        const bf16* arow[4];
#pragma unroll
        for (int mi = 0; mi < 4; ++mi) arow[mi] = PO + (size_t)(rt * 64 + 16 * mi + fr) * D + g * 256;
        f32x4 acc[4][4]; zero_acc(acc);
        sg_kloop<4>(256, arow, [=](int n, int k0) { return WPOOL + (size_t)(ct * 64 + n) * 256 + k0; }, NoKS(), acc, fr, fq);
#pragma unroll
        for (int mi = 0; mi < 4; ++mi) { const int row = rt * 64 + 16 * mi + fr;
#pragma unroll
            for (int nj = 0; nj < 4; ++nj) { const int c = ct * 64 + 16 * nj + 4 * fq; float* hp = H + (size_t)row * D + c;
                const f32x4 v = *(const f32x4*)hp + (acc[mi][nj] + *(const f32x4*)(a.in[I_PB] + c)) * *(const f32x4*)(a.in[I_PS] + c); *(f32x4*)hp = v;
                v2u w; w.x = pk2(v.x, v.y); w.y = pk2(v.z, v.w); *(v2u*)(HB + (size_t)row * D + c) = w; } }
    }
}
__device__ __forceinline__ void ph_final(const Args& a, int wk, int nwk) {
    const int tid = threadIdx.x, lane = tid & 63, wave = __builtin_amdgcn_readfirstlane(tid >> 6);
    const int gw = wk * NWAVES + wave, NGW = nwk * NWAVES;
    const f32x4* gn = (const f32x4*)a.in[I_NORMF] + lane;
    const bf16* HF = (const bf16*)(a.ws + WS_H);
    for (int orow = gw; orow < NB * SEQ; orow += NGW) {
        const int b = orow / SEQ, l = orow - b * SEQ, row = b * LSEQ + NMETA + l;
        const v2u* xr = (const v2u*)(HF + (size_t)row * D) + lane; f32x4 v[4]; float ss = 0.f;
#pragma unroll
        for (int j = 0; j < 4; ++j) { const v2u q = xr[64 * j]; v[j][0] = __uint_as_float(q.x << 16); v[j][1] = __uint_as_float(q.x & 0xffff0000u); v[j][2] = __uint_as_float(q.y << 16); v[j][3] = __uint_as_float(q.y & 0xffff0000u);
            ss += v[j].x * v[j].x + v[j].y * v[j].y + v[j].z * v[j].z + v[j].w * v[j].w; }
        ss = wave_sum(ss);
        const float rstd = rsqrtf(ss * (1.f / D) + EPS);
        f32x4* o = (f32x4*)(a.out + (size_t)orow * D) + lane;
#ifdef PROBE_T
        const unsigned long long* ts = (const unsigned long long*)(a.ws + WS_CTL + 2048);
        const float tA = (float)(ts[PROBE_A_HI] - ts[PROBE_A_LO]) * 0.01f, tB = (float)(ts[PROBE_B_HI] - ts[PROBE_B_LO]) * 0.01f;
#pragma unroll
        for (int j = 0; j < 4; ++j) { f32x4 r = v[j] * rstd * gn[64 * j] + tB * 0.01f; if (orow == 0 && lane == 0 && j == 0) r.x += tA; o[64 * j] = r; }
#else
#pragma unroll
        for (int j = 0; j < 4; ++j) o[64 * j] = v[j] * rstd * gn[64 * j];
#endif
    }
}

__global__ void __launch_bounds__(NWAVES * 64, 2) fwd_kernel(Args a) {
    extern __shared__ __attribute__((aligned(16))) unsigned char lds_raw[];
    LAS unsigned char* lds = (LAS unsigned char*)lds_raw;
    volatile LAS unsigned* MISC = (volatile LAS unsigned*)(lds + LDS_BYTES - 256);
    const int tid = threadIdx.x;
    const int G = gridDim.x; const int bx = blockIdx.x;
    const int wk = (G % 8 == 0) ? (bx % 8) * (G / 8) + bx / 8 : bx;
    if (tid < 64) MISC[tid] = 0u;
    __syncthreads();
    XcdBarrier bar; bar.bar = (unsigned*)(a.ws + WS_CTL) + CW_BAR; bar.x = 0; bar.st = nullptr;
    if (N_LAUNCHES == 1) bar = xcd_barrier_post((unsigned*)(a.ws + WS_CTL) + CW_BAR, MISC + 8);
    const int lo = a.ph_lo, hi = a.ph_hi;
#ifndef PH_MASK
#define PH_MASK 0xFFFF
#endif
#define IN(k) (((PH_MASK >> (k)) & 1) && lo <= (k) && (k) < hi)
#ifdef PROBE_T
#define STAMP(k) do { if (blockIdx.x == 0 && tid == 0) ((unsigned long long*)(a.ws + WS_CTL + 2048))[k] = __builtin_amdgcn_s_memrealtime(); } while (0)
#else
#define STAMP(k) do { } while (0)
#endif
#ifdef PROBE_K
    volatile LAS unsigned long long* pkt = (volatile LAS unsigned long long*)(lds + LDS_BYTES - 128);
#define PSTAMP(k) do { if (blockIdx.x == 0 && tid == 0) { if ((k) == PROBE_K) pkt[0] = __builtin_amdgcn_s_memrealtime(); if ((k) == PROBE_K + 1) pkt[1] = __builtin_amdgcn_s_memrealtime(); } } while (0)
#else
#define PSTAMP(k) do { } while (0)
#endif
#define SEAM(k) do { if (IN(k) && IN((k) + 1)) xcd_barrier(bar); STAMP((k) + 1); PSTAMP((k) + 1); } while (0)
    STAMP(0); PSTAMP(0);
    if (IN(0)) { ph_prep(a, lds, wk, G); } SEAM(0);
    if (IN(1)) { ph_gemm1_pg8(a, lds, G); } SEAM(1);
    if (IN(2)) { ph_conv(a, wk, G); } SEAM(2);
    if (IN(3)) { ph_mixers3(a, lds, wk, G); } SEAM(3);
    if (IN(4)) { ph_gemm2_pg8(a, lds, wk, G); } SEAM(4);
    if (IN(5)) { ph_router(a, lds, 0, wk, G); } SEAM(5);
    if (IN(6)) { ph_moe_up_pg8(a, lds, 0, G); } SEAM(6);
    if (IN(7)) { ph_moe_down_pg8(a, lds, 0, G); } SEAM(7);
    if (IN(8)) { ph_pooled(a, lds, wk, G); } SEAM(8);
    if (IN(9)) { ph_poolgemm_pg8(a, lds, G); } SEAM(9);
    if (IN(10)) { ph_router(a, lds, 1, wk, G); } SEAM(10);
    if (IN(11)) { ph_moe_up_pg8(a, lds, 1, G); } SEAM(11);
    if (IN(12)) { ph_moe_down_pg8(a, lds, 1, G); } SEAM(12);
    if (IN(13)) { ph_final(a, wk, G); }
#ifdef PROBE_K
    if (blockIdx.x == 0 && tid == 0) {
        asm volatile("s_waitcnt vmcnt(0)" ::: "memory");
        if (PROBE_K == 13) pkt[1] = __builtin_amdgcn_s_memrealtime();
        const unsigned long long tend = __builtin_amdgcn_s_memrealtime() + 4ull * (pkt[1] - pkt[0]);
        while (__builtin_amdgcn_s_memrealtime() < tend) __builtin_amdgcn_s_sleep(16);
    }
#endif
#undef IN
#undef SEAM
}

extern "C" void kernel_launch(void* const* d_in, const int* in_sizes, int n_in, void* d_out, int out_size, void* d_ws, size_t ws_size, hipStream_t stream) {
    static int grid = 0;
    if (grid == 0) {
        if (n_in != 31 || out_size != NB * SEQ * D || ws_size < WS_END) { fprintf(stderr, "kernel_launch: unexpected shapes (n_in %d out %d ws %zu)\n", n_in, out_size, ws_size); grid = -1; return; }
        int dev = 0, cus = 0;
        if (hipGetDevice(&dev) != hipSuccess || hipDeviceGetAttribute(&cus, hipDeviceAttributeMultiprocessorCount, dev) != hipSuccess) { grid = -1; return; }
        if (hipFuncSetAttribute((const void*)fwd_kernel, hipFuncAttributeMaxDynamicSharedMemorySize, LDS_BYTES) != hipSuccess) { grid = -1; return; }
        grid = cus;
    }
    if (grid < 0) return;
    (void)hipMemsetAsync((char*)d_ws + WS_CTL, 0, CTL_ZERO_BYTES, stream);
    Args a{};
    for (int i = 0; i < 31; ++i) a.in[i] = (const float*)d_in[i];
    a.out = (float*)d_out; a.ws = (unsigned char*)d_ws;
    if (N_LAUNCHES == 1) { a.ph_lo = 0; a.ph_hi = NPH; hipLaunchKernelGGL(fwd_kernel, dim3(grid), dim3(NWAVES * 64), LDS_BYTES, stream, a); }
    else for (int p = 0; p < NPH; ++p) { a.ph_lo = p; a.ph_hi = p + 1; hipLaunchKernelGGL(fwd_kernel, dim3(grid), dim3(NWAVES * 64), LDS_BYTES, stream, a); }
}
```

```cpp
#include <hip/hip_runtime.h>
#include <cstdio>
#include <cstdint>

#define GAS __attribute__((address_space(1)))
#define LAS __attribute__((address_space(3)))
typedef unsigned short bf16;
typedef short bf16x8 __attribute__((ext_vector_type(8)));
typedef float f32x4 __attribute__((ext_vector_type(4)));
typedef unsigned v4u __attribute__((ext_vector_type(4)));
typedef unsigned v2u __attribute__((ext_vector_type(2)));

#ifndef MK_N_LAUNCHES
#define MK_N_LAUNCHES 1
#endif
constexpr int NPH = 14;
constexpr int N_LAUNCHES = MK_N_LAUNCHES;

constexpr int NB = 8, SEQ = 2048, NMETA = 16, LSEQ = SEQ + NMETA, T = NB * LSEQ, D = 1024;
constexpr int PROJ_SRC = 4624, LDP = 4608;
constexpr int C_Z = 0, C_G = 1024, C_X = 2048, C_B = 3072, C_C = 3328, C_LI = 3584;
constexpr float EPS = 1e-6f;
constexpr int NBK = 24;

constexpr size_t MiB = 1u << 20;
constexpr size_t WS_CTL = 0, CTL_ZERO_BYTES = 1 * MiB;
constexpr size_t WS_WIN = 1 * MiB;
constexpr size_t WS_WOUT = 10 * MiB;
constexpr size_t WS_WPOOL = 14 * MiB;
constexpr size_t WS_WRT = 14 * MiB + 512 * 1024;
constexpr size_t WS_WDTT = 15 * MiB + 512 * 1024;
constexpr size_t WS_RSTD0 = 15 * MiB;
constexpr size_t WS_RSTD1 = WS_RSTD0 + 128 * 1024;
constexpr size_t WS_BKT = WS_RSTD1 + 128 * 1024;
constexpr size_t WS_GATES = WS_BKT + 128 * 1024;
constexpr size_t WS_DT = 16 * MiB;
constexpr size_t WS_SSDSQ = 17 * MiB + 64 * 1024;
constexpr size_t WS_LIST = 19 * MiB;
constexpr size_t WS_WGU = 21 * MiB;
constexpr size_t WS_WD = 53 * MiB;
constexpr size_t WS_H = 69 * MiB;
constexpr size_t WS_PROJ = 134 * MiB;
constexpr size_t WS_HID = WS_PROJ;
constexpr size_t WS_POOLED = WS_PROJ;
constexpr size_t WS_END = 280 * MiB;
constexpr size_t WS_WGU1 = WS_PROJ + 64 * MiB, WS_WD1 = WS_PROJ + 96 * MiB;
__host__ __device__ constexpr size_t ws_wgu(int L) { return L ? WS_WGU1 : WS_WGU; }
__host__ __device__ constexpr size_t ws_wd(int L) { return L ? WS_WD1 : WS_WD; }
static_assert(WS_H + (size_t)T * D * 4 <= WS_PROJ && WS_PROJ + (size_t)T * LDP * 2 <= WS_END, "ws map");
static_assert(WS_DT + (size_t)T * 16 * 4 <= WS_SSDSQ && WS_SSDSQ + (size_t)T * 16 * 4 <= WS_LIST && WS_LIST + (size_t)NBK * T * 4 <= WS_WGU, "ws map small");
constexpr int CW_CNT = 8192;
constexpr int CW_BAR = 4096;
constexpr int CW_RT = 16384;

constexpr int LDS_BYTES = 147456;
constexpr int NWAVES = 8;

struct Args { const float* in[31]; float* out; unsigned char* ws; int ph_lo, ph_hi; };
enum { I_X = 0, I_META, I_NORMF, I_MNE, I_WIN, I_SCW, I_SCB, I_DTB, I_ALOG, I_SD, I_SNORM, I_LCW, I_LCB, I_LWA, I_LBA, I_LWX, I_LBX, I_LLAM, I_WOUT,
       I_MNO, I_PW, I_PB, I_PS, I_FFN, I_RGW, I_RGB, I_REW, I_REB, I_EWG, I_EWU, I_EWD };

#define LDS_WAIT() asm volatile("s_waitcnt lgkmcnt(0)" ::: "memory")
__device__ __forceinline__ float bf2f(unsigned v) { return __uint_as_float(v << 16); }
__device__ __forceinline__ unsigned f2bf(float f) { unsigned u = __float_as_uint(f); return (u + 0x7fffu + ((u >> 16) & 1u)) >> 16; }
__device__ __forceinline__ unsigned pk2(float lo, float hi) { return f2bf(lo) | (f2bf(hi) << 16); }
__device__ __forceinline__ void unpack8v(const v4u r, f32x4& a, f32x4& b) {
    a[0] = __uint_as_float(r.x << 16); a[1] = __uint_as_float(r.x & 0xffff0000u); a[2] = __uint_as_float(r.y << 16); a[3] = __uint_as_float(r.y & 0xffff0000u);
    b[0] = __uint_as_float(r.z << 16); b[1] = __uint_as_float(r.z & 0xffff0000u); b[2] = __uint_as_float(r.w << 16); b[3] = __uint_as_float(r.w & 0xffff0000u);
}
__device__ __forceinline__ float wave_sum(float v) {
#pragma unroll
    for (int o = 1; o < 64; o <<= 1) v += __shfl_xor(v, o);
    return v;
}
__device__ __forceinline__ float rcp_f(float v) { return __builtin_amdgcn_rcpf(v); }
__device__ __forceinline__ float sigmoid_f(float v) { return rcp_f(1.f + __expf(-v)); }
__device__ __forceinline__ float silu_f(float v) { return v * rcp_f(1.f + __expf(-v)); }
__device__ __forceinline__ float softplus_f(float v) { return v > 20.f ? v : log1pf(__expf(v)); }
__device__ __forceinline__ float gelu_tanh_f(float v) { const float u2 = 1.5957691216057308f * (v + 0.044715f * v * v * v); return v * rcp_f(1.f + __expf(-u2)); }
__device__ __forceinline__ const float* h0_row(const Args& a, int row) {
    const int b = row / LSEQ, l = row - b * LSEQ;
    return l < NMETA ? a.in[I_META] + (size_t)l * D : a.in[I_X] + ((size_t)b * SEQ + (l - NMETA)) * D;
}

#define XB_TMO      128
#define XB_XCNT(j)  (256  + 64 * (j))
#define XB_XSUB(j)  (1280 + 64 * (j))
#define XB_XGEN(j)  (2304 + 64 * (j))
#define XB_TOP      3328
#define XB_TOPGEN   3392
#define XCD_BAR_WORDS 3456
#define XB_SPIN_CAP (1u << 18)
__device__ __forceinline__ unsigned xb_ld(unsigned* p)              { return __hip_atomic_load(p, __ATOMIC_RELAXED, __HIP_MEMORY_SCOPE_AGENT); }
__device__ __forceinline__ unsigned xb_add(unsigned* p, unsigned v) { return __hip_atomic_fetch_add(p, v, __ATOMIC_RELAXED, __HIP_MEMORY_SCOPE_AGENT); }
__device__ __forceinline__ unsigned xb_xcc_id() { return (unsigned)__builtin_amdgcn_s_getreg((3 << 11) | 20) & 0xFu; }
#define XB_SPIN(cond, bar) do { unsigned _sp = 0; while (cond) { __builtin_amdgcn_s_sleep(1); \
    if ((++_sp & 255u) == 0u) { if (xb_ld(&(bar)[XB_TMO])) break; if (_sp > XB_SPIN_CAP) { atomicAdd(&(bar)[XB_TMO], 1u); break; } } } } while (0)
struct XcdBarrier { unsigned* bar; unsigned x; volatile LAS unsigned* st; };
__device__ __forceinline__ XcdBarrier xcd_barrier_post(unsigned* bar, volatile LAS unsigned* st) {
    XcdBarrier b; b.bar = bar; b.x = xb_xcc_id(); b.st = st;
    if (threadIdx.x == 0) (void)xb_add(&bar[XB_XCNT(b.x)], 1u);
    return b;
}
__device__ __forceinline__ void xcd_barrier_complete(unsigned* bar, unsigned x, unsigned& nloc, unsigned& nx) {
    const unsigned G = gridDim.x * gridDim.y * gridDim.z;
    unsigned sum, cnt, mine, sp = 0u;
    for (;;) {
        sum = 0u; cnt = 0u; mine = 0u;
#pragma unroll
        for (unsigned j = 0; j < 16; ++j) { const unsigned c = xb_ld(&bar[XB_XCNT(j)]); sum += c; cnt += (c > 0u) ? 1u : 0u; mine = (j == x) ? c : mine; }
        if (sum == G) break;
        __builtin_amdgcn_s_sleep(1);
        if ((++sp & 255u) == 0u) { if (xb_ld(&bar[XB_TMO])) break; if (sp > XB_SPIN_CAP) { atomicAdd(&bar[XB_TMO], 1u); break; } }
    }
    nloc = mine > 0u ? mine : 1u; nx = cnt > 0u ? cnt : 1u;
}
__device__ __forceinline__ void xcd_barrier(const XcdBarrier& b) {
    asm volatile("s_waitcnt vmcnt(0)" ::: "memory");
    __syncthreads();
    if (threadIdx.x == 0) {
        unsigned* bar = b.bar;
        __builtin_amdgcn_s_waitcnt(0);
        unsigned nloc = b.st[0], nx = b.st[1];
        if (nloc == 0u) { xcd_barrier_complete(bar, b.x, nloc, nx); b.st[0] = nloc; b.st[1] = nx; }
        const unsigned old = xb_add(&bar[XB_XSUB(b.x)], 1u);
        const unsigned gen = old / nloc;
        if (old + 1u == (gen + 1u) * nloc) {
            __builtin_amdgcn_fence(__ATOMIC_RELEASE, "agent");
            asm volatile("s_waitcnt vmcnt(0)" ::: "memory");
            const unsigned og = xb_add(&bar[XB_TOP], 1u);
            const unsigned tg = og / nx;
            if (og + 1u == (tg + 1u) * nx) xb_add(&bar[XB_TOPGEN], 1u);
            else XB_SPIN(xb_ld(&bar[XB_TOPGEN]) == tg, bar);
            __builtin_amdgcn_fence(__ATOMIC_ACQUIRE, "agent");
            xb_add(&bar[XB_XGEN(b.x)], 1u);
            asm volatile("s_waitcnt vmcnt(0)" ::: "memory");
        } else {
            XB_SPIN(xb_ld(&bar[XB_XGEN(b.x)]) == gen, bar);
            __builtin_amdgcn_fence(__ATOMIC_ACQUIRE, "agent");
            asm volatile("s_waitcnt vmcnt(0)" ::: "memory");
        }
    }
    __syncthreads();
}

__device__ __forceinline__ void tr_item(const float* src, int ldsrc, const float* gain, bf16* dst, int lddst, LAS float* scr, int lane) {
    float tv[32];
#pragma unroll
    for (int i = 0; i < 32; ++i) { const int kk = 2 * i + (lane >> 5); tv[i] = src[(size_t)kk * ldsrc + (lane & 31)]; }
#pragma unroll
    for (int i = 0; i < 32; ++i) { const int kk = 2 * i + (lane >> 5); float v = tv[i]; if (gain) v *= gain[kk]; scr[kk * 33 + (lane & 31)] = v; }
    LDS_WAIT();
    const int c = lane & 7;
#pragma unroll
    for (int j = 0; j < 4; ++j) { const int n = (lane >> 3) + 8 * j; const LAS float* s = scr + (8 * c) * 33 + n;
        v4u o; o.x = pk2(s[0 * 33], s[1 * 33]); o.y = pk2(s[2 * 33], s[3 * 33]); o.z = pk2(s[4 * 33], s[5 * 33]); o.w = pk2(s[6 * 33], s[7 * 33]);
        *(v4u*)(dst + (size_t)n * lddst + 8 * c) = o; }
    LDS_WAIT();
}
__device__ __forceinline__ void convert_experts(const Args& a, int L, LAS float* scr, int gw, int NGW, int lane) {
    bf16* WGU = (bf16*)(a.ws + ws_wgu(L)); bf16* WD = (bf16*)(a.ws + ws_wd(L));
    const float* gain = a.in[I_FFN] + L * D;
    constexpr int I_GU = 16 * 16 * 16, I_DN = 16 * 8 * 32;
    for (int it = gw; it < 2 * I_GU + I_DN; it += NGW) {
        int r = it;
        if (r < 2 * I_GU) {
            const int up = r >= I_GU; if (up) r -= I_GU;
            const int e = r >> 8, kb = (r >> 4) & 15, nb = r & 15;
            const float* src = a.in[up ? I_EWU : I_EWG] + ((size_t)(L * 16 + e) * 1024 + kb * 64) * 512 + nb * 32;
            const int drow = e * 1024 + (nb >> 2) * 256 + (nb & 3) * 32 + (up ? 128 : 0);
            tr_item(src, 512, gain + kb * 64, WGU + (size_t)drow * 1024 + kb * 64, 1024, scr, lane);
        } else {
            r -= 2 * I_GU;
            const int e = r >> 8, kb = (r >> 5) & 7, nb = r & 31;
            const float* src = a.in[I_EWD] + ((size_t)(L * 16 + e) * 512 + kb * 64) * 1024 + nb * 32;
            tr_item(src, 1024, nullptr, WD + (size_t)(e * 1024 + nb * 32) * 512 + kb * 64, 512, scr, lane);
        }
    }
}
__device__ __forceinline__ void ph_prep(const Args& a, LAS unsigned char* lds, int wk, int nwk) {
    const int tid = threadIdx.x, lane = tid & 63, wave = __builtin_amdgcn_readfirstlane(tid >> 6);
    const int gw = wk * NWAVES + wave, NGW = nwk * NWAVES;
    LAS float* scr = (LAS float*)(lds + wave * 8448);
    bf16* WIN = (bf16*)(a.ws + WS_WIN); bf16* WOUT = (bf16*)(a.ws + WS_WOUT); bf16* WPOOL = (bf16*)(a.ws + WS_WPOOL);
    constexpr int I_IN = 16 * 144, I_OUT = 32 * 32, I_POOL = 4 * 4 * 8;
    for (int it = gw; it < I_IN + I_OUT + I_POOL; it += NGW) {
        int r = it;
        if (r < I_IN) { const int kb = r / 144, nb = r % 144, n0 = nb * 32;
            const int sc = n0 < 1024 ? n0 : (n0 < 2048 ? n0 - 1024 + 2576 : (n0 < 3584 ? n0 - 2048 + 1024 : n0 - 3584 + 3600));
            tr_item(a.in[I_WIN] + (size_t)(kb * 64) * PROJ_SRC + sc, PROJ_SRC, a.in[I_MNE] + kb * 64, WIN + (size_t)n0 * 1024 + kb * 64, 1024, scr, lane); continue; }
        r -= I_IN;
        if (r < I_OUT) { const int kb = r >> 5, nb = r & 31;
            tr_item(a.in[I_WOUT] + (size_t)(kb * 64) * 1024 + nb * 32, 1024, kb < 16 ? a.in[I_SNORM] + kb * 64 : nullptr, WOUT + (size_t)(nb * 32) * 2048 + kb * 64, 2048, scr, lane); continue; }
        r -= I_OUT;
        { const int g = r >> 5, kb = (r >> 3) & 3, nb = r & 7;
            tr_item(a.in[I_PW] + (size_t)g * 65536 + (size_t)(kb * 64) * 256 + nb * 32, 256, a.in[I_MNO] + g * 256 + kb * 64, WPOOL + (size_t)(g * 256 + nb * 32) * 256 + kb * 64, 256, scr, lane); }
    }
    {
        v4u* WRT = (v4u*)(a.ws + WS_WRT); v4u* WDTT = (v4u*)(a.ws + WS_WDTT);
        for (int i = wk * 512 + tid; i < 2 * 48 * 128 + 256 * 128; i += nwk * 512) {
            float f[8];
            if (i < 2 * 48 * 128) {
                const int L = i / 6144, r = i % 6144, n = r >> 7, k8 = (r & 127) * 8, j = n < 20 ? n : n - 20;
#pragma unroll
                for (int e = 0; e < 8; ++e) { const int k = k8 + e; float w = 0.f;
                    if (n < 40) { w = (j < 4 ? a.in[I_RGW][((size_t)L * 1024 + k) * 4 + j] : a.in[I_REW][((size_t)L * 1024 + k) * 16 + (j - 4)]) * a.in[I_FFN][L * 1024 + k];
                        if (n >= 20) w -= bf2f(f2bf(w)); }
                    f[e] = w; }
                v4u o; o.x = pk2(f[0], f[1]); o.y = pk2(f[2], f[3]); o.z = pk2(f[4], f[5]); o.w = pk2(f[6], f[7]); WRT[i] = o;
            } else {
                const int r = i - 2 * 48 * 128, n = r >> 7, k8 = (r & 127) * 8;
#pragma unroll
                for (int e = 0; e < 8; ++e) { const int k = k8 + e; f[e] = n < 16 ? a.in[I_WIN][(size_t)k * PROJ_SRC + 2560 + n] * a.in[I_MNE][k] : 0.f; }
                v4u o; o.x = pk2(f[0], f[1]); o.y = pk2(f[2], f[3]); o.z = pk2(f[4], f[5]); o.w = pk2(f[6], f[7]); WDTT[r] = o;
            }
        }
    }
    bf16* HB = (bf16*)a.out; float* RSTD0 = (float*)(a.ws + WS_RSTD0);
    for (int row = gw; row < T; row += NGW) {
        const f32x4* xr = (const f32x4*)h0_row(a, row) + lane;
        f32x4 v[4]; float ss = 0.f;
#pragma unroll
        for (int j = 0; j < 4; ++j) { v[j] = xr[64 * j]; ss += v[j].x * v[j].x + v[j].y * v[j].y + v[j].z * v[j].z + v[j].w * v[j].w; }
        ss = wave_sum(ss);
        v2u* o8 = (v2u*)(HB + (size_t)row * D) + lane;
#pragma unroll
        for (int j = 0; j < 4; ++j) { v2u w; w.x = pk2(v[j].x, v[j].y); w.y = pk2(v[j].z, v[j].w); o8[64 * j] = w; }
        if (lane == 0) RSTD0[row] = rsqrtf(ss * (1.f / D) + EPS);
    }
}

template <int NT, class BP, class KS>
__device__ __forceinline__ void sg_kloop(int K, const bf16* const (&arow)[4], BP bp, KS ks, f32x4 (&acc)[4][NT], int fr, int fq) {
    for (int k0 = 0; k0 < K; k0 += 32) {
        ks(k0, acc);
        bf16x8 av[4], bv[NT];
#pragma unroll
        for (int mi = 0; mi < 4; ++mi) av[mi] = *(const bf16x8*)(arow[mi] + k0 + 8 * fq);
#pragma unroll
        for (int nj = 0; nj < NT; ++nj) bv[nj] = *(const bf16x8*)(bp(16 * nj + fr, k0) + 8 * fq);
#pragma unroll
        for (int mi = 0; mi < 4; ++mi)
#pragma unroll
            for (int nj = 0; nj < NT; ++nj) acc[mi][nj] = __builtin_amdgcn_mfma_f32_16x16x32_bf16(bv[nj], av[mi], acc[mi][nj], 0, 0, 0);
    }
}
template <int NT> __device__ __forceinline__ void zero_acc(f32x4 (&acc)[4][NT]) {
#pragma unroll
    for (int mi = 0; mi < 4; ++mi)
#pragma unroll
        for (int nj = 0; nj < NT; ++nj) acc[mi][nj] = (f32x4){0.f, 0.f, 0.f, 0.f};
}
struct NoKS { template <int NT> __device__ __forceinline__ void operator()(int, f32x4 (&)[4][NT]) const {} };

__device__ __forceinline__ void ph_gemm1(const Args& a, int wk, int nwk) {
    const int tid = threadIdx.x, lane = tid & 63, wave = __builtin_amdgcn_readfirstlane(tid >> 6), fr = lane & 15, fq = lane >> 4;
    const int gw = wk * NWAVES + wave, NGW = nwk * NWAVES;
    const bf16* HB = (const bf16*)a.out; const bf16* WIN = (const bf16*)(a.ws + WS_WIN); bf16* PROJ = (bf16*)(a.ws + WS_PROJ);
    const float* RSTD0 = (const float*)(a.ws + WS_RSTD0);
    for (int u = gw; u < 258 * 72; u += NGW) {
        const int rt = u / 72, ct = u % 72;
        const bf16* arow[4];
#pragma unroll
        for (int mi = 0; mi < 4; ++mi) arow[mi] = HB + (size_t)(rt * 64 + 16 * mi + fr) * D;
        f32x4 acc[4][4]; zero_acc(acc);
        sg_kloop<4>(1024, arow, [=](int n, int k0) { return WIN + (size_t)(ct * 64 + n) * 1024 + k0; }, NoKS(), acc, fr, fq);
#pragma unroll
        for (int mi = 0; mi < 4; ++mi) { const int row = rt * 64 + 16 * mi + fr; const float rs = RSTD0[row];
#pragma unroll
            for (int nj = 0; nj < 4; ++nj) { const f32x4 v = acc[mi][nj] * rs; v2u w; w.x = pk2(v.x, v.y); w.y = pk2(v.z, v.w);
                *(v2u*)(PROJ + (size_t)row * LDP + ct * 64 + 16 * nj + 4 * fq) = w; } }
    }
}

__device__ __forceinline__ void ph_gemm2(const Args& a, int wk, int nwk) {
    const int tid = threadIdx.x, lane = tid & 63, wave = __builtin_amdgcn_readfirstlane(tid >> 6), fr = lane & 15, fq = lane >> 4;
    const int gw = wk * NWAVES + wave, NGW = nwk * NWAVES;
    const bf16* PROJ = (const bf16*)(a.ws + WS_PROJ); const bf16* WOUT = (const bf16*)(a.ws + WS_WOUT);
    const float* SSDSQ = (const float*)(a.ws + WS_SSDSQ);
    float* H = (float*)(a.ws + WS_H); bf16* HB = (bf16*)a.out;
    for (int u = gw; u < 258 * 16; u += NGW) {
        const int rt = u / 16, ct = u % 16;
        const bf16* arow[4]; float f0[4], f1[4];
#pragma unroll
        for (int mi = 0; mi < 4; ++mi) { const int row = rt * 64 + 16 * mi + fr; arow[mi] = PROJ + (size_t)row * LDP;
            const f32x4* sq = (const f32x4*)(SSDSQ + (size_t)row * 16); const f32x4 q0 = sq[0], q1 = sq[1], q2 = sq[2], q3 = sq[3];
            const float s0 = (q0.x + q0.y + q0.z + q0.w) + (q1.x + q1.y + q1.z + q1.w), s1 = (q2.x + q2.y + q2.z + q2.w) + (q3.x + q3.y + q3.z + q3.w);
            const float r0 = rsqrtf(s0 * (1.f / 512.f) + EPS), r1 = rsqrtf(s1 * (1.f / 512.f) + EPS);
            f0[mi] = r0 / r1; f1[mi] = r1; }
        f32x4 acc[4][4]; zero_acc(acc);
        auto ks = [=](int k0, f32x4 (&ac)[4][4]) {
            if (k0 == 512) {
#pragma unroll
                for (int mi = 0; mi < 4; ++mi)
#pragma unroll
                    for (int nj = 0; nj < 4; ++nj) ac[mi][nj] *= f0[mi]; }
            if (k0 == 1024) {
#pragma unroll
                for (int mi = 0; mi < 4; ++mi)
#pragma unroll
                    for (int nj = 0; nj < 4; ++nj) ac[mi][nj] *= f1[mi]; }
        };
        sg_kloop<4>(2048, arow, [=](int n, int k0) { return WOUT + (size_t)(ct * 64 + n) * 2048 + k0; }, ks, acc, fr, fq);
#pragma unroll
        for (int mi = 0; mi < 4; ++mi) { const int row = rt * 64 + 16 * mi + fr; const float* hr = h0_row(a, row);
#pragma unroll
            for (int nj = 0; nj < 4; ++nj) { const int c = ct * 64 + 16 * nj + 4 * fq; const f32x4 v = acc[mi][nj] + *(const f32x4*)(hr + c);
                *(f32x4*)(H + (size_t)row * D + c) = v; v2u w; w.x = pk2(v.x, v.y); w.y = pk2(v.z, v.w); *(v2u*)(HB + (size_t)row * D + c) = w; } }
    }
}


namespace pg8 {
constexpr int BM = 256, BK = 64, HALF = 128, HTB = HALF * BK * 2, STAGE_BYTES = 8 * HTB, NXCD = 8, WGM = 8;
__host__ __device__ __forceinline__ int lds_byte(int r, int c) { const int st = (r >> 4) * 2 + (c >> 5), rr = r & 15, cc = c & 31, ob = rr * 64 + cc * 2; return st * 1024 + (ob ^ (((ob >> 9) & 1) << 5)); }
__host__ __device__ __forceinline__ void stage_rc(int b, int& R, int& C) { const int st = b / 1024, sb = b % 1024, swz = sb ^ (((sb >> 9) & 1) << 5); R = (st >> 1) * 16 + swz / 64; C = (st & 1) * 32 + (swz % 64) / 2; }
__host__ __device__ __forceinline__ int perm32(int rho) { const int n = rho >> 4, i = rho & 15; return 8 * (i >> 2) + 4 * n + (i & 3); }
__device__ __forceinline__ unsigned cvt_pk_bf16(float lo, float hi) { unsigned r; asm volatile("v_cvt_pk_bf16_f32 %0, %1, %2" : "=v"(r) : "v"(lo), "v"(hi)); return r; }
typedef f32x4 Acc[2][2][4][2];

__device__ __forceinline__ bool static_order(int nM, int nN, int G, int c, int i, int& pm, int& pn) {
    const int nwg = nM * nN; const long L = (long)i * G + c; if (L >= nwg) return false;
    int wgid = (int)L; { const int q = nwg / NXCD, r = nwg % NXCD, xcd = wgid % NXCD, off = wgid / NXCD; wgid = (xcd < r ? xcd * (q + 1) : r * (q + 1) + (xcd - r) * q) + off; }
    const int nig = WGM * nN, gid = wgid / nig, fm = gid * WGM, gsz = (nM - fm) < WGM ? (nM - fm) : WGM;
    pm = fm + ((wgid % nig) % gsz); pn = (wgid % nig) / gsz; return true;
}

template <class P, bool ALIGN_EPI>
__device__ __forceinline__ void gemm_phase(LAS unsigned char* lds, const P& S) {
    const int tid = threadIdx.x, wid = __builtin_amdgcn_readfirstlane(tid >> 6), lane = tid & 63, wr = wid >> 2, wc = wid & 3, fr = lane & 15, fq = lane >> 4;
    const int nt = S.nt;
    int RA[2], CA[2]; unsigned voffB[2];
#pragma unroll
    for (int i = 0; i < 2; ++i) { int R, C; stage_rc(tid * 16 + i * 8192, R, C); RA[i] = R; CA[i] = C; const int Rb = P::PERM ? ((R & ~31) + perm32(R & 31)) : R;
        voffB[i] = (unsigned)(Rb * S.ldb + C) * 2u; }
    const size_t kstep = (size_t)(BK * 2);
    const size_t hstepB = (size_t)HALF * S.ldb * 2;
    const unsigned ldsw = (unsigned)wid * 1024u;
    const int aoff = lds_byte(wr * 64 + fr, fq * 8), boff = lds_byte(wc * 32 + fr, fq * 8);
#define PG8_SA(b, h) (((b) * 2 + (h)) * HTB)
#define PG8_SB(b, h) ((4 + (b) * 2 + (h)) * HTB)
#define PG8_STAGE(bufoff, gbase, voff) do { _Pragma("unroll") for (int _i = 0; _i < 2; ++_i) \
        __builtin_amdgcn_global_load_lds((const unsigned*)((const char*)(gbase) + (voff)[_i]), (LAS unsigned*)(lds + (bufoff) + ldsw + _i * 8192), 16, 0, 0); } while (0)
#define PG8_LDA(dst, b, h) do { _Pragma("unroll") for (int m = 0; m < 4; ++m) _Pragma("unroll") for (int k = 0; k < 2; ++k) dst[m][k] = *(const LAS bf16x8*)(lds + PG8_SA(b, h) + aoff + m * 2048 + k * 1024); } while (0)
#define PG8_LDB(dst, b, h) do { _Pragma("unroll") for (int n = 0; n < 2; ++n) _Pragma("unroll") for (int k = 0; k < 2; ++k) dst[n][k] = *(const LAS bf16x8*)(lds + PG8_SB(b, h) + boff + n * 2048 + k * 1024); } while (0)
#define PG8_MMA(ai, bj, At, Bt) do { __builtin_amdgcn_s_setprio(1); _Pragma("unroll") for (int m = 0; m < 4; ++m) _Pragma("unroll") for (int n = 0; n < 2; ++n) _Pragma("unroll") for (int k = 0; k < 2; ++k) \
        acc[ai][bj][m][n] = __builtin_amdgcn_mfma_f32_16x16x32_bf16(Bt[n][k], At[m][k], acc[ai][bj][m][n], 0, 0, 0); __builtin_amdgcn_s_setprio(0); } while (0)
#define PG8_WAIT_V(n) asm volatile("s_waitcnt vmcnt(" #n ")" ::: "memory")
#define PG8_WAIT_L(n) asm volatile("s_waitcnt lgkmcnt(" #n ")" ::: "memory")
#define PG8_BAR __builtin_amdgcn_s_barrier()
#define PG8_SCHED __builtin_amdgcn_sched_barrier(0)
    typename P::Unit cur, nxt; int ui = 0;
    if (!S.next(0, cur)) return;
    f32x4 acc[2][2][4][2];
#pragma unroll
    for (int a = 0; a < 2; ++a)
#pragma unroll
        for (int b = 0; b < 2; ++b)
#pragma unroll
            for (int m = 0; m < 4; ++m)
#pragma unroll
                for (int n = 0; n < 2; ++n) acc[a][b][m][n] = (f32x4){0.f, 0.f, 0.f, 0.f};
    bf16x8 At[4][2], B0[2][2], B1[2][2];
    unsigned vA[4];
    S.a_ready(cur);
    S.avoff(cur, RA, CA, vA);
    const char* cA = S.abase(cur);
    {
        const char* b0 = S.btile(cur, 0); const char* b1 = S.btile(cur, 1);
        PG8_STAGE(PG8_SB(0, 0), b0, voffB); PG8_STAGE(PG8_SB(0, 1), b0 + hstepB, voffB); PG8_STAGE(PG8_SA(0, 0), cA, vA); PG8_STAGE(PG8_SA(0, 1), cA, vA + 2);
        if (wr == 1) PG8_BAR;
        PG8_WAIT_V(2); PG8_BAR;
        PG8_STAGE(PG8_SB(1, 0), b1, voffB); PG8_STAGE(PG8_SA(1, 0), cA + kstep, vA); PG8_STAGE(PG8_SB(1, 1), b1 + hstepB, voffB);
        PG8_WAIT_V(6); PG8_BAR;
    }
    for (;;) {
        const bool has_next = S.next(ui + 1, nxt);
        for (int t = 0; t < nt; t += 2) {
            const bool last = (t == nt - 2);
            const char* a1 = cA + (size_t)(t + 1) * kstep;
            S.khook(t, acc, cur, lds, wr, wc, fr, fq);
            PG8_LDB(B0, 0, 0); PG8_LDB(B1, 0, 1); PG8_SCHED; PG8_LDA(At, 0, 0); PG8_STAGE(PG8_SA(1, 1), a1, vA + 2);
            PG8_WAIT_V(8); PG8_WAIT_L(0); PG8_BAR; PG8_MMA(0, 0, At, B0); PG8_MMA(0, 1, At, B1); PG8_BAR; PG8_SCHED;
            const bool sw = last && has_next;
            if (sw) { S.a_ready(nxt); S.avoff(nxt, RA, CA, vA); }
            const char* a2 = last ? (sw ? S.abase(nxt) : cA) : cA + (size_t)(t + 2) * kstep;
            const char* b2 = last ? (sw ? S.btile(nxt, 0) : S.btile(cur, 0)) : S.btile(cur, t + 2);
            const char* b3 = last ? (sw ? S.btile(nxt, 1) : S.btile(cur, 1)) : S.btile(cur, t + 3);
            const char* a3 = a2 + kstep;
            PG8_LDA(At, 0, 1); PG8_STAGE(PG8_SB(0, 0), b2, voffB); PG8_STAGE(PG8_SB(0, 1), b2 + hstepB, voffB); PG8_STAGE(PG8_SA(0, 0), a2, vA);
            PG8_WAIT_V(8); PG8_WAIT_L(0); PG8_BAR; PG8_MMA(1, 0, At, B0); PG8_MMA(1, 1, At, B1); PG8_BAR; PG8_SCHED;
            PG8_LDB(B0, 1, 0); PG8_LDB(B1, 1, 1); PG8_SCHED; PG8_LDA(At, 1, 0); PG8_STAGE(PG8_SA(0, 1), a2, vA + 2);
            PG8_WAIT_V(8); PG8_WAIT_L(0); PG8_BAR; PG8_MMA(0, 0, At, B0); PG8_MMA(0, 1, At, B1); PG8_BAR; PG8_SCHED;
            PG8_LDA(At, 1, 1); PG8_STAGE(PG8_SB(1, 0), b3, voffB); PG8_STAGE(PG8_SB(1, 1), b3 + hstepB, voffB); PG8_STAGE(PG8_SA(1, 0), a3, vA);
            PG8_WAIT_V(8); PG8_WAIT_L(0); PG8_BAR; PG8_MMA(1, 0, At, B0); PG8_MMA(1, 1, At, B1); PG8_BAR; PG8_SCHED;
        }
        if constexpr (ALIGN_EPI) { if (wr == 0) PG8_BAR; }
        S.epi(acc, cur, wr, wc, fr, fq);
        S.done(cur);
        if (!has_next) break;
#pragma unroll
        for (int a = 0; a < 2; ++a)
#pragma unroll
            for (int b = 0; b < 2; ++b)
#pragma unroll
                for (int m = 0; m < 4; ++m)
#pragma unroll
                    for (int n = 0; n < 2; ++n) acc[a][b][m][n] = (f32x4){0.f, 0.f, 0.f, 0.f};
        cur = nxt; cA = S.abase(cur); ++ui;
        if constexpr (ALIGN_EPI) { if (wr == 1) PG8_BAR; }
    }
    PG8_WAIT_V(0);
    if constexpr (!ALIGN_EPI) { if (wr == 0) PG8_BAR; }
    PG8_BAR;
#undef PG8_SA
#undef PG8_SB
#undef PG8_STAGE
#undef PG8_LDA
#undef PG8_LDB
#undef PG8_MMA
#undef PG8_WAIT_V
#undef PG8_WAIT_L
#undef PG8_BAR
#undef PG8_SCHED
}
}

struct PGemm1 {
    static constexpr bool PERM = true;
    struct Unit { int pm, pn; };
    const char* A; const char* B; const char* Bdt; bf16* O; const float* rstd; float* DT; const float* dtb; int G, c; int ldb, nt;
    __device__ __forceinline__ bool next(int i, Unit& u) const { return pg8::static_order(65, 19, G, c, i, u.pm, u.pn); }
    __device__ __forceinline__ void avoff(const Unit& u, const int (&RA)[2], const int (&CA)[2], unsigned (&v)[4]) const {
#pragma unroll
        for (int h = 0; h < 2; ++h)
#pragma unroll
            for (int i = 0; i < 2; ++i) { int row = u.pm * 256 + h * 128 + RA[i]; row = row < T ? row : T - 1; v[h * 2 + i] = (unsigned)(row * D + CA[i]) * 2u; }
    }
    __device__ __forceinline__ const char* abase(const Unit&) const { return A; }
    __device__ __forceinline__ const char* btile(const Unit& u, int t) const { return (u.pn < 18 ? B + (size_t)u.pn * 256 * 1024 * 2 : Bdt) + (size_t)t * 64 * 2; }
    __device__ __forceinline__ void khook(int, pg8::Acc&, const Unit&, LAS unsigned char*, int, int, int, int) const {}
    __device__ __forceinline__ void a_ready(const Unit&) const {}
    __device__ __forceinline__ void done(const Unit&) const {}
    __device__ __forceinline__ void epi(const pg8::Acc& acc, const Unit& u, int wr, int wc, int fr, int fq) const {
        const int row0 = u.pm * 256 + wr * 64 + fr, col0 = u.pn * 256 + wc * 32 + 8 * fq;
        float rsv[2][4];
#pragma unroll
        for (int ai = 0; ai < 2; ++ai)
#pragma unroll
            for (int m = 0; m < 4; ++m) { const int row = row0 + ai * 128 + m * 16; rsv[ai][m] = rstd[row < T ? row : T - 1]; }
        if (u.pn == 18) {
            if (wc == 0 && fq < 2) { const f32x4 b0 = *(const f32x4*)(dtb + 8 * fq), b1 = *(const f32x4*)(dtb + 8 * fq + 4);
#pragma unroll
                for (int ai = 0; ai < 2; ++ai)
#pragma unroll
                    for (int m = 0; m < 4; ++m) { const int row = row0 + ai * 128 + m * 16;
                        if (row < T) { const float rs = rsv[ai][m]; f32x4 d0 = acc[ai][0][m][0] * rs + b0, d1 = acc[ai][0][m][1] * rs + b1;
#pragma unroll
                            for (int j = 0; j < 4; ++j) { d0[j] = softplus_f(d0[j]); d1[j] = softplus_f(d1[j]); }
                            *(f32x4*)(DT + (size_t)row * 16 + 8 * fq) = d0; *(f32x4*)(DT + (size_t)row * 16 + 8 * fq + 4) = d1; } } }
            return; }
#pragma unroll
        for (int ai = 0; ai < 2; ++ai)
#pragma unroll
            for (int m = 0; m < 4; ++m) { const int row = row0 + ai * 128 + m * 16;
                if (row < T) { const float rs = rsv[ai][m]; bf16* rowp = O + (size_t)row * LDP + col0;
#pragma unroll
                    for (int bj = 0; bj < 2; ++bj) { const f32x4 v0 = acc[ai][bj][m][0] * rs, v1 = acc[ai][bj][m][1] * rs;
                        v4u w; w.x = pg8::cvt_pk_bf16(v0[0], v0[1]); w.y = pg8::cvt_pk_bf16(v0[2], v0[3]); w.z = pg8::cvt_pk_bf16(v1[0], v1[1]); w.w = pg8::cvt_pk_bf16(v1[2], v1[3]);
                        *(v4u*)(rowp + bj * 128) = w; } } }
    }
};
__device__ __forceinline__ void ph_gemm1_pg8(const Args& a, LAS unsigned char* lds, int G) {
    PGemm1 S; S.A = (const char*)a.out; S.B = (const char*)(a.ws + WS_WIN); S.O = (bf16*)(a.ws + WS_PROJ); S.rstd = (const float*)(a.ws + WS_RSTD0); S.Bdt = (const char*)(a.ws + WS_WDTT); S.DT = (float*)(a.ws + WS_DT); S.dtb = a.in[I_DTB];
    S.G = G; S.c = (int)blockIdx.x; S.ldb = 1024; S.nt = 16;
    pg8::gemm_phase<PGemm1, true>(lds, S);
}

__device__ __forceinline__ void ssd_item(const Args& a, LAS unsigned char* lds, int b, int h) {
    const int tid = threadIdx.x, lane = tid & 63;
    constexpr int TB = 64;
    LAS float* xs = (LAS float*)lds;
    LAS float* Bs = xs + TB * 64;
    LAS float* Cs = Bs + TB * 128;
    LAS float* ys = Cs + TB * 128;
    LAS float* dts = ys + TB * 64;
    LAS float* decs = dts + TB;
    bf16* PROJ = (bf16*)(a.ws + WS_PROJ); const float* DT = (const float*)(a.ws + WS_DT); float* SSDSQ = (float*)(a.ws + WS_SSDSQ);
    const int g = h >> 3;
    const float Ah = -__expf(a.in[I_ALOG][h]), Dh = a.in[I_SD][h];
    int ccol = 0, cch = 0; float cw0 = 0.f, cw1 = 0.f, cw2 = 0.f, cw3 = 0.f, cb = 0.f;
    if (tid < 320) {
        if (tid < 64) { ccol = C_X + h * 64 + tid; cch = h * 64 + tid; }
        else if (tid < 192) { ccol = C_B + g * 128 + (tid - 64); cch = 1024 + g * 128 + (tid - 64); }
        else { ccol = C_C + g * 128 + (tid - 192); cch = 1280 + g * 128 + (tid - 192); }
        const float* cw = a.in[I_SCW]; cw0 = cw[cch]; cw1 = cw[1536 + cch]; cw2 = cw[2 * 1536 + cch]; cw3 = cw[3 * 1536 + cch]; cb = a.in[I_SCB][cch];
    }
    const int p = tid >> 3, nq = tid & 7;
    float S[16];
#pragma unroll
    for (int i = 0; i < 16; ++i) S[i] = 0.f;
    const size_t rbase = (size_t)b * LSEQ;
    for (int l0 = 0; l0 < LSEQ; l0 += TB) {
        const int nt = (LSEQ - l0) < TB ? (LSEQ - l0) : TB;
        __syncthreads();
        if (tid < 320) {
            float r0 = l0 >= 3 ? bf2f(PROJ[(rbase + l0 - 3) * LDP + ccol]) : 0.f, r1 = l0 >= 2 ? bf2f(PROJ[(rbase + l0 - 2) * LDP + ccol]) : 0.f, r2 = l0 >= 1 ? bf2f(PROJ[(rbase + l0 - 1) * LDP + ccol]) : 0.f;
            for (int t = 0; t < nt; ++t) {
                const float r3 = bf2f(PROJ[(rbase + l0 + t) * LDP + ccol]);
                const float v = silu_f(cw0 * r0 + cw1 * r1 + cw2 * r2 + cw3 * r3 + cb);
                if (tid < 64) xs[t * 64 + tid] = v; else if (tid < 192) Bs[t * 128 + tid - 64] = v; else Cs[t * 128 + tid - 192] = v;
                r0 = r1; r1 = r2; r2 = r3;
            }
        } else if (tid < 320 + TB) {
            const int t = tid - 320;
            if (t < nt) { const float dt = DT[(rbase + l0 + t) * 16 + h]; dts[t] = dt; decs[t] = __expf(Ah * dt); }
        }
        __syncthreads();
        for (int t = 0; t < nt; ++t) {
            const float xv = xs[t * 64 + p], xdt = xv * dts[t], dec = decs[t];
            float yp = 0.f;
#pragma unroll
            for (int i = 0; i < 16; ++i) { S[i] = dec * S[i] + Bs[t * 128 + nq * 16 + i] * xdt; yp += Cs[t * 128 + nq * 16 + i] * S[i]; }
            yp += __shfl_xor(yp, 1); yp += __shfl_xor(yp, 2); yp += __shfl_xor(yp, 4);
            if (nq == 0) ys[t * 64 + p] = yp + Dh * xv;
        }
        __syncthreads();
        for (int t = tid >> 6; t < nt; t += 8) {
            const size_t row = rbase + l0 + t;
            const float z = bf2f(PROJ[row * LDP + C_Z + h * 64 + lane]);
            const float yg = ys[t * 64 + lane] * silu_f(z);
            PROJ[row * LDP + C_Z + h * 64 + lane] = (bf16)f2bf(yg);
            const float sq = wave_sum(yg * yg);
            if (lane == 0) SSDSQ[row * 16 + h] = sq;
        }
    }
    __syncthreads();
}
__device__ __forceinline__ void lru_item(const Args& a, LAS unsigned char* lds, int b, int h) {
    const int tid = threadIdx.x;
    constexpr int TB = 64;
    LAS float* Wa = (LAS float*)lds;
    LAS float* Wx = Wa + 4096;
    LAS float* xb = Wx + 4096;
    LAS float* as = xb + TB * 64;
    LAS float* us = as + TB * 64;
    bf16* PROJ = (bf16*)(a.ws + WS_PROJ);
    __syncthreads();
    for (int i = tid; i < 4096; i += 512) { Wa[i] = a.in[I_LWA][(size_t)h * 4096 + i]; Wx[i] = a.in[I_LWX][(size_t)h * 4096 + i]; }
    const size_t rbase = (size_t)b * LSEQ;
    float hprev = 0.f;
    const int c = tid & 63, tq = tid >> 6;
    const float* cw = a.in[I_LCW]; const int ch = h * 64 + c;
    const float cw0 = cw[ch], cw1 = cw[1024 + ch], cw2 = cw[2048 + ch], cw3 = cw[3072 + ch], cb = a.in[I_LCB][ch];
    const int gt = tid >> 3, jq = tid & 7;
    for (int l0 = 0; l0 < LSEQ; l0 += TB) {
        const int nt = (LSEQ - l0) < TB ? (LSEQ - l0) : TB;
        __syncthreads();
        for (int t = tq * 8; t < tq * 8 + 8; ++t) if (t < nt) {
            const int l = l0 + t; const size_t row = rbase + l;
            const float r3 = bf2f(PROJ[row * LDP + C_LI + ch]);
            const float r2 = l >= 1 ? bf2f(PROJ[(row - 1) * LDP + C_LI + ch]) : 0.f;
            const float r1 = l >= 2 ? bf2f(PROJ[(row - 2) * LDP + C_LI + ch]) : 0.f;
            const float r0 = l >= 3 ? bf2f(PROJ[(row - 3) * LDP + C_LI + ch]) : 0.f;
            xb[t * 64 + c] = cw0 * r0 + cw1 * r1 + cw2 * r2 + cw3 * r3 + cb;
        }
        __syncthreads();
        if (gt < nt) {
            float ra[8], ri[8];
#pragma unroll
            for (int j = 0; j < 8; ++j) { ra[j] = 0.f; ri[j] = 0.f; }
            for (int i = 0; i < 64; ++i) { const float xv = xb[gt * 64 + i];
#pragma unroll
                for (int j = 0; j < 8; ++j) { ra[j] += xv * Wa[i * 64 + jq * 8 + j]; ri[j] += xv * Wx[i * 64 + jq * 8 + j]; } }
#pragma unroll
            for (int j = 0; j < 8; ++j) { const int cc = h * 64 + jq * 8 + j;
                const float r = sigmoid_f(ra[j] + a.in[I_LBA][cc]), ig = sigmoid_f(ri[j] + a.in[I_LBX][cc]);
                const float log_a = -8.0f * r * softplus_f(-a.in[I_LLAM][cc]);
                const float av = __expf(log_a);
                const float mult = (l0 + gt == 0) ? 1.f : sqrtf(fmaxf(-expm1f(2.f * log_a), 0.f));
                as[gt * 64 + jq * 8 + j] = av; us[gt * 64 + jq * 8 + j] = mult * ig * xb[gt * 64 + jq * 8 + j]; }
        }
        __syncthreads();
        if (tid < 64) { for (int t = 0; t < nt; ++t) { hprev = as[t * 64 + tid] * hprev + us[t * 64 + tid]; us[t * 64 + tid] = hprev; } }
        __syncthreads();
        for (int t = tq * 8; t < tq * 8 + 8; ++t) if (t < nt) {
            const size_t row = rbase + l0 + t;
            const float gv = bf2f(PROJ[row * LDP + C_G + ch]);
            PROJ[row * LDP + C_G + ch] = (bf16)f2bf(us[t * 64 + c] * gelu_tanh_f(gv));
        }
    }
    __syncthreads();
}
__device__ __forceinline__ void ph_mixers(const Args& a, LAS unsigned char* lds, int wk, int nwk) {
    for (int it = wk; it < 256; it += nwk) {
        if (it < 128) ssd_item(a, lds, it >> 4, it & 15); else lru_item(a, lds, (it - 128) >> 4, (it - 128) & 15);
    }
}


__device__ __forceinline__ f32x4 mfma16(bf16x8 a, bf16x8 b, f32x4 c) { return __builtin_amdgcn_mfma_f32_16x16x32_bf16(a, b, c, 0, 0, 0); }
constexpr int RSX = 144, RSB = 272;
constexpr int SO_X = 0, SO_B = SO_X + 128 * RSX, SO_C = SO_B + 128 * RSB, SO_M = SO_C + 128 * RSB, SO_S = SO_M + 128 * RSB, SO_V = SO_S + 64 * RSB;
static_assert(SO_V + 4096 <= LDS_BYTES - 256, "ssd lds");
#define TR4(RS4, o0, o1, o2, o3, addr) do { v2u l0_, h0_, l1_, h1_, l2_, h2_, l3_, h3_; \
    asm volatile("ds_read_b64_tr_b16 %0, %8\n\tds_read_b64_tr_b16 %1, %8 offset:" #RS4 "\n\t" \
                 "ds_read_b64_tr_b16 %2, %8 offset:32\n\tds_read_b64_tr_b16 %3, %8 offset:" #RS4 "+32\n\t" \
                 "ds_read_b64_tr_b16 %4, %8 offset:64\n\tds_read_b64_tr_b16 %5, %8 offset:" #RS4 "+64\n\t" \
                 "ds_read_b64_tr_b16 %6, %8 offset:96\n\tds_read_b64_tr_b16 %7, %8 offset:" #RS4 "+96\n\ts_waitcnt lgkmcnt(0)" \
                 : "=&v"(l0_), "=&v"(h0_), "=&v"(l1_), "=&v"(h1_), "=&v"(l2_), "=&v"(h2_), "=&v"(l3_), "=&v"(h3_) : "v"(addr) : "memory"); \
    o0 = __builtin_bit_cast(bf16x8, (v4u){l0_.x, l0_.y, h0_.x, h0_.y}); o1 = __builtin_bit_cast(bf16x8, (v4u){l1_.x, l1_.y, h1_.x, h1_.y}); \
    o2 = __builtin_bit_cast(bf16x8, (v4u){l2_.x, l2_.y, h2_.x, h2_.y}); o3 = __builtin_bit_cast(bf16x8, (v4u){l3_.x, l3_.y, h3_.x, h3_.y}); } while (0)
#define TR1(RS4, o0, addr) do { v2u l0_, h0_; \
    asm volatile("ds_read_b64_tr_b16 %0, %2\n\tds_read_b64_tr_b16 %1, %2 offset:" #RS4 "\n\ts_waitcnt lgkmcnt(0)" : "=&v"(l0_), "=&v"(h0_) : "v"(addr) : "memory"); \
    o0 = __builtin_bit_cast(bf16x8, (v4u){l0_.x, l0_.y, h0_.x, h0_.y}); } while (0)
__device__ __forceinline__ void unpack8(const v4u r, float (&f)[8]) {
    f[0] = __uint_as_float(r.x << 16); f[1] = __uint_as_float(r.x & 0xffff0000u); f[2] = __uint_as_float(r.y << 16); f[3] = __uint_as_float(r.y & 0xffff0000u);
    f[4] = __uint_as_float(r.z << 16); f[5] = __uint_as_float(r.z & 0xffff0000u); f[6] = __uint_as_float(r.w << 16); f[7] = __uint_as_float(r.w & 0xffff0000u);
}
__device__ __forceinline__ void ph_conv(const Args& a, int wk, int nwk) {
    const bf16* PROJ = (const bf16*)(a.ws + WS_PROJ); bf16* XACT = (bf16*)(a.ws + WS_H); bf16* XLRU = (bf16*)a.out;
    for (int id = wk * 512 + (int)threadIdx.x; id < NB * 48 * 320; id += nwk * 512) {
        const int cg = id % 320, rr = id / 320, b = rr / 48, t0 = (rr % 48) * 43;
        const bool ssd = cg < 192; const int ch = ssd ? cg * 8 : (cg - 192) * 8;
        const float* cwp = ssd ? a.in[I_SCW] + ch : a.in[I_LCW] + ch; const int cst = ssd ? 1536 : 1024;
        float cw[4][8], cb[8];
#pragma unroll
        for (int k = 0; k < 4; ++k) { const f32x4 wa = *(const f32x4*)(cwp + k * cst), wb = *(const f32x4*)(cwp + k * cst + 4);
#pragma unroll
            for (int j = 0; j < 4; ++j) { cw[k][j] = wa[j]; cw[k][4 + j] = wb[j]; } }
        { const float* cbp = ssd ? a.in[I_SCB] + ch : a.in[I_LCB] + ch; const f32x4 wa = *(const f32x4*)cbp, wb = *(const f32x4*)(cbp + 4);
#pragma unroll
          for (int j = 0; j < 4; ++j) { cb[j] = wa[j]; cb[4 + j] = wb[j]; } }
        const size_t rb = (size_t)b * LSEQ;
        const bf16* src = PROJ + rb * LDP + 2048 + cg * 8;
        bf16* dst = ssd ? XACT + rb * 1536 + ch : XLRU + rb * 1024 + ch; const int dst_ld = ssd ? 1536 : 1024;
        float p0[8], p1[8], p2[8];
        {   v4u q0 = (v4u){0u, 0u, 0u, 0u}, q1 = q0, q2 = q0;
            if (t0 >= 3) { q0 = *(const v4u*)(src + (size_t)(t0 - 3) * LDP); q1 = *(const v4u*)(src + (size_t)(t0 - 2) * LDP); q2 = *(const v4u*)(src + (size_t)(t0 - 1) * LDP); }
            unpack8(q0, p0); unpack8(q1, p1); unpack8(q2, p2); }
#pragma unroll 4
        for (int t = 0; t < 43; ++t) {
            const int l = t0 + t; float p3[8]; unpack8(*(const v4u*)(src + (size_t)l * LDP), p3);
            float o[8];
#pragma unroll
            for (int j = 0; j < 8; ++j) { const float v = cw[0][j] * p0[j] + cw[1][j] * p1[j] + cw[2][j] * p2[j] + cw[3][j] * p3[j] + cb[j]; o[j] = ssd ? silu_f(v) : v; p0[j] = p1[j]; p1[j] = p2[j]; p2[j] = p3[j]; }
            v4u ov; ov.x = pk2(o[0], o[1]); ov.y = pk2(o[2], o[3]); ov.z = pk2(o[4], o[5]); ov.w = pk2(o[6], o[7]);
            *(v4u*)(dst + (size_t)l * dst_ld) = ov;
        }
    }
}
__device__ __forceinline__ void ssd_item3(const Args& a, LAS unsigned char* lds, int b, int h) {
    const int tid = threadIdx.x, lane = tid & 63, w = __builtin_amdgcn_readfirstlane(tid >> 6), fr = lane & 15, fq = lane >> 4;
    bf16* PROJ = (bf16*)(a.ws + WS_PROJ); const bf16* XACT = (const bf16*)(a.ws + WS_H); const float* DT = (const float*)(a.ws + WS_DT); float* SSDSQ = (float*)(a.ws + WS_SSDSQ);
    const int g = h >> 3;
    const float Ah = -__expf(a.in[I_ALOG][h]), Dh = a.in[I_SD][h];
    LAS float* acs = (LAS float*)(lds + SO_V); LAS float* dtv = acs + 128; LAS float* wv = acs + 256; LAS float* eacs = acs + 384;
    const size_t rbase = (size_t)b * LSEQ;
    const int pt_s = w & 3, nh = w >> 2;
    f32x4 sacc[4];
#pragma unroll
    for (int i = 0; i < 4; ++i) sacc[i] = (f32x4){0.f, 0.f, 0.f, 0.f};
    __syncthreads();
    for (int i = tid; i < 64 * RSB / 4; i += 512) ((LAS unsigned*)(lds + SO_S))[i] = 0u;
    v4u pf[10], zp[2]; float d0 = 0.f, d1 = 0.f;
    const int ft = tid >> 2, q4 = tid & 3;
    const int xr_ = tid >> 3, xp_ = tid & 7, br_ = tid >> 4, bp_ = tid & 15;
    const bf16* xsrc = XACT + (rbase + xr_) * 1536 + h * 64 + xp_ * 8;
    const bf16* bsrc = XACT + (rbase + br_) * 1536 + 1024 + g * 128 + bp_ * 8;
#define SSD_PREFETCH(L0) do { const int l0_ = (L0); \
        _Pragma("unroll") for (int i = 0; i < 2; ++i) { pf[i] = (v4u){0u, 0u, 0u, 0u}; if (l0_ + xr_ + 64 * i < LSEQ) pf[i] = *(const v4u*)(xsrc + (size_t)(l0_ + 64 * i) * 1536); } \
        _Pragma("unroll") for (int i = 0; i < 4; ++i) { pf[2 + i] = (v4u){0u, 0u, 0u, 0u}; pf[6 + i] = (v4u){0u, 0u, 0u, 0u}; \
            if (l0_ + br_ + 32 * i < LSEQ) { pf[2 + i] = *(const v4u*)(bsrc + (size_t)(l0_ + 32 * i) * 1536); pf[6 + i] = *(const v4u*)(bsrc + (size_t)(l0_ + 32 * i) * 1536 + 256); } } \
        zp[0] = (v4u){0u, 0u, 0u, 0u}; zp[1] = zp[0]; \
        if (l0_ + ft < LSEQ) { const bf16* zq = PROJ + (rbase + l0_ + ft) * LDP + C_Z + h * 64 + 16 * q4; zp[0] = *(const v4u*)zq; zp[1] = *(const v4u*)(zq + 8); } \
        if (w == 0) { d0 = (l0_ + lane) < LSEQ ? DT[(rbase + l0_ + lane) * 16 + h] : 0.f; d1 = (l0_ + lane + 64) < LSEQ ? DT[(rbase + l0_ + lane + 64) * 16 + h] : 0.f; } } while (0)
    SSD_PREFETCH(0);
    for (int l0 = 0; l0 < LSEQ; l0 += 128) {
        const int nvalid = (LSEQ - l0) < 128 ? (LSEQ - l0) : 128;
#pragma unroll
        for (int i = 0; i < 2; ++i) *(LAS v4u*)(lds + SO_X + (xr_ + 64 * i) * RSX + xp_ * 16) = pf[i];
#pragma unroll
        for (int i = 0; i < 4; ++i) { *(LAS v4u*)(lds + SO_B + (br_ + 32 * i) * RSB + bp_ * 16) = pf[2 + i]; *(LAS v4u*)(lds + SO_C + (br_ + 32 * i) * RSB + bp_ * 16) = pf[6 + i]; }
        const v4u z0 = zp[0], z1 = zp[1];
        if (w == 0) {
            float a0 = Ah * d0, a1 = Ah * d1;
#pragma unroll
            for (int o = 1; o < 64; o <<= 1) { const float v0 = __shfl_up(a0, o), v1 = __shfl_up(a1, o); if (lane >= o) { a0 += v0; a1 += v1; } }
            a1 += __shfl(a0, 63);
            const float aend = __shfl(a1, 63);
            acs[lane] = a0; acs[lane + 64] = a1; dtv[lane] = d0; dtv[lane + 64] = d1;
            wv[lane] = __expf(aend - a0) * d0; wv[lane + 64] = __expf(aend - a1) * d1; eacs[lane] = __expf(a0); eacs[lane + 64] = __expf(a1);
            if (lane == 0) acs[512] = aend;
        }
        __syncthreads();
        if (l0 + 128 < LSEQ) SSD_PREFETCH(l0 + 128);
        for (int hh = 0; hh < 2; ++hh) {
            f32x4 gacc[4];
#pragma unroll
            for (int st = 0; st < 4; ++st) gacc[st] = (f32x4){0.f, 0.f, 0.f, 0.f};
#pragma unroll
            for (int k0 = 0; k0 < 128; k0 += 32) {
                const bf16x8 cf = *(const LAS bf16x8*)(lds + SO_C + (16 * w + fr) * RSB + (k0 + 8 * fq) * 2);
#pragma unroll
                for (int st = 0; st < 4; ++st) { const bf16x8 bf = *(const LAS bf16x8*)(lds + SO_B + (16 * (4 * hh + st) + fr) * RSB + (k0 + 8 * fq) * 2); gacc[st] = mfma16(bf, cf, gacc[st]); }
            }
            const int l = 16 * w + fr; const float al = acs[l];
#pragma unroll
            for (int st = 0; st < 4; ++st) {
                const int s0 = 16 * (4 * hh + st) + 4 * fq; const f32x4 as = *(const LAS f32x4*)(acs + s0), ds = *(const LAS f32x4*)(dtv + s0);
                float m[4];
#pragma unroll
                for (int j = 0; j < 4; ++j) m[j] = (s0 + j <= l) ? gacc[st][j] * __expf(al - as[j]) * ds[j] : 0.f;
                v2u mv; mv.x = pk2(m[0], m[1]); mv.y = pk2(m[2], m[3]);
                *(LAS v2u*)(lds + SO_M + l * RSB + s0 * 2) = mv;
            }
        }
        __syncthreads();
        {
            f32x4 y[4];
#pragma unroll
            for (int pt = 0; pt < 4; ++pt) y[pt] = (f32x4){0.f, 0.f, 0.f, 0.f};
#pragma unroll
            for (int k0 = 0; k0 < 128; k0 += 32) {
                const bf16x8 cf = *(const LAS bf16x8*)(lds + SO_C + (16 * w + fr) * RSB + (k0 + 8 * fq) * 2);
#pragma unroll
                for (int pt = 0; pt < 4; ++pt) { const bf16x8 sf = *(const LAS bf16x8*)(lds + SO_S + (16 * pt + fr) * RSB + (k0 + 8 * fq) * 2); y[pt] = mfma16(cf, sf, y[pt]); }
                __builtin_amdgcn_sched_barrier(0);
            }
            const f32x4 ea = *(const LAS f32x4*)(eacs + 16 * w + 4 * fq);
#pragma unroll
            for (int pt = 0; pt < 4; ++pt) y[pt] *= ea;
            for (int k0 = 0; k0 <= 16 * w + 15; k0 += 32) {
                const bf16x8 mf = *(const LAS bf16x8*)(lds + SO_M + (16 * w + fr) * RSB + (k0 + 8 * fq) * 2);
                const unsigned xa = (unsigned)(size_t)(lds + SO_X) + (unsigned)((k0 + 8 * fq + (fr >> 2)) * RSX + (fr & 3) * 8);
                bf16x8 x0, x1, x2, x3; TR4(576, x0, x1, x2, x3, xa);
                y[0] = mfma16(mf, x0, y[0]); y[1] = mfma16(mf, x1, y[1]); y[2] = mfma16(mf, x2, y[2]); y[3] = mfma16(mf, x3, y[3]);
                __builtin_amdgcn_sched_barrier(0);
            }
#pragma unroll
            for (int pt = 0; pt < 4; ++pt)
#pragma unroll
                for (int r = 0; r < 4; ++r) *(LAS float*)(lds + SO_M + (16 * w + 4 * fq + r) * RSB + (16 * pt + fr) * 4) = y[pt][r];
        }
        {
            const float dec = __expf(acs[512]);
#pragma unroll
            for (int i = 0; i < 4; ++i) sacc[i] *= dec;
#pragma unroll
            for (int k0 = 0; k0 < 128; k0 += 32) {
                const unsigned xa = (unsigned)(size_t)(lds + SO_X) + (unsigned)((k0 + 8 * fq + (fr >> 2)) * RSX + pt_s * 32 + (fr & 3) * 8);
                bf16x8 xf; TR1(576, xf, xa);
                const f32x4 w0 = *(const LAS f32x4*)(wv + k0 + 8 * fq), w1 = *(const LAS f32x4*)(wv + k0 + 8 * fq + 4);
                float xv[8]; unpack8(__builtin_bit_cast(v4u, xf), xv);
                v4u xs; xs.x = pk2(xv[0] * w0[0], xv[1] * w0[1]); xs.y = pk2(xv[2] * w0[2], xv[3] * w0[3]); xs.z = pk2(xv[4] * w1[0], xv[5] * w1[1]); xs.w = pk2(xv[6] * w1[2], xv[7] * w1[3]);
                const bf16x8 xw = __builtin_bit_cast(bf16x8, xs);
                const unsigned ba = (unsigned)(size_t)(lds + SO_B) + (unsigned)((k0 + 8 * fq + (fr >> 2)) * RSB + nh * 128 + (fr & 3) * 8);
                bf16x8 b0, b1, b2, b3; TR4(1088, b0, b1, b2, b3, ba);
                sacc[0] = mfma16(xw, b0, sacc[0]); sacc[1] = mfma16(xw, b1, sacc[1]); sacc[2] = mfma16(xw, b2, sacc[2]); sacc[3] = mfma16(xw, b3, sacc[3]);
                __builtin_amdgcn_sched_barrier(0);
            }
        }
        __syncthreads();
#pragma unroll
        for (int i = 0; i < 4; ++i)
#pragma unroll
            for (int r = 0; r < 4; ++r) *(LAS bf16*)(lds + SO_S + (16 * pt_s + 4 * fq + r) * RSB + (16 * (4 * nh + i) + fr) * 2) = (bf16)f2bf(sacc[i][r]);
        if (ft < nvalid) {
            const size_t row = rbase + l0 + ft;
            bf16* zq = PROJ + row * LDP + C_Z + h * 64 + 16 * q4;
            const v4u x0 = *(const LAS v4u*)(lds + SO_X + ft * RSX + q4 * 32), x1 = *(const LAS v4u*)(lds + SO_X + ft * RSX + q4 * 32 + 16);
            float zf[16], xf[16], yo[16];
            { float tmp[8]; unpack8(z0, tmp);
#pragma unroll
              for (int j = 0; j < 8; ++j) zf[j] = tmp[j];
              unpack8(z1, tmp);
#pragma unroll
              for (int j = 0; j < 8; ++j) zf[8 + j] = tmp[j];
              unpack8(x0, tmp);
#pragma unroll
              for (int j = 0; j < 8; ++j) xf[j] = tmp[j];
              unpack8(x1, tmp);
#pragma unroll
              for (int j = 0; j < 8; ++j) xf[8 + j] = tmp[j]; }
            float sq = 0.f;
#pragma unroll
            for (int j4 = 0; j4 < 4; ++j4) { const f32x4 yv = *(const LAS f32x4*)(lds + SO_M + ft * RSB + (16 * q4 + 4 * j4) * 4);
#pragma unroll
                for (int j = 0; j < 4; ++j) { const float v = (yv[j] + Dh * xf[4 * j4 + j]) * silu_f(zf[4 * j4 + j]); yo[4 * j4 + j] = v; sq += v * v; } }
            v4u o0, o1; o0.x = pk2(yo[0], yo[1]); o0.y = pk2(yo[2], yo[3]); o0.z = pk2(yo[4], yo[5]); o0.w = pk2(yo[6], yo[7]);
            o1.x = pk2(yo[8], yo[9]); o1.y = pk2(yo[10], yo[11]); o1.z = pk2(yo[12], yo[13]); o1.w = pk2(yo[14], yo[15]);
            *(v4u*)zq = o0; *(v4u*)(zq + 8) = o1;
            sq += __shfl_xor(sq, 1); sq += __shfl_xor(sq, 2);
            if (q4 == 0) SSDSQ[row * 16 + h] = sq;
        }
        __syncthreads();
    }
#undef SSD_PREFETCH
}
constexpr int LO_XB = 0, LO_XF = LO_XB + 128 * RSX, LO_A = LO_XF + 128 * 260, LO_U = LO_A + 128 * 260, LO_WA = LO_U + 128 * 260, LO_WX = LO_WA + 64 * RSX, LO_SC = LO_WX + 64 * RSX;
static_assert(LO_SC + 17 * 256 <= LDS_BYTES - 256, "lru lds");
__device__ __forceinline__ void lru_item3(const Args& a, LAS unsigned char* lds, int b, int h) {
    const int tid = threadIdx.x, lane = tid & 63, w = __builtin_amdgcn_readfirstlane(tid >> 6), fr = lane & 15, fq = lane >> 4;
    bf16* PROJ = (bf16*)(a.ws + WS_PROJ); const bf16* XLRU = (const bf16*)a.out;
    const size_t rbase = (size_t)b * LSEQ;
    LAS float* segP = (LAS float*)(lds + LO_SC); LAS float* segH = segP + 512; LAS float* carry = segH + 512;
    __syncthreads();
    for (int i = tid; i < 4096; i += 512) { const int ii = i >> 6, j = i & 63;
        *(LAS bf16*)(lds + LO_WA + j * RSX + ii * 2) = (bf16)f2bf(a.in[I_LWA][(size_t)h * 4096 + i]);
        *(LAS bf16*)(lds + LO_WX + j * RSX + ii * 2) = (bf16)f2bf(a.in[I_LWX][(size_t)h * 4096 + i]); }
    if (tid < 64) carry[tid] = 0.f;
    float gba[4], gbx[4], gsp[4];
#pragma unroll
    for (int jt = 0; jt < 4; ++jt) { const int c = h * 64 + 16 * jt + fr; gba[jt] = a.in[I_LBA][c]; gbx[jt] = a.in[I_LBX][c]; gsp[jt] = softplus_f(-a.in[I_LLAM][c]); }
    const int ft = tid >> 2, q4 = tid & 3;
    v4u xp[2], gp[2];
#define LRU_PREFETCH(L0) do { const int l0_ = (L0); \
        _Pragma("unroll") for (int i = 0; i < 2; ++i) { const int q = tid + 512 * i, row = q >> 3, pc = q & 7; xp[i] = (v4u){0u, 0u, 0u, 0u}; \
            if (l0_ + row < LSEQ) xp[i] = *(const v4u*)(XLRU + (rbase + l0_ + row) * 1024 + h * 64 + pc * 8); } \
        gp[0] = (v4u){0u, 0u, 0u, 0u}; gp[1] = gp[0]; \
        if (l0_ + ft < LSEQ) { const bf16* gq = PROJ + (rbase + l0_ + ft) * LDP + C_G + h * 64 + 16 * q4; gp[0] = *(const v4u*)gq; gp[1] = *(const v4u*)(gq + 8); } } while (0)
    LRU_PREFETCH(0);
    for (int l0 = 0; l0 < LSEQ; l0 += 128) {
        const int nvalid = (LSEQ - l0) < 128 ? (LSEQ - l0) : 128;
#pragma unroll
        for (int i = 0; i < 2; ++i) { const int q = tid + 512 * i, row = q >> 3, pc = q & 7;
            *(LAS v4u*)(lds + LO_XB + row * RSX + pc * 16) = xp[i];
            float xv[8]; unpack8(xp[i], xv);
#pragma unroll
            for (int j = 0; j < 8; ++j) *(LAS float*)(lds + LO_XF + row * 260 + (pc * 8 + j) * 4) = xv[j]; }
        const v4u g0 = gp[0], g1 = gp[1];
        __syncthreads();
        if (l0 + 128 < LSEQ) LRU_PREFETCH(l0 + 128);
        {
            f32x4 ga[4], gx[4];
#pragma unroll
            for (int jt = 0; jt < 4; ++jt) { ga[jt] = (f32x4){0.f, 0.f, 0.f, 0.f}; gx[jt] = ga[jt]; }
#pragma unroll
            for (int k0 = 0; k0 < 64; k0 += 32) {
                const bf16x8 xf = *(const LAS bf16x8*)(lds + LO_XB + (16 * w + fr) * RSX + (k0 + 8 * fq) * 2);
#pragma unroll
                for (int jt = 0; jt < 4; ++jt) {
                    const bf16x8 wa = *(const LAS bf16x8*)(lds + LO_WA + (16 * jt + fr) * RSX + (k0 + 8 * fq) * 2), wx = *(const LAS bf16x8*)(lds + LO_WX + (16 * jt + fr) * RSX + (k0 + 8 * fq) * 2);
                    ga[jt] = mfma16(xf, wa, ga[jt]); gx[jt] = mfma16(xf, wx, gx[jt]); }
            }
#pragma unroll
            for (int jt = 0; jt < 4; ++jt)
#pragma unroll
                for (int r = 0; r < 4; ++r) { const int l = 16 * w + 4 * fq + r, j = 16 * jt + fr;
                    const float rr = sigmoid_f(ga[jt][r] + gba[jt]), ig = sigmoid_f(gx[jt][r] + gbx[jt]);
                    const float log_a = -8.0f * rr * gsp[jt];
                    const float av = __expf(log_a);
                    const float t2 = 2.f * log_a;
                    const float om = t2 > -0.1f ? -t2 * (1.f + t2 * (0.5f + t2 * (0.16666667f + t2 * 0.041666668f))) : 1.f - av * av;
                    const float mult = (l0 + l == 0) ? 1.f : __builtin_amdgcn_sqrtf(fmaxf(om, 0.f));
                    const float xv = *(const LAS float*)(lds + LO_XF + l * 260 + j * 4);
                    *(LAS float*)(lds + LO_A + l * 260 + j * 4) = av; *(LAS float*)(lds + LO_U + l * 260 + j * 4) = mult * ig * xv; }
        }
        __syncthreads();
        {
            float P = 1.f, Hl = 0.f;
#pragma unroll
            for (int t = 0; t < 16; ++t) { const float av = *(const LAS float*)(lds + LO_A + (16 * w + t) * 260 + lane * 4), uv = *(const LAS float*)(lds + LO_U + (16 * w + t) * 260 + lane * 4); Hl = av * Hl + uv; P *= av; }
            segP[w * 64 + lane] = P; segH[w * 64 + lane] = Hl;
            __syncthreads();
            float hin = carry[lane];
            for (int s2 = 0; s2 < w; ++s2) hin = segP[s2 * 64 + lane] * hin + segH[s2 * 64 + lane];
#pragma unroll
            for (int t = 0; t < 16; ++t) { LAS float* up = (LAS float*)(lds + LO_U + (16 * w + t) * 260 + lane * 4); hin = *(const LAS float*)(lds + LO_A + (16 * w + t) * 260 + lane * 4) * hin + *up; *up = hin; }
            __syncthreads();
            if (w == 7) carry[lane] = hin;
        }
        if (ft < nvalid) {
            const size_t row = rbase + l0 + ft;
            bf16* gq = PROJ + row * LDP + C_G + h * 64 + 16 * q4;
            float gf[16], yo[16];
            { float tmp[8]; unpack8(g0, tmp);
#pragma unroll
              for (int j = 0; j < 8; ++j) gf[j] = tmp[j];
              unpack8(g1, tmp);
#pragma unroll
              for (int j = 0; j < 8; ++j) gf[8 + j] = tmp[j]; }
#pragma unroll
            for (int j = 0; j < 16; ++j) yo[j] = *(const LAS float*)(lds + LO_U + ft * 260 + (16 * q4 + j) * 4) * gelu_tanh_f(gf[j]);
            v4u o0, o1; o0.x = pk2(yo[0], yo[1]); o0.y = pk2(yo[2], yo[3]); o0.z = pk2(yo[4], yo[5]); o0.w = pk2(yo[6], yo[7]);
            o1.x = pk2(yo[8], yo[9]); o1.y = pk2(yo[10], yo[11]); o1.z = pk2(yo[12], yo[13]); o1.w = pk2(yo[14], yo[15]);
            *(v4u*)gq = o0; *(v4u*)(gq + 8) = o1;
        }
        __syncthreads();
    }
#undef LRU_PREFETCH
}
__device__ __forceinline__ void ph_mixers3(const Args& a, LAS unsigned char* lds, int wk, int nwk) {
    for (int it = wk; it < 256; it += nwk) if (it < 128) ssd_item3(a, lds, it >> 4, it & 15);
    for (int it = wk; it < 256; it += nwk) if (it >= 128) lru_item3(a, lds, (it - 128) >> 4, (it - 128) & 15);
    {
        const int wave = __builtin_amdgcn_readfirstlane((int)threadIdx.x >> 6), lane = (int)threadIdx.x & 63;
        __syncthreads();
        if (nwk >= 256) { if (wk >= 128) convert_experts(a, 0, (LAS float*)(lds + wave * 8448), (wk - 128) * NWAVES + wave, (nwk - 128) * NWAVES, lane); }
        else convert_experts(a, 0, (LAS float*)(lds + wave * 8448), wk * NWAVES + wave, nwk * NWAVES, lane);
    }
}

constexpr int RW_STRIDE = 2064;
__device__ __forceinline__ void ph_router(const Args& a, LAS unsigned char* lds, int L, int wk, int nwk) {
    const int tid = threadIdx.x, lane = tid & 63, wave = __builtin_amdgcn_readfirstlane(tid >> 6), fr = lane & 15, fq = lane >> 4;
    const int gw = wk * NWAVES + wave, NGW = nwk * NWAVES;
    LAS unsigned char* wl = lds;
    LAS float* sc = (LAS float*)(lds + 99328) + wave * 768;
    LAS int* lcnt = (LAS int*)(lds + 123904); LAS int* gbase = lcnt + 32; LAS int* rinfo = lcnt + 64;
    const v4u* WRT = (const v4u*)(a.ws + WS_WRT) + (size_t)L * 6144;
    __syncthreads();
    for (int i = tid; i < 6144; i += 512) *(LAS v4u*)(wl + (i >> 7) * RW_STRIDE + (i & 127) * 16) = WRT[i];
    if (tid < 32) lcnt[tid] = 0;
    __syncthreads();
    const bf16* HBr = (const bf16*)a.out;
    float* RSTD1 = (float*)(a.ws + WS_RSTD1); float* GATES = (float*)(a.ws + WS_GATES); int* LIST = (int*)(a.ws + WS_LIST);
    unsigned* cnt = (unsigned*)(a.ws + WS_CTL) + CW_CNT + 1024 * L;
    const float* bg = a.in[I_RGB] + L * 4; const float* be = a.in[I_REB] + L * 16;
    int it = 0;
    for (int u = gw; u < T / 16; u += NGW, ++it) {
        const int r0 = u * 16;
        const bf16* hrow = HBr + (size_t)(r0 + fr) * D + 8 * fq;
        f32x4 acc[3]; float ss = 0.f;
#pragma unroll
        for (int t = 0; t < 3; ++t) acc[t] = (f32x4){0.f, 0.f, 0.f, 0.f};
#pragma unroll 4
        for (int k0 = 0; k0 < 1024; k0 += 32) {
            const v4u hv = *(const v4u*)(hrow + k0);
            f32x4 h0v, h1v; unpack8v(hv, h0v, h1v);
            ss += (h0v[0] * h0v[0] + h0v[1] * h0v[1] + h0v[2] * h0v[2] + h0v[3] * h0v[3]) + (h1v[0] * h1v[0] + h1v[1] * h1v[1] + h1v[2] * h1v[2] + h1v[3] * h1v[3]);
            const bf16x8 hf = __builtin_bit_cast(bf16x8, hv);
#pragma unroll
            for (int t = 0; t < 3; ++t) { const bf16x8 wf = *(const LAS bf16x8*)(wl + (16 * t + fr) * RW_STRIDE + (k0 + 8 * fq) * 2); acc[t] = mfma16(wf, hf, acc[t]); }
        }
        ss += __shfl_xor(ss, 16); ss += __shfl_xor(ss, 32);
        const float rstd = rsqrtf(ss * (1.f / D) + EPS);
#pragma unroll
        for (int t = 0; t < 3; ++t)
#pragma unroll
            for (int r = 0; r < 4; ++r) sc[fr * 48 + 16 * t + 4 * fq + r] = acc[t][r];
        LDS_WAIT();
        if (lane < 16) {
            const int row = r0 + lane;
            float lg[20];
#pragma unroll
            for (int j = 0; j < 20; ++j) lg[j] = (sc[lane * 48 + j] + sc[lane * 48 + 20 + j]) * rstd + (j < 4 ? bg[j] : be[j - 4]);
            int gs = 0; float gm = lg[0];
#pragma unroll
            for (int j = 1; j < 4; ++j) if (lg[j] > gm) { gm = lg[j]; gs = j; }
            const float pg = 1.f / (__expf(lg[0] - gm) + __expf(lg[1] - gm) + __expf(lg[2] - gm) + __expf(lg[3] - gm));
            float f[4];
#pragma unroll
            for (int i = 0; i < 4; ++i) f[i] = gs == 0 ? lg[4 + i] : (gs == 1 ? lg[8 + i] : (gs == 2 ? lg[12 + i] : lg[16 + i]));
            int i0 = 0; float m0 = f[0];
#pragma unroll
            for (int i = 1; i < 4; ++i) if (f[i] > m0) { m0 = f[i]; i0 = i; }
            int i1 = -1; float m1 = -3.0e38f;
#pragma unroll
            for (int i = 0; i < 4; ++i) if (i != i0 && f[i] > m1) { m1 = f[i]; i1 = i; }
            const float w0 = 1.f / (1.f + __expf(m1 - m0)), w1 = 1.f - w0;
            const int lo = i0 < i1 ? i0 : i1, hi = i0 < i1 ? i1 : i0;
            const float glo = pg * (i0 < i1 ? w0 : w1), ghi = pg * (i0 < i1 ? w1 : w0);
            const int pair = lo == 0 ? hi - 1 : (lo == 1 ? hi + 1 : 5);
            const int bk = gs * 6 + pair;
            const int ls = __hip_atomic_fetch_add(lcnt + bk, 1, __ATOMIC_RELAXED, __HIP_MEMORY_SCOPE_WORKGROUP);
            rinfo[(it * NWAVES + wave) * 16 + lane] = bk | (ls << 8);
            RSTD1[row] = rstd; GATES[(size_t)row * 2] = glo; GATES[(size_t)row * 2 + 1] = ghi;
        }
        LDS_WAIT();
    }
    __syncthreads();
    if (tid < NBK) gbase[tid] = (int)atomicAdd(cnt + 32 * tid, (unsigned)lcnt[tid]);
    __syncthreads();
    it = 0;
    for (int u = gw; u < T / 16; u += NGW, ++it)
        if (lane < 16) { const int info = rinfo[(it * NWAVES + wave) * 16 + lane], bk = info & 255; LIST[(size_t)bk * T + gbase[bk] + (info >> 8)] = u * 16 + lane; }
}

struct BkTab { int cnt[NBK], off[NBK], ust[NBK + 1]; };
__device__ __forceinline__ void bk_table(const Args& a, LAS unsigned char* lds, int L, int per_tile  ) {
    LAS int* tb = (LAS int*)lds;
    __syncthreads();
    if (threadIdx.x == 0) {
        const unsigned* cnt = (const unsigned*)(a.ws + WS_CTL) + CW_CNT + 1024 * L;
        int off = 0, us = 0;
        for (int i = 0; i < NBK; ++i) { const int c = (int)__hip_atomic_load(cnt + 32 * i, __ATOMIC_RELAXED, __HIP_MEMORY_SCOPE_AGENT);
            tb[i] = c; tb[NBK + i] = off; tb[2 * NBK + i] = us; off += (c + 255) & ~255; us += ((c + 63) >> 6) * per_tile; }
        tb[2 * NBK + NBK] = us;
    }
    __syncthreads();
}
__device__ __forceinline__ void bk_experts(int bk, int& elo, int& ehi) {
    const int g = bk / 6, pr = bk - g * 6;
    const int lo = pr < 3 ? 0 : (pr < 5 ? 1 : 2), hi = pr < 3 ? pr + 1 : (pr < 5 ? pr - 1 : 3);
    elo = g * 4 + lo; ehi = g * 4 + hi;
}
__device__ __forceinline__ void ph_moe_up(const Args& a, LAS unsigned char* lds, int L, int wk, int nwk) {
    const int tid = threadIdx.x, lane = tid & 63, wave = __builtin_amdgcn_readfirstlane(tid >> 6), fr = lane & 15, fq = lane >> 4;
    const int gw = wk * NWAVES + wave, NGW = nwk * NWAVES;
    bk_table(a, lds, L, 32);
    LAS int* tb = (LAS int*)lds;
    const bf16* HB = (const bf16*)a.out; const bf16* WGU = (const bf16*)(a.ws + WS_WGU); bf16* HID = (bf16*)(a.ws + WS_HID);
    const int* LIST = (const int*)(a.ws + WS_LIST); const float* RSTD1 = (const float*)(a.ws + WS_RSTD1); const float* GATES = (const float*)(a.ws + WS_GATES);
    const int nun = tb[2 * NBK + NBK];
    for (int u = gw; u < nun; u += NGW) {
        int bk = 0;
        for (int i = 1; i < NBK; ++i) if (u >= tb[2 * NBK + i]) bk = i;
        const int cnt = tb[bk], off = tb[NBK + bk], r = u - tb[2 * NBK + bk];
        const int rt = r >> 5, ek = (r >> 4) & 1, ct = r & 15;
        int elo, ehi; bk_experts(bk, elo, ehi); const int e = ek ? ehi : elo;
        const int c0 = ct * 32, brow = e * 1024 + (c0 >> 7) * 256 + (c0 & 127);
        const bf16* arow[4]; int tok[4];
#pragma unroll
        for (int mi = 0; mi < 4; ++mi) { int rr = rt * 64 + 16 * mi + fr; if (rr >= cnt) rr = cnt - 1; tok[mi] = LIST[(size_t)bk * T + rr]; arow[mi] = HB + (size_t)tok[mi] * D; }
        f32x4 acc[4][4]; zero_acc(acc);
        sg_kloop<4>(1024, arow, [=](int n, int k0) { return WGU + (size_t)(brow + (n < 32 ? n : n + 96)) * 1024 + k0; }, NoKS(), acc, fr, fq);
#pragma unroll
        for (int mi = 0; mi < 4; ++mi) { const int rr = rt * 64 + 16 * mi + fr;
            if (rr < cnt) { const float rs = RSTD1[tok[mi]], gt = GATES[(size_t)tok[mi] * 2 + ek];
#pragma unroll
                for (int nj = 0; nj < 2; ++nj) { const f32x4 gv = acc[mi][nj] * rs, uv = acc[mi][nj + 2] * rs; f32x4 hv;
                    hv.x = silu_f(gv.x) * uv.x * gt; hv.y = silu_f(gv.y) * uv.y * gt; hv.z = silu_f(gv.z) * uv.z * gt; hv.w = silu_f(gv.w) * uv.w * gt;
                    v2u w; w.x = pk2(hv.x, hv.y); w.y = pk2(hv.z, hv.w);
                    *(v2u*)(HID + (size_t)(off + rr) * 1024 + ek * 512 + c0 + 16 * nj + 4 * fq) = w; } } }
    }
}
__device__ __forceinline__ void ph_moe_down(const Args& a, LAS unsigned char* lds, int L, int wk, int nwk) {
    const int tid = threadIdx.x, lane = tid & 63, wave = __builtin_amdgcn_readfirstlane(tid >> 6), fr = lane & 15, fq = lane >> 4;
    const int gw = wk * NWAVES + wave, NGW = nwk * NWAVES;
    bk_table(a, lds, L, 16);
    LAS int* tb = (LAS int*)lds;
    const bf16* HID = (const bf16*)(a.ws + WS_HID); const bf16* WD = (const bf16*)(a.ws + WS_WD);
    float* H = (float*)(a.ws + WS_H); bf16* HB = (bf16*)a.out; const int* LIST = (const int*)(a.ws + WS_LIST);
    const int nun = tb[2 * NBK + NBK];
    for (int u = gw; u < nun; u += NGW) {
        int bk = 0;
        for (int i = 1; i < NBK; ++i) if (u >= tb[2 * NBK + i]) bk = i;
        const int cnt = tb[bk], off = tb[NBK + bk], r = u - tb[2 * NBK + bk];
        const int rt = r >> 4, ct = r & 15;
        int elo, ehi; bk_experts(bk, elo, ehi);
        const bf16* arow[4];
#pragma unroll
        for (int mi = 0; mi < 4; ++mi) arow[mi] = HID + (size_t)(off + rt * 64 + 16 * mi + fr) * 1024;
        f32x4 acc[4][4]; zero_acc(acc);
        sg_kloop<4>(1024, arow, [=](int n, int k0) { return WD + ((size_t)((k0 < 512 ? elo : ehi) * 1024 + ct * 64 + n)) * 512 + (k0 & 511); }, NoKS(), acc, fr, fq);
#pragma unroll
        for (int mi = 0; mi < 4; ++mi) { const int rr = rt * 64 + 16 * mi + fr;
            if (rr < cnt) { const int tok = LIST[(size_t)bk * T + rr];
#pragma unroll
                for (int nj = 0; nj < 4; ++nj) { const int c = ct * 64 + 16 * nj + 4 * fq; float* hp = H + (size_t)tok * D + c;
                    const f32x4 v = *(const f32x4*)hp + acc[mi][nj]; *(f32x4*)hp = v;
                    v2u w; w.x = pk2(v.x, v.y); w.y = pk2(v.z, v.w); *(v2u*)(HB + (size_t)tok * D + c) = w; } } }
    }
}


__device__ __forceinline__ void hb_store4(bf16* HB, int row, int col, const f32x4 v) {
    v2u w; w.x = pg8::cvt_pk_bf16(v[0], v[1]); w.y = pg8::cvt_pk_bf16(v[2], v[3]); *(v2u*)(HB + (size_t)row * D + col) = w;
}
__device__ __forceinline__ void hb_store8(bf16* HB, int row, int col, const f32x4 v0, const f32x4 v1) {
    v4u w; w.x = pg8::cvt_pk_bf16(v0[0], v0[1]); w.y = pg8::cvt_pk_bf16(v0[2], v0[3]); w.z = pg8::cvt_pk_bf16(v1[0], v1[1]); w.w = pg8::cvt_pk_bf16(v1[2], v1[3]);
    *(v4u*)(HB + (size_t)row * D + col) = w;
}
constexpr int LDS_TAB = 131072;

struct PGemm2 {
    static constexpr bool PERM = true;
    struct Unit { int pm, pn, ui; };
    const Args* ap; const char* A; const char* B; bf16* HB; int G, c; int ldb, nt;
    __device__ __forceinline__ bool next(int i, Unit& u) const { u.ui = i; return pg8::static_order(64, 4, G, c, i, u.pm, u.pn); }
    __device__ __forceinline__ void avoff(const Unit& u, const int (&RA)[2], const int (&CA)[2], unsigned (&v)[4]) const {
#pragma unroll
        for (int h = 0; h < 2; ++h)
#pragma unroll
            for (int i = 0; i < 2; ++i) { const int row = u.pm * 256 + h * 128 + RA[i]; v[h * 2 + i] = (unsigned)(row * LDP + CA[i]) * 2u; }
    }
    __device__ __forceinline__ const char* abase(const Unit&) const { return A; }
    __device__ __forceinline__ const char* btile(const Unit& u, int t) const { return B + ((size_t)u.pn * 256 * 2048 + (size_t)t * 64) * 2; }
    __device__ __forceinline__ void a_ready(const Unit&) const {}
    __device__ __forceinline__ void done(const Unit&) const {}
    __device__ __forceinline__ void khook(int t, pg8::Acc& acc, const Unit& u, LAS unsigned char* lds, int wr, int wc, int fr, int fq) const {
        if (t == 8 || t == 16) {
            const LAS float* ft = (const LAS float*)(lds + LDS_TAB) + u.ui * 512 + (t == 16 ? 1 : 0);
#pragma unroll
            for (int ai = 0; ai < 2; ++ai)
#pragma unroll
                for (int m = 0; m < 4; ++m) { const float f = ft[(ai * 128 + wr * 64 + m * 16 + fr) * 2];
#pragma unroll
                    for (int bj = 0; bj < 2; ++bj)
#pragma unroll
                        for (int n = 0; n < 2; ++n) acc[ai][bj][m][n] *= f; }
        }
    }
    __device__ __forceinline__ void epi(const pg8::Acc& acc, const Unit& u, int wr, int wc, int fr, int fq) const {
        const int row0 = u.pm * 256 + wr * 64 + fr, col0 = u.pn * 256 + wc * 32 + 8 * fq;
#pragma unroll
        for (int ai = 0; ai < 2; ++ai)
#pragma unroll
            for (int m = 0; m < 4; ++m) { const int row = row0 + ai * 128 + m * 16; const float* hr = h0_row(*ap, row);
#pragma unroll
                for (int bj = 0; bj < 2; ++bj) { const int col = col0 + bj * 128;
                    hb_store8(HB, row, col, acc[ai][bj][m][0] + *(const f32x4*)(hr + col), acc[ai][bj][m][1] + *(const f32x4*)(hr + col + 4)); } }
    }
};
__device__ __forceinline__ void ssd_factors(const float* SSDSQ, int row, float& f0, float& f1) {
    const f32x4* sq = (const f32x4*)(SSDSQ + (size_t)row * 16); const f32x4 q0 = sq[0], q1 = sq[1], q2 = sq[2], q3 = sq[3];
    const float s0 = (q0.x + q0.y + q0.z + q0.w) + (q1.x + q1.y + q1.z + q1.w), s1 = (q2.x + q2.y + q2.z + q2.w) + (q3.x + q3.y + q3.z + q3.w);
    const float r0 = rsqrtf(s0 * (1.f / 512.f) + EPS), r1 = rsqrtf(s1 * (1.f / 512.f) + EPS);
    f0 = r0 / r1; f1 = r1;
}
__device__ __forceinline__ void ph_gemm2_pg8(const Args& a, LAS unsigned char* lds, int wk, int G) {
    const int tid = threadIdx.x, lane = tid & 63, wave = __builtin_amdgcn_readfirstlane(tid >> 6), fr = lane & 15, fq = lane >> 4;
    const float* SSDSQ = (const float*)(a.ws + WS_SSDSQ);
    PGemm2 S; S.ap = &a; S.A = (const char*)(a.ws + WS_PROJ); S.B = (const char*)(a.ws + WS_WOUT); S.HB = (bf16*)a.out;
    S.G = G; S.c = (int)blockIdx.x; S.ldb = 2048; S.nt = 32;
    {
        LAS float* ft = (LAS float*)(lds + LDS_TAB);
        PGemm2::Unit u;
        for (int i = 0; i < 4 && S.next(i, u); ++i)
            if (tid < 256) { float f0, f1; ssd_factors(SSDSQ, u.pm * 256 + tid, f0, f1); ft[i * 512 + tid * 2] = f0; ft[i * 512 + tid * 2 + 1] = f1; }
        __syncthreads();
    }
    pg8::gemm_phase<PGemm2, true>(lds, S);
    const bf16* PROJ = (const bf16*)(a.ws + WS_PROJ); const bf16* WOUT = (const bf16*)(a.ws + WS_WOUT);
    for (int tile = wk; tile < 32; tile += G) {
        const int rt = tile >> 4, ct = tile & 15, kb = wave * 256;
        const bf16* arow[4];
#pragma unroll
        for (int mi = 0; mi < 4; ++mi) arow[mi] = PROJ + (size_t)(16384 + rt * 64 + 16 * mi + fr) * LDP + kb;
        f32x4 acc[4][4]; zero_acc(acc);
        sg_kloop<4>(256, arow, [=](int n, int k0) { return WOUT + (size_t)(ct * 64 + n) * 2048 + kb + k0; }, NoKS(), acc, fr, fq);
        LAS float* part = (LAS float*)lds + wave * 4096;
        __syncthreads();
#pragma unroll
        for (int mi = 0; mi < 4; ++mi) { const int r = 16 * mi + fr; float f0, f1; ssd_factors(SSDSQ, 16384 + rt * 64 + r, f0, f1);
            const float sc = wave < 2 ? f0 * f1 : (wave < 4 ? f1 : 1.f);
#pragma unroll
            for (int nj = 0; nj < 4; ++nj) *(LAS f32x4*)(part + r * 64 + 16 * nj + 4 * fq) = acc[mi][nj] * sc; }
        __syncthreads();
        for (int q = tid; q < 1024; q += 512) { const int r = q >> 4, c4 = (q & 15) * 4; f32x4 s = *(const LAS f32x4*)((LAS float*)lds + r * 64 + c4);
#pragma unroll
            for (int w = 1; w < 8; ++w) s += *(const LAS f32x4*)((LAS float*)lds + w * 4096 + r * 64 + c4);
            const int row = 16384 + rt * 64 + r, col = ct * 64 + c4;
            hb_store4(S.HB, row, col, s + *(const f32x4*)(h0_row(a, row) + col)); }
        __syncthreads();
    }
}

struct BkInfo { int bk, rt, cnt, off; };
__device__ __forceinline__ void bk_table256(const Args& a, LAS unsigned char* lds, int L) {
    LAS int* tb = (LAS int*)(lds + LDS_TAB);
    __syncthreads();
    if (threadIdx.x == 0) {
        const unsigned* cnt = (const unsigned*)(a.ws + WS_CTL) + CW_CNT + 1024 * L;
        int off = 0, rts = 0;
        for (int i = 0; i < NBK; ++i) { const int c = (int)__hip_atomic_load(cnt + 32 * i, __ATOMIC_RELAXED, __HIP_MEMORY_SCOPE_AGENT);
            tb[i] = c; tb[NBK + i] = off; tb[2 * NBK + i] = rts; off += (c + 255) & ~255; rts += (c + 255) >> 8; }
        tb[2 * NBK + NBK] = rts;
    }
    __syncthreads();
}
__device__ __forceinline__ bool bk_find(const LAS int* tb, int rti, BkInfo& o) {
    if (rti >= tb[2 * NBK + NBK]) return false;
    int bk = 0;
    for (int i = 1; i < NBK; ++i) if (rti >= tb[2 * NBK + i]) bk = i;
    o.bk = bk; o.rt = rti - tb[2 * NBK + bk]; o.cnt = tb[bk]; o.off = tb[NBK + bk]; return true;
}
struct PMoeUp {
    static constexpr bool PERM = true;
    struct Unit { int bk, rt, cnt, off, e, ek, pnl, ui, rti; };
    const char* A; const char* B; bf16* HID; const float* rstd; const float* gates; const LAS int* tb; const LAS int* rowtab; unsigned* ctr; int G, c; int ldb, nt;
    __device__ __forceinline__ bool next(int i, Unit& u) const {
        const int Lu = i * G + c; BkInfo o; if (!bk_find(tb, Lu >> 3, o)) return false;
        u.bk = o.bk; u.rt = o.rt; u.cnt = o.cnt; u.off = o.off; u.ek = (Lu >> 2) & 1; u.pnl = Lu & 3; u.ui = i; u.rti = Lu >> 3;
        int elo, ehi; bk_experts(o.bk, elo, ehi); u.e = u.ek ? ehi : elo; return true;
    }
    __device__ __forceinline__ void avoff(const Unit& u, const int (&RA)[2], const int (&CA)[2], unsigned (&v)[4]) const {
#pragma unroll
        for (int h = 0; h < 2; ++h)
#pragma unroll
            for (int i = 0; i < 2; ++i) { const int tok = rowtab[u.ui * 256 + h * 128 + RA[i]]; v[h * 2 + i] = (unsigned)(tok * D + CA[i]) * 2u; }
    }
    __device__ __forceinline__ const char* abase(const Unit&) const { return A; }
    __device__ __forceinline__ const char* btile(const Unit& u, int t) const { return B + ((size_t)(u.e * 1024 + u.pnl * 256) * 1024 + (size_t)t * 64) * 2; }
    __device__ __forceinline__ void khook(int, pg8::Acc&, const Unit&, LAS unsigned char*, int, int, int, int) const {}
    __device__ __forceinline__ void a_ready(const Unit&) const {}
    __device__ __forceinline__ void done(const Unit& u) const {
        asm volatile("s_waitcnt vmcnt(0)" ::: "memory");
        if ((threadIdx.x & 63) == 0) __hip_atomic_fetch_add(ctr + 32 * u.rti, 1u, __ATOMIC_RELAXED, __HIP_MEMORY_SCOPE_AGENT);
    }
    __device__ __forceinline__ void epi(const pg8::Acc& acc, const Unit& u, int wr, int wc, int fr, int fq) const {
        const int r0 = wr * 64 + fr, col0 = u.ek * 512 + u.pnl * 128 + wc * 32 + 8 * fq;
        float rsv[2][4], gtv[2][4];
#pragma unroll
        for (int ai = 0; ai < 2; ++ai)
#pragma unroll
            for (int m = 0; m < 4; ++m) { const int tok = rowtab[u.ui * 256 + r0 + ai * 128 + m * 16]; rsv[ai][m] = rstd[tok]; gtv[ai][m] = gates[(size_t)tok * 2 + u.ek]; }
#pragma unroll
        for (int ai = 0; ai < 2; ++ai)
#pragma unroll
            for (int m = 0; m < 4; ++m) { const int rr = u.rt * 256 + r0 + ai * 128 + m * 16;
                if (rr < u.cnt) { const float rs = rsv[ai][m], gt = gtv[ai][m]; float hv[8];
#pragma unroll
                    for (int n = 0; n < 2; ++n)
#pragma unroll
                        for (int j = 0; j < 4; ++j) { const float g = acc[ai][0][m][n][j] * rs, uu = acc[ai][1][m][n][j] * rs; hv[n * 4 + j] = silu_f(g) * uu * gt; }
                    v4u w; w.x = pg8::cvt_pk_bf16(hv[0], hv[1]); w.y = pg8::cvt_pk_bf16(hv[2], hv[3]); w.z = pg8::cvt_pk_bf16(hv[4], hv[5]); w.w = pg8::cvt_pk_bf16(hv[6], hv[7]);
                    unsigned long long* hp = (unsigned long long*)(HID + (size_t)(u.off + rr) * 1024 + col0);
                    __hip_atomic_store(hp, (unsigned long long)w.x | ((unsigned long long)w.y << 32), __ATOMIC_RELAXED, __HIP_MEMORY_SCOPE_AGENT);
                    __hip_atomic_store(hp + 1, (unsigned long long)w.z | ((unsigned long long)w.w << 32), __ATOMIC_RELAXED, __HIP_MEMORY_SCOPE_AGENT); } }
    }
};
__device__ __forceinline__ void ph_moe_up_pg8(const Args& a, LAS unsigned char* lds, int L, int G) {
    bk_table256(a, lds, L);
    const LAS int* tb = (const LAS int*)(lds + LDS_TAB); LAS int* rowtab = (LAS int*)(lds + LDS_TAB + 1024);
    PMoeUp S; S.A = (const char*)a.out; S.B = (const char*)(a.ws + ws_wgu(L)); S.HID = (bf16*)(a.ws + WS_HID); S.rstd = (const float*)(a.ws + WS_RSTD1); S.gates = (const float*)(a.ws + WS_GATES);
    S.tb = tb; S.rowtab = rowtab; S.G = G; S.c = (int)blockIdx.x; S.ldb = 1024; S.nt = 16; S.ctr = (unsigned*)(a.ws + WS_CTL) + CW_RT + 8192 * L;
    {   const int* LIST = (const int*)(a.ws + WS_LIST); PMoeUp::Unit u;
        for (int i = 0; i < 6 && S.next(i, u); ++i)
            if (threadIdx.x < 256) { int rr = u.rt * 256 + (int)threadIdx.x; rr = rr < u.cnt ? rr : u.cnt - 1; rowtab[i * 256 + threadIdx.x] = LIST[(size_t)u.bk * T + rr]; }
        __syncthreads();
    }
    pg8::gemm_phase<PMoeUp, true>(lds, S);
}
struct PMoeDown {
    static constexpr bool PERM = true;
    struct Unit { int bk, rt, cnt, off, elo, ehi, pn, ui, rti; };
    const char* A; const char* B; bf16* HB; bf16* HBo; float* SSQ; const LAS int* tb; const LAS int* rowtab; unsigned* ctr; unsigned* err; int G, c, i0; int ldb, nt;
    __device__ __forceinline__ bool next(int i, Unit& u) const {
        const int Ld = (i0 + i) * G + c - 8 * tb[2 * NBK + NBK]; BkInfo o; if (!bk_find(tb, Ld >> 2, o)) return false;
        u.bk = o.bk; u.rt = o.rt; u.cnt = o.cnt; u.off = o.off; u.pn = Ld & 3; u.ui = i; u.rti = Ld >> 2; bk_experts(o.bk, u.elo, u.ehi); return true;
    }
    __device__ __forceinline__ void avoff(const Unit& u, const int (&RA)[2], const int (&CA)[2], unsigned (&v)[4]) const {
#pragma unroll
        for (int h = 0; h < 2; ++h)
#pragma unroll
            for (int i = 0; i < 2; ++i) { const int row = u.off + u.rt * 256 + h * 128 + RA[i]; v[h * 2 + i] = (unsigned)(row * 1024 + CA[i]) * 2u; }
    }
    __device__ __forceinline__ const char* abase(const Unit&) const { return A; }
    __device__ __forceinline__ const char* btile(const Unit& u, int t) const { return B + ((size_t)((t < 8 ? u.elo : u.ehi) * 1024 + u.pn * 256) * 512 + (size_t)(t & 7) * 64) * 2; }
    __device__ __forceinline__ void khook(int, pg8::Acc&, const Unit&, LAS unsigned char*, int, int, int, int) const {}
    __device__ __forceinline__ void a_ready(const Unit& u) const {
        if (threadIdx.x < 64) {
            unsigned spins = 0;
            while ((unsigned)__builtin_amdgcn_readfirstlane(__hip_atomic_load(ctr + 32 * u.rti, __ATOMIC_RELAXED, __HIP_MEMORY_SCOPE_AGENT)) < 64u) {
                __builtin_amdgcn_s_sleep(2);
                if (++spins > (1u << 22)) { if (threadIdx.x == 0) __hip_atomic_store(err, 1u, __ATOMIC_RELAXED, __HIP_MEMORY_SCOPE_AGENT); break; } }
            __builtin_amdgcn_fence(__ATOMIC_ACQUIRE, "agent");
            asm volatile("s_waitcnt vmcnt(0)" ::: "memory");
        }
        asm volatile("" ::: "memory"); __builtin_amdgcn_s_barrier(); asm volatile("" ::: "memory");
    }
    __device__ __forceinline__ void done(const Unit&) const {}
    __device__ __forceinline__ void epi(const pg8::Acc& acc, const Unit& u, int wr, int wc, int fr, int fq) const {
        const int r0 = wr * 64 + fr, col0 = u.pn * 256 + wc * 32 + 8 * fq;
        int tok[8];
#pragma unroll
        for (int g8 = 0; g8 < 8; ++g8) tok[g8] = rowtab[u.ui * 256 + r0 + (g8 >> 2) * 128 + (g8 & 3) * 16];
        v4u cur[2], nxt[2];
#pragma unroll
        for (int bj = 0; bj < 2; ++bj) cur[bj] = *(const v4u*)(HB + (size_t)tok[0] * D + col0 + bj * 128);
#pragma unroll
        for (int g8 = 0; g8 < 8; ++g8) {
            const int ai = g8 >> 2, m = g8 & 3;
            if (g8 < 7) {
#pragma unroll
                for (int bj = 0; bj < 2; ++bj) nxt[bj] = *(const v4u*)(HB + (size_t)tok[g8 + 1] * D + col0 + bj * 128); }
            const int rr = u.rt * 256 + r0 + ai * 128 + m * 16;
            float sq = 0.f;
#pragma unroll
            for (int bj = 0; bj < 2; ++bj) { f32x4 h0v, h1v; unpack8v(cur[bj], h0v, h1v);
                const f32x4 v0 = acc[ai][bj][m][0] + h0v, v1 = acc[ai][bj][m][1] + h1v;
                sq += (v0[0] * v0[0] + v0[1] * v0[1] + v0[2] * v0[2] + v0[3] * v0[3]) + (v1[0] * v1[0] + v1[1] * v1[1] + v1[2] * v1[2] + v1[3] * v1[3]);
                if (rr < u.cnt) hb_store8(HBo, tok[g8], col0 + bj * 128, v0, v1); }
            sq += __shfl_xor(sq, 16); sq += __shfl_xor(sq, 32);
            if (rr < u.cnt && fq == 0) SSQ[(size_t)tok[g8] * 16 + u.pn * 4 + wc] = sq;
#pragma unroll
            for (int bj = 0; bj < 2; ++bj) cur[bj] = nxt[bj];
        }
    }
};
__device__ __forceinline__ void ph_moe_down_pg8(const Args& a, LAS unsigned char* lds, int L, int G) {
    bk_table256(a, lds, L);
    const LAS int* tb = (const LAS int*)(lds + LDS_TAB); LAS int* rowtab = (LAS int*)(lds + LDS_TAB + 1024);
    PMoeDown S; S.A = (const char*)(a.ws + WS_HID); S.B = (const char*)(a.ws + ws_wd(L)); S.SSQ = (float*)(a.ws + WS_SSDSQ); S.HB = (bf16*)a.out; S.HBo = L ? (bf16*)(a.ws + WS_H) : (bf16*)a.out;
    S.tb = tb; S.rowtab = rowtab; S.G = G; S.c = (int)blockIdx.x; S.ldb = 512; S.nt = 16; S.ctr = (unsigned*)(a.ws + WS_CTL) + CW_RT + 8192 * L; S.err = (unsigned*)(a.ws + WS_CTL) + 16;
    { const int nup = 8 * tb[2 * NBK + NBK]; S.i0 = nup > S.c ? (nup - S.c + G - 1) / G : 0; }
    {   const int* LIST = (const int*)(a.ws + WS_LIST); PMoeDown::Unit u;
        for (int i = 0; i < 4 && S.next(i, u); ++i)
            if (threadIdx.x < 256) { int rr = u.rt * 256 + (int)threadIdx.x; rr = rr < u.cnt ? rr : u.cnt - 1; rowtab[i * 256 + threadIdx.x] = LIST[(size_t)u.bk * T + rr]; }
        __syncthreads();
    }
    pg8::gemm_phase<PMoeDown, true>(lds, S);
    if (L == 0) {
        const int wave = __builtin_amdgcn_readfirstlane((int)threadIdx.x >> 6), lane = (int)threadIdx.x & 63;
        const int ntot = 12 * tb[2 * NBK + NBK], n_more = ntot % G;
        __syncthreads();
        if (n_more > 0 && n_more <= G - 32) { if (S.c >= n_more) convert_experts(a, 1, (LAS float*)(lds + wave * 8448), (S.c - n_more) * NWAVES + wave, (G - n_more) * NWAVES, lane); }
        else convert_experts(a, 1, (LAS float*)(lds + wave * 8448), S.c * NWAVES + wave, G * NWAVES, lane);
    }
}
struct PPool {
    static constexpr bool PERM = true;
    struct Unit { int pm, pn; };
    const char* A; const char* B; bf16* HB; const float* pb; const float* ps; int G, c; int ldb, nt;
    __device__ __forceinline__ bool next(int i, Unit& u) const { return pg8::static_order(65, 4, G, c, i, u.pm, u.pn); }
    __device__ __forceinline__ void avoff(const Unit& u, const int (&RA)[2], const int (&CA)[2], unsigned (&v)[4]) const {
#pragma unroll
        for (int h = 0; h < 2; ++h)
#pragma unroll
            for (int i = 0; i < 2; ++i) { int row = u.pm * 256 + h * 128 + RA[i]; row = row < T ? row : T - 1; v[h * 2 + i] = (unsigned)(row * D + CA[i]) * 2u; }
    }
    __device__ __forceinline__ const char* abase(const Unit& u) const { return A + (size_t)u.pn * 256 * 2; }
    __device__ __forceinline__ const char* btile(const Unit& u, int t) const { return B + ((size_t)u.pn * 256 * 256 + (size_t)t * 64) * 2; }
    __device__ __forceinline__ void khook(int, pg8::Acc&, const Unit&, LAS unsigned char*, int, int, int, int) const {}
    __device__ __forceinline__ void a_ready(const Unit&) const {}
    __device__ __forceinline__ void done(const Unit&) const {}
    __device__ __forceinline__ void epi(const pg8::Acc& acc, const Unit& u, int wr, int wc, int fr, int fq) const {
        const int row0 = u.pm * 256 + wr * 64 + fr, col0 = u.pn * 256 + wc * 32 + 8 * fq;
        v4u cur[2], nxt[2];
        { const int rc = row0 < T ? row0 : T - 1;
#pragma unroll
          for (int bj = 0; bj < 2; ++bj) cur[bj] = *(const v4u*)(HB + (size_t)rc * D + col0 + bj * 128); }
#pragma unroll
        for (int g8 = 0; g8 < 8; ++g8) {
            const int ai = g8 >> 2, m = g8 & 3, row = row0 + ai * 128 + m * 16;
            if (g8 < 7) { const int rn = row0 + ((g8 + 1) >> 2) * 128 + ((g8 + 1) & 3) * 16, rc = rn < T ? rn : T - 1;
#pragma unroll
                for (int bj = 0; bj < 2; ++bj) nxt[bj] = *(const v4u*)(HB + (size_t)rc * D + col0 + bj * 128); }
            if (row < T) {
#pragma unroll
                for (int bj = 0; bj < 2; ++bj) { const int cc = col0 + bj * 128; f32x4 h0v, h1v; unpack8v(cur[bj], h0v, h1v);
                    hb_store8(HB, row, cc, h0v + (acc[ai][bj][m][0] + *(const f32x4*)(pb + cc)) * *(const f32x4*)(ps + cc),
                                           h1v + (acc[ai][bj][m][1] + *(const f32x4*)(pb + cc + 4)) * *(const f32x4*)(ps + cc + 4)); } }
#pragma unroll
            for (int bj = 0; bj < 2; ++bj) cur[bj] = nxt[bj];
        }
    }
};
__device__ __forceinline__ void ph_poolgemm_pg8(const Args& a, LAS unsigned char* lds, int G) {
    PPool S; S.A = (const char*)(a.ws + WS_POOLED); S.B = (const char*)(a.ws + WS_WPOOL); S.HB = (bf16*)a.out; S.pb = a.in[I_PB]; S.ps = a.in[I_PS];
    S.G = G; S.c = (int)blockIdx.x; S.ldb = 256; S.nt = 4;
    pg8::gemm_phase<PPool, true>(lds, S);
}

__device__ __forceinline__ void ph_pooled(const Args& a, LAS unsigned char* lds, int wk, int nwk) {
    const int tid = threadIdx.x, qt = tid >> 7, c8 = tid & 127, c = c8 * 8, g = c >> 8, w = 2 << g;
    const bf16* HBr = (const bf16*)a.out; const float* SSQ = (const float*)(a.ws + WS_SSDSQ); bf16* PO = (bf16*)(a.ws + WS_POOLED);
    LAS float* rs = (LAS float*)lds + qt * 64;
    for (int pr = wk; pr < 172; pr += nwk) {
        const int task = pr * 4 + qt, b = task / 86, t0 = (task % 86) * 24;
        const size_t rb = (size_t)b * LSEQ;
        __syncthreads();
        if (c8 < 40) { const int l = t0 - 16 + c8; float r = 0.f;
            if (l >= 0) { const f32x4* q = (const f32x4*)(SSQ + (rb + l) * 16); const f32x4 sv = (q[0] + q[1]) + (q[2] + q[3]); r = rsqrtf((sv[0] + sv[1] + sv[2] + sv[3]) * (1.f / D) + EPS); }
            rs[c8] = r; }
        __syncthreads();
        f32x4 S0 = (f32x4){0.f, 0.f, 0.f, 0.f}, S1 = S0;
        for (int j = 1; j <= w; ++j) { const int l = t0 - j; if (l >= 0) { f32x4 x0, x1; unpack8v(*(const v4u*)(HBr + (rb + l) * D + c), x0, x1); S0 += x0 * rs[16 - j]; S1 += x1 * rs[16 - j]; } }
#pragma unroll 4
        for (int t = 0; t < 24; ++t) {
            const int l = t0 + t;
            f32x4 h0v, h1v; unpack8v(*(const v4u*)(HBr + (rb + l) * D + c), h0v, h1v); h0v *= rs[16 + t]; h1v *= rs[16 + t];
            const int lo = l - w, loc = lo >= 0 ? lo : 0; const float rl = lo >= 0 ? rs[16 + t - w] : 0.f;
            f32x4 s0v, s1v; unpack8v(*(const v4u*)(HBr + (rb + loc) * D + c), s0v, s1v);
            S0 += h0v; S0 -= s0v * rl; S1 += h1v; S1 -= s1v * rl;
            const int n = (l + 1) < w ? (l + 1) : w; const float inv = 1.f / (float)n;
            const f32x4 o0 = S0 * inv - h0v, o1 = S1 * inv - h1v;
            v4u wv; wv.x = pk2(o0[0], o0[1]); wv.y = pk2(o0[2], o0[3]); wv.z = pk2(o1[0], o1[1]); wv.w = pk2(o1[2], o1[3]); *(v4u*)(PO + (rb + l) * D + c) = wv;
        }
    }
}
__device__ __forceinline__ void ph_poolgemm(const Args& a, int wk, int nwk) {
    const int tid = threadIdx.x, lane = tid & 63, wave = __builtin_amdgcn_readfirstlane(tid >> 6), fr = lane & 15, fq = lane >> 4;
    const int gw = wk * NWAVES + wave, NGW = nwk * NWAVES;
    const bf16* PO = (const bf16*)(a.ws + WS_POOLED); const bf16* WPOOL = (const bf16*)(a.ws + WS_WPOOL);
    float* H = (float*)(a.ws + WS_H); bf16* HB = (bf16*)a.out;
    for (int u = gw; u < 258 * 16; u += NGW) {
        const int rt = u / 16, ct = u % 16, g = ct >> 2;
        const bf16* arow[4];
#pragma unroll
        for (int mi = 0; mi < 4; ++mi) arow[mi] = PO + (size_t)(rt * 64 + 16 * mi + fr) * D + g * 256;
        f32x4 acc[4][4]; zero_acc(acc);
        sg_kloop<4>(256, arow, [=](int n, int k0) { return WPOOL + (size_t)(ct * 64 + n) * 256 + k0; }, NoKS(), acc, fr, fq);
#pragma unroll
        for (int mi = 0; mi < 4; ++mi) { const int row = rt * 64 + 16 * mi + fr;
#pragma unroll
            for (int nj = 0; nj < 4; ++nj) { const int c = ct * 64 + 16 * nj + 4 * fq; float* hp = H + (size_t)row * D + c;
                const f32x4 v = *(const f32x4*)hp + (acc[mi][nj] + *(const f32x4*)(a.in[I_PB] + c)) * *(const f32x4*)(a.in[I_PS] + c); *(f32x4*)hp = v;
                v2u w; w.x = pk2(v.x, v.y); w.y = pk2(v.z, v.w); *(v2u*)(HB + (size_t)row * D + c) = w; } }
    }
}
__device__ __forceinline__ void ph_final(const Args& a, int wk, int nwk) {
    const int tid = threadIdx.x, lane = tid & 63, wave = __builtin_amdgcn_readfirstlane(tid >> 6);
    const int gw = wk * NWAVES + wave, NGW = nwk * NWAVES;
    const f32x4* gn = (const f32x4*)a.in[I_NORMF] + lane;
    const bf16* HF = (const bf16*)(a.ws + WS_H);
    for (int orow = gw; orow < NB * SEQ; orow += NGW) {
        const int b = orow / SEQ, l = orow - b * SEQ, row = b * LSEQ + NMETA + l;
        const v2u* xr = (const v2u*)(HF + (size_t)row * D) + lane; f32x4 v[4]; float ss = 0.f;
#pragma unroll
        for (int j = 0; j < 4; ++j) { const v2u q = xr[64 * j]; v[j][0] = __uint_as_float(q.x << 16); v[j][1] = __uint_as_float(q.x & 0xffff0000u); v[j][2] = __uint_as_float(q.y << 16); v[j][3] = __uint_as_float(q.y & 0xffff0000u);
            ss += v[j].x * v[j].x + v[j].y * v[j].y + v[j].z * v[j].z + v[j].w * v[j].w; }
        ss = wave_sum(ss);
        const float rstd = rsqrtf(ss * (1.f / D) + EPS);
        f32x4* o = (f32x4*)(a.out + (size_t)orow * D) + lane;
#ifdef PROBE_T
        const unsigned long long* ts = (const unsigned long long*)(a.ws + WS_CTL + 2048);
        const float tA = (float)(ts[PROBE_A_HI] - ts[PROBE_A_LO]) * 0.01f, tB = (float)(ts[PROBE_B_HI] - ts[PROBE_B_LO]) * 0.01f;
#pragma unroll
        for (int j = 0; j < 4; ++j) { f32x4 r = v[j] * rstd * gn[64 * j] + tB * 0.01f; if (orow == 0 && lane == 0 && j == 0) r.x += tA; o[64 * j] = r; }
#else
#pragma unroll
        for (int j = 0; j < 4; ++j) o[64 * j] = v[j] * rstd * gn[64 * j];
#endif
    }
}

__global__ void __launch_bounds__(NWAVES * 64, 2) fwd_kernel(Args a) {
    extern __shared__ __attribute__((aligned(16))) unsigned char lds_raw[];
    LAS unsigned char* lds = (LAS unsigned char*)lds_raw;
    volatile LAS unsigned* MISC = (volatile LAS unsigned*)(lds + LDS_BYTES - 256);
    const int tid = threadIdx.x;
    const int G = gridDim.x; const int bx = blockIdx.x;
    const int wk = (G % 8 == 0) ? (bx % 8) * (G / 8) + bx / 8 : bx;
    if (tid < 64) MISC[tid] = 0u;
    __syncthreads();
    XcdBarrier bar; bar.bar = (unsigned*)(a.ws + WS_CTL) + CW_BAR; bar.x = 0; bar.st = nullptr;
    if (N_LAUNCHES == 1) bar = xcd_barrier_post((unsigned*)(a.ws + WS_CTL) + CW_BAR, MISC + 8);
    const int lo = a.ph_lo, hi = a.ph_hi;
#ifndef PH_MASK
#define PH_MASK 0xFFFF
#endif
#define IN(k) (((PH_MASK >> (k)) & 1) && lo <= (k) && (k) < hi)
#ifdef PROBE_T
#define STAMP(k) do { if (blockIdx.x == 0 && tid == 0) ((unsigned long long*)(a.ws + WS_CTL + 2048))[k] = __builtin_amdgcn_s_memrealtime(); } while (0)
#else
#define STAMP(k) do { } while (0)
#endif
#ifdef PROBE_K
    volatile LAS unsigned long long* pkt = (volatile LAS unsigned long long*)(lds + LDS_BYTES - 128);
#define PSTAMP(k) do { if (blockIdx.x == 0 && tid == 0) { if ((k) == PROBE_K) pkt[0] = __builtin_amdgcn_s_memrealtime(); if ((k) == PROBE_K + 1) pkt[1] = __builtin_amdgcn_s_memrealtime(); } } while (0)
#else
#define PSTAMP(k) do { } while (0)
#endif
#define SEAM(k) do { if (IN(k) && IN((k) + 1)) xcd_barrier(bar); STAMP((k) + 1); PSTAMP((k) + 1); } while (0)
    STAMP(0); PSTAMP(0);
    if (IN(0)) { ph_prep(a, lds, wk, G); } SEAM(0);
    if (IN(1)) { ph_gemm1_pg8(a, lds, G); } SEAM(1);
    if (IN(2)) { ph_conv(a, wk, G); } SEAM(2);
    if (IN(3)) { ph_mixers3(a, lds, wk, G); } SEAM(3);
    if (IN(4)) { ph_gemm2_pg8(a, lds, wk, G); } SEAM(4);
    if (IN(5)) { ph_router(a, lds, 0, wk, G); } SEAM(5);
    if (IN(6)) { ph_moe_up_pg8(a, lds, 0, G); ph_moe_down_pg8(a, lds, 0, G); } SEAM(6);
    STAMP(8); PSTAMP(8);
    if (IN(8)) { ph_pooled(a, lds, wk, G); } SEAM(8);
    if (IN(9)) { ph_poolgemm_pg8(a, lds, G); } SEAM(9);
    if (IN(10)) { ph_router(a, lds, 1, wk, G); } SEAM(10);
    if (IN(11)) { ph_moe_up_pg8(a, lds, 1, G); ph_moe_down_pg8(a, lds, 1, G); } SEAM(11);
    STAMP(13); PSTAMP(13);
    if (IN(13)) { ph_final(a, wk, G); }
#ifdef PROBE_K
    if (blockIdx.x == 0 && tid == 0) {
        asm volatile("s_waitcnt vmcnt(0)" ::: "memory");
        if (PROBE_K == 13) pkt[1] = __builtin_amdgcn_s_memrealtime();
        const unsigned long long tend = __builtin_amdgcn_s_memrealtime() + 4ull * (pkt[1] - pkt[0]);
        while (__builtin_amdgcn_s_memrealtime() < tend) __builtin_amdgcn_s_sleep(16);
    }
#endif
#undef IN
#undef SEAM
}

extern "C" void kernel_launch(void* const* d_in, const int* in_sizes, int n_in, void* d_out, int out_size, void* d_ws, size_t ws_size, hipStream_t stream) {
    static int grid = 0;
    if (grid == 0) {
        if (n_in != 31 || out_size != NB * SEQ * D || ws_size < WS_END) { fprintf(stderr, "kernel_launch: unexpected shapes (n_in %d out %d ws %zu)\n", n_in, out_size, ws_size); grid = -1; return; }
        int dev = 0, cus = 0;
        if (hipGetDevice(&dev) != hipSuccess || hipDeviceGetAttribute(&cus, hipDeviceAttributeMultiprocessorCount, dev) != hipSuccess) { grid = -1; return; }
        if (hipFuncSetAttribute((const void*)fwd_kernel, hipFuncAttributeMaxDynamicSharedMemorySize, LDS_BYTES) != hipSuccess) { grid = -1; return; }
        grid = cus;
    }
    if (grid < 0) return;
    (void)hipMemsetAsync((char*)d_ws + WS_CTL, 0, CTL_ZERO_BYTES, stream);
    Args a{};
    for (int i = 0; i < 31; ++i) a.in[i] = (const float*)d_in[i];
    a.out = (float*)d_out; a.ws = (unsigned char*)d_ws;
    if (N_LAUNCHES == 1) { a.ph_lo = 0; a.ph_hi = NPH; hipLaunchKernelGGL(fwd_kernel, dim3(grid), dim3(NWAVES * 64), LDS_BYTES, stream, a); }
    else for (int p = 0; p < NPH; ++p) { a.ph_lo = p; a.ph_hi = p + 1; hipLaunchKernelGGL(fwd_kernel, dim3(grid), dim3(NWAVES * 64), LDS_BYTES, stream, a); }
}
```

```cpp
#include <hip/hip_runtime.h>
#include <cstdio>
#include <cstdint>

#define GAS __attribute__((address_space(1)))
#define LAS __attribute__((address_space(3)))
typedef unsigned short bf16;
typedef short bf16x8 __attribute__((ext_vector_type(8)));
typedef float f32x4 __attribute__((ext_vector_type(4)));
typedef unsigned v4u __attribute__((ext_vector_type(4)));
typedef unsigned v2u __attribute__((ext_vector_type(2)));

#ifndef MK_N_LAUNCHES
#define MK_N_LAUNCHES 1
#endif
constexpr int NPH = 14;
constexpr int N_LAUNCHES = MK_N_LAUNCHES;

constexpr int NB = 8, SEQ = 2048, NMETA = 16, LSEQ = SEQ + NMETA, T = NB * LSEQ, D = 1024;
constexpr int PROJ_SRC = 4624, LDP = 4608;
constexpr int C_Z = 0, C_G = 1024, C_X = 2048, C_B = 3072, C_C = 3328, C_LI = 3584;
constexpr float EPS = 1e-6f;
constexpr int NBK = 24;

constexpr size_t MiB = 1u << 20;
constexpr size_t WS_CTL = 0, CTL_ZERO_BYTES = 1 * MiB;
constexpr size_t WS_WIN = 1 * MiB;
constexpr size_t WS_WOUT = 10 * MiB;
constexpr size_t WS_WPOOL = 14 * MiB;
constexpr size_t WS_WRT = 14 * MiB + 512 * 1024;
constexpr size_t WS_WDTT = 15 * MiB + 512 * 1024;
constexpr size_t WS_RSTD0 = 15 * MiB;
constexpr size_t WS_RSTD1 = WS_RSTD0 + 128 * 1024;
constexpr size_t WS_BKT = WS_RSTD1 + 128 * 1024;
constexpr size_t WS_GATES = WS_BKT + 128 * 1024;
constexpr size_t WS_DT = 16 * MiB;
constexpr size_t WS_SSDSQ = 17 * MiB + 64 * 1024;
constexpr size_t WS_LIST = 19 * MiB;
constexpr size_t WS_WGU = 21 * MiB;
constexpr size_t WS_WD = 53 * MiB;
constexpr size_t WS_H = 69 * MiB;
constexpr size_t WS_PROJ = 134 * MiB;
constexpr size_t WS_HID = WS_PROJ;
constexpr size_t WS_POOLED = WS_PROJ;
constexpr size_t WS_END = 280 * MiB;
constexpr size_t WS_WGU1 = WS_PROJ + 64 * MiB, WS_WD1 = WS_PROJ + 96 * MiB;
__host__ __device__ constexpr size_t ws_wgu(int L) { return L ? WS_WGU1 : WS_WGU; }
__host__ __device__ constexpr size_t ws_wd(int L) { return L ? WS_WD1 : WS_WD; }
constexpr size_t WS_SB = WS_H, WS_SC = WS_H + (size_t)T * D * 2;
static_assert(WS_H + (size_t)T * D * 4 <= WS_PROJ && WS_PROJ + (size_t)T * LDP * 2 <= WS_END, "ws map");
static_assert(WS_DT + (size_t)T * 16 * 4 <= WS_SSDSQ && WS_SSDSQ + (size_t)T * 16 * 4 <= WS_LIST && WS_LIST + (size_t)NBK * T * 4 <= WS_WGU, "ws map small");
constexpr int CW_CNT = 8192;
constexpr int CW_BAR = 4096;
constexpr int CW_RT = 16384;

constexpr int LDS_BYTES = 163840;
constexpr int NWAVES = 8;

struct Args { const float* in[31]; float* out; unsigned char* ws; int ph_lo, ph_hi; };
enum { I_X = 0, I_META, I_NORMF, I_MNE, I_WIN, I_SCW, I_SCB, I_DTB, I_ALOG, I_SD, I_SNORM, I_LCW, I_LCB, I_LWA, I_LBA, I_LWX, I_LBX, I_LLAM, I_WOUT,
       I_MNO, I_PW, I_PB, I_PS, I_FFN, I_RGW, I_RGB, I_REW, I_REB, I_EWG, I_EWU, I_EWD };

#define LDS_WAIT() asm volatile("s_waitcnt lgkmcnt(0)" ::: "memory")
__device__ __forceinline__ float bf2f(unsigned v) { return __uint_as_float(v << 16); }
__device__ __forceinline__ unsigned f2bf(float f) { unsigned u = __float_as_uint(f); return (u + 0x7fffu + ((u >> 16) & 1u)) >> 16; }
__device__ __forceinline__ unsigned pk2(float lo, float hi) { return f2bf(lo) | (f2bf(hi) << 16); }
__device__ __forceinline__ void unpack8v(const v4u r, f32x4& a, f32x4& b) {
    a[0] = __uint_as_float(r.x << 16); a[1] = __uint_as_float(r.x & 0xffff0000u); a[2] = __uint_as_float(r.y << 16); a[3] = __uint_as_float(r.y & 0xffff0000u);
    b[0] = __uint_as_float(r.z << 16); b[1] = __uint_as_float(r.z & 0xffff0000u); b[2] = __uint_as_float(r.w << 16); b[3] = __uint_as_float(r.w & 0xffff0000u);
}
__device__ __forceinline__ float wave_sum(float v) {
#pragma unroll
    for (int o = 1; o < 64; o <<= 1) v += __shfl_xor(v, o);
    return v;
}
__device__ __forceinline__ float rcp_f(float v) { return __builtin_amdgcn_rcpf(v); }
__device__ __forceinline__ float sigmoid_f(float v) { return rcp_f(1.f + __expf(-v)); }
__device__ __forceinline__ float silu_f(float v) { return v * rcp_f(1.f + __expf(-v)); }
__device__ __forceinline__ float softplus_f(float v) { return v > 20.f ? v : log1pf(__expf(v)); }
__device__ __forceinline__ float gelu_tanh_f(float v) { const float u2 = 1.5957691216057308f * (v + 0.044715f * v * v * v); return v * rcp_f(1.f + __expf(-u2)); }
__device__ __forceinline__ const float* h0_row(const Args& a, int row) {
    const int b = row / LSEQ, l = row - b * LSEQ;
    return l < NMETA ? a.in[I_META] + (size_t)l * D : a.in[I_X] + ((size_t)b * SEQ + (l - NMETA)) * D;
}

#define XB_TMO      128
#define XB_XCNT(j)  (256  + 64 * (j))
#define XB_XSUB(j)  (1280 + 64 * (j))
#define XB_XGEN(j)  (2304 + 64 * (j))
#define XB_TOP      3328
#define XB_TOPGEN   3392
#define XCD_BAR_WORDS 3456
#define XB_SPIN_CAP (1u << 18)
__device__ __forceinline__ unsigned xb_ld(unsigned* p)              { return __hip_atomic_load(p, __ATOMIC_RELAXED, __HIP_MEMORY_SCOPE_AGENT); }
__device__ __forceinline__ unsigned xb_add(unsigned* p, unsigned v) { return __hip_atomic_fetch_add(p, v, __ATOMIC_RELAXED, __HIP_MEMORY_SCOPE_AGENT); }
__device__ __forceinline__ unsigned xb_xcc_id() { return (unsigned)__builtin_amdgcn_s_getreg((3 << 11) | 20) & 0xFu; }
#define XB_SPIN(cond, bar) do { unsigned _sp = 0; while (cond) { __builtin_amdgcn_s_sleep(1); \
    if ((++_sp & 255u) == 0u) { if (xb_ld(&(bar)[XB_TMO])) break; if (_sp > XB_SPIN_CAP) { atomicAdd(&(bar)[XB_TMO], 1u); break; } } } } while (0)
struct XcdBarrier { unsigned* bar; unsigned x; volatile LAS unsigned* st; };
__device__ __forceinline__ XcdBarrier xcd_barrier_post(unsigned* bar, volatile LAS unsigned* st) {
    XcdBarrier b; b.bar = bar; b.x = xb_xcc_id(); b.st = st;
    if (threadIdx.x == 0) (void)xb_add(&bar[XB_XCNT(b.x)], 1u);
    return b;
}
__device__ __forceinline__ void xcd_barrier_complete(unsigned* bar, unsigned x, unsigned& nloc, unsigned& nx) {
    const unsigned G = gridDim.x * gridDim.y * gridDim.z;
    unsigned sum, cnt, mine, sp = 0u;
    for (;;) {
        sum = 0u; cnt = 0u; mine = 0u;
#pragma unroll
        for (unsigned j = 0; j < 16; ++j) { const unsigned c = xb_ld(&bar[XB_XCNT(j)]); sum += c; cnt += (c > 0u) ? 1u : 0u; mine = (j == x) ? c : mine; }
        if (sum == G) break;
        __builtin_amdgcn_s_sleep(1);
        if ((++sp & 255u) == 0u) { if (xb_ld(&bar[XB_TMO])) break; if (sp > XB_SPIN_CAP) { atomicAdd(&bar[XB_TMO], 1u); break; } }
    }
    nloc = mine > 0u ? mine : 1u; nx = cnt > 0u ? cnt : 1u;
}
__device__ __forceinline__ void xcd_barrier(const XcdBarrier& b) {
    asm volatile("s_waitcnt vmcnt(0)" ::: "memory");
    __syncthreads();
    if (threadIdx.x == 0) {
        unsigned* bar = b.bar;
        __builtin_amdgcn_s_waitcnt(0);
        unsigned nloc = b.st[0], nx = b.st[1];
        if (nloc == 0u) { xcd_barrier_complete(bar, b.x, nloc, nx); b.st[0] = nloc; b.st[1] = nx; }
        const unsigned old = xb_add(&bar[XB_XSUB(b.x)], 1u);
        const unsigned gen = old / nloc;
        if (old + 1u == (gen + 1u) * nloc) {
            __builtin_amdgcn_fence(__ATOMIC_RELEASE, "agent");
            asm volatile("s_waitcnt vmcnt(0)" ::: "memory");
            const unsigned og = xb_add(&bar[XB_TOP], 1u);
            const unsigned tg = og / nx;
            if (og + 1u == (tg + 1u) * nx) xb_add(&bar[XB_TOPGEN], 1u);
            else XB_SPIN(xb_ld(&bar[XB_TOPGEN]) == tg, bar);
            __builtin_amdgcn_fence(__ATOMIC_ACQUIRE, "agent");
            xb_add(&bar[XB_XGEN(b.x)], 1u);
            asm volatile("s_waitcnt vmcnt(0)" ::: "memory");
        } else {
            XB_SPIN(xb_ld(&bar[XB_XGEN(b.x)]) == gen, bar);
            __builtin_amdgcn_fence(__ATOMIC_ACQUIRE, "agent");
            asm volatile("s_waitcnt vmcnt(0)" ::: "memory");
        }
    }
    __syncthreads();
}

__device__ __forceinline__ void tr_item(const float* src, int ldsrc, const float* gain, bf16* dst, int lddst, LAS float* scr, int lane) {
    float tv[32];
#pragma unroll
    for (int i = 0; i < 32; ++i) { const int kk = 2 * i + (lane >> 5); tv[i] = src[(size_t)kk * ldsrc + (lane & 31)]; }
#pragma unroll
    for (int i = 0; i < 32; ++i) { const int kk = 2 * i + (lane >> 5); float v = tv[i]; if (gain) v *= gain[kk]; scr[kk * 33 + (lane & 31)] = v; }
    LDS_WAIT();
    const int c = lane & 7;
#pragma unroll
    for (int j = 0; j < 4; ++j) { const int n = (lane >> 3) + 8 * j; const LAS float* s = scr + (8 * c) * 33 + n;
        v4u o; o.x = pk2(s[0 * 33], s[1 * 33]); o.y = pk2(s[2 * 33], s[3 * 33]); o.z = pk2(s[4 * 33], s[5 * 33]); o.w = pk2(s[6 * 33], s[7 * 33]);
        *(v4u*)(dst + (size_t)n * lddst + 8 * c) = o; }
    LDS_WAIT();
}
__device__ __forceinline__ void convert_experts(const Args& a, int L, LAS float* scr, int gw, int NGW, int lane) {
    bf16* WGU = (bf16*)(a.ws + ws_wgu(L)); bf16* WD = (bf16*)(a.ws + ws_wd(L));
    const float* gain = a.in[I_FFN] + L * D;
    constexpr int I_GU = 16 * 16 * 16, I_DN = 16 * 8 * 32;
    for (int it = gw; it < 2 * I_GU + I_DN; it += NGW) {
        int r = it;
        if (r < 2 * I_GU) {
            const int up = r >= I_GU; if (up) r -= I_GU;
            const int e = r >> 8, kb = (r >> 4) & 15, nb = r & 15;
            const float* src = a.in[up ? I_EWU : I_EWG] + ((size_t)(L * 16 + e) * 1024 + kb * 64) * 512 + nb * 32;
            const int drow = e * 1024 + (nb >> 2) * 256 + (nb & 3) * 32 + (up ? 128 : 0);
            tr_item(src, 512, gain + kb * 64, WGU + (size_t)drow * 1024 + kb * 64, 1024, scr, lane);
        } else {
            r -= 2 * I_GU;
            const int e = r >> 8, kb = (r >> 5) & 7, nb = r & 31;
            const float* src = a.in[I_EWD] + ((size_t)(L * 16 + e) * 512 + kb * 64) * 1024 + nb * 32;
            tr_item(src, 1024, nullptr, WD + (size_t)(e * 1024 + nb * 32) * 512 + kb * 64, 512, scr, lane);
        }
    }
}
__device__ __forceinline__ void ph_prep(const Args& a, LAS unsigned char* lds, int wk, int nwk) {
    const int tid = threadIdx.x, lane = tid & 63, wave = __builtin_amdgcn_readfirstlane(tid >> 6);
    const int gw = wk * NWAVES + wave, NGW = nwk * NWAVES;
    LAS float* scr = (LAS float*)(lds + wave * 8448);
    bf16* WIN = (bf16*)(a.ws + WS_WIN); bf16* WOUT = (bf16*)(a.ws + WS_WOUT); bf16* WPOOL = (bf16*)(a.ws + WS_WPOOL);
    constexpr int I_IN = 16 * 144, I_OUT = 32 * 32, I_POOL = 4 * 4 * 8;
    for (int it = gw; it < I_IN + I_OUT + I_POOL; it += NGW) {
        int r = it;
        if (r < I_IN) { const int kb = r / 144, nb = r % 144, n0 = nb * 32;
            const int sc = n0 < 1024 ? n0 : (n0 < 2048 ? n0 - 1024 + 2576 : (n0 < 3584 ? n0 - 2048 + 1024 : n0 - 3584 + 3600));
            tr_item(a.in[I_WIN] + (size_t)(kb * 64) * PROJ_SRC + sc, PROJ_SRC, a.in[I_MNE] + kb * 64, WIN + (size_t)n0 * 1024 + kb * 64, 1024, scr, lane); continue; }
        r -= I_IN;
        if (r < I_OUT) { const int kb = r >> 5, nb = r & 31;
            tr_item(a.in[I_WOUT] + (size_t)(kb * 64) * 1024 + nb * 32, 1024, kb < 16 ? a.in[I_SNORM] + kb * 64 : nullptr, WOUT + (size_t)(nb * 32) * 2048 + kb * 64, 2048, scr, lane); continue; }
        r -= I_OUT;
        { const int g = r >> 5, kb = (r >> 3) & 3, nb = r & 7;
            tr_item(a.in[I_PW] + (size_t)g * 65536 + (size_t)(kb * 64) * 256 + nb * 32, 256, a.in[I_MNO] + g * 256 + kb * 64, WPOOL + (size_t)(g * 256 + nb * 32) * 256 + kb * 64, 256, scr, lane); }
    }
    {
        v4u* WRT = (v4u*)(a.ws + WS_WRT); v4u* WDTT = (v4u*)(a.ws + WS_WDTT);
        for (int i = wk * 512 + tid; i < 2 * 48 * 128 + 256 * 128; i += nwk * 512) {
            float f[8];
            if (i < 2 * 48 * 128) {
                const int L = i / 6144, r = i % 6144, n = r >> 7, k8 = (r & 127) * 8, j = n < 20 ? n : n - 20;
#pragma unroll
                for (int e = 0; e < 8; ++e) { const int k = k8 + e; float w = 0.f;
                    if (n < 40) { w = (j < 4 ? a.in[I_RGW][((size_t)L * 1024 + k) * 4 + j] : a.in[I_REW][((size_t)L * 1024 + k) * 16 + (j - 4)]) * a.in[I_FFN][L * 1024 + k];
                        if (n >= 20) w -= bf2f(f2bf(w)); }
                    f[e] = w; }
                v4u o; o.x = pk2(f[0], f[1]); o.y = pk2(f[2], f[3]); o.z = pk2(f[4], f[5]); o.w = pk2(f[6], f[7]); WRT[i] = o;
            } else {
                const int r = i - 2 * 48 * 128, n = r >> 7, k8 = (r & 127) * 8;
#pragma unroll
                for (int e = 0; e < 8; ++e) { const int k = k8 + e; f[e] = n < 16 ? a.in[I_WIN][(size_t)k * PROJ_SRC + 2560 + n] * a.in[I_MNE][k] : 0.f; }
                v4u o; o.x = pk2(f[0], f[1]); o.y = pk2(f[2], f[3]); o.z = pk2(f[4], f[5]); o.w = pk2(f[6], f[7]); WDTT[r] = o;
            }
        }
    }
    bf16* HB = (bf16*)a.out; float* RSTD0 = (float*)(a.ws + WS_RSTD0);
    for (int row = gw; row < T; row += NGW) {
        const f32x4* xr = (const f32x4*)h0_row(a, row) + lane;
        f32x4 v[4]; float ss = 0.f;
#pragma unroll
        for (int j = 0; j < 4; ++j) { v[j] = xr[64 * j]; ss += v[j].x * v[j].x + v[j].y * v[j].y + v[j].z * v[j].z + v[j].w * v[j].w; }
        ss = wave_sum(ss);
        v2u* o8 = (v2u*)(HB + (size_t)row * D) + lane;
#pragma unroll
        for (int j = 0; j < 4; ++j) { v2u w; w.x = pk2(v[j].x, v[j].y); w.y = pk2(v[j].z, v[j].w); o8[64 * j] = w; }
        if (lane == 0) RSTD0[row] = rsqrtf(ss * (1.f / D) + EPS);
    }
}

template <int NT, class BP, class KS>
__device__ __forceinline__ void sg_kloop(int K, const bf16* const (&arow)[4], BP bp, KS ks, f32x4 (&acc)[4][NT], int fr, int fq) {
    for (int k0 = 0; k0 < K; k0 += 32) {
        ks(k0, acc);
        bf16x8 av[4], bv[NT];
#pragma unroll
        for (int mi = 0; mi < 4; ++mi) av[mi] = *(const bf16x8*)(arow[mi] + k0 + 8 * fq);
#pragma unroll
        for (int nj = 0; nj < NT; ++nj) bv[nj] = *(const bf16x8*)(bp(16 * nj + fr, k0) + 8 * fq);
#pragma unroll
        for (int mi = 0; mi < 4; ++mi)
#pragma unroll
            for (int nj = 0; nj < NT; ++nj) acc[mi][nj] = __builtin_amdgcn_mfma_f32_16x16x32_bf16(bv[nj], av[mi], acc[mi][nj], 0, 0, 0);
    }
}
template <int NT> __device__ __forceinline__ void zero_acc(f32x4 (&acc)[4][NT]) {
#pragma unroll
    for (int mi = 0; mi < 4; ++mi)
#pragma unroll
        for (int nj = 0; nj < NT; ++nj) acc[mi][nj] = (f32x4){0.f, 0.f, 0.f, 0.f};
}
struct NoKS { template <int NT> __device__ __forceinline__ void operator()(int, f32x4 (&)[4][NT]) const {} };

__device__ __forceinline__ void ph_gemm1(const Args& a, int wk, int nwk) {
    const int tid = threadIdx.x, lane = tid & 63, wave = __builtin_amdgcn_readfirstlane(tid >> 6), fr = lane & 15, fq = lane >> 4;
    const int gw = wk * NWAVES + wave, NGW = nwk * NWAVES;
    const bf16* HB = (const bf16*)a.out; const bf16* WIN = (const bf16*)(a.ws + WS_WIN); bf16* PROJ = (bf16*)(a.ws + WS_PROJ);
    const float* RSTD0 = (const float*)(a.ws + WS_RSTD0);
    for (int u = gw; u < 258 * 72; u += NGW) {
        const int rt = u / 72, ct = u % 72;
        const bf16* arow[4];
#pragma unroll
        for (int mi = 0; mi < 4; ++mi) arow[mi] = HB + (size_t)(rt * 64 + 16 * mi + fr) * D;
        f32x4 acc[4][4]; zero_acc(acc);
        sg_kloop<4>(1024, arow, [=](int n, int k0) { return WIN + (size_t)(ct * 64 + n) * 1024 + k0; }, NoKS(), acc, fr, fq);
#pragma unroll
        for (int mi = 0; mi < 4; ++mi) { const int row = rt * 64 + 16 * mi + fr; const float rs = RSTD0[row];
#pragma unroll
            for (int nj = 0; nj < 4; ++nj) { const f32x4 v = acc[mi][nj] * rs; v2u w; w.x = pk2(v.x, v.y); w.y = pk2(v.z, v.w);
                *(v2u*)(PROJ + (size_t)row * LDP + ct * 64 + 16 * nj + 4 * fq) = w; } }
    }
}

__device__ __forceinline__ void ph_gemm2(const Args& a, int wk, int nwk) {
    const int tid = threadIdx.x, lane = tid & 63, wave = __builtin_amdgcn_readfirstlane(tid >> 6), fr = lane & 15, fq = lane >> 4;
    const int gw = wk * NWAVES + wave, NGW = nwk * NWAVES;
    const bf16* PROJ = (const bf16*)(a.ws + WS_PROJ); const bf16* WOUT = (const bf16*)(a.ws + WS_WOUT);
    const float* SSDSQ = (const float*)(a.ws + WS_SSDSQ);
    float* H = (float*)(a.ws + WS_H); bf16* HB = (bf16*)a.out;
    for (int u = gw; u < 258 * 16; u += NGW) {
        const int rt = u / 16, ct = u % 16;
        const bf16* arow[4]; float f0[4], f1[4];
#pragma unroll
        for (int mi = 0; mi < 4; ++mi) { const int row = rt * 64 + 16 * mi + fr; arow[mi] = PROJ + (size_t)row * LDP;
            const f32x4* sq = (const f32x4*)(SSDSQ + (size_t)row * 16); const f32x4 q0 = sq[0], q1 = sq[1], q2 = sq[2], q3 = sq[3];
            const float s0 = (q0.x + q0.y + q0.z + q0.w) + (q1.x + q1.y + q1.z + q1.w), s1 = (q2.x + q2.y + q2.z + q2.w) + (q3.x + q3.y + q3.z + q3.w);
            const float r0 = rsqrtf(s0 * (1.f / 512.f) + EPS), r1 = rsqrtf(s1 * (1.f / 512.f) + EPS);
            f0[mi] = r0 / r1; f1[mi] = r1; }
        f32x4 acc[4][4]; zero_acc(acc);
        auto ks = [=](int k0, f32x4 (&ac)[4][4]) {
            if (k0 == 512) {
#pragma unroll
                for (int mi = 0; mi < 4; ++mi)
#pragma unroll
                    for (int nj = 0; nj < 4; ++nj) ac[mi][nj] *= f0[mi]; }
            if (k0 == 1024) {
#pragma unroll
                for (int mi = 0; mi < 4; ++mi)
#pragma unroll
                    for (int nj = 0; nj < 4; ++nj) ac[mi][nj] *= f1[mi]; }
        };
        sg_kloop<4>(2048, arow, [=](int n, int k0) { return WOUT + (size_t)(ct * 64 + n) * 2048 + k0; }, ks, acc, fr, fq);
#pragma unroll
        for (int mi = 0; mi < 4; ++mi) { const int row = rt * 64 + 16 * mi + fr; const float* hr = h0_row(a, row);
#pragma unroll
            for (int nj = 0; nj < 4; ++nj) { const int c = ct * 64 + 16 * nj + 4 * fq; const f32x4 v = acc[mi][nj] + *(const f32x4*)(hr + c);
                *(f32x4*)(H + (size_t)row * D + c) = v; v2u w; w.x = pk2(v.x, v.y); w.y = pk2(v.z, v.w); *(v2u*)(HB + (size_t)row * D + c) = w; } }
    }
}


namespace pg8 {
constexpr int BM = 256, BK = 64, HALF = 128, HTB = HALF * BK * 2, STAGE_BYTES = 8 * HTB, NXCD = 8, WGM = 8;
__host__ __device__ __forceinline__ int lds_byte(int r, int c) { const int st = (r >> 4) * 2 + (c >> 5), rr = r & 15, cc = c & 31, ob = rr * 64 + cc * 2; return st * 1024 + (ob ^ (((ob >> 9) & 1) << 5)); }
__host__ __device__ __forceinline__ void stage_rc(int b, int& R, int& C) { const int st = b / 1024, sb = b % 1024, swz = sb ^ (((sb >> 9) & 1) << 5); R = (st >> 1) * 16 + swz / 64; C = (st & 1) * 32 + (swz % 64) / 2; }
__host__ __device__ __forceinline__ int perm32(int rho) { const int n = rho >> 4, i = rho & 15; return 8 * (i >> 2) + 4 * n + (i & 3); }
__device__ __forceinline__ unsigned cvt_pk_bf16(float lo, float hi) { unsigned r; asm volatile("v_cvt_pk_bf16_f32 %0, %1, %2" : "=v"(r) : "v"(lo), "v"(hi)); return r; }
typedef f32x4 Acc[2][2][4][2];

__device__ __forceinline__ bool static_order(int nM, int nN, int G, int c, int i, int& pm, int& pn) {
    const int nwg = nM * nN; const long L = (long)i * G + c; if (L >= nwg) return false;
    int wgid = (int)L; { const int q = nwg / NXCD, r = nwg % NXCD, xcd = wgid % NXCD, off = wgid / NXCD; wgid = (xcd < r ? xcd * (q + 1) : r * (q + 1) + (xcd - r) * q) + off; }
    const int nig = WGM * nN, gid = wgid / nig, fm = gid * WGM, gsz = (nM - fm) < WGM ? (nM - fm) : WGM;
    pm = fm + ((wgid % nig) % gsz); pn = (wgid % nig) / gsz; return true;
}

template <class P, bool ALIGN_EPI>
__device__ __forceinline__ void gemm_phase(LAS unsigned char* lds, const P& S) {
    const int tid = threadIdx.x, wid = __builtin_amdgcn_readfirstlane(tid >> 6), lane = tid & 63, wr = wid >> 2, wc = wid & 3, fr = lane & 15, fq = lane >> 4;
    const int nt = S.nt;
    int RA[2], CA[2]; unsigned voffB[2];
#pragma unroll
    for (int i = 0; i < 2; ++i) { int R, C; stage_rc(tid * 16 + i * 8192, R, C); RA[i] = R; CA[i] = C; const int Rb = P::PERM ? ((R & ~31) + perm32(R & 31)) : R;
        voffB[i] = (unsigned)(Rb * S.ldb + C) * 2u; }
    const size_t kstep = (size_t)(BK * 2);
    const size_t hstepB = (size_t)HALF * S.ldb * 2;
    const unsigned ldsw = (unsigned)wid * 1024u;
    const int aoff = lds_byte(wr * 64 + fr, fq * 8), boff = lds_byte(wc * 32 + fr, fq * 8);
#define PG8_SA(b, h) (((b) * 2 + (h)) * HTB)
#define PG8_SB(b, h) ((4 + (b) * 2 + (h)) * HTB)
#define PG8_STAGE(bufoff, gbase, voff) do { _Pragma("unroll") for (int _i = 0; _i < 2; ++_i) \
        __builtin_amdgcn_global_load_lds((const unsigned*)((const char*)(gbase) + (voff)[_i]), (LAS unsigned*)(lds + (bufoff) + ldsw + _i * 8192), 16, 0, 0); } while (0)
#define PG8_LDA(dst, b, h) do { _Pragma("unroll") for (int m = 0; m < 4; ++m) _Pragma("unroll") for (int k = 0; k < 2; ++k) dst[m][k] = *(const LAS bf16x8*)(lds + PG8_SA(b, h) + aoff + m * 2048 + k * 1024); } while (0)
#define PG8_LDB(dst, b, h) do { _Pragma("unroll") for (int n = 0; n < 2; ++n) _Pragma("unroll") for (int k = 0; k < 2; ++k) dst[n][k] = *(const LAS bf16x8*)(lds + PG8_SB(b, h) + boff + n * 2048 + k * 1024); } while (0)
#define PG8_MMA(ai, bj, At, Bt) do { __builtin_amdgcn_s_setprio(1); _Pragma("unroll") for (int m = 0; m < 4; ++m) _Pragma("unroll") for (int n = 0; n < 2; ++n) _Pragma("unroll") for (int k = 0; k < 2; ++k) \
        acc[ai][bj][m][n] = __builtin_amdgcn_mfma_f32_16x16x32_bf16(Bt[n][k], At[m][k], acc[ai][bj][m][n], 0, 0, 0); __builtin_amdgcn_s_setprio(0); } while (0)
#define PG8_WAIT_V(n) asm volatile("s_waitcnt vmcnt(" #n ")" ::: "memory")
#define PG8_WAIT_L(n) asm volatile("s_waitcnt lgkmcnt(" #n ")" ::: "memory")
#define PG8_BAR __builtin_amdgcn_s_barrier()
#define PG8_SCHED __builtin_amdgcn_sched_barrier(0)
    typename P::Unit cur, nxt; int ui = 0;
    if (!S.next(0, cur)) return;
    f32x4 acc[2][2][4][2];
#pragma unroll
    for (int a = 0; a < 2; ++a)
#pragma unroll
        for (int b = 0; b < 2; ++b)
#pragma unroll
            for (int m = 0; m < 4; ++m)
#pragma unroll
                for (int n = 0; n < 2; ++n) acc[a][b][m][n] = (f32x4){0.f, 0.f, 0.f, 0.f};
    bf16x8 At[4][2], B0[2][2], B1[2][2];
    unsigned vA[4];
    S.a_ready(cur);
    S.avoff(cur, RA, CA, vA);
    const char* cA = S.abase(cur);
    {
        const char* b0 = S.btile(cur, 0); const char* b1 = S.btile(cur, 1);
        PG8_STAGE(PG8_SB(0, 0), b0, voffB); PG8_STAGE(PG8_SB(0, 1), b0 + hstepB, voffB); PG8_STAGE(PG8_SA(0, 0), cA, vA); PG8_STAGE(PG8_SA(0, 1), cA, vA + 2);
        if (wr == 1) PG8_BAR;
        PG8_WAIT_V(2); PG8_BAR;
        PG8_STAGE(PG8_SB(1, 0), b1, voffB); PG8_STAGE(PG8_SA(1, 0), cA + kstep, vA); PG8_STAGE(PG8_SB(1, 1), b1 + hstepB, voffB);
        PG8_WAIT_V(6); PG8_BAR;
    }
    for (;;) {
        const bool has_next = S.next(ui + 1, nxt);
        for (int t = 0; t < nt; t += 2) {
            const bool last = (t == nt - 2);
            const char* a1 = cA + (size_t)(t + 1) * kstep;
            S.khook(t, acc, cur, lds, wr, wc, fr, fq);
            PG8_LDB(B0, 0, 0); PG8_LDB(B1, 0, 1); PG8_SCHED; PG8_LDA(At, 0, 0); PG8_STAGE(PG8_SA(1, 1), a1, vA + 2);
            PG8_WAIT_V(8); PG8_WAIT_L(0); PG8_BAR; PG8_MMA(0, 0, At, B0); PG8_MMA(0, 1, At, B1); PG8_BAR; PG8_SCHED;
            const bool sw = last && has_next;
            if (sw) { S.a_ready(nxt); S.avoff(nxt, RA, CA, vA); }
            const char* a2 = last ? (sw ? S.abase(nxt) : cA) : cA + (size_t)(t + 2) * kstep;
            const char* b2 = last ? (sw ? S.btile(nxt, 0) : S.btile(cur, 0)) : S.btile(cur, t + 2);
            const char* b3 = last ? (sw ? S.btile(nxt, 1) : S.btile(cur, 1)) : S.btile(cur, t + 3);
            const char* a3 = a2 + kstep;
            PG8_LDA(At, 0, 1); PG8_STAGE(PG8_SB(0, 0), b2, voffB); PG8_STAGE(PG8_SB(0, 1), b2 + hstepB, voffB); PG8_STAGE(PG8_SA(0, 0), a2, vA);
            PG8_WAIT_V(8); PG8_WAIT_L(0); PG8_BAR; PG8_MMA(1, 0, At, B0); PG8_MMA(1, 1, At, B1); PG8_BAR; PG8_SCHED;
            PG8_LDB(B0, 1, 0); PG8_LDB(B1, 1, 1); PG8_SCHED; PG8_LDA(At, 1, 0); PG8_STAGE(PG8_SA(0, 1), a2, vA + 2);
            PG8_WAIT_V(8); PG8_WAIT_L(0); PG8_BAR; PG8_MMA(0, 0, At, B0); PG8_MMA(0, 1, At, B1); PG8_BAR; PG8_SCHED;
            PG8_LDA(At, 1, 1); PG8_STAGE(PG8_SB(1, 0), b3, voffB); PG8_STAGE(PG8_SB(1, 1), b3 + hstepB, voffB); PG8_STAGE(PG8_SA(1, 0), a3, vA);
            PG8_WAIT_V(8); PG8_WAIT_L(0); PG8_BAR; PG8_MMA(1, 0, At, B0); PG8_MMA(1, 1, At, B1); PG8_BAR; PG8_SCHED;
        }
        if constexpr (ALIGN_EPI) { if (wr == 0) PG8_BAR; }
        S.epi(acc, cur, wr, wc, fr, fq);
        S.done(cur);
        if (!has_next) break;
#pragma unroll
        for (int a = 0; a < 2; ++a)
#pragma unroll
            for (int b = 0; b < 2; ++b)
#pragma unroll
                for (int m = 0; m < 4; ++m)
#pragma unroll
                    for (int n = 0; n < 2; ++n) acc[a][b][m][n] = (f32x4){0.f, 0.f, 0.f, 0.f};
        cur = nxt; cA = S.abase(cur); ++ui;
        if constexpr (ALIGN_EPI) { if (wr == 1) PG8_BAR; }
    }
    PG8_WAIT_V(0);
    if constexpr (!ALIGN_EPI) { if (wr == 0) PG8_BAR; }
    PG8_BAR;
#undef PG8_SA
#undef PG8_SB
#undef PG8_STAGE
#undef PG8_LDA
#undef PG8_LDB
#undef PG8_MMA
#undef PG8_WAIT_V
#undef PG8_WAIT_L
#undef PG8_BAR
#undef PG8_SCHED
}
}

struct PGemm1 {
    static constexpr bool PERM = true;
    struct Unit { int pm, pn; };
    const char* A; const char* B; const char* Bdt; bf16* O; const float* rstd; float* DT; const float* dtb; int G, c; int ldb, nt;
    __device__ __forceinline__ bool next(int i, Unit& u) const { return pg8::static_order(65, 19, G, c, i, u.pm, u.pn); }
    __device__ __forceinline__ void avoff(const Unit& u, const int (&RA)[2], const int (&CA)[2], unsigned (&v)[4]) const {
#pragma unroll
        for (int h = 0; h < 2; ++h)
#pragma unroll
            for (int i = 0; i < 2; ++i) { int row = u.pm * 256 + h * 128 + RA[i]; row = row < T ? row : T - 1; v[h * 2 + i] = (unsigned)(row * D + CA[i]) * 2u; }
    }
    __device__ __forceinline__ const char* abase(const Unit&) const { return A; }
    __device__ __forceinline__ const char* btile(const Unit& u, int t) const { return (u.pn < 18 ? B + (size_t)u.pn * 256 * 1024 * 2 : Bdt) + (size_t)t * 64 * 2; }
    __device__ __forceinline__ void khook(int, pg8::Acc&, const Unit&, LAS unsigned char*, int, int, int, int) const {}
    __device__ __forceinline__ void a_ready(const Unit&) const {}
    __device__ __forceinline__ void done(const Unit&) const {}
    __device__ __forceinline__ void epi(const pg8::Acc& acc, const Unit& u, int wr, int wc, int fr, int fq) const {
        const int row0 = u.pm * 256 + wr * 64 + fr, col0 = u.pn * 256 + wc * 32 + 8 * fq;
        float rsv[2][4];
#pragma unroll
        for (int ai = 0; ai < 2; ++ai)
#pragma unroll
            for (int m = 0; m < 4; ++m) { const int row = row0 + ai * 128 + m * 16; rsv[ai][m] = rstd[row < T ? row : T - 1]; }
        if (u.pn == 18) {
            if (wc == 0 && fq < 2) { const f32x4 b0 = *(const f32x4*)(dtb + 8 * fq), b1 = *(const f32x4*)(dtb + 8 * fq + 4);
#pragma unroll
                for (int ai = 0; ai < 2; ++ai)
#pragma unroll
                    for (int m = 0; m < 4; ++m) { const int row = row0 + ai * 128 + m * 16;
                        if (row < T) { const float rs = rsv[ai][m]; f32x4 d0 = acc[ai][0][m][0] * rs + b0, d1 = acc[ai][0][m][1] * rs + b1;
#pragma unroll
                            for (int j = 0; j < 4; ++j) { d0[j] = softplus_f(d0[j]); d1[j] = softplus_f(d1[j]); }
                            *(f32x4*)(DT + (size_t)row * 16 + 8 * fq) = d0; *(f32x4*)(DT + (size_t)row * 16 + 8 * fq + 4) = d1; } } }
            return; }
#pragma unroll
        for (int ai = 0; ai < 2; ++ai)
#pragma unroll
            for (int m = 0; m < 4; ++m) { const int row = row0 + ai * 128 + m * 16;
                if (row < T) { const float rs = rsv[ai][m]; bf16* rowp = O + (size_t)row * LDP + col0;
#pragma unroll
                    for (int bj = 0; bj < 2; ++bj) { const f32x4 v0 = acc[ai][bj][m][0] * rs, v1 = acc[ai][bj][m][1] * rs;
                        v4u w; w.x = pg8::cvt_pk_bf16(v0[0], v0[1]); w.y = pg8::cvt_pk_bf16(v0[2], v0[3]); w.z = pg8::cvt_pk_bf16(v1[0], v1[1]); w.w = pg8::cvt_pk_bf16(v1[2], v1[3]);
                        *(v4u*)(rowp + bj * 128) = w; } } }
    }
};
__device__ __forceinline__ void ph_gemm1_pg8(const Args& a, LAS unsigned char* lds, int G) {
    PGemm1 S; S.A = (const char*)a.out; S.B = (const char*)(a.ws + WS_WIN); S.O = (bf16*)(a.ws + WS_PROJ); S.rstd = (const float*)(a.ws + WS_RSTD0); S.Bdt = (const char*)(a.ws + WS_WDTT); S.DT = (float*)(a.ws + WS_DT); S.dtb = a.in[I_DTB];
    S.G = G; S.c = (int)blockIdx.x; S.ldb = 1024; S.nt = 16;
    pg8::gemm_phase<PGemm1, true>(lds, S);
}

__device__ __forceinline__ void ssd_item(const Args& a, LAS unsigned char* lds, int b, int h) {
    const int tid = threadIdx.x, lane = tid & 63;
    constexpr int TB = 64;
    LAS float* xs = (LAS float*)lds;
    LAS float* Bs = xs + TB * 64;
    LAS float* Cs = Bs + TB * 128;
    LAS float* ys = Cs + TB * 128;
    LAS float* dts = ys + TB * 64;
    LAS float* decs = dts + TB;
    bf16* PROJ = (bf16*)(a.ws + WS_PROJ); const float* DT = (const float*)(a.ws + WS_DT); float* SSDSQ = (float*)(a.ws + WS_SSDSQ);
    const int g = h >> 3;
    const float Ah = -__expf(a.in[I_ALOG][h]), Dh = a.in[I_SD][h];
    int ccol = 0, cch = 0; float cw0 = 0.f, cw1 = 0.f, cw2 = 0.f, cw3 = 0.f, cb = 0.f;
    if (tid < 320) {
        if (tid < 64) { ccol = C_X + h * 64 + tid; cch = h * 64 + tid; }
        else if (tid < 192) { ccol = C_B + g * 128 + (tid - 64); cch = 1024 + g * 128 + (tid - 64); }
        else { ccol = C_C + g * 128 + (tid - 192); cch = 1280 + g * 128 + (tid - 192); }
        const float* cw = a.in[I_SCW]; cw0 = cw[cch]; cw1 = cw[1536 + cch]; cw2 = cw[2 * 1536 + cch]; cw3 = cw[3 * 1536 + cch]; cb = a.in[I_SCB][cch];
    }
    const int p = tid >> 3, nq = tid & 7;
    float S[16];
#pragma unroll
    for (int i = 0; i < 16; ++i) S[i] = 0.f;
    const size_t rbase = (size_t)b * LSEQ;
    for (int l0 = 0; l0 < LSEQ; l0 += TB) {
        const int nt = (LSEQ - l0) < TB ? (LSEQ - l0) : TB;
        __syncthreads();
        if (tid < 320) {
            float r0 = l0 >= 3 ? bf2f(PROJ[(rbase + l0 - 3) * LDP + ccol]) : 0.f, r1 = l0 >= 2 ? bf2f(PROJ[(rbase + l0 - 2) * LDP + ccol]) : 0.f, r2 = l0 >= 1 ? bf2f(PROJ[(rbase + l0 - 1) * LDP + ccol]) : 0.f;
            for (int t = 0; t < nt; ++t) {
                const float r3 = bf2f(PROJ[(rbase + l0 + t) * LDP + ccol]);
                const float v = silu_f(cw0 * r0 + cw1 * r1 + cw2 * r2 + cw3 * r3 + cb);
                if (tid < 64) xs[t * 64 + tid] = v; else if (tid < 192) Bs[t * 128 + tid - 64] = v; else Cs[t * 128 + tid - 192] = v;
                r0 = r1; r1 = r2; r2 = r3;
            }
        } else if (tid < 320 + TB) {
            const int t = tid - 320;
            if (t < nt) { const float dt = DT[(rbase + l0 + t) * 16 + h]; dts[t] = dt; decs[t] = __expf(Ah * dt); }
        }
        __syncthreads();
        for (int t = 0; t < nt; ++t) {
            const float xv = xs[t * 64 + p], xdt = xv * dts[t], dec = decs[t];
            float yp = 0.f;
#pragma unroll
            for (int i = 0; i < 16; ++i) { S[i] = dec * S[i] + Bs[t * 128 + nq * 16 + i] * xdt; yp += Cs[t * 128 + nq * 16 + i] * S[i]; }
            yp += __shfl_xor(yp, 1); yp += __shfl_xor(yp, 2); yp += __shfl_xor(yp, 4);
            if (nq == 0) ys[t * 64 + p] = yp + Dh * xv;
        }
        __syncthreads();
        for (int t = tid >> 6; t < nt; t += 8) {
            const size_t row = rbase + l0 + t;
            const float z = bf2f(PROJ[row * LDP + C_Z + h * 64 + lane]);
            const float yg = ys[t * 64 + lane] * silu_f(z);
            PROJ[row * LDP + C_Z + h * 64 + lane] = (bf16)f2bf(yg);
            const float sq = wave_sum(yg * yg);
            if (lane == 0) SSDSQ[row * 16 + h] = sq;
        }
    }
    __syncthreads();
}
__device__ __forceinline__ void lru_item(const Args& a, LAS unsigned char* lds, int b, int h) {
    const int tid = threadIdx.x;
    constexpr int TB = 64;
    LAS float* Wa = (LAS float*)lds;
    LAS float* Wx = Wa + 4096;
    LAS float* xb = Wx + 4096;
    LAS float* as = xb + TB * 64;
    LAS float* us = as + TB * 64;
    bf16* PROJ = (bf16*)(a.ws + WS_PROJ);
    __syncthreads();
    for (int i = tid; i < 4096; i += 512) { Wa[i] = a.in[I_LWA][(size_t)h * 4096 + i]; Wx[i] = a.in[I_LWX][(size_t)h * 4096 + i]; }
    const size_t rbase = (size_t)b * LSEQ;
    float hprev = 0.f;
    const int c = tid & 63, tq = tid >> 6;
    const float* cw = a.in[I_LCW]; const int ch = h * 64 + c;
    const float cw0 = cw[ch], cw1 = cw[1024 + ch], cw2 = cw[2048 + ch], cw3 = cw[3072 + ch], cb = a.in[I_LCB][ch];
    const int gt = tid >> 3, jq = tid & 7;
    for (int l0 = 0; l0 < LSEQ; l0 += TB) {
        const int nt = (LSEQ - l0) < TB ? (LSEQ - l0) : TB;
        __syncthreads();
        for (int t = tq * 8; t < tq * 8 + 8; ++t) if (t < nt) {
            const int l = l0 + t; const size_t row = rbase + l;
            const float r3 = bf2f(PROJ[row * LDP + C_LI + ch]);
            const float r2 = l >= 1 ? bf2f(PROJ[(row - 1) * LDP + C_LI + ch]) : 0.f;
            const float r1 = l >= 2 ? bf2f(PROJ[(row - 2) * LDP + C_LI + ch]) : 0.f;
            const float r0 = l >= 3 ? bf2f(PROJ[(row - 3) * LDP + C_LI + ch]) : 0.f;
            xb[t * 64 + c] = cw0 * r0 + cw1 * r1 + cw2 * r2 + cw3 * r3 + cb;
        }
        __syncthreads();
        if (gt < nt) {
            float ra[8], ri[8];
#pragma unroll
            for (int j = 0; j < 8; ++j) { ra[j] = 0.f; ri[j] = 0.f; }
            for (int i = 0; i < 64; ++i) { const float xv = xb[gt * 64 + i];
#pragma unroll
                for (int j = 0; j < 8; ++j) { ra[j] += xv * Wa[i * 64 + jq * 8 + j]; ri[j] += xv * Wx[i * 64 + jq * 8 + j]; } }
#pragma unroll
            for (int j = 0; j < 8; ++j) { const int cc = h * 64 + jq * 8 + j;
                const float r = sigmoid_f(ra[j] + a.in[I_LBA][cc]), ig = sigmoid_f(ri[j] + a.in[I_LBX][cc]);
                const float log_a = -8.0f * r * softplus_f(-a.in[I_LLAM][cc]);
                const float av = __expf(log_a);
                const float mult = (l0 + gt == 0) ? 1.f : sqrtf(fmaxf(-expm1f(2.f * log_a), 0.f));
                as[gt * 64 + jq * 8 + j] = av; us[gt * 64 + jq * 8 + j] = mult * ig * xb[gt * 64 + jq * 8 + j]; }
        }
        __syncthreads();
        if (tid < 64) { for (int t = 0; t < nt; ++t) { hprev = as[t * 64 + tid] * hprev + us[t * 64 + tid]; us[t * 64 + tid] = hprev; } }
        __syncthreads();
        for (int t = tq * 8; t < tq * 8 + 8; ++t) if (t < nt) {
            const size_t row = rbase + l0 + t;
            const float gv = bf2f(PROJ[row * LDP + C_G + ch]);
            PROJ[row * LDP + C_G + ch] = (bf16)f2bf(us[t * 64 + c] * gelu_tanh_f(gv));
        }
    }
    __syncthreads();
}
__device__ __forceinline__ void ph_mixers(const Args& a, LAS unsigned char* lds, int wk, int nwk) {
    for (int it = wk; it < 256; it += nwk) {
        if (it < 128) ssd_item(a, lds, it >> 4, it & 15); else lru_item(a, lds, (it - 128) >> 4, (it - 128) & 15);
    }
}


__device__ __forceinline__ f32x4 mfma16(bf16x8 a, bf16x8 b, f32x4 c) { return __builtin_amdgcn_mfma_f32_16x16x32_bf16(a, b, c, 0, 0, 0); }
constexpr int RSX = 144, RSB = 272;
constexpr int SO_X = 0, SO_B = SO_X + 128 * RSX, SO_C = SO_B + 128 * RSB, SO_M = SO_C + 128 * RSB, SO_S = SO_M + 128 * RSB, SO_V = SO_S + 64 * RSB;
static_assert(SO_V + 4096 <= LDS_BYTES - 256, "ssd lds");
#define TR4(RS4, o0, o1, o2, o3, addr) do { v2u l0_, h0_, l1_, h1_, l2_, h2_, l3_, h3_; \
    asm volatile("ds_read_b64_tr_b16 %0, %8\n\tds_read_b64_tr_b16 %1, %8 offset:" #RS4 "\n\t" \
                 "ds_read_b64_tr_b16 %2, %8 offset:32\n\tds_read_b64_tr_b16 %3, %8 offset:" #RS4 "+32\n\t" \
                 "ds_read_b64_tr_b16 %4, %8 offset:64\n\tds_read_b64_tr_b16 %5, %8 offset:" #RS4 "+64\n\t" \
                 "ds_read_b64_tr_b16 %6, %8 offset:96\n\tds_read_b64_tr_b16 %7, %8 offset:" #RS4 "+96\n\ts_waitcnt lgkmcnt(0)" \
                 : "=&v"(l0_), "=&v"(h0_), "=&v"(l1_), "=&v"(h1_), "=&v"(l2_), "=&v"(h2_), "=&v"(l3_), "=&v"(h3_) : "v"(addr) : "memory"); \
    o0 = __builtin_bit_cast(bf16x8, (v4u){l0_.x, l0_.y, h0_.x, h0_.y}); o1 = __builtin_bit_cast(bf16x8, (v4u){l1_.x, l1_.y, h1_.x, h1_.y}); \
    o2 = __builtin_bit_cast(bf16x8, (v4u){l2_.x, l2_.y, h2_.x, h2_.y}); o3 = __builtin_bit_cast(bf16x8, (v4u){l3_.x, l3_.y, h3_.x, h3_.y}); } while (0)
#define TR1(RS4, o0, addr) do { v2u l0_, h0_; \
    asm volatile("ds_read_b64_tr_b16 %0, %2\n\tds_read_b64_tr_b16 %1, %2 offset:" #RS4 "\n\ts_waitcnt lgkmcnt(0)" : "=&v"(l0_), "=&v"(h0_) : "v"(addr) : "memory"); \
    o0 = __builtin_bit_cast(bf16x8, (v4u){l0_.x, l0_.y, h0_.x, h0_.y}); } while (0)
__device__ __forceinline__ void unpack8(const v4u r, float (&f)[8]) {
    f[0] = __uint_as_float(r.x << 16); f[1] = __uint_as_float(r.x & 0xffff0000u); f[2] = __uint_as_float(r.y << 16); f[3] = __uint_as_float(r.y & 0xffff0000u);
    f[4] = __uint_as_float(r.z << 16); f[5] = __uint_as_float(r.z & 0xffff0000u); f[6] = __uint_as_float(r.w << 16); f[7] = __uint_as_float(r.w & 0xffff0000u);
}
__device__ __forceinline__ void ph_conv(const Args& a, int wk, int nwk) {
    const bf16* PROJ = (const bf16*)(a.ws + WS_PROJ); bf16* XACT = (bf16*)(a.ws + WS_H);
    for (int id = wk * 512 + (int)threadIdx.x; id < NB * 48 * 192; id += nwk * 512) {
        const int cg = id % 192, rr = id / 192, b = rr / 48, t0 = (rr % 48) * 43;
        const int ch = cg * 8;
        const float* cwp = a.in[I_SCW] + ch;
        float cw[4][8], cb[8];
#pragma unroll
        for (int k = 0; k < 4; ++k) { const f32x4 wa = *(const f32x4*)(cwp + k * 1536), wb = *(const f32x4*)(cwp + k * 1536 + 4);
#pragma unroll
            for (int j = 0; j < 4; ++j) { cw[k][j] = wa[j]; cw[k][4 + j] = wb[j]; } }
        { const float* cbp = a.in[I_SCB] + ch; const f32x4 wa = *(const f32x4*)cbp, wb = *(const f32x4*)(cbp + 4);
#pragma unroll
          for (int j = 0; j < 4; ++j) { cb[j] = wa[j]; cb[4 + j] = wb[j]; } }
        const size_t rb = (size_t)b * LSEQ;
        const bf16* src = PROJ + rb * LDP + 2048 + cg * 8;
        bf16* dst = XACT + rb * 1536 + ch;
        float p0[8], p1[8], p2[8];
        {   v4u q0 = (v4u){0u, 0u, 0u, 0u}, q1 = q0, q2 = q0;
            if (t0 >= 3) { q0 = *(const v4u*)(src + (size_t)(t0 - 3) * LDP); q1 = *(const v4u*)(src + (size_t)(t0 - 2) * LDP); q2 = *(const v4u*)(src + (size_t)(t0 - 1) * LDP); }
            unpack8(q0, p0); unpack8(q1, p1); unpack8(q2, p2); }
#pragma unroll 4
        for (int t = 0; t < 43; ++t) {
            const int l = t0 + t; float p3[8]; unpack8(*(const v4u*)(src + (size_t)l * LDP), p3);
            float o[8];
#pragma unroll
            for (int j = 0; j < 8; ++j) { o[j] = silu_f(cw[0][j] * p0[j] + cw[1][j] * p1[j] + cw[2][j] * p2[j] + cw[3][j] * p3[j] + cb[j]); p0[j] = p1[j]; p1[j] = p2[j]; p2[j] = p3[j]; }
            v4u ov; ov.x = pk2(o[0], o[1]); ov.y = pk2(o[2], o[3]); ov.z = pk2(o[4], o[5]); ov.w = pk2(o[6], o[7]);
            *(v4u*)(dst + (size_t)l * 1536) = ov;
        }
    }
}
__device__ __forceinline__ void ssd_item3(const Args& a, LAS unsigned char* lds, int b, int h) {
    const int tid = threadIdx.x, lane = tid & 63, w = __builtin_amdgcn_readfirstlane(tid >> 6), fr0 = lane & 15, fq0 = lane >> 4;
    bf16* PROJ = (bf16*)(a.ws + WS_PROJ); const bf16* XACT = (const bf16*)(a.ws + WS_H); const float* DT = (const float*)(a.ws + WS_DT); float* SSDSQ = (float*)(a.ws + WS_SSDSQ);
    const int g = h >> 3;
    const float Ah = -__expf(a.in[I_ALOG][h]), Dh = a.in[I_SD][h];
    LAS float* acs = (LAS float*)(lds + SO_V); LAS float* dtv = acs + 128; LAS float* wv = acs + 256; LAS float* eacs = acs + 384;
    const size_t rbase = (size_t)b * LSEQ;
    const int pt_s = w & 3, nh = w >> 2;
    f32x4 sacc[4];
#pragma unroll
    for (int i = 0; i < 4; ++i) sacc[i] = (f32x4){0.f, 0.f, 0.f, 0.f};
    __syncthreads();
    for (int i = tid; i < 64 * RSB / 4; i += 512) ((LAS unsigned*)(lds + SO_S))[i] = 0u;
    v4u pf[10], zp[2]; float d0 = 0.f, d1 = 0.f;
    const int ft = tid >> 2, q4 = tid & 3;
    const int xr_ = tid >> 3, xp_ = tid & 7, br_ = tid >> 4, bp_ = tid & 15;
    const bf16* xsrc = XACT + (rbase + xr_) * 1536 + h * 64 + xp_ * 8;
    const bf16* bsrc = XACT + (rbase + br_) * 1536 + 1024 + g * 128 + bp_ * 8;
#define SSD_PREFETCH(L0) do { const int l0_ = (L0); \
        _Pragma("unroll") for (int i = 0; i < 2; ++i) { pf[i] = (v4u){0u, 0u, 0u, 0u}; if (l0_ + xr_ + 64 * i < LSEQ) pf[i] = *(const v4u*)(xsrc + (size_t)(l0_ + 64 * i) * 1536); } \
        _Pragma("unroll") for (int i = 0; i < 4; ++i) { pf[2 + i] = (v4u){0u, 0u, 0u, 0u}; pf[6 + i] = (v4u){0u, 0u, 0u, 0u}; \
            if (l0_ + br_ + 32 * i < LSEQ) { pf[2 + i] = *(const v4u*)(bsrc + (size_t)(l0_ + 32 * i) * 1536); pf[6 + i] = *(const v4u*)(bsrc + (size_t)(l0_ + 32 * i) * 1536 + 256); } } \
        zp[0] = (v4u){0u, 0u, 0u, 0u}; zp[1] = zp[0]; \
        if (l0_ + ft < LSEQ) { const bf16* zq = PROJ + (rbase + l0_ + ft) * LDP + C_Z + h * 64 + 16 * q4; zp[0] = *(const v4u*)zq; zp[1] = *(const v4u*)(zq + 8); } \
        if (w == 0) { d0 = (l0_ + lane) < LSEQ ? DT[(rbase + l0_ + lane) * 16 + h] : 0.f; d1 = (l0_ + lane + 64) < LSEQ ? DT[(rbase + l0_ + lane + 64) * 16 + h] : 0.f; } } while (0)
    SSD_PREFETCH(0);
    for (int l0 = 0; l0 < LSEQ; l0 += 128) {
        const int nvalid = (LSEQ - l0) < 128 ? (LSEQ - l0) : 128;
        int fr = fr0, fq = fq0; asm volatile("" : "+v"(fr), "+v"(fq));
#pragma unroll
        for (int i = 0; i < 2; ++i) *(LAS v4u*)(lds + SO_X + (xr_ + 64 * i) * RSX + xp_ * 16) = pf[i];
#pragma unroll
        for (int i = 0; i < 4; ++i) { *(LAS v4u*)(lds + SO_B + (br_ + 32 * i) * RSB + bp_ * 16) = pf[2 + i]; *(LAS v4u*)(lds + SO_C + (br_ + 32 * i) * RSB + bp_ * 16) = pf[6 + i]; }
        const v4u z0 = zp[0], z1 = zp[1];
        if (w == 0) {
            float a0 = Ah * d0, a1 = Ah * d1;
#pragma unroll
            for (int o = 1; o < 64; o <<= 1) { const float v0 = __shfl_up(a0, o), v1 = __shfl_up(a1, o); if (lane >= o) { a0 += v0; a1 += v1; } }
            a1 += __shfl(a0, 63);
            const float aend = __shfl(a1, 63);
            acs[lane] = a0; acs[lane + 64] = a1; dtv[lane] = d0; dtv[lane + 64] = d1;
            wv[lane] = __expf(aend - a0) * d0; wv[lane + 64] = __expf(aend - a1) * d1; eacs[lane] = __expf(a0); eacs[lane + 64] = __expf(a1);
            if (lane == 0) acs[512] = aend;
        }
        __syncthreads();
        if (l0 + 128 < LSEQ) SSD_PREFETCH(l0 + 128);
        for (int hh = 0; hh < 2; ++hh) {
            f32x4 gacc[4];
#pragma unroll
            for (int st = 0; st < 4; ++st) gacc[st] = (f32x4){0.f, 0.f, 0.f, 0.f};
#pragma unroll
            for (int k0 = 0; k0 < 128; k0 += 32) {
                const bf16x8 cf = *(const LAS bf16x8*)(lds + SO_C + (16 * w + fr) * RSB + (k0 + 8 * fq) * 2);
                bf16x8 bfv[4];
#pragma unroll
                for (int st = 0; st < 4; ++st) bfv[st] = *(const LAS bf16x8*)(lds + SO_B + (16 * (4 * hh + st) + fr) * RSB + (k0 + 8 * fq) * 2);
#pragma unroll
                for (int st = 0; st < 4; ++st) gacc[st] = mfma16(bfv[st], cf, gacc[st]);
            }
            const int l = 16 * w + fr; const float al = acs[l];
#pragma unroll
            for (int st = 0; st < 4; ++st) {
                const int s0 = 16 * (4 * hh + st) + 4 * fq; const f32x4 as = *(const LAS f32x4*)(acs + s0), ds = *(const LAS f32x4*)(dtv + s0);
                float m[4];
#pragma unroll
                for (int j = 0; j < 4; ++j) m[j] = (s0 + j <= l) ? gacc[st][j] * __expf(al - as[j]) * ds[j] : 0.f;
                v2u mv; mv.x = pk2(m[0], m[1]); mv.y = pk2(m[2], m[3]);
                *(LAS v2u*)(lds + SO_M + l * RSB + s0 * 2) = mv;
            }
        }
        __syncthreads();
        {
            f32x4 y[4];
#pragma unroll
            for (int pt = 0; pt < 4; ++pt) y[pt] = (f32x4){0.f, 0.f, 0.f, 0.f};
#pragma unroll
            for (int k0 = 0; k0 < 128; k0 += 32) {
                const bf16x8 cf = *(const LAS bf16x8*)(lds + SO_C + (16 * w + fr) * RSB + (k0 + 8 * fq) * 2);
                bf16x8 sfv[4];
#pragma unroll
                for (int pt = 0; pt < 4; ++pt) sfv[pt] = *(const LAS bf16x8*)(lds + SO_S + (16 * pt + fr) * RSB + (k0 + 8 * fq) * 2);
#pragma unroll
                for (int pt = 0; pt < 4; ++pt) y[pt] = mfma16(cf, sfv[pt], y[pt]);
                __builtin_amdgcn_sched_barrier(0);
            }
            const f32x4 ea = *(const LAS f32x4*)(eacs + 16 * w + 4 * fq);
#pragma unroll
            for (int pt = 0; pt < 4; ++pt) y[pt] *= ea;
            for (int k0 = 0; k0 <= 16 * w + 15; k0 += 32) {
                const bf16x8 mf = *(const LAS bf16x8*)(lds + SO_M + (16 * w + fr) * RSB + (k0 + 8 * fq) * 2);
                const unsigned xa = (unsigned)(size_t)(lds + SO_X) + (unsigned)((k0 + 8 * fq + (fr >> 2)) * RSX + (fr & 3) * 8);
                bf16x8 x0, x1, x2, x3; TR4(576, x0, x1, x2, x3, xa);
                y[0] = mfma16(mf, x0, y[0]); y[1] = mfma16(mf, x1, y[1]); y[2] = mfma16(mf, x2, y[2]); y[3] = mfma16(mf, x3, y[3]);
                __builtin_amdgcn_sched_barrier(0);
            }
#pragma unroll
            for (int pt = 0; pt < 4; ++pt)
#pragma unroll
                for (int r = 0; r < 4; ++r) *(LAS float*)(lds + SO_M + (16 * w + 4 * fq + r) * RSB + (16 * pt + fr) * 4) = y[pt][r];
        }
        {
            const float dec = __expf(acs[512]);
#pragma unroll
            for (int i = 0; i < 4; ++i) sacc[i] *= dec;
#pragma unroll
            for (int k0 = 0; k0 < 128; k0 += 32) {
                const unsigned xa = (unsigned)(size_t)(lds + SO_X) + (unsigned)((k0 + 8 * fq + (fr >> 2)) * RSX + pt_s * 32 + (fr & 3) * 8);
                bf16x8 xf; TR1(576, xf, xa);
                const f32x4 w0 = *(const LAS f32x4*)(wv + k0 + 8 * fq), w1 = *(const LAS f32x4*)(wv + k0 + 8 * fq + 4);
                float xv[8]; unpack8(__builtin_bit_cast(v4u, xf), xv);
                v4u xs; xs.x = pk2(xv[0] * w0[0], xv[1] * w0[1]); xs.y = pk2(xv[2] * w0[2], xv[3] * w0[3]); xs.z = pk2(xv[4] * w1[0], xv[5] * w1[1]); xs.w = pk2(xv[6] * w1[2], xv[7] * w1[3]);
                const bf16x8 xw = __builtin_bit_cast(bf16x8, xs);
                const unsigned ba = (unsigned)(size_t)(lds + SO_B) + (unsigned)((k0 + 8 * fq + (fr >> 2)) * RSB + nh * 128 + (fr & 3) * 8);
                bf16x8 b0, b1, b2, b3; TR4(1088, b0, b1, b2, b3, ba);
                sacc[0] = mfma16(xw, b0, sacc[0]); sacc[1] = mfma16(xw, b1, sacc[1]); sacc[2] = mfma16(xw, b2, sacc[2]); sacc[3] = mfma16(xw, b3, sacc[3]);
                __builtin_amdgcn_sched_barrier(0);
            }
        }
        __syncthreads();
#pragma unroll
        for (int i = 0; i < 4; ++i)
#pragma unroll
            for (int r = 0; r < 4; ++r) *(LAS bf16*)(lds + SO_S + (16 * pt_s + 4 * fq + r) * RSB + (16 * (4 * nh + i) + fr) * 2) = (bf16)f2bf(sacc[i][r]);
        if (ft < nvalid) {
            const size_t row = rbase + l0 + ft;
            bf16* zq = PROJ + row * LDP + C_Z + h * 64 + 16 * q4;
            const v4u x0 = *(const LAS v4u*)(lds + SO_X + ft * RSX + q4 * 32), x1 = *(const LAS v4u*)(lds + SO_X + ft * RSX + q4 * 32 + 16);
            float zf[16], xf[16], yo[16];
            { float tmp[8]; unpack8(z0, tmp);
#pragma unroll
              for (int j = 0; j < 8; ++j) zf[j] = tmp[j];
              unpack8(z1, tmp);
#pragma unroll
              for (int j = 0; j < 8; ++j) zf[8 + j] = tmp[j];
              unpack8(x0, tmp);
#pragma unroll
              for (int j = 0; j < 8; ++j) xf[j] = tmp[j];
              unpack8(x1, tmp);
#pragma unroll
              for (int j = 0; j < 8; ++j) xf[8 + j] = tmp[j]; }
            float sq = 0.f;
#pragma unroll
            for (int j4 = 0; j4 < 4; ++j4) { const f32x4 yv = *(const LAS f32x4*)(lds + SO_M + ft * RSB + (16 * q4 + 4 * j4) * 4);
#pragma unroll
                for (int j = 0; j < 4; ++j) { const float v = (yv[j] + Dh * xf[4 * j4 + j]) * silu_f(zf[4 * j4 + j]); yo[4 * j4 + j] = v; sq += v * v; } }
            v4u o0, o1; o0.x = pk2(yo[0], yo[1]); o0.y = pk2(yo[2], yo[3]); o0.z = pk2(yo[4], yo[5]); o0.w = pk2(yo[6], yo[7]);
            o1.x = pk2(yo[8], yo[9]); o1.y = pk2(yo[10], yo[11]); o1.z = pk2(yo[12], yo[13]); o1.w = pk2(yo[14], yo[15]);
            *(v4u*)zq = o0; *(v4u*)(zq + 8) = o1;
            sq += __shfl_xor(sq, 1); sq += __shfl_xor(sq, 2);
            if (q4 == 0) SSDSQ[row * 16 + h] = sq;
        }
        __syncthreads();
    }
#undef SSD_PREFETCH
}
constexpr int LO_XB = 0, LO_XF = LO_XB + 128 * RSX, LO_A = LO_XF + 128 * 260, LO_U = LO_A + 128 * 260, LO_WA = LO_U + 128 * 260, LO_WX = LO_WA + 64 * RSX, LO_SC = LO_WX + 64 * RSX;
static_assert(LO_SC + 17 * 256 <= LDS_BYTES - 256, "lru lds");
__device__ __forceinline__ void lru_item3(const Args& a, LAS unsigned char* lds, int b, int h) {
    const int tid = threadIdx.x, lane0 = tid & 63, w = __builtin_amdgcn_readfirstlane(tid >> 6), fr0 = lane0 & 15, fq0 = lane0 >> 4;
    bf16* PROJ = (bf16*)(a.ws + WS_PROJ);
    const size_t rbase = (size_t)b * LSEQ;
    LAS float* segP = (LAS float*)(lds + LO_SC); LAS float* segH = segP + 512; LAS float* carry = segH + 512;
    __syncthreads();
    for (int i = tid; i < 4096; i += 512) { const int ii = i >> 6, j = i & 63;
        *(LAS bf16*)(lds + LO_WA + j * RSX + ii * 2) = (bf16)f2bf(a.in[I_LWA][(size_t)h * 4096 + i]);
        *(LAS bf16*)(lds + LO_WX + j * RSX + ii * 2) = (bf16)f2bf(a.in[I_LWX][(size_t)h * 4096 + i]); }
    if (tid < 64) carry[tid] = 0.f;
    float gba[4], gbx[4], gsp[4];
#pragma unroll
    for (int jt = 0; jt < 4; ++jt) { const int c = h * 64 + 16 * jt + fr0; gba[jt] = a.in[I_LBA][c]; gbx[jt] = a.in[I_LBX][c]; gsp[jt] = softplus_f(-a.in[I_LLAM][c]); }
    const int ft = tid >> 2, q4 = tid & 3;
    const int cg = tid & 7, rg = tid >> 3;
    v4u xp[5], gp[2];
#define LRU_PREFETCH(L0) do { const int l0_ = (L0); \
        _Pragma("unroll") for (int r = 0; r < 5; ++r) { const int l = l0_ + 2 * rg - 3 + r; xp[r] = (v4u){0u, 0u, 0u, 0u}; \
            if (l >= 0 && l < LSEQ) xp[r] = *(const v4u*)(PROJ + (rbase + l) * LDP + C_LI + h * 64 + cg * 8); } \
        gp[0] = (v4u){0u, 0u, 0u, 0u}; gp[1] = gp[0]; \
        if (l0_ + ft < LSEQ) { const bf16* gq = PROJ + (rbase + l0_ + ft) * LDP + C_G + h * 64 + 16 * q4; gp[0] = *(const v4u*)gq; gp[1] = *(const v4u*)(gq + 8); } } while (0)
    LRU_PREFETCH(0);
    for (int l0 = 0; l0 < LSEQ; l0 += 128) {
        const int nvalid = (LSEQ - l0) < 128 ? (LSEQ - l0) : 128;
        int fr = fr0, fq = fq0, lane = lane0; asm volatile("" : "+v"(fr), "+v"(fq), "+v"(lane));
        {
            float cw[4][8], cb[8], p[5][8];
#pragma unroll
            for (int k = 0; k < 4; ++k) { const f32x4 wa = *(const f32x4*)(a.in[I_LCW] + k * 1024 + h * 64 + cg * 8), wb = *(const f32x4*)(a.in[I_LCW] + k * 1024 + h * 64 + cg * 8 + 4);
#pragma unroll
                for (int j = 0; j < 4; ++j) { cw[k][j] = wa[j]; cw[k][4 + j] = wb[j]; } }
            { const f32x4 wa = *(const f32x4*)(a.in[I_LCB] + h * 64 + cg * 8), wb = *(const f32x4*)(a.in[I_LCB] + h * 64 + cg * 8 + 4);
#pragma unroll
              for (int j = 0; j < 4; ++j) { cb[j] = wa[j]; cb[4 + j] = wb[j]; } }
#pragma unroll
            for (int r = 0; r < 5; ++r) unpack8(xp[r], p[r]);
#pragma unroll
            for (int rr = 0; rr < 2; ++rr) { const int t = 2 * rg + rr; float o[8];
#pragma unroll
                for (int j = 0; j < 8; ++j) o[j] = cw[0][j] * p[rr][j] + cw[1][j] * p[rr + 1][j] + cw[2][j] * p[rr + 2][j] + cw[3][j] * p[rr + 3][j] + cb[j];
                v4u ov; ov.x = pk2(o[0], o[1]); ov.y = pk2(o[2], o[3]); ov.z = pk2(o[4], o[5]); ov.w = pk2(o[6], o[7]);
                *(LAS v4u*)(lds + LO_XB + t * RSX + cg * 16) = ov;
#pragma unroll
                for (int j = 0; j < 8; ++j) *(LAS float*)(lds + LO_XF + t * 260 + (cg * 8 + j) * 4) = o[j]; }
        }
        const v4u g0 = gp[0], g1 = gp[1];
        __syncthreads();
        if (l0 + 128 < LSEQ) LRU_PREFETCH(l0 + 128);
        {
            f32x4 ga[4], gx[4];
#pragma unroll
            for (int jt = 0; jt < 4; ++jt) { ga[jt] = (f32x4){0.f, 0.f, 0.f, 0.f}; gx[jt] = ga[jt]; }
#pragma unroll
            for (int k0 = 0; k0 < 64; k0 += 32) {
                const bf16x8 xf = *(const LAS bf16x8*)(lds + LO_XB + (16 * w + fr) * RSX + (k0 + 8 * fq) * 2);
                bf16x8 wav[4], wxv[4];
#pragma unroll
                for (int jt = 0; jt < 4; ++jt) { wav[jt] = *(const LAS bf16x8*)(lds + LO_WA + (16 * jt + fr) * RSX + (k0 + 8 * fq) * 2); wxv[jt] = *(const LAS bf16x8*)(lds + LO_WX + (16 * jt + fr) * RSX + (k0 + 8 * fq) * 2); }
#pragma unroll
                for (int jt = 0; jt < 4; ++jt) { ga[jt] = mfma16(xf, wav[jt], ga[jt]); gx[jt] = mfma16(xf, wxv[jt], gx[jt]); }
            }
#pragma unroll
            for (int jt = 0; jt < 4; ++jt)
#pragma unroll
                for (int r = 0; r < 4; ++r) { const int l = 16 * w + 4 * fq + r, j = 16 * jt + fr;
                    const float rr = sigmoid_f(ga[jt][r] + gba[jt]), ig = sigmoid_f(gx[jt][r] + gbx[jt]);
                    const float log_a = -8.0f * rr * gsp[jt];
                    const float av = __expf(log_a);
                    const float t2 = 2.f * log_a;
                    const float om = t2 > -0.1f ? -t2 * (1.f + t2 * (0.5f + t2 * (0.16666667f + t2 * 0.041666668f))) : 1.f - av * av;
                    const float mult = (l0 + l == 0) ? 1.f : __builtin_amdgcn_sqrtf(fmaxf(om, 0.f));
                    const float xv = *(const LAS float*)(lds + LO_XF + l * 260 + j * 4);
                    *(LAS float*)(lds + LO_A + l * 260 + j * 4) = av; *(LAS float*)(lds + LO_U + l * 260 + j * 4) = mult * ig * xv; }
        }
        __syncthreads();
        {
            float P = 1.f, Hl = 0.f;
#pragma unroll
            for (int t = 0; t < 16; ++t) { const float av = *(const LAS float*)(lds + LO_A + (16 * w + t) * 260 + lane * 4), uv = *(const LAS float*)(lds + LO_U + (16 * w + t) * 260 + lane * 4); Hl = av * Hl + uv; P *= av; }
            segP[w * 64 + lane] = P; segH[w * 64 + lane] = Hl;
            __syncthreads();
            float hin = carry[lane];
            for (int s2 = 0; s2 < w; ++s2) hin = segP[s2 * 64 + lane] * hin + segH[s2 * 64 + lane];
#pragma unroll
            for (int t = 0; t < 16; ++t) { LAS float* up = (LAS float*)(lds + LO_U + (16 * w + t) * 260 + lane * 4); hin = *(const LAS float*)(lds + LO_A + (16 * w + t) * 260 + lane * 4) * hin + *up; *up = hin; }
            __syncthreads();
            if (w == 7) carry[lane] = hin;
        }
        if (ft < nvalid) {
            const size_t row = rbase + l0 + ft;
            bf16* gq = PROJ + row * LDP + C_G + h * 64 + 16 * q4;
            float gf[16], yo[16];
            { float tmp[8]; unpack8(g0, tmp);
#pragma unroll
              for (int j = 0; j < 8; ++j) gf[j] = tmp[j];
              unpack8(g1, tmp);
#pragma unroll
              for (int j = 0; j < 8; ++j) gf[8 + j] = tmp[j]; }
#pragma unroll
            for (int j = 0; j < 16; ++j) yo[j] = *(const LAS float*)(lds + LO_U + ft * 260 + (16 * q4 + j) * 4) * gelu_tanh_f(gf[j]);
            v4u o0, o1; o0.x = pk2(yo[0], yo[1]); o0.y = pk2(yo[2], yo[3]); o0.z = pk2(yo[4], yo[5]); o0.w = pk2(yo[6], yo[7]);
            o1.x = pk2(yo[8], yo[9]); o1.y = pk2(yo[10], yo[11]); o1.z = pk2(yo[12], yo[13]); o1.w = pk2(yo[14], yo[15]);
            *(v4u*)gq = o0; *(v4u*)(gq + 8) = o1;
        }
        __syncthreads();
    }
#undef LRU_PREFETCH
}
__device__ __forceinline__ void ph_mixers3(const Args& a, LAS unsigned char* lds, int wk, int nwk) {
    for (int it = wk; it < 256; it += nwk) if (it < 128) ssd_item3(a, lds, it >> 4, it & 15);
    for (int it = wk; it < 256; it += nwk) if (it >= 128) lru_item3(a, lds, (it - 128) >> 4, (it - 128) & 15);
    {
        const int wave = __builtin_amdgcn_readfirstlane((int)threadIdx.x >> 6), lane = (int)threadIdx.x & 63;
        __syncthreads();
        if (nwk >= 256) { if (wk >= 128) convert_experts(a, 0, (LAS float*)(lds + wave * 8448), (wk - 128) * NWAVES + wave, (nwk - 128) * NWAVES, lane); }
        else convert_experts(a, 0, (LAS float*)(lds + wave * 8448), wk * NWAVES + wave, nwk * NWAVES, lane);
    }
}

constexpr int RW_STRIDE = 2064;
__device__ __forceinline__ void ph_router(const Args& a, LAS unsigned char* lds, int L, int wk, int nwk) {
    const int tid = threadIdx.x, lane = tid & 63, wave = __builtin_amdgcn_readfirstlane(tid >> 6), fr = lane & 15, fq = lane >> 4;
    const int gw = wk * NWAVES + wave, NGW = nwk * NWAVES;
    LAS unsigned char* wl = lds;
    LAS float* sc = (LAS float*)(lds + 99328) + wave * 768;
    LAS int* lcnt = (LAS int*)(lds + 123904); LAS int* gbase = lcnt + 32; LAS int* rinfo = lcnt + 64;
    const v4u* WRT = (const v4u*)(a.ws + WS_WRT) + (size_t)L * 6144;
    __syncthreads();
    for (int i = tid; i < 6144; i += 512) *(LAS v4u*)(wl + (i >> 7) * RW_STRIDE + (i & 127) * 16) = WRT[i];
    if (tid < 32) lcnt[tid] = 0;
    __syncthreads();
    const bf16* HBr = L ? (const bf16*)(a.ws + WS_SB) : (const bf16*)a.out;
    float* RSTD1 = (float*)(a.ws + WS_RSTD1); float* GATES = (float*)(a.ws + WS_GATES); int* LIST = (int*)(a.ws + WS_LIST);
    unsigned* cnt = (unsigned*)(a.ws + WS_CTL) + CW_CNT + 1024 * L;
    const float* bg = a.in[I_RGB] + L * 4; const float* be = a.in[I_REB] + L * 16;
    int it = 0;
    for (int u = gw; u < T / 16; u += NGW, ++it) {
        const int r0 = u * 16;
        const bf16* hrow = HBr + (size_t)(r0 + fr) * D + 8 * fq;
        f32x4 acc[3]; float ss = 0.f;
#pragma unroll
        for (int t = 0; t < 3; ++t) acc[t] = (f32x4){0.f, 0.f, 0.f, 0.f};
#pragma unroll 4
        for (int k0 = 0; k0 < 1024; k0 += 32) {
            const v4u hv = *(const v4u*)(hrow + k0);
            f32x4 h0v, h1v; unpack8v(hv, h0v, h1v);
            ss += (h0v[0] * h0v[0] + h0v[1] * h0v[1] + h0v[2] * h0v[2] + h0v[3] * h0v[3]) + (h1v[0] * h1v[0] + h1v[1] * h1v[1] + h1v[2] * h1v[2] + h1v[3] * h1v[3]);
            const bf16x8 hf = __builtin_bit_cast(bf16x8, hv);
#pragma unroll
            for (int t = 0; t < 3; ++t) { const bf16x8 wf = *(const LAS bf16x8*)(wl + (16 * t + fr) * RW_STRIDE + (k0 + 8 * fq) * 2); acc[t] = mfma16(wf, hf, acc[t]); }
        }
        ss += __shfl_xor(ss, 16); ss += __shfl_xor(ss, 32);
        const float rstd = rsqrtf(ss * (1.f / D) + EPS);
#pragma unroll
        for (int t = 0; t < 3; ++t)
#pragma unroll
            for (int r = 0; r < 4; ++r) sc[fr * 48 + 16 * t + 4 * fq + r] = acc[t][r];
        LDS_WAIT();
        if (lane < 16) {
            const int row = r0 + lane;
            float lg[20];
#pragma unroll
            for (int j = 0; j < 20; ++j) lg[j] = (sc[lane * 48 + j] + sc[lane * 48 + 20 + j]) * rstd + (j < 4 ? bg[j] : be[j - 4]);
            int gs = 0; float gm = lg[0];
#pragma unroll
            for (int j = 1; j < 4; ++j) if (lg[j] > gm) { gm = lg[j]; gs = j; }
            const float pg = 1.f / (__expf(lg[0] - gm) + __expf(lg[1] - gm) + __expf(lg[2] - gm) + __expf(lg[3] - gm));
            float f[4];
#pragma unroll
            for (int i = 0; i < 4; ++i) f[i] = gs == 0 ? lg[4 + i] : (gs == 1 ? lg[8 + i] : (gs == 2 ? lg[12 + i] : lg[16 + i]));
            int i0 = 0; float m0 = f[0];
#pragma unroll
            for (int i = 1; i < 4; ++i) if (f[i] > m0) { m0 = f[i]; i0 = i; }
            int i1 = -1; float m1 = -3.0e38f;
#pragma unroll
            for (int i = 0; i < 4; ++i) if (i != i0 && f[i] > m1) { m1 = f[i]; i1 = i; }
            const float w0 = 1.f / (1.f + __expf(m1 - m0)), w1 = 1.f - w0;
            const int lo = i0 < i1 ? i0 : i1, hi = i0 < i1 ? i1 : i0;
            const float glo = pg * (i0 < i1 ? w0 : w1), ghi = pg * (i0 < i1 ? w1 : w0);
            const int pair = lo == 0 ? hi - 1 : (lo == 1 ? hi + 1 : 5);
            const int bk = gs * 6 + pair;
            const int ls = __hip_atomic_fetch_add(lcnt + bk, 1, __ATOMIC_RELAXED, __HIP_MEMORY_SCOPE_WORKGROUP);
            rinfo[(it * NWAVES + wave) * 16 + lane] = bk | (ls << 8);
            RSTD1[row] = rstd; GATES[(size_t)row * 2] = glo; GATES[(size_t)row * 2 + 1] = ghi;
        }
        LDS_WAIT();
    }
    __syncthreads();
    if (tid < NBK) gbase[tid] = (int)atomicAdd(cnt + 32 * tid, (unsigned)lcnt[tid]);
    __syncthreads();
    it = 0;
    for (int u = gw; u < T / 16; u += NGW, ++it)
        if (lane < 16) { const int info = rinfo[(it * NWAVES + wave) * 16 + lane], bk = info & 255; LIST[(size_t)bk * T + gbase[bk] + (info >> 8)] = u * 16 + lane; }
}

struct BkTab { int cnt[NBK], off[NBK], ust[NBK + 1]; };
__device__ __forceinline__ void bk_table(const Args& a, LAS unsigned char* lds, int L, int per_tile  ) {
    LAS int* tb = (LAS int*)lds;
    __syncthreads();
    if (threadIdx.x == 0) {
        const unsigned* cnt = (const unsigned*)(a.ws + WS_CTL) + CW_CNT + 1024 * L;
        int off = 0, us = 0;
        for (int i = 0; i < NBK; ++i) { const int c = (int)__hip_atomic_load(cnt + 32 * i, __ATOMIC_RELAXED, __HIP_MEMORY_SCOPE_AGENT);
            tb[i] = c; tb[NBK + i] = off; tb[2 * NBK + i] = us; off += (c + 255) & ~255; us += ((c + 63) >> 6) * per_tile; }
        tb[2 * NBK + NBK] = us;
    }
    __syncthreads();
}
__device__ __forceinline__ void bk_experts(int bk, int& elo, int& ehi) {
    const int g = bk / 6, pr = bk - g * 6;
    const int lo = pr < 3 ? 0 : (pr < 5 ? 1 : 2), hi = pr < 3 ? pr + 1 : (pr < 5 ? pr - 1 : 3);
    elo = g * 4 + lo; ehi = g * 4 + hi;
}
__device__ __forceinline__ void ph_moe_up(const Args& a, LAS unsigned char* lds, int L, int wk, int nwk) {
    const int tid = threadIdx.x, lane = tid & 63, wave = __builtin_amdgcn_readfirstlane(tid >> 6), fr = lane & 15, fq = lane >> 4;
    const int gw = wk * NWAVES + wave, NGW = nwk * NWAVES;
    bk_table(a, lds, L, 32);
    LAS int* tb = (LAS int*)lds;
    const bf16* HB = (const bf16*)a.out; const bf16* WGU = (const bf16*)(a.ws + WS_WGU); bf16* HID = (bf16*)(a.ws + WS_HID);
    const int* LIST = (const int*)(a.ws + WS_LIST); const float* RSTD1 = (const float*)(a.ws + WS_RSTD1); const float* GATES = (const float*)(a.ws + WS_GATES);
    const int nun = tb[2 * NBK + NBK];
    for (int u = gw; u < nun; u += NGW) {
        int bk = 0;
        for (int i = 1; i < NBK; ++i) if (u >= tb[2 * NBK + i]) bk = i;
        const int cnt = tb[bk], off = tb[NBK + bk], r = u - tb[2 * NBK + bk];
        const int rt = r >> 5, ek = (r >> 4) & 1, ct = r & 15;
        int elo, ehi; bk_experts(bk, elo, ehi); const int e = ek ? ehi : elo;
        const int c0 = ct * 32, brow = e * 1024 + (c0 >> 7) * 256 + (c0 & 127);
        const bf16* arow[4]; int tok[4];
#pragma unroll
        for (int mi = 0; mi < 4; ++mi) { int rr = rt * 64 + 16 * mi + fr; if (rr >= cnt) rr = cnt - 1; tok[mi] = LIST[(size_t)bk * T + rr]; arow[mi] = HB + (size_t)tok[mi] * D; }
        f32x4 acc[4][4]; zero_acc(acc);
        sg_kloop<4>(1024, arow, [=](int n, int k0) { return WGU + (size_t)(brow + (n < 32 ? n : n + 96)) * 1024 + k0; }, NoKS(), acc, fr, fq);
#pragma unroll
        for (int mi = 0; mi < 4; ++mi) { const int rr = rt * 64 + 16 * mi + fr;
            if (rr < cnt) { const float rs = RSTD1[tok[mi]], gt = GATES[(size_t)tok[mi] * 2 + ek];
#pragma unroll
                for (int nj = 0; nj < 2; ++nj) { const f32x4 gv = acc[mi][nj] * rs, uv = acc[mi][nj + 2] * rs; f32x4 hv;
                    hv.x = silu_f(gv.x) * uv.x * gt; hv.y = silu_f(gv.y) * uv.y * gt; hv.z = silu_f(gv.z) * uv.z * gt; hv.w = silu_f(gv.w) * uv.w * gt;
                    v2u w; w.x = pk2(hv.x, hv.y); w.y = pk2(hv.z, hv.w);
                    *(v2u*)(HID + (size_t)(off + rr) * 1024 + ek * 512 + c0 + 16 * nj + 4 * fq) = w; } } }
    }
}
__device__ __forceinline__ void ph_moe_down(const Args& a, LAS unsigned char* lds, int L, int wk, int nwk) {
    const int tid = threadIdx.x, lane = tid & 63, wave = __builtin_amdgcn_readfirstlane(tid >> 6), fr = lane & 15, fq = lane >> 4;
    const int gw = wk * NWAVES + wave, NGW = nwk * NWAVES;
    bk_table(a, lds, L, 16);
    LAS int* tb = (LAS int*)lds;
    const bf16* HID = (const bf16*)(a.ws + WS_HID); const bf16* WD = (const bf16*)(a.ws + WS_WD);
    float* H = (float*)(a.ws + WS_H); bf16* HB = (bf16*)a.out; const int* LIST = (const int*)(a.ws + WS_LIST);
    const int nun = tb[2 * NBK + NBK];
    for (int u = gw; u < nun; u += NGW) {
        int bk = 0;
        for (int i = 1; i < NBK; ++i) if (u >= tb[2 * NBK + i]) bk = i;
        const int cnt = tb[bk], off = tb[NBK + bk], r = u - tb[2 * NBK + bk];
        const int rt = r >> 4, ct = r & 15;
        int elo, ehi; bk_experts(bk, elo, ehi);
        const bf16* arow[4];
#pragma unroll
        for (int mi = 0; mi < 4; ++mi) arow[mi] = HID + (size_t)(off + rt * 64 + 16 * mi + fr) * 1024;
        f32x4 acc[4][4]; zero_acc(acc);
        sg_kloop<4>(1024, arow, [=](int n, int k0) { return WD + ((size_t)((k0 < 512 ? elo : ehi) * 1024 + ct * 64 + n)) * 512 + (k0 & 511); }, NoKS(), acc, fr, fq);
#pragma unroll
        for (int mi = 0; mi < 4; ++mi) { const int rr = rt * 64 + 16 * mi + fr;
            if (rr < cnt) { const int tok = LIST[(size_t)bk * T + rr];
#pragma unroll
                for (int nj = 0; nj < 4; ++nj) { const int c = ct * 64 + 16 * nj + 4 * fq; float* hp = H + (size_t)tok * D + c;
                    const f32x4 v = *(const f32x4*)hp + acc[mi][nj]; *(f32x4*)hp = v;
                    v2u w; w.x = pk2(v.x, v.y); w.y = pk2(v.z, v.w); *(v2u*)(HB + (size_t)tok * D + c) = w; } } }
    }
}


__device__ __forceinline__ void hb_store4(bf16* HB, int row, int col, const f32x4 v) {
    v2u w; w.x = pg8::cvt_pk_bf16(v[0], v[1]); w.y = pg8::cvt_pk_bf16(v[2], v[3]); *(v2u*)(HB + (size_t)row * D + col) = w;
}
__device__ __forceinline__ void hb_store8(bf16* HB, int row, int col, const f32x4 v0, const f32x4 v1) {
    v4u w; w.x = pg8::cvt_pk_bf16(v0[0], v0[1]); w.y = pg8::cvt_pk_bf16(v0[2], v0[3]); w.z = pg8::cvt_pk_bf16(v1[0], v1[1]); w.w = pg8::cvt_pk_bf16(v1[2], v1[3]);
    *(v4u*)(HB + (size_t)row * D + col) = w;
}
constexpr int LDS_TAB = 131072;

struct PGemm2 {
    static constexpr bool PERM = true;
    struct Unit { int pm, pn, ui; };
    const Args* ap; const char* A; const char* B; bf16* HB; int G, c; int ldb, nt;
    __device__ __forceinline__ bool next(int i, Unit& u) const { u.ui = i; return pg8::static_order(64, 4, G, c, i, u.pm, u.pn); }
    __device__ __forceinline__ void avoff(const Unit& u, const int (&RA)[2], const int (&CA)[2], unsigned (&v)[4]) const {
#pragma unroll
        for (int h = 0; h < 2; ++h)
#pragma unroll
            for (int i = 0; i < 2; ++i) { const int row = u.pm * 256 + h * 128 + RA[i]; v[h * 2 + i] = (unsigned)(row * LDP + CA[i]) * 2u; }
    }
    __device__ __forceinline__ const char* abase(const Unit&) const { return A; }
    __device__ __forceinline__ const char* btile(const Unit& u, int t) const { return B + ((size_t)u.pn * 256 * 2048 + (size_t)t * 64) * 2; }
    __device__ __forceinline__ void a_ready(const Unit&) const {}
    __device__ __forceinline__ void done(const Unit&) const {}
    __device__ __forceinline__ void khook(int t, pg8::Acc& acc, const Unit& u, LAS unsigned char* lds, int wr, int wc, int fr, int fq) const {
        if (t == 8 || t == 16) {
            const LAS float* ft = (const LAS float*)(lds + LDS_TAB) + u.ui * 512 + (t == 16 ? 1 : 0);
#pragma unroll
            for (int ai = 0; ai < 2; ++ai)
#pragma unroll
                for (int m = 0; m < 4; ++m) { const float f = ft[(ai * 128 + wr * 64 + m * 16 + fr) * 2];
#pragma unroll
                    for (int bj = 0; bj < 2; ++bj)
#pragma unroll
                        for (int n = 0; n < 2; ++n) acc[ai][bj][m][n] *= f; }
        }
    }
    __device__ __forceinline__ void epi(const pg8::Acc& acc, const Unit& u, int wr, int wc, int fr, int fq) const {
        const int row0 = u.pm * 256 + wr * 64 + fr, col0 = u.pn * 256 + wc * 32 + 8 * fq;
        v4u cur[2], nxt[2];
#pragma unroll
        for (int bj = 0; bj < 2; ++bj) cur[bj] = *(const v4u*)(HB + (size_t)row0 * D + col0 + bj * 128);
#pragma unroll
        for (int g8 = 0; g8 < 8; ++g8) {
            const int ai = g8 >> 2, m = g8 & 3, row = row0 + ai * 128 + m * 16;
            if (g8 < 7) { const int rn = row0 + ((g8 + 1) >> 2) * 128 + ((g8 + 1) & 3) * 16;
#pragma unroll
                for (int bj = 0; bj < 2; ++bj) nxt[bj] = *(const v4u*)(HB + (size_t)rn * D + col0 + bj * 128); }
#pragma unroll
            for (int bj = 0; bj < 2; ++bj) { f32x4 h0v, h1v; unpack8v(cur[bj], h0v, h1v); hb_store8(HB, row, col0 + bj * 128, acc[ai][bj][m][0] + h0v, acc[ai][bj][m][1] + h1v); }
#pragma unroll
            for (int bj = 0; bj < 2; ++bj) cur[bj] = nxt[bj];
        }
    }
};
__device__ __forceinline__ void ssd_factors(const float* SSDSQ, int row, float& f0, float& f1) {
    const f32x4* sq = (const f32x4*)(SSDSQ + (size_t)row * 16); const f32x4 q0 = sq[0], q1 = sq[1], q2 = sq[2], q3 = sq[3];
    const float s0 = (q0.x + q0.y + q0.z + q0.w) + (q1.x + q1.y + q1.z + q1.w), s1 = (q2.x + q2.y + q2.z + q2.w) + (q3.x + q3.y + q3.z + q3.w);
    const float r0 = rsqrtf(s0 * (1.f / 512.f) + EPS), r1 = rsqrtf(s1 * (1.f / 512.f) + EPS);
    f0 = r0 / r1; f1 = r1;
}
__device__ __forceinline__ void ph_gemm2_pg8(const Args& a, LAS unsigned char* lds, int wk, int G) {
    const int tid = threadIdx.x, lane = tid & 63, wave = __builtin_amdgcn_readfirstlane(tid >> 6), fr = lane & 15, fq = lane >> 4;
    const float* SSDSQ = (const float*)(a.ws + WS_SSDSQ);
    PGemm2 S; S.ap = &a; S.A = (const char*)(a.ws + WS_PROJ); S.B = (const char*)(a.ws + WS_WOUT); S.HB = (bf16*)a.out;
    S.G = G; S.c = (int)blockIdx.x; S.ldb = 2048; S.nt = 32;
    {
        LAS float* ft = (LAS float*)(lds + LDS_TAB);
        PGemm2::Unit u;
        for (int i = 0; i < 4 && S.next(i, u); ++i)
            if (tid < 256) { float f0, f1; ssd_factors(SSDSQ, u.pm * 256 + tid, f0, f1); ft[i * 512 + tid * 2] = f0; ft[i * 512 + tid * 2 + 1] = f1; }
        __syncthreads();
    }
    pg8::gemm_phase<PGemm2, true>(lds, S);
    const bf16* PROJ = (const bf16*)(a.ws + WS_PROJ); const bf16* WOUT = (const bf16*)(a.ws + WS_WOUT);
    for (int tile = wk; tile < 32; tile += G) {
        const int rt = tile >> 4, ct = tile & 15, kb = wave * 256;
        const bf16* arow[4];
#pragma unroll
        for (int mi = 0; mi < 4; ++mi) arow[mi] = PROJ + (size_t)(16384 + rt * 64 + 16 * mi + fr) * LDP + kb;
        f32x4 acc[4][4]; zero_acc(acc);
        sg_kloop<4>(256, arow, [=](int n, int k0) { return WOUT + (size_t)(ct * 64 + n) * 2048 + kb + k0; }, NoKS(), acc, fr, fq);
        LAS float* part = (LAS float*)lds + wave * 4096;
        __syncthreads();
#pragma unroll
        for (int mi = 0; mi < 4; ++mi) { const int r = 16 * mi + fr; float f0, f1; ssd_factors(SSDSQ, 16384 + rt * 64 + r, f0, f1);
            const float sc = wave < 2 ? f0 * f1 : (wave < 4 ? f1 : 1.f);
#pragma unroll
            for (int nj = 0; nj < 4; ++nj) *(LAS f32x4*)(part + r * 64 + 16 * nj + 4 * fq) = acc[mi][nj] * sc; }
        __syncthreads();
        for (int q = tid; q < 1024; q += 512) { const int r = q >> 4, c4 = (q & 15) * 4; f32x4 s = *(const LAS f32x4*)((LAS float*)lds + r * 64 + c4);
#pragma unroll
            for (int w = 1; w < 8; ++w) s += *(const LAS f32x4*)((LAS float*)lds + w * 4096 + r * 64 + c4);
            const int row = 16384 + rt * 64 + r, col = ct * 64 + c4;
            const v2u hq = *(const v2u*)(S.HB + (size_t)row * D + col); f32x4 hv; hv[0] = __uint_as_float(hq.x << 16); hv[1] = __uint_as_float(hq.x & 0xffff0000u); hv[2] = __uint_as_float(hq.y << 16); hv[3] = __uint_as_float(hq.y & 0xffff0000u);
            hb_store4(S.HB, row, col, s + hv); }
        __syncthreads();
    }
}

struct BkInfo { int bk, rt, cnt, off; };
__device__ __forceinline__ void bk_table256(const Args& a, LAS unsigned char* lds, int L) {
    LAS int* tb = (LAS int*)(lds + LDS_TAB);
    __syncthreads();
    if (threadIdx.x == 0) {
        const unsigned* cnt = (const unsigned*)(a.ws + WS_CTL) + CW_CNT + 1024 * L;
        int off = 0, rts = 0;
        for (int i = 0; i < NBK; ++i) { const int c = (int)__hip_atomic_load(cnt + 32 * i, __ATOMIC_RELAXED, __HIP_MEMORY_SCOPE_AGENT);
            tb[i] = c; tb[NBK + i] = off; tb[2 * NBK + i] = rts; off += (c + 255) & ~255; rts += (c + 255) >> 8; }
        tb[2 * NBK + NBK] = rts;
    }
    __syncthreads();
}
__device__ __forceinline__ bool bk_find(const LAS int* tb, int rti, BkInfo& o) {
    if (rti >= tb[2 * NBK + NBK]) return false;
    int bk = 0;
    for (int i = 1; i < NBK; ++i) if (rti >= tb[2 * NBK + i]) bk = i;
    o.bk = bk; o.rt = rti - tb[2 * NBK + bk]; o.cnt = tb[bk]; o.off = tb[NBK + bk]; return true;
}
struct PMoeUp {
    static constexpr bool PERM = true;
    struct Unit { int bk, rt, cnt, off, e, ek, pnl, ui, rti; };
    const char* A; const char* B; bf16* HID; const float* rstd; const float* gates; const LAS int* tb; const LAS int* rowtab; unsigned* ctr; int G, c; int ldb, nt;
    __device__ __forceinline__ bool next(int i, Unit& u) const {
        const int Lu = i * G + c; BkInfo o; if (!bk_find(tb, Lu >> 3, o)) return false;
        u.bk = o.bk; u.rt = o.rt; u.cnt = o.cnt; u.off = o.off; u.ek = (Lu >> 2) & 1; u.pnl = Lu & 3; u.ui = i; u.rti = Lu >> 3;
        int elo, ehi; bk_experts(o.bk, elo, ehi); u.e = u.ek ? ehi : elo; return true;
    }
    __device__ __forceinline__ void avoff(const Unit& u, const int (&RA)[2], const int (&CA)[2], unsigned (&v)[4]) const {
#pragma unroll
        for (int h = 0; h < 2; ++h)
#pragma unroll
            for (int i = 0; i < 2; ++i) { const int tok = rowtab[u.ui * 256 + h * 128 + RA[i]]; v[h * 2 + i] = (unsigned)(tok * D + CA[i]) * 2u; }
    }
    __device__ __forceinline__ const char* abase(const Unit&) const { return A; }
    __device__ __forceinline__ const char* btile(const Unit& u, int t) const { return B + ((size_t)(u.e * 1024 + u.pnl * 256) * 1024 + (size_t)t * 64) * 2; }
    __device__ __forceinline__ void khook(int, pg8::Acc&, const Unit&, LAS unsigned char*, int, int, int, int) const {}
    __device__ __forceinline__ void a_ready(const Unit&) const {}
    __device__ __forceinline__ void done(const Unit& u) const {
        asm volatile("s_waitcnt vmcnt(0)" ::: "memory");
        if ((threadIdx.x & 63) == 0) __hip_atomic_fetch_add(ctr + 32 * u.rti, 1u, __ATOMIC_RELAXED, __HIP_MEMORY_SCOPE_AGENT);
    }
    __device__ __forceinline__ void epi(const pg8::Acc& acc, const Unit& u, int wr, int wc, int fr, int fq) const {
        const int r0 = wr * 64 + fr, col0 = u.ek * 512 + u.pnl * 128 + wc * 32 + 8 * fq;
        float rsv[2][4], gtv[2][4];
#pragma unroll
        for (int ai = 0; ai < 2; ++ai)
#pragma unroll
            for (int m = 0; m < 4; ++m) { const int tok = rowtab[u.ui * 256 + r0 + ai * 128 + m * 16]; rsv[ai][m] = rstd[tok]; gtv[ai][m] = gates[(size_t)tok * 2 + u.ek]; }
#pragma unroll
        for (int ai = 0; ai < 2; ++ai)
#pragma unroll
            for (int m = 0; m < 4; ++m) { const int rr = u.rt * 256 + r0 + ai * 128 + m * 16;
                if (rr < u.cnt) { const float rs = rsv[ai][m], gt = gtv[ai][m]; float hv[8];
#pragma unroll
                    for (int n = 0; n < 2; ++n)
#pragma unroll
                        for (int j = 0; j < 4; ++j) { const float g = acc[ai][0][m][n][j] * rs, uu = acc[ai][1][m][n][j] * rs; hv[n * 4 + j] = silu_f(g) * uu * gt; }
                    v4u w; w.x = pg8::cvt_pk_bf16(hv[0], hv[1]); w.y = pg8::cvt_pk_bf16(hv[2], hv[3]); w.z = pg8::cvt_pk_bf16(hv[4], hv[5]); w.w = pg8::cvt_pk_bf16(hv[6], hv[7]);
                    unsigned long long* hp = (unsigned long long*)(HID + (size_t)(u.off + rr) * 1024 + col0);
                    __hip_atomic_store(hp, (unsigned long long)w.x | ((unsigned long long)w.y << 32), __ATOMIC_RELAXED, __HIP_MEMORY_SCOPE_AGENT);
                    __hip_atomic_store(hp + 1, (unsigned long long)w.z | ((unsigned long long)w.w << 32), __ATOMIC_RELAXED, __HIP_MEMORY_SCOPE_AGENT); } }
    }
};
__device__ __forceinline__ void ph_moe_up_pg8(const Args& a, LAS unsigned char* lds, int L, int G) {
    bk_table256(a, lds, L);
    const LAS int* tb = (const LAS int*)(lds + LDS_TAB); LAS int* rowtab = (LAS int*)(lds + LDS_TAB + 1024);
    PMoeUp S; S.A = L ? (const char*)(a.ws + WS_SB) : (const char*)a.out; S.B = (const char*)(a.ws + ws_wgu(L)); S.HID = (bf16*)(a.ws + WS_HID); S.rstd = (const float*)(a.ws + WS_RSTD1); S.gates = (const float*)(a.ws + WS_GATES);
    S.tb = tb; S.rowtab = rowtab; S.G = G; S.c = (int)blockIdx.x; S.ldb = 1024; S.nt = 16; S.ctr = (unsigned*)(a.ws + WS_CTL) + CW_RT + 8192 * L;
    {   const int* LIST = (const int*)(a.ws + WS_LIST); PMoeUp::Unit u;
        for (int i = 0; i < 6 && S.next(i, u); ++i)
            if (threadIdx.x < 256) { int rr = u.rt * 256 + (int)threadIdx.x; rr = rr < u.cnt ? rr : u.cnt - 1; rowtab[i * 256 + threadIdx.x] = LIST[(size_t)u.bk * T + rr]; }
        __syncthreads();
    }
    pg8::gemm_phase<PMoeUp, true>(lds, S);
}
struct PMoeDown {
    static constexpr bool PERM = true;
    struct Unit { int bk, rt, cnt, off, elo, ehi, pn, ui, rti; };
    const char* A; const char* B; bf16* HB; bf16* HBo; float* SSQ; const LAS int* tb; const LAS int* rowtab; unsigned* ctr; unsigned* err; int G, c, i0; int ldb, nt;
    __device__ __forceinline__ bool next(int i, Unit& u) const {
        const int Ld = (i0 + i) * G + c - 8 * tb[2 * NBK + NBK]; BkInfo o; if (!bk_find(tb, Ld >> 2, o)) return false;
        u.bk = o.bk; u.rt = o.rt; u.cnt = o.cnt; u.off = o.off; u.pn = Ld & 3; u.ui = i; u.rti = Ld >> 2; bk_experts(o.bk, u.elo, u.ehi); return true;
    }
    __device__ __forceinline__ void avoff(const Unit& u, const int (&RA)[2], const int (&CA)[2], unsigned (&v)[4]) const {
#pragma unroll
        for (int h = 0; h < 2; ++h)
#pragma unroll
            for (int i = 0; i < 2; ++i) { const int row = u.off + u.rt * 256 + h * 128 + RA[i]; v[h * 2 + i] = (unsigned)(row * 1024 + CA[i]) * 2u; }
    }
    __device__ __forceinline__ const char* abase(const Unit&) const { return A; }
    __device__ __forceinline__ const char* btile(const Unit& u, int t) const { return B + ((size_t)((t < 8 ? u.elo : u.ehi) * 1024 + u.pn * 256) * 512 + (size_t)(t & 7) * 64) * 2; }
    __device__ __forceinline__ void khook(int, pg8::Acc&, const Unit&, LAS unsigned char*, int, int, int, int) const {}
    __device__ __forceinline__ void a_ready(const Unit& u) const {
        if (threadIdx.x < 64) {
            unsigned spins = 0;
            while ((unsigned)__builtin_amdgcn_readfirstlane(__hip_atomic_load(ctr + 32 * u.rti, __ATOMIC_RELAXED, __HIP_MEMORY_SCOPE_AGENT)) < 64u) {
                __builtin_amdgcn_s_sleep(2);
                if (++spins > (1u << 22)) { if (threadIdx.x == 0) __hip_atomic_store(err, 1u, __ATOMIC_RELAXED, __HIP_MEMORY_SCOPE_AGENT); break; } }
            __builtin_amdgcn_fence(__ATOMIC_ACQUIRE, "agent");
            asm volatile("s_waitcnt vmcnt(0)" ::: "memory");
        }
        asm volatile("" ::: "memory"); __builtin_amdgcn_s_barrier(); asm volatile("" ::: "memory");
    }
    __device__ __forceinline__ void done(const Unit&) const {}
    __device__ __forceinline__ void epi(const pg8::Acc& acc, const Unit& u, int wr, int wc, int fr, int fq) const {
        const int r0 = wr * 64 + fr, col0 = u.pn * 256 + wc * 32 + 8 * fq;
        int tok[8];
#pragma unroll
        for (int g8 = 0; g8 < 8; ++g8) tok[g8] = rowtab[u.ui * 256 + r0 + (g8 >> 2) * 128 + (g8 & 3) * 16];
        v4u cur[2], nxt[2];
#pragma unroll
        for (int bj = 0; bj < 2; ++bj) cur[bj] = *(const v4u*)(HB + (size_t)tok[0] * D + col0 + bj * 128);
#pragma unroll
        for (int g8 = 0; g8 < 8; ++g8) {
            const int ai = g8 >> 2, m = g8 & 3;
            if (g8 < 7) {
#pragma unroll
                for (int bj = 0; bj < 2; ++bj) nxt[bj] = *(const v4u*)(HB + (size_t)tok[g8 + 1] * D + col0 + bj * 128); }
            const int rr = u.rt * 256 + r0 + ai * 128 + m * 16;
            float sq = 0.f;
#pragma unroll
            for (int bj = 0; bj < 2; ++bj) { f32x4 h0v, h1v; unpack8v(cur[bj], h0v, h1v);
                const f32x4 v0 = acc[ai][bj][m][0] + h0v, v1 = acc[ai][bj][m][1] + h1v;
                sq += (v0[0] * v0[0] + v0[1] * v0[1] + v0[2] * v0[2] + v0[3] * v0[3]) + (v1[0] * v1[0] + v1[1] * v1[1] + v1[2] * v1[2] + v1[3] * v1[3]);
                if (rr < u.cnt) hb_store8(HBo, tok[g8], col0 + bj * 128, v0, v1); }
            sq += __shfl_xor(sq, 16); sq += __shfl_xor(sq, 32);
            if (rr < u.cnt && fq == 0) SSQ[(size_t)tok[g8] * 16 + u.pn * 4 + wc] = sq;
#pragma unroll
            for (int bj = 0; bj < 2; ++bj) cur[bj] = nxt[bj];
        }
    }
};
__device__ __forceinline__ void ph_moe_down_pg8(const Args& a, LAS unsigned char* lds, int L, int G) {
    bk_table256(a, lds, L);
    const LAS int* tb = (const LAS int*)(lds + LDS_TAB); LAS int* rowtab = (LAS int*)(lds + LDS_TAB + 1024);
    PMoeDown S; S.A = (const char*)(a.ws + WS_HID); S.B = (const char*)(a.ws + ws_wd(L)); S.SSQ = (float*)(a.ws + WS_SSDSQ); S.HB = L ? (bf16*)(a.ws + WS_SB) : (bf16*)a.out; S.HBo = L ? (bf16*)(a.ws + WS_SC) : (bf16*)a.out;
    S.tb = tb; S.rowtab = rowtab; S.G = G; S.c = (int)blockIdx.x; S.ldb = 512; S.nt = 16; S.ctr = (unsigned*)(a.ws + WS_CTL) + CW_RT + 8192 * L; S.err = (unsigned*)(a.ws + WS_CTL) + 16;
    { const int nup = 8 * tb[2 * NBK + NBK]; S.i0 = nup > S.c ? (nup - S.c + G - 1) / G : 0; }
    {   const int* LIST = (const int*)(a.ws + WS_LIST); PMoeDown::Unit u;
        for (int i = 0; i < 4 && S.next(i, u); ++i)
            if (threadIdx.x < 256) { int rr = u.rt * 256 + (int)threadIdx.x; rr = rr < u.cnt ? rr : u.cnt - 1; rowtab[i * 256 + threadIdx.x] = LIST[(size_t)u.bk * T + rr]; }
        __syncthreads();
    }
    pg8::gemm_phase<PMoeDown, true>(lds, S);
    if (L == 0) {
        const int wave = __builtin_amdgcn_readfirstlane((int)threadIdx.x >> 6), lane = (int)threadIdx.x & 63;
        const int ntot = 12 * tb[2 * NBK + NBK], n_more = ntot % G;
        __syncthreads();
        if (n_more > 0 && n_more <= G - 32) { if (S.c >= n_more) convert_experts(a, 1, (LAS float*)(lds + wave * 8448), (S.c - n_more) * NWAVES + wave, (G - n_more) * NWAVES, lane); }
        else convert_experts(a, 1, (LAS float*)(lds + wave * 8448), S.c * NWAVES + wave, G * NWAVES, lane);
    }
}
struct PPool {
    static constexpr bool PERM = true;
    struct Unit { int pm, pn; };
    const char* A; const char* B; bf16* HB; const float* pb; const float* ps; int G, c; int ldb, nt;
    __device__ __forceinline__ bool next(int i, Unit& u) const { return pg8::static_order(65, 4, G, c, i, u.pm, u.pn); }
    __device__ __forceinline__ void avoff(const Unit& u, const int (&RA)[2], const int (&CA)[2], unsigned (&v)[4]) const {
#pragma unroll
        for (int h = 0; h < 2; ++h)
#pragma unroll
            for (int i = 0; i < 2; ++i) { int row = u.pm * 256 + h * 128 + RA[i]; row = row < T ? row : T - 1; v[h * 2 + i] = (unsigned)(row * D + CA[i]) * 2u; }
    }
    __device__ __forceinline__ const char* abase(const Unit& u) const { return A + (size_t)u.pn * 256 * 2; }
    __device__ __forceinline__ const char* btile(const Unit& u, int t) const { return B + ((size_t)u.pn * 256 * 256 + (size_t)t * 64) * 2; }
    __device__ __forceinline__ void khook(int, pg8::Acc&, const Unit&, LAS unsigned char*, int, int, int, int) const {}
    __device__ __forceinline__ void a_ready(const Unit&) const {}
    __device__ __forceinline__ void done(const Unit&) const {}
    __device__ __forceinline__ void epi(const pg8::Acc& acc, const Unit& u, int wr, int wc, int fr, int fq) const {
        const int row0 = u.pm * 256 + wr * 64 + fr, col0 = u.pn * 256 + wc * 32 + 8 * fq;
        v4u cur[2], nxt[2];
        { const int rc = row0 < T ? row0 : T - 1;
#pragma unroll
          for (int bj = 0; bj < 2; ++bj) cur[bj] = *(const v4u*)(HB + (size_t)rc * D + col0 + bj * 128); }
#pragma unroll
        for (int g8 = 0; g8 < 8; ++g8) {
            const int ai = g8 >> 2, m = g8 & 3, row = row0 + ai * 128 + m * 16;
            if (g8 < 7) { const int rn = row0 + ((g8 + 1) >> 2) * 128 + ((g8 + 1) & 3) * 16, rc = rn < T ? rn : T - 1;
#pragma unroll
                for (int bj = 0; bj < 2; ++bj) nxt[bj] = *(const v4u*)(HB + (size_t)rc * D + col0 + bj * 128); }
            if (row < T) {
#pragma unroll
                for (int bj = 0; bj < 2; ++bj) { const int cc = col0 + bj * 128; f32x4 h0v, h1v; unpack8v(cur[bj], h0v, h1v);
                    hb_store8(HB, row, cc, h0v + (acc[ai][bj][m][0] + *(const f32x4*)(pb + cc)) * *(const f32x4*)(ps + cc),
                                           h1v + (acc[ai][bj][m][1] + *(const f32x4*)(pb + cc + 4)) * *(const f32x4*)(ps + cc + 4)); } }
#pragma unroll
            for (int bj = 0; bj < 2; ++bj) cur[bj] = nxt[bj];
        }
    }
};
__device__ __forceinline__ void ph_poolgemm_pg8(const Args& a, LAS unsigned char* lds, int G) {
    PPool S; S.A = (const char*)(a.ws + WS_POOLED); S.B = (const char*)(a.ws + WS_WPOOL); S.HB = (bf16*)a.out; S.pb = a.in[I_PB]; S.ps = a.in[I_PS];
    S.G = G; S.c = (int)blockIdx.x; S.ldb = 256; S.nt = 4;
    pg8::gemm_phase<PPool, true>(lds, S);
}

constexpr int PF_RS_ROW = 528;
constexpr int PF_RAW = 0, PF_RS = 112 * PF_RS_ROW, PF_A = PF_RS + 512, PF_END = PF_A + 96 * PF_RS_ROW;
static_assert(PF_END <= LDS_BYTES - 256, "pool lds");
__device__ __forceinline__ void ph_pool_fused(const Args& a, LAS unsigned char* lds, int wk, int nwk) {
    const int tid = threadIdx.x, lane = tid & 63, w = __builtin_amdgcn_readfirstlane(tid >> 6), fr = lane & 15, fq = lane >> 4;
    const bf16* SA = (const bf16*)a.out; bf16* SB = (bf16*)(a.ws + WS_SB); const float* SSQ = (const float*)(a.ws + WS_SSDSQ); const bf16* WPOOL = (const bf16*)(a.ws + WS_WPOOL);
    LAS float* rs = (LAS float*)(lds + PF_RS);
    v4u rp[7]; f32x4 sq4[4];
#define POOL_PREFETCH(U) do { const int rt_ = (U) >> 2, g_ = (U) & 3, t0_ = rt_ * 96; \
        _Pragma("unroll") for (int i = 0; i < 7; ++i) { const int q = tid + 512 * i, row = q >> 5, pc = q & 31; int gr = t0_ - 16 + row; gr = gr < 0 ? 0 : gr; \
            rp[i] = *(const v4u*)(SA + (size_t)gr * D + g_ * 256 + pc * 8); } \
        if (tid < 112) { int gr = t0_ - 16 + tid; gr = gr < 0 ? 0 : gr; const f32x4* q = (const f32x4*)(SSQ + (size_t)gr * 16); sq4[0] = q[0]; sq4[1] = q[1]; sq4[2] = q[2]; sq4[3] = q[3]; } } while (0)
    if (wk < 172 * 4) POOL_PREFETCH(wk);
    for (int u = wk; u < 172 * 4; u += nwk) {
        const int rt = u >> 2, g = u & 3, t0 = rt * 96, win = 2 << g;
        const bf16* wrow = WPOOL + (size_t)(g * 256 + 32 * w + fr) * 256 + 8 * fq;
        bf16x8 bfr[8][2];
#pragma unroll
        for (int ks = 0; ks < 8; ++ks) { bfr[ks][0] = *(const bf16x8*)(wrow + 32 * ks); bfr[ks][1] = *(const bf16x8*)(wrow + 16 * 256 + 32 * ks); }
        __syncthreads();
#pragma unroll
        for (int i = 0; i < 7; ++i) { const int q = tid + 512 * i, row = q >> 5, pc = q & 31; *(LAS v4u*)(lds + PF_RAW + row * PF_RS_ROW + pc * 16) = rp[i]; }
        if (tid < 112) { const f32x4 sv = (sq4[0] + sq4[1]) + (sq4[2] + sq4[3]); rs[tid] = rsqrtf((sv[0] + sv[1] + sv[2] + sv[3]) * (1.f / D) + EPS); }
        __syncthreads();
        if (u + nwk < 172 * 4) POOL_PREFETCH(u + nwk);
        {   const int c4 = tid & 63, r0 = (tid >> 6) * 12;
            const LAS unsigned char* rawc = lds + PF_RAW + 16 * PF_RS_ROW + c4 * 8;
            int l = (t0 + r0) % LSEQ;
            f32x4 Sb = (f32x4){0.f, 0.f, 0.f, 0.f};
            for (int j = 1; j < win; ++j) if (l - j >= 0) { const v2u q = *(const LAS v2u*)(rawc + (r0 - j) * PF_RS_ROW); const float rr = rs[16 + r0 - j];
                Sb[0] += __uint_as_float(q.x << 16) * rr; Sb[1] += __uint_as_float(q.x & 0xffff0000u) * rr; Sb[2] += __uint_as_float(q.y << 16) * rr; Sb[3] += __uint_as_float(q.y & 0xffff0000u) * rr; }
#pragma unroll 4
            for (int r = r0; r < r0 + 12; ++r) {
                if (l == 0) Sb = (f32x4){0.f, 0.f, 0.f, 0.f};
                const v2u q = *(const LAS v2u*)(rawc + r * PF_RS_ROW); const float rr = rs[16 + r];
                f32x4 hv; hv[0] = __uint_as_float(q.x << 16) * rr; hv[1] = __uint_as_float(q.x & 0xffff0000u) * rr; hv[2] = __uint_as_float(q.y << 16) * rr; hv[3] = __uint_as_float(q.y & 0xffff0000u) * rr;
                const f32x4 full = Sb + hv;
                const int n = (l + 1) < win ? (l + 1) : win;
                const f32x4 o = full * (1.f / (float)n) - hv;
                v2u wv; wv.x = pk2(o[0], o[1]); wv.y = pk2(o[2], o[3]);
                *(LAS v2u*)(lds + PF_A + r * PF_RS_ROW + c4 * 8) = wv;
                Sb = full;
                if (l + 1 >= win) { const v2u qo = *(const LAS v2u*)(rawc + (r - win + 1) * PF_RS_ROW); const float ro = rs[16 + r - win + 1];
                    Sb[0] -= __uint_as_float(qo.x << 16) * ro; Sb[1] -= __uint_as_float(qo.x & 0xffff0000u) * ro; Sb[2] -= __uint_as_float(qo.y << 16) * ro; Sb[3] -= __uint_as_float(qo.y & 0xffff0000u) * ro; }
                l = (l + 1 == LSEQ) ? 0 : l + 1;
            }
        }
        __syncthreads();
        f32x4 acc[6][2];
#pragma unroll
        for (int m = 0; m < 6; ++m) { acc[m][0] = (f32x4){0.f, 0.f, 0.f, 0.f}; acc[m][1] = acc[m][0]; }
#pragma unroll
        for (int ks = 0; ks < 8; ++ks) {
            bf16x8 af[6];
#pragma unroll
            for (int m = 0; m < 6; ++m) af[m] = *(const LAS bf16x8*)(lds + PF_A + (16 * m + fr) * PF_RS_ROW + (32 * ks + 8 * fq) * 2);
#pragma unroll
            for (int m = 0; m < 6; ++m) { acc[m][0] = mfma16(bfr[ks][0], af[m], acc[m][0]); acc[m][1] = mfma16(bfr[ks][1], af[m], acc[m][1]); }
        }
#pragma unroll
        for (int j = 0; j < 2; ++j) { const int col = g * 256 + 32 * w + 16 * j + 4 * fq; const f32x4 pbv = *(const f32x4*)(a.in[I_PB] + col), psv = *(const f32x4*)(a.in[I_PS] + col);
#pragma unroll
            for (int m = 0; m < 6; ++m) { const int row = t0 + 16 * m + fr;
                const v2u hq = *(const LAS v2u*)(lds + PF_RAW + (16 + 16 * m + fr) * PF_RS_ROW + (32 * w + 16 * j + 4 * fq) * 2);
                f32x4 hv; hv[0] = __uint_as_float(hq.x << 16); hv[1] = __uint_as_float(hq.x & 0xffff0000u); hv[2] = __uint_as_float(hq.y << 16); hv[3] = __uint_as_float(hq.y & 0xffff0000u);
                hb_store4(SB, row, col, hv + (acc[m][j] + pbv) * psv); } }
    }
#undef POOL_PREFETCH
}
__device__ __forceinline__ void ph_pooled(const Args& a, LAS unsigned char* lds, int wk, int nwk) {
    const int tid = threadIdx.x, qt = tid >> 7, c8 = tid & 127, c = c8 * 8, g = c >> 8, w = 2 << g;
    const bf16* HBr = (const bf16*)a.out; const float* SSQ = (const float*)(a.ws + WS_SSDSQ); bf16* PO = (bf16*)(a.ws + WS_POOLED);
    LAS float* rs = (LAS float*)lds + qt * 64;
    for (int pr = wk; pr < 172; pr += nwk) {
        const int task = pr * 4 + qt, b = task / 86, t0 = (task % 86) * 24;
        const size_t rb = (size_t)b * LSEQ;
        __syncthreads();
        if (c8 < 40) { const int l = t0 - 16 + c8; float r = 0.f;
            if (l >= 0) { const f32x4* q = (const f32x4*)(SSQ + (rb + l) * 16); const f32x4 sv = (q[0] + q[1]) + (q[2] + q[3]); r = rsqrtf((sv[0] + sv[1] + sv[2] + sv[3]) * (1.f / D) + EPS); }
            rs[c8] = r; }
        __syncthreads();
        f32x4 S0 = (f32x4){0.f, 0.f, 0.f, 0.f}, S1 = S0;
        for (int j = 1; j <= w; ++j) { const int l = t0 - j; if (l >= 0) { f32x4 x0, x1; unpack8v(*(const v4u*)(HBr + (rb + l) * D + c), x0, x1); S0 += x0 * rs[16 - j]; S1 += x1 * rs[16 - j]; } }
#pragma unroll 4
        for (int t = 0; t < 24; ++t) {
            const int l = t0 + t;
            f32x4 h0v, h1v; unpack8v(*(const v4u*)(HBr + (rb + l) * D + c), h0v, h1v); h0v *= rs[16 + t]; h1v *= rs[16 + t];
            const int lo = l - w, loc = lo >= 0 ? lo : 0; const float rl = lo >= 0 ? rs[16 + t - w] : 0.f;
            f32x4 s0v, s1v; unpack8v(*(const v4u*)(HBr + (rb + loc) * D + c), s0v, s1v);
            S0 += h0v; S0 -= s0v * rl; S1 += h1v; S1 -= s1v * rl;
            const int n = (l + 1) < w ? (l + 1) : w; const float inv = 1.f / (float)n;
            const f32x4 o0 = S0 * inv - h0v, o1 = S1 * inv - h1v;
            v4u wv; wv.x = pk2(o0[0], o0[1]); wv.y = pk2(o0[2], o0[3]); wv.z = pk2(o1[0], o1[1]); wv.w = pk2(o1[2], o1[3]); *(v4u*)(PO + (rb + l) * D + c) = wv;
        }
    }
}
__device__ __forceinline__ void ph_poolgemm(const Args& a, int wk, int nwk) {
    const int tid = threadIdx.x, lane = tid & 63, wave = __builtin_amdgcn_readfirstlane(tid >> 6), fr = lane & 15, fq = lane >> 4;
    const int gw = wk * NWAVES + wave, NGW = nwk * NWAVES;
    const bf16* PO = (const bf16*)(a.ws + WS_POOLED); const bf16* WPOOL = (const bf16*)(a.ws + WS_WPOOL);
    float* H = (float*)(a.ws + WS_H); bf16* HB = (bf16*)a.out;
    for (int u = gw; u < 258 * 16; u += NGW) {
        const int rt = u / 16, ct = u % 16, g = ct >> 2;
        const bf16* arow[4];
#pragma unroll
        for (int mi = 0; mi < 4; ++mi) arow[mi] = PO + (size_t)(rt * 64 + 16 * mi + fr) * D + g * 256;
        f32x4 acc[4][4]; zero_acc(acc);
        sg_kloop<4>(256, arow, [=](int n, int k0) { return WPOOL + (size_t)(ct * 64 + n) * 256 + k0; }, NoKS(), acc, fr, fq);
#pragma unroll
        for (int mi = 0; mi < 4; ++mi) { const int row = rt * 64 + 16 * mi + fr;
#pragma unroll
            for (int nj = 0; nj < 4; ++nj) { const int c = ct * 64 + 16 * nj + 4 * fq; float* hp = H + (size_t)row * D + c;
                const f32x4 v = *(const f32x4*)hp + (acc[mi][nj] + *(const f32x4*)(a.in[I_PB] + c)) * *(const f32x4*)(a.in[I_PS] + c); *(f32x4*)hp = v;
                v2u w; w.x = pk2(v.x, v.y); w.y = pk2(v.z, v.w); *(v2u*)(HB + (size_t)row * D + c) = w; } }
    }
}
__device__ __forceinline__ void ph_final(const Args& a, int wk, int nwk) {
    const int tid = threadIdx.x, lane = tid & 63, wave = __builtin_amdgcn_readfirstlane(tid >> 6);
    const int gw = wk * NWAVES + wave, NGW = nwk * NWAVES;
    const f32x4* gn = (const f32x4*)a.in[I_NORMF] + lane;
    const bf16* HF = (const bf16*)(a.ws + WS_SC);
    for (int orow = gw; orow < NB * SEQ; orow += NGW) {
        const int b = orow / SEQ, l = orow - b * SEQ, row = b * LSEQ + NMETA + l;
        const v2u* xr = (const v2u*)(HF + (size_t)row * D) + lane; f32x4 v[4]; float ss = 0.f;
#pragma unroll
        for (int j = 0; j < 4; ++j) { const v2u q = xr[64 * j]; v[j][0] = __uint_as_float(q.x << 16); v[j][1] = __uint_as_float(q.x & 0xffff0000u); v[j][2] = __uint_as_float(q.y << 16); v[j][3] = __uint_as_float(q.y & 0xffff0000u);
            ss += v[j].x * v[j].x + v[j].y * v[j].y + v[j].z * v[j].z + v[j].w * v[j].w; }
        ss = wave_sum(ss);
        const float rstd = rsqrtf(ss * (1.f / D) + EPS);
        f32x4* o = (f32x4*)(a.out + (size_t)orow * D) + lane;
#ifdef PROBE_T
        const unsigned long long* ts = (const unsigned long long*)(a.ws + WS_CTL + 2048);
        const float tA = (float)(ts[PROBE_A_HI] - ts[PROBE_A_LO]) * 0.01f, tB = (float)(ts[PROBE_B_HI] - ts[PROBE_B_LO]) * 0.01f;
#pragma unroll
        for (int j = 0; j < 4; ++j) { f32x4 r = v[j] * rstd * gn[64 * j] + tB * 0.01f; if (orow == 0 && lane == 0 && j == 0) r.x += tA; o[64 * j] = r; }
#else
#pragma unroll
        for (int j = 0; j < 4; ++j) o[64 * j] = v[j] * rstd * gn[64 * j];
#endif
    }
}

__global__ void __launch_bounds__(NWAVES * 64, 2) fwd_kernel(Args a) {
    extern __shared__ __attribute__((aligned(16))) unsigned char lds_raw[];
    LAS unsigned char* lds = (LAS unsigned char*)lds_raw;
    volatile LAS unsigned* MISC = (volatile LAS unsigned*)(lds + LDS_BYTES - 256);
    const int tid = threadIdx.x;
    const int G = gridDim.x; const int bx = blockIdx.x;
    const int wk = (G % 8 == 0) ? (bx % 8) * (G / 8) + bx / 8 : bx;
    if (tid < 64) MISC[tid] = 0u;
    __syncthreads();
    XcdBarrier bar; bar.bar = (unsigned*)(a.ws + WS_CTL) + CW_BAR; bar.x = 0; bar.st = nullptr;
    if (N_LAUNCHES == 1) bar = xcd_barrier_post((unsigned*)(a.ws + WS_CTL) + CW_BAR, MISC + 8);
    const int lo = a.ph_lo, hi = a.ph_hi;
#ifndef PH_MASK
#define PH_MASK 0xFFFF
#endif
#define IN(k) (((PH_MASK >> (k)) & 1) && lo <= (k) && (k) < hi)
#ifdef PROBE_T
#define STAMP(k) do { if (blockIdx.x == 0 && tid == 0) ((unsigned long long*)(a.ws + WS_CTL + 2048))[k] = __builtin_amdgcn_s_memrealtime(); } while (0)
#else
#define STAMP(k) do { } while (0)
#endif
#ifdef PROBE_K
    volatile LAS unsigned long long* pkt = (volatile LAS unsigned long long*)(lds + LDS_BYTES - 128);
#define PSTAMP(k) do { if (blockIdx.x == 0 && tid == 0) { if ((k) == PROBE_K) pkt[0] = __builtin_amdgcn_s_memrealtime(); if ((k) == PROBE_K + 1) pkt[1] = __builtin_amdgcn_s_memrealtime(); } } while (0)
#else
#define PSTAMP(k) do { } while (0)
#endif
#define SEAM(k) do { if (IN(k) && IN((k) + 1)) xcd_barrier(bar); STAMP((k) + 1); PSTAMP((k) + 1); } while (0)
    STAMP(0); PSTAMP(0);
    if (IN(0)) { ph_prep(a, lds, wk, G); } SEAM(0);
    if (IN(1)) { ph_gemm1_pg8(a, lds, G); } SEAM(1);
    if (IN(2)) { ph_conv(a, wk, G); } SEAM(2);
    if (IN(3)) { ph_mixers3(a, lds, wk, G); } SEAM(3);
    if (IN(4)) { ph_gemm2_pg8(a, lds, wk, G); } SEAM(4);
    if (IN(5)) { ph_router(a, lds, 0, wk, G); } SEAM(5);
    if (IN(6)) { ph_moe_up_pg8(a, lds, 0, G); ph_moe_down_pg8(a, lds, 0, G); } SEAM(6);
    STAMP(8); PSTAMP(8);
    if (IN(8)) { ph_pool_fused(a, lds, wk, G); } SEAM(8);
    STAMP(10); PSTAMP(10);
    if (IN(10)) { ph_router(a, lds, 1, wk, G); } SEAM(10);
    if (IN(11)) { ph_moe_up_pg8(a, lds, 1, G); ph_moe_down_pg8(a, lds, 1, G); } SEAM(11);
    STAMP(13); PSTAMP(13);
    if (IN(13)) { ph_final(a, wk, G); }
#ifdef PROBE_K
    if (blockIdx.x == 0 && tid == 0) {
        asm volatile("s_waitcnt vmcnt(0)" ::: "memory");
        if (PROBE_K == 13) pkt[1] = __builtin_amdgcn_s_memrealtime();
        const unsigned long long tend = __builtin_amdgcn_s_memrealtime() + 4ull * (pkt[1] - pkt[0]);
        while (__builtin_amdgcn_s_memrealtime() < tend) __builtin_amdgcn_s_sleep(16);
    }
#endif
#undef IN
#undef SEAM
}

extern "C" void kernel_launch(void* const* d_in, const int* in_sizes, int n_in, void* d_out, int out_size, void* d_ws, size_t ws_size, hipStream_t stream) {
    static int grid = 0;
    if (grid == 0) {
        if (n_in != 31 || out_size != NB * SEQ * D || ws_size < WS_END) { fprintf(stderr, "kernel_launch: unexpected shapes (n_in %d out %d ws %zu)\n", n_in, out_size, ws_size); grid = -1; return; }
        int dev = 0, cus = 0;
        if (hipGetDevice(&dev) != hipSuccess || hipDeviceGetAttribute(&cus, hipDeviceAttributeMultiprocessorCount, dev) != hipSuccess) { grid = -1; return; }
        if (hipFuncSetAttribute((const void*)fwd_kernel, hipFuncAttributeMaxDynamicSharedMemorySize, LDS_BYTES) != hipSuccess) { grid = -1; return; }
        grid = cus;
    }
    if (grid < 0) return;
    (void)hipMemsetAsync((char*)d_ws + WS_CTL, 0, CTL_ZERO_BYTES, stream);
    Args a{};
    for (int i = 0; i < 31; ++i) a.in[i] = (const float*)d_in[i];
    a.out = (float*)d_out; a.ws = (unsigned char*)d_ws;
    if (N_LAUNCHES == 1) { a.ph_lo = 0; a.ph_hi = NPH; hipLaunchKernelGGL(fwd_kernel, dim3(grid), dim3(NWAVES * 64), LDS_BYTES, stream, a); }
    else for (int p = 0; p < NPH; ++p) { a.ph_lo = p; a.ph_hi = p + 1; hipLaunchKernelGGL(fwd_kernel, dim3(grid), dim3(NWAVES * 64), LDS_BYTES, stream, a); }
}
```

```cpp
#include <hip/hip_runtime.h>
#include <cstdio>
#include <cstdint>

#define GAS __attribute__((address_space(1)))
#define LAS __attribute__((address_space(3)))
typedef unsigned short bf16;
typedef short bf16x8 __attribute__((ext_vector_type(8)));
typedef float f32x4 __attribute__((ext_vector_type(4)));
typedef unsigned v4u __attribute__((ext_vector_type(4)));
typedef unsigned v2u __attribute__((ext_vector_type(2)));

#ifndef MK_N_LAUNCHES
#define MK_N_LAUNCHES 1
#endif
constexpr int NPH = 14;
constexpr int N_LAUNCHES = MK_N_LAUNCHES;

constexpr int NB = 8, SEQ = 2048, NMETA = 16, LSEQ = SEQ + NMETA, T = NB * LSEQ, D = 1024;
constexpr int PROJ_SRC = 4624, LDP = 4608;
constexpr int C_Z = 0, C_G = 1024, C_X = 2048, C_B = 3072, C_C = 3328, C_LI = 3584;
constexpr float EPS = 1e-6f;
constexpr int NBK = 24;

constexpr size_t MiB = 1u << 20;
constexpr size_t WS_CTL = 0, CTL_ZERO_BYTES = 1 * MiB;
constexpr size_t WS_WIN = 1 * MiB;
constexpr size_t WS_WOUT = 10 * MiB;
constexpr size_t WS_WPOOL = 14 * MiB;
constexpr size_t WS_WRT = 14 * MiB + 512 * 1024;
constexpr size_t WS_WDTT = 15 * MiB + 512 * 1024;
constexpr size_t WS_RSTD0 = 15 * MiB;
constexpr size_t WS_RSTD1 = WS_RSTD0 + 128 * 1024;
constexpr size_t WS_BKT = WS_RSTD1 + 128 * 1024;
constexpr size_t WS_GATES = WS_BKT + 128 * 1024;
constexpr size_t WS_DT = 16 * MiB;
constexpr size_t WS_SSDSQ = 17 * MiB + 64 * 1024;
constexpr size_t WS_LIST = 19 * MiB;
constexpr size_t WS_WGU = 21 * MiB;
constexpr size_t WS_WD = 53 * MiB;
constexpr size_t WS_H = 69 * MiB;
constexpr size_t WS_PROJ = 134 * MiB;
constexpr size_t WS_HID = WS_PROJ;
constexpr size_t WS_POOLED = WS_PROJ;
constexpr size_t WS_END = 280 * MiB;
constexpr size_t WS_WGU1 = WS_PROJ + 64 * MiB, WS_WD1 = WS_PROJ + 96 * MiB;
__host__ __device__ constexpr size_t ws_wgu(int L) { return L ? WS_WGU1 : WS_WGU; }
__host__ __device__ constexpr size_t ws_wd(int L) { return L ? WS_WD1 : WS_WD; }
constexpr size_t WS_SB = WS_H, WS_SC = WS_H + (size_t)T * D * 2;
static_assert(WS_H + (size_t)T * D * 4 <= WS_PROJ && WS_PROJ + (size_t)T * LDP * 2 <= WS_END, "ws map");
static_assert(WS_DT + (size_t)T * 16 * 4 <= WS_SSDSQ && WS_SSDSQ + (size_t)T * 16 * 4 <= WS_LIST && WS_LIST + (size_t)NBK * T * 4 <= WS_WGU, "ws map small");
constexpr int CW_CNT = 8192;
constexpr int CW_BAR = 4096;
constexpr int CW_RT = 16384;

constexpr int LDS_BYTES = 163840;
constexpr int LDS_TAB = 131072;
constexpr int NWAVES = 8;

struct Args { const float* in[31]; float* out; unsigned char* ws; int ph_lo, ph_hi; };
enum { I_X = 0, I_META, I_NORMF, I_MNE, I_WIN, I_SCW, I_SCB, I_DTB, I_ALOG, I_SD, I_SNORM, I_LCW, I_LCB, I_LWA, I_LBA, I_LWX, I_LBX, I_LLAM, I_WOUT,
       I_MNO, I_PW, I_PB, I_PS, I_FFN, I_RGW, I_RGB, I_REW, I_REB, I_EWG, I_EWU, I_EWD };

#define LDS_WAIT() asm volatile("s_waitcnt lgkmcnt(0)" ::: "memory")
__device__ __forceinline__ float bf2f(unsigned v) { return __uint_as_float(v << 16); }
__device__ __forceinline__ unsigned f2bf(float f) { unsigned u = __float_as_uint(f); return (u + 0x7fffu + ((u >> 16) & 1u)) >> 16; }
__device__ __forceinline__ unsigned pk2(float lo, float hi) { return f2bf(lo) | (f2bf(hi) << 16); }
__device__ __forceinline__ void unpack8v(const v4u r, f32x4& a, f32x4& b) {
    a[0] = __uint_as_float(r.x << 16); a[1] = __uint_as_float(r.x & 0xffff0000u); a[2] = __uint_as_float(r.y << 16); a[3] = __uint_as_float(r.y & 0xffff0000u);
    b[0] = __uint_as_float(r.z << 16); b[1] = __uint_as_float(r.z & 0xffff0000u); b[2] = __uint_as_float(r.w << 16); b[3] = __uint_as_float(r.w & 0xffff0000u);
}
__device__ __forceinline__ float wave_sum(float v) {
#pragma unroll
    for (int o = 1; o < 64; o <<= 1) v += __shfl_xor(v, o);
    return v;
}
__device__ __forceinline__ float rcp_f(float v) { return __builtin_amdgcn_rcpf(v); }
__device__ __forceinline__ float sigmoid_f(float v) { return rcp_f(1.f + __expf(-v)); }
__device__ __forceinline__ float silu_f(float v) { return v * rcp_f(1.f + __expf(-v)); }
__device__ __forceinline__ float softplus_f(float v) {
    const float e = __expf(-fabsf(v));
    const float lp = e < 0.03f ? e * (1.f - e * (0.5f - e * 0.33333334f)) : __logf(1.f + e);
    return fmaxf(v, 0.f) + lp;
}
__device__ __forceinline__ float gelu_tanh_f(float v) { const float u2 = 1.5957691216057308f * (v + 0.044715f * v * v * v); return v * rcp_f(1.f + __expf(-u2)); }
__device__ __forceinline__ const float* h0_row(const Args& a, int row) {
    const int b = row / LSEQ, l = row - b * LSEQ;
    return l < NMETA ? a.in[I_META] + (size_t)l * D : a.in[I_X] + ((size_t)b * SEQ + (l - NMETA)) * D;
}

#define XB_TMO      128
#define XB_XCNT(j)  (256  + 64 * (j))
#define XB_XSUB(j)  (1280 + 64 * (j))
#define XB_XGEN(j)  (2304 + 64 * (j))
#define XB_TOP      3328
#define XB_TOPGEN   3392
#define XCD_BAR_WORDS 3456
#define XB_SPIN_CAP (1u << 18)
__device__ __forceinline__ unsigned xb_ld(unsigned* p)              { return __hip_atomic_load(p, __ATOMIC_RELAXED, __HIP_MEMORY_SCOPE_AGENT); }
__device__ __forceinline__ unsigned xb_add(unsigned* p, unsigned v) { return __hip_atomic_fetch_add(p, v, __ATOMIC_RELAXED, __HIP_MEMORY_SCOPE_AGENT); }
__device__ __forceinline__ unsigned xb_xcc_id() { return (unsigned)__builtin_amdgcn_s_getreg((3 << 11) | 20) & 0xFu; }
#define XB_SPIN(cond, bar) do { unsigned _sp = 0; while (cond) { __builtin_amdgcn_s_sleep(1); \
    if ((++_sp & 255u) == 0u) { if (xb_ld(&(bar)[XB_TMO])) break; if (_sp > XB_SPIN_CAP) { atomicAdd(&(bar)[XB_TMO], 1u); break; } } } } while (0)
struct XcdBarrier { unsigned* bar; unsigned x; volatile LAS unsigned* st; };
__device__ __forceinline__ XcdBarrier xcd_barrier_post(unsigned* bar, volatile LAS unsigned* st) {
    XcdBarrier b; b.bar = bar; b.x = xb_xcc_id(); b.st = st;
    if (threadIdx.x == 0) (void)xb_add(&bar[XB_XCNT(b.x)], 1u);
    return b;
}
__device__ __forceinline__ void xcd_barrier_complete(unsigned* bar, unsigned x, unsigned& nloc, unsigned& nx) {
    const unsigned G = gridDim.x * gridDim.y * gridDim.z;
    unsigned sum, cnt, mine, sp = 0u;
    for (;;) {
        sum = 0u; cnt = 0u; mine = 0u;
#pragma unroll
        for (unsigned j = 0; j < 16; ++j) { const unsigned c = xb_ld(&bar[XB_XCNT(j)]); sum += c; cnt += (c > 0u) ? 1u : 0u; mine = (j == x) ? c : mine; }
        if (sum == G) break;
        __builtin_amdgcn_s_sleep(1);
        if ((++sp & 255u) == 0u) { if (xb_ld(&bar[XB_TMO])) break; if (sp > XB_SPIN_CAP) { atomicAdd(&bar[XB_TMO], 1u); break; } }
    }
    nloc = mine > 0u ? mine : 1u; nx = cnt > 0u ? cnt : 1u;
}
__device__ __forceinline__ void xcd_barrier(const XcdBarrier& b) {
    asm volatile("s_waitcnt vmcnt(0)" ::: "memory");
    __syncthreads();
    if (threadIdx.x == 0) {
        unsigned* bar = b.bar;
        __builtin_amdgcn_s_waitcnt(0);
        unsigned nloc = b.st[0], nx = b.st[1];
        if (nloc == 0u) { xcd_barrier_complete(bar, b.x, nloc, nx); b.st[0] = nloc; b.st[1] = nx; }
        const unsigned old = xb_add(&bar[XB_XSUB(b.x)], 1u);
        const unsigned gen = old / nloc;
        if (old + 1u == (gen + 1u) * nloc) {
            __builtin_amdgcn_fence(__ATOMIC_RELEASE, "agent");
            asm volatile("s_waitcnt vmcnt(0)" ::: "memory");
            const unsigned og = xb_add(&bar[XB_TOP], 1u);
            const unsigned tg = og / nx;
            if (og + 1u == (tg + 1u) * nx) xb_add(&bar[XB_TOPGEN], 1u);
            else XB_SPIN(xb_ld(&bar[XB_TOPGEN]) == tg, bar);
            __builtin_amdgcn_fence(__ATOMIC_ACQUIRE, "agent");
            xb_add(&bar[XB_XGEN(b.x)], 1u);
            asm volatile("s_waitcnt vmcnt(0)" ::: "memory");
        } else {
            XB_SPIN(xb_ld(&bar[XB_XGEN(b.x)]) == gen, bar);
            __builtin_amdgcn_fence(__ATOMIC_ACQUIRE, "agent");
            asm volatile("s_waitcnt vmcnt(0)" ::: "memory");
        }
    }
    __syncthreads();
}

__device__ __forceinline__ void tr_item(const float* src, int ldsrc, const float* gain, bf16* dst, int lddst, LAS float* scr, int lane) {
    float tv[32];
#pragma unroll
    for (int i = 0; i < 32; ++i) { const int kk = 2 * i + (lane >> 5); tv[i] = src[(size_t)kk * ldsrc + (lane & 31)]; }
#pragma unroll
    for (int i = 0; i < 32; ++i) { const int kk = 2 * i + (lane >> 5); float v = tv[i]; if (gain) v *= gain[kk]; scr[kk * 33 + (lane & 31)] = v; }
    LDS_WAIT();
    const int c = lane & 7;
#pragma unroll
    for (int j = 0; j < 4; ++j) { const int n = (lane >> 3) + 8 * j; const LAS float* s = scr + (8 * c) * 33 + n;
        v4u o; o.x = pk2(s[0 * 33], s[1 * 33]); o.y = pk2(s[2 * 33], s[3 * 33]); o.z = pk2(s[4 * 33], s[5 * 33]); o.w = pk2(s[6 * 33], s[7 * 33]);
        *(v4u*)(dst + (size_t)n * lddst + 8 * c) = o; }
    LDS_WAIT();
}
__device__ __forceinline__ void convert_experts(const Args& a, int L, LAS float* scr, int gw, int NGW, int lane) {
    bf16* WGU = (bf16*)(a.ws + ws_wgu(L)); bf16* WD = (bf16*)(a.ws + ws_wd(L));
    const float* gain = a.in[I_FFN] + L * D;
    constexpr int I_GU = 16 * 16 * 16, I_DN = 16 * 8 * 32;
    for (int it = gw; it < 2 * I_GU + I_DN; it += NGW) {
        int r = it;
        if (r < 2 * I_GU) {
            const int up = r >= I_GU; if (up) r -= I_GU;
            const int e = r >> 8, kb = (r >> 4) & 15, nb = r & 15;
            const float* src = a.in[up ? I_EWU : I_EWG] + ((size_t)(L * 16 + e) * 1024 + kb * 64) * 512 + nb * 32;
            const int drow = e * 1024 + (nb >> 2) * 256 + (nb & 3) * 32 + (up ? 128 : 0);
            tr_item(src, 512, gain + kb * 64, WGU + (size_t)drow * 1024 + kb * 64, 1024, scr, lane);
        } else {
            r -= 2 * I_GU;
            const int e = r >> 8, kb = (r >> 5) & 7, nb = r & 31;
            const float* src = a.in[I_EWD] + ((size_t)(L * 16 + e) * 512 + kb * 64) * 1024 + nb * 32;
            tr_item(src, 1024, nullptr, WD + (size_t)(e * 1024 + nb * 32) * 512 + kb * 64, 512, scr, lane);
        }
    }
}
__device__ __forceinline__ void ph_prep(const Args& a, LAS unsigned char* lds, int wk, int nwk) {
    const int tid = threadIdx.x, lane = tid & 63, wave = __builtin_amdgcn_readfirstlane(tid >> 6);
    const int gw = wk * NWAVES + wave, NGW = nwk * NWAVES;
    LAS float* scr = (LAS float*)(lds + wave * 8448);
    bf16* WIN = (bf16*)(a.ws + WS_WIN); bf16* WOUT = (bf16*)(a.ws + WS_WOUT); bf16* WPOOL = (bf16*)(a.ws + WS_WPOOL);
    constexpr int I_IN = 16 * 144, I_OUT = 32 * 32, I_POOL = 4 * 4 * 8;
    for (int it = gw; it < I_IN + I_OUT + I_POOL; it += NGW) {
        int r = it;
        if (r < I_IN) { const int kb = r / 144, nb = r % 144, n0 = nb * 32;
            const int sc = n0 < 1024 ? n0 : (n0 < 2048 ? n0 - 1024 + 2576 : (n0 < 3584 ? n0 - 2048 + 1024 : n0 - 3584 + 3600));
            tr_item(a.in[I_WIN] + (size_t)(kb * 64) * PROJ_SRC + sc, PROJ_SRC, a.in[I_MNE] + kb * 64, WIN + (size_t)n0 * 1024 + kb * 64, 1024, scr, lane); continue; }
        r -= I_IN;
        if (r < I_OUT) { const int kb = r >> 5, nb = r & 31;
            tr_item(a.in[I_WOUT] + (size_t)(kb * 64) * 1024 + nb * 32, 1024, kb < 16 ? a.in[I_SNORM] + kb * 64 : nullptr, WOUT + (size_t)(nb * 32) * 2048 + kb * 64, 2048, scr, lane); continue; }
        r -= I_OUT;
        { const int g = r >> 5, kb = (r >> 3) & 3, nb = r & 7;
            tr_item(a.in[I_PW] + (size_t)g * 65536 + (size_t)(kb * 64) * 256 + nb * 32, 256, a.in[I_MNO] + g * 256 + kb * 64, WPOOL + (size_t)(g * 256 + nb * 32) * 256 + kb * 64, 256, scr, lane); }
    }
    {
        v4u* WRT = (v4u*)(a.ws + WS_WRT); v4u* WDTT = (v4u*)(a.ws + WS_WDTT);
        for (int i = wk * 512 + tid; i < 2 * 48 * 128 + 256 * 128; i += nwk * 512) {
            float f[8];
            if (i < 2 * 48 * 128) {
                const int L = i / 6144, r = i % 6144, n = r >> 7, k8 = (r & 127) * 8, j = n < 20 ? n : n - 20;
#pragma unroll
                for (int e = 0; e < 8; ++e) { const int k = k8 + e; float w = 0.f;
                    if (n < 40) { w = (j < 4 ? a.in[I_RGW][((size_t)L * 1024 + k) * 4 + j] : a.in[I_REW][((size_t)L * 1024 + k) * 16 + (j - 4)]) * a.in[I_FFN][L * 1024 + k];
                        if (n >= 20) w -= bf2f(f2bf(w)); }
                    f[e] = w; }
                v4u o; o.x = pk2(f[0], f[1]); o.y = pk2(f[2], f[3]); o.z = pk2(f[4], f[5]); o.w = pk2(f[6], f[7]); WRT[i] = o;
            } else {
                const int r = i - 2 * 48 * 128, n = r >> 7, k8 = (r & 127) * 8;
#pragma unroll
                for (int e = 0; e < 8; ++e) { const int k = k8 + e; f[e] = n < 16 ? a.in[I_WIN][(size_t)k * PROJ_SRC + 2560 + n] * a.in[I_MNE][k] : 0.f; }
                v4u o; o.x = pk2(f[0], f[1]); o.y = pk2(f[2], f[3]); o.z = pk2(f[4], f[5]); o.w = pk2(f[6], f[7]); WDTT[r] = o;
            }
        }
    }
    bf16* HB = (bf16*)a.out; float* RSTD0 = (float*)(a.ws + WS_RSTD0);
    for (int row = gw; row < T; row += NGW) {
        const f32x4* xr = (const f32x4*)h0_row(a, row) + lane;
        f32x4 v[4]; float ss = 0.f;
#pragma unroll
        for (int j = 0; j < 4; ++j) { v[j] = xr[64 * j]; ss += v[j].x * v[j].x + v[j].y * v[j].y + v[j].z * v[j].z + v[j].w * v[j].w; }
        ss = wave_sum(ss);
        v2u* o8 = (v2u*)(HB + (size_t)row * D) + lane;
#pragma unroll
        for (int j = 0; j < 4; ++j) { v2u w; w.x = pk2(v[j].x, v[j].y); w.y = pk2(v[j].z, v[j].w); o8[64 * j] = w; }
        if (lane == 0) RSTD0[row] = rsqrtf(ss * (1.f / D) + EPS);
    }
}

template <int NT, class BP, class KS>
__device__ __forceinline__ void sg_kloop(int K, const bf16* const (&arow)[4], BP bp, KS ks, f32x4 (&acc)[4][NT], int fr, int fq) {
    for (int k0 = 0; k0 < K; k0 += 32) {
        ks(k0, acc);
        bf16x8 av[4], bv[NT];
#pragma unroll
        for (int mi = 0; mi < 4; ++mi) av[mi] = *(const bf16x8*)(arow[mi] + k0 + 8 * fq);
#pragma unroll
        for (int nj = 0; nj < NT; ++nj) bv[nj] = *(const bf16x8*)(bp(16 * nj + fr, k0) + 8 * fq);
#pragma unroll
        for (int mi = 0; mi < 4; ++mi)
#pragma unroll
            for (int nj = 0; nj < NT; ++nj) acc[mi][nj] = __builtin_amdgcn_mfma_f32_16x16x32_bf16(bv[nj], av[mi], acc[mi][nj], 0, 0, 0);
    }
}
template <int NT> __device__ __forceinline__ void zero_acc(f32x4 (&acc)[4][NT]) {
#pragma unroll
    for (int mi = 0; mi < 4; ++mi)
#pragma unroll
        for (int nj = 0; nj < NT; ++nj) acc[mi][nj] = (f32x4){0.f, 0.f, 0.f, 0.f};
}
struct NoKS { template <int NT> __device__ __forceinline__ void operator()(int, f32x4 (&)[4][NT]) const {} };

__device__ __forceinline__ void ph_gemm1(const Args& a, int wk, int nwk) {
    const int tid = threadIdx.x, lane = tid & 63, wave = __builtin_amdgcn_readfirstlane(tid >> 6), fr = lane & 15, fq = lane >> 4;
    const int gw = wk * NWAVES + wave, NGW = nwk * NWAVES;
    const bf16* HB = (const bf16*)a.out; const bf16* WIN = (const bf16*)(a.ws + WS_WIN); bf16* PROJ = (bf16*)(a.ws + WS_PROJ);
    const float* RSTD0 = (const float*)(a.ws + WS_RSTD0);
    for (int u = gw; u < 258 * 72; u += NGW) {
        const int rt = u / 72, ct = u % 72;
        const bf16* arow[4];
#pragma unroll
        for (int mi = 0; mi < 4; ++mi) arow[mi] = HB + (size_t)(rt * 64 + 16 * mi + fr) * D;
        f32x4 acc[4][4]; zero_acc(acc);
        sg_kloop<4>(1024, arow, [=](int n, int k0) { return WIN + (size_t)(ct * 64 + n) * 1024 + k0; }, NoKS(), acc, fr, fq);
#pragma unroll
        for (int mi = 0; mi < 4; ++mi) { const int row = rt * 64 + 16 * mi + fr; const float rs = RSTD0[row];
#pragma unroll
            for (int nj = 0; nj < 4; ++nj) { const f32x4 v = acc[mi][nj] * rs; v2u w; w.x = pk2(v.x, v.y); w.y = pk2(v.z, v.w);
                *(v2u*)(PROJ + (size_t)row * LDP + ct * 64 + 16 * nj + 4 * fq) = w; } }
    }
}

__device__ __forceinline__ void ph_gemm2(const Args& a, int wk, int nwk) {
    const int tid = threadIdx.x, lane = tid & 63, wave = __builtin_amdgcn_readfirstlane(tid >> 6), fr = lane & 15, fq = lane >> 4;
    const int gw = wk * NWAVES + wave, NGW = nwk * NWAVES;
    const bf16* PROJ = (const bf16*)(a.ws + WS_PROJ); const bf16* WOUT = (const bf16*)(a.ws + WS_WOUT);
    const float* SSDSQ = (const float*)(a.ws + WS_SSDSQ);
    float* H = (float*)(a.ws + WS_H); bf16* HB = (bf16*)a.out;
    for (int u = gw; u < 258 * 16; u += NGW) {
        const int rt = u / 16, ct = u % 16;
        const bf16* arow[4]; float f0[4], f1[4];
#pragma unroll
        for (int mi = 0; mi < 4; ++mi) { const int row = rt * 64 + 16 * mi + fr; arow[mi] = PROJ + (size_t)row * LDP;
            const f32x4* sq = (const f32x4*)(SSDSQ + (size_t)row * 16); const f32x4 q0 = sq[0], q1 = sq[1], q2 = sq[2], q3 = sq[3];
            const float s0 = (q0.x + q0.y + q0.z + q0.w) + (q1.x + q1.y + q1.z + q1.w), s1 = (q2.x + q2.y + q2.z + q2.w) + (q3.x + q3.y + q3.z + q3.w);
            const float r0 = rsqrtf(s0 * (1.f / 512.f) + EPS), r1 = rsqrtf(s1 * (1.f / 512.f) + EPS);
            f0[mi] = r0 / r1; f1[mi] = r1; }
        f32x4 acc[4][4]; zero_acc(acc);
        auto ks = [=](int k0, f32x4 (&ac)[4][4]) {
            if (k0 == 512) {
#pragma unroll
                for (int mi = 0; mi < 4; ++mi)
#pragma unroll
                    for (int nj = 0; nj < 4; ++nj) ac[mi][nj] *= f0[mi]; }
            if (k0 == 1024) {
#pragma unroll
                for (int mi = 0; mi < 4; ++mi)
#pragma unroll
                    for (int nj = 0; nj < 4; ++nj) ac[mi][nj] *= f1[mi]; }
        };
        sg_kloop<4>(2048, arow, [=](int n, int k0) { return WOUT + (size_t)(ct * 64 + n) * 2048 + k0; }, ks, acc, fr, fq);
#pragma unroll
        for (int mi = 0; mi < 4; ++mi) { const int row = rt * 64 + 16 * mi + fr; const float* hr = h0_row(a, row);
#pragma unroll
            for (int nj = 0; nj < 4; ++nj) { const int c = ct * 64 + 16 * nj + 4 * fq; const f32x4 v = acc[mi][nj] + *(const f32x4*)(hr + c);
                *(f32x4*)(H + (size_t)row * D + c) = v; v2u w; w.x = pk2(v.x, v.y); w.y = pk2(v.z, v.w); *(v2u*)(HB + (size_t)row * D + c) = w; } }
    }
}


namespace pg8 {
constexpr int BM = 256, BK = 64, HALF = 128, HTB = HALF * BK * 2, STAGE_BYTES = 8 * HTB, NXCD = 8, WGM = 8;
__host__ __device__ __forceinline__ int lds_byte(int r, int c) { const int st = (r >> 4) * 2 + (c >> 5), rr = r & 15, cc = c & 31, ob = rr * 64 + cc * 2; return st * 1024 + (ob ^ (((ob >> 9) & 1) << 5)); }
__host__ __device__ __forceinline__ void stage_rc(int b, int& R, int& C) { const int st = b / 1024, sb = b % 1024, swz = sb ^ (((sb >> 9) & 1) << 5); R = (st >> 1) * 16 + swz / 64; C = (st & 1) * 32 + (swz % 64) / 2; }
__host__ __device__ __forceinline__ int perm32(int rho) { const int n = rho >> 4, i = rho & 15; return 8 * (i >> 2) + 4 * n + (i & 3); }
__device__ __forceinline__ unsigned cvt_pk_bf16(float lo, float hi) { unsigned r; asm volatile("v_cvt_pk_bf16_f32 %0, %1, %2" : "=v"(r) : "v"(lo), "v"(hi)); return r; }
typedef f32x4 Acc[2][2][4][2];

__device__ __forceinline__ bool static_order(int nM, int nN, int G, int c, int i, int& pm, int& pn) {
    const int nwg = nM * nN; const long L = (long)i * G + c; if (L >= nwg) return false;
    int wgid = (int)L; { const int q = nwg / NXCD, r = nwg % NXCD, xcd = wgid % NXCD, off = wgid / NXCD; wgid = (xcd < r ? xcd * (q + 1) : r * (q + 1) + (xcd - r) * q) + off; }
    const int nig = WGM * nN, gid = wgid / nig, fm = gid * WGM, gsz = (nM - fm) < WGM ? (nM - fm) : WGM;
    pm = fm + ((wgid % nig) % gsz); pn = (wgid % nig) / gsz; return true;
}

template <class P, bool ALIGN_EPI>
__device__ __forceinline__ void gemm_phase(LAS unsigned char* lds, const P& S) {
    const int tid = threadIdx.x, wid = __builtin_amdgcn_readfirstlane(tid >> 6), lane = tid & 63, wr = wid >> 2, wc = wid & 3, fr = lane & 15, fq = lane >> 4;
    const int nt = S.nt;
    int RA[2], CA[2]; unsigned voffB[2];
#pragma unroll
    for (int i = 0; i < 2; ++i) { int R, C; stage_rc(tid * 16 + i * 8192, R, C); RA[i] = R; CA[i] = C; const int Rb = P::PERM ? ((R & ~31) + perm32(R & 31)) : R;
        voffB[i] = (unsigned)(Rb * S.ldb + C) * 2u; }
    const size_t kstep = (size_t)(BK * 2);
    const size_t hstepB = (size_t)HALF * S.ldb * 2;
    const unsigned ldsw = (unsigned)wid * 1024u;
    const int aoff = lds_byte(wr * 64 + fr, fq * 8), boff = lds_byte(wc * 32 + fr, fq * 8);
#define PG8_SA(b, h) (((b) * 2 + (h)) * HTB)
#define PG8_SB(b, h) ((4 + (b) * 2 + (h)) * HTB)
#define PG8_STAGE(bufoff, gbase, voff) do { _Pragma("unroll") for (int _i = 0; _i < 2; ++_i) \
        __builtin_amdgcn_global_load_lds((const unsigned*)((const char*)(gbase) + (voff)[_i]), (LAS unsigned*)(lds + (bufoff) + ldsw + _i * 8192), 16, 0, 0); } while (0)
#define PG8_LDA(dst, b, h) do { _Pragma("unroll") for (int m = 0; m < 4; ++m) _Pragma("unroll") for (int k = 0; k < 2; ++k) dst[m][k] = *(const LAS bf16x8*)(lds + PG8_SA(b, h) + aoff + m * 2048 + k * 1024); } while (0)
#define PG8_LDB(dst, b, h) do { _Pragma("unroll") for (int n = 0; n < 2; ++n) _Pragma("unroll") for (int k = 0; k < 2; ++k) dst[n][k] = *(const LAS bf16x8*)(lds + PG8_SB(b, h) + boff + n * 2048 + k * 1024); } while (0)
#define PG8_MMA(ai, bj, At, Bt) do { __builtin_amdgcn_s_setprio(1); _Pragma("unroll") for (int m = 0; m < 4; ++m) _Pragma("unroll") for (int n = 0; n < 2; ++n) _Pragma("unroll") for (int k = 0; k < 2; ++k) \
        acc[ai][bj][m][n] = __builtin_amdgcn_mfma_f32_16x16x32_bf16(Bt[n][k], At[m][k], acc[ai][bj][m][n], 0, 0, 0); __builtin_amdgcn_s_setprio(0); } while (0)
#define PG8_WAIT_V(n) asm volatile("s_waitcnt vmcnt(" #n ")" ::: "memory")
#define PG8_WAIT_L(n) asm volatile("s_waitcnt lgkmcnt(" #n ")" ::: "memory")
#define PG8_BAR __builtin_amdgcn_s_barrier()
#define PG8_SCHED __builtin_amdgcn_sched_barrier(0)
    typename P::Unit cur, nxt; int ui = 0;
    if (!S.next(0, cur)) return;
    f32x4 acc[2][2][4][2];
#pragma unroll
    for (int a = 0; a < 2; ++a)
#pragma unroll
        for (int b = 0; b < 2; ++b)
#pragma unroll
            for (int m = 0; m < 4; ++m)
#pragma unroll
                for (int n = 0; n < 2; ++n) acc[a][b][m][n] = (f32x4){0.f, 0.f, 0.f, 0.f};
    bf16x8 At[4][2], B0[2][2], B1[2][2];
    typename P::EpiRegs er;
    unsigned vA[4];
    S.a_ready(cur);
    S.avoff(cur, RA, CA, vA);
    const char* cA = S.abase(cur);
    {
        const char* b0 = S.btile(cur, 0); const char* b1 = S.btile(cur, 1);
        PG8_STAGE(PG8_SB(0, 0), b0, voffB); PG8_STAGE(PG8_SB(0, 1), b0 + hstepB, voffB); PG8_STAGE(PG8_SA(0, 0), cA, vA); PG8_STAGE(PG8_SA(0, 1), cA, vA + 2);
        if (wr == 1) PG8_BAR;
        PG8_WAIT_V(2); PG8_BAR;
        PG8_STAGE(PG8_SB(1, 0), b1, voffB); PG8_STAGE(PG8_SA(1, 0), cA + kstep, vA); PG8_STAGE(PG8_SB(1, 1), b1 + hstepB, voffB);
        PG8_WAIT_V(6); PG8_BAR;
    }
    for (;;) {
        const bool has_next = S.next(ui + 1, nxt);
        for (int t = 0; t < nt; t += 2) {
            const bool last = (t == nt - 2);
            const char* a1 = cA + (size_t)(t + 1) * kstep;
            S.khook(t, acc, cur, lds, wr, wc, fr, fq);
            if (last) S.epi_pre(cur, er, wr, wc, fr, fq);
            PG8_LDB(B0, 0, 0); PG8_LDB(B1, 0, 1); PG8_SCHED; PG8_LDA(At, 0, 0); PG8_STAGE(PG8_SA(1, 1), a1, vA + 2);
            PG8_WAIT_V(8); PG8_WAIT_L(0); PG8_BAR; PG8_MMA(0, 0, At, B0); PG8_MMA(0, 1, At, B1); PG8_BAR; PG8_SCHED;
            const bool sw = last && has_next;
            if (sw) { S.a_ready(nxt);
                int t2 = tid; asm volatile("" : "+v"(t2));
                int RA2[2], CA2[2];
#pragma unroll
                for (int i = 0; i < 2; ++i) stage_rc(t2 * 16 + i * 8192, RA2[i], CA2[i]);
                S.avoff(nxt, RA2, CA2, vA); }
            const char* a2 = last ? (sw ? S.abase(nxt) : cA) : cA + (size_t)(t + 2) * kstep;
            const char* b2 = last ? (sw ? S.btile(nxt, 0) : S.btile(cur, 0)) : S.btile(cur, t + 2);
            const char* b3 = last ? (sw ? S.btile(nxt, 1) : S.btile(cur, 1)) : S.btile(cur, t + 3);
            const char* a3 = a2 + kstep;
            PG8_LDA(At, 0, 1); PG8_STAGE(PG8_SB(0, 0), b2, voffB); PG8_STAGE(PG8_SB(0, 1), b2 + hstepB, voffB); PG8_STAGE(PG8_SA(0, 0), a2, vA);
            PG8_WAIT_V(8); PG8_WAIT_L(0); PG8_BAR; PG8_MMA(1, 0, At, B0); PG8_MMA(1, 1, At, B1); PG8_BAR; PG8_SCHED;
            PG8_LDB(B0, 1, 0); PG8_LDB(B1, 1, 1); PG8_SCHED; PG8_LDA(At, 1, 0); PG8_STAGE(PG8_SA(0, 1), a2, vA + 2);
            PG8_WAIT_V(8); PG8_WAIT_L(0); PG8_BAR; PG8_MMA(0, 0, At, B0); PG8_MMA(0, 1, At, B1); PG8_BAR; PG8_SCHED;
            PG8_LDA(At, 1, 1); PG8_STAGE(PG8_SB(1, 0), b3, voffB); PG8_STAGE(PG8_SB(1, 1), b3 + hstepB, voffB); PG8_STAGE(PG8_SA(1, 0), a3, vA);
            PG8_WAIT_V(8); PG8_WAIT_L(0); PG8_BAR; PG8_MMA(1, 0, At, B0); PG8_MMA(1, 1, At, B1); PG8_BAR; PG8_SCHED;
        }
        if constexpr (ALIGN_EPI) { if (wr == 0) PG8_BAR; }
        S.epi(acc, cur, er, wr, wc, fr, fq);
        S.done(cur);
        if (!has_next) break;
#pragma unroll
        for (int a = 0; a < 2; ++a)
#pragma unroll
            for (int b = 0; b < 2; ++b)
#pragma unroll
                for (int m = 0; m < 4; ++m)
#pragma unroll
                    for (int n = 0; n < 2; ++n) acc[a][b][m][n] = (f32x4){0.f, 0.f, 0.f, 0.f};
        cur = nxt; cA = S.abase(cur); ++ui;
        if constexpr (ALIGN_EPI) { if (wr == 1) PG8_BAR; }
    }
    PG8_WAIT_V(0);
    if constexpr (!ALIGN_EPI) { if (wr == 0) PG8_BAR; }
    PG8_BAR;
#undef PG8_SA
#undef PG8_SB
#undef PG8_STAGE
#undef PG8_LDA
#undef PG8_LDB
#undef PG8_MMA
#undef PG8_WAIT_V
#undef PG8_WAIT_L
#undef PG8_BAR
#undef PG8_SCHED
}
}

struct PGemm1 {
    static constexpr bool PERM = true;
    struct EpiRegs {};
    template <class U_> __device__ __forceinline__ void epi_pre(const U_&, EpiRegs&, int, int, int, int) const {}
    struct Unit { int pm, pn, ui; };
    const char* A; const char* B; const char* Bdt; bf16* O; const float* rstd; const LAS float* rstab; float* DT; const float* dtb; int G, c; int ldb, nt;
    __device__ __forceinline__ bool next(int i, Unit& u) const { u.ui = i; return pg8::static_order(65, 19, G, c, i, u.pm, u.pn); }
    __device__ __forceinline__ void avoff(const Unit& u, const int (&RA)[2], const int (&CA)[2], unsigned (&v)[4]) const {
#pragma unroll
        for (int h = 0; h < 2; ++h)
#pragma unroll
            for (int i = 0; i < 2; ++i) { int row = u.pm * 256 + h * 128 + RA[i]; row = row < T ? row : T - 1; v[h * 2 + i] = (unsigned)(row * D + CA[i]) * 2u; }
    }
    __device__ __forceinline__ const char* abase(const Unit&) const { return A; }
    __device__ __forceinline__ const char* btile(const Unit& u, int t) const { return (u.pn < 18 ? B + (size_t)u.pn * 256 * 1024 * 2 : Bdt) + (size_t)t * 64 * 2; }
    __device__ __forceinline__ void khook(int, pg8::Acc&, const Unit&, LAS unsigned char*, int, int, int, int) const {}
    __device__ __forceinline__ void a_ready(const Unit&) const {}
    __device__ __forceinline__ void done(const Unit&) const {}
    __device__ __forceinline__ void epi(const pg8::Acc& acc, const Unit& u, const EpiRegs&, int wr, int wc, int fr, int fq) const {
        const int row0 = u.pm * 256 + wr * 64 + fr, col0 = u.pn * 256 + wc * 32 + 8 * fq;
        float rsv[2][4];
#pragma unroll
        for (int ai = 0; ai < 2; ++ai)
#pragma unroll
            for (int m = 0; m < 4; ++m) rsv[ai][m] = rstab[u.ui * 256 + wr * 64 + fr + ai * 128 + m * 16];
        if (u.pn == 18) {
            if (wc == 0 && fq < 2) { const f32x4 b0 = *(const f32x4*)(dtb + 8 * fq), b1 = *(const f32x4*)(dtb + 8 * fq + 4);
#pragma unroll
                for (int ai = 0; ai < 2; ++ai)
#pragma unroll
                    for (int m = 0; m < 4; ++m) { const int row = row0 + ai * 128 + m * 16;
                        if (row < T) { const float rs = rsv[ai][m]; f32x4 d0 = acc[ai][0][m][0] * rs + b0, d1 = acc[ai][0][m][1] * rs + b1;
#pragma unroll
                            for (int j = 0; j < 4; ++j) { d0[j] = softplus_f(d0[j]); d1[j] = softplus_f(d1[j]); }
                            *(f32x4*)(DT + (size_t)row * 16 + 8 * fq) = d0; *(f32x4*)(DT + (size_t)row * 16 + 8 * fq + 4) = d1; } } }
            return; }
#pragma unroll
        for (int ai = 0; ai < 2; ++ai)
#pragma unroll
            for (int m = 0; m < 4; ++m) { const int row = row0 + ai * 128 + m * 16;
                if (row < T) { const float rs = rsv[ai][m]; bf16* rowp = O + (size_t)row * LDP + col0;
#pragma unroll
                    for (int bj = 0; bj < 2; ++bj) { const f32x4 v0 = acc[ai][bj][m][0] * rs, v1 = acc[ai][bj][m][1] * rs;
                        v4u w; w.x = pg8::cvt_pk_bf16(v0[0], v0[1]); w.y = pg8::cvt_pk_bf16(v0[2], v0[3]); w.z = pg8::cvt_pk_bf16(v1[0], v1[1]); w.w = pg8::cvt_pk_bf16(v1[2], v1[3]);
                        *(v4u*)(rowp + bj * 128) = w; } } }
    }
};
__device__ __forceinline__ void ph_gemm1_pg8(const Args& a, LAS unsigned char* lds, int G) {
    PGemm1 S; S.A = (const char*)a.out; S.B = (const char*)(a.ws + WS_WIN); S.O = (bf16*)(a.ws + WS_PROJ); S.rstd = (const float*)(a.ws + WS_RSTD0); S.Bdt = (const char*)(a.ws + WS_WDTT); S.DT = (float*)(a.ws + WS_DT); S.dtb = a.in[I_DTB];
    S.G = G; S.c = (int)blockIdx.x; S.ldb = 1024; S.nt = 16;
    {
        LAS float* rt = (LAS float*)(lds + LDS_TAB); S.rstab = rt; PGemm1::Unit u;
        __syncthreads();
        for (int i = 0; i < 8 && S.next(i, u); ++i) if (threadIdx.x < 256) { const int row = u.pm * 256 + (int)threadIdx.x; rt[i * 256 + threadIdx.x] = S.rstd[row < T ? row : T - 1]; }
        __syncthreads();
    }
    pg8::gemm_phase<PGemm1, true>(lds, S);
}

__device__ __forceinline__ void ssd_item(const Args& a, LAS unsigned char* lds, int b, int h) {
    const int tid = threadIdx.x, lane = tid & 63;
    constexpr int TB = 64;
    LAS float* xs = (LAS float*)lds;
    LAS float* Bs = xs + TB * 64;
    LAS float* Cs = Bs + TB * 128;
    LAS float* ys = Cs + TB * 128;
    LAS float* dts = ys + TB * 64;
    LAS float* decs = dts + TB;
    bf16* PROJ = (bf16*)(a.ws + WS_PROJ); const float* DT = (const float*)(a.ws + WS_DT); float* SSDSQ = (float*)(a.ws + WS_SSDSQ);
    const int g = h >> 3;
    const float Ah = -__expf(a.in[I_ALOG][h]), Dh = a.in[I_SD][h];
    int ccol = 0, cch = 0; float cw0 = 0.f, cw1 = 0.f, cw2 = 0.f, cw3 = 0.f, cb = 0.f;
    if (tid < 320) {
        if (tid < 64) { ccol = C_X + h * 64 + tid; cch = h * 64 + tid; }
        else if (tid < 192) { ccol = C_B + g * 128 + (tid - 64); cch = 1024 + g * 128 + (tid - 64); }
        else { ccol = C_C + g * 128 + (tid - 192); cch = 1280 + g * 128 + (tid - 192); }
        const float* cw = a.in[I_SCW]; cw0 = cw[cch]; cw1 = cw[1536 + cch]; cw2 = cw[2 * 1536 + cch]; cw3 = cw[3 * 1536 + cch]; cb = a.in[I_SCB][cch];
    }
    const int p = tid >> 3, nq = tid & 7;
    float S[16];
#pragma unroll
    for (int i = 0; i < 16; ++i) S[i] = 0.f;
    const size_t rbase = (size_t)b * LSEQ;
    for (int l0 = 0; l0 < LSEQ; l0 += TB) {
        const int nt = (LSEQ - l0) < TB ? (LSEQ - l0) : TB;
        __syncthreads();
        if (tid < 320) {
            float r0 = l0 >= 3 ? bf2f(PROJ[(rbase + l0 - 3) * LDP + ccol]) : 0.f, r1 = l0 >= 2 ? bf2f(PROJ[(rbase + l0 - 2) * LDP + ccol]) : 0.f, r2 = l0 >= 1 ? bf2f(PROJ[(rbase + l0 - 1) * LDP + ccol]) : 0.f;
            for (int t = 0; t < nt; ++t) {
                const float r3 = bf2f(PROJ[(rbase + l0 + t) * LDP + ccol]);
                const float v = silu_f(cw0 * r0 + cw1 * r1 + cw2 * r2 + cw3 * r3 + cb);
                if (tid < 64) xs[t * 64 + tid] = v; else if (tid < 192) Bs[t * 128 + tid - 64] = v; else Cs[t * 128 + tid - 192] = v;
                r0 = r1; r1 = r2; r2 = r3;
            }
        } else if (tid < 320 + TB) {
            const int t = tid - 320;
            if (t < nt) { const float dt = DT[(rbase + l0 + t) * 16 + h]; dts[t] = dt; decs[t] = __expf(Ah * dt); }
        }
        __syncthreads();
        for (int t = 0; t < nt; ++t) {
            const float xv = xs[t * 64 + p], xdt = xv * dts[t], dec = decs[t];
            float yp = 0.f;
#pragma unroll
            for (int i = 0; i < 16; ++i) { S[i] = dec * S[i] + Bs[t * 128 + nq * 16 + i] * xdt; yp += Cs[t * 128 + nq * 16 + i] * S[i]; }
            yp += __shfl_xor(yp, 1); yp += __shfl_xor(yp, 2); yp += __shfl_xor(yp, 4);
            if (nq == 0) ys[t * 64 + p] = yp + Dh * xv;
        }
        __syncthreads();
        for (int t = tid >> 6; t < nt; t += 8) {
            const size_t row = rbase + l0 + t;
            const float z = bf2f(PROJ[row * LDP + C_Z + h * 64 + lane]);
            const float yg = ys[t * 64 + lane] * silu_f(z);
            PROJ[row * LDP + C_Z + h * 64 + lane] = (bf16)f2bf(yg);
            const float sq = wave_sum(yg * yg);
            if (lane == 0) SSDSQ[row * 16 + h] = sq;
        }
    }
    __syncthreads();
}
__device__ __forceinline__ void lru_item(const Args& a, LAS unsigned char* lds, int b, int h) {
    const int tid = threadIdx.x;
    constexpr int TB = 64;
    LAS float* Wa = (LAS float*)lds;
    LAS float* Wx = Wa + 4096;
    LAS float* xb = Wx + 4096;
    LAS float* as = xb + TB * 64;
    LAS float* us = as + TB * 64;
    bf16* PROJ = (bf16*)(a.ws + WS_PROJ);
    __syncthreads();
    for (int i = tid; i < 4096; i += 512) { Wa[i] = a.in[I_LWA][(size_t)h * 4096 + i]; Wx[i] = a.in[I_LWX][(size_t)h * 4096 + i]; }
    const size_t rbase = (size_t)b * LSEQ;
    float hprev = 0.f;
    const int c = tid & 63, tq = tid >> 6;
    const float* cw = a.in[I_LCW]; const int ch = h * 64 + c;
    const float cw0 = cw[ch], cw1 = cw[1024 + ch], cw2 = cw[2048 + ch], cw3 = cw[3072 + ch], cb = a.in[I_LCB][ch];
    const int gt = tid >> 3, jq = tid & 7;
    for (int l0 = 0; l0 < LSEQ; l0 += TB) {
        const int nt = (LSEQ - l0) < TB ? (LSEQ - l0) : TB;
        __syncthreads();
        for (int t = tq * 8; t < tq * 8 + 8; ++t) if (t < nt) {
            const int l = l0 + t; const size_t row = rbase + l;
            const float r3 = bf2f(PROJ[row * LDP + C_LI + ch]);
            const float r2 = l >= 1 ? bf2f(PROJ[(row - 1) * LDP + C_LI + ch]) : 0.f;
            const float r1 = l >= 2 ? bf2f(PROJ[(row - 2) * LDP + C_LI + ch]) : 0.f;
            const float r0 = l >= 3 ? bf2f(PROJ[(row - 3) * LDP + C_LI + ch]) : 0.f;
            xb[t * 64 + c] = cw0 * r0 + cw1 * r1 + cw2 * r2 + cw3 * r3 + cb;
        }
        __syncthreads();
        if (gt < nt) {
            float ra[8], ri[8];
#pragma unroll
            for (int j = 0; j < 8; ++j) { ra[j] = 0.f; ri[j] = 0.f; }
            for (int i = 0; i < 64; ++i) { const float xv = xb[gt * 64 + i];
#pragma unroll
                for (int j = 0; j < 8; ++j) { ra[j] += xv * Wa[i * 64 + jq * 8 + j]; ri[j] += xv * Wx[i * 64 + jq * 8 + j]; } }
#pragma unroll
            for (int j = 0; j < 8; ++j) { const int cc = h * 64 + jq * 8 + j;
                const float r = sigmoid_f(ra[j] + a.in[I_LBA][cc]), ig = sigmoid_f(ri[j] + a.in[I_LBX][cc]);
                const float log_a = -8.0f * r * softplus_f(-a.in[I_LLAM][cc]);
                const float av = __expf(log_a);
                const float mult = (l0 + gt == 0) ? 1.f : sqrtf(fmaxf(-expm1f(2.f * log_a), 0.f));
                as[gt * 64 + jq * 8 + j] = av; us[gt * 64 + jq * 8 + j] = mult * ig * xb[gt * 64 + jq * 8 + j]; }
        }
        __syncthreads();
        if (tid < 64) { for (int t = 0; t < nt; ++t) { hprev = as[t * 64 + tid] * hprev + us[t * 64 + tid]; us[t * 64 + tid] = hprev; } }
        __syncthreads();
        for (int t = tq * 8; t < tq * 8 + 8; ++t) if (t < nt) {
            const size_t row = rbase + l0 + t;
            const float gv = bf2f(PROJ[row * LDP + C_G + ch]);
            PROJ[row * LDP + C_G + ch] = (bf16)f2bf(us[t * 64 + c] * gelu_tanh_f(gv));
        }
    }
    __syncthreads();
}
__device__ __forceinline__ void ph_mixers(const Args& a, LAS unsigned char* lds, int wk, int nwk) {
    for (int it = wk; it < 256; it += nwk) {
        if (it < 128) ssd_item(a, lds, it >> 4, it & 15); else lru_item(a, lds, (it - 128) >> 4, (it - 128) & 15);
    }
}


__device__ __forceinline__ f32x4 mfma16(bf16x8 a, bf16x8 b, f32x4 c) { return __builtin_amdgcn_mfma_f32_16x16x32_bf16(a, b, c, 0, 0, 0); }
constexpr int RSX = 144, RSB = 272;
constexpr int SO_X = 0, SO_B = SO_X + 128 * RSX, SO_C = SO_B + 128 * RSB, SO_M = SO_C + 128 * RSB, SO_S = SO_M + 128 * RSB, SO_V = SO_S + 64 * RSB;
static_assert(SO_V + 4096 <= LDS_BYTES - 256, "ssd lds");
#define TR4(RS4, o0, o1, o2, o3, addr) do { v2u l0_, h0_, l1_, h1_, l2_, h2_, l3_, h3_; \
    asm volatile("ds_read_b64_tr_b16 %0, %8\n\tds_read_b64_tr_b16 %1, %8 offset:" #RS4 "\n\t" \
                 "ds_read_b64_tr_b16 %2, %8 offset:32\n\tds_read_b64_tr_b16 %3, %8 offset:" #RS4 "+32\n\t" \
                 "ds_read_b64_tr_b16 %4, %8 offset:64\n\tds_read_b64_tr_b16 %5, %8 offset:" #RS4 "+64\n\t" \
                 "ds_read_b64_tr_b16 %6, %8 offset:96\n\tds_read_b64_tr_b16 %7, %8 offset:" #RS4 "+96\n\ts_waitcnt lgkmcnt(0)" \
                 : "=&v"(l0_), "=&v"(h0_), "=&v"(l1_), "=&v"(h1_), "=&v"(l2_), "=&v"(h2_), "=&v"(l3_), "=&v"(h3_) : "v"(addr) : "memory"); \
    o0 = __builtin_bit_cast(bf16x8, (v4u){l0_.x, l0_.y, h0_.x, h0_.y}); o1 = __builtin_bit_cast(bf16x8, (v4u){l1_.x, l1_.y, h1_.x, h1_.y}); \
    o2 = __builtin_bit_cast(bf16x8, (v4u){l2_.x, l2_.y, h2_.x, h2_.y}); o3 = __builtin_bit_cast(bf16x8, (v4u){l3_.x, l3_.y, h3_.x, h3_.y}); } while (0)
#define TR1(RS4, o0, addr) do { v2u l0_, h0_; \
    asm volatile("ds_read_b64_tr_b16 %0, %2\n\tds_read_b64_tr_b16 %1, %2 offset:" #RS4 "\n\ts_waitcnt lgkmcnt(0)" : "=&v"(l0_), "=&v"(h0_) : "v"(addr) : "memory"); \
    o0 = __builtin_bit_cast(bf16x8, (v4u){l0_.x, l0_.y, h0_.x, h0_.y}); } while (0)
__device__ __forceinline__ void unpack8(const v4u r, float (&f)[8]) {
    f[0] = __uint_as_float(r.x << 16); f[1] = __uint_as_float(r.x & 0xffff0000u); f[2] = __uint_as_float(r.y << 16); f[3] = __uint_as_float(r.y & 0xffff0000u);
    f[4] = __uint_as_float(r.z << 16); f[5] = __uint_as_float(r.z & 0xffff0000u); f[6] = __uint_as_float(r.w << 16); f[7] = __uint_as_float(r.w & 0xffff0000u);
}
__device__ __forceinline__ void ph_conv(const Args& a, int wk, int nwk) {
    const bf16* PROJ = (const bf16*)(a.ws + WS_PROJ); bf16* XACT = (bf16*)(a.ws + WS_H);
    for (int id = wk * 512 + (int)threadIdx.x; id < NB * 48 * 192; id += nwk * 512) {
        const int cg = id % 192, rr = id / 192, b = rr / 48, t0 = (rr % 48) * 43;
        const int ch = cg * 8;
        const float* cwp = a.in[I_SCW] + ch;
        float cw[4][8], cb[8];
#pragma unroll
        for (int k = 0; k < 4; ++k) { const f32x4 wa = *(const f32x4*)(cwp + k * 1536), wb = *(const f32x4*)(cwp + k * 1536 + 4);
#pragma unroll
            for (int j = 0; j < 4; ++j) { cw[k][j] = wa[j]; cw[k][4 + j] = wb[j]; } }
        { const float* cbp = a.in[I_SCB] + ch; const f32x4 wa = *(const f32x4*)cbp, wb = *(const f32x4*)(cbp + 4);
#pragma unroll
          for (int j = 0; j < 4; ++j) { cb[j] = wa[j]; cb[4 + j] = wb[j]; } }
        const size_t rb = (size_t)b * LSEQ;
        const bf16* src = PROJ + rb * LDP + 2048 + cg * 8;
        bf16* dst = XACT + rb * 1536 + ch;
        float p0[8], p1[8], p2[8];
        {   v4u q0 = (v4u){0u, 0u, 0u, 0u}, q1 = q0, q2 = q0;
            if (t0 >= 3) { q0 = *(const v4u*)(src + (size_t)(t0 - 3) * LDP); q1 = *(const v4u*)(src + (size_t)(t0 - 2) * LDP); q2 = *(const v4u*)(src + (size_t)(t0 - 1) * LDP); }
            unpack8(q0, p0); unpack8(q1, p1); unpack8(q2, p2); }
#pragma unroll 4
        for (int t = 0; t < 43; ++t) {
            const int l = t0 + t; float p3[8]; unpack8(*(const v4u*)(src + (size_t)l * LDP), p3);
            float o[8];
#pragma unroll
            for (int j = 0; j < 8; ++j) { o[j] = silu_f(cw[0][j] * p0[j] + cw[1][j] * p1[j] + cw[2][j] * p2[j] + cw[3][j] * p3[j] + cb[j]); p0[j] = p1[j]; p1[j] = p2[j]; p2[j] = p3[j]; }
            v4u ov; ov.x = pk2(o[0], o[1]); ov.y = pk2(o[2], o[3]); ov.z = pk2(o[4], o[5]); ov.w = pk2(o[6], o[7]);
            *(v4u*)(dst + (size_t)l * 1536) = ov;
        }
    }
}
__device__ __forceinline__ void ssd_item3(const Args& a, LAS unsigned char* lds, int b, int h) {
    const int tid = threadIdx.x, lane = tid & 63, w = __builtin_amdgcn_readfirstlane(tid >> 6), fr0 = lane & 15, fq0 = lane >> 4;
    bf16* PROJ = (bf16*)(a.ws + WS_PROJ); const bf16* XACT = (const bf16*)(a.ws + WS_H); const float* DT = (const float*)(a.ws + WS_DT); float* SSDSQ = (float*)(a.ws + WS_SSDSQ);
    const int g = h >> 3;
    const float Ah = -__expf(a.in[I_ALOG][h]), Dh = a.in[I_SD][h];
    LAS float* acs = (LAS float*)(lds + SO_V); LAS float* dtv = acs + 128; LAS float* wv = acs + 256; LAS float* eacs = acs + 384;
    const size_t rbase = (size_t)b * LSEQ;
    const int pt_s = w & 3, nh = w >> 2;
    f32x4 sacc[4];
#pragma unroll
    for (int i = 0; i < 4; ++i) sacc[i] = (f32x4){0.f, 0.f, 0.f, 0.f};
    __syncthreads();
    for (int i = tid; i < 64 * RSB / 4; i += 512) ((LAS unsigned*)(lds + SO_S))[i] = 0u;
    v4u pf[10], zp[2]; float d0 = 0.f, d1 = 0.f;
    const int ft = tid >> 2, q4 = tid & 3;
    const int xr_ = tid >> 3, xp_ = tid & 7, br_ = tid >> 4, bp_ = tid & 15;
    const bf16* xsrc = XACT + (rbase + xr_) * 1536 + h * 64 + xp_ * 8;
    const bf16* bsrc = XACT + (rbase + br_) * 1536 + 1024 + g * 128 + bp_ * 8;
#define SSD_PREFETCH(L0) do { const int l0_ = (L0); \
        _Pragma("unroll") for (int i = 0; i < 2; ++i) { pf[i] = (v4u){0u, 0u, 0u, 0u}; if (l0_ + xr_ + 64 * i < LSEQ) pf[i] = *(const v4u*)(xsrc + (size_t)(l0_ + 64 * i) * 1536); } \
        _Pragma("unroll") for (int i = 0; i < 4; ++i) { pf[2 + i] = (v4u){0u, 0u, 0u, 0u}; pf[6 + i] = (v4u){0u, 0u, 0u, 0u}; \
            if (l0_ + br_ + 32 * i < LSEQ) { pf[2 + i] = *(const v4u*)(bsrc + (size_t)(l0_ + 32 * i) * 1536); pf[6 + i] = *(const v4u*)(bsrc + (size_t)(l0_ + 32 * i) * 1536 + 256); } } \
        zp[0] = (v4u){0u, 0u, 0u, 0u}; zp[1] = zp[0]; \
        if (l0_ + ft < LSEQ) { const bf16* zq = PROJ + (rbase + l0_ + ft) * LDP + C_Z + h * 64 + 16 * q4; zp[0] = *(const v4u*)zq; zp[1] = *(const v4u*)(zq + 8); } \
        if (w == 0) { d0 = (l0_ + lane) < LSEQ ? DT[(rbase + l0_ + lane) * 16 + h] : 0.f; d1 = (l0_ + lane + 64) < LSEQ ? DT[(rbase + l0_ + lane + 64) * 16 + h] : 0.f; } } while (0)
    SSD_PREFETCH(0);
    for (int l0 = 0; l0 < LSEQ; l0 += 128) {
        const int nvalid = (LSEQ - l0) < 128 ? (LSEQ - l0) : 128;
        int fr = fr0, fq = fq0; asm volatile("" : "+v"(fr), "+v"(fq));
#pragma unroll
        for (int i = 0; i < 2; ++i) *(LAS v4u*)(lds + SO_X + (xr_ + 64 * i) * RSX + xp_ * 16) = pf[i];
#pragma unroll
        for (int i = 0; i < 4; ++i) { *(LAS v4u*)(lds + SO_B + (br_ + 32 * i) * RSB + bp_ * 16) = pf[2 + i]; *(LAS v4u*)(lds + SO_C + (br_ + 32 * i) * RSB + bp_ * 16) = pf[6 + i]; }
        const v4u z0 = zp[0], z1 = zp[1];
        if (w == 0) {
            float a0 = Ah * d0, a1 = Ah * d1;
#pragma unroll
            for (int o = 1; o < 64; o <<= 1) { const float v0 = __shfl_up(a0, o), v1 = __shfl_up(a1, o); if (lane >= o) { a0 += v0; a1 += v1; } }
            a1 += __shfl(a0, 63);
            const float aend = __shfl(a1, 63);
            acs[lane] = a0; acs[lane + 64] = a1; dtv[lane] = d0; dtv[lane + 64] = d1;
            wv[lane] = __expf(aend - a0) * d0; wv[lane + 64] = __expf(aend - a1) * d1; eacs[lane] = __expf(a0); eacs[lane + 64] = __expf(a1);
            if (lane == 0) acs[512] = aend;
        }
        __syncthreads();
        if (l0 + 128 < LSEQ) SSD_PREFETCH(l0 + 128);
        for (int hh = 0; hh < 2; ++hh) {
            f32x4 gacc[4];
#pragma unroll
            for (int st = 0; st < 4; ++st) gacc[st] = (f32x4){0.f, 0.f, 0.f, 0.f};
#pragma unroll
            for (int k0 = 0; k0 < 128; k0 += 32) {
                const bf16x8 cf = *(const LAS bf16x8*)(lds + SO_C + (16 * w + fr) * RSB + (k0 + 8 * fq) * 2);
                bf16x8 bfv[4];
#pragma unroll
                for (int st = 0; st < 4; ++st) bfv[st] = *(const LAS bf16x8*)(lds + SO_B + (16 * (4 * hh + st) + fr) * RSB + (k0 + 8 * fq) * 2);
#pragma unroll
                for (int st = 0; st < 4; ++st) gacc[st] = mfma16(bfv[st], cf, gacc[st]);
            }
            const int l = 16 * w + fr; const float al = acs[l];
#pragma unroll
            for (int st = 0; st < 4; ++st) {
                const int s0 = 16 * (4 * hh + st) + 4 * fq; const f32x4 as = *(const LAS f32x4*)(acs + s0), ds = *(const LAS f32x4*)(dtv + s0);
                float m[4];
#pragma unroll
                for (int j = 0; j < 4; ++j) m[j] = (s0 + j <= l) ? gacc[st][j] * __expf(al - as[j]) * ds[j] : 0.f;
                v2u mv; mv.x = pk2(m[0], m[1]); mv.y = pk2(m[2], m[3]);
                *(LAS v2u*)(lds + SO_M + l * RSB + s0 * 2) = mv;
            }
        }
        __syncthreads();
        {
            f32x4 y[4];
#pragma unroll
            for (int pt = 0; pt < 4; ++pt) y[pt] = (f32x4){0.f, 0.f, 0.f, 0.f};
#pragma unroll
            for (int k0 = 0; k0 < 128; k0 += 32) {
                const bf16x8 cf = *(const LAS bf16x8*)(lds + SO_C + (16 * w + fr) * RSB + (k0 + 8 * fq) * 2);
                bf16x8 sfv[4];
#pragma unroll
                for (int pt = 0; pt < 4; ++pt) sfv[pt] = *(const LAS bf16x8*)(lds + SO_S + (16 * pt + fr) * RSB + (k0 + 8 * fq) * 2);
#pragma unroll
                for (int pt = 0; pt < 4; ++pt) y[pt] = mfma16(cf, sfv[pt], y[pt]);
                __builtin_amdgcn_sched_barrier(0);
            }
            const f32x4 ea = *(const LAS f32x4*)(eacs + 16 * w + 4 * fq);
#pragma unroll
            for (int pt = 0; pt < 4; ++pt) y[pt] *= ea;
            for (int k0 = 0; k0 <= 16 * w + 15; k0 += 32) {
                const bf16x8 mf = *(const LAS bf16x8*)(lds + SO_M + (16 * w + fr) * RSB + (k0 + 8 * fq) * 2);
                const unsigned xa = (unsigned)(size_t)(lds + SO_X) + (unsigned)((k0 + 8 * fq + (fr >> 2)) * RSX + (fr & 3) * 8);
                bf16x8 x0, x1, x2, x3; TR4(576, x0, x1, x2, x3, xa);
                y[0] = mfma16(mf, x0, y[0]); y[1] = mfma16(mf, x1, y[1]); y[2] = mfma16(mf, x2, y[2]); y[3] = mfma16(mf, x3, y[3]);
                __builtin_amdgcn_sched_barrier(0);
            }
#pragma unroll
            for (int pt = 0; pt < 4; ++pt)
#pragma unroll
                for (int r = 0; r < 4; ++r) *(LAS float*)(lds + SO_M + (16 * w + 4 * fq + r) * RSB + (16 * pt + fr) * 4) = y[pt][r];
        }
        {
            const float dec = __expf(acs[512]);
#pragma unroll
            for (int i = 0; i < 4; ++i) sacc[i] *= dec;
#pragma unroll
            for (int k0 = 0; k0 < 128; k0 += 32) {
                const unsigned xa = (unsigned)(size_t)(lds + SO_X) + (unsigned)((k0 + 8 * fq + (fr >> 2)) * RSX + pt_s * 32 + (fr & 3) * 8);
                bf16x8 xf; TR1(576, xf, xa);
                const f32x4 w0 = *(const LAS f32x4*)(wv + k0 + 8 * fq), w1 = *(const LAS f32x4*)(wv + k0 + 8 * fq + 4);
                float xv[8]; unpack8(__builtin_bit_cast(v4u, xf), xv);
                v4u xs; xs.x = pk2(xv[0] * w0[0], xv[1] * w0[1]); xs.y = pk2(xv[2] * w0[2], xv[3] * w0[3]); xs.z = pk2(xv[4] * w1[0], xv[5] * w1[1]); xs.w = pk2(xv[6] * w1[2], xv[7] * w1[3]);
                const bf16x8 xw = __builtin_bit_cast(bf16x8, xs);
                const unsigned ba = (unsigned)(size_t)(lds + SO_B) + (unsigned)((k0 + 8 * fq + (fr >> 2)) * RSB + nh * 128 + (fr & 3) * 8);
                bf16x8 b0, b1, b2, b3; TR4(1088, b0, b1, b2, b3, ba);
                sacc[0] = mfma16(xw, b0, sacc[0]); sacc[1] = mfma16(xw, b1, sacc[1]); sacc[2] = mfma16(xw, b2, sacc[2]); sacc[3] = mfma16(xw, b3, sacc[3]);
                __builtin_amdgcn_sched_barrier(0);
            }
        }
        __syncthreads();
#pragma unroll
        for (int i = 0; i < 4; ++i)
#pragma unroll
            for (int r = 0; r < 4; ++r) *(LAS bf16*)(lds + SO_S + (16 * pt_s + 4 * fq + r) * RSB + (16 * (4 * nh + i) + fr) * 2) = (bf16)f2bf(sacc[i][r]);
        if (ft < nvalid) {
            const size_t row = rbase + l0 + ft;
            bf16* zq = PROJ + row * LDP + C_Z + h * 64 + 16 * q4;
            const v4u x0 = *(const LAS v4u*)(lds + SO_X + ft * RSX + q4 * 32), x1 = *(const LAS v4u*)(lds + SO_X + ft * RSX + q4 * 32 + 16);
            float zf[16], xf[16], yo[16];
            { float tmp[8]; unpack8(z0, tmp);
#pragma unroll
              for (int j = 0; j < 8; ++j) zf[j] = tmp[j];
              unpack8(z1, tmp);
#pragma unroll
              for (int j = 0; j < 8; ++j) zf[8 + j] = tmp[j];
              unpack8(x0, tmp);
#pragma unroll
              for (int j = 0; j < 8; ++j) xf[j] = tmp[j];
              unpack8(x1, tmp);
#pragma unroll
              for (int j = 0; j < 8; ++j) xf[8 + j] = tmp[j]; }
            float sq = 0.f;
#pragma unroll
            for (int j4 = 0; j4 < 4; ++j4) { const f32x4 yv = *(const LAS f32x4*)(lds + SO_M + ft * RSB + (16 * q4 + 4 * j4) * 4);
#pragma unroll
                for (int j = 0; j < 4; ++j) { const float v = (yv[j] + Dh * xf[4 * j4 + j]) * silu_f(zf[4 * j4 + j]); yo[4 * j4 + j] = v; sq += v * v; } }
            v4u o0, o1; o0.x = pk2(yo[0], yo[1]); o0.y = pk2(yo[2], yo[3]); o0.z = pk2(yo[4], yo[5]); o0.w = pk2(yo[6], yo[7]);
            o1.x = pk2(yo[8], yo[9]); o1.y = pk2(yo[10], yo[11]); o1.z = pk2(yo[12], yo[13]); o1.w = pk2(yo[14], yo[15]);
            *(v4u*)zq = o0; *(v4u*)(zq + 8) = o1;
            sq += __shfl_xor(sq, 1); sq += __shfl_xor(sq, 2);
            if (q4 == 0) SSDSQ[row * 16 + h] = sq;
        }
        __syncthreads();
    }
#undef SSD_PREFETCH
}
constexpr int LO_XB = 0, LO_XF = LO_XB + 128 * RSX, LO_A = LO_XF + 128 * 260, LO_U = LO_A + 128 * 260, LO_WA = LO_U + 128 * 260, LO_WX = LO_WA + 64 * RSX, LO_SC = LO_WX + 64 * RSX;
static_assert(LO_SC + 17 * 256 <= LDS_BYTES - 256, "lru lds");
__device__ __forceinline__ void lru_item3(const Args& a, LAS unsigned char* lds, int b, int h) {
    const int tid = threadIdx.x, lane0 = tid & 63, w = __builtin_amdgcn_readfirstlane(tid >> 6), fr0 = lane0 & 15, fq0 = lane0 >> 4;
    bf16* PROJ = (bf16*)(a.ws + WS_PROJ);
    const size_t rbase = (size_t)b * LSEQ;
    LAS float* segP = (LAS float*)(lds + LO_SC); LAS float* segH = segP + 512; LAS float* carry = segH + 512;
    __syncthreads();
    for (int i = tid; i < 4096; i += 512) { const int ii = i >> 6, j = i & 63;
        *(LAS bf16*)(lds + LO_WA + j * RSX + ii * 2) = (bf16)f2bf(-1.4426950408889634f * a.in[I_LWA][(size_t)h * 4096 + i]);
        *(LAS bf16*)(lds + LO_WX + j * RSX + ii * 2) = (bf16)f2bf(-1.4426950408889634f * a.in[I_LWX][(size_t)h * 4096 + i]); }
    if (tid < 64) carry[tid] = 0.f;
    float gba[4], gbx[4], gsp[4];
#pragma unroll
    for (int jt = 0; jt < 4; ++jt) { const int c = h * 64 + 16 * jt + fr0; gba[jt] = -1.4426950408889634f * a.in[I_LBA][c]; gbx[jt] = -1.4426950408889634f * a.in[I_LBX][c]; gsp[jt] = -8.0f * softplus_f(-a.in[I_LLAM][c]); }
    const int ft = tid >> 2, q4 = tid & 3;
    const int cg = tid & 7, rg = tid >> 3;
    v4u xp[5], gp[2];
#define LRU_PREFETCH(L0) do { const int l0_ = (L0); \
        _Pragma("unroll") for (int r = 0; r < 5; ++r) { const int l = l0_ + 2 * rg - 3 + r; xp[r] = (v4u){0u, 0u, 0u, 0u}; \
            if (l >= 0 && l < LSEQ) xp[r] = *(const v4u*)(PROJ + (rbase + l) * LDP + C_LI + h * 64 + cg * 8); } \
        gp[0] = (v4u){0u, 0u, 0u, 0u}; gp[1] = gp[0]; \
        if (l0_ + ft < LSEQ) { const bf16* gq = PROJ + (rbase + l0_ + ft) * LDP + C_G + h * 64 + 16 * q4; gp[0] = *(const v4u*)gq; gp[1] = *(const v4u*)(gq + 8); } } while (0)
    LRU_PREFETCH(0);
    for (int l0 = 0; l0 < LSEQ; l0 += 128) {
        const int nvalid = (LSEQ - l0) < 128 ? (LSEQ - l0) : 128;
        int fr = fr0, fq = fq0, lane = lane0; asm volatile("" : "+v"(fr), "+v"(fq), "+v"(lane));
        {
            float cw[4][8], cb[8], p[5][8];
#pragma unroll
            for (int k = 0; k < 4; ++k) { const f32x4 wa = *(const f32x4*)(a.in[I_LCW] + k * 1024 + h * 64 + cg * 8), wb = *(const f32x4*)(a.in[I_LCW] + k * 1024 + h * 64 + cg * 8 + 4);
#pragma unroll
                for (int j = 0; j < 4; ++j) { cw[k][j] = wa[j]; cw[k][4 + j] = wb[j]; } }
            { const f32x4 wa = *(const f32x4*)(a.in[I_LCB] + h * 64 + cg * 8), wb = *(const f32x4*)(a.in[I_LCB] + h * 64 + cg * 8 + 4);
#pragma unroll
              for (int j = 0; j < 4; ++j) { cb[j] = wa[j]; cb[4 + j] = wb[j]; } }
#pragma unroll
            for (int r = 0; r < 5; ++r) unpack8(xp[r], p[r]);
#pragma unroll
            for (int rr = 0; rr < 2; ++rr) { const int t = 2 * rg + rr; float o[8];
#pragma unroll
                for (int j = 0; j < 8; ++j) o[j] = cw[0][j] * p[rr][j] + cw[1][j] * p[rr + 1][j] + cw[2][j] * p[rr + 2][j] + cw[3][j] * p[rr + 3][j] + cb[j];
                v4u ov; ov.x = pk2(o[0], o[1]); ov.y = pk2(o[2], o[3]); ov.z = pk2(o[4], o[5]); ov.w = pk2(o[6], o[7]);
                *(LAS v4u*)(lds + LO_XB + t * RSX + cg * 16) = ov;
}
        }
        const v4u g0 = gp[0], g1 = gp[1];
        __syncthreads();
        if (l0 + 128 < LSEQ) LRU_PREFETCH(l0 + 128);
        {
            f32x4 ga[4], gx[4];
#pragma unroll
            for (int jt = 0; jt < 4; ++jt) { ga[jt] = (f32x4){gba[jt], gba[jt], gba[jt], gba[jt]}; gx[jt] = (f32x4){gbx[jt], gbx[jt], gbx[jt], gbx[jt]}; }
#pragma unroll
            for (int k0 = 0; k0 < 64; k0 += 32) {
                const bf16x8 xf = *(const LAS bf16x8*)(lds + LO_XB + (16 * w + fr) * RSX + (k0 + 8 * fq) * 2);
                bf16x8 wav[4], wxv[4];
#pragma unroll
                for (int jt = 0; jt < 4; ++jt) { wav[jt] = *(const LAS bf16x8*)(lds + LO_WA + (16 * jt + fr) * RSX + (k0 + 8 * fq) * 2); wxv[jt] = *(const LAS bf16x8*)(lds + LO_WX + (16 * jt + fr) * RSX + (k0 + 8 * fq) * 2); }
#pragma unroll
                for (int jt = 0; jt < 4; ++jt) { ga[jt] = mfma16(xf, wav[jt], ga[jt]); gx[jt] = mfma16(xf, wxv[jt], gx[jt]); }
            }
#pragma unroll
            for (int jt = 0; jt < 4; ++jt)
#pragma unroll
                for (int r = 0; r < 4; ++r) { const int l = 16 * w + 4 * fq + r, j = 16 * jt + fr;
                    const float rr = rcp_f(1.f + __builtin_amdgcn_exp2f(ga[jt][r])), ig = rcp_f(1.f + __builtin_amdgcn_exp2f(gx[jt][r]));
                    const float log_a = rr * gsp[jt];
                    const float av = __builtin_amdgcn_exp2f(1.4426950408889634f * log_a);
                    const float t2 = 2.f * log_a;
                    const float om = t2 > -0.1f ? -t2 * (1.f + t2 * (0.5f + t2 * (0.16666667f + t2 * 0.041666668f))) : 1.f - av * av;
                    const float mult = (l0 + l == 0) ? 1.f : __builtin_amdgcn_sqrtf(fmaxf(om, 0.f));
                    const float xv = __uint_as_float((unsigned)*(const LAS unsigned short*)(lds + LO_XB + l * RSX + j * 2) << 16);
                    *(LAS float*)(lds + LO_A + l * 260 + j * 4) = av; *(LAS float*)(lds + LO_U + l * 260 + j * 4) = mult * ig * xv; }
        }
        __syncthreads();
        {
            float P = 1.f, Hl = 0.f;
#pragma unroll
            for (int t = 0; t < 16; ++t) { const float av = *(const LAS float*)(lds + LO_A + (16 * w + t) * 260 + lane * 4), uv = *(const LAS float*)(lds + LO_U + (16 * w + t) * 260 + lane * 4); Hl = av * Hl + uv; P *= av; }
            segP[w * 64 + lane] = P; segH[w * 64 + lane] = Hl;
            __syncthreads();
            float hin = carry[lane];
            for (int s2 = 0; s2 < w; ++s2) hin = segP[s2 * 64 + lane] * hin + segH[s2 * 64 + lane];
#pragma unroll
            for (int t = 0; t < 16; ++t) { LAS float* up = (LAS float*)(lds + LO_U + (16 * w + t) * 260 + lane * 4); hin = *(const LAS float*)(lds + LO_A + (16 * w + t) * 260 + lane * 4) * hin + *up; *up = hin; }
            __syncthreads();
            if (w == 7) carry[lane] = hin;
        }
        if (ft < nvalid) {
            const size_t row = rbase + l0 + ft;
            bf16* gq = PROJ + row * LDP + C_G + h * 64 + 16 * q4;
            float gf[16], yo[16];
            { float tmp[8]; unpack8(g0, tmp);
#pragma unroll
              for (int j = 0; j < 8; ++j) gf[j] = tmp[j];
              unpack8(g1, tmp);
#pragma unroll
              for (int j = 0; j < 8; ++j) gf[8 + j] = tmp[j]; }
#pragma unroll
            for (int j = 0; j < 16; ++j) yo[j] = *(const LAS float*)(lds + LO_U + ft * 260 + (16 * q4 + j) * 4) * gelu_tanh_f(gf[j]);
            v4u o0, o1; o0.x = pk2(yo[0], yo[1]); o0.y = pk2(yo[2], yo[3]); o0.z = pk2(yo[4], yo[5]); o0.w = pk2(yo[6], yo[7]);
            o1.x = pk2(yo[8], yo[9]); o1.y = pk2(yo[10], yo[11]); o1.z = pk2(yo[12], yo[13]); o1.w = pk2(yo[14], yo[15]);
            *(v4u*)gq = o0; *(v4u*)(gq + 8) = o1;
        }
        __syncthreads();
    }
#undef LRU_PREFETCH
}
__device__ __forceinline__ void ph_mixers3(const Args& a, LAS unsigned char* lds, int wk, int nwk) {
    for (int it = wk; it < 256; it += nwk) if (it < 128) ssd_item3(a, lds, it >> 4, it & 15);
    for (int it = wk; it < 256; it += nwk) if (it >= 128) lru_item3(a, lds, (it - 128) >> 4, (it - 128) & 15);
    {
        const int wave = __builtin_amdgcn_readfirstlane((int)threadIdx.x >> 6), lane = (int)threadIdx.x & 63;
        __syncthreads();
        if (nwk >= 256) { if (wk >= 128) convert_experts(a, 0, (LAS float*)(lds + wave * 8448), (wk - 128) * NWAVES + wave, (nwk - 128) * NWAVES, lane); }
        else convert_experts(a, 0, (LAS float*)(lds + wave * 8448), wk * NWAVES + wave, nwk * NWAVES, lane);
    }
}

constexpr int RW_STRIDE = 2064;
__device__ __forceinline__ void ph_router(const Args& a, LAS unsigned char* lds, int L, int wk, int nwk) {
    const int tid = threadIdx.x, lane = tid & 63, wave = __builtin_amdgcn_readfirstlane(tid >> 6), fr = lane & 15, fq = lane >> 4;
    const int gw = wk * NWAVES + wave, NGW = nwk * NWAVES;
    LAS unsigned char* wl = lds;
    LAS float* sc = (LAS float*)(lds + 99328) + wave * 768;
    LAS int* lcnt = (LAS int*)(lds + 123904); LAS int* gbase = lcnt + 32; LAS int* rinfo = lcnt + 64;
    const v4u* WRT = (const v4u*)(a.ws + WS_WRT) + (size_t)L * 6144;
    __syncthreads();
    for (int i = tid; i < 6144; i += 512) *(LAS v4u*)(wl + (i >> 7) * RW_STRIDE + (i & 127) * 16) = WRT[i];
    if (tid < 32) lcnt[tid] = 0;
    __syncthreads();
    const bf16* HBr = L ? (const bf16*)(a.ws + WS_SB) : (const bf16*)a.out;
    float* RSTD1 = (float*)(a.ws + WS_RSTD1); float* GATES = (float*)(a.ws + WS_GATES); int* LIST = (int*)(a.ws + WS_LIST);
    unsigned* cnt = (unsigned*)(a.ws + WS_CTL) + CW_CNT + 1024 * L;
    const float* bg = a.in[I_RGB] + L * 4; const float* be = a.in[I_REB] + L * 16;
    int it = 0;
    for (int u = gw; u < T / 16; u += NGW, ++it) {
        const int r0 = u * 16;
        const bf16* hrow = HBr + (size_t)(r0 + fr) * D + 8 * fq;
        f32x4 acc[3]; float ss = 0.f;
#pragma unroll
        for (int t = 0; t < 3; ++t) acc[t] = (f32x4){0.f, 0.f, 0.f, 0.f};
#pragma unroll 4
        for (int k0 = 0; k0 < 1024; k0 += 32) {
            const v4u hv = *(const v4u*)(hrow + k0);
            f32x4 h0v, h1v; unpack8v(hv, h0v, h1v);
            ss += (h0v[0] * h0v[0] + h0v[1] * h0v[1] + h0v[2] * h0v[2] + h0v[3] * h0v[3]) + (h1v[0] * h1v[0] + h1v[1] * h1v[1] + h1v[2] * h1v[2] + h1v[3] * h1v[3]);
            const bf16x8 hf = __builtin_bit_cast(bf16x8, hv);
#pragma unroll
            for (int t = 0; t < 3; ++t) { const bf16x8 wf = *(const LAS bf16x8*)(wl + (16 * t + fr) * RW_STRIDE + (k0 + 8 * fq) * 2); acc[t] = mfma16(wf, hf, acc[t]); }
        }
        ss += __shfl_xor(ss, 16); ss += __shfl_xor(ss, 32);
        const float rstd = rsqrtf(ss * (1.f / D) + EPS);
#pragma unroll
        for (int t = 0; t < 3; ++t)
#pragma unroll
            for (int r = 0; r < 4; ++r) sc[fr * 48 + 16 * t + 4 * fq + r] = acc[t][r];
        LDS_WAIT();
        if (lane < 16) {
            const int row = r0 + lane;
            float lg[20];
#pragma unroll
            for (int j = 0; j < 20; ++j) lg[j] = (sc[lane * 48 + j] + sc[lane * 48 + 20 + j]) * rstd + (j < 4 ? bg[j] : be[j - 4]);
            int gs = 0; float gm = lg[0];
#pragma unroll
            for (int j = 1; j < 4; ++j) if (lg[j] > gm) { gm = lg[j]; gs = j; }
            const float pg = 1.f / (__expf(lg[0] - gm) + __expf(lg[1] - gm) + __expf(lg[2] - gm) + __expf(lg[3] - gm));
            float f[4];
#pragma unroll
            for (int i = 0; i < 4; ++i) f[i] = gs == 0 ? lg[4 + i] : (gs == 1 ? lg[8 + i] : (gs == 2 ? lg[12 + i] : lg[16 + i]));
            int i0 = 0; float m0 = f[0];
#pragma unroll
            for (int i = 1; i < 4; ++i) if (f[i] > m0) { m0 = f[i]; i0 = i; }
            int i1 = -1; float m1 = -3.0e38f;
#pragma unroll
            for (int i = 0; i < 4; ++i) if (i != i0 && f[i] > m1) { m1 = f[i]; i1 = i; }
            const float w0 = 1.f / (1.f + __expf(m1 - m0)), w1 = 1.f - w0;
            const int lo = i0 < i1 ? i0 : i1, hi = i0 < i1 ? i1 : i0;
            const float glo = pg * (i0 < i1 ? w0 : w1), ghi = pg * (i0 < i1 ? w1 : w0);
            const int pair = lo == 0 ? hi - 1 : (lo == 1 ? hi + 1 : 5);
            const int bk = gs * 6 + pair;
            const int ls = __hip_atomic_fetch_add(lcnt + bk, 1, __ATOMIC_RELAXED, __HIP_MEMORY_SCOPE_WORKGROUP);
            rinfo[(it * NWAVES + wave) * 16 + lane] = bk | (ls << 8);
            RSTD1[row] = rstd; GATES[(size_t)row * 2] = glo; GATES[(size_t)row * 2 + 1] = ghi;
        }
        LDS_WAIT();
    }
    __syncthreads();
    if (tid < NBK) gbase[tid] = (int)atomicAdd(cnt + 32 * tid, (unsigned)lcnt[tid]);
    __syncthreads();
    it = 0;
    for (int u = gw; u < T / 16; u += NGW, ++it)
        if (lane < 16) { const int info = rinfo[(it * NWAVES + wave) * 16 + lane], bk = info & 255; LIST[(size_t)bk * T + gbase[bk] + (info >> 8)] = u * 16 + lane; }
}

struct BkTab { int cnt[NBK], off[NBK], ust[NBK + 1]; };
__device__ __forceinline__ void bk_table(const Args& a, LAS unsigned char* lds, int L, int per_tile  ) {
    LAS int* tb = (LAS int*)lds;
    __syncthreads();
    if (threadIdx.x == 0) {
        const unsigned* cnt = (const unsigned*)(a.ws + WS_CTL) + CW_CNT + 1024 * L;
        int off = 0, us = 0;
        for (int i = 0; i < NBK; ++i) { const int c = (int)__hip_atomic_load(cnt + 32 * i, __ATOMIC_RELAXED, __HIP_MEMORY_SCOPE_AGENT);
            tb[i] = c; tb[NBK + i] = off; tb[2 * NBK + i] = us; off += (c + 255) & ~255; us += ((c + 63) >> 6) * per_tile; }
        tb[2 * NBK + NBK] = us;
    }
    __syncthreads();
}
__device__ __forceinline__ void bk_experts(int bk, int& elo, int& ehi) {
    const int g = bk / 6, pr = bk - g * 6;
    const int lo = pr < 3 ? 0 : (pr < 5 ? 1 : 2), hi = pr < 3 ? pr + 1 : (pr < 5 ? pr - 1 : 3);
    elo = g * 4 + lo; ehi = g * 4 + hi;
}
__device__ __forceinline__ void ph_moe_up(const Args& a, LAS unsigned char* lds, int L, int wk, int nwk) {
    const int tid = threadIdx.x, lane = tid & 63, wave = __builtin_amdgcn_readfirstlane(tid >> 6), fr = lane & 15, fq = lane >> 4;
    const int gw = wk * NWAVES + wave, NGW = nwk * NWAVES;
    bk_table(a, lds, L, 32);
    LAS int* tb = (LAS int*)lds;
    const bf16* HB = (const bf16*)a.out; const bf16* WGU = (const bf16*)(a.ws + WS_WGU); bf16* HID = (bf16*)(a.ws + WS_HID);
    const int* LIST = (const int*)(a.ws + WS_LIST); const float* RSTD1 = (const float*)(a.ws + WS_RSTD1); const float* GATES = (const float*)(a.ws + WS_GATES);
    const int nun = tb[2 * NBK + NBK];
    for (int u = gw; u < nun; u += NGW) {
        int bk = 0;
        for (int i = 1; i < NBK; ++i) if (u >= tb[2 * NBK + i]) bk = i;
        const int cnt = tb[bk], off = tb[NBK + bk], r = u - tb[2 * NBK + bk];
        const int rt = r >> 5, ek = (r >> 4) & 1, ct = r & 15;
        int elo, ehi; bk_experts(bk, elo, ehi); const int e = ek ? ehi : elo;
        const int c0 = ct * 32, brow = e * 1024 + (c0 >> 7) * 256 + (c0 & 127);
        const bf16* arow[4]; int tok[4];
#pragma unroll
        for (int mi = 0; mi < 4; ++mi) { int rr = rt * 64 + 16 * mi + fr; if (rr >= cnt) rr = cnt - 1; tok[mi] = LIST[(size_t)bk * T + rr]; arow[mi] = HB + (size_t)tok[mi] * D; }
        f32x4 acc[4][4]; zero_acc(acc);
        sg_kloop<4>(1024, arow, [=](int n, int k0) { return WGU + (size_t)(brow + (n < 32 ? n : n + 96)) * 1024 + k0; }, NoKS(), acc, fr, fq);
#pragma unroll
        for (int mi = 0; mi < 4; ++mi) { const int rr = rt * 64 + 16 * mi + fr;
            if (rr < cnt) { const float rs = RSTD1[tok[mi]], gt = GATES[(size_t)tok[mi] * 2 + ek];
#pragma unroll
                for (int nj = 0; nj < 2; ++nj) { const f32x4 gv = acc[mi][nj] * rs, uv = acc[mi][nj + 2] * rs; f32x4 hv;
                    hv.x = silu_f(gv.x) * uv.x * gt; hv.y = silu_f(gv.y) * uv.y * gt; hv.z = silu_f(gv.z) * uv.z * gt; hv.w = silu_f(gv.w) * uv.w * gt;
                    v2u w; w.x = pk2(hv.x, hv.y); w.y = pk2(hv.z, hv.w);
                    *(v2u*)(HID + (size_t)(off + rr) * 1024 + ek * 512 + c0 + 16 * nj + 4 * fq) = w; } } }
    }
}
__device__ __forceinline__ void ph_moe_down(const Args& a, LAS unsigned char* lds, int L, int wk, int nwk) {
    const int tid = threadIdx.x, lane = tid & 63, wave = __builtin_amdgcn_readfirstlane(tid >> 6), fr = lane & 15, fq = lane >> 4;
    const int gw = wk * NWAVES + wave, NGW = nwk * NWAVES;
    bk_table(a, lds, L, 16);
    LAS int* tb = (LAS int*)lds;
    const bf16* HID = (const bf16*)(a.ws + WS_HID); const bf16* WD = (const bf16*)(a.ws + WS_WD);
    float* H = (float*)(a.ws + WS_H); bf16* HB = (bf16*)a.out; const int* LIST = (const int*)(a.ws + WS_LIST);
    const int nun = tb[2 * NBK + NBK];
    for (int u = gw; u < nun; u += NGW) {
        int bk = 0;
        for (int i = 1; i < NBK; ++i) if (u >= tb[2 * NBK + i]) bk = i;
        const int cnt = tb[bk], off = tb[NBK + bk], r = u - tb[2 * NBK + bk];
        const int rt = r >> 4, ct = r & 15;
        int elo, ehi; bk_experts(bk, elo, ehi);
        const bf16* arow[4];
#pragma unroll
        for (int mi = 0; mi < 4; ++mi) arow[mi] = HID + (size_t)(off + rt * 64 + 16 * mi + fr) * 1024;
        f32x4 acc[4][4]; zero_acc(acc);
        sg_kloop<4>(1024, arow, [=](int n, int k0) { return WD + ((size_t)((k0 < 512 ? elo : ehi) * 1024 + ct * 64 + n)) * 512 + (k0 & 511); }, NoKS(), acc, fr, fq);
#pragma unroll
        for (int mi = 0; mi < 4; ++mi) { const int rr = rt * 64 + 16 * mi + fr;
            if (rr < cnt) { const int tok = LIST[(size_t)bk * T + rr];
#pragma unroll
                for (int nj = 0; nj < 4; ++nj) { const int c = ct * 64 + 16 * nj + 4 * fq; float* hp = H + (size_t)tok * D + c;
                    const f32x4 v = *(const f32x4*)hp + acc[mi][nj]; *(f32x4*)hp = v;
                    v2u w; w.x = pk2(v.x, v.y); w.y = pk2(v.z, v.w); *(v2u*)(HB + (size_t)tok * D + c) = w; } } }
    }
}


__device__ __forceinline__ void hb_store4(bf16* HB, int row, int col, const f32x4 v) {
    v2u w; w.x = pg8::cvt_pk_bf16(v[0], v[1]); w.y = pg8::cvt_pk_bf16(v[2], v[3]); *(v2u*)(HB + (size_t)row * D + col) = w;
}
__device__ __forceinline__ void hb_store8(bf16* HB, int row, int col, const f32x4 v0, const f32x4 v1) {
    v4u w; w.x = pg8::cvt_pk_bf16(v0[0], v0[1]); w.y = pg8::cvt_pk_bf16(v0[2], v0[3]); w.z = pg8::cvt_pk_bf16(v1[0], v1[1]); w.w = pg8::cvt_pk_bf16(v1[2], v1[3]);
    *(v4u*)(HB + (size_t)row * D + col) = w;
}

struct PGemm2 {
    static constexpr bool PERM = true;
    struct EpiRegs {};
    template <class U_> __device__ __forceinline__ void epi_pre(const U_&, EpiRegs&, int, int, int, int) const {}
    struct Unit { int pm, pn, ui; };
    const Args* ap; const char* A; const char* B; bf16* HB; int G, c; int ldb, nt;
    __device__ __forceinline__ bool next(int i, Unit& u) const { u.ui = i; return pg8::static_order(64, 4, G, c, i, u.pm, u.pn); }
    __device__ __forceinline__ void avoff(const Unit& u, const int (&RA)[2], const int (&CA)[2], unsigned (&v)[4]) const {
#pragma unroll
        for (int h = 0; h < 2; ++h)
#pragma unroll
            for (int i = 0; i < 2; ++i) { const int row = u.pm * 256 + h * 128 + RA[i]; v[h * 2 + i] = (unsigned)(row * LDP + CA[i]) * 2u; }
    }
    __device__ __forceinline__ const char* abase(const Unit&) const { return A; }
    __device__ __forceinline__ const char* btile(const Unit& u, int t) const { return B + ((size_t)u.pn * 256 * 2048 + (size_t)t * 64) * 2; }
    __device__ __forceinline__ void a_ready(const Unit&) const {}
    __device__ __forceinline__ void done(const Unit&) const {}
    __device__ __forceinline__ void khook(int t, pg8::Acc& acc, const Unit& u, LAS unsigned char* lds, int wr, int wc, int fr, int fq) const {
        if (t == 8 || t == 16) {
            const LAS float* ft = (const LAS float*)(lds + LDS_TAB) + u.ui * 512 + (t == 16 ? 1 : 0);
#pragma unroll
            for (int ai = 0; ai < 2; ++ai)
#pragma unroll
                for (int m = 0; m < 4; ++m) { const float f = ft[(ai * 128 + wr * 64 + m * 16 + fr) * 2];
#pragma unroll
                    for (int bj = 0; bj < 2; ++bj)
#pragma unroll
                        for (int n = 0; n < 2; ++n) acc[ai][bj][m][n] *= f; }
        }
    }
    __device__ __forceinline__ void epi(const pg8::Acc& acc, const Unit& u, const EpiRegs&, int wr, int wc, int fr, int fq) const {
        const int row0 = u.pm * 256 + wr * 64 + fr, col0 = u.pn * 256 + wc * 32 + 8 * fq;
        v4u cur[2], nxt[2];
#pragma unroll
        for (int bj = 0; bj < 2; ++bj) cur[bj] = *(const v4u*)(HB + (size_t)row0 * D + col0 + bj * 128);
#pragma unroll
        for (int g8 = 0; g8 < 8; ++g8) {
            const int ai = g8 >> 2, m = g8 & 3, row = row0 + ai * 128 + m * 16;
            if (g8 < 7) { const int rn = row0 + ((g8 + 1) >> 2) * 128 + ((g8 + 1) & 3) * 16;
#pragma unroll
                for (int bj = 0; bj < 2; ++bj) nxt[bj] = *(const v4u*)(HB + (size_t)rn * D + col0 + bj * 128); }
#pragma unroll
            for (int bj = 0; bj < 2; ++bj) { f32x4 h0v, h1v; unpack8v(cur[bj], h0v, h1v); hb_store8(HB, row, col0 + bj * 128, acc[ai][bj][m][0] + h0v, acc[ai][bj][m][1] + h1v); }
#pragma unroll
            for (int bj = 0; bj < 2; ++bj) cur[bj] = nxt[bj];
        }
    }
};
__device__ __forceinline__ void ssd_factors(const float* SSDSQ, int row, float& f0, float& f1) {
    const f32x4* sq = (const f32x4*)(SSDSQ + (size_t)row * 16); const f32x4 q0 = sq[0], q1 = sq[1], q2 = sq[2], q3 = sq[3];
    const float s0 = (q0.x + q0.y + q0.z + q0.w) + (q1.x + q1.y + q1.z + q1.w), s1 = (q2.x + q2.y + q2.z + q2.w) + (q3.x + q3.y + q3.z + q3.w);
    const float r0 = rsqrtf(s0 * (1.f / 512.f) + EPS), r1 = rsqrtf(s1 * (1.f / 512.f) + EPS);
    f0 = r0 / r1; f1 = r1;
}
__device__ __forceinline__ void ph_gemm2_pg8(const Args& a, LAS unsigned char* lds, int wk, int G) {
    const int tid = threadIdx.x, lane = tid & 63, wave = __builtin_amdgcn_readfirstlane(tid >> 6), fr = lane & 15, fq = lane >> 4;
    const float* SSDSQ = (const float*)(a.ws + WS_SSDSQ);
    PGemm2 S; S.ap = &a; S.A = (const char*)(a.ws + WS_PROJ); S.B = (const char*)(a.ws + WS_WOUT); S.HB = (bf16*)a.out;
    S.G = G; S.c = (int)blockIdx.x; S.ldb = 2048; S.nt = 32;
    {
        LAS float* ft = (LAS float*)(lds + LDS_TAB);
        PGemm2::Unit u;
        for (int i = 0; i < 4 && S.next(i, u); ++i)
            if (tid < 256) { float f0, f1; ssd_factors(SSDSQ, u.pm * 256 + tid, f0, f1); ft[i * 512 + tid * 2] = f0; ft[i * 512 + tid * 2 + 1] = f1; }
        __syncthreads();
    }
    pg8::gemm_phase<PGemm2, true>(lds, S);
    const bf16* PROJ = (const bf16*)(a.ws + WS_PROJ); const bf16* WOUT = (const bf16*)(a.ws + WS_WOUT);
    for (int tile = wk; tile < 32; tile += G) {
        const int rt = tile >> 4, ct = tile & 15, kb = wave * 256;
        const bf16* arow[4];
#pragma unroll
        for (int mi = 0; mi < 4; ++mi) arow[mi] = PROJ + (size_t)(16384 + rt * 64 + 16 * mi + fr) * LDP + kb;
        f32x4 acc[4][4]; zero_acc(acc);
        sg_kloop<4>(256, arow, [=](int n, int k0) { return WOUT + (size_t)(ct * 64 + n) * 2048 + kb + k0; }, NoKS(), acc, fr, fq);
        LAS float* part = (LAS float*)lds + wave * 4096;
        __syncthreads();
#pragma unroll
        for (int mi = 0; mi < 4; ++mi) { const int r = 16 * mi + fr; float f0, f1; ssd_factors(SSDSQ, 16384 + rt * 64 + r, f0, f1);
            const float sc = wave < 2 ? f0 * f1 : (wave < 4 ? f1 : 1.f);
#pragma unroll
            for (int nj = 0; nj < 4; ++nj) *(LAS f32x4*)(part + r * 64 + 16 * nj + 4 * fq) = acc[mi][nj] * sc; }
        __syncthreads();
        for (int q = tid; q < 1024; q += 512) { const int r = q >> 4, c4 = (q & 15) * 4; f32x4 s = *(const LAS f32x4*)((LAS float*)lds + r * 64 + c4);
#pragma unroll
            for (int w = 1; w < 8; ++w) s += *(const LAS f32x4*)((LAS float*)lds + w * 4096 + r * 64 + c4);
            const int row = 16384 + rt * 64 + r, col = ct * 64 + c4;
            const v2u hq = *(const v2u*)(S.HB + (size_t)row * D + col); f32x4 hv; hv[0] = __uint_as_float(hq.x << 16); hv[1] = __uint_as_float(hq.x & 0xffff0000u); hv[2] = __uint_as_float(hq.y << 16); hv[3] = __uint_as_float(hq.y & 0xffff0000u);
            hb_store4(S.HB, row, col, s + hv); }
        __syncthreads();
    }
}

struct BkInfo { int bk, rt, cnt, off; };
__device__ __forceinline__ void bk_table256(const Args& a, LAS unsigned char* lds, int L) {
    LAS int* tb = (LAS int*)(lds + LDS_TAB);
    __syncthreads();
    if (threadIdx.x == 0) {
        const unsigned* cnt = (const unsigned*)(a.ws + WS_CTL) + CW_CNT + 1024 * L;
        int off = 0, rts = 0;
        for (int i = 0; i < NBK; ++i) { const int c = (int)__hip_atomic_load(cnt + 32 * i, __ATOMIC_RELAXED, __HIP_MEMORY_SCOPE_AGENT);
            tb[i] = c; tb[NBK + i] = off; tb[2 * NBK + i] = rts; off += (c + 255) & ~255; rts += (c + 255) >> 8; }
        tb[2 * NBK + NBK] = rts;
    }
    __syncthreads();
}
__device__ __forceinline__ bool bk_find(const LAS int* tb, int rti, BkInfo& o) {
    if (rti >= tb[2 * NBK + NBK]) return false;
    int bk = 0;
    for (int i = 1; i < NBK; ++i) if (rti >= tb[2 * NBK + i]) bk = i;
    o.bk = __builtin_amdgcn_readfirstlane(bk); o.rt = __builtin_amdgcn_readfirstlane(rti - tb[2 * NBK + bk]); o.cnt = __builtin_amdgcn_readfirstlane(tb[bk]); o.off = __builtin_amdgcn_readfirstlane(tb[NBK + bk]); return true;
}
struct PMoeUp {
    static constexpr bool PERM = true;
    struct EpiRegs {};
    template <class U_> __device__ __forceinline__ void epi_pre(const U_&, EpiRegs&, int, int, int, int) const {}
    struct Unit { int bk, rt, cnt, off, e, ek, pnl, ui, rti; };
    const char* A; const char* B; bf16* HID; const float* rstd; const float* gates; const LAS int* tb; const LAS int* rowtab; const LAS float* rgtab; unsigned* ctr; int G, c; int ldb, nt;
    __device__ __forceinline__ bool next(int i, Unit& u) const {
        const int Lu = i * G + c; BkInfo o; if (!bk_find(tb, Lu >> 3, o)) return false;
        u.bk = o.bk; u.rt = o.rt; u.cnt = o.cnt; u.off = o.off; u.ek = (Lu >> 2) & 1; u.pnl = Lu & 3; u.ui = i; u.rti = Lu >> 3;
        int elo, ehi; bk_experts(o.bk, elo, ehi); u.e = u.ek ? ehi : elo; return true;
    }
    __device__ __forceinline__ void avoff(const Unit& u, const int (&RA)[2], const int (&CA)[2], unsigned (&v)[4]) const {
#pragma unroll
        for (int h = 0; h < 2; ++h)
#pragma unroll
            for (int i = 0; i < 2; ++i) { const int tok = rowtab[u.ui * 256 + h * 128 + RA[i]]; v[h * 2 + i] = (unsigned)(tok * D + CA[i]) * 2u; }
    }
    __device__ __forceinline__ const char* abase(const Unit&) const { return A; }
    __device__ __forceinline__ const char* btile(const Unit& u, int t) const { return B + ((size_t)(u.e * 1024 + u.pnl * 256) * 1024 + (size_t)t * 64) * 2; }
    __device__ __forceinline__ void khook(int, pg8::Acc&, const Unit&, LAS unsigned char*, int, int, int, int) const {}
    __device__ __forceinline__ void a_ready(const Unit&) const {}
    __device__ __forceinline__ void done(const Unit& u) const {
        asm volatile("s_waitcnt vmcnt(0)" ::: "memory");
        if ((threadIdx.x & 63) == 0) __hip_atomic_fetch_add(ctr + 32 * u.rti, 1u, __ATOMIC_RELAXED, __HIP_MEMORY_SCOPE_AGENT);
    }
    __device__ __forceinline__ void epi(const pg8::Acc& acc, const Unit& u, const EpiRegs&, int wr, int wc, int fr, int fq) const {
        const int r0 = wr * 64 + fr, col0 = u.ek * 512 + u.pnl * 128 + wc * 32 + 8 * fq;
        float rsv[2][4], gtv[2][4];
#pragma unroll
        for (int ai = 0; ai < 2; ++ai)
#pragma unroll
            for (int m = 0; m < 4; ++m) { const LAS float* rg = rgtab + (u.ui * 256 + r0 + ai * 128 + m * 16) * 2; rsv[ai][m] = rg[0]; gtv[ai][m] = rg[1]; }
#pragma unroll
        for (int ai = 0; ai < 2; ++ai)
#pragma unroll
            for (int m = 0; m < 4; ++m) { const int rr = u.rt * 256 + r0 + ai * 128 + m * 16;
                const float rs = rsv[ai][m], gt = gtv[ai][m]; float hv[8];
#pragma unroll
                for (int n = 0; n < 2; ++n)
#pragma unroll
                    for (int j = 0; j < 4; ++j) { const float g = acc[ai][0][m][n][j] * rs, uu = acc[ai][1][m][n][j] * rs; hv[n * 4 + j] = silu_f(g) * uu * gt; }
                v4u w; w.x = pg8::cvt_pk_bf16(hv[0], hv[1]); w.y = pg8::cvt_pk_bf16(hv[2], hv[3]); w.z = pg8::cvt_pk_bf16(hv[4], hv[5]); w.w = pg8::cvt_pk_bf16(hv[6], hv[7]);
                const bf16* hp = HID + (size_t)(u.off + rr) * 1024 + col0;
                asm volatile("global_store_dwordx4 %0, %1, off sc1\n\ts_nop 1" :: "v"(hp), "v"(w) : "memory"); }
    }
};
__device__ __forceinline__ void ph_moe_up_pg8(const Args& a, LAS unsigned char* lds, int L, int G) {
    bk_table256(a, lds, L);
    const LAS int* tb = (const LAS int*)(lds + LDS_TAB); LAS int* rowtab = (LAS int*)(lds + LDS_TAB + 1024); LAS float* rgtab = (LAS float*)(lds + LDS_TAB + 1024 + 6 * 1024);
    PMoeUp S; S.rgtab = rgtab; S.A = L ? (const char*)(a.ws + WS_SB) : (const char*)a.out; S.B = (const char*)(a.ws + ws_wgu(L)); S.HID = (bf16*)(a.ws + WS_HID); S.rstd = (const float*)(a.ws + WS_RSTD1); S.gates = (const float*)(a.ws + WS_GATES);
    S.tb = tb; S.rowtab = rowtab; S.G = G; S.c = (int)blockIdx.x; S.ldb = 1024; S.nt = 16; S.ctr = (unsigned*)(a.ws + WS_CTL) + CW_RT + 8192 * L;
    {   const int* LIST = (const int*)(a.ws + WS_LIST); PMoeUp::Unit u;
        for (int i = 0; i < 6 && S.next(i, u); ++i)
            if (threadIdx.x < 256) { int rr = u.rt * 256 + (int)threadIdx.x; rr = rr < u.cnt ? rr : u.cnt - 1; const int tok = LIST[(size_t)u.bk * T + rr]; rowtab[i * 256 + threadIdx.x] = tok;
                rgtab[(i * 256 + threadIdx.x) * 2] = S.rstd[tok]; rgtab[(i * 256 + threadIdx.x) * 2 + 1] = S.gates[(size_t)tok * 2 + u.ek]; }
        __syncthreads();
    }
    pg8::gemm_phase<PMoeUp, true>(lds, S);
}
struct PMoeDown {
    static constexpr bool PERM = true;
    struct EpiRegs {};
    template <class U_> __device__ __forceinline__ void epi_pre(const U_&, EpiRegs&, int, int, int, int) const {}
    struct Unit { int bk, rt, cnt, off, elo, ehi, pn, ui, rti; };
    const char* A; const char* B; bf16* HB; bf16* HBo; float* SSQ; const LAS int* tb; const LAS int* rowtab; unsigned* ctr; unsigned* err; int G, c, i0; int ldb, nt;
    __device__ __forceinline__ bool next(int i, Unit& u) const {
        const int Ld = (i0 + i) * G + c - 8 * tb[2 * NBK + NBK]; BkInfo o; if (!bk_find(tb, Ld >> 2, o)) return false;
        u.bk = o.bk; u.rt = o.rt; u.cnt = o.cnt; u.off = o.off; u.pn = Ld & 3; u.ui = i; u.rti = Ld >> 2; bk_experts(o.bk, u.elo, u.ehi); return true;
    }
    __device__ __forceinline__ void avoff(const Unit& u, const int (&RA)[2], const int (&CA)[2], unsigned (&v)[4]) const {
#pragma unroll
        for (int h = 0; h < 2; ++h)
#pragma unroll
            for (int i = 0; i < 2; ++i) { const int row = u.off + u.rt * 256 + h * 128 + RA[i]; v[h * 2 + i] = (unsigned)(row * 1024 + CA[i]) * 2u; }
    }
    __device__ __forceinline__ const char* abase(const Unit&) const { return A; }
    __device__ __forceinline__ const char* btile(const Unit& u, int t) const { return B + ((size_t)((t < 8 ? u.elo : u.ehi) * 1024 + u.pn * 256) * 512 + (size_t)(t & 7) * 64) * 2; }
    __device__ __forceinline__ void khook(int, pg8::Acc&, const Unit&, LAS unsigned char*, int, int, int, int) const {}
    __device__ __forceinline__ void a_ready(const Unit& u) const {
        if (threadIdx.x < 64) {
            unsigned spins = 0;
            while ((unsigned)__builtin_amdgcn_readfirstlane(__hip_atomic_load(ctr + 32 * u.rti, __ATOMIC_RELAXED, __HIP_MEMORY_SCOPE_AGENT)) < 64u) {
                __builtin_amdgcn_s_sleep(2);
                if (++spins > (1u << 22)) { if (threadIdx.x == 0) __hip_atomic_store(err, 1u, __ATOMIC_RELAXED, __HIP_MEMORY_SCOPE_AGENT); break; } }
            __builtin_amdgcn_fence(__ATOMIC_ACQUIRE, "agent");
            asm volatile("s_waitcnt vmcnt(0)" ::: "memory");
        }
        asm volatile("" ::: "memory"); __builtin_amdgcn_s_barrier(); asm volatile("" ::: "memory");
    }
    __device__ __forceinline__ void done(const Unit&) const {}
    __device__ __forceinline__ void epi(const pg8::Acc& acc, const Unit& u, const EpiRegs&, int wr, int wc, int fr, int fq) const {
        const int r0 = wr * 64 + fr, col0 = u.pn * 256 + wc * 32 + 8 * fq;
        int tok[8];
#pragma unroll
        for (int g8 = 0; g8 < 8; ++g8) tok[g8] = rowtab[u.ui * 256 + r0 + (g8 >> 2) * 128 + (g8 & 3) * 16];
#pragma unroll
        for (int hf = 0; hf < 2; ++hf) {
            v4u res[4][2];
#pragma unroll
            for (int g4 = 0; g4 < 4; ++g4)
#pragma unroll
                for (int bj = 0; bj < 2; ++bj) res[g4][bj] = *(const v4u*)(HB + (size_t)tok[hf * 4 + g4] * D + col0 + bj * 128);
#pragma unroll
            for (int g4 = 0; g4 < 4; ++g4) {
                const int g8 = hf * 4 + g4, ai = g8 >> 2, m = g8 & 3;
                const int rr = u.rt * 256 + r0 + ai * 128 + m * 16;
                float sq = 0.f;
#pragma unroll
                for (int bj = 0; bj < 2; ++bj) { f32x4 h0v, h1v; unpack8v(res[g4][bj], h0v, h1v);
                    const f32x4 v0 = acc[ai][bj][m][0] + h0v, v1 = acc[ai][bj][m][1] + h1v;
                    sq += (v0[0] * v0[0] + v0[1] * v0[1] + v0[2] * v0[2] + v0[3] * v0[3]) + (v1[0] * v1[0] + v1[1] * v1[1] + v1[2] * v1[2] + v1[3] * v1[3]);
                    if (rr < u.cnt) hb_store8(HBo, tok[g8], col0 + bj * 128, v0, v1); }
                sq += __shfl_xor(sq, 16); sq += __shfl_xor(sq, 32);
                if (rr < u.cnt && fq == 0) SSQ[(size_t)tok[g8] * 16 + u.pn * 4 + wc] = sq;
            }
        }
    }
};
__device__ __forceinline__ void ph_moe_down_pg8(const Args& a, LAS unsigned char* lds, int L, int G) {
    bk_table256(a, lds, L);
    const LAS int* tb = (const LAS int*)(lds + LDS_TAB); LAS int* rowtab = (LAS int*)(lds + LDS_TAB + 1024);
    PMoeDown S; S.A = (const char*)(a.ws + WS_HID); S.B = (const char*)(a.ws + ws_wd(L)); S.SSQ = (float*)(a.ws + WS_SSDSQ); S.HB = L ? (bf16*)(a.ws + WS_SB) : (bf16*)a.out; S.HBo = L ? (bf16*)(a.ws + WS_SC) : (bf16*)a.out;
    S.tb = tb; S.rowtab = rowtab; S.G = G; S.c = (int)blockIdx.x; S.ldb = 512; S.nt = 16; S.ctr = (unsigned*)(a.ws + WS_CTL) + CW_RT + 8192 * L; S.err = (unsigned*)(a.ws + WS_CTL) + 16;
    { const int nup = 8 * tb[2 * NBK + NBK]; S.i0 = nup > S.c ? (nup - S.c + G - 1) / G : 0; }
    {   const int* LIST = (const int*)(a.ws + WS_LIST); PMoeDown::Unit u;
        for (int i = 0; i < 4 && S.next(i, u); ++i)
            if (threadIdx.x < 256) { int rr = u.rt * 256 + (int)threadIdx.x; rr = rr < u.cnt ? rr : u.cnt - 1; rowtab[i * 256 + threadIdx.x] = LIST[(size_t)u.bk * T + rr]; }
        __syncthreads();
    }
    pg8::gemm_phase<PMoeDown, true>(lds, S);
    if (L == 0) {
        const int wave = __builtin_amdgcn_readfirstlane((int)threadIdx.x >> 6), lane = (int)threadIdx.x & 63;
        const int ntot = 12 * tb[2 * NBK + NBK], n_more = ntot % G;
        __syncthreads();
        if (n_more > 0 && n_more <= G - 32) { if (S.c >= n_more) convert_experts(a, 1, (LAS float*)(lds + wave * 8448), (S.c - n_more) * NWAVES + wave, (G - n_more) * NWAVES, lane); }
        else convert_experts(a, 1, (LAS float*)(lds + wave * 8448), S.c * NWAVES + wave, G * NWAVES, lane);
    }
}
struct PPool {
    static constexpr bool PERM = true;
    struct EpiRegs {};
    template <class U_> __device__ __forceinline__ void epi_pre(const U_&, EpiRegs&, int, int, int, int) const {}
    struct Unit { int pm, pn; };
    const char* A; const char* B; bf16* HB; const float* pb; const float* ps; int G, c; int ldb, nt;
    __device__ __forceinline__ bool next(int i, Unit& u) const { return pg8::static_order(65, 4, G, c, i, u.pm, u.pn); }
    __device__ __forceinline__ void avoff(const Unit& u, const int (&RA)[2], const int (&CA)[2], unsigned (&v)[4]) const {
#pragma unroll
        for (int h = 0; h < 2; ++h)
#pragma unroll
            for (int i = 0; i < 2; ++i) { int row = u.pm * 256 + h * 128 + RA[i]; row = row < T ? row : T - 1; v[h * 2 + i] = (unsigned)(row * D + CA[i]) * 2u; }
    }
    __device__ __forceinline__ const char* abase(const Unit& u) const { return A + (size_t)u.pn * 256 * 2; }
    __device__ __forceinline__ const char* btile(const Unit& u, int t) const { return B + ((size_t)u.pn * 256 * 256 + (size_t)t * 64) * 2; }
    __device__ __forceinline__ void khook(int, pg8::Acc&, const Unit&, LAS unsigned char*, int, int, int, int) const {}
    __device__ __forceinline__ void a_ready(const Unit&) const {}
    __device__ __forceinline__ void done(const Unit&) const {}
    __device__ __forceinline__ void epi(const pg8::Acc& acc, const Unit& u, const EpiRegs&, int wr, int wc, int fr, int fq) const {
        const int row0 = u.pm * 256 + wr * 64 + fr, col0 = u.pn * 256 + wc * 32 + 8 * fq;
        v4u cur[2], nxt[2];
        { const int rc = row0 < T ? row0 : T - 1;
#pragma unroll
          for (int bj = 0; bj < 2; ++bj) cur[bj] = *(const v4u*)(HB + (size_t)rc * D + col0 + bj * 128); }
#pragma unroll
        for (int g8 = 0; g8 < 8; ++g8) {
            const int ai = g8 >> 2, m = g8 & 3, row = row0 + ai * 128 + m * 16;
            if (g8 < 7) { const int rn = row0 + ((g8 + 1) >> 2) * 128 + ((g8 + 1) & 3) * 16, rc = rn < T ? rn : T - 1;
#pragma unroll
                for (int bj = 0; bj < 2; ++bj) nxt[bj] = *(const v4u*)(HB + (size_t)rc * D + col0 + bj * 128); }
            if (row < T) {
#pragma unroll
                for (int bj = 0; bj < 2; ++bj) { const int cc = col0 + bj * 128; f32x4 h0v, h1v; unpack8v(cur[bj], h0v, h1v);
                    hb_store8(HB, row, cc, h0v + (acc[ai][bj][m][0] + *(const f32x4*)(pb + cc)) * *(const f32x4*)(ps + cc),
                                           h1v + (acc[ai][bj][m][1] + *(const f32x4*)(pb + cc + 4)) * *(const f32x4*)(ps + cc + 4)); } }
#pragma unroll
            for (int bj = 0; bj < 2; ++bj) cur[bj] = nxt[bj];
        }
    }
};
__device__ __forceinline__ void ph_poolgemm_pg8(const Args& a, LAS unsigned char* lds, int G) {
    PPool S; S.A = (const char*)(a.ws + WS_POOLED); S.B = (const char*)(a.ws + WS_WPOOL); S.HB = (bf16*)a.out; S.pb = a.in[I_PB]; S.ps = a.in[I_PS];
    S.G = G; S.c = (int)blockIdx.x; S.ldb = 256; S.nt = 4;
    pg8::gemm_phase<PPool, true>(lds, S);
}

constexpr int PF_RS_ROW = 528;
constexpr int PF_RAW = 0, PF_RS = 112 * PF_RS_ROW, PF_A = PF_RS + 512, PF_END = PF_A + 96 * PF_RS_ROW;
static_assert(PF_END <= LDS_BYTES - 256, "pool lds");
__device__ __forceinline__ void ph_pool_fused(const Args& a, LAS unsigned char* lds, int wk, int nwk) {
    const int tid = threadIdx.x, lane = tid & 63, w = __builtin_amdgcn_readfirstlane(tid >> 6), fr = lane & 15, fq = lane >> 4;
    const bf16* SA = (const bf16*)a.out; bf16* SB = (bf16*)(a.ws + WS_SB); const float* SSQ = (const float*)(a.ws + WS_SSDSQ); const bf16* WPOOL = (const bf16*)(a.ws + WS_WPOOL);
    LAS float* rs = (LAS float*)(lds + PF_RS);
    v4u rp[7]; f32x4 sq4[4];
#define POOL_PREFETCH(U) do { const int rt_ = (U) >> 2, g_ = (U) & 3, t0_ = rt_ * 96; \
        _Pragma("unroll") for (int i = 0; i < 7; ++i) { const int q = tid + 512 * i, row = q >> 5, pc = q & 31; int gr = t0_ - 16 + row; gr = gr < 0 ? 0 : gr; \
            rp[i] = *(const v4u*)(SA + (size_t)gr * D + g_ * 256 + pc * 8); } \
        if (tid < 112) { int gr = t0_ - 16 + tid; gr = gr < 0 ? 0 : gr; const f32x4* q = (const f32x4*)(SSQ + (size_t)gr * 16); sq4[0] = q[0]; sq4[1] = q[1]; sq4[2] = q[2]; sq4[3] = q[3]; } } while (0)
    if (wk < 172 * 4) POOL_PREFETCH(wk);
    for (int u = wk; u < 172 * 4; u += nwk) {
        const int rt = u >> 2, g = u & 3, t0 = rt * 96, win = 2 << g;
        const bf16* wrow = WPOOL + (size_t)(g * 256 + 32 * w + fr) * 256 + 8 * fq;
        bf16x8 bfr[8][2];
#pragma unroll
        for (int ks = 0; ks < 8; ++ks) { bfr[ks][0] = *(const bf16x8*)(wrow + 32 * ks); bfr[ks][1] = *(const bf16x8*)(wrow + 16 * 256 + 32 * ks); }
        __syncthreads();
#pragma unroll
        for (int i = 0; i < 7; ++i) { const int q = tid + 512 * i, row = q >> 5, pc = q & 31; *(LAS v4u*)(lds + PF_RAW + row * PF_RS_ROW + pc * 16) = rp[i]; }
        if (tid < 112) { const f32x4 sv = (sq4[0] + sq4[1]) + (sq4[2] + sq4[3]); rs[tid] = rsqrtf((sv[0] + sv[1] + sv[2] + sv[3]) * (1.f / D) + EPS); }
        __syncthreads();
        if (u + nwk < 172 * 4) POOL_PREFETCH(u + nwk);
        {   const int c4 = tid & 63, r0 = (tid >> 6) * 12;
            const LAS unsigned char* rawc = lds + PF_RAW + 16 * PF_RS_ROW + c4 * 8;
            int l = (t0 + r0) % LSEQ;
            f32x4 Sb = (f32x4){0.f, 0.f, 0.f, 0.f};
            for (int j = 1; j < win; ++j) if (l - j >= 0) { const v2u q = *(const LAS v2u*)(rawc + (r0 - j) * PF_RS_ROW); const float rr = rs[16 + r0 - j];
                Sb[0] += __uint_as_float(q.x << 16) * rr; Sb[1] += __uint_as_float(q.x & 0xffff0000u) * rr; Sb[2] += __uint_as_float(q.y << 16) * rr; Sb[3] += __uint_as_float(q.y & 0xffff0000u) * rr; }
#pragma unroll 4
            for (int r = r0; r < r0 + 12; ++r) {
                if (l == 0) Sb = (f32x4){0.f, 0.f, 0.f, 0.f};
                const v2u q = *(const LAS v2u*)(rawc + r * PF_RS_ROW); const float rr = rs[16 + r];
                f32x4 hv; hv[0] = __uint_as_float(q.x << 16) * rr; hv[1] = __uint_as_float(q.x & 0xffff0000u) * rr; hv[2] = __uint_as_float(q.y << 16) * rr; hv[3] = __uint_as_float(q.y & 0xffff0000u) * rr;
                const f32x4 full = Sb + hv;
                const int n = (l + 1) < win ? (l + 1) : win;
                const f32x4 o = full * (1.f / (float)n) - hv;
                v2u wv; wv.x = pk2(o[0], o[1]); wv.y = pk2(o[2], o[3]);
                *(LAS v2u*)(lds + PF_A + r * PF_RS_ROW + c4 * 8) = wv;
                Sb = full;
                if (l + 1 >= win) { const v2u qo = *(const LAS v2u*)(rawc + (r - win + 1) * PF_RS_ROW); const float ro = rs[16 + r - win + 1];
                    Sb[0] -= __uint_as_float(qo.x << 16) * ro; Sb[1] -= __uint_as_float(qo.x & 0xffff0000u) * ro; Sb[2] -= __uint_as_float(qo.y << 16) * ro; Sb[3] -= __uint_as_float(qo.y & 0xffff0000u) * ro; }
                l = (l + 1 == LSEQ) ? 0 : l + 1;
            }
        }
        __syncthreads();
        f32x4 acc[6][2];
#pragma unroll
        for (int m = 0; m < 6; ++m) { acc[m][0] = (f32x4){0.f, 0.f, 0.f, 0.f}; acc[m][1] = acc[m][0]; }
#pragma unroll
        for (int ks = 0; ks < 8; ++ks) {
            bf16x8 af[6];
#pragma unroll
            for (int m = 0; m < 6; ++m) af[m] = *(const LAS bf16x8*)(lds + PF_A + (16 * m + fr) * PF_RS_ROW + (32 * ks + 8 * fq) * 2);
#pragma unroll
            for (int m = 0; m < 6; ++m) { acc[m][0] = mfma16(bfr[ks][0], af[m], acc[m][0]); acc[m][1] = mfma16(bfr[ks][1], af[m], acc[m][1]); }
        }
#pragma unroll
        for (int j = 0; j < 2; ++j) { const int col = g * 256 + 32 * w + 16 * j + 4 * fq; const f32x4 pbv = *(const f32x4*)(a.in[I_PB] + col), psv = *(const f32x4*)(a.in[I_PS] + col);
#pragma unroll
            for (int m = 0; m < 6; ++m) { const int row = t0 + 16 * m + fr;
                const v2u hq = *(const LAS v2u*)(lds + PF_RAW + (16 + 16 * m + fr) * PF_RS_ROW + (32 * w + 16 * j + 4 * fq) * 2);
                f32x4 hv; hv[0] = __uint_as_float(hq.x << 16); hv[1] = __uint_as_float(hq.x & 0xffff0000u); hv[2] = __uint_as_float(hq.y << 16); hv[3] = __uint_as_float(hq.y & 0xffff0000u);
                hb_store4(SB, row, col, hv + (acc[m][j] + pbv) * psv); } }
    }
#undef POOL_PREFETCH
}
__device__ __forceinline__ void ph_pooled(const Args& a, LAS unsigned char* lds, int wk, int nwk) {
    const int tid = threadIdx.x, qt = tid >> 7, c8 = tid & 127, c = c8 * 8, g = c >> 8, w = 2 << g;
    const bf16* HBr = (const bf16*)a.out; const float* SSQ = (const float*)(a.ws + WS_SSDSQ); bf16* PO = (bf16*)(a.ws + WS_POOLED);
    LAS float* rs = (LAS float*)lds + qt * 64;
    for (int pr = wk; pr < 172; pr += nwk) {
        const int task = pr * 4 + qt, b = task / 86, t0 = (task % 86) * 24;
        const size_t rb = (size_t)b * LSEQ;
        __syncthreads();
        if (c8 < 40) { const int l = t0 - 16 + c8; float r = 0.f;
            if (l >= 0) { const f32x4* q = (const f32x4*)(SSQ + (rb + l) * 16); const f32x4 sv = (q[0] + q[1]) + (q[2] + q[3]); r = rsqrtf((sv[0] + sv[1] + sv[2] + sv[3]) * (1.f / D) + EPS); }
            rs[c8] = r; }
        __syncthreads();
        f32x4 S0 = (f32x4){0.f, 0.f, 0.f, 0.f}, S1 = S0;
        for (int j = 1; j <= w; ++j) { const int l = t0 - j; if (l >= 0) { f32x4 x0, x1; unpack8v(*(const v4u*)(HBr + (rb + l) * D + c), x0, x1); S0 += x0 * rs[16 - j]; S1 += x1 * rs[16 - j]; } }
#pragma unroll 4
        for (int t = 0; t < 24; ++t) {
            const int l = t0 + t;
            f32x4 h0v, h1v; unpack8v(*(const v4u*)(HBr + (rb + l) * D + c), h0v, h1v); h0v *= rs[16 + t]; h1v *= rs[16 + t];
            const int lo = l - w, loc = lo >= 0 ? lo : 0; const float rl = lo >= 0 ? rs[16 + t - w] : 0.f;
            f32x4 s0v, s1v; unpack8v(*(const v4u*)(HBr + (rb + loc) * D + c), s0v, s1v);
            S0 += h0v; S0 -= s0v * rl; S1 += h1v; S1 -= s1v * rl;
            const int n = (l + 1) < w ? (l + 1) : w; const float inv = 1.f / (float)n;
            const f32x4 o0 = S0 * inv - h0v, o1 = S1 * inv - h1v;
            v4u wv; wv.x = pk2(o0[0], o0[1]); wv.y = pk2(o0[2], o0[3]); wv.z = pk2(o1[0], o1[1]); wv.w = pk2(o1[2], o1[3]); *(v4u*)(PO + (rb + l) * D + c) = wv;
        }
    }
}
__device__ __forceinline__ void ph_poolgemm(const Args& a, int wk, int nwk) {
    const int tid = threadIdx.x, lane = tid & 63, wave = __builtin_amdgcn_readfirstlane(tid >> 6), fr = lane & 15, fq = lane >> 4;
    const int gw = wk * NWAVES + wave, NGW = nwk * NWAVES;
    const bf16* PO = (const bf16*)(a.ws + WS_POOLED); const bf16* WPOOL = (const bf16*)(a.ws + WS_WPOOL);
    float* H = (float*)(a.ws + WS_H); bf16* HB = (bf16*)a.out;
    for (int u = gw; u < 258 * 16; u += NGW) {
        const int rt = u / 16, ct = u % 16, g = ct >> 2;
        const bf16* arow[4];
#pragma unroll
        for (int mi = 0; mi < 4; ++mi) arow[mi] = PO + (size_t)(rt * 64 + 16 * mi + fr) * D + g * 256;
        f32x4 acc[4][4]; zero_acc(acc);
        sg_kloop<4>(256, arow, [=](int n, int k0) { return WPOOL + (size_t)(ct * 64 + n) * 256 + k0; }, NoKS(), acc, fr, fq);
#pragma unroll
        for (int mi = 0; mi < 4; ++mi) { const int row = rt * 64 + 16 * mi + fr;
#pragma unroll
            for (int nj = 0; nj < 4; ++nj) { const int c = ct * 64 + 16 * nj + 4 * fq; float* hp = H + (size_t)row * D + c;
                const f32x4 v = *(const f32x4*)hp + (acc[mi][nj] + *(const f32x4*)(a.in[I_PB] + c)) * *(const f32x4*)(a.in[I_PS] + c); *(f32x4*)hp = v;
                v2u w; w.x = pk2(v.x, v.y); w.y = pk2(v.z, v.w); *(v2u*)(HB + (size_t)row * D + c) = w; } }
    }
}
__device__ __forceinline__ void ph_final(const Args& a, int wk, int nwk) {
    const int tid = threadIdx.x, lane = tid & 63, wave = __builtin_amdgcn_readfirstlane(tid >> 6);
    const int gw = wk * NWAVES + wave, NGW = nwk * NWAVES;
    const f32x4* gn = (const f32x4*)a.in[I_NORMF] + lane;
    const bf16* HF = (const bf16*)(a.ws + WS_SC);
    for (int orow = gw; orow < NB * SEQ; orow += NGW) {
        const int b = orow / SEQ, l = orow - b * SEQ, row = b * LSEQ + NMETA + l;
        const v2u* xr = (const v2u*)(HF + (size_t)row * D) + lane; f32x4 v[4]; float ss = 0.f;
#pragma unroll
        for (int j = 0; j < 4; ++j) { const v2u q = xr[64 * j]; v[j][0] = __uint_as_float(q.x << 16); v[j][1] = __uint_as_float(q.x & 0xffff0000u); v[j][2] = __uint_as_float(q.y << 16); v[j][3] = __uint_as_float(q.y & 0xffff0000u);
            ss += v[j].x * v[j].x + v[j].y * v[j].y + v[j].z * v[j].z + v[j].w * v[j].w; }
        ss = wave_sum(ss);
        const float rstd = rsqrtf(ss * (1.f / D) + EPS);
        f32x4* o = (f32x4*)(a.out + (size_t)orow * D) + lane;
#ifdef PROBE_T
        const unsigned long long* ts = (const unsigned long long*)(a.ws + WS_CTL + 2048);
        const float tA = (float)(ts[PROBE_A_HI] - ts[PROBE_A_LO]) * 0.01f, tB = (float)(ts[PROBE_B_HI] - ts[PROBE_B_LO]) * 0.01f;
#pragma unroll
        for (int j = 0; j < 4; ++j) { f32x4 r = v[j] * rstd * gn[64 * j] + tB * 0.01f; if (orow == 0 && lane == 0 && j == 0) r.x += tA; o[64 * j] = r; }
#else
#pragma unroll
        for (int j = 0; j < 4; ++j) o[64 * j] = v[j] * rstd * gn[64 * j];
#endif
    }
}

__global__ void __launch_bounds__(NWAVES * 64, 2) fwd_kernel(Args a) {
    extern __shared__ __attribute__((aligned(16))) unsigned char lds_raw[];
    LAS unsigned char* lds = (LAS unsigned char*)lds_raw;
    volatile LAS unsigned* MISC = (volatile LAS unsigned*)(lds + LDS_BYTES - 256);
    const int tid = threadIdx.x;
    const int G = gridDim.x; const int bx = blockIdx.x;
    const int wk = (G % 8 == 0) ? (bx % 8) * (G / 8) + bx / 8 : bx;
    if (tid < 64) MISC[tid] = 0u;
    __syncthreads();
    XcdBarrier bar; bar.bar = (unsigned*)(a.ws + WS_CTL) + CW_BAR; bar.x = 0; bar.st = nullptr;
    if (N_LAUNCHES == 1) bar = xcd_barrier_post((unsigned*)(a.ws + WS_CTL) + CW_BAR, MISC + 8);
    const int lo = a.ph_lo, hi = a.ph_hi;
#ifndef PH_MASK
#define PH_MASK 0xFFFF
#endif
#define IN(k) (((PH_MASK >> (k)) & 1) && lo <= (k) && (k) < hi)
#ifdef PROBE_T
#define STAMP(k) do { if (blockIdx.x == 0 && tid == 0) ((unsigned long long*)(a.ws + WS_CTL + 2048))[k] = __builtin_amdgcn_s_memrealtime(); } while (0)
#else
#define STAMP(k) do { } while (0)
#endif
#ifdef PROBE_K
    volatile LAS unsigned long long* pkt = (volatile LAS unsigned long long*)(lds + LDS_BYTES - 128);
#define PSTAMP(k) do { if (blockIdx.x == 0 && tid == 0) { if ((k) == PROBE_K) pkt[0] = __builtin_amdgcn_s_memrealtime(); if ((k) == PROBE_K + 1) pkt[1] = __builtin_amdgcn_s_memrealtime(); } } while (0)
#else
#define PSTAMP(k) do { } while (0)
#endif
#define SEAM(k) do { if (IN(k) && IN((k) + 1)) xcd_barrier(bar); STAMP((k) + 1); PSTAMP((k) + 1); } while (0)
    STAMP(0); PSTAMP(0);
    if (IN(0)) { ph_prep(a, lds, wk, G); } SEAM(0);
    if (IN(1)) { ph_gemm1_pg8(a, lds, G); } SEAM(1);
    if (IN(2)) { ph_conv(a, wk, G); } SEAM(2);
    if (IN(3)) { ph_mixers3(a, lds, wk, G); } SEAM(3);
    if (IN(4)) { ph_gemm2_pg8(a, lds, wk, G); } SEAM(4);
    if (IN(5)) { ph_router(a, lds, 0, wk, G); } SEAM(5);
    if (IN(6)) { ph_moe_up_pg8(a, lds, 0, G); ph_moe_down_pg8(a, lds, 0, G); } SEAM(6);
    STAMP(8); PSTAMP(8);
    if (IN(8)) { ph_pool_fused(a, lds, wk, G); } SEAM(8);
    STAMP(10); PSTAMP(10);
    if (IN(10)) { ph_router(a, lds, 1, wk, G); } SEAM(10);
    if (IN(11)) { ph_moe_up_pg8(a, lds, 1, G); ph_moe_down_pg8(a, lds, 1, G); } SEAM(11);
    STAMP(13); PSTAMP(13);
    if (IN(13)) { ph_final(a, wk, G); }
#ifdef PROBE_K
    if (blockIdx.x == 0 && tid == 0) {
        asm volatile("s_waitcnt vmcnt(0)" ::: "memory");
        if (PROBE_K == 13) pkt[1] = __builtin_amdgcn_s_memrealtime();
        const unsigned long long tend = __builtin_amdgcn_s_memrealtime() + 4ull * (pkt[1] - pkt[0]);
        while (__builtin_amdgcn_s_memrealtime() < tend) __builtin_amdgcn_s_sleep(16);
    }
#endif
#undef IN
#undef SEAM
}

extern "C" void kernel_launch(void* const* d_in, const int* in_sizes, int n_in, void* d_out, int out_size, void* d_ws, size_t ws_size, hipStream_t stream) {
    static int grid = 0;
    if (grid == 0) {
        if (n_in != 31 || out_size != NB * SEQ * D || ws_size < WS_END) { fprintf(stderr, "kernel_launch: unexpected shapes (n_in %d out %d ws %zu)\n", n_in, out_size, ws_size); grid = -1; return; }
        int dev = 0, cus = 0;
        if (hipGetDevice(&dev) != hipSuccess || hipDeviceGetAttribute(&cus, hipDeviceAttributeMultiprocessorCount, dev) != hipSuccess) { grid = -1; return; }
        if (hipFuncSetAttribute((const void*)fwd_kernel, hipFuncAttributeMaxDynamicSharedMemorySize, LDS_BYTES) != hipSuccess) { grid = -1; return; }
        grid = cus;
    }
    if (grid < 0) return;
    (void)hipMemsetAsync((char*)d_ws + WS_CTL, 0, CTL_ZERO_BYTES, stream);
    Args a{};
    for (int i = 0; i < 31; ++i) a.in[i] = (const float*)d_in[i];
    a.out = (float*)d_out; a.ws = (unsigned char*)d_ws;
    if (N_LAUNCHES == 1) { a.ph_lo = 0; a.ph_hi = NPH; hipLaunchKernelGGL(fwd_kernel, dim3(grid), dim3(NWAVES * 64), LDS_BYTES, stream, a); }
    else for (int p = 0; p < NPH; ++p) { a.ph_lo = p; a.ph_hi = p + 1; hipLaunchKernelGGL(fwd_kernel, dim3(grid), dim3(NWAVES * 64), LDS_BYTES, stream, a); }
}
```

```cpp
#include <hip/hip_runtime.h>
#include <cstdio>
#include <cstdint>

#define GAS __attribute__((address_space(1)))
#define LAS __attribute__((address_space(3)))
typedef unsigned short bf16;
typedef short bf16x8 __attribute__((ext_vector_type(8)));
typedef float f32x4 __attribute__((ext_vector_type(4)));
typedef unsigned v4u __attribute__((ext_vector_type(4)));
typedef unsigned v2u __attribute__((ext_vector_type(2)));

#ifndef MK_N_LAUNCHES
#define MK_N_LAUNCHES 1
#endif
constexpr int NPH = 14;
constexpr int N_LAUNCHES = MK_N_LAUNCHES;

constexpr int NB = 8, SEQ = 2048, NMETA = 16, LSEQ = SEQ + NMETA, T = NB * LSEQ, D = 1024;
constexpr int PROJ_SRC = 4624, LDP = 4608;
constexpr int C_Z = 0, C_G = 1024, C_X = 2048, C_B = 3072, C_C = 3328, C_LI = 3584;
constexpr float EPS = 1e-6f;
constexpr int NBK = 24;

constexpr size_t MiB = 1u << 20;
constexpr size_t WS_CTL = 0, CTL_ZERO_BYTES = 1 * MiB;
constexpr size_t WS_WIN = 1 * MiB;
constexpr size_t WS_WOUT = 10 * MiB;
constexpr size_t WS_WPOOL = 14 * MiB;
constexpr size_t WS_WRT = 14 * MiB + 512 * 1024;
constexpr size_t WS_WDTT = 15 * MiB + 512 * 1024;
constexpr size_t WS_RSTD0 = 15 * MiB;
constexpr size_t WS_RSTD1 = WS_RSTD0 + 128 * 1024;
constexpr size_t WS_BKT = WS_RSTD1 + 128 * 1024;
constexpr size_t WS_GATES = WS_BKT + 128 * 1024;
constexpr size_t WS_DT = 16 * MiB;
constexpr size_t WS_SSDSQ = 17 * MiB + 64 * 1024;
constexpr size_t WS_LIST = 19 * MiB;
constexpr size_t WS_WGU = 21 * MiB;
constexpr size_t WS_WD = 53 * MiB;
constexpr size_t WS_H = 69 * MiB;
constexpr size_t WS_PROJ = 134 * MiB;
constexpr size_t WS_HID = WS_PROJ;
constexpr size_t WS_POOLED = WS_PROJ;
constexpr size_t WS_END = 280 * MiB;
constexpr size_t WS_WGU1 = WS_PROJ + 64 * MiB, WS_WD1 = WS_PROJ + 96 * MiB;
__host__ __device__ constexpr size_t ws_wgu(int L) { return L ? WS_WGU1 : WS_WGU; }
__host__ __device__ constexpr size_t ws_wd(int L) { return L ? WS_WD1 : WS_WD; }
constexpr size_t WS_SB = WS_H, WS_SC = WS_H + (size_t)T * D * 2;
static_assert(WS_H + (size_t)T * D * 4 <= WS_PROJ && WS_PROJ + (size_t)T * LDP * 2 <= WS_END, "ws map");
static_assert(WS_DT + (size_t)T * 16 * 4 <= WS_SSDSQ && WS_SSDSQ + (size_t)T * 16 * 4 <= WS_LIST && WS_LIST + (size_t)NBK * T * 4 <= WS_WGU, "ws map small");
constexpr int CW_CNT = 8192;
constexpr int CW_BAR = 4096;
constexpr int CW_RT = 16384;

constexpr int LDS_BYTES = 163840;
constexpr int LDS_TAB = 131072;
constexpr int NWAVES = 8;

struct Args { const float* in[31]; float* out; unsigned char* ws; int ph_lo, ph_hi; };
enum { I_X = 0, I_META, I_NORMF, I_MNE, I_WIN, I_SCW, I_SCB, I_DTB, I_ALOG, I_SD, I_SNORM, I_LCW, I_LCB, I_LWA, I_LBA, I_LWX, I_LBX, I_LLAM, I_WOUT,
       I_MNO, I_PW, I_PB, I_PS, I_FFN, I_RGW, I_RGB, I_REW, I_REB, I_EWG, I_EWU, I_EWD };

#define LDS_WAIT() asm volatile("s_waitcnt lgkmcnt(0)" ::: "memory")
__device__ __forceinline__ float bf2f(unsigned v) { return __uint_as_float(v << 16); }
__device__ __forceinline__ unsigned f2bf(float f) { unsigned u = __float_as_uint(f); return (u + 0x7fffu + ((u >> 16) & 1u)) >> 16; }
__device__ __forceinline__ unsigned pk2(float lo, float hi) { return f2bf(lo) | (f2bf(hi) << 16); }
__device__ __forceinline__ void unpack8v(const v4u r, f32x4& a, f32x4& b) {
    a[0] = __uint_as_float(r.x << 16); a[1] = __uint_as_float(r.x & 0xffff0000u); a[2] = __uint_as_float(r.y << 16); a[3] = __uint_as_float(r.y & 0xffff0000u);
    b[0] = __uint_as_float(r.z << 16); b[1] = __uint_as_float(r.z & 0xffff0000u); b[2] = __uint_as_float(r.w << 16); b[3] = __uint_as_float(r.w & 0xffff0000u);
}
__device__ __forceinline__ float wave_sum(float v) {
#pragma unroll
    for (int o = 1; o < 64; o <<= 1) v += __shfl_xor(v, o);
    return v;
}
__device__ __forceinline__ float rcp_f(float v) { return __builtin_amdgcn_rcpf(v); }
__device__ __forceinline__ float sigmoid_f(float v) { return rcp_f(1.f + __expf(-v)); }
__device__ __forceinline__ float silu_f(float v) { return v * rcp_f(1.f + __expf(-v)); }
__device__ __forceinline__ float softplus_f(float v) {
    const float e = __expf(-fabsf(v));
    const float lp = e < 0.03f ? e * (1.f - e * (0.5f - e * 0.33333334f)) : __logf(1.f + e);
    return fmaxf(v, 0.f) + lp;
}
__device__ __forceinline__ float gelu_tanh_f(float v) { const float u2 = 1.5957691216057308f * (v + 0.044715f * v * v * v); return v * rcp_f(1.f + __expf(-u2)); }
__device__ __forceinline__ const float* h0_row(const Args& a, int row) {
    const int b = row / LSEQ, l = row - b * LSEQ;
    return l < NMETA ? a.in[I_META] + (size_t)l * D : a.in[I_X] + ((size_t)b * SEQ + (l - NMETA)) * D;
}

#define XB_TMO      128
#define XB_XCNT(j)  (256  + 64 * (j))
#define XB_XSUB(j)  (1280 + 64 * (j))
#define XB_XGEN(j)  (2304 + 64 * (j))
#define XB_TOP      3328
#define XB_TOPGEN   3392
#define XCD_BAR_WORDS 3456
#define XB_SPIN_CAP (1u << 18)
__device__ __forceinline__ unsigned xb_ld(unsigned* p)              { return __hip_atomic_load(p, __ATOMIC_RELAXED, __HIP_MEMORY_SCOPE_AGENT); }
__device__ __forceinline__ unsigned xb_add(unsigned* p, unsigned v) { return __hip_atomic_fetch_add(p, v, __ATOMIC_RELAXED, __HIP_MEMORY_SCOPE_AGENT); }
__device__ __forceinline__ unsigned xb_xcc_id() { return (unsigned)__builtin_amdgcn_s_getreg((3 << 11) | 20) & 0xFu; }
#define XB_SPIN(cond, bar) do { unsigned _sp = 0; while (cond) { __builtin_amdgcn_s_sleep(1); \
    if ((++_sp & 255u) == 0u) { if (xb_ld(&(bar)[XB_TMO])) break; if (_sp > XB_SPIN_CAP) { atomicAdd(&(bar)[XB_TMO], 1u); break; } } } } while (0)
struct XcdBarrier { unsigned* bar; unsigned x; volatile LAS unsigned* st; };
__device__ __forceinline__ XcdBarrier xcd_barrier_post(unsigned* bar, volatile LAS unsigned* st) {
    XcdBarrier b; b.bar = bar; b.x = xb_xcc_id(); b.st = st;
    if (threadIdx.x == 0) (void)xb_add(&bar[XB_XCNT(b.x)], 1u);
    return b;
}
__device__ __forceinline__ void xcd_barrier_complete(unsigned* bar, unsigned x, unsigned& nloc, unsigned& nx) {
    const unsigned G = gridDim.x * gridDim.y * gridDim.z;
    unsigned sum, cnt, mine, sp = 0u;
    for (;;) {
        sum = 0u; cnt = 0u; mine = 0u;
#pragma unroll
        for (unsigned j = 0; j < 16; ++j) { const unsigned c = xb_ld(&bar[XB_XCNT(j)]); sum += c; cnt += (c > 0u) ? 1u : 0u; mine = (j == x) ? c : mine; }
        if (sum == G) break;
        __builtin_amdgcn_s_sleep(1);
        if ((++sp & 255u) == 0u) { if (xb_ld(&bar[XB_TMO])) break; if (sp > XB_SPIN_CAP) { atomicAdd(&bar[XB_TMO], 1u); break; } }
    }
    nloc = mine > 0u ? mine : 1u; nx = cnt > 0u ? cnt : 1u;
}
__device__ __forceinline__ void xcd_barrier(const XcdBarrier& b) {
    asm volatile("s_waitcnt vmcnt(0)" ::: "memory");
    __syncthreads();
    if (threadIdx.x == 0) {
        unsigned* bar = b.bar;
        __builtin_amdgcn_s_waitcnt(0);
        unsigned nloc = b.st[0], nx = b.st[1];
        if (nloc == 0u) { xcd_barrier_complete(bar, b.x, nloc, nx); b.st[0] = nloc; b.st[1] = nx; }
        const unsigned old = xb_add(&bar[XB_XSUB(b.x)], 1u);
        const unsigned gen = old / nloc;
        if (old + 1u == (gen + 1u) * nloc) {
            __builtin_amdgcn_fence(__ATOMIC_RELEASE, "agent");
            asm volatile("s_waitcnt vmcnt(0)" ::: "memory");
            const unsigned og = xb_add(&bar[XB_TOP], 1u);
            const unsigned tg = og / nx;
            if (og + 1u == (tg + 1u) * nx) xb_add(&bar[XB_TOPGEN], 1u);
            else XB_SPIN(xb_ld(&bar[XB_TOPGEN]) == tg, bar);
            __builtin_amdgcn_fence(__ATOMIC_ACQUIRE, "agent");
            xb_add(&bar[XB_XGEN(b.x)], 1u);
            asm volatile("s_waitcnt vmcnt(0)" ::: "memory");
        } else {
            XB_SPIN(xb_ld(&bar[XB_XGEN(b.x)]) == gen, bar);
            __builtin_amdgcn_fence(__ATOMIC_ACQUIRE, "agent");
            asm volatile("s_waitcnt vmcnt(0)" ::: "memory");
        }
    }
    __syncthreads();
}

__device__ __forceinline__ void tr_item(const float* src, int ldsrc, const float* gain, bf16* dst, int lddst, LAS float* scr, int lane) {
    float tv[32];
#pragma unroll
    for (int i = 0; i < 32; ++i) { const int kk = 2 * i + (lane >> 5); tv[i] = src[(size_t)kk * ldsrc + (lane & 31)]; }
#pragma unroll
    for (int i = 0; i < 32; ++i) { const int kk = 2 * i + (lane >> 5); float v = tv[i]; if (gain) v *= gain[kk]; scr[kk * 33 + (lane & 31)] = v; }
    LDS_WAIT();
    const int c = lane & 7;
#pragma unroll
    for (int j = 0; j < 4; ++j) { const int n = (lane >> 3) + 8 * j; const LAS float* s = scr + (8 * c) * 33 + n;
        v4u o; o.x = pk2(s[0 * 33], s[1 * 33]); o.y = pk2(s[2 * 33], s[3 * 33]); o.z = pk2(s[4 * 33], s[5 * 33]); o.w = pk2(s[6 * 33], s[7 * 33]);
        *(v4u*)(dst + (size_t)n * lddst + 8 * c) = o; }
    LDS_WAIT();
}
__device__ __forceinline__ void convert_experts(const Args& a, int L, LAS float* scr, int gw, int NGW, int lane);
__device__ __forceinline__ void convert_experts_dyn(const Args& a, int L, LAS unsigned char* lds, unsigned* ctr) {
    const int wave = __builtin_amdgcn_readfirstlane((int)threadIdx.x >> 6), lane = (int)threadIdx.x & 63;
    LAS int* slot = (LAS int*)(lds + 8 * 8448);
    for (;;) {
        __syncthreads();
        if (threadIdx.x == 0) *slot = (int)atomicAdd(ctr, 64u);
        __syncthreads();
        const int base = __builtin_amdgcn_readfirstlane(*slot);
        if (base >= 12288) break;
        convert_experts(a, L, (LAS float*)(lds + wave * 8448), base + wave * 8, 8, lane);
    }
}
__device__ __forceinline__ void convert_experts(const Args& a, int L, LAS float* scr, int gw, int NGW, int lane) {
    bf16* WGU = (bf16*)(a.ws + ws_wgu(L)); bf16* WD = (bf16*)(a.ws + ws_wd(L));
    const float* gain = a.in[I_FFN] + L * D;
    constexpr int I_GU = 16 * 16 * 16, I_DN = 16 * 8 * 32;
    const int it_end = NGW == 8 ? (gw + 8 < 2 * I_GU + I_DN ? gw + 8 : 2 * I_GU + I_DN) : 2 * I_GU + I_DN, it_step = NGW == 8 ? 1 : NGW;
    for (int it = gw; it < it_end; it += it_step) {
        int r = it;
        if (r < 2 * I_GU) {
            const int up = r >= I_GU; if (up) r -= I_GU;
            const int e = r >> 8, kb = (r >> 4) & 15, nb = r & 15;
            const float* src = a.in[up ? I_EWU : I_EWG] + ((size_t)(L * 16 + e) * 1024 + kb * 64) * 512 + nb * 32;
            const int drow = e * 1024 + (nb >> 2) * 256 + (nb & 3) * 32 + (up ? 128 : 0);
            tr_item(src, 512, gain + kb * 64, WGU + (size_t)drow * 1024 + kb * 64, 1024, scr, lane);
        } else {
            r -= 2 * I_GU;
            const int e = r >> 8, kb = (r >> 5) & 7, nb = r & 31;
            const float* src = a.in[I_EWD] + ((size_t)(L * 16 + e) * 512 + kb * 64) * 1024 + nb * 32;
            tr_item(src, 1024, nullptr, WD + (size_t)(e * 1024 + nb * 32) * 512 + kb * 64, 512, scr, lane);
        }
    }
}
__device__ __forceinline__ void ph_prep(const Args& a, LAS unsigned char* lds, int wk, int nwk) {
    const int tid = threadIdx.x, lane = tid & 63, wave = __builtin_amdgcn_readfirstlane(tid >> 6);
    const int gw = wk * NWAVES + wave, NGW = nwk * NWAVES;
    LAS float* scr = (LAS float*)(lds + wave * 8448);
    bf16* WIN = (bf16*)(a.ws + WS_WIN); bf16* WOUT = (bf16*)(a.ws + WS_WOUT); bf16* WPOOL = (bf16*)(a.ws + WS_WPOOL);
    constexpr int I_IN = 16 * 144, I_OUT = 32 * 32, I_POOL = 4 * 4 * 8;
    for (int it = gw; it < I_IN + I_OUT + I_POOL; it += NGW) {
        int r = it;
        if (r < I_IN) { const int kb = r / 144, nb = r % 144, n0 = nb * 32;
            const int sc = n0 < 1024 ? n0 : (n0 < 2048 ? n0 - 1024 + 2576 : (n0 < 3584 ? n0 - 2048 + 1024 : n0 - 3584 + 3600));
            tr_item(a.in[I_WIN] + (size_t)(kb * 64) * PROJ_SRC + sc, PROJ_SRC, a.in[I_MNE] + kb * 64, WIN + (size_t)n0 * 1024 + kb * 64, 1024, scr, lane); continue; }
        r -= I_IN;
        if (r < I_OUT) { const int kb = r >> 5, nb = r & 31;
            tr_item(a.in[I_WOUT] + (size_t)(kb * 64) * 1024 + nb * 32, 1024, kb < 16 ? a.in[I_SNORM] + kb * 64 : nullptr, WOUT + (size_t)(nb * 32) * 2048 + kb * 64, 2048, scr, lane); continue; }
        r -= I_OUT;
        { const int g = r >> 5, kb = (r >> 3) & 3, nb = r & 7;
            tr_item(a.in[I_PW] + (size_t)g * 65536 + (size_t)(kb * 64) * 256 + nb * 32, 256, a.in[I_MNO] + g * 256 + kb * 64, WPOOL + (size_t)(g * 256 + nb * 32) * 256 + kb * 64, 256, scr, lane); }
    }
    {
        v4u* WRT = (v4u*)(a.ws + WS_WRT); v4u* WDTT = (v4u*)(a.ws + WS_WDTT);
        for (int i = wk * 512 + tid; i < 2 * 48 * 128 + 256 * 128; i += nwk * 512) {
            float f[8];
            if (i < 2 * 48 * 128) {
                const int L = i / 6144, r = i % 6144, n = r >> 7, k8 = (r & 127) * 8, j = n < 20 ? n : n - 20;
#pragma unroll
                for (int e = 0; e < 8; ++e) { const int k = k8 + e; float w = 0.f;
                    if (n < 40) { w = (j < 4 ? a.in[I_RGW][((size_t)L * 1024 + k) * 4 + j] : a.in[I_REW][((size_t)L * 1024 + k) * 16 + (j - 4)]) * a.in[I_FFN][L * 1024 + k];
                        if (n >= 20) w -= bf2f(f2bf(w)); }
                    f[e] = w; }
                v4u o; o.x = pk2(f[0], f[1]); o.y = pk2(f[2], f[3]); o.z = pk2(f[4], f[5]); o.w = pk2(f[6], f[7]); WRT[i] = o;
            } else {
                const int r = i - 2 * 48 * 128, n = r >> 7, k8 = (r & 127) * 8;
#pragma unroll
                for (int e = 0; e < 8; ++e) { const int k = k8 + e; f[e] = n < 16 ? a.in[I_WIN][(size_t)k * PROJ_SRC + 2560 + n] * a.in[I_MNE][k] : 0.f; }
                v4u o; o.x = pk2(f[0], f[1]); o.y = pk2(f[2], f[3]); o.z = pk2(f[4], f[5]); o.w = pk2(f[6], f[7]); WDTT[r] = o;
            }
        }
    }
    bf16* HB = (bf16*)a.out; float* RSTD0 = (float*)(a.ws + WS_RSTD0);
    for (int row = gw; row < T; row += NGW) {
        const f32x4* xr = (const f32x4*)h0_row(a, row) + lane;
        f32x4 v[4]; float ss = 0.f;
#pragma unroll
        for (int j = 0; j < 4; ++j) { v[j] = xr[64 * j]; ss += v[j].x * v[j].x + v[j].y * v[j].y + v[j].z * v[j].z + v[j].w * v[j].w; }
        ss = wave_sum(ss);
        v2u* o8 = (v2u*)(HB + (size_t)row * D) + lane;
#pragma unroll
        for (int j = 0; j < 4; ++j) { v2u w; w.x = pk2(v[j].x, v[j].y); w.y = pk2(v[j].z, v[j].w); o8[64 * j] = w; }
        if (lane == 0) RSTD0[row] = rsqrtf(ss * (1.f / D) + EPS);
    }
}

template <int NT, class BP, class KS>
__device__ __forceinline__ void sg_kloop(int K, const bf16* const (&arow)[4], BP bp, KS ks, f32x4 (&acc)[4][NT], int fr, int fq) {
    for (int k0 = 0; k0 < K; k0 += 32) {
        ks(k0, acc);
        bf16x8 av[4], bv[NT];
#pragma unroll
        for (int mi = 0; mi < 4; ++mi) av[mi] = *(const bf16x8*)(arow[mi] + k0 + 8 * fq);
#pragma unroll
        for (int nj = 0; nj < NT; ++nj) bv[nj] = *(const bf16x8*)(bp(16 * nj + fr, k0) + 8 * fq);
#pragma unroll
        for (int mi = 0; mi < 4; ++mi)
#pragma unroll
            for (int nj = 0; nj < NT; ++nj) acc[mi][nj] = __builtin_amdgcn_mfma_f32_16x16x32_bf16(bv[nj], av[mi], acc[mi][nj], 0, 0, 0);
    }
}
template <int NT> __device__ __forceinline__ void zero_acc(f32x4 (&acc)[4][NT]) {
#pragma unroll
    for (int mi = 0; mi < 4; ++mi)
#pragma unroll
        for (int nj = 0; nj < NT; ++nj) acc[mi][nj] = (f32x4){0.f, 0.f, 0.f, 0.f};
}
struct NoKS { template <int NT> __device__ __forceinline__ void operator()(int, f32x4 (&)[4][NT]) const {} };

__device__ __forceinline__ void ph_gemm1(const Args& a, int wk, int nwk) {
    const int tid = threadIdx.x, lane = tid & 63, wave = __builtin_amdgcn_readfirstlane(tid >> 6), fr = lane & 15, fq = lane >> 4;
    const int gw = wk * NWAVES + wave, NGW = nwk * NWAVES;
    const bf16* HB = (const bf16*)a.out; const bf16* WIN = (const bf16*)(a.ws + WS_WIN); bf16* PROJ = (bf16*)(a.ws + WS_PROJ);
    const float* RSTD0 = (const float*)(a.ws + WS_RSTD0);
    for (int u = gw; u < 258 * 72; u += NGW) {
        const int rt = u / 72, ct = u % 72;
        const bf16* arow[4];
#pragma unroll
        for (int mi = 0; mi < 4; ++mi) arow[mi] = HB + (size_t)(rt * 64 + 16 * mi + fr) * D;
        f32x4 acc[4][4]; zero_acc(acc);
        sg_kloop<4>(1024, arow, [=](int n, int k0) { return WIN + (size_t)(ct * 64 + n) * 1024 + k0; }, NoKS(), acc, fr, fq);
#pragma unroll
        for (int mi = 0; mi < 4; ++mi) { const int row = rt * 64 + 16 * mi + fr; const float rs = RSTD0[row];
#pragma unroll
            for (int nj = 0; nj < 4; ++nj) { const f32x4 v = acc[mi][nj] * rs; v2u w; w.x = pk2(v.x, v.y); w.y = pk2(v.z, v.w);
                *(v2u*)(PROJ + (size_t)row * LDP + ct * 64 + 16 * nj + 4 * fq) = w; } }
    }
}

__device__ __forceinline__ void ph_gemm2(const Args& a, int wk, int nwk) {
    const int tid = threadIdx.x, lane = tid & 63, wave = __builtin_amdgcn_readfirstlane(tid >> 6), fr = lane & 15, fq = lane >> 4;
    const int gw = wk * NWAVES + wave, NGW = nwk * NWAVES;
    const bf16* PROJ = (const bf16*)(a.ws + WS_PROJ); const bf16* WOUT = (const bf16*)(a.ws + WS_WOUT);
    const float* SSDSQ = (const float*)(a.ws + WS_SSDSQ);
    float* H = (float*)(a.ws + WS_H); bf16* HB = (bf16*)a.out;
    for (int u = gw; u < 258 * 16; u += NGW) {
        const int rt = u / 16, ct = u % 16;
        const bf16* arow[4]; float f0[4], f1[4];
#pragma unroll
        for (int mi = 0; mi < 4; ++mi) { const int row = rt * 64 + 16 * mi + fr; arow[mi] = PROJ + (size_t)row * LDP;
            const f32x4* sq = (const f32x4*)(SSDSQ + (size_t)row * 16); const f32x4 q0 = sq[0], q1 = sq[1], q2 = sq[2], q3 = sq[3];
            const float s0 = (q0.x + q0.y + q0.z + q0.w) + (q1.x + q1.y + q1.z + q1.w), s1 = (q2.x + q2.y + q2.z + q2.w) + (q3.x + q3.y + q3.z + q3.w);
            const float r0 = rsqrtf(s0 * (1.f / 512.f) + EPS), r1 = rsqrtf(s1 * (1.f / 512.f) + EPS);
            f0[mi] = r0 / r1; f1[mi] = r1; }
        f32x4 acc[4][4]; zero_acc(acc);
        auto ks = [=](int k0, f32x4 (&ac)[4][4]) {
            if (k0 == 512) {
#pragma unroll
                for (int mi = 0; mi < 4; ++mi)
#pragma unroll
                    for (int nj = 0; nj < 4; ++nj) ac[mi][nj] *= f0[mi]; }
            if (k0 == 1024) {
#pragma unroll
                for (int mi = 0; mi < 4; ++mi)
#pragma unroll
                    for (int nj = 0; nj < 4; ++nj) ac[mi][nj] *= f1[mi]; }
        };
        sg_kloop<4>(2048, arow, [=](int n, int k0) { return WOUT + (size_t)(ct * 64 + n) * 2048 + k0; }, ks, acc, fr, fq);
#pragma unroll
        for (int mi = 0; mi < 4; ++mi) { const int row = rt * 64 + 16 * mi + fr; const float* hr = h0_row(a, row);
#pragma unroll
            for (int nj = 0; nj < 4; ++nj) { const int c = ct * 64 + 16 * nj + 4 * fq; const f32x4 v = acc[mi][nj] + *(const f32x4*)(hr + c);
                *(f32x4*)(H + (size_t)row * D + c) = v; v2u w; w.x = pk2(v.x, v.y); w.y = pk2(v.z, v.w); *(v2u*)(HB + (size_t)row * D + c) = w; } }
    }
}


namespace pg8 {
constexpr int BM = 256, BK = 64, HALF = 128, HTB = HALF * BK * 2, STAGE_BYTES = 8 * HTB, NXCD = 8, WGM = 8;
__host__ __device__ __forceinline__ int lds_byte(int r, int c) { const int st = (r >> 4) * 2 + (c >> 5), rr = r & 15, cc = c & 31, ob = rr * 64 + cc * 2; return st * 1024 + (ob ^ (((ob >> 9) & 1) << 5)); }
__host__ __device__ __forceinline__ void stage_rc(int b, int& R, int& C) { const int st = b / 1024, sb = b % 1024, swz = sb ^ (((sb >> 9) & 1) << 5); R = (st >> 1) * 16 + swz / 64; C = (st & 1) * 32 + (swz % 64) / 2; }
__host__ __device__ __forceinline__ int perm32(int rho) { const int n = rho >> 4, i = rho & 15; return 8 * (i >> 2) + 4 * n + (i & 3); }
__device__ __forceinline__ unsigned cvt_pk_bf16(float lo, float hi) { unsigned r; asm volatile("v_cvt_pk_bf16_f32 %0, %1, %2" : "=v"(r) : "v"(lo), "v"(hi)); return r; }
typedef f32x4 Acc[2][2][4][2];

__device__ __forceinline__ bool static_order(int nM, int nN, int G, int c, int i, int& pm, int& pn) {
    const int nwg = nM * nN; const long L = (long)i * G + c; if (L >= nwg) return false;
    int wgid = (int)L; { const int q = nwg / NXCD, r = nwg % NXCD, xcd = wgid % NXCD, off = wgid / NXCD; wgid = (xcd < r ? xcd * (q + 1) : r * (q + 1) + (xcd - r) * q) + off; }
    const int nig = WGM * nN, gid = wgid / nig, fm = gid * WGM, gsz = (nM - fm) < WGM ? (nM - fm) : WGM;
    pm = fm + ((wgid % nig) % gsz); pn = (wgid % nig) / gsz; return true;
}

template <class P, bool ALIGN_EPI>
__device__ __forceinline__ void gemm_phase(LAS unsigned char* lds, const P& S) {
    const int tid = threadIdx.x, wid = __builtin_amdgcn_readfirstlane(tid >> 6), lane = tid & 63, wr = wid >> 2, wc = wid & 3, fr = lane & 15, fq = lane >> 4;
    const int nt = S.nt;
    int RA[2], CA[2]; unsigned voffB[2];
#pragma unroll
    for (int i = 0; i < 2; ++i) { int R, C; stage_rc(tid * 16 + i * 8192, R, C); RA[i] = R; CA[i] = C; const int Rb = P::PERM ? ((R & ~31) + perm32(R & 31)) : R;
        voffB[i] = (unsigned)(Rb * S.ldb + C) * 2u; }
    const size_t kstep = (size_t)(BK * 2);
    const size_t hstepB = (size_t)HALF * S.ldb * 2;
    const unsigned ldsw = (unsigned)wid * 1024u;
    const int aoff = lds_byte(wr * 64 + fr, fq * 8), boff = lds_byte(wc * 32 + fr, fq * 8);
#define PG8_SA(b, h) (((b) * 2 + (h)) * HTB)
#define PG8_SB(b, h) ((4 + (b) * 2 + (h)) * HTB)
#define PG8_STAGE(bufoff, gbase, voff) do { _Pragma("unroll") for (int _i = 0; _i < 2; ++_i) \
        __builtin_amdgcn_global_load_lds((const unsigned*)((const char*)(gbase) + (voff)[_i]), (LAS unsigned*)(lds + (bufoff) + ldsw + _i * 8192), 16, 0, 0); } while (0)
#define PG8_LDA(dst, b, h) do { _Pragma("unroll") for (int m = 0; m < 4; ++m) _Pragma("unroll") for (int k = 0; k < 2; ++k) dst[m][k] = *(const LAS bf16x8*)(lds + PG8_SA(b, h) + aoff + m * 2048 + k * 1024); } while (0)
#define PG8_LDB(dst, b, h) do { _Pragma("unroll") for (int n = 0; n < 2; ++n) _Pragma("unroll") for (int k = 0; k < 2; ++k) dst[n][k] = *(const LAS bf16x8*)(lds + PG8_SB(b, h) + boff + n * 2048 + k * 1024); } while (0)
#define PG8_MMA(ai, bj, At, Bt) do { __builtin_amdgcn_s_setprio(1); _Pragma("unroll") for (int m = 0; m < 4; ++m) _Pragma("unroll") for (int n = 0; n < 2; ++n) _Pragma("unroll") for (int k = 0; k < 2; ++k) \
        acc[ai][bj][m][n] = __builtin_amdgcn_mfma_f32_16x16x32_bf16(Bt[n][k], At[m][k], acc[ai][bj][m][n], 0, 0, 0); __builtin_amdgcn_s_setprio(0); } while (0)
#define PG8_WAIT_V(n) asm volatile("s_waitcnt vmcnt(" #n ")" ::: "memory")
#define PG8_WAIT_L(n) asm volatile("s_waitcnt lgkmcnt(" #n ")" ::: "memory")
#define PG8_BAR __builtin_amdgcn_s_barrier()
#define PG8_SCHED __builtin_amdgcn_sched_barrier(0)
    typename P::Unit cur, nxt; int ui = 0;
    if (!S.next(0, cur)) return;
    f32x4 acc[2][2][4][2];
#pragma unroll
    for (int a = 0; a < 2; ++a)
#pragma unroll
        for (int b = 0; b < 2; ++b)
#pragma unroll
            for (int m = 0; m < 4; ++m)
#pragma unroll
                for (int n = 0; n < 2; ++n) acc[a][b][m][n] = (f32x4){0.f, 0.f, 0.f, 0.f};
    bf16x8 At[4][2], B0[2][2], B1[2][2];
    typename P::EpiRegs er;
    unsigned vA[4];
    S.a_ready(cur);
    S.avoff(cur, RA, CA, vA);
    const char* cA = S.abase(cur);
    {
        const char* b0 = S.btile(cur, 0); const char* b1 = S.btile(cur, 1);
        PG8_STAGE(PG8_SB(0, 0), b0, voffB); PG8_STAGE(PG8_SB(0, 1), b0 + hstepB, voffB); PG8_STAGE(PG8_SA(0, 0), cA, vA); PG8_STAGE(PG8_SA(0, 1), cA, vA + 2);
        if (wr == 1) PG8_BAR;
        PG8_WAIT_V(2); PG8_BAR;
        PG8_STAGE(PG8_SB(1, 0), b1, voffB); PG8_STAGE(PG8_SA(1, 0), cA + kstep, vA); PG8_STAGE(PG8_SB(1, 1), b1 + hstepB, voffB);
        PG8_WAIT_V(6); PG8_BAR;
    }
    for (;;) {
        const bool has_next = S.next(ui + 1, nxt);
        for (int t = 0; t < nt; t += 2) {
            const bool last = (t == nt - 2);
            const char* a1 = cA + (size_t)(t + 1) * kstep;
            S.khook(t, acc, cur, lds, wr, wc, fr, fq);
            if (last) S.epi_pre(cur, er, wr, wc, fr, fq);
            PG8_LDB(B0, 0, 0); PG8_LDB(B1, 0, 1); PG8_SCHED; PG8_LDA(At, 0, 0); PG8_STAGE(PG8_SA(1, 1), a1, vA + 2);
            PG8_WAIT_V(8); PG8_WAIT_L(0); PG8_BAR; PG8_MMA(0, 0, At, B0); PG8_MMA(0, 1, At, B1); PG8_BAR; PG8_SCHED;
            const bool sw = last && has_next;
            if (sw) { S.a_ready(nxt);
                int t2 = tid; asm volatile("" : "+v"(t2));
                int RA2[2], CA2[2];
#pragma unroll
                for (int i = 0; i < 2; ++i) stage_rc(t2 * 16 + i * 8192, RA2[i], CA2[i]);
                S.avoff(nxt, RA2, CA2, vA); }
            const char* a2 = last ? (sw ? S.abase(nxt) : cA) : cA + (size_t)(t + 2) * kstep;
            const char* b2 = last ? (sw ? S.btile(nxt, 0) : S.btile(cur, 0)) : S.btile(cur, t + 2);
            const char* b3 = last ? (sw ? S.btile(nxt, 1) : S.btile(cur, 1)) : S.btile(cur, t + 3);
            const char* a3 = a2 + kstep;
            PG8_LDA(At, 0, 1); PG8_STAGE(PG8_SB(0, 0), b2, voffB); PG8_STAGE(PG8_SB(0, 1), b2 + hstepB, voffB); PG8_STAGE(PG8_SA(0, 0), a2, vA);
            PG8_WAIT_V(8); PG8_WAIT_L(0); PG8_BAR; PG8_MMA(1, 0, At, B0); PG8_MMA(1, 1, At, B1); PG8_BAR; PG8_SCHED;
            PG8_LDB(B0, 1, 0); PG8_LDB(B1, 1, 1); PG8_SCHED; PG8_LDA(At, 1, 0); PG8_STAGE(PG8_SA(0, 1), a2, vA + 2);
            PG8_WAIT_V(8); PG8_WAIT_L(0); PG8_BAR; PG8_MMA(0, 0, At, B0); PG8_MMA(0, 1, At, B1); PG8_BAR; PG8_SCHED;
            PG8_LDA(At, 1, 1); PG8_STAGE(PG8_SB(1, 0), b3, voffB); PG8_STAGE(PG8_SB(1, 1), b3 + hstepB, voffB); PG8_STAGE(PG8_SA(1, 0), a3, vA);
            PG8_WAIT_V(8); PG8_WAIT_L(0); PG8_BAR; PG8_MMA(1, 0, At, B0); PG8_MMA(1, 1, At, B1); PG8_BAR; PG8_SCHED;
        }
        if constexpr (ALIGN_EPI) { if (wr == 0) PG8_BAR; }
        S.epi(acc, cur, er, wr, wc, fr, fq);
        S.done(cur);
        if (!has_next) break;
#pragma unroll
        for (int a = 0; a < 2; ++a)
#pragma unroll
            for (int b = 0; b < 2; ++b)
#pragma unroll
                for (int m = 0; m < 4; ++m)
#pragma unroll
                    for (int n = 0; n < 2; ++n) acc[a][b][m][n] = (f32x4){0.f, 0.f, 0.f, 0.f};
        cur = nxt; cA = S.abase(cur); ++ui;
        if constexpr (ALIGN_EPI) { if (wr == 1) PG8_BAR; }
    }
    PG8_WAIT_V(0);
    if constexpr (!ALIGN_EPI) { if (wr == 0) PG8_BAR; }
    PG8_BAR;
#undef PG8_SA
#undef PG8_SB
#undef PG8_STAGE
#undef PG8_LDA
#undef PG8_LDB
#undef PG8_MMA
#undef PG8_WAIT_V
#undef PG8_WAIT_L
#undef PG8_BAR
#undef PG8_SCHED
}
}

struct PGemm1 {
    static constexpr bool PERM = true;
    struct EpiRegs {};
    template <class U_> __device__ __forceinline__ void epi_pre(const U_&, EpiRegs&, int, int, int, int) const {}
    struct Unit { int pm, pn, ui; };
    const char* A; const char* B; const char* Bdt; bf16* O; const float* rstd; const LAS float* rstab; float* DT; const float* dtb; int G, c; int ldb, nt;
    __device__ __forceinline__ bool next(int i, Unit& u) const { u.ui = i; return pg8::static_order(65, 19, G, c, i, u.pm, u.pn); }
    __device__ __forceinline__ void avoff(const Unit& u, const int (&RA)[2], const int (&CA)[2], unsigned (&v)[4]) const {
#pragma unroll
        for (int h = 0; h < 2; ++h)
#pragma unroll
            for (int i = 0; i < 2; ++i) { int row = u.pm * 256 + h * 128 + RA[i]; row = row < T ? row : T - 1; v[h * 2 + i] = (unsigned)(row * D + CA[i]) * 2u; }
    }
    __device__ __forceinline__ const char* abase(const Unit&) const { return A; }
    __device__ __forceinline__ const char* btile(const Unit& u, int t) const { return (u.pn < 18 ? B + (size_t)u.pn * 256 * 1024 * 2 : Bdt) + (size_t)t * 64 * 2; }
    __device__ __forceinline__ void khook(int, pg8::Acc&, const Unit&, LAS unsigned char*, int, int, int, int) const {}
    __device__ __forceinline__ void a_ready(const Unit&) const {}
    __device__ __forceinline__ void done(const Unit&) const {}
    __device__ __forceinline__ void epi(const pg8::Acc& acc, const Unit& u, const EpiRegs&, int wr, int wc, int fr, int fq) const {
        const int row0 = u.pm * 256 + wr * 64 + fr, col0 = u.pn * 256 + wc * 32 + 8 * fq;
        float rsv[2][4];
#pragma unroll
        for (int ai = 0; ai < 2; ++ai)
#pragma unroll
            for (int m = 0; m < 4; ++m) rsv[ai][m] = rstab[u.ui * 256 + wr * 64 + fr + ai * 128 + m * 16];
        if (u.pn == 18) {
            if (wc == 0 && fq < 2) { const f32x4 b0 = *(const f32x4*)(dtb + 8 * fq), b1 = *(const f32x4*)(dtb + 8 * fq + 4);
#pragma unroll
                for (int ai = 0; ai < 2; ++ai)
#pragma unroll
                    for (int m = 0; m < 4; ++m) { const int row = row0 + ai * 128 + m * 16;
                        if (row < T) { const float rs = rsv[ai][m]; f32x4 d0 = acc[ai][0][m][0] * rs + b0, d1 = acc[ai][0][m][1] * rs + b1;
#pragma unroll
                            for (int j = 0; j < 4; ++j) { d0[j] = softplus_f(d0[j]); d1[j] = softplus_f(d1[j]); }
                            *(f32x4*)(DT + (size_t)row * 16 + 8 * fq) = d0; *(f32x4*)(DT + (size_t)row * 16 + 8 * fq + 4) = d1; } } }
            return; }
#pragma unroll
        for (int ai = 0; ai < 2; ++ai)
#pragma unroll
            for (int m = 0; m < 4; ++m) { const int row = row0 + ai * 128 + m * 16;
                if (row < T) { const float rs = rsv[ai][m]; bf16* rowp = O + (size_t)row * LDP + col0;
#pragma unroll
                    for (int bj = 0; bj < 2; ++bj) { const f32x4 v0 = acc[ai][bj][m][0] * rs, v1 = acc[ai][bj][m][1] * rs;
                        v4u w; w.x = pg8::cvt_pk_bf16(v0[0], v0[1]); w.y = pg8::cvt_pk_bf16(v0[2], v0[3]); w.z = pg8::cvt_pk_bf16(v1[0], v1[1]); w.w = pg8::cvt_pk_bf16(v1[2], v1[3]);
                        *(v4u*)(rowp + bj * 128) = w; } } }
    }
};
__device__ __forceinline__ void ph_gemm1_pg8(const Args& a, LAS unsigned char* lds, int G) {
    PGemm1 S; S.A = (const char*)a.out; S.B = (const char*)(a.ws + WS_WIN); S.O = (bf16*)(a.ws + WS_PROJ); S.rstd = (const float*)(a.ws + WS_RSTD0); S.Bdt = (const char*)(a.ws + WS_WDTT); S.DT = (float*)(a.ws + WS_DT); S.dtb = a.in[I_DTB];
    S.G = G; S.c = (int)blockIdx.x; S.ldb = 1024; S.nt = 16;
    {
        LAS float* rt = (LAS float*)(lds + LDS_TAB); S.rstab = rt; PGemm1::Unit u;
        __syncthreads();
        for (int i = 0; i < 8 && S.next(i, u); ++i) if (threadIdx.x < 256) { const int row = u.pm * 256 + (int)threadIdx.x; rt[i * 256 + threadIdx.x] = S.rstd[row < T ? row : T - 1]; }
        __syncthreads();
    }
    pg8::gemm_phase<PGemm1, true>(lds, S);
}

__device__ __forceinline__ void ssd_item(const Args& a, LAS unsigned char* lds, int b, int h) {
    const int tid = threadIdx.x, lane = tid & 63;
    constexpr int TB = 64;
    LAS float* xs = (LAS float*)lds;
    LAS float* Bs = xs + TB * 64;
    LAS float* Cs = Bs + TB * 128;
    LAS float* ys = Cs + TB * 128;
    LAS float* dts = ys + TB * 64;
    LAS float* decs = dts + TB;
    bf16* PROJ = (bf16*)(a.ws + WS_PROJ); const float* DT = (const float*)(a.ws + WS_DT); float* SSDSQ = (float*)(a.ws + WS_SSDSQ);
    const int g = h >> 3;
    const float Ah = -__expf(a.in[I_ALOG][h]), Dh = a.in[I_SD][h];
    int ccol = 0, cch = 0; float cw0 = 0.f, cw1 = 0.f, cw2 = 0.f, cw3 = 0.f, cb = 0.f;
    if (tid < 320) {
        if (tid < 64) { ccol = C_X + h * 64 + tid; cch = h * 64 + tid; }
        else if (tid < 192) { ccol = C_B + g * 128 + (tid - 64); cch = 1024 + g * 128 + (tid - 64); }
        else { ccol = C_C + g * 128 + (tid - 192); cch = 1280 + g * 128 + (tid - 192); }
        const float* cw = a.in[I_SCW]; cw0 = cw[cch]; cw1 = cw[1536 + cch]; cw2 = cw[2 * 1536 + cch]; cw3 = cw[3 * 1536 + cch]; cb = a.in[I_SCB][cch];
    }
    const int p = tid >> 3, nq = tid & 7;
    float S[16];
#pragma unroll
    for (int i = 0; i < 16; ++i) S[i] = 0.f;
    const size_t rbase = (size_t)b * LSEQ;
    for (int l0 = 0; l0 < LSEQ; l0 += TB) {
        const int nt = (LSEQ - l0) < TB ? (LSEQ - l0) : TB;
        __syncthreads();
        if (tid < 320) {
            float r0 = l0 >= 3 ? bf2f(PROJ[(rbase + l0 - 3) * LDP + ccol]) : 0.f, r1 = l0 >= 2 ? bf2f(PROJ[(rbase + l0 - 2) * LDP + ccol]) : 0.f, r2 = l0 >= 1 ? bf2f(PROJ[(rbase + l0 - 1) * LDP + ccol]) : 0.f;
            for (int t = 0; t < nt; ++t) {
                const float r3 = bf2f(PROJ[(rbase + l0 + t) * LDP + ccol]);
                const float v = silu_f(cw0 * r0 + cw1 * r1 + cw2 * r2 + cw3 * r3 + cb);
                if (tid < 64) xs[t * 64 + tid] = v; else if (tid < 192) Bs[t * 128 + tid - 64] = v; else Cs[t * 128 + tid - 192] = v;
                r0 = r1; r1 = r2; r2 = r3;
            }
        } else if (tid < 320 + TB) {
            const int t = tid - 320;
            if (t < nt) { const float dt = DT[(rbase + l0 + t) * 16 + h]; dts[t] = dt; decs[t] = __expf(Ah * dt); }
        }
        __syncthreads();
        for (int t = 0; t < nt; ++t) {
            const float xv = xs[t * 64 + p], xdt = xv * dts[t], dec = decs[t];
            float yp = 0.f;
#pragma unroll
            for (int i = 0; i < 16; ++i) { S[i] = dec * S[i] + Bs[t * 128 + nq * 16 + i] * xdt; yp += Cs[t * 128 + nq * 16 + i] * S[i]; }
            yp += __shfl_xor(yp, 1); yp += __shfl_xor(yp, 2); yp += __shfl_xor(yp, 4);
            if (nq == 0) ys[t * 64 + p] = yp + Dh * xv;
        }
        __syncthreads();
        for (int t = tid >> 6; t < nt; t += 8) {
            const size_t row = rbase + l0 + t;
            const float z = bf2f(PROJ[row * LDP + C_Z + h * 64 + lane]);
            const float yg = ys[t * 64 + lane] * silu_f(z);
            PROJ[row * LDP + C_Z + h * 64 + lane] = (bf16)f2bf(yg);
            const float sq = wave_sum(yg * yg);
            if (lane == 0) SSDSQ[row * 16 + h] = sq;
        }
    }
    __syncthreads();
}
__device__ __forceinline__ void lru_item(const Args& a, LAS unsigned char* lds, int b, int h) {
    const int tid = threadIdx.x;
    constexpr int TB = 64;
    LAS float* Wa = (LAS float*)lds;
    LAS float* Wx = Wa + 4096;
    LAS float* xb = Wx + 4096;
    LAS float* as = xb + TB * 64;
    LAS float* us = as + TB * 64;
    bf16* PROJ = (bf16*)(a.ws + WS_PROJ);
    __syncthreads();
    for (int i = tid; i < 4096; i += 512) { Wa[i] = a.in[I_LWA][(size_t)h * 4096 + i]; Wx[i] = a.in[I_LWX][(size_t)h * 4096 + i]; }
    const size_t rbase = (size_t)b * LSEQ;
    float hprev = 0.f;
    const int c = tid & 63, tq = tid >> 6;
    const float* cw = a.in[I_LCW]; const int ch = h * 64 + c;
    const float cw0 = cw[ch], cw1 = cw[1024 + ch], cw2 = cw[2048 + ch], cw3 = cw[3072 + ch], cb = a.in[I_LCB][ch];
    const int gt = tid >> 3, jq = tid & 7;
    for (int l0 = 0; l0 < LSEQ; l0 += TB) {
        const int nt = (LSEQ - l0) < TB ? (LSEQ - l0) : TB;
        __syncthreads();
        for (int t = tq * 8; t < tq * 8 + 8; ++t) if (t < nt) {
            const int l = l0 + t; const size_t row = rbase + l;
            const float r3 = bf2f(PROJ[row * LDP + C_LI + ch]);
            const float r2 = l >= 1 ? bf2f(PROJ[(row - 1) * LDP + C_LI + ch]) : 0.f;
            const float r1 = l >= 2 ? bf2f(PROJ[(row - 2) * LDP + C_LI + ch]) : 0.f;
            const float r0 = l >= 3 ? bf2f(PROJ[(row - 3) * LDP + C_LI + ch]) : 0.f;
            xb[t * 64 + c] = cw0 * r0 + cw1 * r1 + cw2 * r2 + cw3 * r3 + cb;
        }
        __syncthreads();
        if (gt < nt) {
            float ra[8], ri[8];
#pragma unroll
            for (int j = 0; j < 8; ++j) { ra[j] = 0.f; ri[j] = 0.f; }
            for (int i = 0; i < 64; ++i) { const float xv = xb[gt * 64 + i];
#pragma unroll
                for (int j = 0; j < 8; ++j) { ra[j] += xv * Wa[i * 64 + jq * 8 + j]; ri[j] += xv * Wx[i * 64 + jq * 8 + j]; } }
#pragma unroll
            for (int j = 0; j < 8; ++j) { const int cc = h * 64 + jq * 8 + j;
                const float r = sigmoid_f(ra[j] + a.in[I_LBA][cc]), ig = sigmoid_f(ri[j] + a.in[I_LBX][cc]);
                const float log_a = -8.0f * r * softplus_f(-a.in[I_LLAM][cc]);
                const float av = __expf(log_a);
                const float mult = (l0 + gt == 0) ? 1.f : sqrtf(fmaxf(-expm1f(2.f * log_a), 0.f));
                as[gt * 64 + jq * 8 + j] = av; us[gt * 64 + jq * 8 + j] = mult * ig * xb[gt * 64 + jq * 8 + j]; }
        }
        __syncthreads();
        if (tid < 64) { for (int t = 0; t < nt; ++t) { hprev = as[t * 64 + tid] * hprev + us[t * 64 + tid]; us[t * 64 + tid] = hprev; } }
        __syncthreads();
        for (int t = tq * 8; t < tq * 8 + 8; ++t) if (t < nt) {
            const size_t row = rbase + l0 + t;
            const float gv = bf2f(PROJ[row * LDP + C_G + ch]);
            PROJ[row * LDP + C_G + ch] = (bf16)f2bf(us[t * 64 + c] * gelu_tanh_f(gv));
        }
    }
    __syncthreads();
}
__device__ __forceinline__ void ph_mixers(const Args& a, LAS unsigned char* lds, int wk, int nwk) {
    for (int it = wk; it < 256; it += nwk) {
        if (it < 128) ssd_item(a, lds, it >> 4, it & 15); else lru_item(a, lds, (it - 128) >> 4, (it - 128) & 15);
    }
}


__device__ __forceinline__ f32x4 mfma16(bf16x8 a, bf16x8 b, f32x4 c) { return __builtin_amdgcn_mfma_f32_16x16x32_bf16(a, b, c, 0, 0, 0); }
constexpr int RSX = 144, RSB = 272;
constexpr int SO_X = 0, SO_B = SO_X + 128 * RSX, SO_C = SO_B + 128 * RSB, SO_M = SO_C + 128 * RSB, SO_S = SO_M + 128 * RSB, SO_V = SO_S + 64 * RSB;
static_assert(SO_V + 4096 <= LDS_BYTES - 256, "ssd lds");
#define TR4(RS4, o0, o1, o2, o3, addr) do { v2u l0_, h0_, l1_, h1_, l2_, h2_, l3_, h3_; \
    asm volatile("ds_read_b64_tr_b16 %0, %8\n\tds_read_b64_tr_b16 %1, %8 offset:" #RS4 "\n\t" \
                 "ds_read_b64_tr_b16 %2, %8 offset:32\n\tds_read_b64_tr_b16 %3, %8 offset:" #RS4 "+32\n\t" \
                 "ds_read_b64_tr_b16 %4, %8 offset:64\n\tds_read_b64_tr_b16 %5, %8 offset:" #RS4 "+64\n\t" \
                 "ds_read_b64_tr_b16 %6, %8 offset:96\n\tds_read_b64_tr_b16 %7, %8 offset:" #RS4 "+96\n\ts_waitcnt lgkmcnt(0)" \
                 : "=&v"(l0_), "=&v"(h0_), "=&v"(l1_), "=&v"(h1_), "=&v"(l2_), "=&v"(h2_), "=&v"(l3_), "=&v"(h3_) : "v"(addr) : "memory"); \
    o0 = __builtin_bit_cast(bf16x8, (v4u){l0_.x, l0_.y, h0_.x, h0_.y}); o1 = __builtin_bit_cast(bf16x8, (v4u){l1_.x, l1_.y, h1_.x, h1_.y}); \
    o2 = __builtin_bit_cast(bf16x8, (v4u){l2_.x, l2_.y, h2_.x, h2_.y}); o3 = __builtin_bit_cast(bf16x8, (v4u){l3_.x, l3_.y, h3_.x, h3_.y}); } while (0)
#define TR1(RS4, o0, addr) do { v2u l0_, h0_; \
    asm volatile("ds_read_b64_tr_b16 %0, %2\n\tds_read_b64_tr_b16 %1, %2 offset:" #RS4 "\n\ts_waitcnt lgkmcnt(0)" : "=&v"(l0_), "=&v"(h0_) : "v"(addr) : "memory"); \
    o0 = __builtin_bit_cast(bf16x8, (v4u){l0_.x, l0_.y, h0_.x, h0_.y}); } while (0)
__device__ __forceinline__ void unpack8(const v4u r, float (&f)[8]) {
    f[0] = __uint_as_float(r.x << 16); f[1] = __uint_as_float(r.x & 0xffff0000u); f[2] = __uint_as_float(r.y << 16); f[3] = __uint_as_float(r.y & 0xffff0000u);
    f[4] = __uint_as_float(r.z << 16); f[5] = __uint_as_float(r.z & 0xffff0000u); f[6] = __uint_as_float(r.w << 16); f[7] = __uint_as_float(r.w & 0xffff0000u);
}
__device__ __forceinline__ void ph_conv(const Args& a, int wk, int nwk) {
    const bf16* PROJ = (const bf16*)(a.ws + WS_PROJ); bf16* XACT = (bf16*)(a.ws + WS_H);
    for (int id = wk * 512 + (int)threadIdx.x; id < NB * 48 * 192; id += nwk * 512) {
        const int cg = id % 192, rr = id / 192, b = rr / 48, t0 = (rr % 48) * 43;
        const int ch = cg * 8;
        const float* cwp = a.in[I_SCW] + ch;
        float cw[4][8], cb[8];
#pragma unroll
        for (int k = 0; k < 4; ++k) { const f32x4 wa = *(const f32x4*)(cwp + k * 1536), wb = *(const f32x4*)(cwp + k * 1536 + 4);
#pragma unroll
            for (int j = 0; j < 4; ++j) { cw[k][j] = wa[j]; cw[k][4 + j] = wb[j]; } }
        { const float* cbp = a.in[I_SCB] + ch; const f32x4 wa = *(const f32x4*)cbp, wb = *(const f32x4*)(cbp + 4);
#pragma unroll
          for (int j = 0; j < 4; ++j) { cb[j] = wa[j]; cb[4 + j] = wb[j]; } }
        const size_t rb = (size_t)b * LSEQ;
        const bf16* src = PROJ + rb * LDP + 2048 + cg * 8;
        bf16* dst = XACT + rb * 1536 + ch;
        float p0[8], p1[8], p2[8];
        {   v4u q0 = (v4u){0u, 0u, 0u, 0u}, q1 = q0, q2 = q0;
            if (t0 >= 3) { q0 = *(const v4u*)(src + (size_t)(t0 - 3) * LDP); q1 = *(const v4u*)(src + (size_t)(t0 - 2) * LDP); q2 = *(const v4u*)(src + (size_t)(t0 - 1) * LDP); }
            unpack8(q0, p0); unpack8(q1, p1); unpack8(q2, p2); }
#pragma unroll 4
        for (int t = 0; t < 43; ++t) {
            const int l = t0 + t; float p3[8]; unpack8(*(const v4u*)(src + (size_t)l * LDP), p3);
            float o[8];
#pragma unroll
            for (int j = 0; j < 8; ++j) { o[j] = silu_f(cw[0][j] * p0[j] + cw[1][j] * p1[j] + cw[2][j] * p2[j] + cw[3][j] * p3[j] + cb[j]); p0[j] = p1[j]; p1[j] = p2[j]; p2[j] = p3[j]; }
            v4u ov; ov.x = pk2(o[0], o[1]); ov.y = pk2(o[2], o[3]); ov.z = pk2(o[4], o[5]); ov.w = pk2(o[6], o[7]);
            *(v4u*)(dst + (size_t)l * 1536) = ov;
        }
    }
}
__device__ __forceinline__ void ssd_item3(const Args& a, LAS unsigned char* lds, int b, int h) {
    const int tid = threadIdx.x, lane = tid & 63, w = __builtin_amdgcn_readfirstlane(tid >> 6), fr0 = lane & 15, fq0 = lane >> 4;
    bf16* PROJ = (bf16*)(a.ws + WS_PROJ); const bf16* XACT = (const bf16*)(a.ws + WS_H); const float* DT = (const float*)(a.ws + WS_DT); float* SSDSQ = (float*)(a.ws + WS_SSDSQ);
    const int g = h >> 3;
    const float Ah = -__expf(a.in[I_ALOG][h]), Dh = a.in[I_SD][h];
    LAS float* acs = (LAS float*)(lds + SO_V); LAS float* dtv = acs + 128; LAS float* wv = acs + 256; LAS float* eacs = acs + 384;
    const size_t rbase = (size_t)b * LSEQ;
    const int pt_s = w & 3, nh = w >> 2;
    f32x4 sacc[4];
#pragma unroll
    for (int i = 0; i < 4; ++i) sacc[i] = (f32x4){0.f, 0.f, 0.f, 0.f};
    __syncthreads();
    for (int i = tid; i < 64 * RSB / 4; i += 512) ((LAS unsigned*)(lds + SO_S))[i] = 0u;
    v4u pf[10], zp[2]; float d0 = 0.f, d1 = 0.f;
    const int ft = tid >> 2, q4 = tid & 3;
    const int xr_ = tid >> 3, xp_ = tid & 7, br_ = tid >> 4, bp_ = tid & 15;
    const bf16* xsrc = XACT + (rbase + xr_) * 1536 + h * 64 + xp_ * 8;
    const bf16* bsrc = XACT + (rbase + br_) * 1536 + 1024 + g * 128 + bp_ * 8;
#define SSD_PREFETCH_A(L0) do { const int l0_ = (L0); \
        _Pragma("unroll") for (int i = 0; i < 2; ++i) { pf[i] = (v4u){0u, 0u, 0u, 0u}; if (l0_ + xr_ + 64 * i < LSEQ) pf[i] = *(const v4u*)(xsrc + (size_t)(l0_ + 64 * i) * 1536); } \
        _Pragma("unroll") for (int i = 0; i < 4; ++i) { pf[2 + i] = (v4u){0u, 0u, 0u, 0u}; if (l0_ + br_ + 32 * i < LSEQ) pf[2 + i] = *(const v4u*)(bsrc + (size_t)(l0_ + 32 * i) * 1536); } } while (0)
#define SSD_PREFETCH_B(L0) do { const int l0_ = (L0); \
        _Pragma("unroll") for (int i = 0; i < 4; ++i) { pf[6 + i] = (v4u){0u, 0u, 0u, 0u}; if (l0_ + br_ + 32 * i < LSEQ) pf[6 + i] = *(const v4u*)(bsrc + (size_t)(l0_ + 32 * i) * 1536 + 256); } \
        zp[0] = (v4u){0u, 0u, 0u, 0u}; zp[1] = zp[0]; \
        if (l0_ + ft < LSEQ) { const bf16* zq = PROJ + (rbase + l0_ + ft) * LDP + C_Z + h * 64 + 16 * q4; zp[0] = *(const v4u*)zq; zp[1] = *(const v4u*)(zq + 8); } \
        if (w == 0) { d0 = (l0_ + lane) < LSEQ ? DT[(rbase + l0_ + lane) * 16 + h] : 0.f; d1 = (l0_ + lane + 64) < LSEQ ? DT[(rbase + l0_ + lane + 64) * 16 + h] : 0.f; } } while (0)
#define SSD_PREFETCH(L0) do { SSD_PREFETCH_A(L0); SSD_PREFETCH_B(L0); } while (0)
    SSD_PREFETCH(0);
    for (int l0 = 0; l0 < LSEQ; l0 += 128) {
        const int nvalid = (LSEQ - l0) < 128 ? (LSEQ - l0) : 128;
        int fr = fr0, fq = fq0; asm volatile("" : "+v"(fr), "+v"(fq));
#pragma unroll
        for (int i = 0; i < 2; ++i) *(LAS v4u*)(lds + SO_X + (xr_ + 64 * i) * RSX + xp_ * 16) = pf[i];
#pragma unroll
        for (int i = 0; i < 4; ++i) { *(LAS v4u*)(lds + SO_B + (br_ + 32 * i) * RSB + bp_ * 16) = pf[2 + i]; *(LAS v4u*)(lds + SO_C + (br_ + 32 * i) * RSB + bp_ * 16) = pf[6 + i]; }
        const v4u z0 = zp[0], z1 = zp[1];
        if (w == 0) {
            float a0 = Ah * d0, a1 = Ah * d1;
#pragma unroll
            for (int o = 1; o < 64; o <<= 1) { const float v0 = __shfl_up(a0, o), v1 = __shfl_up(a1, o); if (lane >= o) { a0 += v0; a1 += v1; } }
            a1 += __shfl(a0, 63);
            const float aend = __shfl(a1, 63);
            acs[lane] = a0; acs[lane + 64] = a1; dtv[lane] = d0; dtv[lane + 64] = d1;
            wv[lane] = __expf(aend - a0) * d0; wv[lane + 64] = __expf(aend - a1) * d1; eacs[lane] = __expf(a0); eacs[lane + 64] = __expf(a1);
            if (lane == 0) acs[512] = aend;
        }
        __syncthreads();
        if (l0 + 128 < LSEQ) SSD_PREFETCH_A(l0 + 128);
        {
            const int p = w < 4 ? w : 7 - w, R1 = p, R2 = 7 - p, nsl = w < 4 ? 4 : 5;
            int srow[5], sst[5];
#pragma unroll
            for (int i = 0; i < 5; ++i) { if (w < 4) { srow[i] = i <= p ? R1 : R2; sst[i] = i <= p ? i : i - p - 1; } else { srow[i] = R2; sst[i] = 3 - p + i; } }
            f32x4 gacc[5];
#pragma unroll
            for (int i = 0; i < 5; ++i) gacc[i] = (f32x4){0.f, 0.f, 0.f, 0.f};
#pragma unroll
            for (int k0 = 0; k0 < 128; k0 += 32) {
                const bf16x8 c1 = *(const LAS bf16x8*)(lds + SO_C + (16 * R1 + fr) * RSB + (k0 + 8 * fq) * 2), c2 = *(const LAS bf16x8*)(lds + SO_C + (16 * R2 + fr) * RSB + (k0 + 8 * fq) * 2);
                bf16x8 bfv[5];
#pragma unroll
                for (int i = 0; i < 5; ++i) bfv[i] = *(const LAS bf16x8*)(lds + SO_B + (16 * (i < nsl ? sst[i] : 0) + fr) * RSB + (k0 + 8 * fq) * 2);
#pragma unroll
                for (int i = 0; i < 5; ++i) gacc[i] = mfma16(bfv[i], (w < 4 && i <= p) ? c1 : c2, gacc[i]);
            }
#pragma unroll
            for (int i = 0; i < 5; ++i) if (i < nsl) {
                const int l = 16 * srow[i] + fr, s0 = 16 * sst[i] + 4 * fq; const float al = acs[l];
                const f32x4 as = *(const LAS f32x4*)(acs + s0), ds = *(const LAS f32x4*)(dtv + s0);
                float m[4];
#pragma unroll
                for (int j = 0; j < 4; ++j) m[j] = (s0 + j <= l) ? gacc[i][j] * __expf(al - as[j]) * ds[j] : 0.f;
                v2u mv; mv.x = pk2(m[0], m[1]); mv.y = pk2(m[2], m[3]);
                *(LAS v2u*)(lds + SO_M + l * RSB + s0 * 2) = mv;
            }
            { const int Rz = (w < 4) ? R1 : R2; if ((Rz & 1) == 0) *(LAS v2u*)(lds + SO_M + (16 * Rz + fr) * RSB + (16 * (Rz + 1) + 4 * fq) * 2) = (v2u){0u, 0u}; }
        }
        __syncthreads();
        if (l0 + 128 < LSEQ) SSD_PREFETCH_B(l0 + 128);
        {
            f32x4 y[4];
#pragma unroll
            for (int pt = 0; pt < 4; ++pt) y[pt] = (f32x4){0.f, 0.f, 0.f, 0.f};
#pragma unroll
            for (int k0 = 0; k0 < 128; k0 += 32) {
                const bf16x8 cf = *(const LAS bf16x8*)(lds + SO_C + (16 * w + fr) * RSB + (k0 + 8 * fq) * 2);
                bf16x8 sfv[4];
#pragma unroll
                for (int pt = 0; pt < 4; ++pt) sfv[pt] = *(const LAS bf16x8*)(lds + SO_S + (16 * pt + fr) * RSB + (k0 + 8 * fq) * 2);
#pragma unroll
                for (int pt = 0; pt < 4; ++pt) y[pt] = mfma16(cf, sfv[pt], y[pt]);
                __builtin_amdgcn_sched_barrier(0);
            }
            const f32x4 ea = *(const LAS f32x4*)(eacs + 16 * w + 4 * fq);
#pragma unroll
            for (int pt = 0; pt < 4; ++pt) y[pt] *= ea;
            for (int k0 = 0; k0 <= 16 * w + 15; k0 += 32) {
                const bf16x8 mf = *(const LAS bf16x8*)(lds + SO_M + (16 * w + fr) * RSB + (k0 + 8 * fq) * 2);
                const unsigned xa = (unsigned)(size_t)(lds + SO_X) + (unsigned)((k0 + 8 * fq + (fr >> 2)) * RSX + (fr & 3) * 8);
                bf16x8 x0, x1, x2, x3; TR4(576, x0, x1, x2, x3, xa);
                y[0] = mfma16(mf, x0, y[0]); y[1] = mfma16(mf, x1, y[1]); y[2] = mfma16(mf, x2, y[2]); y[3] = mfma16(mf, x3, y[3]);
                __builtin_amdgcn_sched_barrier(0);
            }
#pragma unroll
            for (int pt = 0; pt < 4; ++pt)
#pragma unroll
                for (int r = 0; r < 4; ++r) *(LAS float*)(lds + SO_M + (16 * w + 4 * fq + r) * RSB + (16 * pt + fr) * 4) = y[pt][r];
        }
        {
            const float dec = __expf(acs[512]);
#pragma unroll
            for (int i = 0; i < 4; ++i) sacc[i] *= dec;
#pragma unroll
            for (int k0 = 0; k0 < 128; k0 += 32) {
                const unsigned xa = (unsigned)(size_t)(lds + SO_X) + (unsigned)((k0 + 8 * fq + (fr >> 2)) * RSX + pt_s * 32 + (fr & 3) * 8);
                bf16x8 xf; TR1(576, xf, xa);
                const f32x4 w0 = *(const LAS f32x4*)(wv + k0 + 8 * fq), w1 = *(const LAS f32x4*)(wv + k0 + 8 * fq + 4);
                float xv[8]; unpack8(__builtin_bit_cast(v4u, xf), xv);
                v4u xs; xs.x = pk2(xv[0] * w0[0], xv[1] * w0[1]); xs.y = pk2(xv[2] * w0[2], xv[3] * w0[3]); xs.z = pk2(xv[4] * w1[0], xv[5] * w1[1]); xs.w = pk2(xv[6] * w1[2], xv[7] * w1[3]);
                const bf16x8 xw = __builtin_bit_cast(bf16x8, xs);
                const unsigned ba = (unsigned)(size_t)(lds + SO_B) + (unsigned)((k0 + 8 * fq + (fr >> 2)) * RSB + nh * 128 + (fr & 3) * 8);
                bf16x8 b0, b1, b2, b3; TR4(1088, b0, b1, b2, b3, ba);
                sacc[0] = mfma16(xw, b0, sacc[0]); sacc[1] = mfma16(xw, b1, sacc[1]); sacc[2] = mfma16(xw, b2, sacc[2]); sacc[3] = mfma16(xw, b3, sacc[3]);
                __builtin_amdgcn_sched_barrier(0);
            }
        }
        __syncthreads();
#pragma unroll
        for (int i = 0; i < 4; ++i)
#pragma unroll
            for (int r = 0; r < 4; ++r) *(LAS bf16*)(lds + SO_S + (16 * pt_s + 4 * fq + r) * RSB + (16 * (4 * nh + i) + fr) * 2) = (bf16)f2bf(sacc[i][r]);
        if (ft < nvalid) {
            const size_t row = rbase + l0 + ft;
            bf16* zq = PROJ + row * LDP + C_Z + h * 64 + 16 * q4;
            const v4u x0 = *(const LAS v4u*)(lds + SO_X + ft * RSX + q4 * 32), x1 = *(const LAS v4u*)(lds + SO_X + ft * RSX + q4 * 32 + 16);
            float zf[16], xf[16], yo[16];
            { float tmp[8]; unpack8(z0, tmp);
#pragma unroll
              for (int j = 0; j < 8; ++j) zf[j] = tmp[j];
              unpack8(z1, tmp);
#pragma unroll
              for (int j = 0; j < 8; ++j) zf[8 + j] = tmp[j];
              unpack8(x0, tmp);
#pragma unroll
              for (int j = 0; j < 8; ++j) xf[j] = tmp[j];
              unpack8(x1, tmp);
#pragma unroll
              for (int j = 0; j < 8; ++j) xf[8 + j] = tmp[j]; }
            float sq = 0.f;
#pragma unroll
            for (int j4 = 0; j4 < 4; ++j4) { const f32x4 yv = *(const LAS f32x4*)(lds + SO_M + ft * RSB + (16 * q4 + 4 * j4) * 4);
#pragma unroll
                for (int j = 0; j < 4; ++j) { const float v = (yv[j] + Dh * xf[4 * j4 + j]) * silu_f(zf[4 * j4 + j]); yo[4 * j4 + j] = v; sq += v * v; } }
            v4u o0, o1; o0.x = pk2(yo[0], yo[1]); o0.y = pk2(yo[2], yo[3]); o0.z = pk2(yo[4], yo[5]); o0.w = pk2(yo[6], yo[7]);
            o1.x = pk2(yo[8], yo[9]); o1.y = pk2(yo[10], yo[11]); o1.z = pk2(yo[12], yo[13]); o1.w = pk2(yo[14], yo[15]);
            *(v4u*)zq = o0; *(v4u*)(zq + 8) = o1;
            sq += __shfl_xor(sq, 1); sq += __shfl_xor(sq, 2);
            if (q4 == 0) SSDSQ[row * 16 + h] = sq;
        }
        __syncthreads();
    }
#undef SSD_PREFETCH
#undef SSD_PREFETCH_A
#undef SSD_PREFETCH_B
}
constexpr int LO_XB = 0, LO_XF = LO_XB + 128 * RSX, LO_A = LO_XF + 128 * 260, LO_U = LO_A + 128 * 260, LO_WA = LO_U + 128 * 260, LO_WX = LO_WA + 64 * RSX, LO_SC = LO_WX + 64 * RSX;
static_assert(LO_SC + 17 * 256 <= LDS_BYTES - 256, "lru lds");
__device__ __forceinline__ void lru_item3(const Args& a, LAS unsigned char* lds, int b, int h) {
    const int tid = threadIdx.x, lane0 = tid & 63, w = __builtin_amdgcn_readfirstlane(tid >> 6), fr0 = lane0 & 15, fq0 = lane0 >> 4;
    bf16* PROJ = (bf16*)(a.ws + WS_PROJ);
    const size_t rbase = (size_t)b * LSEQ;
    LAS float* segP = (LAS float*)(lds + LO_SC); LAS float* segH = segP + 512; LAS float* carry = segH + 512;
    __syncthreads();
    for (int i = tid; i < 4096; i += 512) { const int ii = i >> 6, j = i & 63;
        *(LAS bf16*)(lds + LO_WA + j * RSX + ii * 2) = (bf16)f2bf(-1.4426950408889634f * a.in[I_LWA][(size_t)h * 4096 + i]);
        *(LAS bf16*)(lds + LO_WX + j * RSX + ii * 2) = (bf16)f2bf(-1.4426950408889634f * a.in[I_LWX][(size_t)h * 4096 + i]); }
    if (tid < 64) carry[tid] = 0.f;
    float gba[4], gbx[4], gsp[4];
#pragma unroll
    for (int jt = 0; jt < 4; ++jt) { const int c = h * 64 + 16 * jt + fr0; gba[jt] = -1.4426950408889634f * a.in[I_LBA][c]; gbx[jt] = -1.4426950408889634f * a.in[I_LBX][c]; gsp[jt] = -8.0f * softplus_f(-a.in[I_LLAM][c]); }
    const int ft = tid >> 2, q4 = tid & 3;
    const int cg = tid & 7, rg = tid >> 3;
    v4u xp[5], gp[2];
#define LRU_PREFETCH(L0) do { const int l0_ = (L0); \
        _Pragma("unroll") for (int r = 0; r < 5; ++r) { const int l = l0_ + 2 * rg - 3 + r; xp[r] = (v4u){0u, 0u, 0u, 0u}; \
            if (l >= 0 && l < LSEQ) xp[r] = *(const v4u*)(PROJ + (rbase + l) * LDP + C_LI + h * 64 + cg * 8); } \
        gp[0] = (v4u){0u, 0u, 0u, 0u}; gp[1] = gp[0]; \
        if (l0_ + ft < LSEQ) { const bf16* gq = PROJ + (rbase + l0_ + ft) * LDP + C_G + h * 64 + 16 * q4; gp[0] = *(const v4u*)gq; gp[1] = *(const v4u*)(gq + 8); } } while (0)
    LRU_PREFETCH(0);
    for (int l0 = 0; l0 < LSEQ; l0 += 128) {
        const int nvalid = (LSEQ - l0) < 128 ? (LSEQ - l0) : 128;
        int fr = fr0, fq = fq0, lane = lane0; asm volatile("" : "+v"(fr), "+v"(fq), "+v"(lane));
        {
            float cw[4][8], cb[8], p[5][8];
#pragma unroll
            for (int k = 0; k < 4; ++k) { const f32x4 wa = *(const f32x4*)(a.in[I_LCW] + k * 1024 + h * 64 + cg * 8), wb = *(const f32x4*)(a.in[I_LCW] + k * 1024 + h * 64 + cg * 8 + 4);
#pragma unroll
                for (int j = 0; j < 4; ++j) { cw[k][j] = wa[j]; cw[k][4 + j] = wb[j]; } }
            { const f32x4 wa = *(const f32x4*)(a.in[I_LCB] + h * 64 + cg * 8), wb = *(const f32x4*)(a.in[I_LCB] + h * 64 + cg * 8 + 4);
#pragma unroll
              for (int j = 0; j < 4; ++j) { cb[j] = wa[j]; cb[4 + j] = wb[j]; } }
#pragma unroll
            for (int r = 0; r < 5; ++r) unpack8(xp[r], p[r]);
#pragma unroll
            for (int rr = 0; rr < 2; ++rr) { const int t = 2 * rg + rr; float o[8];
#pragma unroll
                for (int j = 0; j < 8; ++j) o[j] = cw[0][j] * p[rr][j] + cw[1][j] * p[rr + 1][j] + cw[2][j] * p[rr + 2][j] + cw[3][j] * p[rr + 3][j] + cb[j];
                v4u ov; ov.x = pk2(o[0], o[1]); ov.y = pk2(o[2], o[3]); ov.z = pk2(o[4], o[5]); ov.w = pk2(o[6], o[7]);
                *(LAS v4u*)(lds + LO_XB + t * RSX + cg * 16) = ov;
}
        }
        const v4u g0 = gp[0], g1 = gp[1];
        __syncthreads();
        if (l0 + 128 < LSEQ) LRU_PREFETCH(l0 + 128);
        {
            f32x4 ga[4], gx[4];
#pragma unroll
            for (int jt = 0; jt < 4; ++jt) { ga[jt] = (f32x4){gba[jt], gba[jt], gba[jt], gba[jt]}; gx[jt] = (f32x4){gbx[jt], gbx[jt], gbx[jt], gbx[jt]}; }
#pragma unroll
            for (int k0 = 0; k0 < 64; k0 += 32) {
                const bf16x8 xf = *(const LAS bf16x8*)(lds + LO_XB + (16 * w + fr) * RSX + (k0 + 8 * fq) * 2);
                bf16x8 wav[4], wxv[4];
#pragma unroll
                for (int jt = 0; jt < 4; ++jt) { wav[jt] = *(const LAS bf16x8*)(lds + LO_WA + (16 * jt + fr) * RSX + (k0 + 8 * fq) * 2); wxv[jt] = *(const LAS bf16x8*)(lds + LO_WX + (16 * jt + fr) * RSX + (k0 + 8 * fq) * 2); }
#pragma unroll
                for (int jt = 0; jt < 4; ++jt) { ga[jt] = mfma16(xf, wav[jt], ga[jt]); gx[jt] = mfma16(xf, wxv[jt], gx[jt]); }
            }
#pragma unroll
            for (int jt = 0; jt < 4; ++jt)
#pragma unroll
                for (int r = 0; r < 4; ++r) { const int l = 16 * w + 4 * fq + r, j = 16 * jt + fr;
                    const float rr = rcp_f(1.f + __builtin_amdgcn_exp2f(ga[jt][r])), ig = rcp_f(1.f + __builtin_amdgcn_exp2f(gx[jt][r]));
                    const float log_a = rr * gsp[jt];
                    const float av = __builtin_amdgcn_exp2f(1.4426950408889634f * log_a);
                    const float t2 = 2.f * log_a;
                    const float om = t2 > -0.1f ? -t2 * (1.f + t2 * (0.5f + t2 * (0.16666667f + t2 * 0.041666668f))) : 1.f - av * av;
                    const float mult = (l0 + l == 0) ? 1.f : __builtin_amdgcn_sqrtf(fmaxf(om, 0.f));
                    const float xv = __uint_as_float((unsigned)*(const LAS unsigned short*)(lds + LO_XB + l * RSX + j * 2) << 16);
                    *(LAS float*)(lds + LO_A + l * 260 + j * 4) = av; *(LAS float*)(lds + LO_U + l * 260 + j * 4) = mult * ig * xv; }
        }
        __syncthreads();
        {
            float P = 1.f, Hl = 0.f;
#pragma unroll
            for (int t = 0; t < 16; ++t) { const float av = *(const LAS float*)(lds + LO_A + (16 * w + t) * 260 + lane * 4), uv = *(const LAS float*)(lds + LO_U + (16 * w + t) * 260 + lane * 4); Hl = av * Hl + uv; P *= av; }
            segP[w * 64 + lane] = P; segH[w * 64 + lane] = Hl;
            __syncthreads();
            float hin = carry[lane];
            for (int s2 = 0; s2 < w; ++s2) hin = segP[s2 * 64 + lane] * hin + segH[s2 * 64 + lane];
#pragma unroll
            for (int t = 0; t < 16; ++t) { LAS float* up = (LAS float*)(lds + LO_U + (16 * w + t) * 260 + lane * 4); hin = *(const LAS float*)(lds + LO_A + (16 * w + t) * 260 + lane * 4) * hin + *up; *up = hin; }
            __syncthreads();
            if (w == 7) carry[lane] = hin;
        }
        if (ft < nvalid) {
            const size_t row = rbase + l0 + ft;
            bf16* gq = PROJ + row * LDP + C_G + h * 64 + 16 * q4;
            float gf[16], yo[16];
            { float tmp[8]; unpack8(g0, tmp);
#pragma unroll
              for (int j = 0; j < 8; ++j) gf[j] = tmp[j];
              unpack8(g1, tmp);
#pragma unroll
              for (int j = 0; j < 8; ++j) gf[8 + j] = tmp[j]; }
#pragma unroll
            for (int j = 0; j < 16; ++j) yo[j] = *(const LAS float*)(lds + LO_U + ft * 260 + (16 * q4 + j) * 4) * gelu_tanh_f(gf[j]);
            v4u o0, o1; o0.x = pk2(yo[0], yo[1]); o0.y = pk2(yo[2], yo[3]); o0.z = pk2(yo[4], yo[5]); o0.w = pk2(yo[6], yo[7]);
            o1.x = pk2(yo[8], yo[9]); o1.y = pk2(yo[10], yo[11]); o1.z = pk2(yo[12], yo[13]); o1.w = pk2(yo[14], yo[15]);
            *(v4u*)gq = o0; *(v4u*)(gq + 8) = o1;
        }
        __syncthreads();
    }
#undef LRU_PREFETCH
}
__device__ __forceinline__ void ph_mixers3(const Args& a, LAS unsigned char* lds, int wk, int nwk) {
    for (int it = wk; it < 256; it += nwk) if (it < 128) ssd_item3(a, lds, it >> 4, it & 15);
    for (int it = wk; it < 256; it += nwk) if (it >= 128) lru_item3(a, lds, (it - 128) >> 4, (it - 128) & 15);
    {
        const int wave = __builtin_amdgcn_readfirstlane((int)threadIdx.x >> 6), lane = (int)threadIdx.x & 63;
        __syncthreads();
        (void)wave; (void)lane;
        convert_experts_dyn(a, 0, lds, (unsigned*)(a.ws + WS_CTL) + 32);
    }
}

constexpr int RW_STRIDE = 2064;
__device__ __forceinline__ void ph_router(const Args& a, LAS unsigned char* lds, int L, int wk, int nwk) {
    const int tid = threadIdx.x, lane = tid & 63, wave = __builtin_amdgcn_readfirstlane(tid >> 6), fr = lane & 15, fq = lane >> 4;
    const int gw = wk * NWAVES + wave, NGW = nwk * NWAVES;
    LAS unsigned char* wl = lds;
    LAS float* sc = (LAS float*)(lds + 99328) + wave * 768;
    LAS int* lcnt = (LAS int*)(lds + 123904); LAS int* gbase = lcnt + 32; LAS int* rinfo = lcnt + 64;
    const v4u* WRT = (const v4u*)(a.ws + WS_WRT) + (size_t)L * 6144;
    __syncthreads();
    for (int i = tid; i < 6144; i += 512) *(LAS v4u*)(wl + (i >> 7) * RW_STRIDE + (i & 127) * 16) = WRT[i];
    if (tid < 32) lcnt[tid] = 0;
    __syncthreads();
    const bf16* HBr = L ? (const bf16*)(a.ws + WS_SB) : (const bf16*)a.out;
    float* RSTD1 = (float*)(a.ws + WS_RSTD1); float* GATES = (float*)(a.ws + WS_GATES); int* LIST = (int*)(a.ws + WS_LIST);
    unsigned* cnt = (unsigned*)(a.ws + WS_CTL) + CW_CNT + 1024 * L;
    const float* bg = a.in[I_RGB] + L * 4; const float* be = a.in[I_REB] + L * 16;
    int it = 0;
    for (int u = gw; u < T / 16; u += NGW, ++it) {
        const int r0 = u * 16;
        const bf16* hrow = HBr + (size_t)(r0 + fr) * D + 8 * fq;
        f32x4 acc[3]; float ss = 0.f;
#pragma unroll
        for (int t = 0; t < 3; ++t) acc[t] = (f32x4){0.f, 0.f, 0.f, 0.f};
#pragma unroll 4
        for (int k0 = 0; k0 < 1024; k0 += 32) {
            const v4u hv = *(const v4u*)(hrow + k0);
            f32x4 h0v, h1v; unpack8v(hv, h0v, h1v);
            ss += (h0v[0] * h0v[0] + h0v[1] * h0v[1] + h0v[2] * h0v[2] + h0v[3] * h0v[3]) + (h1v[0] * h1v[0] + h1v[1] * h1v[1] + h1v[2] * h1v[2] + h1v[3] * h1v[3]);
            const bf16x8 hf = __builtin_bit_cast(bf16x8, hv);
#pragma unroll
            for (int t = 0; t < 3; ++t) { const bf16x8 wf = *(const LAS bf16x8*)(wl + (16 * t + fr) * RW_STRIDE + (k0 + 8 * fq) * 2); acc[t] = mfma16(wf, hf, acc[t]); }
        }
        ss += __shfl_xor(ss, 16); ss += __shfl_xor(ss, 32);
        const float rstd = rsqrtf(ss * (1.f / D) + EPS);
#pragma unroll
        for (int t = 0; t < 3; ++t)
#pragma unroll
            for (int r = 0; r < 4; ++r) sc[fr * 48 + 16 * t + 4 * fq + r] = acc[t][r];
        LDS_WAIT();
        if (lane < 16) {
            const int row = r0 + lane;
            float lg[20];
#pragma unroll
            for (int j = 0; j < 20; ++j) lg[j] = (sc[lane * 48 + j] + sc[lane * 48 + 20 + j]) * rstd + (j < 4 ? bg[j] : be[j - 4]);
            int gs = 0; float gm = lg[0];
#pragma unroll
            for (int j = 1; j < 4; ++j) if (lg[j] > gm) { gm = lg[j]; gs = j; }
            const float pg = 1.f / (__expf(lg[0] - gm) + __expf(lg[1] - gm) + __expf(lg[2] - gm) + __expf(lg[3] - gm));
            float f[4];
#pragma unroll
            for (int i = 0; i < 4; ++i) f[i] = gs == 0 ? lg[4 + i] : (gs == 1 ? lg[8 + i] : (gs == 2 ? lg[12 + i] : lg[16 + i]));
            int i0 = 0; float m0 = f[0];
#pragma unroll
            for (int i = 1; i < 4; ++i) if (f[i] > m0) { m0 = f[i]; i0 = i; }
            int i1 = -1; float m1 = -3.0e38f;
#pragma unroll
            for (int i = 0; i < 4; ++i) if (i != i0 && f[i] > m1) { m1 = f[i]; i1 = i; }
            const float w0 = 1.f / (1.f + __expf(m1 - m0)), w1 = 1.f - w0;
            const int lo = i0 < i1 ? i0 : i1, hi = i0 < i1 ? i1 : i0;
            const float glo = pg * (i0 < i1 ? w0 : w1), ghi = pg * (i0 < i1 ? w1 : w0);
            const int pair = lo == 0 ? hi - 1 : (lo == 1 ? hi + 1 : 5);
            const int bk = gs * 6 + pair;
            const int ls = __hip_atomic_fetch_add(lcnt + bk, 1, __ATOMIC_RELAXED, __HIP_MEMORY_SCOPE_WORKGROUP);
            rinfo[(it * NWAVES + wave) * 16 + lane] = bk | (ls << 8);
            RSTD1[row] = rstd; GATES[(size_t)row * 2] = glo; GATES[(size_t)row * 2 + 1] = ghi;
        }
        LDS_WAIT();
    }
    __syncthreads();
    if (tid < NBK) gbase[tid] = (int)atomicAdd(cnt + 32 * tid, (unsigned)lcnt[tid]);
    __syncthreads();
    it = 0;
    for (int u = gw; u < T / 16; u += NGW, ++it)
        if (lane < 16) { const int info = rinfo[(it * NWAVES + wave) * 16 + lane], bk = info & 255; LIST[(size_t)bk * T + gbase[bk] + (info >> 8)] = u * 16 + lane; }
}

struct BkTab { int cnt[NBK], off[NBK], ust[NBK + 1]; };
__device__ __forceinline__ void bk_table(const Args& a, LAS unsigned char* lds, int L, int per_tile  ) {
    LAS int* tb = (LAS int*)lds;
    __syncthreads();
    if (threadIdx.x == 0) {
        const unsigned* cnt = (const unsigned*)(a.ws + WS_CTL) + CW_CNT + 1024 * L;
        int off = 0, us = 0;
        for (int i = 0; i < NBK; ++i) { const int c = (int)__hip_atomic_load(cnt + 32 * i, __ATOMIC_RELAXED, __HIP_MEMORY_SCOPE_AGENT);
            tb[i] = c; tb[NBK + i] = off; tb[2 * NBK + i] = us; off += (c + 255) & ~255; us += ((c + 63) >> 6) * per_tile; }
        tb[2 * NBK + NBK] = us;
    }
    __syncthreads();
}
__device__ __forceinline__ void bk_experts(int bk, int& elo, int& ehi) {
    const int g = bk / 6, pr = bk - g * 6;
    const int lo = pr < 3 ? 0 : (pr < 5 ? 1 : 2), hi = pr < 3 ? pr + 1 : (pr < 5 ? pr - 1 : 3);
    elo = g * 4 + lo; ehi = g * 4 + hi;
}
__device__ __forceinline__ void ph_moe_up(const Args& a, LAS unsigned char* lds, int L, int wk, int nwk) {
    const int tid = threadIdx.x, lane = tid & 63, wave = __builtin_amdgcn_readfirstlane(tid >> 6), fr = lane & 15, fq = lane >> 4;
    const int gw = wk * NWAVES + wave, NGW = nwk * NWAVES;
    bk_table(a, lds, L, 32);
    LAS int* tb = (LAS int*)lds;
    const bf16* HB = (const bf16*)a.out; const bf16* WGU = (const bf16*)(a.ws + WS_WGU); bf16* HID = (bf16*)(a.ws + WS_HID);
    const int* LIST = (const int*)(a.ws + WS_LIST); const float* RSTD1 = (const float*)(a.ws + WS_RSTD1); const float* GATES = (const float*)(a.ws + WS_GATES);
    const int nun = tb[2 * NBK + NBK];
    for (int u = gw; u < nun; u += NGW) {
        int bk = 0;
        for (int i = 1; i < NBK; ++i) if (u >= tb[2 * NBK + i]) bk = i;
        const int cnt = tb[bk], off = tb[NBK + bk], r = u - tb[2 * NBK + bk];
        const int rt = r >> 5, ek = (r >> 4) & 1, ct = r & 15;
        int elo, ehi; bk_experts(bk, elo, ehi); const int e = ek ? ehi : elo;
        const int c0 = ct * 32, brow = e * 1024 + (c0 >> 7) * 256 + (c0 & 127);
        const bf16* arow[4]; int tok[4];
#pragma unroll
        for (int mi = 0; mi < 4; ++mi) { int rr = rt * 64 + 16 * mi + fr; if (rr >= cnt) rr = cnt - 1; tok[mi] = LIST[(size_t)bk * T + rr]; arow[mi] = HB + (size_t)tok[mi] * D; }
        f32x4 acc[4][4]; zero_acc(acc);
        sg_kloop<4>(1024, arow, [=](int n, int k0) { return WGU + (size_t)(brow + (n < 32 ? n : n + 96)) * 1024 + k0; }, NoKS(), acc, fr, fq);
#pragma unroll
        for (int mi = 0; mi < 4; ++mi) { const int rr = rt * 64 + 16 * mi + fr;
            if (rr < cnt) { const float rs = RSTD1[tok[mi]], gt = GATES[(size_t)tok[mi] * 2 + ek];
#pragma unroll
                for (int nj = 0; nj < 2; ++nj) { const f32x4 gv = acc[mi][nj] * rs, uv = acc[mi][nj + 2] * rs; f32x4 hv;
                    hv.x = silu_f(gv.x) * uv.x * gt; hv.y = silu_f(gv.y) * uv.y * gt; hv.z = silu_f(gv.z) * uv.z * gt; hv.w = silu_f(gv.w) * uv.w * gt;
                    v2u w; w.x = pk2(hv.x, hv.y); w.y = pk2(hv.z, hv.w);
                    *(v2u*)(HID + (size_t)(off + rr) * 1024 + ek * 512 + c0 + 16 * nj + 4 * fq) = w; } } }
    }
}
__device__ __forceinline__ void ph_moe_down(const Args& a, LAS unsigned char* lds, int L, int wk, int nwk) {
    const int tid = threadIdx.x, lane = tid & 63, wave = __builtin_amdgcn_readfirstlane(tid >> 6), fr = lane & 15, fq = lane >> 4;
    const int gw = wk * NWAVES + wave, NGW = nwk * NWAVES;
    bk_table(a, lds, L, 16);
    LAS int* tb = (LAS int*)lds;
    const bf16* HID = (const bf16*)(a.ws + WS_HID); const bf16* WD = (const bf16*)(a.ws + WS_WD);
    float* H = (float*)(a.ws + WS_H); bf16* HB = (bf16*)a.out; const int* LIST = (const int*)(a.ws + WS_LIST);
    const int nun = tb[2 * NBK + NBK];
    for (int u = gw; u < nun; u += NGW) {
        int bk = 0;
        for (int i = 1; i < NBK; ++i) if (u >= tb[2 * NBK + i]) bk = i;
        const int cnt = tb[bk], off = tb[NBK + bk], r = u - tb[2 * NBK + bk];
        const int rt = r >> 4, ct = r & 15;
        int elo, ehi; bk_experts(bk, elo, ehi);
        const bf16* arow[4];
#pragma unroll
        for (int mi = 0; mi < 4; ++mi) arow[mi] = HID + (size_t)(off + rt * 64 + 16 * mi + fr) * 1024;
        f32x4 acc[4][4]; zero_acc(acc);
        sg_kloop<4>(1024, arow, [=](int n, int k0) { return WD + ((size_t)((k0 < 512 ? elo : ehi) * 1024 + ct * 64 + n)) * 512 + (k0 & 511); }, NoKS(), acc, fr, fq);
#pragma unroll
        for (int mi = 0; mi < 4; ++mi) { const int rr = rt * 64 + 16 * mi + fr;
            if (rr < cnt) { const int tok = LIST[(size_t)bk * T + rr];
#pragma unroll
                for (int nj = 0; nj < 4; ++nj) { const int c = ct * 64 + 16 * nj + 4 * fq; float* hp = H + (size_t)tok * D + c;
                    const f32x4 v = *(const f32x4*)hp + acc[mi][nj]; *(f32x4*)hp = v;
                    v2u w; w.x = pk2(v.x, v.y); w.y = pk2(v.z, v.w); *(v2u*)(HB + (size_t)tok * D + c) = w; } } }
    }
}


__device__ __forceinline__ void hb_store4(bf16* HB, int row, int col, const f32x4 v) {
    v2u w; w.x = pg8::cvt_pk_bf16(v[0], v[1]); w.y = pg8::cvt_pk_bf16(v[2], v[3]); *(v2u*)(HB + (size_t)row * D + col) = w;
}
__device__ __forceinline__ void hb_store8(bf16* HB, int row, int col, const f32x4 v0, const f32x4 v1) {
    v4u w; w.x = pg8::cvt_pk_bf16(v0[0], v0[1]); w.y = pg8::cvt_pk_bf16(v0[2], v0[3]); w.z = pg8::cvt_pk_bf16(v1[0], v1[1]); w.w = pg8::cvt_pk_bf16(v1[2], v1[3]);
    *(v4u*)(HB + (size_t)row * D + col) = w;
}

struct PGemm2 {
    static constexpr bool PERM = true;
    struct EpiRegs {};
    template <class U_> __device__ __forceinline__ void epi_pre(const U_&, EpiRegs&, int, int, int, int) const {}
    struct Unit { int pm, pn, ui; };
    const Args* ap; const char* A; const char* B; bf16* HB; int G, c; int ldb, nt;
    __device__ __forceinline__ bool next(int i, Unit& u) const { u.ui = i; return pg8::static_order(64, 4, G, c, i, u.pm, u.pn); }
    __device__ __forceinline__ void avoff(const Unit& u, const int (&RA)[2], const int (&CA)[2], unsigned (&v)[4]) const {
#pragma unroll
        for (int h = 0; h < 2; ++h)
#pragma unroll
            for (int i = 0; i < 2; ++i) { const int row = u.pm * 256 + h * 128 + RA[i]; v[h * 2 + i] = (unsigned)(row * LDP + CA[i]) * 2u; }
    }
    __device__ __forceinline__ const char* abase(const Unit&) const { return A; }
    __device__ __forceinline__ const char* btile(const Unit& u, int t) const { return B + ((size_t)u.pn * 256 * 2048 + (size_t)t * 64) * 2; }
    __device__ __forceinline__ void a_ready(const Unit&) const {}
    __device__ __forceinline__ void done(const Unit&) const {}
    __device__ __forceinline__ void khook(int t, pg8::Acc& acc, const Unit& u, LAS unsigned char* lds, int wr, int wc, int fr, int fq) const {
        if (t == 8 || t == 16) {
            const LAS float* ft = (const LAS float*)(lds + LDS_TAB) + u.ui * 512 + (t == 16 ? 1 : 0);
#pragma unroll
            for (int ai = 0; ai < 2; ++ai)
#pragma unroll
                for (int m = 0; m < 4; ++m) { const float f = ft[(ai * 128 + wr * 64 + m * 16 + fr) * 2];
#pragma unroll
                    for (int bj = 0; bj < 2; ++bj)
#pragma unroll
                        for (int n = 0; n < 2; ++n) acc[ai][bj][m][n] *= f; }
        }
    }
    __device__ __forceinline__ void epi(const pg8::Acc& acc, const Unit& u, const EpiRegs&, int wr, int wc, int fr, int fq) const {
        const int row0 = u.pm * 256 + wr * 64 + fr, col0 = u.pn * 256 + wc * 32 + 8 * fq;
#pragma unroll
        for (int hf = 0; hf < 2; ++hf) {
            v4u res[4][2];
#pragma unroll
            for (int g4 = 0; g4 < 4; ++g4)
#pragma unroll
                for (int bj = 0; bj < 2; ++bj) res[g4][bj] = *(const v4u*)(HB + (size_t)(row0 + hf * 128 + g4 * 16) * D + col0 + bj * 128);
#pragma unroll
            for (int g4 = 0; g4 < 4; ++g4)
#pragma unroll
                for (int bj = 0; bj < 2; ++bj) { f32x4 h0v, h1v; unpack8v(res[g4][bj], h0v, h1v); hb_store8(HB, row0 + hf * 128 + g4 * 16, col0 + bj * 128, acc[hf][bj][g4][0] + h0v, acc[hf][bj][g4][1] + h1v); }
        }
    }
};
__device__ __forceinline__ void ssd_factors(const float* SSDSQ, int row, float& f0, float& f1) {
    const f32x4* sq = (const f32x4*)(SSDSQ + (size_t)row * 16); const f32x4 q0 = sq[0], q1 = sq[1], q2 = sq[2], q3 = sq[3];
    const float s0 = (q0.x + q0.y + q0.z + q0.w) + (q1.x + q1.y + q1.z + q1.w), s1 = (q2.x + q2.y + q2.z + q2.w) + (q3.x + q3.y + q3.z + q3.w);
    const float r0 = rsqrtf(s0 * (1.f / 512.f) + EPS), r1 = rsqrtf(s1 * (1.f / 512.f) + EPS);
    f0 = r0 / r1; f1 = r1;
}
__device__ __forceinline__ void ph_gemm2_pg8(const Args& a, LAS unsigned char* lds, int wk, int G) {
    const int tid = threadIdx.x, lane = tid & 63, wave = __builtin_amdgcn_readfirstlane(tid >> 6), fr = lane & 15, fq = lane >> 4;
    const float* SSDSQ = (const float*)(a.ws + WS_SSDSQ);
    PGemm2 S; S.ap = &a; S.A = (const char*)(a.ws + WS_PROJ); S.B = (const char*)(a.ws + WS_WOUT); S.HB = (bf16*)a.out;
    S.G = G; S.c = (int)blockIdx.x; S.ldb = 2048; S.nt = 32;
    {
        LAS float* ft = (LAS float*)(lds + LDS_TAB);
        PGemm2::Unit u;
        for (int i = 0; i < 4 && S.next(i, u); ++i)
            if (tid < 256) { float f0, f1; ssd_factors(SSDSQ, u.pm * 256 + tid, f0, f1); ft[i * 512 + tid * 2] = f0; ft[i * 512 + tid * 2 + 1] = f1; }
        __syncthreads();
    }
    pg8::gemm_phase<PGemm2, true>(lds, S);
    const bf16* PROJ = (const bf16*)(a.ws + WS_PROJ); const bf16* WOUT = (const bf16*)(a.ws + WS_WOUT);
    for (int piece = wk; piece < 256; piece += G) {
        const int rb = piece >> 5, cb = piece & 31, kb = wave * 256, row = 16384 + rb * 16 + fr;
        const bf16* ar = PROJ + (size_t)row * LDP + kb + 8 * fq;
        const bf16* br = WOUT + (size_t)(cb * 32 + fr) * 2048 + kb + 8 * fq;
        f32x4 acc0 = (f32x4){0.f, 0.f, 0.f, 0.f}, acc1 = acc0;
        bf16x8 av[8], b0v[8], b1v[8];
#pragma unroll
        for (int ks = 0; ks < 8; ++ks) { av[ks] = *(const bf16x8*)(ar + 32 * ks); b0v[ks] = *(const bf16x8*)(br + 32 * ks); b1v[ks] = *(const bf16x8*)(br + 16 * 2048 + 32 * ks); }
#pragma unroll
        for (int ks = 0; ks < 8; ++ks) { acc0 = mfma16(b0v[ks], av[ks], acc0); acc1 = mfma16(b1v[ks], av[ks], acc1); }
        float f0, f1; ssd_factors(SSDSQ, row, f0, f1);
        const float sc = wave < 2 ? f0 * f1 : (wave < 4 ? f1 : 1.f);
        LAS float* part = (LAS float*)lds + wave * 512;
        __syncthreads();
        *(LAS f32x4*)(part + fr * 32 + 4 * fq) = acc0 * sc; *(LAS f32x4*)(part + fr * 32 + 16 + 4 * fq) = acc1 * sc;
        __syncthreads();
        if (tid < 128) { const int r = tid >> 3, c4 = (tid & 7) * 4; f32x4 sv = *(const LAS f32x4*)((LAS float*)lds + r * 32 + c4);
#pragma unroll
            for (int w2 = 1; w2 < 8; ++w2) sv += *(const LAS f32x4*)((LAS float*)lds + w2 * 512 + r * 32 + c4);
            const int orow = 16384 + rb * 16 + r, col = cb * 32 + c4;
            const v2u hq = *(const v2u*)(S.HB + (size_t)orow * D + col); f32x4 hv; hv[0] = __uint_as_float(hq.x << 16); hv[1] = __uint_as_float(hq.x & 0xffff0000u); hv[2] = __uint_as_float(hq.y << 16); hv[3] = __uint_as_float(hq.y & 0xffff0000u);
            hb_store4(S.HB, orow, col, sv + hv); }
        __syncthreads();
    }
}

struct BkInfo { int bk, rt, cnt, off; };
__device__ __forceinline__ void bk_table256(const Args& a, LAS unsigned char* lds, int L) {
    LAS int* tb = (LAS int*)(lds + LDS_TAB);
    __syncthreads();
    if (threadIdx.x == 0) {
        const unsigned* cnt = (const unsigned*)(a.ws + WS_CTL) + CW_CNT + 1024 * L;
        int off = 0, rts = 0;
        for (int i = 0; i < NBK; ++i) { const int c = (int)__hip_atomic_load(cnt + 32 * i, __ATOMIC_RELAXED, __HIP_MEMORY_SCOPE_AGENT);
            tb[i] = c; tb[NBK + i] = off; tb[2 * NBK + i] = rts; off += (c + 255) & ~255; rts += (c + 255) >> 8; }
        tb[2 * NBK + NBK] = rts;
    }
    __syncthreads();
}
__device__ __forceinline__ bool bk_find(const LAS int* tb, int rti, BkInfo& o) {
    if (rti >= tb[2 * NBK + NBK]) return false;
    int bk = 0;
    for (int i = 1; i < NBK; ++i) if (rti >= tb[2 * NBK + i]) bk = i;
    o.bk = __builtin_amdgcn_readfirstlane(bk); o.rt = __builtin_amdgcn_readfirstlane(rti - tb[2 * NBK + bk]); o.cnt = __builtin_amdgcn_readfirstlane(tb[bk]); o.off = __builtin_amdgcn_readfirstlane(tb[NBK + bk]); return true;
}
struct PMoeUp {
    static constexpr bool PERM = true;
    struct EpiRegs {};
    template <class U_> __device__ __forceinline__ void epi_pre(const U_&, EpiRegs&, int, int, int, int) const {}
    struct Unit { int bk, rt, cnt, off, e, ek, pnl, ui, rti; };
    const char* A; const char* B; bf16* HID; const float* rstd; const float* gates; const LAS int* tb; const LAS int* rowtab; const LAS float* rgtab; unsigned* ctr; int G, c; int ldb, nt;
    __device__ __forceinline__ bool next(int i, Unit& u) const {
        const int Lu = i * G + c; BkInfo o; if (!bk_find(tb, Lu >> 3, o)) return false;
        u.bk = o.bk; u.rt = o.rt; u.cnt = o.cnt; u.off = o.off; u.ek = (Lu >> 2) & 1; u.pnl = Lu & 3; u.ui = i; u.rti = Lu >> 3;
        int elo, ehi; bk_experts(o.bk, elo, ehi); u.e = u.ek ? ehi : elo; return true;
    }
    __device__ __forceinline__ void avoff(const Unit& u, const int (&RA)[2], const int (&CA)[2], unsigned (&v)[4]) const {
#pragma unroll
        for (int h = 0; h < 2; ++h)
#pragma unroll
            for (int i = 0; i < 2; ++i) { const int tok = rowtab[u.ui * 256 + h * 128 + RA[i]]; v[h * 2 + i] = (unsigned)(tok * D + CA[i]) * 2u; }
    }
    __device__ __forceinline__ const char* abase(const Unit&) const { return A; }
    __device__ __forceinline__ const char* btile(const Unit& u, int t) const { return B + ((size_t)(u.e * 1024 + u.pnl * 256) * 1024 + (size_t)t * 64) * 2; }
    __device__ __forceinline__ void khook(int, pg8::Acc&, const Unit&, LAS unsigned char*, int, int, int, int) const {}
    __device__ __forceinline__ void a_ready(const Unit&) const {}
    __device__ __forceinline__ void done(const Unit& u) const {
        asm volatile("s_waitcnt vmcnt(0)" ::: "memory");
        if ((threadIdx.x & 63) == 0) __hip_atomic_fetch_add(ctr + 32 * u.rti, 1u, __ATOMIC_RELAXED, __HIP_MEMORY_SCOPE_AGENT);
    }
    __device__ __forceinline__ void epi(const pg8::Acc& acc, const Unit& u, const EpiRegs&, int wr, int wc, int fr, int fq) const {
        const int r0 = wr * 64 + fr, col0 = u.ek * 512 + u.pnl * 128 + wc * 32 + 8 * fq;
        float rsv[2][4], gtv[2][4];
#pragma unroll
        for (int ai = 0; ai < 2; ++ai)
#pragma unroll
            for (int m = 0; m < 4; ++m) { const LAS float* rg = rgtab + (u.ui * 256 + r0 + ai * 128 + m * 16) * 2; rsv[ai][m] = rg[0]; gtv[ai][m] = rg[1]; }
#pragma unroll
        for (int ai = 0; ai < 2; ++ai)
#pragma unroll
            for (int m = 0; m < 4; ++m) { const int rr = u.rt * 256 + r0 + ai * 128 + m * 16;
                const float rs = rsv[ai][m], gt = gtv[ai][m]; float hv[8];
#pragma unroll
                for (int n = 0; n < 2; ++n)
#pragma unroll
                    for (int j = 0; j < 4; ++j) { const float g = acc[ai][0][m][n][j] * rs, uu = acc[ai][1][m][n][j] * rs; hv[n * 4 + j] = silu_f(g) * uu * gt; }
                v4u w; w.x = pg8::cvt_pk_bf16(hv[0], hv[1]); w.y = pg8::cvt_pk_bf16(hv[2], hv[3]); w.z = pg8::cvt_pk_bf16(hv[4], hv[5]); w.w = pg8::cvt_pk_bf16(hv[6], hv[7]);
                const bf16* hp = HID + (size_t)(u.off + rr) * 1024 + col0;
                asm volatile("global_store_dwordx4 %0, %1, off sc1\n\ts_nop 1" :: "v"(hp), "v"(w) : "memory"); }
    }
};
__device__ __forceinline__ void ph_moe_up_pg8(const Args& a, LAS unsigned char* lds, int L, int G) {
    bk_table256(a, lds, L);
    const LAS int* tb = (const LAS int*)(lds + LDS_TAB); LAS int* rowtab = (LAS int*)(lds + LDS_TAB + 1024); LAS float* rgtab = (LAS float*)(lds + LDS_TAB + 1024 + 6 * 1024);
    PMoeUp S; S.rgtab = rgtab; S.A = L ? (const char*)(a.ws + WS_SB) : (const char*)a.out; S.B = (const char*)(a.ws + ws_wgu(L)); S.HID = (bf16*)(a.ws + WS_HID); S.rstd = (const float*)(a.ws + WS_RSTD1); S.gates = (const float*)(a.ws + WS_GATES);
    S.tb = tb; S.rowtab = rowtab; S.G = G; S.c = (int)blockIdx.x; S.ldb = 1024; S.nt = 16; S.ctr = (unsigned*)(a.ws + WS_CTL) + CW_RT + 8192 * L;
    {   const int* LIST = (const int*)(a.ws + WS_LIST); PMoeUp::Unit u;
        for (int i = 0; i < 6 && S.next(i, u); ++i)
            if (threadIdx.x < 256) { int rr = u.rt * 256 + (int)threadIdx.x; rr = rr < u.cnt ? rr : u.cnt - 1; const int tok = LIST[(size_t)u.bk * T + rr]; rowtab[i * 256 + threadIdx.x] = tok;
                rgtab[(i * 256 + threadIdx.x) * 2] = S.rstd[tok]; rgtab[(i * 256 + threadIdx.x) * 2 + 1] = S.gates[(size_t)tok * 2 + u.ek]; }
        __syncthreads();
    }
    pg8::gemm_phase<PMoeUp, true>(lds, S);
}
struct PMoeDown {
    static constexpr bool PERM = true;
    struct EpiRegs {};
    template <class U_> __device__ __forceinline__ void epi_pre(const U_&, EpiRegs&, int, int, int, int) const {}
    struct Unit { int bk, rt, cnt, off, elo, ehi, pn, ui, rti; };
    const char* A; const char* B; bf16* HB; bf16* HBo; float* SSQ; const LAS int* tb; const LAS int* rowtab; unsigned* ctr; unsigned* err; int G, c, i0; int ldb, nt;
    __device__ __forceinline__ bool next(int i, Unit& u) const {
        const int Ld = (i0 + i) * G + c - 8 * tb[2 * NBK + NBK]; BkInfo o; if (!bk_find(tb, Ld >> 2, o)) return false;
        u.bk = o.bk; u.rt = o.rt; u.cnt = o.cnt; u.off = o.off; u.pn = Ld & 3; u.ui = i; u.rti = Ld >> 2; bk_experts(o.bk, u.elo, u.ehi); return true;
    }
    __device__ __forceinline__ void avoff(const Unit& u, const int (&RA)[2], const int (&CA)[2], unsigned (&v)[4]) const {
#pragma unroll
        for (int h = 0; h < 2; ++h)
#pragma unroll
            for (int i = 0; i < 2; ++i) { const int row = u.off + u.rt * 256 + h * 128 + RA[i]; v[h * 2 + i] = (unsigned)(row * 1024 + CA[i]) * 2u; }
    }
    __device__ __forceinline__ const char* abase(const Unit&) const { return A; }
    __device__ __forceinline__ const char* btile(const Unit& u, int t) const { return B + ((size_t)((t < 8 ? u.elo : u.ehi) * 1024 + u.pn * 256) * 512 + (size_t)(t & 7) * 64) * 2; }
    __device__ __forceinline__ void khook(int, pg8::Acc&, const Unit&, LAS unsigned char*, int, int, int, int) const {}
    __device__ __forceinline__ void a_ready(const Unit& u) const {
        if (threadIdx.x < 64) {
            unsigned spins = 0;
            while ((unsigned)__builtin_amdgcn_readfirstlane(__hip_atomic_load(ctr + 32 * u.rti, __ATOMIC_RELAXED, __HIP_MEMORY_SCOPE_AGENT)) < 64u) {
                __builtin_amdgcn_s_sleep(2);
                if (++spins > (1u << 22)) { if (threadIdx.x == 0) __hip_atomic_store(err, 1u, __ATOMIC_RELAXED, __HIP_MEMORY_SCOPE_AGENT); break; } }
            __builtin_amdgcn_fence(__ATOMIC_ACQUIRE, "agent");
            asm volatile("s_waitcnt vmcnt(0)" ::: "memory");
        }
        asm volatile("" ::: "memory"); __builtin_amdgcn_s_barrier(); asm volatile("" ::: "memory");
    }
    __device__ __forceinline__ void done(const Unit&) const {}
    __device__ __forceinline__ void epi(const pg8::Acc& acc, const Unit& u, const EpiRegs&, int wr, int wc, int fr, int fq) const {
        const int r0 = wr * 64 + fr, col0 = u.pn * 256 + wc * 32 + 8 * fq;
        int tok[8];
#pragma unroll
        for (int g8 = 0; g8 < 8; ++g8) tok[g8] = rowtab[u.ui * 256 + r0 + (g8 >> 2) * 128 + (g8 & 3) * 16];
#pragma unroll
        for (int hf = 0; hf < 2; ++hf) {
            v4u res[4][2];
#pragma unroll
            for (int g4 = 0; g4 < 4; ++g4)
#pragma unroll
                for (int bj = 0; bj < 2; ++bj) res[g4][bj] = *(const v4u*)(HB + (size_t)tok[hf * 4 + g4] * D + col0 + bj * 128);
#pragma unroll
            for (int g4 = 0; g4 < 4; ++g4) {
                const int g8 = hf * 4 + g4, ai = g8 >> 2, m = g8 & 3;
                const int rr = u.rt * 256 + r0 + ai * 128 + m * 16;
                float sq = 0.f;
#pragma unroll
                for (int bj = 0; bj < 2; ++bj) { f32x4 h0v, h1v; unpack8v(res[g4][bj], h0v, h1v);
                    const f32x4 v0 = acc[ai][bj][m][0] + h0v, v1 = acc[ai][bj][m][1] + h1v;
                    sq += (v0[0] * v0[0] + v0[1] * v0[1] + v0[2] * v0[2] + v0[3] * v0[3]) + (v1[0] * v1[0] + v1[1] * v1[1] + v1[2] * v1[2] + v1[3] * v1[3]);
                    if (rr < u.cnt) hb_store8(HBo, tok[g8], col0 + bj * 128, v0, v1); }
                sq += __shfl_xor(sq, 16); sq += __shfl_xor(sq, 32);
                if (rr < u.cnt && fq == 0) SSQ[(size_t)tok[g8] * 16 + u.pn * 4 + wc] = sq;
            }
        }
    }
};
__device__ __forceinline__ void ph_moe_down_pg8(const Args& a, LAS unsigned char* lds, int L, int G) {
    bk_table256(a, lds, L);
    const LAS int* tb = (const LAS int*)(lds + LDS_TAB); LAS int* rowtab = (LAS int*)(lds + LDS_TAB + 1024);
    PMoeDown S; S.A = (const char*)(a.ws + WS_HID); S.B = (const char*)(a.ws + ws_wd(L)); S.SSQ = (float*)(a.ws + WS_SSDSQ); S.HB = L ? (bf16*)(a.ws + WS_SB) : (bf16*)a.out; S.HBo = L ? (bf16*)(a.ws + WS_SC) : (bf16*)a.out;
    S.tb = tb; S.rowtab = rowtab; S.G = G; S.c = (int)blockIdx.x; S.ldb = 512; S.nt = 16; S.ctr = (unsigned*)(a.ws + WS_CTL) + CW_RT + 8192 * L; S.err = (unsigned*)(a.ws + WS_CTL) + 16;
    { const int nup = 8 * tb[2 * NBK + NBK]; S.i0 = nup > S.c ? (nup - S.c + G - 1) / G : 0; }
    {   const int* LIST = (const int*)(a.ws + WS_LIST); PMoeDown::Unit u;
        for (int i = 0; i < 4 && S.next(i, u); ++i)
            if (threadIdx.x < 256) { int rr = u.rt * 256 + (int)threadIdx.x; rr = rr < u.cnt ? rr : u.cnt - 1; rowtab[i * 256 + threadIdx.x] = LIST[(size_t)u.bk * T + rr]; }
        __syncthreads();
    }
    pg8::gemm_phase<PMoeDown, true>(lds, S);
    if (L == 0) {
        const int wave = __builtin_amdgcn_readfirstlane((int)threadIdx.x >> 6), lane = (int)threadIdx.x & 63;
        const int ntot = 12 * tb[2 * NBK + NBK], n_more = ntot % G;
        __syncthreads();
        (void)wave; (void)lane; (void)n_more;
        convert_experts_dyn(a, 1, lds, (unsigned*)(a.ws + WS_CTL) + 64);
    }
}
struct PPool {
    static constexpr bool PERM = true;
    struct EpiRegs {};
    template <class U_> __device__ __forceinline__ void epi_pre(const U_&, EpiRegs&, int, int, int, int) const {}
    struct Unit { int pm, pn; };
    const char* A; const char* B; bf16* HB; const float* pb; const float* ps; int G, c; int ldb, nt;
    __device__ __forceinline__ bool next(int i, Unit& u) const { return pg8::static_order(65, 4, G, c, i, u.pm, u.pn); }
    __device__ __forceinline__ void avoff(const Unit& u, const int (&RA)[2], const int (&CA)[2], unsigned (&v)[4]) const {
#pragma unroll
        for (int h = 0; h < 2; ++h)
#pragma unroll
            for (int i = 0; i < 2; ++i) { int row = u.pm * 256 + h * 128 + RA[i]; row = row < T ? row : T - 1; v[h * 2 + i] = (unsigned)(row * D + CA[i]) * 2u; }
    }
    __device__ __forceinline__ const char* abase(const Unit& u) const { return A + (size_t)u.pn * 256 * 2; }
    __device__ __forceinline__ const char* btile(const Unit& u, int t) const { return B + ((size_t)u.pn * 256 * 256 + (size_t)t * 64) * 2; }
    __device__ __forceinline__ void khook(int, pg8::Acc&, const Unit&, LAS unsigned char*, int, int, int, int) const {}
    __device__ __forceinline__ void a_ready(const Unit&) const {}
    __device__ __forceinline__ void done(const Unit&) const {}
    __device__ __forceinline__ void epi(const pg8::Acc& acc, const Unit& u, const EpiRegs&, int wr, int wc, int fr, int fq) const {
        const int row0 = u.pm * 256 + wr * 64 + fr, col0 = u.pn * 256 + wc * 32 + 8 * fq;
        v4u cur[2], nxt[2];
        { const int rc = row0 < T ? row0 : T - 1;
#pragma unroll
          for (int bj = 0; bj < 2; ++bj) cur[bj] = *(const v4u*)(HB + (size_t)rc * D + col0 + bj * 128); }
#pragma unroll
        for (int g8 = 0; g8 < 8; ++g8) {
            const int ai = g8 >> 2, m = g8 & 3, row = row0 + ai * 128 + m * 16;
            if (g8 < 7) { const int rn = row0 + ((g8 + 1) >> 2) * 128 + ((g8 + 1) & 3) * 16, rc = rn < T ? rn : T - 1;
#pragma unroll
                for (int bj = 0; bj < 2; ++bj) nxt[bj] = *(const v4u*)(HB + (size_t)rc * D + col0 + bj * 128); }
            if (row < T) {
#pragma unroll
                for (int bj = 0; bj < 2; ++bj) { const int cc = col0 + bj * 128; f32x4 h0v, h1v; unpack8v(cur[bj], h0v, h1v);
                    hb_store8(HB, row, cc, h0v + (acc[ai][bj][m][0] + *(const f32x4*)(pb + cc)) * *(const f32x4*)(ps + cc),
                                           h1v + (acc[ai][bj][m][1] + *(const f32x4*)(pb + cc + 4)) * *(const f32x4*)(ps + cc + 4)); } }
#pragma unroll
            for (int bj = 0; bj < 2; ++bj) cur[bj] = nxt[bj];
        }
    }
};
__device__ __forceinline__ void ph_poolgemm_pg8(const Args& a, LAS unsigned char* lds, int G) {
    PPool S; S.A = (const char*)(a.ws + WS_POOLED); S.B = (const char*)(a.ws + WS_WPOOL); S.HB = (bf16*)a.out; S.pb = a.in[I_PB]; S.ps = a.in[I_PS];
    S.G = G; S.c = (int)blockIdx.x; S.ldb = 256; S.nt = 4;
    pg8::gemm_phase<PPool, true>(lds, S);
}

constexpr int PF_RS_ROW = 528;
constexpr int PF_RAW = 0, PF_RS = 112 * PF_RS_ROW, PF_A = PF_RS + 512, PF_END = PF_A + 96 * PF_RS_ROW;
static_assert(PF_END <= LDS_BYTES - 256, "pool lds");
__device__ __forceinline__ void ph_pool_fused(const Args& a, LAS unsigned char* lds, int wk, int nwk) {
    const int tid = threadIdx.x, lane = tid & 63, w = __builtin_amdgcn_readfirstlane(tid >> 6), fr = lane & 15, fq = lane >> 4;
    const bf16* SA = (const bf16*)a.out; bf16* SB = (bf16*)(a.ws + WS_SB); const float* SSQ = (const float*)(a.ws + WS_SSDSQ); const bf16* WPOOL = (const bf16*)(a.ws + WS_WPOOL);
    LAS float* rs = (LAS float*)(lds + PF_RS);
    v4u rp[7]; f32x4 sq4[4];
#define POOL_PREFETCH(U) do { const int rt_ = (U) >> 2, g_ = (U) & 3, t0_ = rt_ * 96; \
        _Pragma("unroll") for (int i = 0; i < 7; ++i) { const int q = tid + 512 * i, row = q >> 5, pc = q & 31; int gr = t0_ - 16 + row; gr = gr < 0 ? 0 : gr; \
            rp[i] = *(const v4u*)(SA + (size_t)gr * D + g_ * 256 + pc * 8); } \
        if (tid < 112) { int gr = t0_ - 16 + tid; gr = gr < 0 ? 0 : gr; const f32x4* q = (const f32x4*)(SSQ + (size_t)gr * 16); sq4[0] = q[0]; sq4[1] = q[1]; sq4[2] = q[2]; sq4[3] = q[3]; } } while (0)
    if (wk < 172 * 4) POOL_PREFETCH(wk);
    for (int u = wk; u < 172 * 4; u += nwk) {
        const int rt = u >> 2, g = u & 3, t0 = rt * 96, win = 2 << g;
        const bf16* wrow = WPOOL + (size_t)(g * 256 + 32 * w + fr) * 256 + 8 * fq;
        bf16x8 bfr[8][2];
#pragma unroll
        for (int ks = 0; ks < 8; ++ks) { bfr[ks][0] = *(const bf16x8*)(wrow + 32 * ks); bfr[ks][1] = *(const bf16x8*)(wrow + 16 * 256 + 32 * ks); }
        __syncthreads();
#pragma unroll
        for (int i = 0; i < 7; ++i) { const int q = tid + 512 * i, row = q >> 5, pc = q & 31; *(LAS v4u*)(lds + PF_RAW + row * PF_RS_ROW + pc * 16) = rp[i]; }
        if (tid < 112) { const f32x4 sv = (sq4[0] + sq4[1]) + (sq4[2] + sq4[3]); rs[tid] = rsqrtf((sv[0] + sv[1] + sv[2] + sv[3]) * (1.f / D) + EPS); }
        __syncthreads();
        if (u + nwk < 172 * 4) POOL_PREFETCH(u + nwk);
        {   const int c4 = tid & 63, r0 = (tid >> 6) * 12;
            const LAS unsigned char* rawc = lds + PF_RAW + 16 * PF_RS_ROW + c4 * 8;
            int l = (t0 + r0) % LSEQ;
            f32x4 Sb = (f32x4){0.f, 0.f, 0.f, 0.f};
            for (int j = 1; j < win; ++j) if (l - j >= 0) { const v2u q = *(const LAS v2u*)(rawc + (r0 - j) * PF_RS_ROW); const float rr = rs[16 + r0 - j];
                Sb[0] += __uint_as_float(q.x << 16) * rr; Sb[1] += __uint_as_float(q.x & 0xffff0000u) * rr; Sb[2] += __uint_as_float(q.y << 16) * rr; Sb[3] += __uint_as_float(q.y & 0xffff0000u) * rr; }
#pragma unroll 4
            for (int r = r0; r < r0 + 12; ++r) {
                if (l == 0) Sb = (f32x4){0.f, 0.f, 0.f, 0.f};
                const v2u q = *(const LAS v2u*)(rawc + r * PF_RS_ROW); const float rr = rs[16 + r];
                f32x4 hv; hv[0] = __uint_as_float(q.x << 16) * rr; hv[1] = __uint_as_float(q.x & 0xffff0000u) * rr; hv[2] = __uint_as_float(q.y << 16) * rr; hv[3] = __uint_as_float(q.y & 0xffff0000u) * rr;
                const f32x4 full = Sb + hv;
                const int n = (l + 1) < win ? (l + 1) : win;
                const f32x4 o = full * (1.f / (float)n) - hv;
                v2u wv; wv.x = pk2(o[0], o[1]); wv.y = pk2(o[2], o[3]);
                *(LAS v2u*)(lds + PF_A + r * PF_RS_ROW + c4 * 8) = wv;
                Sb = full;
                if (l + 1 >= win) { const v2u qo = *(const LAS v2u*)(rawc + (r - win + 1) * PF_RS_ROW); const float ro = rs[16 + r - win + 1];
                    Sb[0] -= __uint_as_float(qo.x << 16) * ro; Sb[1] -= __uint_as_float(qo.x & 0xffff0000u) * ro; Sb[2] -= __uint_as_float(qo.y << 16) * ro; Sb[3] -= __uint_as_float(qo.y & 0xffff0000u) * ro; }
                l = (l + 1 == LSEQ) ? 0 : l + 1;
            }
        }
        __syncthreads();
        f32x4 acc[6][2];
#pragma unroll
        for (int m = 0; m < 6; ++m) { acc[m][0] = (f32x4){0.f, 0.f, 0.f, 0.f}; acc[m][1] = acc[m][0]; }
#pragma unroll
        for (int ks = 0; ks < 8; ++ks) {
            bf16x8 af[6];
#pragma unroll
            for (int m = 0; m < 6; ++m) af[m] = *(const LAS bf16x8*)(lds + PF_A + (16 * m + fr) * PF_RS_ROW + (32 * ks + 8 * fq) * 2);
#pragma unroll
            for (int m = 0; m < 6; ++m) { acc[m][0] = mfma16(bfr[ks][0], af[m], acc[m][0]); acc[m][1] = mfma16(bfr[ks][1], af[m], acc[m][1]); }
        }
#pragma unroll
        for (int j = 0; j < 2; ++j) { const int col = g * 256 + 32 * w + 16 * j + 4 * fq; const f32x4 pbv = *(const f32x4*)(a.in[I_PB] + col), psv = *(const f32x4*)(a.in[I_PS] + col);
#pragma unroll
            for (int m = 0; m < 6; ++m) { const int row = t0 + 16 * m + fr;
                const v2u hq = *(const LAS v2u*)(lds + PF_RAW + (16 + 16 * m + fr) * PF_RS_ROW + (32 * w + 16 * j + 4 * fq) * 2);
                f32x4 hv; hv[0] = __uint_as_float(hq.x << 16); hv[1] = __uint_as_float(hq.x & 0xffff0000u); hv[2] = __uint_as_float(hq.y << 16); hv[3] = __uint_as_float(hq.y & 0xffff0000u);
                hb_store4(SB, row, col, hv + (acc[m][j] + pbv) * psv); } }
    }
#undef POOL_PREFETCH
}
__device__ __forceinline__ void ph_pooled(const Args& a, LAS unsigned char* lds, int wk, int nwk) {
    const int tid = threadIdx.x, qt = tid >> 7, c8 = tid & 127, c = c8 * 8, g = c >> 8, w = 2 << g;
    const bf16* HBr = (const bf16*)a.out; const float* SSQ = (const float*)(a.ws + WS_SSDSQ); bf16* PO = (bf16*)(a.ws + WS_POOLED);
    LAS float* rs = (LAS float*)lds + qt * 64;
    for (int pr = wk; pr < 172; pr += nwk) {
        const int task = pr * 4 + qt, b = task / 86, t0 = (task % 86) * 24;
        const size_t rb = (size_t)b * LSEQ;
        __syncthreads();
        if (c8 < 40) { const int l = t0 - 16 + c8; float r = 0.f;
            if (l >= 0) { const f32x4* q = (const f32x4*)(SSQ + (rb + l) * 16); const f32x4 sv = (q[0] + q[1]) + (q[2] + q[3]); r = rsqrtf((sv[0] + sv[1] + sv[2] + sv[3]) * (1.f / D) + EPS); }
            rs[c8] = r; }
        __syncthreads();
        f32x4 S0 = (f32x4){0.f, 0.f, 0.f, 0.f}, S1 = S0;
        for (int j = 1; j <= w; ++j) { const int l = t0 - j; if (l >= 0) { f32x4 x0, x1; unpack8v(*(const v4u*)(HBr + (rb + l) * D + c), x0, x1); S0 += x0 * rs[16 - j]; S1 += x1 * rs[16 - j]; } }
#pragma unroll 4
        for (int t = 0; t < 24; ++t) {
            const int l = t0 + t;
            f32x4 h0v, h1v; unpack8v(*(const v4u*)(HBr + (rb + l) * D + c), h0v, h1v); h0v *= rs[16 + t]; h1v *= rs[16 + t];
            const int lo = l - w, loc = lo >= 0 ? lo : 0; const float rl = lo >= 0 ? rs[16 + t - w] : 0.f;
            f32x4 s0v, s1v; unpack8v(*(const v4u*)(HBr + (rb + loc) * D + c), s0v, s1v);
            S0 += h0v; S0 -= s0v * rl; S1 += h1v; S1 -= s1v * rl;
            const int n = (l + 1) < w ? (l + 1) : w; const float inv = 1.f / (float)n;
            const f32x4 o0 = S0 * inv - h0v, o1 = S1 * inv - h1v;
            v4u wv; wv.x = pk2(o0[0], o0[1]); wv.y = pk2(o0[2], o0[3]); wv.z = pk2(o1[0], o1[1]); wv.w = pk2(o1[2], o1[3]); *(v4u*)(PO + (rb + l) * D + c) = wv;
        }
    }
}
__device__ __forceinline__ void ph_poolgemm(const Args& a, int wk, int nwk) {
    const int tid = threadIdx.x, lane = tid & 63, wave = __builtin_amdgcn_readfirstlane(tid >> 6), fr = lane & 15, fq = lane >> 4;
    const int gw = wk * NWAVES + wave, NGW = nwk * NWAVES;
    const bf16* PO = (const bf16*)(a.ws + WS_POOLED); const bf16* WPOOL = (const bf16*)(a.ws + WS_WPOOL);
    float* H = (float*)(a.ws + WS_H); bf16* HB = (bf16*)a.out;
    for (int u = gw; u < 258 * 16; u += NGW) {
        const int rt = u / 16, ct = u % 16, g = ct >> 2;
        const bf16* arow[4];
#pragma unroll
        for (int mi = 0; mi < 4; ++mi) arow[mi] = PO + (size_t)(rt * 64 + 16 * mi + fr) * D + g * 256;
        f32x4 acc[4][4]; zero_acc(acc);
        sg_kloop<4>(256, arow, [=](int n, int k0) { return WPOOL + (size_t)(ct * 64 + n) * 256 + k0; }, NoKS(), acc, fr, fq);
#pragma unroll
        for (int mi = 0; mi < 4; ++mi) { const int row = rt * 64 + 16 * mi + fr;
#pragma unroll
            for (int nj = 0; nj < 4; ++nj) { const int c = ct * 64 + 16 * nj + 4 * fq; float* hp = H + (size_t)row * D + c;
                const f32x4 v = *(const f32x4*)hp + (acc[mi][nj] + *(const f32x4*)(a.in[I_PB] + c)) * *(const f32x4*)(a.in[I_PS] + c); *(f32x4*)hp = v;
                v2u w; w.x = pk2(v.x, v.y); w.y = pk2(v.z, v.w); *(v2u*)(HB + (size_t)row * D + c) = w; } }
    }
}
__device__ __forceinline__ void ph_final(const Args& a, int wk, int nwk) {
    const int tid = threadIdx.x, lane = tid & 63, wave = __builtin_amdgcn_readfirstlane(tid >> 6);
    const int gw = wk * NWAVES + wave, NGW = nwk * NWAVES;
    const f32x4* gn = (const f32x4*)a.in[I_NORMF] + lane;
    const bf16* HF = (const bf16*)(a.ws + WS_SC);
    for (int orow = gw; orow < NB * SEQ; orow += NGW) {
        const int b = orow / SEQ, l = orow - b * SEQ, row = b * LSEQ + NMETA + l;
        const v2u* xr = (const v2u*)(HF + (size_t)row * D) + lane; f32x4 v[4]; float ss = 0.f;
#pragma unroll
        for (int j = 0; j < 4; ++j) { const v2u q = xr[64 * j]; v[j][0] = __uint_as_float(q.x << 16); v[j][1] = __uint_as_float(q.x & 0xffff0000u); v[j][2] = __uint_as_float(q.y << 16); v[j][3] = __uint_as_float(q.y & 0xffff0000u);
            ss += v[j].x * v[j].x + v[j].y * v[j].y + v[j].z * v[j].z + v[j].w * v[j].w; }
        ss = wave_sum(ss);
        const float rstd = rsqrtf(ss * (1.f / D) + EPS);
        f32x4* o = (f32x4*)(a.out + (size_t)orow * D) + lane;
#ifdef PROBE_T
        const unsigned long long* ts = (const unsigned long long*)(a.ws + WS_CTL + 2048);
        const float tA = (float)(ts[PROBE_A_HI] - ts[PROBE_A_LO]) * 0.01f, tB = (float)(ts[PROBE_B_HI] - ts[PROBE_B_LO]) * 0.01f;
#pragma unroll
        for (int j = 0; j < 4; ++j) { f32x4 r = v[j] * rstd * gn[64 * j] + tB * 0.01f; if (orow == 0 && lane == 0 && j == 0) r.x += tA; o[64 * j] = r; }
#else
#pragma unroll
        for (int j = 0; j < 4; ++j) o[64 * j] = v[j] * rstd * gn[64 * j];
#endif
    }
}

__global__ void __launch_bounds__(NWAVES * 64, 2) fwd_kernel(Args a) {
    extern __shared__ __attribute__((aligned(16))) unsigned char lds_raw[];
    LAS unsigned char* lds = (LAS unsigned char*)lds_raw;
    volatile LAS unsigned* MISC = (volatile LAS unsigned*)(lds + LDS_BYTES - 256);
    const int tid = threadIdx.x;
    const int G = gridDim.x; const int bx = blockIdx.x;
    const int wk = (G % 8 == 0) ? (bx % 8) * (G / 8) + bx / 8 : bx;
    if (tid < 64) MISC[tid] = 0u;
    __syncthreads();
    XcdBarrier bar; bar.bar = (unsigned*)(a.ws + WS_CTL) + CW_BAR; bar.x = 0; bar.st = nullptr;
    if (N_LAUNCHES == 1) bar = xcd_barrier_post((unsigned*)(a.ws + WS_CTL) + CW_BAR, MISC + 8);
    const int lo = a.ph_lo, hi = a.ph_hi;
#ifndef PH_MASK
#define PH_MASK 0xFFFF
#endif
#define IN(k) (((PH_MASK >> (k)) & 1) && lo <= (k) && (k) < hi)
#ifdef PROBE_T
#define STAMP(k) do { if (blockIdx.x == 0 && tid == 0) ((unsigned long long*)(a.ws + WS_CTL + 2048))[k] = __builtin_amdgcn_s_memrealtime(); } while (0)
#else
#define STAMP(k) do { } while (0)
#endif
#ifdef PROBE_K
    volatile LAS unsigned long long* pkt = (volatile LAS unsigned long long*)(lds + LDS_BYTES - 128);
#define PSTAMP(k) do { if (blockIdx.x == 0 && tid == 0) { if ((k) == PROBE_K) pkt[0] = __builtin_amdgcn_s_memrealtime(); if ((k) == PROBE_K + 1) pkt[1] = __builtin_amdgcn_s_memrealtime(); } } while (0)
#else
#define PSTAMP(k) do { } while (0)
#endif
#define SEAM(k) do { if (IN(k) && IN((k) + 1)) xcd_barrier(bar); STAMP((k) + 1); PSTAMP((k) + 1); } while (0)
    STAMP(0); PSTAMP(0);
    if (IN(0)) { ph_prep(a, lds, wk, G); } SEAM(0);
    if (IN(1)) { ph_gemm1_pg8(a, lds, G); } SEAM(1);
    if (IN(2)) { ph_conv(a, wk, G); } SEAM(2);
    if (IN(3)) { ph_mixers3(a, lds, wk, G); } SEAM(3);
    if (IN(4)) { ph_gemm2_pg8(a, lds, wk, G); } SEAM(4);
    if (IN(5)) { ph_router(a, lds, 0, wk, G); } SEAM(5);
    if (IN(6)) { ph_moe_up_pg8(a, lds, 0, G); ph_moe_down_pg8(a, lds, 0, G); } SEAM(6);
    STAMP(8); PSTAMP(8);
    if (IN(8)) { ph_pool_fused(a, lds, wk, G); } SEAM(8);
    STAMP(10); PSTAMP(10);
    if (IN(10)) { ph_router(a, lds, 1, wk, G); } SEAM(10);
    if (IN(11)) { ph_moe_up_pg8(a, lds, 1, G); ph_moe_down_pg8(a, lds, 1, G); } SEAM(11);
    STAMP(13); PSTAMP(13);
    if (IN(13)) { ph_final(a, wk, G); }
#ifdef PROBE_K
    if (blockIdx.x == 0 && tid == 0) {
        asm volatile("s_waitcnt vmcnt(0)" ::: "memory");
        if (PROBE_K == 13) pkt[1] = __builtin_amdgcn_s_memrealtime();
        const unsigned long long tend = __builtin_amdgcn_s_memrealtime() + 4ull * (pkt[1] - pkt[0]);
        while (__builtin_amdgcn_s_memrealtime() < tend) __builtin_amdgcn_s_sleep(16);
    }
#endif
#undef IN
#undef SEAM
}

extern "C" void kernel_launch(void* const* d_in, const int* in_sizes, int n_in, void* d_out, int out_size, void* d_ws, size_t ws_size, hipStream_t stream) {
    static int grid = 0;
    if (grid == 0) {
        if (n_in != 31 || out_size != NB * SEQ * D || ws_size < WS_END) { fprintf(stderr, "kernel_launch: unexpected shapes (n_in %d out %d ws %zu)\n", n_in, out_size, ws_size); grid = -1; return; }
        int dev = 0, cus = 0;
        if (hipGetDevice(&dev) != hipSuccess || hipDeviceGetAttribute(&cus, hipDeviceAttributeMultiprocessorCount, dev) != hipSuccess) { grid = -1; return; }
        if (hipFuncSetAttribute((const void*)fwd_kernel, hipFuncAttributeMaxDynamicSharedMemorySize, LDS_BYTES) != hipSuccess) { grid = -1; return; }
        grid = cus;
    }
    if (grid < 0) return;
    (void)hipMemsetAsync((char*)d_ws + WS_CTL, 0, CTL_ZERO_BYTES, stream);
    Args a{};
    for (int i = 0; i < 31; ++i) a.in[i] = (const float*)d_in[i];
    a.out = (float*)d_out; a.ws = (unsigned char*)d_ws;
    if (N_LAUNCHES == 1) { a.ph_lo = 0; a.ph_hi = NPH; hipLaunchKernelGGL(fwd_kernel, dim3(grid), dim3(NWAVES * 64), LDS_BYTES, stream, a); }
    else for (int p = 0; p < NPH; ++p) { a.ph_lo = p; a.ph_hi = p + 1; hipLaunchKernelGGL(fwd_kernel, dim3(grid), dim3(NWAVES * 64), LDS_BYTES, stream, a); }
}
```

```cpp
#include <hip/hip_runtime.h>
#include <cstdio>
#include <cstdint>

#define GAS __attribute__((address_space(1)))
#define LAS __attribute__((address_space(3)))
typedef unsigned short bf16;
typedef short bf16x8 __attribute__((ext_vector_type(8)));
typedef float f32x4 __attribute__((ext_vector_type(4)));
typedef unsigned v4u __attribute__((ext_vector_type(4)));
typedef unsigned v2u __attribute__((ext_vector_type(2)));

#ifndef MK_N_LAUNCHES
#define MK_N_LAUNCHES 1
#endif
constexpr int NPH = 14;
constexpr int N_LAUNCHES = MK_N_LAUNCHES;

constexpr int NB = 8, SEQ = 2048, NMETA = 16, LSEQ = SEQ + NMETA, T = NB * LSEQ, D = 1024;
constexpr int PROJ_SRC = 4624, LDP = 4608;
constexpr int C_Z = 0, C_G = 1024, C_X = 2048, C_B = 3072, C_C = 3328, C_LI = 3584;
constexpr float EPS = 1e-6f;
constexpr int NBK = 24;

constexpr size_t MiB = 1u << 20;
constexpr size_t WS_CTL = 0, CTL_ZERO_BYTES = 160 * 1024;
constexpr size_t WS_WIN = 1 * MiB;
constexpr size_t WS_WOUT = 10 * MiB;
constexpr size_t WS_WPOOL = 14 * MiB;
constexpr size_t WS_WRT = 14 * MiB + 512 * 1024;
constexpr size_t WS_WDTT = 15 * MiB + 512 * 1024;
constexpr size_t WS_RSTD0 = 15 * MiB;
constexpr size_t WS_RSTD1 = WS_RSTD0 + 128 * 1024;
constexpr size_t WS_BKT = WS_RSTD1 + 128 * 1024;
constexpr size_t WS_GATES = WS_BKT + 128 * 1024;
constexpr size_t WS_DT = 16 * MiB;
constexpr size_t WS_SSDSQ = 17 * MiB + 64 * 1024;
constexpr size_t WS_LIST = 19 * MiB;
constexpr size_t WS_WGU = 21 * MiB;
constexpr size_t WS_WD = 53 * MiB;
constexpr size_t WS_H = 69 * MiB;
constexpr size_t WS_PROJ = 134 * MiB;
constexpr size_t WS_HID = WS_PROJ;
constexpr size_t WS_POOLED = WS_PROJ;
constexpr size_t WS_END = 280 * MiB;
constexpr size_t WS_WGU1 = WS_PROJ + 64 * MiB, WS_WD1 = WS_PROJ + 96 * MiB;
__host__ __device__ constexpr size_t ws_wgu(int L) { return L ? WS_WGU1 : WS_WGU; }
__host__ __device__ constexpr size_t ws_wd(int L) { return L ? WS_WD1 : WS_WD; }
constexpr size_t WS_X8 = WS_PROJ + 46 * MiB;
constexpr size_t WS_SB = WS_H, WS_SC = WS_H + (size_t)T * D * 2;
static_assert(WS_H + (size_t)T * D * 4 <= WS_PROJ && WS_PROJ + (size_t)T * LDP * 2 <= WS_END, "ws map");
static_assert(WS_DT + (size_t)T * 16 * 4 <= WS_SSDSQ && WS_SSDSQ + (size_t)T * 16 * 4 <= WS_LIST && WS_LIST + (size_t)NBK * T * 4 <= WS_WGU, "ws map small");
constexpr int CW_CNT = 8192;
constexpr int CW_BAR = 4096;
constexpr int CW_RT = 16384;

constexpr int LDS_BYTES = 163840;
#ifndef MOE_UP_F8
#define MOE_UP_F8 1
#endif
#ifndef MOE_DOWN_F8
#define MOE_DOWN_F8 0
#endif
constexpr int LDS_TAB = 131072;
constexpr int NWAVES = 8;

struct Args { const float* in[31]; float* out; unsigned char* ws; int ph_lo, ph_hi; };
enum { I_X = 0, I_META, I_NORMF, I_MNE, I_WIN, I_SCW, I_SCB, I_DTB, I_ALOG, I_SD, I_SNORM, I_LCW, I_LCB, I_LWA, I_LBA, I_LWX, I_LBX, I_LLAM, I_WOUT,
       I_MNO, I_PW, I_PB, I_PS, I_FFN, I_RGW, I_RGB, I_REW, I_REB, I_EWG, I_EWU, I_EWD };

#define LDS_WAIT() asm volatile("s_waitcnt lgkmcnt(0)" ::: "memory")
__device__ __forceinline__ float bf2f(unsigned v) { return __uint_as_float(v << 16); }
__device__ __forceinline__ unsigned f2bf(float f) { unsigned u = __float_as_uint(f); return (u + 0x7fffu + ((u >> 16) & 1u)) >> 16; }
__device__ __forceinline__ unsigned pk2(float lo, float hi) { return f2bf(lo) | (f2bf(hi) << 16); }
__device__ __forceinline__ void unpack8v(const v4u r, f32x4& a, f32x4& b) {
    a[0] = __uint_as_float(r.x << 16); a[1] = __uint_as_float(r.x & 0xffff0000u); a[2] = __uint_as_float(r.y << 16); a[3] = __uint_as_float(r.y & 0xffff0000u);
    b[0] = __uint_as_float(r.z << 16); b[1] = __uint_as_float(r.z & 0xffff0000u); b[2] = __uint_as_float(r.w << 16); b[3] = __uint_as_float(r.w & 0xffff0000u);
}
__device__ __forceinline__ unsigned pack_fp8x4(float a, float b, float c, float d) {
    int r = 0; r = __builtin_amdgcn_cvt_pk_fp8_f32(a, b, r, false); r = __builtin_amdgcn_cvt_pk_fp8_f32(c, d, r, true); return (unsigned)r;
}
__device__ __forceinline__ void x8_store8(unsigned char* X8, int row, int col, const f32x4 v0, const f32x4 v1) {
    v2u o; o.x = pack_fp8x4(v0[0], v0[1], v0[2], v0[3]); o.y = pack_fp8x4(v1[0], v1[1], v1[2], v1[3]); *(v2u*)(X8 + (size_t)row * 1024 + col) = o;
}
__device__ __forceinline__ float wave_sum(float v) {
#pragma unroll
    for (int o = 1; o < 64; o <<= 1) v += __shfl_xor(v, o);
    return v;
}
__device__ __forceinline__ float rcp_f(float v) { return __builtin_amdgcn_rcpf(v); }
__device__ __forceinline__ float sigmoid_f(float v) { return rcp_f(1.f + __expf(-v)); }
__device__ __forceinline__ float silu_f(float v) { return v * rcp_f(1.f + __expf(-v)); }
__device__ __forceinline__ float softplus_f(float v) {
    const float e = __expf(-fabsf(v));
    const float lp = e < 0.03f ? e * (1.f - e * (0.5f - e * 0.33333334f)) : __logf(1.f + e);
    return fmaxf(v, 0.f) + lp;
}
__device__ __forceinline__ float gelu_tanh_f(float v) { const float u2 = 1.5957691216057308f * (v + 0.044715f * v * v * v); return v * rcp_f(1.f + __expf(-u2)); }
__device__ __forceinline__ const float* h0_row(const Args& a, int row) {
    const int b = row / LSEQ, l = row - b * LSEQ;
    return l < NMETA ? a.in[I_META] + (size_t)l * D : a.in[I_X] + ((size_t)b * SEQ + (l - NMETA)) * D;
}

#define XB_TMO      128
#define XB_XCNT(j)  (256  + 64 * (j))
#define XB_XSUB(j)  (1280 + 64 * (j))
#define XB_XGEN(j)  (2304 + 64 * (j))
#define XB_TOP      3328
#define XB_TOPGEN   3392
#define XCD_BAR_WORDS 3456
#define XB_SPIN_CAP (1u << 18)
__device__ __forceinline__ unsigned xb_ld(unsigned* p)              { return __hip_atomic_load(p, __ATOMIC_RELAXED, __HIP_MEMORY_SCOPE_AGENT); }
__device__ __forceinline__ unsigned xb_add(unsigned* p, unsigned v) { return __hip_atomic_fetch_add(p, v, __ATOMIC_RELAXED, __HIP_MEMORY_SCOPE_AGENT); }
__device__ __forceinline__ unsigned xb_xcc_id() { return (unsigned)__builtin_amdgcn_s_getreg((3 << 11) | 20) & 0xFu; }
#define XB_SPIN(cond, bar) do { unsigned _sp = 0; while (cond) { __builtin_amdgcn_s_sleep(1); \
    if ((++_sp & 255u) == 0u) { if (xb_ld(&(bar)[XB_TMO])) break; if (_sp > XB_SPIN_CAP) { atomicAdd(&(bar)[XB_TMO], 1u); break; } } } } while (0)
struct XcdBarrier { unsigned* bar; unsigned x; volatile LAS unsigned* st; };
__device__ __forceinline__ XcdBarrier xcd_barrier_post(unsigned* bar, volatile LAS unsigned* st) {
    XcdBarrier b; b.bar = bar; b.x = xb_xcc_id(); b.st = st;
    if (threadIdx.x == 0) (void)xb_add(&bar[XB_XCNT(b.x)], 1u);
    return b;
}
__device__ __forceinline__ void xcd_barrier_complete(unsigned* bar, unsigned x, unsigned& nloc, unsigned& nx) {
    const unsigned G = gridDim.x * gridDim.y * gridDim.z;
    unsigned sum, cnt, mine, sp = 0u;
    for (;;) {
        sum = 0u; cnt = 0u; mine = 0u;
#pragma unroll
        for (unsigned j = 0; j < 16; ++j) { const unsigned c = xb_ld(&bar[XB_XCNT(j)]); sum += c; cnt += (c > 0u) ? 1u : 0u; mine = (j == x) ? c : mine; }
        if (sum == G) break;
        __builtin_amdgcn_s_sleep(1);
        if ((++sp & 255u) == 0u) { if (xb_ld(&bar[XB_TMO])) break; if (sp > XB_SPIN_CAP) { atomicAdd(&bar[XB_TMO], 1u); break; } }
    }
    nloc = mine > 0u ? mine : 1u; nx = cnt > 0u ? cnt : 1u;
}
__device__ __forceinline__ void xcd_barrier(const XcdBarrier& b) {
    asm volatile("s_waitcnt vmcnt(0)" ::: "memory");
    __syncthreads();
    if (threadIdx.x == 0) {
        unsigned* bar = b.bar;
        __builtin_amdgcn_s_waitcnt(0);
        unsigned nloc = b.st[0], nx = b.st[1];
        if (nloc == 0u) { xcd_barrier_complete(bar, b.x, nloc, nx); b.st[0] = nloc; b.st[1] = nx; }
        const unsigned old = xb_add(&bar[XB_XSUB(b.x)], 1u);
        const unsigned gen = old / nloc;
        if (old + 1u == (gen + 1u) * nloc) {
            __builtin_amdgcn_fence(__ATOMIC_RELEASE, "agent");
            asm volatile("s_waitcnt vmcnt(0)" ::: "memory");
            const unsigned og = xb_add(&bar[XB_TOP], 1u);
            const unsigned tg = og / nx;
            if (og + 1u == (tg + 1u) * nx) xb_add(&bar[XB_TOPGEN], 1u);
            else XB_SPIN(xb_ld(&bar[XB_TOPGEN]) == tg, bar);
            __builtin_amdgcn_fence(__ATOMIC_ACQUIRE, "agent");
            xb_add(&bar[XB_XGEN(b.x)], 1u);
            asm volatile("s_waitcnt vmcnt(0)" ::: "memory");
        } else {
            XB_SPIN(xb_ld(&bar[XB_XGEN(b.x)]) == gen, bar);
            __builtin_amdgcn_fence(__ATOMIC_ACQUIRE, "agent");
            asm volatile("s_waitcnt vmcnt(0)" ::: "memory");
        }
    }
    __syncthreads();
}

template <bool F8>
__device__ __forceinline__ void tr_item_t(const float* src, int ldsrc, const float* gain, void* dstv, int lddst  , float scale, LAS float* scr, int lane) {
    float tv[32];
#pragma unroll
    for (int i = 0; i < 32; ++i) { const int kk = 2 * i + (lane >> 5); tv[i] = src[(size_t)kk * ldsrc + (lane & 31)]; }
#pragma unroll
    for (int i = 0; i < 32; ++i) { const int kk = 2 * i + (lane >> 5); float v = tv[i]; if (gain) v *= gain[kk]; scr[kk * 33 + (lane & 31)] = v; }
    LDS_WAIT();
    const int c = lane & 7;
#pragma unroll
    for (int j = 0; j < 4; ++j) { const int n = (lane >> 3) + 8 * j; const LAS float* sp = scr + (8 * c) * 33 + n;
        if (F8) { v2u o; o.x = pack_fp8x4(sp[0 * 33] * scale, sp[1 * 33] * scale, sp[2 * 33] * scale, sp[3 * 33] * scale); o.y = pack_fp8x4(sp[4 * 33] * scale, sp[5 * 33] * scale, sp[6 * 33] * scale, sp[7 * 33] * scale);
            *(v2u*)((unsigned char*)dstv + (size_t)n * lddst + 8 * c) = o; }
        else { v4u o; o.x = pk2(sp[0 * 33], sp[1 * 33]); o.y = pk2(sp[2 * 33], sp[3 * 33]); o.z = pk2(sp[4 * 33], sp[5 * 33]); o.w = pk2(sp[6 * 33], sp[7 * 33]);
            *(v4u*)((bf16*)dstv + (size_t)n * lddst + 8 * c) = o; } }
    LDS_WAIT();
}
__device__ __forceinline__ void tr_item(const float* src, int ldsrc, const float* gain, bf16* dst, int lddst, LAS float* scr, int lane) { tr_item_t<false>(src, ldsrc, gain, dst, lddst, 1.f, scr, lane); }
__device__ __forceinline__ void convert_experts(const Args& a, int L, LAS float* scr, int gw, int NGW, int lane);
__device__ __forceinline__ void convert_experts_dyn(const Args& a, int L, LAS unsigned char* lds, unsigned* ctr) {
    const int wave = __builtin_amdgcn_readfirstlane((int)threadIdx.x >> 6), lane = (int)threadIdx.x & 63;
    LAS int* slot = (LAS int*)(lds + 8 * 8448);
    for (;;) {
        __syncthreads();
        if (threadIdx.x == 0) *slot = (int)atomicAdd(ctr, 64u);
        __syncthreads();
        const int base = __builtin_amdgcn_readfirstlane(*slot);
        if (base >= 12288) break;
        convert_experts(a, L, (LAS float*)(lds + wave * 8448), base + wave * 8, 8, lane);
    }
}
__device__ __forceinline__ void convert_experts(const Args& a, int L, LAS float* scr, int gw, int NGW, int lane) {
    bf16* WGU = (bf16*)(a.ws + ws_wgu(L)); bf16* WD = (bf16*)(a.ws + ws_wd(L));
    const float* gain = a.in[I_FFN] + L * D;
    constexpr int I_GU = 16 * 16 * 16, I_DN = 16 * 8 * 32;
    const int it_end = NGW == 8 ? (gw + 8 < 2 * I_GU + I_DN ? gw + 8 : 2 * I_GU + I_DN) : 2 * I_GU + I_DN, it_step = NGW == 8 ? 1 : NGW;
    for (int it = gw; it < it_end; it += it_step) {
        int r = it;
        if (r < 2 * I_GU) {
            const int up = r >= I_GU; if (up) r -= I_GU;
            const int e = r >> 8, kb = (r >> 4) & 15, nb = r & 15;
            const float* src = a.in[up ? I_EWU : I_EWG] + ((size_t)(L * 16 + e) * 1024 + kb * 64) * 512 + nb * 32;
            const int drow = e * 1024 + (nb >> 2) * 256 + (nb & 3) * 32 + (up ? 128 : 0);
#if MOE_UP_F8
            tr_item_t<true>(src, 512, gain + kb * 64, (unsigned char*)WGU + (size_t)drow * 1024 + kb * 64, 1024, 32.f, scr, lane);
#else
            tr_item(src, 512, gain + kb * 64, WGU + (size_t)drow * 1024 + kb * 64, 1024, scr, lane);
#endif
        } else {
            r -= 2 * I_GU;
            const int e = r >> 8, kb = (r >> 5) & 7, nb = r & 31;
            const float* src = a.in[I_EWD] + ((size_t)(L * 16 + e) * 512 + kb * 64) * 1024 + nb * 32;
#if MOE_DOWN_F8
            tr_item_t<true>(src, 1024, nullptr, (unsigned char*)WD + (size_t)(e * 1024 + nb * 32) * 512 + kb * 64, 512, 16.f, scr, lane);
#else
            tr_item(src, 1024, nullptr, WD + (size_t)(e * 1024 + nb * 32) * 512 + kb * 64, 512, scr, lane);
#endif
        }
    }
}
__device__ __forceinline__ void ph_prep(const Args& a, LAS unsigned char* lds, int wk, int nwk) {
    const int tid = threadIdx.x, lane = tid & 63, wave = __builtin_amdgcn_readfirstlane(tid >> 6);
    const int gw = wk * NWAVES + wave, NGW = nwk * NWAVES;
    LAS float* scr = (LAS float*)(lds + wave * 8448);
    bf16* WIN = (bf16*)(a.ws + WS_WIN); bf16* WOUT = (bf16*)(a.ws + WS_WOUT); bf16* WPOOL = (bf16*)(a.ws + WS_WPOOL);
    constexpr int I_IN = 16 * 144, I_OUT = 32 * 32, I_POOL = 4 * 4 * 8;
    for (int it = gw; it < I_IN + I_OUT + I_POOL; it += NGW) {
        int r = it;
        if (r < I_IN) { const int kb = r / 144, nb = r % 144, n0 = nb * 32;
            const int sc = n0 < 1024 ? n0 : (n0 < 2048 ? n0 - 1024 + 2576 : (n0 < 3584 ? n0 - 2048 + 1024 : n0 - 3584 + 3600));
            tr_item(a.in[I_WIN] + (size_t)(kb * 64) * PROJ_SRC + sc, PROJ_SRC, a.in[I_MNE] + kb * 64, WIN + (size_t)n0 * 1024 + kb * 64, 1024, scr, lane); continue; }
        r -= I_IN;
        if (r < I_OUT) { const int kb = r >> 5, nb = r & 31;
            tr_item(a.in[I_WOUT] + (size_t)(kb * 64) * 1024 + nb * 32, 1024, kb < 16 ? a.in[I_SNORM] + kb * 64 : nullptr, WOUT + (size_t)(nb * 32) * 2048 + kb * 64, 2048, scr, lane); continue; }
        r -= I_OUT;
        { const int g = r >> 5, kb = (r >> 3) & 3, nb = r & 7;
            tr_item(a.in[I_PW] + (size_t)g * 65536 + (size_t)(kb * 64) * 256 + nb * 32, 256, a.in[I_MNO] + g * 256 + kb * 64, WPOOL + (size_t)(g * 256 + nb * 32) * 256 + kb * 64, 256, scr, lane); }
    }
    {
        v4u* WRT = (v4u*)(a.ws + WS_WRT); v4u* WDTT = (v4u*)(a.ws + WS_WDTT);
        for (int i = wk * 512 + tid; i < 2 * 48 * 128 + 256 * 128; i += nwk * 512) {
            float f[8];
            if (i < 2 * 48 * 128) {
                const int L = i / 6144, r = i % 6144, n = r >> 7, k8 = (r & 127) * 8, j = n < 20 ? n : n - 20;
#pragma unroll
                for (int e = 0; e < 8; ++e) { const int k = k8 + e; float w = 0.f;
                    if (n < 40) { w = (j < 4 ? a.in[I_RGW][((size_t)L * 1024 + k) * 4 + j] : a.in[I_REW][((size_t)L * 1024 + k) * 16 + (j - 4)]) * a.in[I_FFN][L * 1024 + k];
                        if (n >= 20) w -= bf2f(f2bf(w)); }
                    f[e] = w; }
                v4u o; o.x = pk2(f[0], f[1]); o.y = pk2(f[2], f[3]); o.z = pk2(f[4], f[5]); o.w = pk2(f[6], f[7]); WRT[i] = o;
            } else {
                const int r = i - 2 * 48 * 128, n = r >> 7, k8 = (r & 127) * 8;
#pragma unroll
                for (int e = 0; e < 8; ++e) { const int k = k8 + e; f[e] = n < 16 ? a.in[I_WIN][(size_t)k * PROJ_SRC + 2560 + n] * a.in[I_MNE][k] : 0.f; }
                v4u o; o.x = pk2(f[0], f[1]); o.y = pk2(f[2], f[3]); o.z = pk2(f[4], f[5]); o.w = pk2(f[6], f[7]); WDTT[r] = o;
            }
        }
    }
    bf16* HB = (bf16*)a.out; float* RSTD0 = (float*)(a.ws + WS_RSTD0);
    for (int row = gw; row < T; row += 2 * NGW) {
        const int row2 = row + NGW; const bool has2 = row2 < T;
        const f32x4* xr = (const f32x4*)h0_row(a, row) + lane; const f32x4* xr2 = (const f32x4*)h0_row(a, has2 ? row2 : row) + lane;
        f32x4 v[4], v2[4]; float ss = 0.f, ss2 = 0.f;
#pragma unroll
        for (int j = 0; j < 4; ++j) { v[j] = xr[64 * j]; v2[j] = xr2[64 * j]; }
#pragma unroll
        for (int j = 0; j < 4; ++j) { ss += v[j].x * v[j].x + v[j].y * v[j].y + v[j].z * v[j].z + v[j].w * v[j].w; ss2 += v2[j].x * v2[j].x + v2[j].y * v2[j].y + v2[j].z * v2[j].z + v2[j].w * v2[j].w; }
#pragma unroll
        for (int o = 1; o < 64; o <<= 1) { ss += __shfl_xor(ss, o); ss2 += __shfl_xor(ss2, o); }
        v2u* o8 = (v2u*)(HB + (size_t)row * D) + lane;
#pragma unroll
        for (int j = 0; j < 4; ++j) { v2u w; w.x = pk2(v[j].x, v[j].y); w.y = pk2(v[j].z, v[j].w); o8[64 * j] = w; }
        if (lane == 0) RSTD0[row] = rsqrtf(ss * (1.f / D) + EPS);
        if (has2) { v2u* o82 = (v2u*)(HB + (size_t)row2 * D) + lane;
#pragma unroll
            for (int j = 0; j < 4; ++j) { v2u w; w.x = pk2(v2[j].x, v2[j].y); w.y = pk2(v2[j].z, v2[j].w); o82[64 * j] = w; }
            if (lane == 0) RSTD0[row2] = rsqrtf(ss2 * (1.f / D) + EPS); }
    }
}

template <int NT, class BP, class KS>
__device__ __forceinline__ void sg_kloop(int K, const bf16* const (&arow)[4], BP bp, KS ks, f32x4 (&acc)[4][NT], int fr, int fq) {
    for (int k0 = 0; k0 < K; k0 += 32) {
        ks(k0, acc);
        bf16x8 av[4], bv[NT];
#pragma unroll
        for (int mi = 0; mi < 4; ++mi) av[mi] = *(const bf16x8*)(arow[mi] + k0 + 8 * fq);
#pragma unroll
        for (int nj = 0; nj < NT; ++nj) bv[nj] = *(const bf16x8*)(bp(16 * nj + fr, k0) + 8 * fq);
#pragma unroll
        for (int mi = 0; mi < 4; ++mi)
#pragma unroll
            for (int nj = 0; nj < NT; ++nj) acc[mi][nj] = __builtin_amdgcn_mfma_f32_16x16x32_bf16(bv[nj], av[mi], acc[mi][nj], 0, 0, 0);
    }
}
template <int NT> __device__ __forceinline__ void zero_acc(f32x4 (&acc)[4][NT]) {
#pragma unroll
    for (int mi = 0; mi < 4; ++mi)
#pragma unroll
        for (int nj = 0; nj < NT; ++nj) acc[mi][nj] = (f32x4){0.f, 0.f, 0.f, 0.f};
}
struct NoKS { template <int NT> __device__ __forceinline__ void operator()(int, f32x4 (&)[4][NT]) const {} };

__device__ __forceinline__ void ph_gemm1(const Args& a, int wk, int nwk) {
    const int tid = threadIdx.x, lane = tid & 63, wave = __builtin_amdgcn_readfirstlane(tid >> 6), fr = lane & 15, fq = lane >> 4;
    const int gw = wk * NWAVES + wave, NGW = nwk * NWAVES;
    const bf16* HB = (const bf16*)a.out; const bf16* WIN = (const bf16*)(a.ws + WS_WIN); bf16* PROJ = (bf16*)(a.ws + WS_PROJ);
    const float* RSTD0 = (const float*)(a.ws + WS_RSTD0);
    for (int u = gw; u < 258 * 72; u += NGW) {
        const int rt = u / 72, ct = u % 72;
        const bf16* arow[4];
#pragma unroll
        for (int mi = 0; mi < 4; ++mi) arow[mi] = HB + (size_t)(rt * 64 + 16 * mi + fr) * D;
        f32x4 acc[4][4]; zero_acc(acc);
        sg_kloop<4>(1024, arow, [=](int n, int k0) { return WIN + (size_t)(ct * 64 + n) * 1024 + k0; }, NoKS(), acc, fr, fq);
#pragma unroll
        for (int mi = 0; mi < 4; ++mi) { const int row = rt * 64 + 16 * mi + fr; const float rs = RSTD0[row];
#pragma unroll
            for (int nj = 0; nj < 4; ++nj) { const f32x4 v = acc[mi][nj] * rs; v2u w; w.x = pk2(v.x, v.y); w.y = pk2(v.z, v.w);
                *(v2u*)(PROJ + (size_t)row * LDP + ct * 64 + 16 * nj + 4 * fq) = w; } }
    }
}

__device__ __forceinline__ void ph_gemm2(const Args& a, int wk, int nwk) {
    const int tid = threadIdx.x, lane = tid & 63, wave = __builtin_amdgcn_readfirstlane(tid >> 6), fr = lane & 15, fq = lane >> 4;
    const int gw = wk * NWAVES + wave, NGW = nwk * NWAVES;
    const bf16* PROJ = (const bf16*)(a.ws + WS_PROJ); const bf16* WOUT = (const bf16*)(a.ws + WS_WOUT);
    const float* SSDSQ = (const float*)(a.ws + WS_SSDSQ);
    float* H = (float*)(a.ws + WS_H); bf16* HB = (bf16*)a.out;
    for (int u = gw; u < 258 * 16; u += NGW) {
        const int rt = u / 16, ct = u % 16;
        const bf16* arow[4]; float f0[4], f1[4];
#pragma unroll
        for (int mi = 0; mi < 4; ++mi) { const int row = rt * 64 + 16 * mi + fr; arow[mi] = PROJ + (size_t)row * LDP;
            const f32x4* sq = (const f32x4*)(SSDSQ + (size_t)row * 16); const f32x4 q0 = sq[0], q1 = sq[1], q2 = sq[2], q3 = sq[3];
            const float s0 = (q0.x + q0.y + q0.z + q0.w) + (q1.x + q1.y + q1.z + q1.w), s1 = (q2.x + q2.y + q2.z + q2.w) + (q3.x + q3.y + q3.z + q3.w);
            const float r0 = rsqrtf(s0 * (1.f / 512.f) + EPS), r1 = rsqrtf(s1 * (1.f / 512.f) + EPS);
            f0[mi] = r0 / r1; f1[mi] = r1; }
        f32x4 acc[4][4]; zero_acc(acc);
        auto ks = [=](int k0, f32x4 (&ac)[4][4]) {
            if (k0 == 512) {
#pragma unroll
                for (int mi = 0; mi < 4; ++mi)
#pragma unroll
                    for (int nj = 0; nj < 4; ++nj) ac[mi][nj] *= f0[mi]; }
            if (k0 == 1024) {
#pragma unroll
                for (int mi = 0; mi < 4; ++mi)
#pragma unroll
                    for (int nj = 0; nj < 4; ++nj) ac[mi][nj] *= f1[mi]; }
        };
        sg_kloop<4>(2048, arow, [=](int n, int k0) { return WOUT + (size_t)(ct * 64 + n) * 2048 + k0; }, ks, acc, fr, fq);
#pragma unroll
        for (int mi = 0; mi < 4; ++mi) { const int row = rt * 64 + 16 * mi + fr; const float* hr = h0_row(a, row);
#pragma unroll
            for (int nj = 0; nj < 4; ++nj) { const int c = ct * 64 + 16 * nj + 4 * fq; const f32x4 v = acc[mi][nj] + *(const f32x4*)(hr + c);
                *(f32x4*)(H + (size_t)row * D + c) = v; v2u w; w.x = pk2(v.x, v.y); w.y = pk2(v.z, v.w); *(v2u*)(HB + (size_t)row * D + c) = w; } }
    }
}


namespace pg8 {
constexpr int BM = 256, BK = 64, HALF = 128, HTB = HALF * BK * 2, STAGE_BYTES = 8 * HTB, NXCD = 8, WGM = 8;
__host__ __device__ __forceinline__ int lds_byte(int r, int c) { const int st = (r >> 4) * 2 + (c >> 5), rr = r & 15, cc = c & 31, ob = rr * 64 + cc * 2; return st * 1024 + (ob ^ (((ob >> 9) & 1) << 5)); }
__host__ __device__ __forceinline__ void stage_rc(int b, int& R, int& C) { const int st = b / 1024, sb = b % 1024, swz = sb ^ (((sb >> 9) & 1) << 5); R = (st >> 1) * 16 + swz / 64; C = (st & 1) * 32 + (swz % 64) / 2; }
__host__ __device__ __forceinline__ int perm32(int rho) { const int n = rho >> 4, i = rho & 15; return 8 * (i >> 2) + 4 * n + (i & 3); }
__device__ __forceinline__ unsigned cvt_pk_bf16(float lo, float hi) { unsigned r; asm volatile("v_cvt_pk_bf16_f32 %0, %1, %2" : "=v"(r) : "v"(lo), "v"(hi)); return r; }
typedef f32x4 Acc[2][2][4][2];

__device__ __forceinline__ bool static_order(int nM, int nN, int G, int c, int i, int& pm, int& pn) {
    const int nwg = nM * nN; const long L = (long)i * G + c; if (L >= nwg) return false;
    int wgid = (int)L; { const int q = nwg / NXCD, r = nwg % NXCD, xcd = wgid % NXCD, off = wgid / NXCD; wgid = (xcd < r ? xcd * (q + 1) : r * (q + 1) + (xcd - r) * q) + off; }
    const int nig = WGM * nN, gid = wgid / nig, fm = gid * WGM, gsz = (nM - fm) < WGM ? (nM - fm) : WGM;
    pm = fm + ((wgid % nig) % gsz); pn = (wgid % nig) / gsz; return true;
}

template <class P, bool ALIGN_EPI>
__device__ __forceinline__ void gemm_phase(LAS unsigned char* lds, const P& S) {
    const int tid = threadIdx.x, wid = __builtin_amdgcn_readfirstlane(tid >> 6), lane = tid & 63, wr = wid >> 2, wc = wid & 3, fr = lane & 15, fq = lane >> 4;
    const int nt = S.nt;
    int RA[2], CA[2]; unsigned voffB[2];
#pragma unroll
    for (int i = 0; i < 2; ++i) { int R, C; stage_rc(tid * 16 + i * 8192, R, C); RA[i] = R; CA[i] = C; const int Rb = P::PERM ? ((R & ~31) + perm32(R & 31)) : R;
        voffB[i] = (unsigned)(Rb * S.ldb + C) * 2u; }
    const size_t kstep = (size_t)(BK * 2);
    const size_t hstepB = (size_t)HALF * S.ldb * 2;
    const unsigned ldsw = (unsigned)wid * 1024u;
    const int aoff = lds_byte(wr * 64 + fr, fq * 8), boff = lds_byte(wc * 32 + fr, fq * 8);
#define PG8_SA(b, h) (((b) * 2 + (h)) * HTB)
#define PG8_SB(b, h) ((4 + (b) * 2 + (h)) * HTB)
#define PG8_STAGE(bufoff, gbase, voff) do { _Pragma("unroll") for (int _i = 0; _i < 2; ++_i) \
        __builtin_amdgcn_global_load_lds((const unsigned*)((const char*)(gbase) + (voff)[_i]), (LAS unsigned*)(lds + (bufoff) + ldsw + _i * 8192), 16, 0, 0); } while (0)
#define PG8_LDA(dst, b, h) do { _Pragma("unroll") for (int m = 0; m < 4; ++m) _Pragma("unroll") for (int k = 0; k < 2; ++k) dst[m][k] = *(const LAS bf16x8*)(lds + PG8_SA(b, h) + aoff + m * 2048 + k * 1024); } while (0)
#define PG8_LDB(dst, b, h) do { _Pragma("unroll") for (int n = 0; n < 2; ++n) _Pragma("unroll") for (int k = 0; k < 2; ++k) dst[n][k] = *(const LAS bf16x8*)(lds + PG8_SB(b, h) + boff + n * 2048 + k * 1024); } while (0)
#define PG8_MMA(ai, bj, At, Bt) do { __builtin_amdgcn_s_setprio(1); _Pragma("unroll") for (int m = 0; m < 4; ++m) _Pragma("unroll") for (int n = 0; n < 2; ++n) _Pragma("unroll") for (int k = 0; k < 2; ++k) \
        acc[ai][bj][m][n] = __builtin_amdgcn_mfma_f32_16x16x32_bf16(Bt[n][k], At[m][k], acc[ai][bj][m][n], 0, 0, 0); __builtin_amdgcn_s_setprio(0); } while (0)
#define PG8_WAIT_V(n) asm volatile("s_waitcnt vmcnt(" #n ")" ::: "memory")
#define PG8_WAIT_L(n) asm volatile("s_waitcnt lgkmcnt(" #n ")" ::: "memory")
#define PG8_BAR __builtin_amdgcn_s_barrier()
#define PG8_SCHED __builtin_amdgcn_sched_barrier(0)
    typename P::Unit cur, nxt; int ui = 0;
    if (!S.next(0, cur)) return;
    f32x4 acc[2][2][4][2];
#pragma unroll
    for (int a = 0; a < 2; ++a)
#pragma unroll
        for (int b = 0; b < 2; ++b)
#pragma unroll
            for (int m = 0; m < 4; ++m)
#pragma unroll
                for (int n = 0; n < 2; ++n) acc[a][b][m][n] = (f32x4){0.f, 0.f, 0.f, 0.f};
    bf16x8 At[4][2], B0[2][2], B1[2][2];
    typename P::EpiRegs er;
    unsigned vA[4];
    S.a_ready(cur);
    S.avoff(cur, RA, CA, vA);
    const char* cA = S.abase(cur);
    {
        const char* b0 = S.btile(cur, 0); const char* b1 = S.btile(cur, 1);
        PG8_STAGE(PG8_SB(0, 0), b0, voffB); PG8_STAGE(PG8_SB(0, 1), b0 + hstepB, voffB); PG8_STAGE(PG8_SA(0, 0), cA, vA); PG8_STAGE(PG8_SA(0, 1), cA, vA + 2);
        if (wr == 1) PG8_BAR;
        PG8_WAIT_V(2); PG8_BAR;
        PG8_STAGE(PG8_SB(1, 0), b1, voffB); PG8_STAGE(PG8_SA(1, 0), cA + kstep, vA); PG8_STAGE(PG8_SB(1, 1), b1 + hstepB, voffB);
        PG8_WAIT_V(6); PG8_BAR;
    }
    for (;;) {
        const bool has_next = S.next(ui + 1, nxt);
        for (int t = 0; t < nt; t += 2) {
            const bool last = (t == nt - 2);
            const char* a1 = cA + (size_t)(t + 1) * kstep;
            S.khook(t, acc, cur, lds, wr, wc, fr, fq);
            if (last) S.epi_pre(cur, er, wr, wc, fr, fq);
            PG8_LDB(B0, 0, 0); PG8_LDB(B1, 0, 1); PG8_SCHED; PG8_LDA(At, 0, 0); PG8_STAGE(PG8_SA(1, 1), a1, vA + 2);
            PG8_WAIT_V(8); PG8_WAIT_L(0); PG8_BAR; PG8_MMA(0, 0, At, B0); PG8_MMA(0, 1, At, B1); PG8_BAR; PG8_SCHED;
            const bool sw = last && has_next;
            if (sw) { S.a_ready(nxt);
                int t2 = tid; asm volatile("" : "+v"(t2));
                int RA2[2], CA2[2];
#pragma unroll
                for (int i = 0; i < 2; ++i) stage_rc(t2 * 16 + i * 8192, RA2[i], CA2[i]);
                S.avoff(nxt, RA2, CA2, vA); }
            const char* a2 = last ? (sw ? S.abase(nxt) : cA) : cA + (size_t)(t + 2) * kstep;
            const char* b2 = last ? (sw ? S.btile(nxt, 0) : S.btile(cur, 0)) : S.btile(cur, t + 2);
            const char* b3 = last ? (sw ? S.btile(nxt, 1) : S.btile(cur, 1)) : S.btile(cur, t + 3);
            const char* a3 = a2 + kstep;
            PG8_LDA(At, 0, 1); PG8_STAGE(PG8_SB(0, 0), b2, voffB); PG8_STAGE(PG8_SB(0, 1), b2 + hstepB, voffB); PG8_STAGE(PG8_SA(0, 0), a2, vA);
            PG8_WAIT_V(8); PG8_WAIT_L(0); PG8_BAR; PG8_MMA(1, 0, At, B0); PG8_MMA(1, 1, At, B1); PG8_BAR; PG8_SCHED;
            PG8_LDB(B0, 1, 0); PG8_LDB(B1, 1, 1); PG8_SCHED; PG8_LDA(At, 1, 0); PG8_STAGE(PG8_SA(0, 1), a2, vA + 2);
            PG8_WAIT_V(8); PG8_WAIT_L(0); PG8_BAR; PG8_MMA(0, 0, At, B0); PG8_MMA(0, 1, At, B1); PG8_BAR; PG8_SCHED;
            PG8_LDA(At, 1, 1); PG8_STAGE(PG8_SB(1, 0), b3, voffB); PG8_STAGE(PG8_SB(1, 1), b3 + hstepB, voffB); PG8_STAGE(PG8_SA(1, 0), a3, vA);
            PG8_WAIT_V(8); PG8_WAIT_L(0); PG8_BAR; PG8_MMA(1, 0, At, B0); PG8_MMA(1, 1, At, B1); PG8_BAR; PG8_SCHED;
        }
        if constexpr (ALIGN_EPI) { if (wr == 0) PG8_BAR; }
        S.epi(acc, cur, er, wr, wc, fr, fq);
        S.done(cur);
        if (!has_next) break;
#pragma unroll
        for (int a = 0; a < 2; ++a)
#pragma unroll
            for (int b = 0; b < 2; ++b)
#pragma unroll
                for (int m = 0; m < 4; ++m)
#pragma unroll
                    for (int n = 0; n < 2; ++n) acc[a][b][m][n] = (f32x4){0.f, 0.f, 0.f, 0.f};
        cur = nxt; cA = S.abase(cur); ++ui;
        if constexpr (ALIGN_EPI) { if (wr == 1) PG8_BAR; }
    }
    PG8_WAIT_V(0);
    if constexpr (!ALIGN_EPI) { if (wr == 0) PG8_BAR; }
    PG8_BAR;
#undef PG8_SA
#undef PG8_SB
#undef PG8_STAGE
#undef PG8_LDA
#undef PG8_LDB
#undef PG8_MMA
#undef PG8_WAIT_V
#undef PG8_WAIT_L
#undef PG8_BAR
#undef PG8_SCHED
}
typedef int v4i __attribute__((ext_vector_type(4)));
typedef int v8i __attribute__((ext_vector_type(8)));
template <class P, bool ALIGN_EPI>
__device__ __forceinline__ void gemm_phase_f8(LAS unsigned char* lds, const P& S) {
    const int tid = threadIdx.x, wid = __builtin_amdgcn_readfirstlane(tid >> 6), lane = tid & 63, wr = wid >> 2, wc = wid & 3, fr = lane & 15, fq = lane >> 4;
    const int nt = S.nt;
    int RA[2], CA[2]; unsigned voffB[2];
#pragma unroll
    for (int i = 0; i < 2; ++i) { int R, C; stage_rc(tid * 16 + i * 8192, R, C); RA[i] = R; CA[i] = C; const int Rb = P::PERM ? ((R & ~31) + perm32(R & 31)) : R;
        voffB[i] = (unsigned)(Rb * S.ldbB + C * 2); }
    const size_t kstep = (size_t)(BK * 2);
    const size_t hstepB = (size_t)HALF * S.ldbB;
    const unsigned ldsw = (unsigned)wid * 1024u;
    const int aoff0 = lds_byte(wr * 64 + fr, fq * 16), boff0 = lds_byte(wc * 32 + fr, fq * 16);
#define PG8_SA(b, h) (((b) * 2 + (h)) * HTB)
#define PG8_SB(b, h) ((4 + (b) * 2 + (h)) * HTB)
#define PG8_STAGE(bufoff, gbase, voff) do { _Pragma("unroll") for (int _i = 0; _i < 2; ++_i) \
        __builtin_amdgcn_global_load_lds((const unsigned*)((const char*)(gbase) + (voff)[_i]), (LAS unsigned*)(lds + (bufoff) + ldsw + _i * 8192), 16, 0, 0); } while (0)
#define PG8_LDA(dst, b, h) do { _Pragma("unroll") for (int m = 0; m < 4; ++m) { const v4i lo_ = *(const LAS v4i*)(lds + PG8_SA(b, h) + aoff0 + m * 2048), hi_ = *(const LAS v4i*)(lds + PG8_SA(b, h) + aoff0 + m * 2048 + 16); dst[m] = __builtin_shufflevector(lo_, hi_, 0, 1, 2, 3, 4, 5, 6, 7); } } while (0)
#define PG8_LDB(dst, b, h) do { _Pragma("unroll") for (int n = 0; n < 2; ++n) { const v4i lo_ = *(const LAS v4i*)(lds + PG8_SB(b, h) + boff0 + n * 2048), hi_ = *(const LAS v4i*)(lds + PG8_SB(b, h) + boff0 + n * 2048 + 16); dst[n] = __builtin_shufflevector(lo_, hi_, 0, 1, 2, 3, 4, 5, 6, 7); } } while (0)
#define PG8_MMA(ai, bj, At, Bt) do { __builtin_amdgcn_s_setprio(1); _Pragma("unroll") for (int m = 0; m < 4; ++m) _Pragma("unroll") for (int n = 0; n < 2; ++n) \
        acc[ai][bj][m][n] = __builtin_amdgcn_mfma_scale_f32_16x16x128_f8f6f4(Bt[n], At[m], acc[ai][bj][m][n], 0, 0, 0, 0x7f7f7f7f, 0, 0x7f7f7f7f); __builtin_amdgcn_s_setprio(0); } while (0)
#define PG8_WAIT_V(n) asm volatile("s_waitcnt vmcnt(" #n ")" ::: "memory")
#define PG8_WAIT_L(n) asm volatile("s_waitcnt lgkmcnt(" #n ")" ::: "memory")
#define PG8_BAR __builtin_amdgcn_s_barrier()
#define PG8_SCHED __builtin_amdgcn_sched_barrier(0)
    typename P::Unit cur, nxt; int ui = 0;
    if (!S.next(0, cur)) return;
    f32x4 acc[2][2][4][2];
#pragma unroll
    for (int a = 0; a < 2; ++a)
#pragma unroll
        for (int b = 0; b < 2; ++b)
#pragma unroll
            for (int m = 0; m < 4; ++m)
#pragma unroll
                for (int n = 0; n < 2; ++n) acc[a][b][m][n] = (f32x4){0.f, 0.f, 0.f, 0.f};
    v8i At[4], B0[2], B1[2];
    typename P::EpiRegs er;
    unsigned vA[4];
    S.a_ready(cur);
    S.avoff(cur, RA, CA, vA);
    const char* cA = S.abase(cur);
    {
        const char* b0 = S.btile(cur, 0); const char* b1 = S.btile(cur, 1);
        PG8_STAGE(PG8_SB(0, 0), b0, voffB); PG8_STAGE(PG8_SB(0, 1), b0 + hstepB, voffB); PG8_STAGE(PG8_SA(0, 0), cA, vA); PG8_STAGE(PG8_SA(0, 1), cA, vA + 2);
        if (wr == 1) PG8_BAR;
        PG8_WAIT_V(2); PG8_BAR;
        PG8_STAGE(PG8_SB(1, 0), b1, voffB); PG8_STAGE(PG8_SA(1, 0), cA + kstep, vA); PG8_STAGE(PG8_SB(1, 1), b1 + hstepB, voffB);
        PG8_WAIT_V(6); PG8_BAR;
    }
    for (;;) {
        const bool has_next = S.next(ui + 1, nxt);
        unsigned vAn[4] = {0u, 0u, 0u, 0u};
        if (P::VA_LDS && has_next) {
            int t2 = tid; asm volatile("" : "+v"(t2));
            int RA2[2], CA2[2];
#pragma unroll
            for (int i = 0; i < 2; ++i) stage_rc(t2 * 16 + i * 8192, RA2[i], CA2[i]);
            S.avoff(nxt, RA2, CA2, vAn); }
        for (int t = 0; t < nt; t += 2) {
            const bool last = (t == nt - 2);
            const char* a1 = cA + (size_t)(t + 1) * kstep;
            S.khook(t, acc, cur, lds, wr, wc, fr, fq);
            if (last) S.epi_pre(cur, er, wr, wc, fr, fq);
            PG8_LDB(B0, 0, 0); PG8_LDB(B1, 0, 1); PG8_SCHED; PG8_LDA(At, 0, 0); PG8_STAGE(PG8_SA(1, 1), a1, vA + 2);
            PG8_WAIT_V(8); PG8_WAIT_L(0); PG8_BAR; PG8_MMA(0, 0, At, B0); PG8_MMA(0, 1, At, B1); PG8_BAR; PG8_SCHED;
            const bool sw = last && has_next;
            if (sw) { S.a_ready(nxt);
                if (P::VA_LDS) {
#pragma unroll
                    for (int i = 0; i < 4; ++i) vA[i] = vAn[i]; }
                else { int t2 = tid; asm volatile("" : "+v"(t2)); int RA2[2], CA2[2];
#pragma unroll
                    for (int i = 0; i < 2; ++i) stage_rc(t2 * 16 + i * 8192, RA2[i], CA2[i]);
                    S.avoff(nxt, RA2, CA2, vA); } }
            const char* a2 = last ? (sw ? S.abase(nxt) : cA) : cA + (size_t)(t + 2) * kstep;
            const char* b2 = last ? (sw ? S.btile(nxt, 0) : S.btile(cur, 0)) : S.btile(cur, t + 2);
            const char* b3 = last ? (sw ? S.btile(nxt, 1) : S.btile(cur, 1)) : S.btile(cur, t + 3);
            const char* a3 = a2 + kstep;
            PG8_LDA(At, 0, 1); PG8_STAGE(PG8_SB(0, 0), b2, voffB); PG8_STAGE(PG8_SB(0, 1), b2 + hstepB, voffB); PG8_STAGE(PG8_SA(0, 0), a2, vA);
            PG8_WAIT_V(8); PG8_WAIT_L(0); PG8_BAR; PG8_MMA(1, 0, At, B0); PG8_MMA(1, 1, At, B1); PG8_BAR; PG8_SCHED;
            PG8_LDB(B0, 1, 0); PG8_LDB(B1, 1, 1); PG8_SCHED; PG8_LDA(At, 1, 0); PG8_STAGE(PG8_SA(0, 1), a2, vA + 2);
            PG8_WAIT_V(8); PG8_WAIT_L(0); PG8_BAR; PG8_MMA(0, 0, At, B0); PG8_MMA(0, 1, At, B1); PG8_BAR; PG8_SCHED;
            PG8_LDA(At, 1, 1); PG8_STAGE(PG8_SB(1, 0), b3, voffB); PG8_STAGE(PG8_SB(1, 1), b3 + hstepB, voffB); PG8_STAGE(PG8_SA(1, 0), a3, vA);
            PG8_WAIT_V(8); PG8_WAIT_L(0); PG8_BAR; PG8_MMA(1, 0, At, B0); PG8_MMA(1, 1, At, B1); PG8_BAR; PG8_SCHED;
        }
        if constexpr (ALIGN_EPI) { if (wr == 0) PG8_BAR; }
        S.epi(acc, cur, er, wr, wc, fr, fq);
        S.done(cur);
        if (!has_next) break;
#pragma unroll
        for (int a = 0; a < 2; ++a)
#pragma unroll
            for (int b = 0; b < 2; ++b)
#pragma unroll
                for (int m = 0; m < 4; ++m)
#pragma unroll
                    for (int n = 0; n < 2; ++n) acc[a][b][m][n] = (f32x4){0.f, 0.f, 0.f, 0.f};
        cur = nxt; cA = S.abase(cur); ++ui;
        if constexpr (ALIGN_EPI) { if (wr == 1) PG8_BAR; }
    }
    PG8_WAIT_V(0);
    if constexpr (!ALIGN_EPI) { if (wr == 0) PG8_BAR; }
    PG8_BAR;
#undef PG8_SA
#undef PG8_SB
#undef PG8_STAGE
#undef PG8_LDA
#undef PG8_LDB
#undef PG8_MMA
#undef PG8_WAIT_V
#undef PG8_WAIT_L
#undef PG8_BAR
#undef PG8_SCHED
}
}

struct PGemm1 {
    static constexpr bool PERM = true;
    struct EpiRegs {};
    template <class U_> __device__ __forceinline__ void epi_pre(const U_&, EpiRegs&, int, int, int, int) const {}
    struct Unit { int pm, pn, ui; };
    const char* A; const char* B; const char* Bdt; bf16* O; const float* rstd; const LAS float* rstab; float* DT; const float* dtb; int G, c; int ldb, nt;
    __device__ __forceinline__ bool next(int i, Unit& u) const { u.ui = i; return pg8::static_order(65, 19, G, c, i, u.pm, u.pn); }
    __device__ __forceinline__ void avoff(const Unit& u, const int (&RA)[2], const int (&CA)[2], unsigned (&v)[4]) const {
#pragma unroll
        for (int h = 0; h < 2; ++h)
#pragma unroll
            for (int i = 0; i < 2; ++i) { int row = u.pm * 256 + h * 128 + RA[i]; row = row < T ? row : T - 1; v[h * 2 + i] = (unsigned)(row * D + CA[i]) * 2u; }
    }
    __device__ __forceinline__ const char* abase(const Unit&) const { return A; }
    __device__ __forceinline__ const char* btile(const Unit& u, int t) const { return (u.pn < 18 ? B + (size_t)u.pn * 256 * 1024 * 2 : Bdt) + (size_t)t * 64 * 2; }
    __device__ __forceinline__ void khook(int, pg8::Acc&, const Unit&, LAS unsigned char*, int, int, int, int) const {}
    __device__ __forceinline__ void a_ready(const Unit&) const {}
    __device__ __forceinline__ void done(const Unit&) const {}
    __device__ __forceinline__ void epi(const pg8::Acc& acc, const Unit& u, const EpiRegs&, int wr, int wc, int fr, int fq) const {
        const int row0 = u.pm * 256 + wr * 64 + fr, col0 = u.pn * 256 + wc * 32 + 8 * fq;
        float rsv[2][4];
#pragma unroll
        for (int ai = 0; ai < 2; ++ai)
#pragma unroll
            for (int m = 0; m < 4; ++m) rsv[ai][m] = rstab[u.ui * 256 + wr * 64 + fr + ai * 128 + m * 16];
        if (u.pn == 18) {
            if (wc == 0 && fq < 2) { const f32x4 b0 = *(const f32x4*)(dtb + 8 * fq), b1 = *(const f32x4*)(dtb + 8 * fq + 4);
#pragma unroll
                for (int ai = 0; ai < 2; ++ai)
#pragma unroll
                    for (int m = 0; m < 4; ++m) { const int row = row0 + ai * 128 + m * 16;
                        if (row < T) { const float rs = rsv[ai][m]; f32x4 d0 = acc[ai][0][m][0] * rs + b0, d1 = acc[ai][0][m][1] * rs + b1;
#pragma unroll
                            for (int j = 0; j < 4; ++j) { d0[j] = softplus_f(d0[j]); d1[j] = softplus_f(d1[j]); }
                            *(f32x4*)(DT + (size_t)row * 16 + 8 * fq) = d0; *(f32x4*)(DT + (size_t)row * 16 + 8 * fq + 4) = d1; } } }
            return; }
#pragma unroll
        for (int ai = 0; ai < 2; ++ai)
#pragma unroll
            for (int m = 0; m < 4; ++m) { const int row = row0 + ai * 128 + m * 16;
                if (row < T) { const float rs = rsv[ai][m]; bf16* rowp = O + (size_t)row * LDP + col0;
#pragma unroll
                    for (int bj = 0; bj < 2; ++bj) { const f32x4 v0 = acc[ai][bj][m][0] * rs, v1 = acc[ai][bj][m][1] * rs;
                        v4u w; w.x = pg8::cvt_pk_bf16(v0[0], v0[1]); w.y = pg8::cvt_pk_bf16(v0[2], v0[3]); w.z = pg8::cvt_pk_bf16(v1[0], v1[1]); w.w = pg8::cvt_pk_bf16(v1[2], v1[3]);
                        *(v4u*)(rowp + bj * 128) = w; } } }
    }
};
__device__ __forceinline__ void ph_gemm1_pg8(const Args& a, LAS unsigned char* lds, int G) {
    PGemm1 S; S.A = (const char*)a.out; S.B = (const char*)(a.ws + WS_WIN); S.O = (bf16*)(a.ws + WS_PROJ); S.rstd = (const float*)(a.ws + WS_RSTD0); S.Bdt = (const char*)(a.ws + WS_WDTT); S.DT = (float*)(a.ws + WS_DT); S.dtb = a.in[I_DTB];
    S.G = G; S.c = (int)blockIdx.x; S.ldb = 1024; S.nt = 16;
    {
        LAS float* rt = (LAS float*)(lds + LDS_TAB); S.rstab = rt; PGemm1::Unit u;
        __syncthreads();
        for (int i = 0; i < 8 && S.next(i, u); ++i) if (threadIdx.x < 256) { const int row = u.pm * 256 + (int)threadIdx.x; rt[i * 256 + threadIdx.x] = S.rstd[row < T ? row : T - 1]; }
        __syncthreads();
    }
    pg8::gemm_phase<PGemm1, true>(lds, S);
}

__device__ __forceinline__ void ssd_item(const Args& a, LAS unsigned char* lds, int b, int h) {
    const int tid = threadIdx.x, lane = tid & 63;
    constexpr int TB = 64;
    LAS float* xs = (LAS float*)lds;
    LAS float* Bs = xs + TB * 64;
    LAS float* Cs = Bs + TB * 128;
    LAS float* ys = Cs + TB * 128;
    LAS float* dts = ys + TB * 64;
    LAS float* decs = dts + TB;
    bf16* PROJ = (bf16*)(a.ws + WS_PROJ); const float* DT = (const float*)(a.ws + WS_DT); float* SSDSQ = (float*)(a.ws + WS_SSDSQ);
    const int g = h >> 3;
    const float Ah = -__expf(a.in[I_ALOG][h]), Dh = a.in[I_SD][h];
    int ccol = 0, cch = 0; float cw0 = 0.f, cw1 = 0.f, cw2 = 0.f, cw3 = 0.f, cb = 0.f;
    if (tid < 320) {
        if (tid < 64) { ccol = C_X + h * 64 + tid; cch = h * 64 + tid; }
        else if (tid < 192) { ccol = C_B + g * 128 + (tid - 64); cch = 1024 + g * 128 + (tid - 64); }
        else { ccol = C_C + g * 128 + (tid - 192); cch = 1280 + g * 128 + (tid - 192); }
        const float* cw = a.in[I_SCW]; cw0 = cw[cch]; cw1 = cw[1536 + cch]; cw2 = cw[2 * 1536 + cch]; cw3 = cw[3 * 1536 + cch]; cb = a.in[I_SCB][cch];
    }
    const int p = tid >> 3, nq = tid & 7;
    float S[16];
#pragma unroll
    for (int i = 0; i < 16; ++i) S[i] = 0.f;
    const size_t rbase = (size_t)b * LSEQ;
    for (int l0 = 0; l0 < LSEQ; l0 += TB) {
        const int nt = (LSEQ - l0) < TB ? (LSEQ - l0) : TB;
        __syncthreads();
        if (tid < 320) {
            float r0 = l0 >= 3 ? bf2f(PROJ[(rbase + l0 - 3) * LDP + ccol]) : 0.f, r1 = l0 >= 2 ? bf2f(PROJ[(rbase + l0 - 2) * LDP + ccol]) : 0.f, r2 = l0 >= 1 ? bf2f(PROJ[(rbase + l0 - 1) * LDP + ccol]) : 0.f;
            for (int t = 0; t < nt; ++t) {
                const float r3 = bf2f(PROJ[(rbase + l0 + t) * LDP + ccol]);
                const float v = silu_f(cw0 * r0 + cw1 * r1 + cw2 * r2 + cw3 * r3 + cb);
                if (tid < 64) xs[t * 64 + tid] = v; else if (tid < 192) Bs[t * 128 + tid - 64] = v; else Cs[t * 128 + tid - 192] = v;
                r0 = r1; r1 = r2; r2 = r3;
            }
        } else if (tid < 320 + TB) {
            const int t = tid - 320;
            if (t < nt) { const float dt = DT[(rbase + l0 + t) * 16 + h]; dts[t] = dt; decs[t] = __expf(Ah * dt); }
        }
        __syncthreads();
        for (int t = 0; t < nt; ++t) {
            const float xv = xs[t * 64 + p], xdt = xv * dts[t], dec = decs[t];
            float yp = 0.f;
#pragma unroll
            for (int i = 0; i < 16; ++i) { S[i] = dec * S[i] + Bs[t * 128 + nq * 16 + i] * xdt; yp += Cs[t * 128 + nq * 16 + i] * S[i]; }
            yp += __shfl_xor(yp, 1); yp += __shfl_xor(yp, 2); yp += __shfl_xor(yp, 4);
            if (nq == 0) ys[t * 64 + p] = yp + Dh * xv;
        }
        __syncthreads();
        for (int t = tid >> 6; t < nt; t += 8) {
            const size_t row = rbase + l0 + t;
            const float z = bf2f(PROJ[row * LDP + C_Z + h * 64 + lane]);
            const float yg = ys[t * 64 + lane] * silu_f(z);
            PROJ[row * LDP + C_Z + h * 64 + lane] = (bf16)f2bf(yg);
            const float sq = wave_sum(yg * yg);
            if (lane == 0) SSDSQ[row * 16 + h] = sq;
        }
    }
    __syncthreads();
}
__device__ __forceinline__ void lru_item(const Args& a, LAS unsigned char* lds, int b, int h) {
    const int tid = threadIdx.x;
    constexpr int TB = 64;
    LAS float* Wa = (LAS float*)lds;
    LAS float* Wx = Wa + 4096;
    LAS float* xb = Wx + 4096;
    LAS float* as = xb + TB * 64;
    LAS float* us = as + TB * 64;
    bf16* PROJ = (bf16*)(a.ws + WS_PROJ);
    __syncthreads();
    for (int i = tid; i < 4096; i += 512) { Wa[i] = a.in[I_LWA][(size_t)h * 4096 + i]; Wx[i] = a.in[I_LWX][(size_t)h * 4096 + i]; }
    const size_t rbase = (size_t)b * LSEQ;
    float hprev = 0.f;
    const int c = tid & 63, tq = tid >> 6;
    const float* cw = a.in[I_LCW]; const int ch = h * 64 + c;
    const float cw0 = cw[ch], cw1 = cw[1024 + ch], cw2 = cw[2048 + ch], cw3 = cw[3072 + ch], cb = a.in[I_LCB][ch];
    const int gt = tid >> 3, jq = tid & 7;
    for (int l0 = 0; l0 < LSEQ; l0 += TB) {
        const int nt = (LSEQ - l0) < TB ? (LSEQ - l0) : TB;
        __syncthreads();
        for (int t = tq * 8; t < tq * 8 + 8; ++t) if (t < nt) {
            const int l = l0 + t; const size_t row = rbase + l;
            const float r3 = bf2f(PROJ[row * LDP + C_LI + ch]);
            const float r2 = l >= 1 ? bf2f(PROJ[(row - 1) * LDP + C_LI + ch]) : 0.f;
            const float r1 = l >= 2 ? bf2f(PROJ[(row - 2) * LDP + C_LI + ch]) : 0.f;
            const float r0 = l >= 3 ? bf2f(PROJ[(row - 3) * LDP + C_LI + ch]) : 0.f;
            xb[t * 64 + c] = cw0 * r0 + cw1 * r1 + cw2 * r2 + cw3 * r3 + cb;
        }
        __syncthreads();
        if (gt < nt) {
            float ra[8], ri[8];
#pragma unroll
            for (int j = 0; j < 8; ++j) { ra[j] = 0.f; ri[j] = 0.f; }
            for (int i = 0; i < 64; ++i) { const float xv = xb[gt * 64 + i];
#pragma unroll
                for (int j = 0; j < 8; ++j) { ra[j] += xv * Wa[i * 64 + jq * 8 + j]; ri[j] += xv * Wx[i * 64 + jq * 8 + j]; } }
#pragma unroll
            for (int j = 0; j < 8; ++j) { const int cc = h * 64 + jq * 8 + j;
                const float r = sigmoid_f(ra[j] + a.in[I_LBA][cc]), ig = sigmoid_f(ri[j] + a.in[I_LBX][cc]);
                const float log_a = -8.0f * r * softplus_f(-a.in[I_LLAM][cc]);
                const float av = __expf(log_a);
                const float mult = (l0 + gt == 0) ? 1.f : sqrtf(fmaxf(-expm1f(2.f * log_a), 0.f));
                as[gt * 64 + jq * 8 + j] = av; us[gt * 64 + jq * 8 + j] = mult * ig * xb[gt * 64 + jq * 8 + j]; }
        }
        __syncthreads();
        if (tid < 64) { for (int t = 0; t < nt; ++t) { hprev = as[t * 64 + tid] * hprev + us[t * 64 + tid]; us[t * 64 + tid] = hprev; } }
        __syncthreads();
        for (int t = tq * 8; t < tq * 8 + 8; ++t) if (t < nt) {
            const size_t row = rbase + l0 + t;
            const float gv = bf2f(PROJ[row * LDP + C_G + ch]);
            PROJ[row * LDP + C_G + ch] = (bf16)f2bf(us[t * 64 + c] * gelu_tanh_f(gv));
        }
    }
    __syncthreads();
}
__device__ __forceinline__ void ph_mixers(const Args& a, LAS unsigned char* lds, int wk, int nwk) {
    for (int it = wk; it < 256; it += nwk) {
        if (it < 128) ssd_item(a, lds, it >> 4, it & 15); else lru_item(a, lds, (it - 128) >> 4, (it - 128) & 15);
    }
}


__device__ __forceinline__ f32x4 mfma16(bf16x8 a, bf16x8 b, f32x4 c) { return __builtin_amdgcn_mfma_f32_16x16x32_bf16(a, b, c, 0, 0, 0); }
constexpr int RSX = 144, RSB = 272;
constexpr int SO_X = 0, SO_B = SO_X + 128 * RSX, SO_C = SO_B + 128 * RSB, SO_M = SO_C + 128 * RSB, SO_S = SO_M + 128 * RSB, SO_V = SO_S + 64 * RSB;
static_assert(SO_V + 4096 <= LDS_BYTES - 256, "ssd lds");
#define TR4(RS4, o0, o1, o2, o3, addr) do { v2u l0_, h0_, l1_, h1_, l2_, h2_, l3_, h3_; \
    asm volatile("ds_read_b64_tr_b16 %0, %8\n\tds_read_b64_tr_b16 %1, %8 offset:" #RS4 "\n\t" \
                 "ds_read_b64_tr_b16 %2, %8 offset:32\n\tds_read_b64_tr_b16 %3, %8 offset:" #RS4 "+32\n\t" \
                 "ds_read_b64_tr_b16 %4, %8 offset:64\n\tds_read_b64_tr_b16 %5, %8 offset:" #RS4 "+64\n\t" \
                 "ds_read_b64_tr_b16 %6, %8 offset:96\n\tds_read_b64_tr_b16 %7, %8 offset:" #RS4 "+96\n\ts_waitcnt lgkmcnt(0)" \
                 : "=&v"(l0_), "=&v"(h0_), "=&v"(l1_), "=&v"(h1_), "=&v"(l2_), "=&v"(h2_), "=&v"(l3_), "=&v"(h3_) : "v"(addr) : "memory"); \
    o0 = __builtin_bit_cast(bf16x8, (v4u){l0_.x, l0_.y, h0_.x, h0_.y}); o1 = __builtin_bit_cast(bf16x8, (v4u){l1_.x, l1_.y, h1_.x, h1_.y}); \
    o2 = __builtin_bit_cast(bf16x8, (v4u){l2_.x, l2_.y, h2_.x, h2_.y}); o3 = __builtin_bit_cast(bf16x8, (v4u){l3_.x, l3_.y, h3_.x, h3_.y}); } while (0)
#define TR1(RS4, o0, addr) do { v2u l0_, h0_; \
    asm volatile("ds_read_b64_tr_b16 %0, %2\n\tds_read_b64_tr_b16 %1, %2 offset:" #RS4 "\n\ts_waitcnt lgkmcnt(0)" : "=&v"(l0_), "=&v"(h0_) : "v"(addr) : "memory"); \
    o0 = __builtin_bit_cast(bf16x8, (v4u){l0_.x, l0_.y, h0_.x, h0_.y}); } while (0)
__device__ __forceinline__ void unpack8(const v4u r, float (&f)[8]) {
    f[0] = __uint_as_float(r.x << 16); f[1] = __uint_as_float(r.x & 0xffff0000u); f[2] = __uint_as_float(r.y << 16); f[3] = __uint_as_float(r.y & 0xffff0000u);
    f[4] = __uint_as_float(r.z << 16); f[5] = __uint_as_float(r.z & 0xffff0000u); f[6] = __uint_as_float(r.w << 16); f[7] = __uint_as_float(r.w & 0xffff0000u);
}
__device__ __forceinline__ void ph_conv(const Args& a, int wk, int nwk) {
    const bf16* PROJ = (const bf16*)(a.ws + WS_PROJ); bf16* XACT = (bf16*)(a.ws + WS_H);
    for (int id = wk * 512 + (int)threadIdx.x; id < NB * 48 * 192; id += nwk * 512) {
        const int cg = id % 192, rr = id / 192, b = rr / 48, t0 = (rr % 48) * 43;
        const int ch = cg * 8;
        const float* cwp = a.in[I_SCW] + ch;
        float cw[4][8], cb[8];
#pragma unroll
        for (int k = 0; k < 4; ++k) { const f32x4 wa = *(const f32x4*)(cwp + k * 1536), wb = *(const f32x4*)(cwp + k * 1536 + 4);
#pragma unroll
            for (int j = 0; j < 4; ++j) { cw[k][j] = wa[j]; cw[k][4 + j] = wb[j]; } }
        { const float* cbp = a.in[I_SCB] + ch; const f32x4 wa = *(const f32x4*)cbp, wb = *(const f32x4*)(cbp + 4);
#pragma unroll
          for (int j = 0; j < 4; ++j) { cb[j] = wa[j]; cb[4 + j] = wb[j]; } }
        const size_t rb = (size_t)b * LSEQ;
        const bf16* src = PROJ + rb * LDP + 2048 + cg * 8;
        bf16* dst = XACT + rb * 1536 + ch;
        float p0[8], p1[8], p2[8];
        {   v4u q0 = (v4u){0u, 0u, 0u, 0u}, q1 = q0, q2 = q0;
            if (t0 >= 3) { q0 = *(const v4u*)(src + (size_t)(t0 - 3) * LDP); q1 = *(const v4u*)(src + (size_t)(t0 - 2) * LDP); q2 = *(const v4u*)(src + (size_t)(t0 - 1) * LDP); }
            unpack8(q0, p0); unpack8(q1, p1); unpack8(q2, p2); }
#pragma unroll 4
        for (int t = 0; t < 43; ++t) {
            const int l = t0 + t; float p3[8]; unpack8(*(const v4u*)(src + (size_t)l * LDP), p3);
            float o[8];
#pragma unroll
            for (int j = 0; j < 8; ++j) { o[j] = silu_f(cw[0][j] * p0[j] + cw[1][j] * p1[j] + cw[2][j] * p2[j] + cw[3][j] * p3[j] + cb[j]); p0[j] = p1[j]; p1[j] = p2[j]; p2[j] = p3[j]; }
            v4u ov; ov.x = pk2(o[0], o[1]); ov.y = pk2(o[2], o[3]); ov.z = pk2(o[4], o[5]); ov.w = pk2(o[6], o[7]);
            *(v4u*)(dst + (size_t)l * 1536) = ov;
        }
    }
}
__device__ __forceinline__ void ssd_item3(const Args& a, LAS unsigned char* lds, int b, int h) {
    const int tid = threadIdx.x, lane = tid & 63, w = __builtin_amdgcn_readfirstlane(tid >> 6), fr0 = lane & 15, fq0 = lane >> 4;
    bf16* PROJ = (bf16*)(a.ws + WS_PROJ); const bf16* XACT = (const bf16*)(a.ws + WS_H); const float* DT = (const float*)(a.ws + WS_DT); float* SSDSQ = (float*)(a.ws + WS_SSDSQ);
    const int g = h >> 3;
    const float Ah = -__expf(a.in[I_ALOG][h]), Dh = a.in[I_SD][h];
    LAS float* acs = (LAS float*)(lds + SO_V); LAS float* dtv = acs + 128; LAS float* wv = acs + 256; LAS float* eacs = acs + 384;
    const size_t rbase = (size_t)b * LSEQ;
    const int pt_s = w & 3, nh = w >> 2;
    f32x4 sacc[4];
#pragma unroll
    for (int i = 0; i < 4; ++i) sacc[i] = (f32x4){0.f, 0.f, 0.f, 0.f};
    __syncthreads();
    for (int i = tid; i < 64 * RSB / 4; i += 512) ((LAS unsigned*)(lds + SO_S))[i] = 0u;
    v4u pf[10], zp[2]; float d0 = 0.f, d1 = 0.f;
    const int ft = tid >> 2, q4 = tid & 3;
    const int xr_ = tid >> 3, xp_ = tid & 7, br_ = tid >> 4, bp_ = tid & 15;
    const bf16* xsrc = XACT + (rbase + xr_) * 1536 + h * 64 + xp_ * 8;
    const bf16* bsrc = XACT + (rbase + br_) * 1536 + 1024 + g * 128 + bp_ * 8;
#define SSD_PREFETCH_A(L0) do { const int l0_ = (L0); \
        _Pragma("unroll") for (int i = 0; i < 2; ++i) { pf[i] = (v4u){0u, 0u, 0u, 0u}; if (l0_ + xr_ + 64 * i < LSEQ) pf[i] = *(const v4u*)(xsrc + (size_t)(l0_ + 64 * i) * 1536); } \
        _Pragma("unroll") for (int i = 0; i < 4; ++i) { pf[2 + i] = (v4u){0u, 0u, 0u, 0u}; if (l0_ + br_ + 32 * i < LSEQ) pf[2 + i] = *(const v4u*)(bsrc + (size_t)(l0_ + 32 * i) * 1536); } } while (0)
#define SSD_PREFETCH_B(L0) do { const int l0_ = (L0); \
        _Pragma("unroll") for (int i = 0; i < 4; ++i) { pf[6 + i] = (v4u){0u, 0u, 0u, 0u}; if (l0_ + br_ + 32 * i < LSEQ) pf[6 + i] = *(const v4u*)(bsrc + (size_t)(l0_ + 32 * i) * 1536 + 256); } \
        zp[0] = (v4u){0u, 0u, 0u, 0u}; zp[1] = zp[0]; \
        if (l0_ + ft < LSEQ) { const bf16* zq = PROJ + (rbase + l0_ + ft) * LDP + C_Z + h * 64 + 16 * q4; zp[0] = *(const v4u*)zq; zp[1] = *(const v4u*)(zq + 8); } \
        if (w == 0) { d0 = (l0_ + lane) < LSEQ ? DT[(rbase + l0_ + lane) * 16 + h] : 0.f; d1 = (l0_ + lane + 64) < LSEQ ? DT[(rbase + l0_ + lane + 64) * 16 + h] : 0.f; } } while (0)
#define SSD_PREFETCH(L0) do { SSD_PREFETCH_A(L0); SSD_PREFETCH_B(L0); } while (0)
    SSD_PREFETCH(0);
    for (int l0 = 0; l0 < LSEQ; l0 += 128) {
        const int nvalid = (LSEQ - l0) < 128 ? (LSEQ - l0) : 128;
        int fr = fr0, fq = fq0; asm volatile("" : "+v"(fr), "+v"(fq));
#pragma unroll
        for (int i = 0; i < 2; ++i) *(LAS v4u*)(lds + SO_X + (xr_ + 64 * i) * RSX + xp_ * 16) = pf[i];
#pragma unroll
        for (int i = 0; i < 4; ++i) { *(LAS v4u*)(lds + SO_B + (br_ + 32 * i) * RSB + bp_ * 16) = pf[2 + i]; *(LAS v4u*)(lds + SO_C + (br_ + 32 * i) * RSB + bp_ * 16) = pf[6 + i]; }
        const v4u z0 = zp[0], z1 = zp[1];
        if (w == 0) {
            float a0 = Ah * d0, a1 = Ah * d1;
#pragma unroll
            for (int o = 1; o < 64; o <<= 1) { const float v0 = __shfl_up(a0, o), v1 = __shfl_up(a1, o); if (lane >= o) { a0 += v0; a1 += v1; } }
            a1 += __shfl(a0, 63);
            const float aend = __shfl(a1, 63);
            acs[lane] = a0; acs[lane + 64] = a1; dtv[lane] = d0; dtv[lane + 64] = d1;
            wv[lane] = __expf(aend - a0) * d0; wv[lane + 64] = __expf(aend - a1) * d1; eacs[lane] = __expf(a0); eacs[lane + 64] = __expf(a1);
            if (lane == 0) acs[512] = aend;
        }
        __syncthreads();
        if (l0 + 128 < LSEQ) SSD_PREFETCH_A(l0 + 128);
        {
            const int p = w < 4 ? w : 7 - w, R1 = p, R2 = 7 - p, nsl = w < 4 ? 4 : 5;
            int srow[5], sst[5];
#pragma unroll
            for (int i = 0; i < 5; ++i) { if (w < 4) { srow[i] = i <= p ? R1 : R2; sst[i] = i <= p ? i : i - p - 1; } else { srow[i] = R2; sst[i] = 3 - p + i; } }
            f32x4 gacc[5];
#pragma unroll
            for (int i = 0; i < 5; ++i) gacc[i] = (f32x4){0.f, 0.f, 0.f, 0.f};
#pragma unroll
            for (int k0 = 0; k0 < 128; k0 += 32) {
                const bf16x8 c1 = *(const LAS bf16x8*)(lds + SO_C + (16 * R1 + fr) * RSB + (k0 + 8 * fq) * 2), c2 = *(const LAS bf16x8*)(lds + SO_C + (16 * R2 + fr) * RSB + (k0 + 8 * fq) * 2);
                bf16x8 bfv[5];
#pragma unroll
                for (int i = 0; i < 5; ++i) bfv[i] = *(const LAS bf16x8*)(lds + SO_B + (16 * (i < nsl ? sst[i] : 0) + fr) * RSB + (k0 + 8 * fq) * 2);
#pragma unroll
                for (int i = 0; i < 5; ++i) gacc[i] = mfma16(bfv[i], (w < 4 && i <= p) ? c1 : c2, gacc[i]);
            }
#pragma unroll
            for (int i = 0; i < 5; ++i) if (i < nsl) {
                const int l = 16 * srow[i] + fr, s0 = 16 * sst[i] + 4 * fq; const float al = acs[l];
                const f32x4 as = *(const LAS f32x4*)(acs + s0), ds = *(const LAS f32x4*)(dtv + s0);
                float m[4];
#pragma unroll
                for (int j = 0; j < 4; ++j) m[j] = (s0 + j <= l) ? gacc[i][j] * __expf(al - as[j]) * ds[j] : 0.f;
                v2u mv; mv.x = pk2(m[0], m[1]); mv.y = pk2(m[2], m[3]);
                *(LAS v2u*)(lds + SO_M + l * RSB + s0 * 2) = mv;
            }
            { const int Rz = (w < 4) ? R1 : R2; if ((Rz & 1) == 0) *(LAS v2u*)(lds + SO_M + (16 * Rz + fr) * RSB + (16 * (Rz + 1) + 4 * fq) * 2) = (v2u){0u, 0u}; }
        }
        __syncthreads();
        if (l0 + 128 < LSEQ) SSD_PREFETCH_B(l0 + 128);
        {
            f32x4 y[4];
#pragma unroll
            for (int pt = 0; pt < 4; ++pt) y[pt] = (f32x4){0.f, 0.f, 0.f, 0.f};
#pragma unroll
            for (int k0 = 0; k0 < 128; k0 += 32) {
                const bf16x8 cf = *(const LAS bf16x8*)(lds + SO_C + (16 * w + fr) * RSB + (k0 + 8 * fq) * 2);
                bf16x8 sfv[4];
#pragma unroll
                for (int pt = 0; pt < 4; ++pt) sfv[pt] = *(const LAS bf16x8*)(lds + SO_S + (16 * pt + fr) * RSB + (k0 + 8 * fq) * 2);
#pragma unroll
                for (int pt = 0; pt < 4; ++pt) y[pt] = mfma16(cf, sfv[pt], y[pt]);
                __builtin_amdgcn_sched_barrier(0);
            }
            const f32x4 ea = *(const LAS f32x4*)(eacs + 16 * w + 4 * fq);
#pragma unroll
            for (int pt = 0; pt < 4; ++pt) y[pt] *= ea;
            for (int k0 = 0; k0 <= 16 * w + 15; k0 += 32) {
                const bf16x8 mf = *(const LAS bf16x8*)(lds + SO_M + (16 * w + fr) * RSB + (k0 + 8 * fq) * 2);
                const unsigned xa = (unsigned)(size_t)(lds + SO_X) + (unsigned)((k0 + 8 * fq + (fr >> 2)) * RSX + (fr & 3) * 8);
                bf16x8 x0, x1, x2, x3; TR4(576, x0, x1, x2, x3, xa);
                y[0] = mfma16(mf, x0, y[0]); y[1] = mfma16(mf, x1, y[1]); y[2] = mfma16(mf, x2, y[2]); y[3] = mfma16(mf, x3, y[3]);
                __builtin_amdgcn_sched_barrier(0);
            }
#pragma unroll
            for (int pt = 0; pt < 4; ++pt)
#pragma unroll
                for (int r = 0; r < 4; ++r) *(LAS float*)(lds + SO_M + (16 * w + 4 * fq + r) * RSB + (16 * pt + fr) * 4) = y[pt][r];
        }
        {
            const float dec = __expf(acs[512]);
#pragma unroll
            for (int i = 0; i < 4; ++i) sacc[i] *= dec;
#pragma unroll
            for (int k0 = 0; k0 < 128; k0 += 32) {
                const unsigned xa = (unsigned)(size_t)(lds + SO_X) + (unsigned)((k0 + 8 * fq + (fr >> 2)) * RSX + pt_s * 32 + (fr & 3) * 8);
                bf16x8 xf; TR1(576, xf, xa);
                const f32x4 w0 = *(const LAS f32x4*)(wv + k0 + 8 * fq), w1 = *(const LAS f32x4*)(wv + k0 + 8 * fq + 4);
                float xv[8]; unpack8(__builtin_bit_cast(v4u, xf), xv);
                v4u xs; xs.x = pk2(xv[0] * w0[0], xv[1] * w0[1]); xs.y = pk2(xv[2] * w0[2], xv[3] * w0[3]); xs.z = pk2(xv[4] * w1[0], xv[5] * w1[1]); xs.w = pk2(xv[6] * w1[2], xv[7] * w1[3]);
                const bf16x8 xw = __builtin_bit_cast(bf16x8, xs);
                const unsigned ba = (unsigned)(size_t)(lds + SO_B) + (unsigned)((k0 + 8 * fq + (fr >> 2)) * RSB + nh * 128 + (fr & 3) * 8);
                bf16x8 b0, b1, b2, b3; TR4(1088, b0, b1, b2, b3, ba);
                sacc[0] = mfma16(xw, b0, sacc[0]); sacc[1] = mfma16(xw, b1, sacc[1]); sacc[2] = mfma16(xw, b2, sacc[2]); sacc[3] = mfma16(xw, b3, sacc[3]);
                __builtin_amdgcn_sched_barrier(0);
            }
        }
        __syncthreads();
#pragma unroll
        for (int i = 0; i < 4; ++i)
#pragma unroll
            for (int r = 0; r < 4; ++r) *(LAS bf16*)(lds + SO_S + (16 * pt_s + 4 * fq + r) * RSB + (16 * (4 * nh + i) + fr) * 2) = (bf16)f2bf(sacc[i][r]);
        if (ft < nvalid) {
            const size_t row = rbase + l0 + ft;
            bf16* zq = PROJ + row * LDP + C_Z + h * 64 + 16 * q4;
            const v4u x0 = *(const LAS v4u*)(lds + SO_X + ft * RSX + q4 * 32), x1 = *(const LAS v4u*)(lds + SO_X + ft * RSX + q4 * 32 + 16);
            float zf[16], xf[16], yo[16];
            { float tmp[8]; unpack8(z0, tmp);
#pragma unroll
              for (int j = 0; j < 8; ++j) zf[j] = tmp[j];
              unpack8(z1, tmp);
#pragma unroll
              for (int j = 0; j < 8; ++j) zf[8 + j] = tmp[j];
              unpack8(x0, tmp);
#pragma unroll
              for (int j = 0; j < 8; ++j) xf[j] = tmp[j];
              unpack8(x1, tmp);
#pragma unroll
              for (int j = 0; j < 8; ++j) xf[8 + j] = tmp[j]; }
            float sq = 0.f;
#pragma unroll
            for (int j4 = 0; j4 < 4; ++j4) { const f32x4 yv = *(const LAS f32x4*)(lds + SO_M + ft * RSB + (16 * q4 + 4 * j4) * 4);
#pragma unroll
                for (int j = 0; j < 4; ++j) { const float v = (yv[j] + Dh * xf[4 * j4 + j]) * silu_f(zf[4 * j4 + j]); yo[4 * j4 + j] = v; sq += v * v; } }
            v4u o0, o1; o0.x = pk2(yo[0], yo[1]); o0.y = pk2(yo[2], yo[3]); o0.z = pk2(yo[4], yo[5]); o0.w = pk2(yo[6], yo[7]);
            o1.x = pk2(yo[8], yo[9]); o1.y = pk2(yo[10], yo[11]); o1.z = pk2(yo[12], yo[13]); o1.w = pk2(yo[14], yo[15]);
            *(v4u*)zq = o0; *(v4u*)(zq + 8) = o1;
            sq += __shfl_xor(sq, 1); sq += __shfl_xor(sq, 2);
            if (q4 == 0) SSDSQ[row * 16 + h] = sq;
        }
        __syncthreads();
    }
#undef SSD_PREFETCH
#undef SSD_PREFETCH_A
#undef SSD_PREFETCH_B
}
constexpr int LO_XB = 0, LO_XF = LO_XB + 128 * RSX, LO_A = LO_XF + 128 * 260, LO_U = LO_A + 128 * 260, LO_WA = LO_U + 128 * 260, LO_WX = LO_WA + 64 * RSX, LO_SC = LO_WX + 64 * RSX;
static_assert(LO_SC + 17 * 256 <= LDS_BYTES - 256, "lru lds");
__device__ __forceinline__ void lru_item3(const Args& a, LAS unsigned char* lds, int b, int h) {
    const int tid = threadIdx.x, lane0 = tid & 63, w = __builtin_amdgcn_readfirstlane(tid >> 6), fr0 = lane0 & 15, fq0 = lane0 >> 4;
    bf16* PROJ = (bf16*)(a.ws + WS_PROJ);
    const size_t rbase = (size_t)b * LSEQ;
    LAS float* segP = (LAS float*)(lds + LO_SC); LAS float* segH = segP + 512; LAS float* carry = segH + 512;
    __syncthreads();
    for (int i = tid; i < 4096; i += 512) { const int ii = i >> 6, j = i & 63;
        *(LAS bf16*)(lds + LO_WA + j * RSX + ii * 2) = (bf16)f2bf(-1.4426950408889634f * a.in[I_LWA][(size_t)h * 4096 + i]);
        *(LAS bf16*)(lds + LO_WX + j * RSX + ii * 2) = (bf16)f2bf(-1.4426950408889634f * a.in[I_LWX][(size_t)h * 4096 + i]); }
    if (tid < 64) carry[tid] = 0.f;
    float gba[4], gbx[4], gsp[4];
#pragma unroll
    for (int jt = 0; jt < 4; ++jt) { const int c = h * 64 + 16 * jt + fr0; gba[jt] = -1.4426950408889634f * a.in[I_LBA][c]; gbx[jt] = -1.4426950408889634f * a.in[I_LBX][c]; gsp[jt] = -8.0f * softplus_f(-a.in[I_LLAM][c]); }
    const int ft = tid >> 2, q4 = tid & 3;
    const int cg = tid & 7, rg = tid >> 3;
    v4u xp[5], gp[2];
#define LRU_PREFETCH(L0) do { const int l0_ = (L0); \
        _Pragma("unroll") for (int r = 0; r < 5; ++r) { const int l = l0_ + 2 * rg - 3 + r; xp[r] = (v4u){0u, 0u, 0u, 0u}; \
            if (l >= 0 && l < LSEQ) xp[r] = *(const v4u*)(PROJ + (rbase + l) * LDP + C_LI + h * 64 + cg * 8); } \
        gp[0] = (v4u){0u, 0u, 0u, 0u}; gp[1] = gp[0]; \
        if (l0_ + ft < LSEQ) { const bf16* gq = PROJ + (rbase + l0_ + ft) * LDP + C_G + h * 64 + 16 * q4; gp[0] = *(const v4u*)gq; gp[1] = *(const v4u*)(gq + 8); } } while (0)
    LRU_PREFETCH(0);
    for (int l0 = 0; l0 < LSEQ; l0 += 128) {
        const int nvalid = (LSEQ - l0) < 128 ? (LSEQ - l0) : 128;
        int fr = fr0, fq = fq0, lane = lane0; asm volatile("" : "+v"(fr), "+v"(fq), "+v"(lane));
        {
            float cw[4][8], cb[8], p[5][8];
#pragma unroll
            for (int k = 0; k < 4; ++k) { const f32x4 wa = *(const f32x4*)(a.in[I_LCW] + k * 1024 + h * 64 + cg * 8), wb = *(const f32x4*)(a.in[I_LCW] + k * 1024 + h * 64 + cg * 8 + 4);
#pragma unroll
                for (int j = 0; j < 4; ++j) { cw[k][j] = wa[j]; cw[k][4 + j] = wb[j]; } }
            { const f32x4 wa = *(const f32x4*)(a.in[I_LCB] + h * 64 + cg * 8), wb = *(const f32x4*)(a.in[I_LCB] + h * 64 + cg * 8 + 4);
#pragma unroll
              for (int j = 0; j < 4; ++j) { cb[j] = wa[j]; cb[4 + j] = wb[j]; } }
#pragma unroll
            for (int r = 0; r < 5; ++r) unpack8(xp[r], p[r]);
#pragma unroll
            for (int rr = 0; rr < 2; ++rr) { const int t = 2 * rg + rr; float o[8];
#pragma unroll
                for (int j = 0; j < 8; ++j) o[j] = cw[0][j] * p[rr][j] + cw[1][j] * p[rr + 1][j] + cw[2][j] * p[rr + 2][j] + cw[3][j] * p[rr + 3][j] + cb[j];
                v4u ov; ov.x = pk2(o[0], o[1]); ov.y = pk2(o[2], o[3]); ov.z = pk2(o[4], o[5]); ov.w = pk2(o[6], o[7]);
                *(LAS v4u*)(lds + LO_XB + t * RSX + cg * 16) = ov;
}
        }
        const v4u g0 = gp[0], g1 = gp[1];
        __syncthreads();
        if (l0 + 128 < LSEQ) LRU_PREFETCH(l0 + 128);
        {
            f32x4 ga[4], gx[4];
#pragma unroll
            for (int jt = 0; jt < 4; ++jt) { ga[jt] = (f32x4){gba[jt], gba[jt], gba[jt], gba[jt]}; gx[jt] = (f32x4){gbx[jt], gbx[jt], gbx[jt], gbx[jt]}; }
#pragma unroll
            for (int k0 = 0; k0 < 64; k0 += 32) {
                const bf16x8 xf = *(const LAS bf16x8*)(lds + LO_XB + (16 * w + fr) * RSX + (k0 + 8 * fq) * 2);
                bf16x8 wav[4], wxv[4];
#pragma unroll
                for (int jt = 0; jt < 4; ++jt) { wav[jt] = *(const LAS bf16x8*)(lds + LO_WA + (16 * jt + fr) * RSX + (k0 + 8 * fq) * 2); wxv[jt] = *(const LAS bf16x8*)(lds + LO_WX + (16 * jt + fr) * RSX + (k0 + 8 * fq) * 2); }
#pragma unroll
                for (int jt = 0; jt < 4; ++jt) { ga[jt] = mfma16(xf, wav[jt], ga[jt]); gx[jt] = mfma16(xf, wxv[jt], gx[jt]); }
            }
#pragma unroll
            for (int jt = 0; jt < 4; ++jt)
#pragma unroll
                for (int r = 0; r < 4; ++r) { const int l = 16 * w + 4 * fq + r, j = 16 * jt + fr;
                    const float rr = rcp_f(1.f + __builtin_amdgcn_exp2f(ga[jt][r])), ig = rcp_f(1.f + __builtin_amdgcn_exp2f(gx[jt][r]));
                    const float log_a = rr * gsp[jt];
                    const float av = __builtin_amdgcn_exp2f(1.4426950408889634f * log_a);
                    const float t2 = 2.f * log_a;
                    const float om = t2 > -0.1f ? -t2 * (1.f + t2 * (0.5f + t2 * (0.16666667f + t2 * 0.041666668f))) : 1.f - av * av;
                    const float mult = (l0 + l == 0) ? 1.f : __builtin_amdgcn_sqrtf(fmaxf(om, 0.f));
                    const float xv = __uint_as_float((unsigned)*(const LAS unsigned short*)(lds + LO_XB + l * RSX + j * 2) << 16);
                    *(LAS float*)(lds + LO_A + l * 260 + j * 4) = av; *(LAS float*)(lds + LO_U + l * 260 + j * 4) = mult * ig * xv; }
        }
        __syncthreads();
        {
            float P = 1.f, Hl = 0.f;
#pragma unroll
            for (int t = 0; t < 16; ++t) { const float av = *(const LAS float*)(lds + LO_A + (16 * w + t) * 260 + lane * 4), uv = *(const LAS float*)(lds + LO_U + (16 * w + t) * 260 + lane * 4); Hl = av * Hl + uv; P *= av; }
            segP[w * 64 + lane] = P; segH[w * 64 + lane] = Hl;
            __syncthreads();
            float hin = carry[lane];
            for (int s2 = 0; s2 < w; ++s2) hin = segP[s2 * 64 + lane] * hin + segH[s2 * 64 + lane];
#pragma unroll
            for (int t = 0; t < 16; ++t) { LAS float* up = (LAS float*)(lds + LO_U + (16 * w + t) * 260 + lane * 4); hin = *(const LAS float*)(lds + LO_A + (16 * w + t) * 260 + lane * 4) * hin + *up; *up = hin; }
            __syncthreads();
            if (w == 7) carry[lane] = hin;
        }
        if (ft < nvalid) {
            const size_t row = rbase + l0 + ft;
            bf16* gq = PROJ + row * LDP + C_G + h * 64 + 16 * q4;
            float gf[16], yo[16];
            { float tmp[8]; unpack8(g0, tmp);
#pragma unroll
              for (int j = 0; j < 8; ++j) gf[j] = tmp[j];
              unpack8(g1, tmp);
#pragma unroll
              for (int j = 0; j < 8; ++j) gf[8 + j] = tmp[j]; }
#pragma unroll
            for (int j = 0; j < 16; ++j) yo[j] = *(const LAS float*)(lds + LO_U + ft * 260 + (16 * q4 + j) * 4) * gelu_tanh_f(gf[j]);
            v4u o0, o1; o0.x = pk2(yo[0], yo[1]); o0.y = pk2(yo[2], yo[3]); o0.z = pk2(yo[4], yo[5]); o0.w = pk2(yo[6], yo[7]);
            o1.x = pk2(yo[8], yo[9]); o1.y = pk2(yo[10], yo[11]); o1.z = pk2(yo[12], yo[13]); o1.w = pk2(yo[14], yo[15]);
            *(v4u*)gq = o0; *(v4u*)(gq + 8) = o1;
        }
        __syncthreads();
    }
#undef LRU_PREFETCH
}
__device__ __forceinline__ void ph_mixers3(const Args& a, LAS unsigned char* lds, int wk, int nwk) {
    for (int it = wk; it < 256; it += nwk) if (it < 128) ssd_item3(a, lds, it >> 4, it & 15);
    for (int it = wk; it < 256; it += nwk) if (it >= 128) lru_item3(a, lds, (it - 128) >> 4, (it - 128) & 15);
    {
        const int wave = __builtin_amdgcn_readfirstlane((int)threadIdx.x >> 6), lane = (int)threadIdx.x & 63;
        __syncthreads();
        (void)wave; (void)lane;
        convert_experts_dyn(a, 0, lds, (unsigned*)(a.ws + WS_CTL) + 32);
    }
}

constexpr int RW_STRIDE = 2064;
__device__ __forceinline__ void ph_router(const Args& a, LAS unsigned char* lds, int L, int wk, int nwk) {
    const int tid = threadIdx.x, lane = tid & 63, wave = __builtin_amdgcn_readfirstlane(tid >> 6), fr = lane & 15, fq = lane >> 4;
    const int gw = wk * NWAVES + wave, NGW = nwk * NWAVES;
    LAS unsigned char* wl = lds;
    LAS float* sc = (LAS float*)(lds + 99328) + wave * 768;
    LAS int* lcnt = (LAS int*)(lds + 123904); LAS int* gbase = lcnt + 32; LAS int* rinfo = lcnt + 64;
    const v4u* WRT = (const v4u*)(a.ws + WS_WRT) + (size_t)L * 6144;
    __syncthreads();
    for (int i = tid; i < 6144; i += 512) *(LAS v4u*)(wl + (i >> 7) * RW_STRIDE + (i & 127) * 16) = WRT[i];
    if (tid < 32) lcnt[tid] = 0;
    __syncthreads();
    const bf16* HBr = L ? (const bf16*)(a.ws + WS_SB) : (const bf16*)a.out;
    float* RSTD1 = (float*)(a.ws + WS_RSTD1); float* GATES = (float*)(a.ws + WS_GATES); int* LIST = (int*)(a.ws + WS_LIST);
    unsigned* cnt = (unsigned*)(a.ws + WS_CTL) + CW_CNT + 1024 * L;
    const float* bg = a.in[I_RGB] + L * 4; const float* be = a.in[I_REB] + L * 16;
    int it = 0;
    for (int u = gw; u < T / 16; u += NGW, ++it) {
        const int r0 = u * 16;
        const bf16* hrow = HBr + (size_t)(r0 + fr) * D + 8 * fq;
        f32x4 acc[3]; float ss = 0.f;
#pragma unroll
        for (int t = 0; t < 3; ++t) acc[t] = (f32x4){0.f, 0.f, 0.f, 0.f};
#pragma unroll 8
        for (int k0 = 0; k0 < 1024; k0 += 32) {
            const v4u hv = *(const v4u*)(hrow + k0);
            f32x4 h0v, h1v; unpack8v(hv, h0v, h1v);
            ss += (h0v[0] * h0v[0] + h0v[1] * h0v[1] + h0v[2] * h0v[2] + h0v[3] * h0v[3]) + (h1v[0] * h1v[0] + h1v[1] * h1v[1] + h1v[2] * h1v[2] + h1v[3] * h1v[3]);
            const bf16x8 hf = __builtin_bit_cast(bf16x8, hv);
#pragma unroll
            for (int t = 0; t < 3; ++t) { const bf16x8 wf = *(const LAS bf16x8*)(wl + (16 * t + fr) * RW_STRIDE + (k0 + 8 * fq) * 2); acc[t] = mfma16(wf, hf, acc[t]); }
        }
        ss += __shfl_xor(ss, 16); ss += __shfl_xor(ss, 32);
        const float rstd = rsqrtf(ss * (1.f / D) + EPS);
#pragma unroll
        for (int t = 0; t < 3; ++t)
#pragma unroll
            for (int r = 0; r < 4; ++r) sc[fr * 48 + 16 * t + 4 * fq + r] = acc[t][r];
        LDS_WAIT();
        if (lane < 16) {
            const int row = r0 + lane;
            float lg[20];
#pragma unroll
            for (int j = 0; j < 20; ++j) lg[j] = (sc[lane * 48 + j] + sc[lane * 48 + 20 + j]) * rstd + (j < 4 ? bg[j] : be[j - 4]);
            int gs = 0; float gm = lg[0];
#pragma unroll
            for (int j = 1; j < 4; ++j) if (lg[j] > gm) { gm = lg[j]; gs = j; }
            const float pg = 1.f / (__expf(lg[0] - gm) + __expf(lg[1] - gm) + __expf(lg[2] - gm) + __expf(lg[3] - gm));
            float f[4];
#pragma unroll
            for (int i = 0; i < 4; ++i) f[i] = gs == 0 ? lg[4 + i] : (gs == 1 ? lg[8 + i] : (gs == 2 ? lg[12 + i] : lg[16 + i]));
            int i0 = 0; float m0 = f[0];
#pragma unroll
            for (int i = 1; i < 4; ++i) if (f[i] > m0) { m0 = f[i]; i0 = i; }
            int i1 = -1; float m1 = -3.0e38f;
#pragma unroll
            for (int i = 0; i < 4; ++i) if (i != i0 && f[i] > m1) { m1 = f[i]; i1 = i; }
            const float w0 = 1.f / (1.f + __expf(m1 - m0)), w1 = 1.f - w0;
            const int lo = i0 < i1 ? i0 : i1, hi = i0 < i1 ? i1 : i0;
            const float glo = pg * (i0 < i1 ? w0 : w1), ghi = pg * (i0 < i1 ? w1 : w0);
            const int pair = lo == 0 ? hi - 1 : (lo == 1 ? hi + 1 : 5);
            const int bk = gs * 6 + pair;
            const int ls = __hip_atomic_fetch_add(lcnt + bk, 1, __ATOMIC_RELAXED, __HIP_MEMORY_SCOPE_WORKGROUP);
            rinfo[(it * NWAVES + wave) * 16 + lane] = bk | (ls << 8);
            RSTD1[row] = rstd; GATES[(size_t)row * 2] = glo; GATES[(size_t)row * 2 + 1] = ghi;
        }
        LDS_WAIT();
    }
    __syncthreads();
    if (tid < NBK) gbase[tid] = (int)atomicAdd(cnt + 32 * tid, (unsigned)lcnt[tid]);
    __syncthreads();
    it = 0;
    for (int u = gw; u < T / 16; u += NGW, ++it)
        if (lane < 16) { const int info = rinfo[(it * NWAVES + wave) * 16 + lane], bk = info & 255; LIST[(size_t)bk * T + gbase[bk] + (info >> 8)] = u * 16 + lane; }
}

struct BkTab { int cnt[NBK], off[NBK], ust[NBK + 1]; };
__device__ __forceinline__ void bk_table(const Args& a, LAS unsigned char* lds, int L, int per_tile  ) {
    LAS int* tb = (LAS int*)lds;
    __syncthreads();
    if (threadIdx.x == 0) {
        const unsigned* cnt = (const unsigned*)(a.ws + WS_CTL) + CW_CNT + 1024 * L;
        int off = 0, us = 0;
        for (int i = 0; i < NBK; ++i) { const int c = (int)__hip_atomic_load(cnt + 32 * i, __ATOMIC_RELAXED, __HIP_MEMORY_SCOPE_AGENT);
            tb[i] = c; tb[NBK + i] = off; tb[2 * NBK + i] = us; off += (c + 255) & ~255; us += ((c + 63) >> 6) * per_tile; }
        tb[2 * NBK + NBK] = us;
    }
    __syncthreads();
}
__device__ __forceinline__ void bk_experts(int bk, int& elo, int& ehi) {
    const int g = bk / 6, pr = bk - g * 6;
    const int lo = pr < 3 ? 0 : (pr < 5 ? 1 : 2), hi = pr < 3 ? pr + 1 : (pr < 5 ? pr - 1 : 3);
    elo = g * 4 + lo; ehi = g * 4 + hi;
}
__device__ __forceinline__ void ph_moe_up(const Args& a, LAS unsigned char* lds, int L, int wk, int nwk) {
    const int tid = threadIdx.x, lane = tid & 63, wave = __builtin_amdgcn_readfirstlane(tid >> 6), fr = lane & 15, fq = lane >> 4;
    const int gw = wk * NWAVES + wave, NGW = nwk * NWAVES;
    bk_table(a, lds, L, 32);
    LAS int* tb = (LAS int*)lds;
    const bf16* HB = (const bf16*)a.out; const bf16* WGU = (const bf16*)(a.ws + WS_WGU); bf16* HID = (bf16*)(a.ws + WS_HID);
    const int* LIST = (const int*)(a.ws + WS_LIST); const float* RSTD1 = (const float*)(a.ws + WS_RSTD1); const float* GATES = (const float*)(a.ws + WS_GATES);
    const int nun = tb[2 * NBK + NBK];
    for (int u = gw; u < nun; u += NGW) {
        int bk = 0;
        for (int i = 1; i < NBK; ++i) if (u >= tb[2 * NBK + i]) bk = i;
        const int cnt = tb[bk], off = tb[NBK + bk], r = u - tb[2 * NBK + bk];
        const int rt = r >> 5, ek = (r >> 4) & 1, ct = r & 15;
        int elo, ehi; bk_experts(bk, elo, ehi); const int e = ek ? ehi : elo;
        const int c0 = ct * 32, brow = e * 1024 + (c0 >> 7) * 256 + (c0 & 127);
        const bf16* arow[4]; int tok[4];
#pragma unroll
        for (int mi = 0; mi < 4; ++mi) { int rr = rt * 64 + 16 * mi + fr; if (rr >= cnt) rr = cnt - 1; tok[mi] = LIST[(size_t)bk * T + rr]; arow[mi] = HB + (size_t)tok[mi] * D; }
        f32x4 acc[4][4]; zero_acc(acc);
        sg_kloop<4>(1024, arow, [=](int n, int k0) { return WGU + (size_t)(brow + (n < 32 ? n : n + 96)) * 1024 + k0; }, NoKS(), acc, fr, fq);
#pragma unroll
        for (int mi = 0; mi < 4; ++mi) { const int rr = rt * 64 + 16 * mi + fr;
            if (rr < cnt) { const float rs = RSTD1[tok[mi]], gt = GATES[(size_t)tok[mi] * 2 + ek];
#pragma unroll
                for (int nj = 0; nj < 2; ++nj) { const f32x4 gv = acc[mi][nj] * rs, uv = acc[mi][nj + 2] * rs; f32x4 hv;
                    hv.x = silu_f(gv.x) * uv.x * gt; hv.y = silu_f(gv.y) * uv.y * gt; hv.z = silu_f(gv.z) * uv.z * gt; hv.w = silu_f(gv.w) * uv.w * gt;
                    v2u w; w.x = pk2(hv.x, hv.y); w.y = pk2(hv.z, hv.w);
                    *(v2u*)(HID + (size_t)(off + rr) * 1024 + ek * 512 + c0 + 16 * nj + 4 * fq) = w; } } }
    }
}
__device__ __forceinline__ void ph_moe_down(const Args& a, LAS unsigned char* lds, int L, int wk, int nwk) {
    const int tid = threadIdx.x, lane = tid & 63, wave = __builtin_amdgcn_readfirstlane(tid >> 6), fr = lane & 15, fq = lane >> 4;
    const int gw = wk * NWAVES + wave, NGW = nwk * NWAVES;
    bk_table(a, lds, L, 16);
    LAS int* tb = (LAS int*)lds;
    const bf16* HID = (const bf16*)(a.ws + WS_HID); const bf16* WD = (const bf16*)(a.ws + WS_WD);
    float* H = (float*)(a.ws + WS_H); bf16* HB = (bf16*)a.out; const int* LIST = (const int*)(a.ws + WS_LIST);
    const int nun = tb[2 * NBK + NBK];
    for (int u = gw; u < nun; u += NGW) {
        int bk = 0;
        for (int i = 1; i < NBK; ++i) if (u >= tb[2 * NBK + i]) bk = i;
        const int cnt = tb[bk], off = tb[NBK + bk], r = u - tb[2 * NBK + bk];
        const int rt = r >> 4, ct = r & 15;
        int elo, ehi; bk_experts(bk, elo, ehi);
        const bf16* arow[4];
#pragma unroll
        for (int mi = 0; mi < 4; ++mi) arow[mi] = HID + (size_t)(off + rt * 64 + 16 * mi + fr) * 1024;
        f32x4 acc[4][4]; zero_acc(acc);
        sg_kloop<4>(1024, arow, [=](int n, int k0) { return WD + ((size_t)((k0 < 512 ? elo : ehi) * 1024 + ct * 64 + n)) * 512 + (k0 & 511); }, NoKS(), acc, fr, fq);
#pragma unroll
        for (int mi = 0; mi < 4; ++mi) { const int rr = rt * 64 + 16 * mi + fr;
            if (rr < cnt) { const int tok = LIST[(size_t)bk * T + rr];
#pragma unroll
                for (int nj = 0; nj < 4; ++nj) { const int c = ct * 64 + 16 * nj + 4 * fq; float* hp = H + (size_t)tok * D + c;
                    const f32x4 v = *(const f32x4*)hp + acc[mi][nj]; *(f32x4*)hp = v;
                    v2u w; w.x = pk2(v.x, v.y); w.y = pk2(v.z, v.w); *(v2u*)(HB + (size_t)tok * D + c) = w; } } }
    }
}


__device__ __forceinline__ void hb_store4(bf16* HB, int row, int col, const f32x4 v) {
    v2u w; w.x = pg8::cvt_pk_bf16(v[0], v[1]); w.y = pg8::cvt_pk_bf16(v[2], v[3]); *(v2u*)(HB + (size_t)row * D + col) = w;
}
__device__ __forceinline__ void hb_store8(bf16* HB, int row, int col, const f32x4 v0, const f32x4 v1) {
    v4u w; w.x = pg8::cvt_pk_bf16(v0[0], v0[1]); w.y = pg8::cvt_pk_bf16(v0[2], v0[3]); w.z = pg8::cvt_pk_bf16(v1[0], v1[1]); w.w = pg8::cvt_pk_bf16(v1[2], v1[3]);
    *(v4u*)(HB + (size_t)row * D + col) = w;
}

struct PGemm2 {
    static constexpr bool PERM = true;
    struct EpiRegs {};
    template <class U_> __device__ __forceinline__ void epi_pre(const U_&, EpiRegs&, int, int, int, int) const {}
    struct Unit { int pm, pn, ui; };
    const Args* ap; const char* A; const char* B; bf16* HB; unsigned char* X8; int G, c; int ldb, nt;
    __device__ __forceinline__ bool next(int i, Unit& u) const { u.ui = i; return pg8::static_order(64, 4, G, c, i, u.pm, u.pn); }
    __device__ __forceinline__ void avoff(const Unit& u, const int (&RA)[2], const int (&CA)[2], unsigned (&v)[4]) const {
#pragma unroll
        for (int h = 0; h < 2; ++h)
#pragma unroll
            for (int i = 0; i < 2; ++i) { const int row = u.pm * 256 + h * 128 + RA[i]; v[h * 2 + i] = (unsigned)(row * LDP + CA[i]) * 2u; }
    }
    __device__ __forceinline__ const char* abase(const Unit&) const { return A; }
    __device__ __forceinline__ const char* btile(const Unit& u, int t) const { return B + ((size_t)u.pn * 256 * 2048 + (size_t)t * 64) * 2; }
    __device__ __forceinline__ void a_ready(const Unit&) const {}
    __device__ __forceinline__ void done(const Unit&) const {}
    __device__ __forceinline__ void khook(int t, pg8::Acc& acc, const Unit& u, LAS unsigned char* lds, int wr, int wc, int fr, int fq) const {
        if (t == 8 || t == 16) {
            const LAS float* ft = (const LAS float*)(lds + LDS_TAB) + u.ui * 512 + (t == 16 ? 1 : 0);
#pragma unroll
            for (int ai = 0; ai < 2; ++ai)
#pragma unroll
                for (int m = 0; m < 4; ++m) { const float f = ft[(ai * 128 + wr * 64 + m * 16 + fr) * 2];
#pragma unroll
                    for (int bj = 0; bj < 2; ++bj)
#pragma unroll
                        for (int n = 0; n < 2; ++n) acc[ai][bj][m][n] *= f; }
        }
    }
    __device__ __forceinline__ void epi(const pg8::Acc& acc, const Unit& u, const EpiRegs&, int wr, int wc, int fr, int fq) const {
        const int row0 = u.pm * 256 + wr * 64 + fr, col0 = u.pn * 256 + wc * 32 + 8 * fq;
#pragma unroll
        for (int hf = 0; hf < 2; ++hf) {
            v4u res[4][2];
#pragma unroll
            for (int g4 = 0; g4 < 4; ++g4)
#pragma unroll
                for (int bj = 0; bj < 2; ++bj) res[g4][bj] = *(const v4u*)(HB + (size_t)(row0 + hf * 128 + g4 * 16) * D + col0 + bj * 128);
#pragma unroll
            for (int g4 = 0; g4 < 4; ++g4)
#pragma unroll
                for (int bj = 0; bj < 2; ++bj) { f32x4 h0v, h1v; unpack8v(res[g4][bj], h0v, h1v); const f32x4 o0 = acc[hf][bj][g4][0] + h0v, o1 = acc[hf][bj][g4][1] + h1v; hb_store8(HB, row0 + hf * 128 + g4 * 16, col0 + bj * 128, o0, o1);
                    if (MOE_UP_F8) x8_store8(X8, row0 + hf * 128 + g4 * 16, col0 + bj * 128, o0, o1); }
        }
    }
};
__device__ __forceinline__ void ssd_factors(const float* SSDSQ, int row, float& f0, float& f1) {
    const f32x4* sq = (const f32x4*)(SSDSQ + (size_t)row * 16); const f32x4 q0 = sq[0], q1 = sq[1], q2 = sq[2], q3 = sq[3];
    const float s0 = (q0.x + q0.y + q0.z + q0.w) + (q1.x + q1.y + q1.z + q1.w), s1 = (q2.x + q2.y + q2.z + q2.w) + (q3.x + q3.y + q3.z + q3.w);
    const float r0 = rsqrtf(s0 * (1.f / 512.f) + EPS), r1 = rsqrtf(s1 * (1.f / 512.f) + EPS);
    f0 = r0 / r1; f1 = r1;
}
__device__ __forceinline__ void ph_gemm2_pg8(const Args& a, LAS unsigned char* lds, int wk, int G) {
    const int tid = threadIdx.x, lane = tid & 63, wave = __builtin_amdgcn_readfirstlane(tid >> 6), fr = lane & 15, fq = lane >> 4;
    const float* SSDSQ = (const float*)(a.ws + WS_SSDSQ);
    PGemm2 S; S.ap = &a; S.A = (const char*)(a.ws + WS_PROJ); S.B = (const char*)(a.ws + WS_WOUT); S.HB = (bf16*)a.out; S.X8 = a.ws + WS_X8;
    S.G = G; S.c = (int)blockIdx.x; S.ldb = 2048; S.nt = 32;
    {
        LAS float* ft = (LAS float*)(lds + LDS_TAB);
        PGemm2::Unit u;
        for (int i = 0; i < 4 && S.next(i, u); ++i)
            if (tid < 256) { float f0, f1; ssd_factors(SSDSQ, u.pm * 256 + tid, f0, f1); ft[i * 512 + tid * 2] = f0; ft[i * 512 + tid * 2 + 1] = f1; }
        __syncthreads();
    }
    pg8::gemm_phase<PGemm2, true>(lds, S);
    const bf16* PROJ = (const bf16*)(a.ws + WS_PROJ); const bf16* WOUT = (const bf16*)(a.ws + WS_WOUT);
    for (int piece = wk; piece < 256; piece += G) {
        const int rb = piece >> 5, cb = piece & 31, kb = wave * 256, row = 16384 + rb * 16 + fr;
        const bf16* ar = PROJ + (size_t)row * LDP + kb + 8 * fq;
        const bf16* br = WOUT + (size_t)(cb * 32 + fr) * 2048 + kb + 8 * fq;
        f32x4 acc0 = (f32x4){0.f, 0.f, 0.f, 0.f}, acc1 = acc0;
        bf16x8 av[8], b0v[8], b1v[8];
#pragma unroll
        for (int ks = 0; ks < 8; ++ks) { av[ks] = *(const bf16x8*)(ar + 32 * ks); b0v[ks] = *(const bf16x8*)(br + 32 * ks); b1v[ks] = *(const bf16x8*)(br + 16 * 2048 + 32 * ks); }
#pragma unroll
        for (int ks = 0; ks < 8; ++ks) { acc0 = mfma16(b0v[ks], av[ks], acc0); acc1 = mfma16(b1v[ks], av[ks], acc1); }
        float f0, f1; ssd_factors(SSDSQ, row, f0, f1);
        const float sc = wave < 2 ? f0 * f1 : (wave < 4 ? f1 : 1.f);
        LAS float* part = (LAS float*)lds + wave * 512;
        __syncthreads();
        *(LAS f32x4*)(part + fr * 32 + 4 * fq) = acc0 * sc; *(LAS f32x4*)(part + fr * 32 + 16 + 4 * fq) = acc1 * sc;
        __syncthreads();
        if (tid < 128) { const int r = tid >> 3, c4 = (tid & 7) * 4; f32x4 sv = *(const LAS f32x4*)((LAS float*)lds + r * 32 + c4);
#pragma unroll
            for (int w2 = 1; w2 < 8; ++w2) sv += *(const LAS f32x4*)((LAS float*)lds + w2 * 512 + r * 32 + c4);
            const int orow = 16384 + rb * 16 + r, col = cb * 32 + c4;
            const v2u hq = *(const v2u*)(S.HB + (size_t)orow * D + col); f32x4 hv; hv[0] = __uint_as_float(hq.x << 16); hv[1] = __uint_as_float(hq.x & 0xffff0000u); hv[2] = __uint_as_float(hq.y << 16); hv[3] = __uint_as_float(hq.y & 0xffff0000u);
            const f32x4 ov = sv + hv; hb_store4(S.HB, orow, col, ov);
            if (MOE_UP_F8) *(unsigned*)(S.X8 + (size_t)orow * 1024 + col) = pack_fp8x4(ov[0], ov[1], ov[2], ov[3]); }
        __syncthreads();
    }
}

struct BkInfo { int bk, rt, cnt, off; };
__device__ __forceinline__ void bk_table256(const Args& a, LAS unsigned char* lds, int L) {
    LAS int* tb = (LAS int*)(lds + LDS_TAB);
    __syncthreads();
    if (threadIdx.x == 0) {
        const unsigned* cnt = (const unsigned*)(a.ws + WS_CTL) + CW_CNT + 1024 * L;
        int off = 0, rts = 0;
        for (int i = 0; i < NBK; ++i) { const int c = (int)__hip_atomic_load(cnt + 32 * i, __ATOMIC_RELAXED, __HIP_MEMORY_SCOPE_AGENT);
            tb[i] = c; tb[NBK + i] = off; tb[2 * NBK + i] = rts; off += (c + 255) & ~255; rts += (c + 255) >> 8; }
        tb[2 * NBK + NBK] = rts;
    }
    __syncthreads();
}
__device__ __forceinline__ bool bk_find(const LAS int* tb, int rti, BkInfo& o) {
    if (rti >= tb[2 * NBK + NBK]) return false;
    int bk = 0;
    for (int i = 1; i < NBK; ++i) if (rti >= tb[2 * NBK + i]) bk = i;
    o.bk = __builtin_amdgcn_readfirstlane(bk); o.rt = __builtin_amdgcn_readfirstlane(rti - tb[2 * NBK + bk]); o.cnt = __builtin_amdgcn_readfirstlane(tb[bk]); o.off = __builtin_amdgcn_readfirstlane(tb[NBK + bk]); return true;
}
struct PMoeUp {
    static constexpr bool PERM = true;
    struct EpiRegs {};
    template <class U_> __device__ __forceinline__ void epi_pre(const U_&, EpiRegs&, int, int, int, int) const {}
    struct Unit { int bk, rt, cnt, off, e, ek, pnl, ui, rti; };
    const char* A; const char* B; bf16* HID; const float* rstd; const float* gates; const LAS int* tb; const LAS int* rowtab; const LAS float* rgtab; unsigned* ctr; int G, c; int ldb, nt;
    __device__ __forceinline__ bool next(int i, Unit& u) const {
        const int Lu = i * G + c; BkInfo o; if (!bk_find(tb, Lu >> 3, o)) return false;
        u.bk = o.bk; u.rt = o.rt; u.cnt = o.cnt; u.off = o.off; u.ek = (Lu >> 2) & 1; u.pnl = Lu & 3; u.ui = i; u.rti = Lu >> 3;
        int elo, ehi; bk_experts(o.bk, elo, ehi); u.e = u.ek ? ehi : elo; return true;
    }
    __device__ __forceinline__ void avoff(const Unit& u, const int (&RA)[2], const int (&CA)[2], unsigned (&v)[4]) const {
#pragma unroll
        for (int h = 0; h < 2; ++h)
#pragma unroll
            for (int i = 0; i < 2; ++i) { const int tok = rowtab[u.ui * 256 + h * 128 + RA[i]]; v[h * 2 + i] = (unsigned)(tok * D + CA[i]) * 2u; }
    }
    __device__ __forceinline__ const char* abase(const Unit&) const { return A; }
    __device__ __forceinline__ const char* btile(const Unit& u, int t) const { return B + ((size_t)(u.e * 1024 + u.pnl * 256) * 1024 + (size_t)t * 64) * 2; }
    __device__ __forceinline__ void khook(int, pg8::Acc&, const Unit&, LAS unsigned char*, int, int, int, int) const {}
    __device__ __forceinline__ void a_ready(const Unit&) const {}
    __device__ __forceinline__ void done(const Unit& u) const {
        asm volatile("s_waitcnt vmcnt(0)" ::: "memory");
        if ((threadIdx.x & 63) == 0) __hip_atomic_fetch_add(ctr + 32 * u.rti, 1u, __ATOMIC_RELAXED, __HIP_MEMORY_SCOPE_AGENT);
    }
    __device__ __forceinline__ void epi(const pg8::Acc& acc, const Unit& u, const EpiRegs&, int wr, int wc, int fr, int fq) const {
        const int r0 = wr * 64 + fr, col0 = u.ek * 512 + u.pnl * 128 + wc * 32 + 8 * fq;
        float rsv[2][4], gtv[2][4];
#pragma unroll
        for (int ai = 0; ai < 2; ++ai)
#pragma unroll
            for (int m = 0; m < 4; ++m) { const LAS float* rg = rgtab + (u.ui * 256 + r0 + ai * 128 + m * 16) * 2; rsv[ai][m] = rg[0]; gtv[ai][m] = rg[1]; }
#pragma unroll
        for (int ai = 0; ai < 2; ++ai)
#pragma unroll
            for (int m = 0; m < 4; ++m) { const int rr = u.rt * 256 + r0 + ai * 128 + m * 16;
                const float rs = rsv[ai][m], gt = gtv[ai][m]; float hv[8];
#pragma unroll
                for (int n = 0; n < 2; ++n)
#pragma unroll
                    for (int j = 0; j < 4; ++j) { const float g = acc[ai][0][m][n][j] * rs, uu = acc[ai][1][m][n][j] * rs; hv[n * 4 + j] = silu_f(g) * uu * gt; }
#if MOE_DOWN_F8
                { unsigned long long* hp = (unsigned long long*)((unsigned char*)HID + (size_t)(u.off + rr) * 1024 + col0);
                  const unsigned lo = pack_fp8x4(hv[0] * 16.f, hv[1] * 16.f, hv[2] * 16.f, hv[3] * 16.f), hi = pack_fp8x4(hv[4] * 16.f, hv[5] * 16.f, hv[6] * 16.f, hv[7] * 16.f);
                  __hip_atomic_store(hp, (unsigned long long)lo | ((unsigned long long)hi << 32), __ATOMIC_RELAXED, __HIP_MEMORY_SCOPE_AGENT); }
#else
                v4u w; w.x = pg8::cvt_pk_bf16(hv[0], hv[1]); w.y = pg8::cvt_pk_bf16(hv[2], hv[3]); w.z = pg8::cvt_pk_bf16(hv[4], hv[5]); w.w = pg8::cvt_pk_bf16(hv[6], hv[7]);
                const bf16* hp = HID + (size_t)(u.off + rr) * 1024 + col0;
                asm volatile("global_store_dwordx4 %0, %1, off sc1\n\ts_nop 1" :: "v"(hp), "v"(w) : "memory");
#endif
            }
    }
};
struct PMoeUp8 {
    static constexpr bool VA_LDS = true;
    static constexpr bool PERM = true;
    struct EpiRegs {};
    template <class U_> __device__ __forceinline__ void epi_pre(const U_&, EpiRegs&, int, int, int, int) const {}
    struct Unit { int bk, rt, cnt, off, e, ek, pnl, ui, rti; };
    const char* A; const char* B; bf16* HID; const float* rstd; const float* gates; const LAS int* tb; const LAS int* rowtab; const LAS float* rgtab; unsigned* ctr; int G, c; int ldbB, nt;
    __device__ __forceinline__ bool next(int i, Unit& u) const {
        const int Lu = i * G + c; BkInfo o; if (!bk_find(tb, Lu >> 3, o)) return false;
        u.bk = o.bk; u.rt = o.rt; u.cnt = o.cnt; u.off = o.off; u.ek = (Lu >> 2) & 1; u.pnl = Lu & 3; u.ui = i; u.rti = Lu >> 3;
        int elo, ehi; bk_experts(o.bk, elo, ehi); u.e = u.ek ? ehi : elo; return true;
    }
    __device__ __forceinline__ void avoff(const Unit& u, const int (&RA)[2], const int (&CA)[2], unsigned (&v)[4]) const {
#pragma unroll
        for (int h = 0; h < 2; ++h)
#pragma unroll
            for (int i = 0; i < 2; ++i) { const int tok = rowtab[u.ui * 256 + h * 128 + RA[i]]; v[h * 2 + i] = (unsigned)(tok * 1024 + CA[i] * 2); }
    }
    __device__ __forceinline__ const char* abase(const Unit&) const { return A; }
    __device__ __forceinline__ const char* btile(const Unit& u, int t) const { return B + (size_t)(u.e * 1024 + u.pnl * 256) * 1024 + (size_t)t * 128; }
    __device__ __forceinline__ void khook(int, pg8::Acc&, const Unit&, LAS unsigned char*, int, int, int, int) const {}
    __device__ __forceinline__ void a_ready(const Unit&) const {}
    __device__ __forceinline__ void done(const Unit& u) const {
        asm volatile("s_waitcnt vmcnt(0)" ::: "memory");
        if ((threadIdx.x & 63) == 0) __hip_atomic_fetch_add(ctr + 32 * u.rti, 1u, __ATOMIC_RELAXED, __HIP_MEMORY_SCOPE_AGENT);
    }
    __device__ __forceinline__ void epi(const pg8::Acc& acc, const Unit& u, const EpiRegs&, int wr, int wc, int fr, int fq) const {
        const int r0 = wr * 64 + fr, col0 = u.ek * 512 + u.pnl * 128 + wc * 32 + 8 * fq;
        float rsv[2][4], gtv[2][4];
#pragma unroll
        for (int ai = 0; ai < 2; ++ai)
#pragma unroll
            for (int m = 0; m < 4; ++m) { const LAS float* rg = rgtab + (u.ui * 256 + r0 + ai * 128 + m * 16) * 2; rsv[ai][m] = rg[0]; gtv[ai][m] = rg[1]; }
#pragma unroll
        for (int ai = 0; ai < 2; ++ai)
#pragma unroll
            for (int m = 0; m < 4; ++m) { const int rr = u.rt * 256 + r0 + ai * 128 + m * 16;
                const float rs = rsv[ai][m] * 0.03125f, gt = gtv[ai][m]; float hv[8];
#pragma unroll
                for (int n = 0; n < 2; ++n)
#pragma unroll
                    for (int j = 0; j < 4; ++j) { const float g = acc[ai][0][m][n][j] * rs, uu = acc[ai][1][m][n][j] * rs; hv[n * 4 + j] = silu_f(g) * uu * gt; }
#if MOE_DOWN_F8
                { unsigned long long* hp = (unsigned long long*)((unsigned char*)HID + (size_t)(u.off + rr) * 1024 + col0);
                  const unsigned lo = pack_fp8x4(hv[0] * 16.f, hv[1] * 16.f, hv[2] * 16.f, hv[3] * 16.f), hi = pack_fp8x4(hv[4] * 16.f, hv[5] * 16.f, hv[6] * 16.f, hv[7] * 16.f);
                  __hip_atomic_store(hp, (unsigned long long)lo | ((unsigned long long)hi << 32), __ATOMIC_RELAXED, __HIP_MEMORY_SCOPE_AGENT); }
#else
                v4u w; w.x = pg8::cvt_pk_bf16(hv[0], hv[1]); w.y = pg8::cvt_pk_bf16(hv[2], hv[3]); w.z = pg8::cvt_pk_bf16(hv[4], hv[5]); w.w = pg8::cvt_pk_bf16(hv[6], hv[7]);
                const bf16* hp = HID + (size_t)(u.off + rr) * 1024 + col0;
                asm volatile("global_store_dwordx4 %0, %1, off sc1\n\ts_nop 1" :: "v"(hp), "v"(w) : "memory");
#endif
            }
    }
};
__device__ __forceinline__ void ph_moe_up_pg8(const Args& a, LAS unsigned char* lds, int L, int G) {
    bk_table256(a, lds, L);
    const LAS int* tb = (const LAS int*)(lds + LDS_TAB); LAS int* rowtab = (LAS int*)(lds + LDS_TAB + 1024); LAS float* rgtab = (LAS float*)(lds + LDS_TAB + 1024 + 6 * 1024);
#if MOE_UP_F8
    typedef PMoeUp8 PU; PU S; S.A = (const char*)(a.ws + WS_X8); S.ldbB = 1024; S.nt = 8;
#else
    typedef PMoeUp PU; PU S; S.A = L ? (const char*)(a.ws + WS_SB) : (const char*)a.out; S.ldb = 1024; S.nt = 16;
#endif
    S.rgtab = rgtab; S.B = (const char*)(a.ws + ws_wgu(L)); S.HID = (bf16*)(a.ws + WS_HID); S.rstd = (const float*)(a.ws + WS_RSTD1); S.gates = (const float*)(a.ws + WS_GATES);
    S.tb = tb; S.rowtab = rowtab; S.G = G; S.c = (int)blockIdx.x; S.ctr = (unsigned*)(a.ws + WS_CTL) + CW_RT + 8192 * L;
    {   const int* LIST = (const int*)(a.ws + WS_LIST); PU::Unit u;
        for (int i = 0; i < 6 && S.next(i, u); ++i)
            if (threadIdx.x < 256) { int rr = u.rt * 256 + (int)threadIdx.x; rr = rr < u.cnt ? rr : u.cnt - 1; const int tok = LIST[(size_t)u.bk * T + rr]; rowtab[i * 256 + threadIdx.x] = tok;
                rgtab[(i * 256 + threadIdx.x) * 2] = S.rstd[tok]; rgtab[(i * 256 + threadIdx.x) * 2 + 1] = S.gates[(size_t)tok * 2 + u.ek]; }
        __syncthreads();
    }
#if MOE_UP_F8
    pg8::gemm_phase_f8<PU, true>(lds, S);
#else
    pg8::gemm_phase<PU, true>(lds, S);
#endif
}
struct PMoeDown {
    static constexpr bool PERM = true;
    struct EpiRegs {};
    template <class U_> __device__ __forceinline__ void epi_pre(const U_&, EpiRegs&, int, int, int, int) const {}
    struct Unit { int bk, rt, cnt, off, elo, ehi, pn, ui, rti; };
    const char* A; const char* B; bf16* HB; bf16* HBo; float* SSQ; const LAS int* tb; const LAS int* rowtab; unsigned* ctr; unsigned* err; int G, c, i0; int ldb, nt;
    __device__ __forceinline__ bool next(int i, Unit& u) const {
        const int Ld = (i0 + i) * G + c - 8 * tb[2 * NBK + NBK]; BkInfo o; if (!bk_find(tb, Ld >> 2, o)) return false;
        u.bk = o.bk; u.rt = o.rt; u.cnt = o.cnt; u.off = o.off; u.pn = Ld & 3; u.ui = i; u.rti = Ld >> 2; bk_experts(o.bk, u.elo, u.ehi); return true;
    }
    __device__ __forceinline__ void avoff(const Unit& u, const int (&RA)[2], const int (&CA)[2], unsigned (&v)[4]) const {
#pragma unroll
        for (int h = 0; h < 2; ++h)
#pragma unroll
            for (int i = 0; i < 2; ++i) { const int row = u.off + u.rt * 256 + h * 128 + RA[i]; v[h * 2 + i] = (unsigned)(row * 1024 + CA[i]) * 2u; }
    }
    __device__ __forceinline__ const char* abase(const Unit&) const { return A; }
    __device__ __forceinline__ const char* btile(const Unit& u, int t) const { return B + ((size_t)((t < 8 ? u.elo : u.ehi) * 1024 + u.pn * 256) * 512 + (size_t)(t & 7) * 64) * 2; }
    __device__ __forceinline__ void khook(int, pg8::Acc&, const Unit&, LAS unsigned char*, int, int, int, int) const {}
    __device__ __forceinline__ void a_ready(const Unit& u) const {
        if (threadIdx.x < 64) {
            unsigned spins = 0;
            while ((unsigned)__builtin_amdgcn_readfirstlane(__hip_atomic_load(ctr + 32 * u.rti, __ATOMIC_RELAXED, __HIP_MEMORY_SCOPE_AGENT)) < 64u) {
                __builtin_amdgcn_s_sleep(2);
                if (++spins > (1u << 22)) { if (threadIdx.x == 0) __hip_atomic_store(err, 1u, __ATOMIC_RELAXED, __HIP_MEMORY_SCOPE_AGENT); break; } }
            __builtin_amdgcn_fence(__ATOMIC_ACQUIRE, "agent");
            asm volatile("s_waitcnt vmcnt(0)" ::: "memory");
        }
        asm volatile("" ::: "memory"); __builtin_amdgcn_s_barrier(); asm volatile("" ::: "memory");
    }
    __device__ __forceinline__ void done(const Unit&) const {}
    __device__ __forceinline__ void epi(const pg8::Acc& acc, const Unit& u, const EpiRegs&, int wr, int wc, int fr, int fq) const {
        const int r0 = wr * 64 + fr, col0 = u.pn * 256 + wc * 32 + 8 * fq;
        int tok[8];
#pragma unroll
        for (int g8 = 0; g8 < 8; ++g8) tok[g8] = rowtab[u.ui * 256 + r0 + (g8 >> 2) * 128 + (g8 & 3) * 16];
#pragma unroll
        for (int hf = 0; hf < 2; ++hf) {
            v4u res[4][2];
#pragma unroll
            for (int g4 = 0; g4 < 4; ++g4)
#pragma unroll
                for (int bj = 0; bj < 2; ++bj) res[g4][bj] = *(const v4u*)(HB + (size_t)tok[hf * 4 + g4] * D + col0 + bj * 128);
#pragma unroll
            for (int g4 = 0; g4 < 4; ++g4) {
                const int g8 = hf * 4 + g4, ai = g8 >> 2, m = g8 & 3;
                const int rr = u.rt * 256 + r0 + ai * 128 + m * 16;
                float sq = 0.f;
#pragma unroll
                for (int bj = 0; bj < 2; ++bj) { f32x4 h0v, h1v; unpack8v(res[g4][bj], h0v, h1v);
                    const f32x4 v0 = acc[ai][bj][m][0] + h0v, v1 = acc[ai][bj][m][1] + h1v;
                    sq += (v0[0] * v0[0] + v0[1] * v0[1] + v0[2] * v0[2] + v0[3] * v0[3]) + (v1[0] * v1[0] + v1[1] * v1[1] + v1[2] * v1[2] + v1[3] * v1[3]);
                    if (rr < u.cnt) hb_store8(HBo, tok[g8], col0 + bj * 128, v0, v1); }
                sq += __shfl_xor(sq, 16); sq += __shfl_xor(sq, 32);
                if (rr < u.cnt && fq == 0) SSQ[(size_t)tok[g8] * 16 + u.pn * 4 + wc] = sq;
            }
        }
    }
};
struct PMoeDown8 {
    static constexpr bool VA_LDS = false;
    static constexpr bool PERM = true;
    struct EpiRegs {};
    template <class U_> __device__ __forceinline__ void epi_pre(const U_&, EpiRegs&, int, int, int, int) const {}
    struct Unit { int bk, rt, cnt, off, elo, ehi, pn, ui, rti; };
    const char* A; const char* B; bf16* HB; bf16* HBo; float* SSQ; const LAS int* tb; const LAS int* rowtab; unsigned* ctr; unsigned* err; int G, c, i0; int ldbB, nt;
    __device__ __forceinline__ bool next(int i, Unit& u) const {
        const int Ld = (i0 + i) * G + c - 8 * tb[2 * NBK + NBK]; BkInfo o; if (!bk_find(tb, Ld >> 2, o)) return false;
        u.bk = o.bk; u.rt = o.rt; u.cnt = o.cnt; u.off = o.off; u.pn = Ld & 3; u.ui = i; u.rti = Ld >> 2; bk_experts(o.bk, u.elo, u.ehi); return true;
    }
    __device__ __forceinline__ void avoff(const Unit& u, const int (&RA)[2], const int (&CA)[2], unsigned (&v)[4]) const {
#pragma unroll
        for (int h = 0; h < 2; ++h)
#pragma unroll
            for (int i = 0; i < 2; ++i) { const int row = u.off + u.rt * 256 + h * 128 + RA[i]; v[h * 2 + i] = (unsigned)(row * 1024 + CA[i] * 2); }
    }
    __device__ __forceinline__ const char* abase(const Unit&) const { return A; }
    __device__ __forceinline__ const char* btile(const Unit& u, int t) const { return B + (size_t)((t < 4 ? u.elo : u.ehi) * 1024 + u.pn * 256) * 512 + (size_t)(t & 3) * 128; }
    __device__ __forceinline__ void khook(int, pg8::Acc&, const Unit&, LAS unsigned char*, int, int, int, int) const {}
    __device__ __forceinline__ void a_ready(const Unit& u) const {
        if (threadIdx.x < 64) {
            unsigned spins = 0;
            while ((unsigned)__builtin_amdgcn_readfirstlane(__hip_atomic_load(ctr + 32 * u.rti, __ATOMIC_RELAXED, __HIP_MEMORY_SCOPE_AGENT)) < 64u) {
                __builtin_amdgcn_s_sleep(2);
                if (++spins > (1u << 22)) { if (threadIdx.x == 0) __hip_atomic_store(err, 1u, __ATOMIC_RELAXED, __HIP_MEMORY_SCOPE_AGENT); break; } }
            __builtin_amdgcn_fence(__ATOMIC_ACQUIRE, "agent");
            asm volatile("s_waitcnt vmcnt(0)" ::: "memory");
        }
        asm volatile("" ::: "memory"); __builtin_amdgcn_s_barrier(); asm volatile("" ::: "memory");
    }
    __device__ __forceinline__ void done(const Unit&) const {}
    __device__ __forceinline__ void epi(const pg8::Acc& acc, const Unit& u, const EpiRegs&, int wr, int wc, int fr, int fq) const {
        const int r0 = wr * 64 + fr, col0 = u.pn * 256 + wc * 32 + 8 * fq;
        int tok[8];
#pragma unroll
        for (int g8 = 0; g8 < 8; ++g8) tok[g8] = rowtab[u.ui * 256 + r0 + (g8 >> 2) * 128 + (g8 & 3) * 16];
        v4u cur[2], nxt[2];
#pragma unroll
        for (int bj = 0; bj < 2; ++bj) cur[bj] = *(const v4u*)(HB + (size_t)tok[0] * D + col0 + bj * 128);
#pragma unroll
        for (int g8 = 0; g8 < 8; ++g8) {
            const int ai = g8 >> 2, m = g8 & 3;
            if (g8 < 7) {
#pragma unroll
                for (int bj = 0; bj < 2; ++bj) nxt[bj] = *(const v4u*)(HB + (size_t)tok[g8 + 1] * D + col0 + bj * 128); }
            const int rr = u.rt * 256 + r0 + ai * 128 + m * 16;
            float sq = 0.f;
#pragma unroll
            for (int bj = 0; bj < 2; ++bj) { f32x4 h0v, h1v; unpack8v(cur[bj], h0v, h1v);
                const f32x4 v0 = acc[ai][bj][m][0] * 0.00390625f + h0v, v1 = acc[ai][bj][m][1] * 0.00390625f + h1v;
                sq += (v0[0] * v0[0] + v0[1] * v0[1] + v0[2] * v0[2] + v0[3] * v0[3]) + (v1[0] * v1[0] + v1[1] * v1[1] + v1[2] * v1[2] + v1[3] * v1[3]);
                if (rr < u.cnt) hb_store8(HBo, tok[g8], col0 + bj * 128, v0, v1); }
            sq += __shfl_xor(sq, 16); sq += __shfl_xor(sq, 32);
            if (rr < u.cnt && fq == 0) SSQ[(size_t)tok[g8] * 16 + u.pn * 4 + wc] = sq;
#pragma unroll
            for (int bj = 0; bj < 2; ++bj) cur[bj] = nxt[bj];
        }
    }
};
__device__ __forceinline__ void ph_moe_down_pg8(const Args& a, LAS unsigned char* lds, int L, int G) {
    bk_table256(a, lds, L);
    const LAS int* tb = (const LAS int*)(lds + LDS_TAB); LAS int* rowtab = (LAS int*)(lds + LDS_TAB + 1024);
#if MOE_DOWN_F8
    typedef PMoeDown8 PD; PD S; S.ldbB = 512; S.nt = 8;
#else
    typedef PMoeDown PD; PD S; S.ldb = 512; S.nt = 16;
#endif
    S.A = (const char*)(a.ws + WS_HID); S.B = (const char*)(a.ws + ws_wd(L)); S.SSQ = (float*)(a.ws + WS_SSDSQ); S.HB = L ? (bf16*)(a.ws + WS_SB) : (bf16*)a.out; S.HBo = L ? (bf16*)(a.ws + WS_SC) : (bf16*)a.out;
    S.tb = tb; S.rowtab = rowtab; S.G = G; S.c = (int)blockIdx.x; S.ctr = (unsigned*)(a.ws + WS_CTL) + CW_RT + 8192 * L; S.err = (unsigned*)(a.ws + WS_CTL) + 16;
    { const int nup = 8 * tb[2 * NBK + NBK]; S.i0 = nup > S.c ? (nup - S.c + G - 1) / G : 0; }
    {   const int* LIST = (const int*)(a.ws + WS_LIST); PD::Unit u;
        for (int i = 0; i < 4 && S.next(i, u); ++i)
            if (threadIdx.x < 256) { int rr = u.rt * 256 + (int)threadIdx.x; rr = rr < u.cnt ? rr : u.cnt - 1; rowtab[i * 256 + threadIdx.x] = LIST[(size_t)u.bk * T + rr]; }
        __syncthreads();
    }
#if MOE_DOWN_F8
    pg8::gemm_phase_f8<PD, true>(lds, S);
#else
    pg8::gemm_phase<PD, true>(lds, S);
#endif
    if (L == 0) {
        const int wave = __builtin_amdgcn_readfirstlane((int)threadIdx.x >> 6), lane = (int)threadIdx.x & 63;
        const int ntot = 12 * tb[2 * NBK + NBK], n_more = ntot % G;
        __syncthreads();
        (void)wave; (void)lane; (void)n_more;
        convert_experts_dyn(a, 1, lds, (unsigned*)(a.ws + WS_CTL) + 64);
    }
}
struct PPool {
    static constexpr bool PERM = true;
    struct EpiRegs {};
    template <class U_> __device__ __forceinline__ void epi_pre(const U_&, EpiRegs&, int, int, int, int) const {}
    struct Unit { int pm, pn; };
    const char* A; const char* B; bf16* HB; const float* pb; const float* ps; int G, c; int ldb, nt;
    __device__ __forceinline__ bool next(int i, Unit& u) const { return pg8::static_order(65, 4, G, c, i, u.pm, u.pn); }
    __device__ __forceinline__ void avoff(const Unit& u, const int (&RA)[2], const int (&CA)[2], unsigned (&v)[4]) const {
#pragma unroll
        for (int h = 0; h < 2; ++h)
#pragma unroll
            for (int i = 0; i < 2; ++i) { int row = u.pm * 256 + h * 128 + RA[i]; row = row < T ? row : T - 1; v[h * 2 + i] = (unsigned)(row * D + CA[i]) * 2u; }
    }
    __device__ __forceinline__ const char* abase(const Unit& u) const { return A + (size_t)u.pn * 256 * 2; }
    __device__ __forceinline__ const char* btile(const Unit& u, int t) const { return B + ((size_t)u.pn * 256 * 256 + (size_t)t * 64) * 2; }
    __device__ __forceinline__ void khook(int, pg8::Acc&, const Unit&, LAS unsigned char*, int, int, int, int) const {}
    __device__ __forceinline__ void a_ready(const Unit&) const {}
    __device__ __forceinline__ void done(const Unit&) const {}
    __device__ __forceinline__ void epi(const pg8::Acc& acc, const Unit& u, const EpiRegs&, int wr, int wc, int fr, int fq) const {
        const int row0 = u.pm * 256 + wr * 64 + fr, col0 = u.pn * 256 + wc * 32 + 8 * fq;
        v4u cur[2], nxt[2];
        { const int rc = row0 < T ? row0 : T - 1;
#pragma unroll
          for (int bj = 0; bj < 2; ++bj) cur[bj] = *(const v4u*)(HB + (size_t)rc * D + col0 + bj * 128); }
#pragma unroll
        for (int g8 = 0; g8 < 8; ++g8) {
            const int ai = g8 >> 2, m = g8 & 3, row = row0 + ai * 128 + m * 16;
            if (g8 < 7) { const int rn = row0 + ((g8 + 1) >> 2) * 128 + ((g8 + 1) & 3) * 16, rc = rn < T ? rn : T - 1;
#pragma unroll
                for (int bj = 0; bj < 2; ++bj) nxt[bj] = *(const v4u*)(HB + (size_t)rc * D + col0 + bj * 128); }
            if (row < T) {
#pragma unroll
                for (int bj = 0; bj < 2; ++bj) { const int cc = col0 + bj * 128; f32x4 h0v, h1v; unpack8v(cur[bj], h0v, h1v);
                    hb_store8(HB, row, cc, h0v + (acc[ai][bj][m][0] + *(const f32x4*)(pb + cc)) * *(const f32x4*)(ps + cc),
                                           h1v + (acc[ai][bj][m][1] + *(const f32x4*)(pb + cc + 4)) * *(const f32x4*)(ps + cc + 4)); } }
#pragma unroll
            for (int bj = 0; bj < 2; ++bj) cur[bj] = nxt[bj];
        }
    }
};
__device__ __forceinline__ void ph_poolgemm_pg8(const Args& a, LAS unsigned char* lds, int G) {
    PPool S; S.A = (const char*)(a.ws + WS_POOLED); S.B = (const char*)(a.ws + WS_WPOOL); S.HB = (bf16*)a.out; S.pb = a.in[I_PB]; S.ps = a.in[I_PS];
    S.G = G; S.c = (int)blockIdx.x; S.ldb = 256; S.nt = 4;
    pg8::gemm_phase<PPool, true>(lds, S);
}

constexpr int PF_RS_ROW = 528;
constexpr int PF_RAW = 0, PF_RS = 112 * PF_RS_ROW, PF_A = PF_RS + 512, PF_END = PF_A + 96 * PF_RS_ROW;
static_assert(PF_END <= LDS_BYTES - 256, "pool lds");
__device__ __forceinline__ void ph_pool_fused(const Args& a, LAS unsigned char* lds, int wk, int nwk) {
    const int tid = threadIdx.x, lane = tid & 63, w = __builtin_amdgcn_readfirstlane(tid >> 6), fr = lane & 15, fq = lane >> 4;
    const bf16* SA = (const bf16*)a.out; bf16* SB = (bf16*)(a.ws + WS_SB); const float* SSQ = (const float*)(a.ws + WS_SSDSQ); const bf16* WPOOL = (const bf16*)(a.ws + WS_WPOOL);
    LAS float* rs = (LAS float*)(lds + PF_RS);
    v4u rp[7]; f32x4 sq4[4];
#define POOL_PREFETCH(U) do { const int rt_ = (U) >> 2, g_ = (U) & 3, t0_ = rt_ * 96; \
        _Pragma("unroll") for (int i = 0; i < 7; ++i) { const int q = tid + 512 * i, row = q >> 5, pc = q & 31; int gr = t0_ - 16 + row; gr = gr < 0 ? 0 : gr; \
            rp[i] = *(const v4u*)(SA + (size_t)gr * D + g_ * 256 + pc * 8); } \
        if (tid < 112) { int gr = t0_ - 16 + tid; gr = gr < 0 ? 0 : gr; const f32x4* q = (const f32x4*)(SSQ + (size_t)gr * 16); sq4[0] = q[0]; sq4[1] = q[1]; sq4[2] = q[2]; sq4[3] = q[3]; } } while (0)
    if (wk < 172 * 4) POOL_PREFETCH(wk);
    for (int u = wk; u < 172 * 4; u += nwk) {
        const int rt = u >> 2, g = u & 3, t0 = rt * 96, win = 2 << g;
        const bf16* wrow = WPOOL + (size_t)(g * 256 + 32 * w + fr) * 256 + 8 * fq;
        bf16x8 bfr[8][2];
#pragma unroll
        for (int ks = 0; ks < 8; ++ks) { bfr[ks][0] = *(const bf16x8*)(wrow + 32 * ks); bfr[ks][1] = *(const bf16x8*)(wrow + 16 * 256 + 32 * ks); }
        __syncthreads();
#pragma unroll
        for (int i = 0; i < 7; ++i) { const int q = tid + 512 * i, row = q >> 5, pc = q & 31; *(LAS v4u*)(lds + PF_RAW + row * PF_RS_ROW + pc * 16) = rp[i]; }
        if (tid < 112) { const f32x4 sv = (sq4[0] + sq4[1]) + (sq4[2] + sq4[3]); rs[tid] = rsqrtf((sv[0] + sv[1] + sv[2] + sv[3]) * (1.f / D) + EPS); }
        __syncthreads();
        if (u + nwk < 172 * 4) POOL_PREFETCH(u + nwk);
        {   const int c4 = tid & 63, r0 = (tid >> 6) * 12;
            const LAS unsigned char* rawc = lds + PF_RAW + 16 * PF_RS_ROW + c4 * 8;
            int l = (t0 + r0) % LSEQ;
            f32x4 Sb = (f32x4){0.f, 0.f, 0.f, 0.f};
            for (int j = 1; j < win; ++j) if (l - j >= 0) { const v2u q = *(const LAS v2u*)(rawc + (r0 - j) * PF_RS_ROW); const float rr = rs[16 + r0 - j];
                Sb[0] += __uint_as_float(q.x << 16) * rr; Sb[1] += __uint_as_float(q.x & 0xffff0000u) * rr; Sb[2] += __uint_as_float(q.y << 16) * rr; Sb[3] += __uint_as_float(q.y & 0xffff0000u) * rr; }
#pragma unroll 4
            for (int r = r0; r < r0 + 12; ++r) {
                if (l == 0) Sb = (f32x4){0.f, 0.f, 0.f, 0.f};
                const v2u q = *(const LAS v2u*)(rawc + r * PF_RS_ROW); const float rr = rs[16 + r];
                f32x4 hv; hv[0] = __uint_as_float(q.x << 16) * rr; hv[1] = __uint_as_float(q.x & 0xffff0000u) * rr; hv[2] = __uint_as_float(q.y << 16) * rr; hv[3] = __uint_as_float(q.y & 0xffff0000u) * rr;
                const f32x4 full = Sb + hv;
                const int n = (l + 1) < win ? (l + 1) : win;
                const f32x4 o = full * (1.f / (float)n) - hv;
                v2u wv; wv.x = pk2(o[0], o[1]); wv.y = pk2(o[2], o[3]);
                *(LAS v2u*)(lds + PF_A + r * PF_RS_ROW + c4 * 8) = wv;
                Sb = full;
                if (l + 1 >= win) { const v2u qo = *(const LAS v2u*)(rawc + (r - win + 1) * PF_RS_ROW); const float ro = rs[16 + r - win + 1];
                    Sb[0] -= __uint_as_float(qo.x << 16) * ro; Sb[1] -= __uint_as_float(qo.x & 0xffff0000u) * ro; Sb[2] -= __uint_as_float(qo.y << 16) * ro; Sb[3] -= __uint_as_float(qo.y & 0xffff0000u) * ro; }
                l = (l + 1 == LSEQ) ? 0 : l + 1;
            }
        }
        __syncthreads();
        f32x4 acc[6][2];
#pragma unroll
        for (int m = 0; m < 6; ++m) { acc[m][0] = (f32x4){0.f, 0.f, 0.f, 0.f}; acc[m][1] = acc[m][0]; }
#pragma unroll
        for (int ks = 0; ks < 8; ++ks) {
            bf16x8 af[6];
#pragma unroll
            for (int m = 0; m < 6; ++m) af[m] = *(const LAS bf16x8*)(lds + PF_A + (16 * m + fr) * PF_RS_ROW + (32 * ks + 8 * fq) * 2);
#pragma unroll
            for (int m = 0; m < 6; ++m) { acc[m][0] = mfma16(bfr[ks][0], af[m], acc[m][0]); acc[m][1] = mfma16(bfr[ks][1], af[m], acc[m][1]); }
        }
#pragma unroll
        for (int j = 0; j < 2; ++j) { const int col = g * 256 + 32 * w + 16 * j + 4 * fq; const f32x4 pbv = *(const f32x4*)(a.in[I_PB] + col), psv = *(const f32x4*)(a.in[I_PS] + col);
#pragma unroll
            for (int m = 0; m < 6; ++m) {
                LAS v2u* hp = (LAS v2u*)(lds + PF_RAW + (16 + 16 * m + fr) * PF_RS_ROW + (32 * w + 16 * j + 4 * fq) * 2);
                const v2u hq = *hp;
                f32x4 hv; hv[0] = __uint_as_float(hq.x << 16); hv[1] = __uint_as_float(hq.x & 0xffff0000u); hv[2] = __uint_as_float(hq.y << 16); hv[3] = __uint_as_float(hq.y & 0xffff0000u);
                const f32x4 o = hv + (acc[m][j] + pbv) * psv;
                v2u wv; wv.x = pg8::cvt_pk_bf16(o[0], o[1]); wv.y = pg8::cvt_pk_bf16(o[2], o[3]); *hp = wv; } }
        __syncthreads();
#pragma unroll
        for (int i = 0; i < 6; ++i) { const int q = tid + 512 * i, row = q >> 5, pc = q & 31;
            const v4u ov = *(const LAS v4u*)(lds + PF_RAW + (16 + row) * PF_RS_ROW + pc * 16); *(v4u*)(SB + (size_t)(t0 + row) * D + g * 256 + pc * 8) = ov;
            if (MOE_UP_F8) { f32x4 o0, o1; unpack8v(ov, o0, o1); x8_store8(a.ws + WS_X8, t0 + row, g * 256 + pc * 8, o0, o1); } }
    }
#undef POOL_PREFETCH
}
__device__ __forceinline__ void ph_pooled(const Args& a, LAS unsigned char* lds, int wk, int nwk) {
    const int tid = threadIdx.x, qt = tid >> 7, c8 = tid & 127, c = c8 * 8, g = c >> 8, w = 2 << g;
    const bf16* HBr = (const bf16*)a.out; const float* SSQ = (const float*)(a.ws + WS_SSDSQ); bf16* PO = (bf16*)(a.ws + WS_POOLED);
    LAS float* rs = (LAS float*)lds + qt * 64;
    for (int pr = wk; pr < 172; pr += nwk) {
        const int task = pr * 4 + qt, b = task / 86, t0 = (task % 86) * 24;
        const size_t rb = (size_t)b * LSEQ;
        __syncthreads();
        if (c8 < 40) { const int l = t0 - 16 + c8; float r = 0.f;
            if (l >= 0) { const f32x4* q = (const f32x4*)(SSQ + (rb + l) * 16); const f32x4 sv = (q[0] + q[1]) + (q[2] + q[3]); r = rsqrtf((sv[0] + sv[1] + sv[2] + sv[3]) * (1.f / D) + EPS); }
            rs[c8] = r; }
        __syncthreads();
        f32x4 S0 = (f32x4){0.f, 0.f, 0.f, 0.f}, S1 = S0;
        for (int j = 1; j <= w; ++j) { const int l = t0 - j; if (l >= 0) { f32x4 x0, x1; unpack8v(*(const v4u*)(HBr + (rb + l) * D + c), x0, x1); S0 += x0 * rs[16 - j]; S1 += x1 * rs[16 - j]; } }
#pragma unroll 4
        for (int t = 0; t < 24; ++t) {
            const int l = t0 + t;
            f32x4 h0v, h1v; unpack8v(*(const v4u*)(HBr + (rb + l) * D + c), h0v, h1v); h0v *= rs[16 + t]; h1v *= rs[16 + t];
            const int lo = l - w, loc = lo >= 0 ? lo : 0; const float rl = lo >= 0 ? rs[16 + t - w] : 0.f;
            f32x4 s0v, s1v; unpack8v(*(const v4u*)(HBr + (rb + loc) * D + c), s0v, s1v);
            S0 += h0v; S0 -= s0v * rl; S1 += h1v; S1 -= s1v * rl;
            const int n = (l + 1) < w ? (l + 1) : w; const float inv = 1.f / (float)n;
            const f32x4 o0 = S0 * inv - h0v, o1 = S1 * inv - h1v;
            v4u wv; wv.x = pk2(o0[0], o0[1]); wv.y = pk2(o0[2], o0[3]); wv.z = pk2(o1[0], o1[1]); wv.w = pk2(o1[2], o1[3]); *(v4u*)(PO + (rb + l) * D + c) = wv;
        }
    }
}
__device__ __forceinline__ void ph_poolgemm(const Args& a, int wk, int nwk) {
    const int tid = threadIdx.x, lane = tid & 63, wave = __builtin_amdgcn_readfirstlane(tid >> 6), fr = lane & 15, fq = lane >> 4;
    const int gw = wk * NWAVES + wave, NGW = nwk * NWAVES;
    const bf16* PO = (const bf16*)(a.ws + WS_POOLED); const bf16* WPOOL = (const bf16*)(a.ws + WS_WPOOL);
    float* H = (float*)(a.ws + WS_H); bf16* HB = (bf16*)a.out;
    for (int u = gw; u < 258 * 16; u += NGW) {
        const int rt = u / 16, ct = u % 16, g = ct >> 2;
        const bf16* arow[4];
#pragma unroll
        for (int mi = 0; mi < 4; ++mi) arow[mi] = PO + (size_t)(rt * 64 + 16 * mi + fr) * D + g * 256;
        f32x4 acc[4][4]; zero_acc(acc);
        sg_kloop<4>(256, arow, [=](int n, int k0) { return WPOOL + (size_t)(ct * 64 + n) * 256 + k0; }, NoKS(), acc, fr, fq);
#pragma unroll
        for (int mi = 0; mi < 4; ++mi) { const int row = rt * 64 + 16 * mi + fr;
#pragma unroll
            for (int nj = 0; nj < 4; ++nj) { const int c = ct * 64 + 16 * nj + 4 * fq; float* hp = H + (size_t)row * D + c;
                const f32x4 v = *(const f32x4*)hp + (acc[mi][nj] + *(const f32x4*)(a.in[I_PB] + c)) * *(const f32x4*)(a.in[I_PS] + c); *(f32x4*)hp = v;
                v2u w; w.x = pk2(v.x, v.y); w.y = pk2(v.z, v.w); *(v2u*)(HB + (size_t)row * D + c) = w; } }
    }
}
__device__ __forceinline__ void ph_final(const Args& a, int wk, int nwk) {
    const int tid = threadIdx.x, lane = tid & 63, wave = __builtin_amdgcn_readfirstlane(tid >> 6);
    const int gw = wk * NWAVES + wave, NGW = nwk * NWAVES;
    const f32x4* gn = (const f32x4*)a.in[I_NORMF] + lane;
    const bf16* HF = (const bf16*)(a.ws + WS_SC);
    for (int orow = gw; orow < NB * SEQ; orow += NGW) {
        const int b = orow / SEQ, l = orow - b * SEQ, row = b * LSEQ + NMETA + l;
        const v2u* xr = (const v2u*)(HF + (size_t)row * D) + lane; f32x4 v[4]; float ss = 0.f;
#pragma unroll
        for (int j = 0; j < 4; ++j) { const v2u q = xr[64 * j]; v[j][0] = __uint_as_float(q.x << 16); v[j][1] = __uint_as_float(q.x & 0xffff0000u); v[j][2] = __uint_as_float(q.y << 16); v[j][3] = __uint_as_float(q.y & 0xffff0000u);
            ss += v[j].x * v[j].x + v[j].y * v[j].y + v[j].z * v[j].z + v[j].w * v[j].w; }
        ss = wave_sum(ss);
        const float rstd = rsqrtf(ss * (1.f / D) + EPS);
        f32x4* o = (f32x4*)(a.out + (size_t)orow * D) + lane;
#ifdef PROBE_T
        const unsigned long long* ts = (const unsigned long long*)(a.ws + WS_CTL + 2048);
        const float tA = (float)(ts[PROBE_A_HI] - ts[PROBE_A_LO]) * 0.01f, tB = (float)(ts[PROBE_B_HI] - ts[PROBE_B_LO]) * 0.01f;
#pragma unroll
        for (int j = 0; j < 4; ++j) { f32x4 r = v[j] * rstd * gn[64 * j] + tB * 0.01f; if (orow == 0 && lane == 0 && j == 0) r.x += tA; o[64 * j] = r; }
#else
#pragma unroll
        for (int j = 0; j < 4; ++j) o[64 * j] = v[j] * rstd * gn[64 * j];
#endif
    }
}

__global__ void __launch_bounds__(NWAVES * 64, 2) fwd_kernel(Args a) {
    extern __shared__ __attribute__((aligned(16))) unsigned char lds_raw[];
    LAS unsigned char* lds = (LAS unsigned char*)lds_raw;
    volatile LAS unsigned* MISC = (volatile LAS unsigned*)(lds + LDS_BYTES - 256);
    const int tid = threadIdx.x;
    const int G = gridDim.x; const int bx = blockIdx.x;
    const int wk = (G % 8 == 0) ? (bx % 8) * (G / 8) + bx / 8 : bx;
    if (tid < 64) MISC[tid] = 0u;
    __syncthreads();
    XcdBarrier bar; bar.bar = (unsigned*)(a.ws + WS_CTL) + CW_BAR; bar.x = 0; bar.st = nullptr;
    if (N_LAUNCHES == 1) bar = xcd_barrier_post((unsigned*)(a.ws + WS_CTL) + CW_BAR, MISC + 8);
    const int lo = a.ph_lo, hi = a.ph_hi;
#ifndef PH_MASK
#define PH_MASK 0xFFFF
#endif
#define IN(k) (((PH_MASK >> (k)) & 1) && lo <= (k) && (k) < hi)
#ifdef PROBE_T
#define STAMP(k) do { if (blockIdx.x == 0 && tid == 0) ((unsigned long long*)(a.ws + WS_CTL + 2048))[k] = __builtin_amdgcn_s_memrealtime(); } while (0)
#else
#define STAMP(k) do { } while (0)
#endif
#ifdef PROBE_K
    volatile LAS unsigned long long* pkt = (volatile LAS unsigned long long*)(lds + LDS_BYTES - 128);
#define PSTAMP(k) do { if (blockIdx.x == 0 && tid == 0) { if ((k) == PROBE_K) pkt[0] = __builtin_amdgcn_s_memrealtime(); if ((k) == PROBE_K + 1) pkt[1] = __builtin_amdgcn_s_memrealtime(); } } while (0)
#else
#define PSTAMP(k) do { } while (0)
#endif
#define SEAM(k) do { if (IN(k) && IN((k) + 1)) xcd_barrier(bar); STAMP((k) + 1); PSTAMP((k) + 1); } while (0)
    STAMP(0); PSTAMP(0);
    if (IN(0)) { ph_prep(a, lds, wk, G); } SEAM(0);
    if (IN(1)) { ph_gemm1_pg8(a, lds, G); } SEAM(1);
    if (IN(2)) { ph_conv(a, wk, G); } SEAM(2);
    if (IN(3)) { ph_mixers3(a, lds, wk, G); } SEAM(3);
    if (IN(4)) { ph_gemm2_pg8(a, lds, wk, G); } SEAM(4);
    if (IN(5)) { ph_router(a, lds, 0, wk, G); } SEAM(5);
    if (IN(6)) { ph_moe_up_pg8(a, lds, 0, G); ph_moe_down_pg8(a, lds, 0, G); } SEAM(6);
    STAMP(8); PSTAMP(8);
    if (IN(8)) { ph_pool_fused(a, lds, wk, G); } SEAM(8);
    STAMP(10); PSTAMP(10);
    if (IN(10)) { ph_router(a, lds, 1, wk, G); } SEAM(10);
    if (IN(11)) { ph_moe_up_pg8(a, lds, 1, G); ph_moe_down_pg8(a, lds, 1, G); } SEAM(11);
    STAMP(13); PSTAMP(13);
    if (IN(13)) { ph_final(a, wk, G); }
#ifdef PROBE_K
    if (blockIdx.x == 0 && tid == 0) {
        asm volatile("s_waitcnt vmcnt(0)" ::: "memory");
        if (PROBE_K == 13) pkt[1] = __builtin_amdgcn_s_memrealtime();
        const unsigned long long tend = __builtin_amdgcn_s_memrealtime() + 4ull * (pkt[1] - pkt[0]);
        while (__builtin_amdgcn_s_memrealtime() < tend) __builtin_amdgcn_s_sleep(16);
    }
#endif
#undef IN
#undef SEAM
}

extern "C" void kernel_launch(void* const* d_in, const int* in_sizes, int n_in, void* d_out, int out_size, void* d_ws, size_t ws_size, hipStream_t stream) {
    static int grid = 0;
    if (grid == 0) {
        if (n_in != 31 || out_size != NB * SEQ * D || ws_size < WS_END) { fprintf(stderr, "kernel_launch: unexpected shapes (n_in %d out %d ws %zu)\n", n_in, out_size, ws_size); grid = -1; return; }
        int dev = 0, cus = 0;
        if (hipGetDevice(&dev) != hipSuccess || hipDeviceGetAttribute(&cus, hipDeviceAttributeMultiprocessorCount, dev) != hipSuccess) { grid = -1; return; }
        if (hipFuncSetAttribute((const void*)fwd_kernel, hipFuncAttributeMaxDynamicSharedMemorySize, LDS_BYTES) != hipSuccess) { grid = -1; return; }
        grid = cus;
    }
    if (grid < 0) return;
    (void)hipMemsetAsync((char*)d_ws + WS_CTL, 0, CTL_ZERO_BYTES, stream);
    Args a{};
    for (int i = 0; i < 31; ++i) a.in[i] = (const float*)d_in[i];
    a.out = (float*)d_out; a.ws = (unsigned char*)d_ws;
    if (N_LAUNCHES == 1) { a.ph_lo = 0; a.ph_hi = NPH; hipLaunchKernelGGL(fwd_kernel, dim3(grid), dim3(NWAVES * 64), LDS_BYTES, stream, a); }
    else for (int p = 0; p < NPH; ++p) { a.ph_lo = p; a.ph_hi = p + 1; hipLaunchKernelGGL(fwd_kernel, dim3(grid), dim3(NWAVES * 64), LDS_BYTES, stream, a); }
}
```

```cpp
#include <hip/hip_runtime.h>
#include <cstdio>
#include <cstdint>

#define GAS __attribute__((address_space(1)))
#define LAS __attribute__((address_space(3)))
typedef unsigned short bf16;
typedef short bf16x8 __attribute__((ext_vector_type(8)));
typedef float f32x4 __attribute__((ext_vector_type(4)));
typedef unsigned v4u __attribute__((ext_vector_type(4)));
typedef unsigned v2u __attribute__((ext_vector_type(2)));

#ifndef MK_N_LAUNCHES
#define MK_N_LAUNCHES 1
#endif
constexpr int NPH = 14;
constexpr int N_LAUNCHES = MK_N_LAUNCHES;

constexpr int NB = 8, SEQ = 2048, NMETA = 16, LSEQ = SEQ + NMETA, T = NB * LSEQ, D = 1024;
constexpr int PROJ_SRC = 4624, LDP = 4608;
constexpr int C_Z = 0, C_G = 1024, C_X = 2048, C_B = 3072, C_C = 3328, C_LI = 3584;
constexpr float EPS = 1e-6f;
constexpr int NBK = 24;

constexpr size_t MiB = 1u << 20;
constexpr size_t WS_CTL = 0, CTL_ZERO_BYTES = 160 * 1024;
constexpr size_t WS_WIN = 1 * MiB;
constexpr size_t WS_WOUT = 10 * MiB;
constexpr size_t WS_WPOOL = 14 * MiB;
constexpr size_t WS_WRT = 14 * MiB + 512 * 1024;
constexpr size_t WS_WDTT = 15 * MiB + 512 * 1024;
constexpr size_t WS_RSTD0 = 15 * MiB;
constexpr size_t WS_RSTD1 = WS_RSTD0 + 128 * 1024;
constexpr size_t WS_BKT = WS_RSTD1 + 128 * 1024;
constexpr size_t WS_GATES = WS_BKT + 128 * 1024;
constexpr size_t WS_DT = 16 * MiB;
constexpr size_t WS_SSDSQ = 17 * MiB + 64 * 1024;
constexpr size_t WS_LIST = 19 * MiB;
constexpr size_t WS_WGU = 21 * MiB;
constexpr size_t WS_WD = 53 * MiB;
constexpr size_t WS_H = 69 * MiB;
constexpr size_t WS_PROJ = 134 * MiB;
constexpr size_t WS_HID = WS_PROJ;
constexpr size_t WS_POOLED = WS_PROJ;
constexpr size_t WS_END = 280 * MiB;
constexpr size_t WS_WGU1 = WS_PROJ + 64 * MiB, WS_WD1 = WS_PROJ + 96 * MiB;
__host__ __device__ constexpr size_t ws_wgu(int L) { return L ? WS_WGU1 : WS_WGU; }
__host__ __device__ constexpr size_t ws_wd(int L) { return L ? WS_WD1 : WS_WD; }
constexpr size_t WS_X8 = WS_PROJ + 46 * MiB;
constexpr size_t WS_SB = WS_H, WS_SC = WS_H + (size_t)T * D * 2;
static_assert(WS_H + (size_t)T * D * 4 <= WS_PROJ && WS_PROJ + (size_t)T * LDP * 2 <= WS_END, "ws map");
static_assert(WS_DT + (size_t)T * 16 * 4 <= WS_SSDSQ && WS_SSDSQ + (size_t)T * 16 * 4 <= WS_LIST && WS_LIST + (size_t)NBK * T * 4 <= WS_WGU, "ws map small");
constexpr int CW_CNT = 8192;
constexpr int CW_BAR = 4096;
constexpr int CW_RT = 16384;

constexpr int LDS_BYTES = 163840;
#ifndef MOE_UP_F8
#define MOE_UP_F8 1
#endif
#ifndef MOE_DOWN_F8
#define MOE_DOWN_F8 1
#endif
constexpr int LDS_TAB = 131072;
constexpr int NWAVES = 8;

struct Args { const float* in[31]; float* out; unsigned char* ws; int ph_lo, ph_hi; };
enum { I_X = 0, I_META, I_NORMF, I_MNE, I_WIN, I_SCW, I_SCB, I_DTB, I_ALOG, I_SD, I_SNORM, I_LCW, I_LCB, I_LWA, I_LBA, I_LWX, I_LBX, I_LLAM, I_WOUT,
       I_MNO, I_PW, I_PB, I_PS, I_FFN, I_RGW, I_RGB, I_REW, I_REB, I_EWG, I_EWU, I_EWD };

#define LDS_WAIT() asm volatile("s_waitcnt lgkmcnt(0)" ::: "memory")
__device__ __forceinline__ float bf2f(unsigned v) { return __uint_as_float(v << 16); }
__device__ __forceinline__ unsigned f2bf(float f) { unsigned u = __float_as_uint(f); return (u + 0x7fffu + ((u >> 16) & 1u)) >> 16; }
__device__ __forceinline__ unsigned pk2(float lo, float hi) { return f2bf(lo) | (f2bf(hi) << 16); }
__device__ __forceinline__ void unpack8v(const v4u r, f32x4& a, f32x4& b) {
    a[0] = __uint_as_float(r.x << 16); a[1] = __uint_as_float(r.x & 0xffff0000u); a[2] = __uint_as_float(r.y << 16); a[3] = __uint_as_float(r.y & 0xffff0000u);
    b[0] = __uint_as_float(r.z << 16); b[1] = __uint_as_float(r.z & 0xffff0000u); b[2] = __uint_as_float(r.w << 16); b[3] = __uint_as_float(r.w & 0xffff0000u);
}
__device__ __forceinline__ unsigned pack_fp8x4(float a, float b, float c, float d) {
    int r = 0; r = __builtin_amdgcn_cvt_pk_fp8_f32(a, b, r, false); r = __builtin_amdgcn_cvt_pk_fp8_f32(c, d, r, true); return (unsigned)r;
}
__device__ __forceinline__ void x8_store8(unsigned char* X8, int row, int col, const f32x4 v0, const f32x4 v1) {
    v2u o; o.x = pack_fp8x4(v0[0], v0[1], v0[2], v0[3]); o.y = pack_fp8x4(v1[0], v1[1], v1[2], v1[3]); *(v2u*)(X8 + (size_t)row * 1024 + col) = o;
}
__device__ __forceinline__ float wave_sum(float v) {
#pragma unroll
    for (int o = 1; o < 64; o <<= 1) v += __shfl_xor(v, o);
    return v;
}
__device__ __forceinline__ float rcp_f(float v) { return __builtin_amdgcn_rcpf(v); }
__device__ __forceinline__ float sigmoid_f(float v) { return rcp_f(1.f + __expf(-v)); }
__device__ __forceinline__ float silu_f(float v) { return v * rcp_f(1.f + __expf(-v)); }
__device__ __forceinline__ float softplus_f(float v) {
    const float e = __expf(-fabsf(v));
    const float lp = e < 0.03f ? e * (1.f - e * (0.5f - e * 0.33333334f)) : __logf(1.f + e);
    return fmaxf(v, 0.f) + lp;
}
__device__ __forceinline__ float gelu_tanh_f(float v) { const float u2 = 1.5957691216057308f * (v + 0.044715f * v * v * v); return v * rcp_f(1.f + __expf(-u2)); }
__device__ __forceinline__ const float* h0_row(const Args& a, int row) {
    const int b = row / LSEQ, l = row - b * LSEQ;
    return l < NMETA ? a.in[I_META] + (size_t)l * D : a.in[I_X] + ((size_t)b * SEQ + (l - NMETA)) * D;
}

#define XB_TMO      128
#define XB_XCNT(j)  (256  + 64 * (j))
#define XB_XSUB(j)  (1280 + 64 * (j))
#define XB_XGEN(j)  (2304 + 64 * (j))
#define XB_TOP      3328
#define XB_TOPGEN   3392
#define XCD_BAR_WORDS 3456
#define XB_SPIN_CAP (1u << 18)
__device__ __forceinline__ unsigned xb_ld(unsigned* p)              { return __hip_atomic_load(p, __ATOMIC_RELAXED, __HIP_MEMORY_SCOPE_AGENT); }
__device__ __forceinline__ unsigned xb_add(unsigned* p, unsigned v) { return __hip_atomic_fetch_add(p, v, __ATOMIC_RELAXED, __HIP_MEMORY_SCOPE_AGENT); }
__device__ __forceinline__ unsigned xb_xcc_id() { return (unsigned)__builtin_amdgcn_s_getreg((3 << 11) | 20) & 0xFu; }
#define XB_SPIN(cond, bar) do { unsigned _sp = 0; while (cond) { __builtin_amdgcn_s_sleep(1); \
    if ((++_sp & 255u) == 0u) { if (xb_ld(&(bar)[XB_TMO])) break; if (_sp > XB_SPIN_CAP) { atomicAdd(&(bar)[XB_TMO], 1u); break; } } } } while (0)
struct XcdBarrier { unsigned* bar; unsigned x; volatile LAS unsigned* st; };
__device__ __forceinline__ XcdBarrier xcd_barrier_post(unsigned* bar, volatile LAS unsigned* st) {
    XcdBarrier b; b.bar = bar; b.x = xb_xcc_id(); b.st = st;
    if (threadIdx.x == 0) (void)xb_add(&bar[XB_XCNT(b.x)], 1u);
    return b;
}
__device__ __forceinline__ void xcd_barrier_complete(unsigned* bar, unsigned x, unsigned& nloc, unsigned& nx) {
    const unsigned G = gridDim.x * gridDim.y * gridDim.z;
    unsigned sum, cnt, mine, sp = 0u;
    for (;;) {
        sum = 0u; cnt = 0u; mine = 0u;
#pragma unroll
        for (unsigned j = 0; j < 16; ++j) { const unsigned c = xb_ld(&bar[XB_XCNT(j)]); sum += c; cnt += (c > 0u) ? 1u : 0u; mine = (j == x) ? c : mine; }
        if (sum == G) break;
        __builtin_amdgcn_s_sleep(1);
        if ((++sp & 255u) == 0u) { if (xb_ld(&bar[XB_TMO])) break; if (sp > XB_SPIN_CAP) { atomicAdd(&bar[XB_TMO], 1u); break; } }
    }
    nloc = mine > 0u ? mine : 1u; nx = cnt > 0u ? cnt : 1u;
}
__device__ __forceinline__ void xcd_barrier(const XcdBarrier& b) {
    asm volatile("s_waitcnt vmcnt(0)" ::: "memory");
    __syncthreads();
    if (threadIdx.x == 0) {
        unsigned* bar = b.bar;
        __builtin_amdgcn_s_waitcnt(0);
        unsigned nloc = b.st[0], nx = b.st[1];
        if (nloc == 0u) { xcd_barrier_complete(bar, b.x, nloc, nx); b.st[0] = nloc; b.st[1] = nx; }
        const unsigned old = xb_add(&bar[XB_XSUB(b.x)], 1u);
        const unsigned gen = old / nloc;
        if (old + 1u == (gen + 1u) * nloc) {
            __builtin_amdgcn_fence(__ATOMIC_RELEASE, "agent");
            asm volatile("s_waitcnt vmcnt(0)" ::: "memory");
            const unsigned og = xb_add(&bar[XB_TOP], 1u);
            const unsigned tg = og / nx;
            if (og + 1u == (tg + 1u) * nx) xb_add(&bar[XB_TOPGEN], 1u);
            else XB_SPIN(xb_ld(&bar[XB_TOPGEN]) == tg, bar);
            __builtin_amdgcn_fence(__ATOMIC_ACQUIRE, "agent");
            xb_add(&bar[XB_XGEN(b.x)], 1u);
            asm volatile("s_waitcnt vmcnt(0)" ::: "memory");
        } else {
            XB_SPIN(xb_ld(&bar[XB_XGEN(b.x)]) == gen, bar);
            __builtin_amdgcn_fence(__ATOMIC_ACQUIRE, "agent");
            asm volatile("s_waitcnt vmcnt(0)" ::: "memory");
        }
    }
    __syncthreads();
}

template <bool F8>
__device__ __forceinline__ void tr_item_t(const float* src, int ldsrc, const float* gain, void* dstv, int lddst  , float scale, LAS float* scr, int lane) {
    float tv[32];
#pragma unroll
    for (int i = 0; i < 32; ++i) { const int kk = 2 * i + (lane >> 5); tv[i] = src[(size_t)kk * ldsrc + (lane & 31)]; }
#pragma unroll
    for (int i = 0; i < 32; ++i) { const int kk = 2 * i + (lane >> 5); float v = tv[i]; if (gain) v *= gain[kk]; scr[kk * 33 + (lane & 31)] = v; }
    LDS_WAIT();
    const int c = lane & 7;
#pragma unroll
    for (int j = 0; j < 4; ++j) { const int n = (lane >> 3) + 8 * j; const LAS float* sp = scr + (8 * c) * 33 + n;
        if (F8) { v2u o; o.x = pack_fp8x4(sp[0 * 33] * scale, sp[1 * 33] * scale, sp[2 * 33] * scale, sp[3 * 33] * scale); o.y = pack_fp8x4(sp[4 * 33] * scale, sp[5 * 33] * scale, sp[6 * 33] * scale, sp[7 * 33] * scale);
            *(v2u*)((unsigned char*)dstv + (size_t)n * lddst + 8 * c) = o; }
        else { v4u o; o.x = pk2(sp[0 * 33], sp[1 * 33]); o.y = pk2(sp[2 * 33], sp[3 * 33]); o.z = pk2(sp[4 * 33], sp[5 * 33]); o.w = pk2(sp[6 * 33], sp[7 * 33]);
            *(v4u*)((bf16*)dstv + (size_t)n * lddst + 8 * c) = o; } }
    LDS_WAIT();
}
__device__ __forceinline__ void tr_item(const float* src, int ldsrc, const float* gain, bf16* dst, int lddst, LAS float* scr, int lane) { tr_item_t<false>(src, ldsrc, gain, dst, lddst, 1.f, scr, lane); }
__device__ __forceinline__ void convert_experts(const Args& a, int L, LAS float* scr, int gw, int NGW, int lane);
__device__ __forceinline__ void convert_experts_dyn(const Args& a, int L, LAS unsigned char* lds, unsigned* ctr) {
    const int wave = __builtin_amdgcn_readfirstlane((int)threadIdx.x >> 6), lane = (int)threadIdx.x & 63;
    LAS int* slot = (LAS int*)(lds + 8 * 8448);
    for (;;) {
        __syncthreads();
        if (threadIdx.x == 0) *slot = (int)atomicAdd(ctr, 64u);
        __syncthreads();
        const int base = __builtin_amdgcn_readfirstlane(*slot);
        if (base >= 12288) break;
        convert_experts(a, L, (LAS float*)(lds + wave * 8448), base + wave * 8, 8, lane);
    }
}
__device__ __forceinline__ void convert_experts(const Args& a, int L, LAS float* scr, int gw, int NGW, int lane) {
    bf16* WGU = (bf16*)(a.ws + ws_wgu(L)); bf16* WD = (bf16*)(a.ws + ws_wd(L));
    const float* gain = a.in[I_FFN] + L * D;
    constexpr int I_GU = 16 * 16 * 16, I_DN = 16 * 8 * 32;
    const int it_end = NGW == 8 ? (gw + 8 < 2 * I_GU + I_DN ? gw + 8 : 2 * I_GU + I_DN) : 2 * I_GU + I_DN, it_step = NGW == 8 ? 1 : NGW;
    for (int it = gw; it < it_end; it += it_step) {
        int r = it;
        if (r < 2 * I_GU) {
            const int up = r >= I_GU; if (up) r -= I_GU;
            const int e = r >> 8, kb = (r >> 4) & 15, nb = r & 15;
            const float* src = a.in[up ? I_EWU : I_EWG] + ((size_t)(L * 16 + e) * 1024 + kb * 64) * 512 + nb * 32;
            const int drow = e * 1024 + (nb >> 2) * 256 + (nb & 3) * 32 + (up ? 128 : 0);
#if MOE_UP_F8
            tr_item_t<true>(src, 512, gain + kb * 64, (unsigned char*)WGU + (size_t)drow * 1024 + kb * 64, 1024, 32.f, scr, lane);
#else
            tr_item(src, 512, gain + kb * 64, WGU + (size_t)drow * 1024 + kb * 64, 1024, scr, lane);
#endif
        } else {
            r -= 2 * I_GU;
            const int e = r >> 8, kb = (r >> 5) & 7, nb = r & 31;
            const float* src = a.in[I_EWD] + ((size_t)(L * 16 + e) * 512 + kb * 64) * 1024 + nb * 32;
#if MOE_DOWN_F8
            tr_item_t<true>(src, 1024, nullptr, (unsigned char*)WD + (size_t)(e * 1024 + nb * 32) * 512 + kb * 64, 512, 16.f, scr, lane);
#else
            tr_item(src, 1024, nullptr, WD + (size_t)(e * 1024 + nb * 32) * 512 + kb * 64, 512, scr, lane);
#endif
        }
    }
}
__device__ __forceinline__ void ph_prep(const Args& a, LAS unsigned char* lds, int wk, int nwk) {
    const int tid = threadIdx.x, lane = tid & 63, wave = __builtin_amdgcn_readfirstlane(tid >> 6);
    const int gw = wk * NWAVES + wave, NGW = nwk * NWAVES;
    LAS float* scr = (LAS float*)(lds + wave * 8448);
    bf16* WIN = (bf16*)(a.ws + WS_WIN); bf16* WOUT = (bf16*)(a.ws + WS_WOUT); bf16* WPOOL = (bf16*)(a.ws + WS_WPOOL);
    constexpr int I_IN = 16 * 144, I_OUT = 32 * 32, I_POOL = 4 * 4 * 8;
    for (int it = gw; it < I_IN + I_OUT + I_POOL; it += NGW) {
        int r = it;
        if (r < I_IN) { const int kb = r / 144, nb = r % 144, n0 = nb * 32;
            const int sc = n0 < 1024 ? n0 : (n0 < 2048 ? n0 - 1024 + 2576 : (n0 < 3584 ? n0 - 2048 + 1024 : n0 - 3584 + 3600));
            tr_item(a.in[I_WIN] + (size_t)(kb * 64) * PROJ_SRC + sc, PROJ_SRC, a.in[I_MNE] + kb * 64, WIN + (size_t)n0 * 1024 + kb * 64, 1024, scr, lane); continue; }
        r -= I_IN;
        if (r < I_OUT) { const int kb = r >> 5, nb = r & 31;
            tr_item(a.in[I_WOUT] + (size_t)(kb * 64) * 1024 + nb * 32, 1024, kb < 16 ? a.in[I_SNORM] + kb * 64 : nullptr, WOUT + (size_t)(nb * 32) * 2048 + kb * 64, 2048, scr, lane); continue; }
        r -= I_OUT;
        { const int g = r >> 5, kb = (r >> 3) & 3, nb = r & 7;
            tr_item(a.in[I_PW] + (size_t)g * 65536 + (size_t)(kb * 64) * 256 + nb * 32, 256, a.in[I_MNO] + g * 256 + kb * 64, WPOOL + (size_t)(g * 256 + nb * 32) * 256 + kb * 64, 256, scr, lane); }
    }
    {
        v4u* WRT = (v4u*)(a.ws + WS_WRT); v4u* WDTT = (v4u*)(a.ws + WS_WDTT);
        for (int i = wk * 512 + tid; i < 2 * 48 * 128 + 256 * 128; i += nwk * 512) {
            float f[8];
            if (i < 2 * 48 * 128) {
                const int L = i / 6144, r = i % 6144, n = r >> 7, k8 = (r & 127) * 8, j = n < 20 ? n : n - 20;
#pragma unroll
                for (int e = 0; e < 8; ++e) { const int k = k8 + e; float w = 0.f;
                    if (n < 40) { w = (j < 4 ? a.in[I_RGW][((size_t)L * 1024 + k) * 4 + j] : a.in[I_REW][((size_t)L * 1024 + k) * 16 + (j - 4)]) * a.in[I_FFN][L * 1024 + k];
                        if (n >= 20) w -= bf2f(f2bf(w)); }
                    f[e] = w; }
                v4u o; o.x = pk2(f[0], f[1]); o.y = pk2(f[2], f[3]); o.z = pk2(f[4], f[5]); o.w = pk2(f[6], f[7]); WRT[i] = o;
            } else {
                const int r = i - 2 * 48 * 128, n = r >> 7, k8 = (r & 127) * 8;
#pragma unroll
                for (int e = 0; e < 8; ++e) { const int k = k8 + e; f[e] = n < 16 ? a.in[I_WIN][(size_t)k * PROJ_SRC + 2560 + n] * a.in[I_MNE][k] : 0.f; }
                v4u o; o.x = pk2(f[0], f[1]); o.y = pk2(f[2], f[3]); o.z = pk2(f[4], f[5]); o.w = pk2(f[6], f[7]); WDTT[r] = o;
            }
        }
    }
    bf16* HB = (bf16*)a.out; float* RSTD0 = (float*)(a.ws + WS_RSTD0);
    for (int row = gw; row < T; row += 2 * NGW) {
        const int row2 = row + NGW; const bool has2 = row2 < T;
        const f32x4* xr = (const f32x4*)h0_row(a, row) + lane; const f32x4* xr2 = (const f32x4*)h0_row(a, has2 ? row2 : row) + lane;
        f32x4 v[4], v2[4]; float ss = 0.f, ss2 = 0.f;
#pragma unroll
        for (int j = 0; j < 4; ++j) { v[j] = xr[64 * j]; v2[j] = xr2[64 * j]; }
#pragma unroll
        for (int j = 0; j < 4; ++j) { ss += v[j].x * v[j].x + v[j].y * v[j].y + v[j].z * v[j].z + v[j].w * v[j].w; ss2 += v2[j].x * v2[j].x + v2[j].y * v2[j].y + v2[j].z * v2[j].z + v2[j].w * v2[j].w; }
#pragma unroll
        for (int o = 1; o < 64; o <<= 1) { ss += __shfl_xor(ss, o); ss2 += __shfl_xor(ss2, o); }
        v2u* o8 = (v2u*)(HB + (size_t)row * D) + lane;
#pragma unroll
        for (int j = 0; j < 4; ++j) { v2u w; w.x = pk2(v[j].x, v[j].y); w.y = pk2(v[j].z, v[j].w); o8[64 * j] = w; }
        if (lane == 0) RSTD0[row] = rsqrtf(ss * (1.f / D) + EPS);
        if (has2) { v2u* o82 = (v2u*)(HB + (size_t)row2 * D) + lane;
#pragma unroll
            for (int j = 0; j < 4; ++j) { v2u w; w.x = pk2(v2[j].x, v2[j].y); w.y = pk2(v2[j].z, v2[j].w); o82[64 * j] = w; }
            if (lane == 0) RSTD0[row2] = rsqrtf(ss2 * (1.f / D) + EPS); }
    }
}

template <int NT, class BP, class KS>
__device__ __forceinline__ void sg_kloop(int K, const bf16* const (&arow)[4], BP bp, KS ks, f32x4 (&acc)[4][NT], int fr, int fq) {
    for (int k0 = 0; k0 < K; k0 += 32) {
        ks(k0, acc);
        bf16x8 av[4], bv[NT];
#pragma unroll
        for (int mi = 0; mi < 4; ++mi) av[mi] = *(const bf16x8*)(arow[mi] + k0 + 8 * fq);
#pragma unroll
        for (int nj = 0; nj < NT; ++nj) bv[nj] = *(const bf16x8*)(bp(16 * nj + fr, k0) + 8 * fq);
#pragma unroll
        for (int mi = 0; mi < 4; ++mi)
#pragma unroll
            for (int nj = 0; nj < NT; ++nj) acc[mi][nj] = __builtin_amdgcn_mfma_f32_16x16x32_bf16(bv[nj], av[mi], acc[mi][nj], 0, 0, 0);
    }
}
template <int NT> __device__ __forceinline__ void zero_acc(f32x4 (&acc)[4][NT]) {
#pragma unroll
    for (int mi = 0; mi < 4; ++mi)
#pragma unroll
        for (int nj = 0; nj < NT; ++nj) acc[mi][nj] = (f32x4){0.f, 0.f, 0.f, 0.f};
}
struct NoKS { template <int NT> __device__ __forceinline__ void operator()(int, f32x4 (&)[4][NT]) const {} };

__device__ __forceinline__ void ph_gemm1(const Args& a, int wk, int nwk) {
    const int tid = threadIdx.x, lane = tid & 63, wave = __builtin_amdgcn_readfirstlane(tid >> 6), fr = lane & 15, fq = lane >> 4;
    const int gw = wk * NWAVES + wave, NGW = nwk * NWAVES;
    const bf16* HB = (const bf16*)a.out; const bf16* WIN = (const bf16*)(a.ws + WS_WIN); bf16* PROJ = (bf16*)(a.ws + WS_PROJ);
    const float* RSTD0 = (const float*)(a.ws + WS_RSTD0);
    for (int u = gw; u < 258 * 72; u += NGW) {
        const int rt = u / 72, ct = u % 72;
        const bf16* arow[4];
#pragma unroll
        for (int mi = 0; mi < 4; ++mi) arow[mi] = HB + (size_t)(rt * 64 + 16 * mi + fr) * D;
        f32x4 acc[4][4]; zero_acc(acc);
        sg_kloop<4>(1024, arow, [=](int n, int k0) { return WIN + (size_t)(ct * 64 + n) * 1024 + k0; }, NoKS(), acc, fr, fq);
#pragma unroll
        for (int mi = 0; mi < 4; ++mi) { const int row = rt * 64 + 16 * mi + fr; const float rs = RSTD0[row];
#pragma unroll
            for (int nj = 0; nj < 4; ++nj) { const f32x4 v = acc[mi][nj] * rs; v2u w; w.x = pk2(v.x, v.y); w.y = pk2(v.z, v.w);
                *(v2u*)(PROJ + (size_t)row * LDP + ct * 64 + 16 * nj + 4 * fq) = w; } }
    }
}

__device__ __forceinline__ void ph_gemm2(const Args& a, int wk, int nwk) {
    const int tid = threadIdx.x, lane = tid & 63, wave = __builtin_amdgcn_readfirstlane(tid >> 6), fr = lane & 15, fq = lane >> 4;
    const int gw = wk * NWAVES + wave, NGW = nwk * NWAVES;
    const bf16* PROJ = (const bf16*)(a.ws + WS_PROJ); const bf16* WOUT = (const bf16*)(a.ws + WS_WOUT);
    const float* SSDSQ = (const float*)(a.ws + WS_SSDSQ);
    float* H = (float*)(a.ws + WS_H); bf16* HB = (bf16*)a.out;
    for (int u = gw; u < 258 * 16; u += NGW) {
        const int rt = u / 16, ct = u % 16;
        const bf16* arow[4]; float f0[4], f1[4];
#pragma unroll
        for (int mi = 0; mi < 4; ++mi) { const int row = rt * 64 + 16 * mi + fr; arow[mi] = PROJ + (size_t)row * LDP;
            const f32x4* sq = (const f32x4*)(SSDSQ + (size_t)row * 16); const f32x4 q0 = sq[0], q1 = sq[1], q2 = sq[2], q3 = sq[3];
            const float s0 = (q0.x + q0.y + q0.z + q0.w) + (q1.x + q1.y + q1.z + q1.w), s1 = (q2.x + q2.y + q2.z + q2.w) + (q3.x + q3.y + q3.z + q3.w);
            const float r0 = rsqrtf(s0 * (1.f / 512.f) + EPS), r1 = rsqrtf(s1 * (1.f / 512.f) + EPS);
            f0[mi] = r0 / r1; f1[mi] = r1; }
        f32x4 acc[4][4]; zero_acc(acc);
        auto ks = [=](int k0, f32x4 (&ac)[4][4]) {
            if (k0 == 512) {
#pragma unroll
                for (int mi = 0; mi < 4; ++mi)
#pragma unroll
                    for (int nj = 0; nj < 4; ++nj) ac[mi][nj] *= f0[mi]; }
            if (k0 == 1024) {
#pragma unroll
                for (int mi = 0; mi < 4; ++mi)
#pragma unroll
                    for (int nj = 0; nj < 4; ++nj) ac[mi][nj] *= f1[mi]; }
        };
        sg_kloop<4>(2048, arow, [=](int n, int k0) { return WOUT + (size_t)(ct * 64 + n) * 2048 + k0; }, ks, acc, fr, fq);
#pragma unroll
        for (int mi = 0; mi < 4; ++mi) { const int row = rt * 64 + 16 * mi + fr; const float* hr = h0_row(a, row);
#pragma unroll
            for (int nj = 0; nj < 4; ++nj) { const int c = ct * 64 + 16 * nj + 4 * fq; const f32x4 v = acc[mi][nj] + *(const f32x4*)(hr + c);
                *(f32x4*)(H + (size_t)row * D + c) = v; v2u w; w.x = pk2(v.x, v.y); w.y = pk2(v.z, v.w); *(v2u*)(HB + (size_t)row * D + c) = w; } }
    }
}


namespace pg8 {
constexpr int BM = 256, BK = 64, HALF = 128, HTB = HALF * BK * 2, STAGE_BYTES = 8 * HTB, NXCD = 8, WGM = 8;
__host__ __device__ __forceinline__ int lds_byte(int r, int c) { const int st = (r >> 4) * 2 + (c >> 5), rr = r & 15, cc = c & 31, ob = rr * 64 + cc * 2; return st * 1024 + (ob ^ (((ob >> 9) & 1) << 5)); }
__host__ __device__ __forceinline__ void stage_rc(int b, int& R, int& C) { const int st = b / 1024, sb = b % 1024, swz = sb ^ (((sb >> 9) & 1) << 5); R = (st >> 1) * 16 + swz / 64; C = (st & 1) * 32 + (swz % 64) / 2; }
__host__ __device__ __forceinline__ int perm32(int rho) { const int n = rho >> 4, i = rho & 15; return 8 * (i >> 2) + 4 * n + (i & 3); }
__device__ __forceinline__ unsigned cvt_pk_bf16(float lo, float hi) { unsigned r; asm volatile("v_cvt_pk_bf16_f32 %0, %1, %2" : "=v"(r) : "v"(lo), "v"(hi)); return r; }
typedef f32x4 Acc[2][2][4][2];

__device__ __forceinline__ bool static_order(int nM, int nN, int G, int c, int i, int& pm, int& pn) {
    const int nwg = nM * nN; const long L = (long)i * G + c; if (L >= nwg) return false;
    int wgid = (int)L; { const int q = nwg / NXCD, r = nwg % NXCD, xcd = wgid % NXCD, off = wgid / NXCD; wgid = (xcd < r ? xcd * (q + 1) : r * (q + 1) + (xcd - r) * q) + off; }
    const int nig = WGM * nN, gid = wgid / nig, fm = gid * WGM, gsz = (nM - fm) < WGM ? (nM - fm) : WGM;
    pm = fm + ((wgid % nig) % gsz); pn = (wgid % nig) / gsz; return true;
}

template <class P, bool ALIGN_EPI>
__device__ __forceinline__ void gemm_phase(LAS unsigned char* lds, const P& S) {
    const int tid = threadIdx.x, wid = __builtin_amdgcn_readfirstlane(tid >> 6), lane = tid & 63, wr = wid >> 2, wc = wid & 3, fr = lane & 15, fq = lane >> 4;
    const int nt = S.nt;
    int RA[2], CA[2]; unsigned voffB[2];
#pragma unroll
    for (int i = 0; i < 2; ++i) { int R, C; stage_rc(tid * 16 + i * 8192, R, C); RA[i] = R; CA[i] = C; const int Rb = P::PERM ? ((R & ~31) + perm32(R & 31)) : R;
        voffB[i] = (unsigned)(Rb * S.ldb + C) * 2u; }
    const size_t kstep = (size_t)(BK * 2);
    const size_t hstepB = (size_t)HALF * S.ldb * 2;
    const unsigned ldsw = (unsigned)wid * 1024u;
    const int aoff = lds_byte(wr * 64 + fr, fq * 8), boff = lds_byte(wc * 32 + fr, fq * 8);
#define PG8_SA(b, h) (((b) * 2 + (h)) * HTB)
#define PG8_SB(b, h) ((4 + (b) * 2 + (h)) * HTB)
#define PG8_STAGE(bufoff, gbase, voff) do { _Pragma("unroll") for (int _i = 0; _i < 2; ++_i) \
        __builtin_amdgcn_global_load_lds((const unsigned*)((const char*)(gbase) + (voff)[_i]), (LAS unsigned*)(lds + (bufoff) + ldsw + _i * 8192), 16, 0, 0); } while (0)
#define PG8_LDA(dst, b, h) do { _Pragma("unroll") for (int m = 0; m < 4; ++m) _Pragma("unroll") for (int k = 0; k < 2; ++k) dst[m][k] = *(const LAS bf16x8*)(lds + PG8_SA(b, h) + aoff + m * 2048 + k * 1024); } while (0)
#define PG8_LDB(dst, b, h) do { _Pragma("unroll") for (int n = 0; n < 2; ++n) _Pragma("unroll") for (int k = 0; k < 2; ++k) dst[n][k] = *(const LAS bf16x8*)(lds + PG8_SB(b, h) + boff + n * 2048 + k * 1024); } while (0)
#define PG8_MMA(ai, bj, At, Bt) do { __builtin_amdgcn_s_setprio(1); _Pragma("unroll") for (int m = 0; m < 4; ++m) _Pragma("unroll") for (int n = 0; n < 2; ++n) _Pragma("unroll") for (int k = 0; k < 2; ++k) \
        acc[ai][bj][m][n] = __builtin_amdgcn_mfma_f32_16x16x32_bf16(Bt[n][k], At[m][k], acc[ai][bj][m][n], 0, 0, 0); __builtin_amdgcn_s_setprio(0); } while (0)
#define PG8_WAIT_V(n) asm volatile("s_waitcnt vmcnt(" #n ")" ::: "memory")
#define PG8_WAIT_L(n) asm volatile("s_waitcnt lgkmcnt(" #n ")" ::: "memory")
#define PG8_BAR __builtin_amdgcn_s_barrier()
#define PG8_SCHED __builtin_amdgcn_sched_barrier(0)
    typename P::Unit cur, nxt; int ui = 0;
    if (!S.next(0, cur)) return;
    f32x4 acc[2][2][4][2];
#pragma unroll
    for (int a = 0; a < 2; ++a)
#pragma unroll
        for (int b = 0; b < 2; ++b)
#pragma unroll
            for (int m = 0; m < 4; ++m)
#pragma unroll
                for (int n = 0; n < 2; ++n) acc[a][b][m][n] = (f32x4){0.f, 0.f, 0.f, 0.f};
    bf16x8 At[4][2], B0[2][2], B1[2][2];
    typename P::EpiRegs er;
    unsigned vA[4];
    S.a_ready(cur);
    S.avoff(cur, RA, CA, vA);
    const char* cA = S.abase(cur);
    {
        const char* b0 = S.btile(cur, 0); const char* b1 = S.btile(cur, 1);
        PG8_STAGE(PG8_SB(0, 0), b0, voffB); PG8_STAGE(PG8_SB(0, 1), b0 + hstepB, voffB); PG8_STAGE(PG8_SA(0, 0), cA, vA); PG8_STAGE(PG8_SA(0, 1), cA, vA + 2);
        if (wr == 1) PG8_BAR;
        PG8_WAIT_V(2); PG8_BAR;
        PG8_STAGE(PG8_SB(1, 0), b1, voffB); PG8_STAGE(PG8_SA(1, 0), cA + kstep, vA); PG8_STAGE(PG8_SB(1, 1), b1 + hstepB, voffB);
        PG8_WAIT_V(6); PG8_BAR;
    }
    for (;;) {
        const bool has_next = S.next(ui + 1, nxt);
        for (int t = 0; t < nt; t += 2) {
            const bool last = (t == nt - 2);
            const char* a1 = cA + (size_t)(t + 1) * kstep;
            S.khook(t, acc, cur, lds, wr, wc, fr, fq);
            if (last) S.epi_pre(cur, er, wr, wc, fr, fq);
            PG8_LDB(B0, 0, 0); PG8_LDB(B1, 0, 1); PG8_SCHED; PG8_LDA(At, 0, 0); PG8_STAGE(PG8_SA(1, 1), a1, vA + 2);
            PG8_WAIT_V(8); PG8_WAIT_L(0); PG8_BAR; PG8_MMA(0, 0, At, B0); PG8_MMA(0, 1, At, B1); PG8_BAR; PG8_SCHED;
            const bool sw = last && has_next;
            if (sw) { S.a_ready(nxt);
                int t2 = tid; asm volatile("" : "+v"(t2));
                int RA2[2], CA2[2];
#pragma unroll
                for (int i = 0; i < 2; ++i) stage_rc(t2 * 16 + i * 8192, RA2[i], CA2[i]);
                S.avoff(nxt, RA2, CA2, vA); }
            const char* a2 = last ? (sw ? S.abase(nxt) : cA) : cA + (size_t)(t + 2) * kstep;
            const char* b2 = last ? (sw ? S.btile(nxt, 0) : S.btile(cur, 0)) : S.btile(cur, t + 2);
            const char* b3 = last ? (sw ? S.btile(nxt, 1) : S.btile(cur, 1)) : S.btile(cur, t + 3);
            const char* a3 = a2 + kstep;
            PG8_LDA(At, 0, 1); PG8_STAGE(PG8_SB(0, 0), b2, voffB); PG8_STAGE(PG8_SB(0, 1), b2 + hstepB, voffB); PG8_STAGE(PG8_SA(0, 0), a2, vA);
            PG8_WAIT_V(8); PG8_WAIT_L(0); PG8_BAR; PG8_MMA(1, 0, At, B0); PG8_MMA(1, 1, At, B1); PG8_BAR; PG8_SCHED;
            PG8_LDB(B0, 1, 0); PG8_LDB(B1, 1, 1); PG8_SCHED; PG8_LDA(At, 1, 0); PG8_STAGE(PG8_SA(0, 1), a2, vA + 2);
            PG8_WAIT_V(8); PG8_WAIT_L(0); PG8_BAR; PG8_MMA(0, 0, At, B0); PG8_MMA(0, 1, At, B1); PG8_BAR; PG8_SCHED;
            PG8_LDA(At, 1, 1); PG8_STAGE(PG8_SB(1, 0), b3, voffB); PG8_STAGE(PG8_SB(1, 1), b3 + hstepB, voffB); PG8_STAGE(PG8_SA(1, 0), a3, vA);
            PG8_WAIT_V(8); PG8_WAIT_L(0); PG8_BAR; PG8_MMA(1, 0, At, B0); PG8_MMA(1, 1, At, B1); PG8_BAR; PG8_SCHED;
        }
        if constexpr (ALIGN_EPI) { if (wr == 0) PG8_BAR; }
        S.epi(acc, cur, er, wr, wc, fr, fq);
        S.done(cur);
        if (!has_next) break;
#pragma unroll
        for (int a = 0; a < 2; ++a)
#pragma unroll
            for (int b = 0; b < 2; ++b)
#pragma unroll
                for (int m = 0; m < 4; ++m)
#pragma unroll
                    for (int n = 0; n < 2; ++n) acc[a][b][m][n] = (f32x4){0.f, 0.f, 0.f, 0.f};
        cur = nxt; cA = S.abase(cur); ++ui;
        if constexpr (ALIGN_EPI) { if (wr == 1) PG8_BAR; }
    }
    PG8_WAIT_V(0);
    if constexpr (!ALIGN_EPI) { if (wr == 0) PG8_BAR; }
    PG8_BAR;
#undef PG8_SA
#undef PG8_SB
#undef PG8_STAGE
#undef PG8_LDA
#undef PG8_LDB
#undef PG8_MMA
#undef PG8_WAIT_V
#undef PG8_WAIT_L
#undef PG8_BAR
#undef PG8_SCHED
}
typedef int v4i __attribute__((ext_vector_type(4)));
typedef int v8i __attribute__((ext_vector_type(8)));
template <class P, bool ALIGN_EPI>
__device__ __forceinline__ void gemm_phase_f8(LAS unsigned char* lds, const P& S) {
    const int tid = threadIdx.x, wid = __builtin_amdgcn_readfirstlane(tid >> 6), lane = tid & 63, wr = wid >> 2, wc = wid & 3, fr = lane & 15, fq = lane >> 4;
    const int nt = S.nt;
    int RA[2], CA[2]; unsigned voffB[2];
#pragma unroll
    for (int i = 0; i < 2; ++i) { int R, C; stage_rc(tid * 16 + i * 8192, R, C); RA[i] = R; CA[i] = C; const int Rb = P::PERM ? ((R & ~31) + perm32(R & 31)) : R;
        voffB[i] = (unsigned)(Rb * S.ldbB + C * 2); }
    const size_t kstep = (size_t)(BK * 2);
    const size_t hstepB = (size_t)HALF * S.ldbB;
    const unsigned ldsw = (unsigned)wid * 1024u;
    const int aoff0 = lds_byte(wr * 64 + fr, fq * 8), boff0 = lds_byte(wc * 32 + fr, fq * 8);
#define PG8_SA(b, h) (((b) * 2 + (h)) * HTB)
#define PG8_SB(b, h) ((4 + (b) * 2 + (h)) * HTB)
#define PG8_STAGE(bufoff, gbase, voff) do { _Pragma("unroll") for (int _i = 0; _i < 2; ++_i) \
        __builtin_amdgcn_global_load_lds((const unsigned*)((const char*)(gbase) + (voff)[_i]), (LAS unsigned*)(lds + (bufoff) + ldsw + _i * 8192), 16, 0, 0); } while (0)
#define PG8_LDA(dst, b, h) do { _Pragma("unroll") for (int m = 0; m < 4; ++m) { const v4i lo_ = *(const LAS v4i*)(lds + PG8_SA(b, h) + aoff0 + m * 2048), hi_ = *(const LAS v4i*)(lds + PG8_SA(b, h) + aoff0 + m * 2048 + 1024); dst[m] = __builtin_shufflevector(lo_, hi_, 0, 1, 2, 3, 4, 5, 6, 7); } } while (0)
#define PG8_LDB(dst, b, h) do { _Pragma("unroll") for (int n = 0; n < 2; ++n) { const v4i lo_ = *(const LAS v4i*)(lds + PG8_SB(b, h) + boff0 + n * 2048), hi_ = *(const LAS v4i*)(lds + PG8_SB(b, h) + boff0 + n * 2048 + 1024); dst[n] = __builtin_shufflevector(lo_, hi_, 0, 1, 2, 3, 4, 5, 6, 7); } } while (0)
#define PG8_MMA(ai, bj, At, Bt) do { __builtin_amdgcn_s_setprio(1); _Pragma("unroll") for (int m = 0; m < 4; ++m) _Pragma("unroll") for (int n = 0; n < 2; ++n) \
        acc[ai][bj][m][n] = __builtin_amdgcn_mfma_scale_f32_16x16x128_f8f6f4(Bt[n], At[m], acc[ai][bj][m][n], 0, 0, 0, 0x7f7f7f7f, 0, 0x7f7f7f7f); __builtin_amdgcn_s_setprio(0); } while (0)
#define PG8_WAIT_V(n) asm volatile("s_waitcnt vmcnt(" #n ")" ::: "memory")
#define PG8_WAIT_L(n) asm volatile("s_waitcnt lgkmcnt(" #n ")" ::: "memory")
#define PG8_BAR __builtin_amdgcn_s_barrier()
#define PG8_SCHED __builtin_amdgcn_sched_barrier(0)
    typename P::Unit cur, nxt; int ui = 0;
    if (!S.next(0, cur)) return;
    f32x4 acc[2][2][4][2];
#pragma unroll
    for (int a = 0; a < 2; ++a)
#pragma unroll
        for (int b = 0; b < 2; ++b)
#pragma unroll
            for (int m = 0; m < 4; ++m)
#pragma unroll
                for (int n = 0; n < 2; ++n) acc[a][b][m][n] = (f32x4){0.f, 0.f, 0.f, 0.f};
    v8i At[4], B0[2], B1[2];
    typename P::EpiRegs er;
    unsigned vA[4];
    S.a_ready(cur);
    S.avoff(cur, RA, CA, vA);
    const char* cA = S.abase(cur);
    {
        const char* b0 = S.btile(cur, 0); const char* b1 = S.btile(cur, 1);
        PG8_STAGE(PG8_SB(0, 0), b0, voffB); PG8_STAGE(PG8_SB(0, 1), b0 + hstepB, voffB); PG8_STAGE(PG8_SA(0, 0), cA, vA); PG8_STAGE(PG8_SA(0, 1), cA, vA + 2);
        if (wr == 1) PG8_BAR;
        PG8_WAIT_V(2); PG8_BAR;
        PG8_STAGE(PG8_SB(1, 0), b1, voffB); PG8_STAGE(PG8_SA(1, 0), cA + kstep, vA); PG8_STAGE(PG8_SB(1, 1), b1 + hstepB, voffB);
        PG8_WAIT_V(6); PG8_BAR;
    }
    for (;;) {
        const bool has_next = S.next(ui + 1, nxt);
        unsigned vAn[4] = {0u, 0u, 0u, 0u};
        if (P::VA_LDS && has_next) {
            int t2 = tid; asm volatile("" : "+v"(t2));
            int RA2[2], CA2[2];
#pragma unroll
            for (int i = 0; i < 2; ++i) stage_rc(t2 * 16 + i * 8192, RA2[i], CA2[i]);
            S.avoff(nxt, RA2, CA2, vAn); }
        for (int t = 0; t < nt; t += 2) {
            const bool last = (t == nt - 2);
            const char* a1 = cA + (size_t)(t + 1) * kstep;
            S.khook(t, acc, cur, lds, wr, wc, fr, fq);
            if (last) S.epi_pre(cur, er, wr, wc, fr, fq);
            PG8_LDB(B0, 0, 0); PG8_LDB(B1, 0, 1); PG8_SCHED; PG8_LDA(At, 0, 0); PG8_STAGE(PG8_SA(1, 1), a1, vA + 2);
            PG8_WAIT_V(8); PG8_WAIT_L(0); PG8_BAR; PG8_MMA(0, 0, At, B0); PG8_MMA(0, 1, At, B1); PG8_BAR; PG8_SCHED;
            const bool sw = last && has_next;
            if (sw) { S.a_ready(nxt);
                if (P::VA_LDS) {
#pragma unroll
                    for (int i = 0; i < 4; ++i) vA[i] = vAn[i]; }
                else { int t2 = tid; asm volatile("" : "+v"(t2)); int RA2[2], CA2[2];
#pragma unroll
                    for (int i = 0; i < 2; ++i) stage_rc(t2 * 16 + i * 8192, RA2[i], CA2[i]);
                    S.avoff(nxt, RA2, CA2, vA); } }
            const char* a2 = last ? (sw ? S.abase(nxt) : cA) : cA + (size_t)(t + 2) * kstep;
            const char* b2 = last ? (sw ? S.btile(nxt, 0) : S.btile(cur, 0)) : S.btile(cur, t + 2);
            const char* b3 = last ? (sw ? S.btile(nxt, 1) : S.btile(cur, 1)) : S.btile(cur, t + 3);
            const char* a3 = a2 + kstep;
            PG8_LDA(At, 0, 1); PG8_STAGE(PG8_SB(0, 0), b2, voffB); PG8_STAGE(PG8_SB(0, 1), b2 + hstepB, voffB); PG8_STAGE(PG8_SA(0, 0), a2, vA);
            PG8_WAIT_V(8); PG8_WAIT_L(0); PG8_BAR; PG8_MMA(1, 0, At, B0); PG8_MMA(1, 1, At, B1); PG8_BAR; PG8_SCHED;
            PG8_LDB(B0, 1, 0); PG8_LDB(B1, 1, 1); PG8_SCHED; PG8_LDA(At, 1, 0); PG8_STAGE(PG8_SA(0, 1), a2, vA + 2);
            PG8_WAIT_V(8); PG8_WAIT_L(0); PG8_BAR; PG8_MMA(0, 0, At, B0); PG8_MMA(0, 1, At, B1); PG8_BAR; PG8_SCHED;
            PG8_LDA(At, 1, 1); PG8_STAGE(PG8_SB(1, 0), b3, voffB); PG8_STAGE(PG8_SB(1, 1), b3 + hstepB, voffB); PG8_STAGE(PG8_SA(1, 0), a3, vA);
            PG8_WAIT_V(8); PG8_WAIT_L(0); PG8_BAR; PG8_MMA(1, 0, At, B0); PG8_MMA(1, 1, At, B1); PG8_BAR; PG8_SCHED;
        }
        if constexpr (ALIGN_EPI) { if (wr == 0) PG8_BAR; }
        S.epi(acc, cur, er, wr, wc, fr, fq);
        S.done(cur);
        if (!has_next) break;
#pragma unroll
        for (int a = 0; a < 2; ++a)
#pragma unroll
            for (int b = 0; b < 2; ++b)
#pragma unroll
                for (int m = 0; m < 4; ++m)
#pragma unroll
                    for (int n = 0; n < 2; ++n) acc[a][b][m][n] = (f32x4){0.f, 0.f, 0.f, 0.f};
        cur = nxt; cA = S.abase(cur); ++ui;
        if constexpr (ALIGN_EPI) { if (wr == 1) PG8_BAR; }
    }
    PG8_WAIT_V(0);
    if constexpr (!ALIGN_EPI) { if (wr == 0) PG8_BAR; }
    PG8_BAR;
#undef PG8_SA
#undef PG8_SB
#undef PG8_STAGE
#undef PG8_LDA
#undef PG8_LDB
#undef PG8_MMA
#undef PG8_WAIT_V
#undef PG8_WAIT_L
#undef PG8_BAR
#undef PG8_SCHED
}
}

struct PGemm1 {
    static constexpr bool PERM = true;
    struct EpiRegs {};
    template <class U_> __device__ __forceinline__ void epi_pre(const U_&, EpiRegs&, int, int, int, int) const {}
    struct Unit { int pm, pn, ui; };
    const char* A; const char* B; const char* Bdt; bf16* O; const float* rstd; const LAS float* rstab; float* DT; const float* dtb; int G, c; int ldb, nt;
    __device__ __forceinline__ bool next(int i, Unit& u) const { u.ui = i; return pg8::static_order(65, 19, G, c, i, u.pm, u.pn); }
    __device__ __forceinline__ void avoff(const Unit& u, const int (&RA)[2], const int (&CA)[2], unsigned (&v)[4]) const {
#pragma unroll
        for (int h = 0; h < 2; ++h)
#pragma unroll
            for (int i = 0; i < 2; ++i) { int row = u.pm * 256 + h * 128 + RA[i]; row = row < T ? row : T - 1; v[h * 2 + i] = (unsigned)(row * D + CA[i]) * 2u; }
    }
    __device__ __forceinline__ const char* abase(const Unit&) const { return A; }
    __device__ __forceinline__ const char* btile(const Unit& u, int t) const { return (u.pn < 18 ? B + (size_t)u.pn * 256 * 1024 * 2 : Bdt) + (size_t)t * 64 * 2; }
    __device__ __forceinline__ void khook(int, pg8::Acc&, const Unit&, LAS unsigned char*, int, int, int, int) const {}
    __device__ __forceinline__ void a_ready(const Unit&) const {}
    __device__ __forceinline__ void done(const Unit&) const {}
    __device__ __forceinline__ void epi(const pg8::Acc& acc, const Unit& u, const EpiRegs&, int wr, int wc, int fr, int fq) const {
        const int row0 = u.pm * 256 + wr * 64 + fr, col0 = u.pn * 256 + wc * 32 + 8 * fq;
        float rsv[2][4];
#pragma unroll
        for (int ai = 0; ai < 2; ++ai)
#pragma unroll
            for (int m = 0; m < 4; ++m) rsv[ai][m] = rstab[u.ui * 256 + wr * 64 + fr + ai * 128 + m * 16];
        if (u.pn == 18) {
            if (wc == 0 && fq < 2) { const f32x4 b0 = *(const f32x4*)(dtb + 8 * fq), b1 = *(const f32x4*)(dtb + 8 * fq + 4);
#pragma unroll
                for (int ai = 0; ai < 2; ++ai)
#pragma unroll
                    for (int m = 0; m < 4; ++m) { const int row = row0 + ai * 128 + m * 16;
                        if (row < T) { const float rs = rsv[ai][m]; f32x4 d0 = acc[ai][0][m][0] * rs + b0, d1 = acc[ai][0][m][1] * rs + b1;
#pragma unroll
                            for (int j = 0; j < 4; ++j) { d0[j] = softplus_f(d0[j]); d1[j] = softplus_f(d1[j]); }
                            *(f32x4*)(DT + (size_t)row * 16 + 8 * fq) = d0; *(f32x4*)(DT + (size_t)row * 16 + 8 * fq + 4) = d1; } } }
            return; }
#pragma unroll
        for (int ai = 0; ai < 2; ++ai)
#pragma unroll
            for (int m = 0; m < 4; ++m) { const int row = row0 + ai * 128 + m * 16;
                if (row < T) { const float rs = rsv[ai][m]; bf16* rowp = O + (size_t)row * LDP + col0;
#pragma unroll
                    for (int bj = 0; bj < 2; ++bj) { const f32x4 v0 = acc[ai][bj][m][0] * rs, v1 = acc[ai][bj][m][1] * rs;
                        v4u w; w.x = pg8::cvt_pk_bf16(v0[0], v0[1]); w.y = pg8::cvt_pk_bf16(v0[2], v0[3]); w.z = pg8::cvt_pk_bf16(v1[0], v1[1]); w.w = pg8::cvt_pk_bf16(v1[2], v1[3]);
                        *(v4u*)(rowp + bj * 128) = w; } } }
    }
};
__device__ __forceinline__ void ph_gemm1_pg8(const Args& a, LAS unsigned char* lds, int G) {
    PGemm1 S; S.A = (const char*)a.out; S.B = (const char*)(a.ws + WS_WIN); S.O = (bf16*)(a.ws + WS_PROJ); S.rstd = (const float*)(a.ws + WS_RSTD0); S.Bdt = (const char*)(a.ws + WS_WDTT); S.DT = (float*)(a.ws + WS_DT); S.dtb = a.in[I_DTB];
    S.G = G; S.c = (int)blockIdx.x; S.ldb = 1024; S.nt = 16;
    {
        LAS float* rt = (LAS float*)(lds + LDS_TAB); S.rstab = rt; PGemm1::Unit u;
        __syncthreads();
        for (int i = 0; i < 8 && S.next(i, u); ++i) if (threadIdx.x < 256) { const int row = u.pm * 256 + (int)threadIdx.x; rt[i * 256 + threadIdx.x] = S.rstd[row < T ? row : T - 1]; }
        __syncthreads();
    }
    pg8::gemm_phase<PGemm1, true>(lds, S);
}

__device__ __forceinline__ void ssd_item(const Args& a, LAS unsigned char* lds, int b, int h) {
    const int tid = threadIdx.x, lane = tid & 63;
    constexpr int TB = 64;
    LAS float* xs = (LAS float*)lds;
    LAS float* Bs = xs + TB * 64;
    LAS float* Cs = Bs + TB * 128;
    LAS float* ys = Cs + TB * 128;
    LAS float* dts = ys + TB * 64;
    LAS float* decs = dts + TB;
    bf16* PROJ = (bf16*)(a.ws + WS_PROJ); const float* DT = (const float*)(a.ws + WS_DT); float* SSDSQ = (float*)(a.ws + WS_SSDSQ);
    const int g = h >> 3;
    const float Ah = -__expf(a.in[I_ALOG][h]), Dh = a.in[I_SD][h];
    int ccol = 0, cch = 0; float cw0 = 0.f, cw1 = 0.f, cw2 = 0.f, cw3 = 0.f, cb = 0.f;
    if (tid < 320) {
        if (tid < 64) { ccol = C_X + h * 64 + tid; cch = h * 64 + tid; }
        else if (tid < 192) { ccol = C_B + g * 128 + (tid - 64); cch = 1024 + g * 128 + (tid - 64); }
        else { ccol = C_C + g * 128 + (tid - 192); cch = 1280 + g * 128 + (tid - 192); }
        const float* cw = a.in[I_SCW]; cw0 = cw[cch]; cw1 = cw[1536 + cch]; cw2 = cw[2 * 1536 + cch]; cw3 = cw[3 * 1536 + cch]; cb = a.in[I_SCB][cch];
    }
    const int p = tid >> 3, nq = tid & 7;
    float S[16];
#pragma unroll
    for (int i = 0; i < 16; ++i) S[i] = 0.f;
    const size_t rbase = (size_t)b * LSEQ;
    for (int l0 = 0; l0 < LSEQ; l0 += TB) {
        const int nt = (LSEQ - l0) < TB ? (LSEQ - l0) : TB;
        __syncthreads();
        if (tid < 320) {
            float r0 = l0 >= 3 ? bf2f(PROJ[(rbase + l0 - 3) * LDP + ccol]) : 0.f, r1 = l0 >= 2 ? bf2f(PROJ[(rbase + l0 - 2) * LDP + ccol]) : 0.f, r2 = l0 >= 1 ? bf2f(PROJ[(rbase + l0 - 1) * LDP + ccol]) : 0.f;
            for (int t = 0; t < nt; ++t) {
                const float r3 = bf2f(PROJ[(rbase + l0 + t) * LDP + ccol]);
                const float v = silu_f(cw0 * r0 + cw1 * r1 + cw2 * r2 + cw3 * r3 + cb);
                if (tid < 64) xs[t * 64 + tid] = v; else if (tid < 192) Bs[t * 128 + tid - 64] = v; else Cs[t * 128 + tid - 192] = v;
                r0 = r1; r1 = r2; r2 = r3;
            }
        } else if (tid < 320 + TB) {
            const int t = tid - 320;
            if (t < nt) { const float dt = DT[(rbase + l0 + t) * 16 + h]; dts[t] = dt; decs[t] = __expf(Ah * dt); }
        }
        __syncthreads();
        for (int t = 0; t < nt; ++t) {
            const float xv = xs[t * 64 + p], xdt = xv * dts[t], dec = decs[t];
            float yp = 0.f;
#pragma unroll
            for (int i = 0; i < 16; ++i) { S[i] = dec * S[i] + Bs[t * 128 + nq * 16 + i] * xdt; yp += Cs[t * 128 + nq * 16 + i] * S[i]; }
            yp += __shfl_xor(yp, 1); yp += __shfl_xor(yp, 2); yp += __shfl_xor(yp, 4);
            if (nq == 0) ys[t * 64 + p] = yp + Dh * xv;
        }
        __syncthreads();
        for (int t = tid >> 6; t < nt; t += 8) {
            const size_t row = rbase + l0 + t;
            const float z = bf2f(PROJ[row * LDP + C_Z + h * 64 + lane]);
            const float yg = ys[t * 64 + lane] * silu_f(z);
            PROJ[row * LDP + C_Z + h * 64 + lane] = (bf16)f2bf(yg);
            const float sq = wave_sum(yg * yg);
            if (lane == 0) SSDSQ[row * 16 + h] = sq;
        }
    }
    __syncthreads();
}
__device__ __forceinline__ void lru_item(const Args& a, LAS unsigned char* lds, int b, int h) {
    const int tid = threadIdx.x;
    constexpr int TB = 64;
    LAS float* Wa = (LAS float*)lds;
    LAS float* Wx = Wa + 4096;
    LAS float* xb = Wx + 4096;
    LAS float* as = xb + TB * 64;
    LAS float* us = as + TB * 64;
    bf16* PROJ = (bf16*)(a.ws + WS_PROJ);
    __syncthreads();
    for (int i = tid; i < 4096; i += 512) { Wa[i] = a.in[I_LWA][(size_t)h * 4096 + i]; Wx[i] = a.in[I_LWX][(size_t)h * 4096 + i]; }
    const size_t rbase = (size_t)b * LSEQ;
    float hprev = 0.f;
    const int c = tid & 63, tq = tid >> 6;
    const float* cw = a.in[I_LCW]; const int ch = h * 64 + c;
    const float cw0 = cw[ch], cw1 = cw[1024 + ch], cw2 = cw[2048 + ch], cw3 = cw[3072 + ch], cb = a.in[I_LCB][ch];
    const int gt = tid >> 3, jq = tid & 7;
    for (int l0 = 0; l0 < LSEQ; l0 += TB) {
        const int nt = (LSEQ - l0) < TB ? (LSEQ - l0) : TB;
        __syncthreads();
        for (int t = tq * 8; t < tq * 8 + 8; ++t) if (t < nt) {
            const int l = l0 + t; const size_t row = rbase + l;
            const float r3 = bf2f(PROJ[row * LDP + C_LI + ch]);
            const float r2 = l >= 1 ? bf2f(PROJ[(row - 1) * LDP + C_LI + ch]) : 0.f;
            const float r1 = l >= 2 ? bf2f(PROJ[(row - 2) * LDP + C_LI + ch]) : 0.f;
            const float r0 = l >= 3 ? bf2f(PROJ[(row - 3) * LDP + C_LI + ch]) : 0.f;
            xb[t * 64 + c] = cw0 * r0 + cw1 * r1 + cw2 * r2 + cw3 * r3 + cb;
        }
        __syncthreads();
        if (gt < nt) {
            float ra[8], ri[8];
#pragma unroll
            for (int j = 0; j < 8; ++j) { ra[j] = 0.f; ri[j] = 0.f; }
            for (int i = 0; i < 64; ++i) { const float xv = xb[gt * 64 + i];
#pragma unroll
                for (int j = 0; j < 8; ++j) { ra[j] += xv * Wa[i * 64 + jq * 8 + j]; ri[j] += xv * Wx[i * 64 + jq * 8 + j]; } }
#pragma unroll
            for (int j = 0; j < 8; ++j) { const int cc = h * 64 + jq * 8 + j;
                const float r = sigmoid_f(ra[j] + a.in[I_LBA][cc]), ig = sigmoid_f(ri[j] + a.in[I_LBX][cc]);
                const float log_a = -8.0f * r * softplus_f(-a.in[I_LLAM][cc]);
                const float av = __expf(log_a);
                const float mult = (l0 + gt == 0) ? 1.f : sqrtf(fmaxf(-expm1f(2.f * log_a), 0.f));
                as[gt * 64 + jq * 8 + j] = av; us[gt * 64 + jq * 8 + j] = mult * ig * xb[gt * 64 + jq * 8 + j]; }
        }
        __syncthreads();
        if (tid < 64) { for (int t = 0; t < nt; ++t) { hprev = as[t * 64 + tid] * hprev + us[t * 64 + tid]; us[t * 64 + tid] = hprev; } }
        __syncthreads();
        for (int t = tq * 8; t < tq * 8 + 8; ++t) if (t < nt) {
            const size_t row = rbase + l0 + t;
            const float gv = bf2f(PROJ[row * LDP + C_G + ch]);
            PROJ[row * LDP + C_G + ch] = (bf16)f2bf(us[t * 64 + c] * gelu_tanh_f(gv));
        }
    }
    __syncthreads();
}
__device__ __forceinline__ void ph_mixers(const Args& a, LAS unsigned char* lds, int wk, int nwk) {
    for (int it = wk; it < 256; it += nwk) {
        if (it < 128) ssd_item(a, lds, it >> 4, it & 15); else lru_item(a, lds, (it - 128) >> 4, (it - 128) & 15);
    }
}


__device__ __forceinline__ f32x4 mfma16(bf16x8 a, bf16x8 b, f32x4 c) { return __builtin_amdgcn_mfma_f32_16x16x32_bf16(a, b, c, 0, 0, 0); }
constexpr int RSX = 144, RSB = 272;
constexpr int SO_X = 0, SO_B = SO_X + 128 * RSX, SO_C = SO_B + 128 * RSB, SO_M = SO_C + 128 * RSB, SO_S = SO_M + 128 * RSB, SO_V = SO_S + 64 * RSB;
static_assert(SO_V + 4096 <= LDS_BYTES - 256, "ssd lds");
#define TR4(RS4, o0, o1, o2, o3, addr) do { v2u l0_, h0_, l1_, h1_, l2_, h2_, l3_, h3_; \
    asm volatile("ds_read_b64_tr_b16 %0, %8\n\tds_read_b64_tr_b16 %1, %8 offset:" #RS4 "\n\t" \
                 "ds_read_b64_tr_b16 %2, %8 offset:32\n\tds_read_b64_tr_b16 %3, %8 offset:" #RS4 "+32\n\t" \
                 "ds_read_b64_tr_b16 %4, %8 offset:64\n\tds_read_b64_tr_b16 %5, %8 offset:" #RS4 "+64\n\t" \
                 "ds_read_b64_tr_b16 %6, %8 offset:96\n\tds_read_b64_tr_b16 %7, %8 offset:" #RS4 "+96\n\ts_waitcnt lgkmcnt(0)" \
                 : "=&v"(l0_), "=&v"(h0_), "=&v"(l1_), "=&v"(h1_), "=&v"(l2_), "=&v"(h2_), "=&v"(l3_), "=&v"(h3_) : "v"(addr) : "memory"); \
    o0 = __builtin_bit_cast(bf16x8, (v4u){l0_.x, l0_.y, h0_.x, h0_.y}); o1 = __builtin_bit_cast(bf16x8, (v4u){l1_.x, l1_.y, h1_.x, h1_.y}); \
    o2 = __builtin_bit_cast(bf16x8, (v4u){l2_.x, l2_.y, h2_.x, h2_.y}); o3 = __builtin_bit_cast(bf16x8, (v4u){l3_.x, l3_.y, h3_.x, h3_.y}); } while (0)
#define TR1(RS4, o0, addr) do { v2u l0_, h0_; \
    asm volatile("ds_read_b64_tr_b16 %0, %2\n\tds_read_b64_tr_b16 %1, %2 offset:" #RS4 "\n\ts_waitcnt lgkmcnt(0)" : "=&v"(l0_), "=&v"(h0_) : "v"(addr) : "memory"); \
    o0 = __builtin_bit_cast(bf16x8, (v4u){l0_.x, l0_.y, h0_.x, h0_.y}); } while (0)
__device__ __forceinline__ void unpack8(const v4u r, float (&f)[8]) {
    f[0] = __uint_as_float(r.x << 16); f[1] = __uint_as_float(r.x & 0xffff0000u); f[2] = __uint_as_float(r.y << 16); f[3] = __uint_as_float(r.y & 0xffff0000u);
    f[4] = __uint_as_float(r.z << 16); f[5] = __uint_as_float(r.z & 0xffff0000u); f[6] = __uint_as_float(r.w << 16); f[7] = __uint_as_float(r.w & 0xffff0000u);
}
__device__ __forceinline__ void ph_conv(const Args& a, int wk, int nwk) {
    const bf16* PROJ = (const bf16*)(a.ws + WS_PROJ); bf16* XACT = (bf16*)(a.ws + WS_H);
    for (int id = wk * 512 + (int)threadIdx.x; id < NB * 48 * 192; id += nwk * 512) {
        const int cg = id % 192, rr = id / 192, b = rr / 48, t0 = (rr % 48) * 43;
        const int ch = cg * 8;
        const float* cwp = a.in[I_SCW] + ch;
        float cw[4][8], cb[8];
#pragma unroll
        for (int k = 0; k < 4; ++k) { const f32x4 wa = *(const f32x4*)(cwp + k * 1536), wb = *(const f32x4*)(cwp + k * 1536 + 4);
#pragma unroll
            for (int j = 0; j < 4; ++j) { cw[k][j] = wa[j]; cw[k][4 + j] = wb[j]; } }
        { const float* cbp = a.in[I_SCB] + ch; const f32x4 wa = *(const f32x4*)cbp, wb = *(const f32x4*)(cbp + 4);
#pragma unroll
          for (int j = 0; j < 4; ++j) { cb[j] = wa[j]; cb[4 + j] = wb[j]; } }
        const size_t rb = (size_t)b * LSEQ;
        const bf16* src = PROJ + rb * LDP + 2048 + cg * 8;
        bf16* dst = XACT + rb * 1536 + ch;
        float p0[8], p1[8], p2[8];
        {   v4u q0 = (v4u){0u, 0u, 0u, 0u}, q1 = q0, q2 = q0;
            if (t0 >= 3) { q0 = *(const v4u*)(src + (size_t)(t0 - 3) * LDP); q1 = *(const v4u*)(src + (size_t)(t0 - 2) * LDP); q2 = *(const v4u*)(src + (size_t)(t0 - 1) * LDP); }
            unpack8(q0, p0); unpack8(q1, p1); unpack8(q2, p2); }
#pragma unroll 4
        for (int t = 0; t < 43; ++t) {
            const int l = t0 + t; float p3[8]; unpack8(*(const v4u*)(src + (size_t)l * LDP), p3);
            float o[8];
#pragma unroll
            for (int j = 0; j < 8; ++j) { o[j] = silu_f(cw[0][j] * p0[j] + cw[1][j] * p1[j] + cw[2][j] * p2[j] + cw[3][j] * p3[j] + cb[j]); p0[j] = p1[j]; p1[j] = p2[j]; p2[j] = p3[j]; }
            v4u ov; ov.x = pk2(o[0], o[1]); ov.y = pk2(o[2], o[3]); ov.z = pk2(o[4], o[5]); ov.w = pk2(o[6], o[7]);
            *(v4u*)(dst + (size_t)l * 1536) = ov;
        }
    }
}
__device__ __forceinline__ void ssd_item3(const Args& a, LAS unsigned char* lds, int b, int h) {
    const int tid = threadIdx.x, lane = tid & 63, w = __builtin_amdgcn_readfirstlane(tid >> 6), fr0 = lane & 15, fq0 = lane >> 4;
    bf16* PROJ = (bf16*)(a.ws + WS_PROJ); const bf16* XACT = (const bf16*)(a.ws + WS_H); const float* DT = (const float*)(a.ws + WS_DT); float* SSDSQ = (float*)(a.ws + WS_SSDSQ);
    const int g = h >> 3;
    const float Ah = -__expf(a.in[I_ALOG][h]), Dh = a.in[I_SD][h];
    LAS float* acs = (LAS float*)(lds + SO_V); LAS float* dtv = acs + 128; LAS float* wv = acs + 256; LAS float* eacs = acs + 384;
    const size_t rbase = (size_t)b * LSEQ;
    const int pt_s = w & 3, nh = w >> 2;
    f32x4 sacc[4];
#pragma unroll
    for (int i = 0; i < 4; ++i) sacc[i] = (f32x4){0.f, 0.f, 0.f, 0.f};
    __syncthreads();
    for (int i = tid; i < 64 * RSB / 4; i += 512) ((LAS unsigned*)(lds + SO_S))[i] = 0u;
    v4u pf[10], zp[2]; float d0 = 0.f, d1 = 0.f;
    const int ft = tid >> 2, q4 = tid & 3;
    const int xr_ = tid >> 3, xp_ = tid & 7, br_ = tid >> 4, bp_ = tid & 15;
    const bf16* xsrc = XACT + (rbase + xr_) * 1536 + h * 64 + xp_ * 8;
    const bf16* bsrc = XACT + (rbase + br_) * 1536 + 1024 + g * 128 + bp_ * 8;
#define SSD_PREFETCH_A(L0) do { const int l0_ = (L0); \
        _Pragma("unroll") for (int i = 0; i < 2; ++i) { pf[i] = (v4u){0u, 0u, 0u, 0u}; if (l0_ + xr_ + 64 * i < LSEQ) pf[i] = *(const v4u*)(xsrc + (size_t)(l0_ + 64 * i) * 1536); } \
        _Pragma("unroll") for (int i = 0; i < 4; ++i) { pf[2 + i] = (v4u){0u, 0u, 0u, 0u}; if (l0_ + br_ + 32 * i < LSEQ) pf[2 + i] = *(const v4u*)(bsrc + (size_t)(l0_ + 32 * i) * 1536); } } while (0)
#define SSD_PREFETCH_B(L0) do { const int l0_ = (L0); \
        _Pragma("unroll") for (int i = 0; i < 4; ++i) { pf[6 + i] = (v4u){0u, 0u, 0u, 0u}; if (l0_ + br_ + 32 * i < LSEQ) pf[6 + i] = *(const v4u*)(bsrc + (size_t)(l0_ + 32 * i) * 1536 + 256); } \
        zp[0] = (v4u){0u, 0u, 0u, 0u}; zp[1] = zp[0]; \
        if (l0_ + ft < LSEQ) { const bf16* zq = PROJ + (rbase + l0_ + ft) * LDP + C_Z + h * 64 + 16 * q4; zp[0] = *(const v4u*)zq; zp[1] = *(const v4u*)(zq + 8); } \
        if (w == 0) { d0 = (l0_ + lane) < LSEQ ? DT[(rbase + l0_ + lane) * 16 + h] : 0.f; d1 = (l0_ + lane + 64) < LSEQ ? DT[(rbase + l0_ + lane + 64) * 16 + h] : 0.f; } } while (0)
#define SSD_PREFETCH(L0) do { SSD_PREFETCH_A(L0); SSD_PREFETCH_B(L0); } while (0)
    SSD_PREFETCH(0);
    for (int l0 = 0; l0 < LSEQ; l0 += 128) {
        const int nvalid = (LSEQ - l0) < 128 ? (LSEQ - l0) : 128;
        int fr = fr0, fq = fq0; asm volatile("" : "+v"(fr), "+v"(fq));
#pragma unroll
        for (int i = 0; i < 2; ++i) *(LAS v4u*)(lds + SO_X + (xr_ + 64 * i) * RSX + xp_ * 16) = pf[i];
#pragma unroll
        for (int i = 0; i < 4; ++i) { *(LAS v4u*)(lds + SO_B + (br_ + 32 * i) * RSB + bp_ * 16) = pf[2 + i]; *(LAS v4u*)(lds + SO_C + (br_ + 32 * i) * RSB + bp_ * 16) = pf[6 + i]; }
        const v4u z0 = zp[0], z1 = zp[1];
        if (w == 0) {
            float a0 = Ah * d0, a1 = Ah * d1;
#pragma unroll
            for (int o = 1; o < 64; o <<= 1) { const float v0 = __shfl_up(a0, o), v1 = __shfl_up(a1, o); if (lane >= o) { a0 += v0; a1 += v1; } }
            a1 += __shfl(a0, 63);
            const float aend = __shfl(a1, 63);
            acs[lane] = a0; acs[lane + 64] = a1; dtv[lane] = d0; dtv[lane + 64] = d1;
            wv[lane] = __expf(aend - a0) * d0; wv[lane + 64] = __expf(aend - a1) * d1; eacs[lane] = __expf(a0); eacs[lane + 64] = __expf(a1);
            if (lane == 0) acs[512] = aend;
        }
        __syncthreads();
        if (l0 + 128 < LSEQ) SSD_PREFETCH_A(l0 + 128);
        {
            const int p = w < 4 ? w : 7 - w, R1 = p, R2 = 7 - p, nsl = w < 4 ? 4 : 5;
            int srow[5], sst[5];
#pragma unroll
            for (int i = 0; i < 5; ++i) { if (w < 4) { srow[i] = i <= p ? R1 : R2; sst[i] = i <= p ? i : i - p - 1; } else { srow[i] = R2; sst[i] = 3 - p + i; } }
            f32x4 gacc[5];
#pragma unroll
            for (int i = 0; i < 5; ++i) gacc[i] = (f32x4){0.f, 0.f, 0.f, 0.f};
#pragma unroll
            for (int k0 = 0; k0 < 128; k0 += 32) {
                const bf16x8 c1 = *(const LAS bf16x8*)(lds + SO_C + (16 * R1 + fr) * RSB + (k0 + 8 * fq) * 2), c2 = *(const LAS bf16x8*)(lds + SO_C + (16 * R2 + fr) * RSB + (k0 + 8 * fq) * 2);
                bf16x8 bfv[5];
#pragma unroll
                for (int i = 0; i < 5; ++i) bfv[i] = *(const LAS bf16x8*)(lds + SO_B + (16 * (i < nsl ? sst[i] : 0) + fr) * RSB + (k0 + 8 * fq) * 2);
#pragma unroll
                for (int i = 0; i < 5; ++i) gacc[i] = mfma16(bfv[i], (w < 4 && i <= p) ? c1 : c2, gacc[i]);
            }
#pragma unroll
            for (int i = 0; i < 5; ++i) if (i < nsl) {
                const int l = 16 * srow[i] + fr, s0 = 16 * sst[i] + 4 * fq; const float al = acs[l];
                const f32x4 as = *(const LAS f32x4*)(acs + s0), ds = *(const LAS f32x4*)(dtv + s0);
                float m[4];
#pragma unroll
                for (int j = 0; j < 4; ++j) m[j] = (s0 + j <= l) ? gacc[i][j] * __expf(al - as[j]) * ds[j] : 0.f;
                v2u mv; mv.x = pk2(m[0], m[1]); mv.y = pk2(m[2], m[3]);
                *(LAS v2u*)(lds + SO_M + l * RSB + s0 * 2) = mv;
            }
            { const int Rz = (w < 4) ? R1 : R2; if ((Rz & 1) == 0) *(LAS v2u*)(lds + SO_M + (16 * Rz + fr) * RSB + (16 * (Rz + 1) + 4 * fq) * 2) = (v2u){0u, 0u}; }
        }
        __syncthreads();
        if (l0 + 128 < LSEQ) SSD_PREFETCH_B(l0 + 128);
        {
            f32x4 y[4];
#pragma unroll
            for (int pt = 0; pt < 4; ++pt) y[pt] = (f32x4){0.f, 0.f, 0.f, 0.f};
#pragma unroll
            for (int k0 = 0; k0 < 128; k0 += 32) {
                const bf16x8 cf = *(const LAS bf16x8*)(lds + SO_C + (16 * w + fr) * RSB + (k0 + 8 * fq) * 2);
                bf16x8 sfv[4];
#pragma unroll
                for (int pt = 0; pt < 4; ++pt) sfv[pt] = *(const LAS bf16x8*)(lds + SO_S + (16 * pt + fr) * RSB + (k0 + 8 * fq) * 2);
#pragma unroll
                for (int pt = 0; pt < 4; ++pt) y[pt] = mfma16(cf, sfv[pt], y[pt]);
                __builtin_amdgcn_sched_barrier(0);
            }
            const f32x4 ea = *(const LAS f32x4*)(eacs + 16 * w + 4 * fq);
#pragma unroll
            for (int pt = 0; pt < 4; ++pt) y[pt] *= ea;
            for (int k0 = 0; k0 <= 16 * w + 15; k0 += 32) {
                const bf16x8 mf = *(const LAS bf16x8*)(lds + SO_M + (16 * w + fr) * RSB + (k0 + 8 * fq) * 2);
                const unsigned xa = (unsigned)(size_t)(lds + SO_X) + (unsigned)((k0 + 8 * fq + (fr >> 2)) * RSX + (fr & 3) * 8);
                bf16x8 x0, x1, x2, x3; TR4(576, x0, x1, x2, x3, xa);
                y[0] = mfma16(mf, x0, y[0]); y[1] = mfma16(mf, x1, y[1]); y[2] = mfma16(mf, x2, y[2]); y[3] = mfma16(mf, x3, y[3]);
                __builtin_amdgcn_sched_barrier(0);
            }
#pragma unroll
            for (int pt = 0; pt < 4; ++pt)
#pragma unroll
                for (int r = 0; r < 4; ++r) *(LAS float*)(lds + SO_M + (16 * w + 4 * fq + r) * RSB + (16 * pt + fr) * 4) = y[pt][r];
        }
        {
            const float dec = __expf(acs[512]);
#pragma unroll
            for (int i = 0; i < 4; ++i) sacc[i] *= dec;
#pragma unroll
            for (int k0 = 0; k0 < 128; k0 += 32) {
                const unsigned xa = (unsigned)(size_t)(lds + SO_X) + (unsigned)((k0 + 8 * fq + (fr >> 2)) * RSX + pt_s * 32 + (fr & 3) * 8);
                bf16x8 xf; TR1(576, xf, xa);
                const f32x4 w0 = *(const LAS f32x4*)(wv + k0 + 8 * fq), w1 = *(const LAS f32x4*)(wv + k0 + 8 * fq + 4);
                float xv[8]; unpack8(__builtin_bit_cast(v4u, xf), xv);
                v4u xs; xs.x = pk2(xv[0] * w0[0], xv[1] * w0[1]); xs.y = pk2(xv[2] * w0[2], xv[3] * w0[3]); xs.z = pk2(xv[4] * w1[0], xv[5] * w1[1]); xs.w = pk2(xv[6] * w1[2], xv[7] * w1[3]);
                const bf16x8 xw = __builtin_bit_cast(bf16x8, xs);
                const unsigned ba = (unsigned)(size_t)(lds + SO_B) + (unsigned)((k0 + 8 * fq + (fr >> 2)) * RSB + nh * 128 + (fr & 3) * 8);
                bf16x8 b0, b1, b2, b3; TR4(1088, b0, b1, b2, b3, ba);
                sacc[0] = mfma16(xw, b0, sacc[0]); sacc[1] = mfma16(xw, b1, sacc[1]); sacc[2] = mfma16(xw, b2, sacc[2]); sacc[3] = mfma16(xw, b3, sacc[3]);
                __builtin_amdgcn_sched_barrier(0);
            }
        }
        __syncthreads();
#pragma unroll
        for (int i = 0; i < 4; ++i)
#pragma unroll
            for (int r = 0; r < 4; ++r) *(LAS bf16*)(lds + SO_S + (16 * pt_s + 4 * fq + r) * RSB + (16 * (4 * nh + i) + fr) * 2) = (bf16)f2bf(sacc[i][r]);
        if (ft < nvalid) {
            const size_t row = rbase + l0 + ft;
            bf16* zq = PROJ + row * LDP + C_Z + h * 64 + 16 * q4;
            const v4u x0 = *(const LAS v4u*)(lds + SO_X + ft * RSX + q4 * 32), x1 = *(const LAS v4u*)(lds + SO_X + ft * RSX + q4 * 32 + 16);
            float zf[16], xf[16], yo[16];
            { float tmp[8]; unpack8(z0, tmp);
#pragma unroll
              for (int j = 0; j < 8; ++j) zf[j] = tmp[j];
              unpack8(z1, tmp);
#pragma unroll
              for (int j = 0; j < 8; ++j) zf[8 + j] = tmp[j];
              unpack8(x0, tmp);
#pragma unroll
              for (int j = 0; j < 8; ++j) xf[j] = tmp[j];
              unpack8(x1, tmp);
#pragma unroll
              for (int j = 0; j < 8; ++j) xf[8 + j] = tmp[j]; }
            float sq = 0.f;
#pragma unroll
            for (int j4 = 0; j4 < 4; ++j4) { const f32x4 yv = *(const LAS f32x4*)(lds + SO_M + ft * RSB + (16 * q4 + 4 * j4) * 4);
#pragma unroll
                for (int j = 0; j < 4; ++j) { const float v = (yv[j] + Dh * xf[4 * j4 + j]) * silu_f(zf[4 * j4 + j]); yo[4 * j4 + j] = v; sq += v * v; } }
            v4u o0, o1; o0.x = pk2(yo[0], yo[1]); o0.y = pk2(yo[2], yo[3]); o0.z = pk2(yo[4], yo[5]); o0.w = pk2(yo[6], yo[7]);
            o1.x = pk2(yo[8], yo[9]); o1.y = pk2(yo[10], yo[11]); o1.z = pk2(yo[12], yo[13]); o1.w = pk2(yo[14], yo[15]);
            *(v4u*)zq = o0; *(v4u*)(zq + 8) = o1;
            sq += __shfl_xor(sq, 1); sq += __shfl_xor(sq, 2);
            if (q4 == 0) SSDSQ[row * 16 + h] = sq;
        }
        __syncthreads();
    }
#undef SSD_PREFETCH
#undef SSD_PREFETCH_A
#undef SSD_PREFETCH_B
}
constexpr int LO_XB = 0, LO_XF = LO_XB + 128 * RSX, LO_A = LO_XF + 128 * 260, LO_U = LO_A + 128 * 260, LO_WA = LO_U + 128 * 260, LO_WX = LO_WA + 64 * RSX, LO_SC = LO_WX + 64 * RSX;
static_assert(LO_SC + 17 * 256 <= LDS_BYTES - 256, "lru lds");
__device__ __forceinline__ void lru_item3(const Args& a, LAS unsigned char* lds, int b, int h) {
    const int tid = threadIdx.x, lane0 = tid & 63, w = __builtin_amdgcn_readfirstlane(tid >> 6), fr0 = lane0 & 15, fq0 = lane0 >> 4;
    bf16* PROJ = (bf16*)(a.ws + WS_PROJ);
    const size_t rbase = (size_t)b * LSEQ;
    LAS float* segP = (LAS float*)(lds + LO_SC); LAS float* segH = segP + 512; LAS float* carry = segH + 512;
    __syncthreads();
    for (int i = tid; i < 4096; i += 512) { const int ii = i >> 6, j = i & 63;
        *(LAS bf16*)(lds + LO_WA + j * RSX + ii * 2) = (bf16)f2bf(-1.4426950408889634f * a.in[I_LWA][(size_t)h * 4096 + i]);
        *(LAS bf16*)(lds + LO_WX + j * RSX + ii * 2) = (bf16)f2bf(-1.4426950408889634f * a.in[I_LWX][(size_t)h * 4096 + i]); }
    if (tid < 64) carry[tid] = 0.f;
    float gba[4], gbx[4], gsp[4];
#pragma unroll
    for (int jt = 0; jt < 4; ++jt) { const int c = h * 64 + 16 * jt + fr0; gba[jt] = -1.4426950408889634f * a.in[I_LBA][c]; gbx[jt] = -1.4426950408889634f * a.in[I_LBX][c]; gsp[jt] = -8.0f * softplus_f(-a.in[I_LLAM][c]); }
    const int ft = tid >> 2, q4 = tid & 3;
    const int cg = tid & 7, rg = tid >> 3;
    v4u xp[5], gp[2];
#define LRU_PREFETCH(L0) do { const int l0_ = (L0); \
        _Pragma("unroll") for (int r = 0; r < 5; ++r) { const int l = l0_ + 2 * rg - 3 + r; xp[r] = (v4u){0u, 0u, 0u, 0u}; \
            if (l >= 0 && l < LSEQ) xp[r] = *(const v4u*)(PROJ + (rbase + l) * LDP + C_LI + h * 64 + cg * 8); } \
        gp[0] = (v4u){0u, 0u, 0u, 0u}; gp[1] = gp[0]; \
        if (l0_ + ft < LSEQ) { const bf16* gq = PROJ + (rbase + l0_ + ft) * LDP + C_G + h * 64 + 16 * q4; gp[0] = *(const v4u*)gq; gp[1] = *(const v4u*)(gq + 8); } } while (0)
    LRU_PREFETCH(0);
    for (int l0 = 0; l0 < LSEQ; l0 += 128) {
        const int nvalid = (LSEQ - l0) < 128 ? (LSEQ - l0) : 128;
        int fr = fr0, fq = fq0, lane = lane0; asm volatile("" : "+v"(fr), "+v"(fq), "+v"(lane));
        {
            float cw[4][8], cb[8], p[5][8];
#pragma unroll
            for (int k = 0; k < 4; ++k) { const f32x4 wa = *(const f32x4*)(a.in[I_LCW] + k * 1024 + h * 64 + cg * 8), wb = *(const f32x4*)(a.in[I_LCW] + k * 1024 + h * 64 + cg * 8 + 4);
#pragma unroll
                for (int j = 0; j < 4; ++j) { cw[k][j] = wa[j]; cw[k][4 + j] = wb[j]; } }
            { const f32x4 wa = *(const f32x4*)(a.in[I_LCB] + h * 64 + cg * 8), wb = *(const f32x4*)(a.in[I_LCB] + h * 64 + cg * 8 + 4);
#pragma unroll
              for (int j = 0; j < 4; ++j) { cb[j] = wa[j]; cb[4 + j] = wb[j]; } }
#pragma unroll
            for (int r = 0; r < 5; ++r) unpack8(xp[r], p[r]);
#pragma unroll
            for (int rr = 0; rr < 2; ++rr) { const int t = 2 * rg + rr; float o[8];
#pragma unroll
                for (int j = 0; j < 8; ++j) o[j] = cw[0][j] * p[rr][j] + cw[1][j] * p[rr + 1][j] + cw[2][j] * p[rr + 2][j] + cw[3][j] * p[rr + 3][j] + cb[j];
                v4u ov; ov.x = pk2(o[0], o[1]); ov.y = pk2(o[2], o[3]); ov.z = pk2(o[4], o[5]); ov.w = pk2(o[6], o[7]);
                *(LAS v4u*)(lds + LO_XB + t * RSX + cg * 16) = ov;
}
        }
        const v4u g0 = gp[0], g1 = gp[1];
        __syncthreads();
        if (l0 + 128 < LSEQ) LRU_PREFETCH(l0 + 128);
        {
            f32x4 ga[4], gx[4];
#pragma unroll
            for (int jt = 0; jt < 4; ++jt) { ga[jt] = (f32x4){gba[jt], gba[jt], gba[jt], gba[jt]}; gx[jt] = (f32x4){gbx[jt], gbx[jt], gbx[jt], gbx[jt]}; }
#pragma unroll
            for (int k0 = 0; k0 < 64; k0 += 32) {
                const bf16x8 xf = *(const LAS bf16x8*)(lds + LO_XB + (16 * w + fr) * RSX + (k0 + 8 * fq) * 2);
                bf16x8 wav[4], wxv[4];
#pragma unroll
                for (int jt = 0; jt < 4; ++jt) { wav[jt] = *(const LAS bf16x8*)(lds + LO_WA + (16 * jt + fr) * RSX + (k0 + 8 * fq) * 2); wxv[jt] = *(const LAS bf16x8*)(lds + LO_WX + (16 * jt + fr) * RSX + (k0 + 8 * fq) * 2); }
#pragma unroll
                for (int jt = 0; jt < 4; ++jt) { ga[jt] = mfma16(xf, wav[jt], ga[jt]); gx[jt] = mfma16(xf, wxv[jt], gx[jt]); }
            }
#pragma unroll
            for (int jt = 0; jt < 4; ++jt)
#pragma unroll
                for (int r = 0; r < 4; ++r) { const int l = 16 * w + 4 * fq + r, j = 16 * jt + fr;
                    const float rr = rcp_f(1.f + __builtin_amdgcn_exp2f(ga[jt][r])), ig = rcp_f(1.f + __builtin_amdgcn_exp2f(gx[jt][r]));
                    const float log_a = rr * gsp[jt];
                    const float av = __builtin_amdgcn_exp2f(1.4426950408889634f * log_a);
                    const float t2 = 2.f * log_a;
                    const float om = t2 > -0.1f ? -t2 * (1.f + t2 * (0.5f + t2 * (0.16666667f + t2 * 0.041666668f))) : 1.f - av * av;
                    const float mult = (l0 + l == 0) ? 1.f : __builtin_amdgcn_sqrtf(fmaxf(om, 0.f));
                    const float xv = __uint_as_float((unsigned)*(const LAS unsigned short*)(lds + LO_XB + l * RSX + j * 2) << 16);
                    *(LAS float*)(lds + LO_A + l * 260 + j * 4) = av; *(LAS float*)(lds + LO_U + l * 260 + j * 4) = mult * ig * xv; }
        }
        __syncthreads();
        {
            float P = 1.f, Hl = 0.f;
#pragma unroll
            for (int t = 0; t < 16; ++t) { const float av = *(const LAS float*)(lds + LO_A + (16 * w + t) * 260 + lane * 4), uv = *(const LAS float*)(lds + LO_U + (16 * w + t) * 260 + lane * 4); Hl = av * Hl + uv; P *= av; }
            segP[w * 64 + lane] = P; segH[w * 64 + lane] = Hl;
            __syncthreads();
            float hin = carry[lane];
            for (int s2 = 0; s2 < w; ++s2) hin = segP[s2 * 64 + lane] * hin + segH[s2 * 64 + lane];
#pragma unroll
            for (int t = 0; t < 16; ++t) { LAS float* up = (LAS float*)(lds + LO_U + (16 * w + t) * 260 + lane * 4); hin = *(const LAS float*)(lds + LO_A + (16 * w + t) * 260 + lane * 4) * hin + *up; *up = hin; }
            __syncthreads();
            if (w == 7) carry[lane] = hin;
        }
        if (ft < nvalid) {
            const size_t row = rbase + l0 + ft;
            bf16* gq = PROJ + row * LDP + C_G + h * 64 + 16 * q4;
            float gf[16], yo[16];
            { float tmp[8]; unpack8(g0, tmp);
#pragma unroll
              for (int j = 0; j < 8; ++j) gf[j] = tmp[j];
              unpack8(g1, tmp);
#pragma unroll
              for (int j = 0; j < 8; ++j) gf[8 + j] = tmp[j]; }
#pragma unroll
            for (int j = 0; j < 16; ++j) yo[j] = *(const LAS float*)(lds + LO_U + ft * 260 + (16 * q4 + j) * 4) * gelu_tanh_f(gf[j]);
            v4u o0, o1; o0.x = pk2(yo[0], yo[1]); o0.y = pk2(yo[2], yo[3]); o0.z = pk2(yo[4], yo[5]); o0.w = pk2(yo[6], yo[7]);
            o1.x = pk2(yo[8], yo[9]); o1.y = pk2(yo[10], yo[11]); o1.z = pk2(yo[12], yo[13]); o1.w = pk2(yo[14], yo[15]);
            *(v4u*)gq = o0; *(v4u*)(gq + 8) = o1;
        }
        __syncthreads();
    }
#undef LRU_PREFETCH
}
__device__ __forceinline__ void ph_mixers3(const Args& a, LAS unsigned char* lds, int wk, int nwk) {
    for (int it = wk; it < 256; it += nwk) if (it < 128) ssd_item3(a, lds, it >> 4, it & 15);
    for (int it = wk; it < 256; it += nwk) if (it >= 128) lru_item3(a, lds, (it - 128) >> 4, (it - 128) & 15);
    {
        const int wave = __builtin_amdgcn_readfirstlane((int)threadIdx.x >> 6), lane = (int)threadIdx.x & 63;
        __syncthreads();
        (void)wave; (void)lane;
        convert_experts_dyn(a, 0, lds, (unsigned*)(a.ws + WS_CTL) + 32);
    }
}

constexpr int RW_STRIDE = 2064;
__device__ __forceinline__ void ph_router(const Args& a, LAS unsigned char* lds, int L, int wk, int nwk) {
    int tid_o = threadIdx.x; asm volatile("" : "+v"(tid_o));
    const int tid = tid_o, lane = tid & 63, wave = __builtin_amdgcn_readfirstlane(tid >> 6), fr = lane & 15, fq = lane >> 4;
    const int gw = wk * NWAVES + wave, NGW = nwk * NWAVES;
    LAS unsigned char* wl = lds;
    LAS float* sc = (LAS float*)(lds + 99328) + wave * 768;
    LAS int* lcnt = (LAS int*)(lds + 123904); LAS int* gbase = lcnt + 32; LAS int* rinfo = lcnt + 64;
    const v4u* WRT = (const v4u*)(a.ws + WS_WRT) + (size_t)L * 6144;
    __syncthreads();
    for (int i = tid; i < 6144; i += 512) *(LAS v4u*)(wl + (i >> 7) * RW_STRIDE + (i & 127) * 16) = WRT[i];
    if (tid < 32) lcnt[tid] = 0;
    __syncthreads();
    const bf16* HBr = L ? (const bf16*)(a.ws + WS_SB) : (const bf16*)a.out;
    float* RSTD1 = (float*)(a.ws + WS_RSTD1); float* GATES = (float*)(a.ws + WS_GATES); int* LIST = (int*)(a.ws + WS_LIST);
    unsigned* cnt = (unsigned*)(a.ws + WS_CTL) + CW_CNT + 1024 * L;
    const float* bg = a.in[I_RGB] + L * 4; const float* be = a.in[I_REB] + L * 16;
    int it = 0;
    for (int u = gw; u < T / 16; u += NGW, ++it) {
        const int r0 = u * 16;
        const bf16* hrow = HBr + (size_t)(r0 + fr) * D + 8 * fq;
        f32x4 acc[3]; float ss = 0.f;
#pragma unroll
        for (int t = 0; t < 3; ++t) acc[t] = (f32x4){0.f, 0.f, 0.f, 0.f};
#pragma unroll 8
        for (int k0 = 0; k0 < 1024; k0 += 32) {
            const v4u hv = *(const v4u*)(hrow + k0);
            f32x4 h0v, h1v; unpack8v(hv, h0v, h1v);
            ss += (h0v[0] * h0v[0] + h0v[1] * h0v[1] + h0v[2] * h0v[2] + h0v[3] * h0v[3]) + (h1v[0] * h1v[0] + h1v[1] * h1v[1] + h1v[2] * h1v[2] + h1v[3] * h1v[3]);
            const bf16x8 hf = __builtin_bit_cast(bf16x8, hv);
#pragma unroll
            for (int t = 0; t < 3; ++t) { const bf16x8 wf = *(const LAS bf16x8*)(wl + (16 * t + fr) * RW_STRIDE + (k0 + 8 * fq) * 2); acc[t] = mfma16(wf, hf, acc[t]); }
        }
        ss += __shfl_xor(ss, 16); ss += __shfl_xor(ss, 32);
        const float rstd = rsqrtf(ss * (1.f / D) + EPS);
#pragma unroll
        for (int t = 0; t < 3; ++t)
#pragma unroll
            for (int r = 0; r < 4; ++r) sc[fr * 48 + 16 * t + 4 * fq + r] = acc[t][r];
        LDS_WAIT();
        if (lane < 16) {
            const int row = r0 + lane;
            float lg[20];
#pragma unroll
            for (int j = 0; j < 20; ++j) lg[j] = (sc[lane * 48 + j] + sc[lane * 48 + 20 + j]) * rstd + (j < 4 ? bg[j] : be[j - 4]);
            int gs = 0; float gm = lg[0];
#pragma unroll
            for (int j = 1; j < 4; ++j) if (lg[j] > gm) { gm = lg[j]; gs = j; }
            const float pg = 1.f / (__expf(lg[0] - gm) + __expf(lg[1] - gm) + __expf(lg[2] - gm) + __expf(lg[3] - gm));
            float f[4];
#pragma unroll
            for (int i = 0; i < 4; ++i) f[i] = gs == 0 ? lg[4 + i] : (gs == 1 ? lg[8 + i] : (gs == 2 ? lg[12 + i] : lg[16 + i]));
            int i0 = 0; float m0 = f[0];
#pragma unroll
            for (int i = 1; i < 4; ++i) if (f[i] > m0) { m0 = f[i]; i0 = i; }
            int i1 = -1; float m1 = -3.0e38f;
#pragma unroll
            for (int i = 0; i < 4; ++i) if (i != i0 && f[i] > m1) { m1 = f[i]; i1 = i; }
            const float w0 = 1.f / (1.f + __expf(m1 - m0)), w1 = 1.f - w0;
            const int lo = i0 < i1 ? i0 : i1, hi = i0 < i1 ? i1 : i0;
            const float glo = pg * (i0 < i1 ? w0 : w1), ghi = pg * (i0 < i1 ? w1 : w0);
            const int pair = lo == 0 ? hi - 1 : (lo == 1 ? hi + 1 : 5);
            const int bk = gs * 6 + pair;
            const int ls = __hip_atomic_fetch_add(lcnt + bk, 1, __ATOMIC_RELAXED, __HIP_MEMORY_SCOPE_WORKGROUP);
            rinfo[(it * NWAVES + wave) * 16 + lane] = bk | (ls << 8);
            RSTD1[row] = rstd; GATES[(size_t)row * 2] = glo; GATES[(size_t)row * 2 + 1] = ghi;
        }
        LDS_WAIT();
    }
    __syncthreads();
    if (tid < NBK) gbase[tid] = (int)atomicAdd(cnt + 32 * tid, (unsigned)lcnt[tid]);
    __syncthreads();
    it = 0;
    for (int u = gw; u < T / 16; u += NGW, ++it)
        if (lane < 16) { const int info = rinfo[(it * NWAVES + wave) * 16 + lane], bk = info & 255; LIST[(size_t)bk * T + gbase[bk] + (info >> 8)] = u * 16 + lane; }
}

struct BkTab { int cnt[NBK], off[NBK], ust[NBK + 1]; };
__device__ __forceinline__ void bk_table(const Args& a, LAS unsigned char* lds, int L, int per_tile  ) {
    LAS int* tb = (LAS int*)lds;
    __syncthreads();
    if (threadIdx.x == 0) {
        const unsigned* cnt = (const unsigned*)(a.ws + WS_CTL) + CW_CNT + 1024 * L;
        int off = 0, us = 0;
        for (int i = 0; i < NBK; ++i) { const int c = (int)__hip_atomic_load(cnt + 32 * i, __ATOMIC_RELAXED, __HIP_MEMORY_SCOPE_AGENT);
            tb[i] = c; tb[NBK + i] = off; tb[2 * NBK + i] = us; off += (c + 255) & ~255; us += ((c + 63) >> 6) * per_tile; }
        tb[2 * NBK + NBK] = us;
    }
    __syncthreads();
}
__device__ __forceinline__ void bk_experts(int bk, int& elo, int& ehi) {
    const int g = bk / 6, pr = bk - g * 6;
    const int lo = pr < 3 ? 0 : (pr < 5 ? 1 : 2), hi = pr < 3 ? pr + 1 : (pr < 5 ? pr - 1 : 3);
    elo = g * 4 + lo; ehi = g * 4 + hi;
}
__device__ __forceinline__ void ph_moe_up(const Args& a, LAS unsigned char* lds, int L, int wk, int nwk) {
    const int tid = threadIdx.x, lane = tid & 63, wave = __builtin_amdgcn_readfirstlane(tid >> 6), fr = lane & 15, fq = lane >> 4;
    const int gw = wk * NWAVES + wave, NGW = nwk * NWAVES;
    bk_table(a, lds, L, 32);
    LAS int* tb = (LAS int*)lds;
    const bf16* HB = (const bf16*)a.out; const bf16* WGU = (const bf16*)(a.ws + WS_WGU); bf16* HID = (bf16*)(a.ws + WS_HID);
    const int* LIST = (const int*)(a.ws + WS_LIST); const float* RSTD1 = (const float*)(a.ws + WS_RSTD1); const float* GATES = (const float*)(a.ws + WS_GATES);
    const int nun = tb[2 * NBK + NBK];
    for (int u = gw; u < nun; u += NGW) {
        int bk = 0;
        for (int i = 1; i < NBK; ++i) if (u >= tb[2 * NBK + i]) bk = i;
        const int cnt = tb[bk], off = tb[NBK + bk], r = u - tb[2 * NBK + bk];
        const int rt = r >> 5, ek = (r >> 4) & 1, ct = r & 15;
        int elo, ehi; bk_experts(bk, elo, ehi); const int e = ek ? ehi : elo;
        const int c0 = ct * 32, brow = e * 1024 + (c0 >> 7) * 256 + (c0 & 127);
        const bf16* arow[4]; int tok[4];
#pragma unroll
        for (int mi = 0; mi < 4; ++mi) { int rr = rt * 64 + 16 * mi + fr; if (rr >= cnt) rr = cnt - 1; tok[mi] = LIST[(size_t)bk * T + rr]; arow[mi] = HB + (size_t)tok[mi] * D; }
        f32x4 acc[4][4]; zero_acc(acc);
        sg_kloop<4>(1024, arow, [=](int n, int k0) { return WGU + (size_t)(brow + (n < 32 ? n : n + 96)) * 1024 + k0; }, NoKS(), acc, fr, fq);
#pragma unroll
        for (int mi = 0; mi < 4; ++mi) { const int rr = rt * 64 + 16 * mi + fr;
            if (rr < cnt) { const float rs = RSTD1[tok[mi]], gt = GATES[(size_t)tok[mi] * 2 + ek];
#pragma unroll
                for (int nj = 0; nj < 2; ++nj) { const f32x4 gv = acc[mi][nj] * rs, uv = acc[mi][nj + 2] * rs; f32x4 hv;
                    hv.x = silu_f(gv.x) * uv.x * gt; hv.y = silu_f(gv.y) * uv.y * gt; hv.z = silu_f(gv.z) * uv.z * gt; hv.w = silu_f(gv.w) * uv.w * gt;
                    v2u w; w.x = pk2(hv.x, hv.y); w.y = pk2(hv.z, hv.w);
                    *(v2u*)(HID + (size_t)(off + rr) * 1024 + ek * 512 + c0 + 16 * nj + 4 * fq) = w; } } }
    }
}
__device__ __forceinline__ void ph_moe_down(const Args& a, LAS unsigned char* lds, int L, int wk, int nwk) {
    const int tid = threadIdx.x, lane = tid & 63, wave = __builtin_amdgcn_readfirstlane(tid >> 6), fr = lane & 15, fq = lane >> 4;
    const int gw = wk * NWAVES + wave, NGW = nwk * NWAVES;
    bk_table(a, lds, L, 16);
    LAS int* tb = (LAS int*)lds;
    const bf16* HID = (const bf16*)(a.ws + WS_HID); const bf16* WD = (const bf16*)(a.ws + WS_WD);
    float* H = (float*)(a.ws + WS_H); bf16* HB = (bf16*)a.out; const int* LIST = (const int*)(a.ws + WS_LIST);
    const int nun = tb[2 * NBK + NBK];
    for (int u = gw; u < nun; u += NGW) {
        int bk = 0;
        for (int i = 1; i < NBK; ++i) if (u >= tb[2 * NBK + i]) bk = i;
        const int cnt = tb[bk], off = tb[NBK + bk], r = u - tb[2 * NBK + bk];
        const int rt = r >> 4, ct = r & 15;
        int elo, ehi; bk_experts(bk, elo, ehi);
        const bf16* arow[4];
#pragma unroll
        for (int mi = 0; mi < 4; ++mi) arow[mi] = HID + (size_t)(off + rt * 64 + 16 * mi + fr) * 1024;
        f32x4 acc[4][4]; zero_acc(acc);
        sg_kloop<4>(1024, arow, [=](int n, int k0) { return WD + ((size_t)((k0 < 512 ? elo : ehi) * 1024 + ct * 64 + n)) * 512 + (k0 & 511); }, NoKS(), acc, fr, fq);
#pragma unroll
        for (int mi = 0; mi < 4; ++mi) { const int rr = rt * 64 + 16 * mi + fr;
            if (rr < cnt) { const int tok = LIST[(size_t)bk * T + rr];
#pragma unroll
                for (int nj = 0; nj < 4; ++nj) { const int c = ct * 64 + 16 * nj + 4 * fq; float* hp = H + (size_t)tok * D + c;
                    const f32x4 v = *(const f32x4*)hp + acc[mi][nj]; *(f32x4*)hp = v;
                    v2u w; w.x = pk2(v.x, v.y); w.y = pk2(v.z, v.w); *(v2u*)(HB + (size_t)tok * D + c) = w; } } }
    }
}


__device__ __forceinline__ void hb_store4(bf16* HB, int row, int col, const f32x4 v) {
    v2u w; w.x = pg8::cvt_pk_bf16(v[0], v[1]); w.y = pg8::cvt_pk_bf16(v[2], v[3]); *(v2u*)(HB + (size_t)row * D + col) = w;
}
__device__ __forceinline__ void hb_store8(bf16* HB, int row, int col, const f32x4 v0, const f32x4 v1) {
    v4u w; w.x = pg8::cvt_pk_bf16(v0[0], v0[1]); w.y = pg8::cvt_pk_bf16(v0[2], v0[3]); w.z = pg8::cvt_pk_bf16(v1[0], v1[1]); w.w = pg8::cvt_pk_bf16(v1[2], v1[3]);
    *(v4u*)(HB + (size_t)row * D + col) = w;
}

struct PGemm2 {
    static constexpr bool PERM = true;
    struct EpiRegs {};
    template <class U_> __device__ __forceinline__ void epi_pre(const U_&, EpiRegs&, int, int, int, int) const {}
    struct Unit { int pm, pn, ui; };
    const Args* ap; const char* A; const char* B; bf16* HB; unsigned char* X8; int G, c; int ldb, nt;
    __device__ __forceinline__ bool next(int i, Unit& u) const { u.ui = i; return pg8::static_order(64, 4, G, c, i, u.pm, u.pn); }
    __device__ __forceinline__ void avoff(const Unit& u, const int (&RA)[2], const int (&CA)[2], unsigned (&v)[4]) const {
#pragma unroll
        for (int h = 0; h < 2; ++h)
#pragma unroll
            for (int i = 0; i < 2; ++i) { const int row = u.pm * 256 + h * 128 + RA[i]; v[h * 2 + i] = (unsigned)(row * LDP + CA[i]) * 2u; }
    }
    __device__ __forceinline__ const char* abase(const Unit&) const { return A; }
    __device__ __forceinline__ const char* btile(const Unit& u, int t) const { return B + ((size_t)u.pn * 256 * 2048 + (size_t)t * 64) * 2; }
    __device__ __forceinline__ void a_ready(const Unit&) const {}
    __device__ __forceinline__ void done(const Unit&) const {}
    __device__ __forceinline__ void khook(int t, pg8::Acc& acc, const Unit& u, LAS unsigned char* lds, int wr, int wc, int fr, int fq) const {
        if (t == 8 || t == 16) {
            const LAS float* ft = (const LAS float*)(lds + LDS_TAB) + u.ui * 512 + (t == 16 ? 1 : 0);
#pragma unroll
            for (int ai = 0; ai < 2; ++ai)
#pragma unroll
                for (int m = 0; m < 4; ++m) { const float f = ft[(ai * 128 + wr * 64 + m * 16 + fr) * 2];
#pragma unroll
                    for (int bj = 0; bj < 2; ++bj)
#pragma unroll
                        for (int n = 0; n < 2; ++n) acc[ai][bj][m][n] *= f; }
        }
    }
    __device__ __forceinline__ void epi(const pg8::Acc& acc, const Unit& u, const EpiRegs&, int wr, int wc, int fr, int fq) const {
        const int row0 = u.pm * 256 + wr * 64 + fr, col0 = u.pn * 256 + wc * 32 + 8 * fq;
#pragma unroll
        for (int hf = 0; hf < 2; ++hf) {
            v4u res[4][2];
#pragma unroll
            for (int g4 = 0; g4 < 4; ++g4)
#pragma unroll
                for (int bj = 0; bj < 2; ++bj) res[g4][bj] = *(const v4u*)(HB + (size_t)(row0 + hf * 128 + g4 * 16) * D + col0 + bj * 128);
#pragma unroll
            for (int g4 = 0; g4 < 4; ++g4)
#pragma unroll
                for (int bj = 0; bj < 2; ++bj) { f32x4 h0v, h1v; unpack8v(res[g4][bj], h0v, h1v); const f32x4 o0 = acc[hf][bj][g4][0] + h0v, o1 = acc[hf][bj][g4][1] + h1v; hb_store8(HB, row0 + hf * 128 + g4 * 16, col0 + bj * 128, o0, o1);
                    if (MOE_UP_F8) x8_store8(X8, row0 + hf * 128 + g4 * 16, col0 + bj * 128, o0, o1); }
        }
    }
};
__device__ __forceinline__ void ssd_factors(const float* SSDSQ, int row, float& f0, float& f1) {
    const f32x4* sq = (const f32x4*)(SSDSQ + (size_t)row * 16); const f32x4 q0 = sq[0], q1 = sq[1], q2 = sq[2], q3 = sq[3];
    const float s0 = (q0.x + q0.y + q0.z + q0.w) + (q1.x + q1.y + q1.z + q1.w), s1 = (q2.x + q2.y + q2.z + q2.w) + (q3.x + q3.y + q3.z + q3.w);
    const float r0 = rsqrtf(s0 * (1.f / 512.f) + EPS), r1 = rsqrtf(s1 * (1.f / 512.f) + EPS);
    f0 = r0 / r1; f1 = r1;
}
__device__ __forceinline__ void ph_gemm2_pg8(const Args& a, LAS unsigned char* lds, int wk, int G) {
    const int tid = threadIdx.x, lane = tid & 63, wave = __builtin_amdgcn_readfirstlane(tid >> 6), fr = lane & 15, fq = lane >> 4;
    const float* SSDSQ = (const float*)(a.ws + WS_SSDSQ);
    PGemm2 S; S.ap = &a; S.A = (const char*)(a.ws + WS_PROJ); S.B = (const char*)(a.ws + WS_WOUT); S.HB = (bf16*)a.out; S.X8 = a.ws + WS_X8;
    S.G = G; S.c = (int)blockIdx.x; S.ldb = 2048; S.nt = 32;
    {
        LAS float* ft = (LAS float*)(lds + LDS_TAB);
        PGemm2::Unit u;
        for (int i = 0; i < 4 && S.next(i, u); ++i)
            if (tid < 256) { float f0, f1; ssd_factors(SSDSQ, u.pm * 256 + tid, f0, f1); ft[i * 512 + tid * 2] = f0; ft[i * 512 + tid * 2 + 1] = f1; }
        __syncthreads();
    }
    pg8::gemm_phase<PGemm2, true>(lds, S);
    const bf16* PROJ = (const bf16*)(a.ws + WS_PROJ); const bf16* WOUT = (const bf16*)(a.ws + WS_WOUT);
    for (int piece = wk; piece < 256; piece += G) {
        const int rb = piece >> 5, cb = piece & 31, kb = wave * 256, row = 16384 + rb * 16 + fr;
        const bf16* ar = PROJ + (size_t)row * LDP + kb + 8 * fq;
        const bf16* br = WOUT + (size_t)(cb * 32 + fr) * 2048 + kb + 8 * fq;
        f32x4 acc0 = (f32x4){0.f, 0.f, 0.f, 0.f}, acc1 = acc0;
        bf16x8 av[8], b0v[8], b1v[8];
#pragma unroll
        for (int ks = 0; ks < 8; ++ks) { av[ks] = *(const bf16x8*)(ar + 32 * ks); b0v[ks] = *(const bf16x8*)(br + 32 * ks); b1v[ks] = *(const bf16x8*)(br + 16 * 2048 + 32 * ks); }
#pragma unroll
        for (int ks = 0; ks < 8; ++ks) { acc0 = mfma16(b0v[ks], av[ks], acc0); acc1 = mfma16(b1v[ks], av[ks], acc1); }
        float f0, f1; ssd_factors(SSDSQ, row, f0, f1);
        const float sc = wave < 2 ? f0 * f1 : (wave < 4 ? f1 : 1.f);
        LAS float* part = (LAS float*)lds + wave * 512;
        __syncthreads();
        *(LAS f32x4*)(part + fr * 32 + 4 * fq) = acc0 * sc; *(LAS f32x4*)(part + fr * 32 + 16 + 4 * fq) = acc1 * sc;
        __syncthreads();
        if (tid < 128) { const int r = tid >> 3, c4 = (tid & 7) * 4; f32x4 sv = *(const LAS f32x4*)((LAS float*)lds + r * 32 + c4);
#pragma unroll
            for (int w2 = 1; w2 < 8; ++w2) sv += *(const LAS f32x4*)((LAS float*)lds + w2 * 512 + r * 32 + c4);
            const int orow = 16384 + rb * 16 + r, col = cb * 32 + c4;
            const v2u hq = *(const v2u*)(S.HB + (size_t)orow * D + col); f32x4 hv; hv[0] = __uint_as_float(hq.x << 16); hv[1] = __uint_as_float(hq.x & 0xffff0000u); hv[2] = __uint_as_float(hq.y << 16); hv[3] = __uint_as_float(hq.y & 0xffff0000u);
            const f32x4 ov = sv + hv; hb_store4(S.HB, orow, col, ov);
            if (MOE_UP_F8) *(unsigned*)(S.X8 + (size_t)orow * 1024 + col) = pack_fp8x4(ov[0], ov[1], ov[2], ov[3]); }
        __syncthreads();
    }
}

struct BkInfo { int bk, rt, cnt, off; };
__device__ __forceinline__ void bk_table256(const Args& a, LAS unsigned char* lds, int L) {
    LAS int* tb = (LAS int*)(lds + LDS_TAB);
    __syncthreads();
    if (threadIdx.x == 0) {
        const unsigned* cnt = (const unsigned*)(a.ws + WS_CTL) + CW_CNT + 1024 * L;
        int off = 0, rts = 0;
        for (int i = 0; i < NBK; ++i) { const int c = (int)__hip_atomic_load(cnt + 32 * i, __ATOMIC_RELAXED, __HIP_MEMORY_SCOPE_AGENT);
            tb[i] = c; tb[NBK + i] = off; tb[2 * NBK + i] = rts; off += (c + 255) & ~255; rts += (c + 255) >> 8; }
        tb[2 * NBK + NBK] = rts;
    }
    __syncthreads();
}
__device__ __forceinline__ bool bk_find(const LAS int* tb, int rti, BkInfo& o) {
    if (rti >= tb[2 * NBK + NBK]) return false;
    int bk = 0;
    for (int i = 1; i < NBK; ++i) if (rti >= tb[2 * NBK + i]) bk = i;
    o.bk = __builtin_amdgcn_readfirstlane(bk); o.rt = __builtin_amdgcn_readfirstlane(rti - tb[2 * NBK + bk]); o.cnt = __builtin_amdgcn_readfirstlane(tb[bk]); o.off = __builtin_amdgcn_readfirstlane(tb[NBK + bk]); return true;
}
struct PMoeUp {
    static constexpr bool PERM = true;
    struct EpiRegs {};
    template <class U_> __device__ __forceinline__ void epi_pre(const U_&, EpiRegs&, int, int, int, int) const {}
    struct Unit { int bk, rt, cnt, off, e, ek, pnl, ui, rti; };
    const char* A; const char* B; bf16* HID; const float* rstd; const float* gates; const LAS int* tb; const LAS int* rowtab; const LAS float* rgtab; unsigned* ctr; int G, c; int ldb, nt;
    __device__ __forceinline__ bool next(int i, Unit& u) const {
        const int Lu = i * G + c; BkInfo o; if (!bk_find(tb, Lu >> 3, o)) return false;
        u.bk = o.bk; u.rt = o.rt; u.cnt = o.cnt; u.off = o.off; u.ek = (Lu >> 2) & 1; u.pnl = Lu & 3; u.ui = i; u.rti = Lu >> 3;
        int elo, ehi; bk_experts(o.bk, elo, ehi); u.e = u.ek ? ehi : elo; return true;
    }
    __device__ __forceinline__ void avoff(const Unit& u, const int (&RA)[2], const int (&CA)[2], unsigned (&v)[4]) const {
#pragma unroll
        for (int h = 0; h < 2; ++h)
#pragma unroll
            for (int i = 0; i < 2; ++i) { const int tok = rowtab[u.ui * 256 + h * 128 + RA[i]]; v[h * 2 + i] = (unsigned)(tok * D + CA[i]) * 2u; }
    }
    __device__ __forceinline__ const char* abase(const Unit&) const { return A; }
    __device__ __forceinline__ const char* btile(const Unit& u, int t) const { return B + ((size_t)(u.e * 1024 + u.pnl * 256) * 1024 + (size_t)t * 64) * 2; }
    __device__ __forceinline__ void khook(int, pg8::Acc&, const Unit&, LAS unsigned char*, int, int, int, int) const {}
    __device__ __forceinline__ void a_ready(const Unit&) const {}
    __device__ __forceinline__ void done(const Unit& u) const {
        asm volatile("s_waitcnt vmcnt(0)" ::: "memory");
        if ((threadIdx.x & 63) == 0) __hip_atomic_fetch_add(ctr + 32 * u.rti, 1u, __ATOMIC_RELAXED, __HIP_MEMORY_SCOPE_AGENT);
    }
    __device__ __forceinline__ void epi(const pg8::Acc& acc, const Unit& u, const EpiRegs&, int wr, int wc, int fr, int fq) const {
        const int r0 = wr * 64 + fr, col0 = u.ek * 512 + u.pnl * 128 + wc * 32 + 8 * fq;
        float rsv[2][4], gtv[2][4];
#pragma unroll
        for (int ai = 0; ai < 2; ++ai)
#pragma unroll
            for (int m = 0; m < 4; ++m) { const LAS float* rg = rgtab + (u.ui * 256 + r0 + ai * 128 + m * 16) * 2; rsv[ai][m] = rg[0]; gtv[ai][m] = rg[1]; }
#pragma unroll
        for (int ai = 0; ai < 2; ++ai)
#pragma unroll
            for (int m = 0; m < 4; ++m) { const int rr = u.rt * 256 + r0 + ai * 128 + m * 16;
                const float rs = rsv[ai][m], gt = gtv[ai][m]; float hv[8];
#pragma unroll
                for (int n = 0; n < 2; ++n)
#pragma unroll
                    for (int j = 0; j < 4; ++j) { const float g = acc[ai][0][m][n][j] * rs, uu = acc[ai][1][m][n][j] * rs; hv[n * 4 + j] = silu_f(g) * uu * gt; }
#if MOE_DOWN_F8
                { unsigned long long* hp = (unsigned long long*)((unsigned char*)HID + (size_t)(u.off + rr) * 1024 + col0);
                  const unsigned lo = pack_fp8x4(hv[0] * 16.f, hv[1] * 16.f, hv[2] * 16.f, hv[3] * 16.f), hi = pack_fp8x4(hv[4] * 16.f, hv[5] * 16.f, hv[6] * 16.f, hv[7] * 16.f);
                  __hip_atomic_store(hp, (unsigned long long)lo | ((unsigned long long)hi << 32), __ATOMIC_RELAXED, __HIP_MEMORY_SCOPE_AGENT); }
#else
                v4u w; w.x = pg8::cvt_pk_bf16(hv[0], hv[1]); w.y = pg8::cvt_pk_bf16(hv[2], hv[3]); w.z = pg8::cvt_pk_bf16(hv[4], hv[5]); w.w = pg8::cvt_pk_bf16(hv[6], hv[7]);
                const bf16* hp = HID + (size_t)(u.off + rr) * 1024 + col0;
                asm volatile("global_store_dwordx4 %0, %1, off sc1\n\ts_nop 1" :: "v"(hp), "v"(w) : "memory");
#endif
            }
    }
};
struct PMoeUp8 {
    static constexpr bool VA_LDS = true;
    static constexpr bool PERM = true;
    struct EpiRegs {};
    template <class U_> __device__ __forceinline__ void epi_pre(const U_&, EpiRegs&, int, int, int, int) const {}
    struct Unit { int bk, rt, cnt, off, e, ek, pnl, ui, rti; };
    const char* A; const char* B; bf16* HID; const float* rstd; const float* gates; const LAS int* tb; const LAS int* rowtab; const LAS float* rgtab; unsigned* ctr; int G, c; int ldbB, nt;
    __device__ __forceinline__ bool next(int i, Unit& u) const {
        const int Lu = i * G + c; BkInfo o; if (!bk_find(tb, Lu >> 3, o)) return false;
        u.bk = o.bk; u.rt = o.rt; u.cnt = o.cnt; u.off = o.off; u.ek = (Lu >> 2) & 1; u.pnl = Lu & 3; u.ui = i; u.rti = Lu >> 3;
        int elo, ehi; bk_experts(o.bk, elo, ehi); u.e = u.ek ? ehi : elo; return true;
    }
    __device__ __forceinline__ void avoff(const Unit& u, const int (&RA)[2], const int (&CA)[2], unsigned (&v)[4]) const {
#pragma unroll
        for (int h = 0; h < 2; ++h)
#pragma unroll
            for (int i = 0; i < 2; ++i) { const int tok = rowtab[u.ui * 256 + h * 128 + RA[i]]; v[h * 2 + i] = (unsigned)(tok * 1024 + CA[i] * 2); }
    }
    __device__ __forceinline__ const char* abase(const Unit&) const { return A; }
    __device__ __forceinline__ const char* btile(const Unit& u, int t) const { return B + (size_t)(u.e * 1024 + u.pnl * 256) * 1024 + (size_t)t * 128; }
    __device__ __forceinline__ void khook(int, pg8::Acc&, const Unit&, LAS unsigned char*, int, int, int, int) const {}
    __device__ __forceinline__ void a_ready(const Unit&) const {}
    __device__ __forceinline__ void done(const Unit& u) const {
        asm volatile("s_waitcnt vmcnt(0)" ::: "memory");
        if ((threadIdx.x & 63) == 0) __hip_atomic_fetch_add(ctr + 32 * u.rti, 1u, __ATOMIC_RELAXED, __HIP_MEMORY_SCOPE_AGENT);
    }
    __device__ __forceinline__ void epi(const pg8::Acc& acc, const Unit& u, const EpiRegs&, int wr, int wc, int fr, int fq) const {
        const int r0 = wr * 64 + fr, col0 = u.ek * 512 + u.pnl * 128 + wc * 32 + 8 * fq;
        float rsv[2][4], gtv[2][4];
#pragma unroll
        for (int ai = 0; ai < 2; ++ai)
#pragma unroll
            for (int m = 0; m < 4; ++m) { const LAS float* rg = rgtab + (u.ui * 256 + r0 + ai * 128 + m * 16) * 2; rsv[ai][m] = rg[0]; gtv[ai][m] = rg[1]; }
#pragma unroll
        for (int ai = 0; ai < 2; ++ai)
#pragma unroll
            for (int m = 0; m < 4; ++m) { const int rr = u.rt * 256 + r0 + ai * 128 + m * 16;
                const float rs = rsv[ai][m] * 0.03125f, gt = gtv[ai][m]; float hv[8];
#pragma unroll
                for (int n = 0; n < 2; ++n)
#pragma unroll
                    for (int j = 0; j < 4; ++j) { const float g = acc[ai][0][m][n][j] * rs, uu = acc[ai][1][m][n][j] * rs; hv[n * 4 + j] = silu_f(g) * uu * gt; }
#if MOE_DOWN_F8
                { unsigned long long* hp = (unsigned long long*)((unsigned char*)HID + (size_t)(u.off + rr) * 1024 + col0);
                  const unsigned lo = pack_fp8x4(hv[0] * 16.f, hv[1] * 16.f, hv[2] * 16.f, hv[3] * 16.f), hi = pack_fp8x4(hv[4] * 16.f, hv[5] * 16.f, hv[6] * 16.f, hv[7] * 16.f);
                  __hip_atomic_store(hp, (unsigned long long)lo | ((unsigned long long)hi << 32), __ATOMIC_RELAXED, __HIP_MEMORY_SCOPE_AGENT); }
#else
                v4u w; w.x = pg8::cvt_pk_bf16(hv[0], hv[1]); w.y = pg8::cvt_pk_bf16(hv[2], hv[3]); w.z = pg8::cvt_pk_bf16(hv[4], hv[5]); w.w = pg8::cvt_pk_bf16(hv[6], hv[7]);
                const bf16* hp = HID + (size_t)(u.off + rr) * 1024 + col0;
                asm volatile("global_store_dwordx4 %0, %1, off sc1\n\ts_nop 1" :: "v"(hp), "v"(w) : "memory");
#endif
            }
    }
};
__device__ __forceinline__ void ph_moe_up_pg8(const Args& a, LAS unsigned char* lds, int L, int G) {
    bk_table256(a, lds, L);
    const LAS int* tb = (const LAS int*)(lds + LDS_TAB); LAS int* rowtab = (LAS int*)(lds + LDS_TAB + 1024); LAS float* rgtab = (LAS float*)(lds + LDS_TAB + 1024 + 6 * 1024);
#if MOE_UP_F8
    typedef PMoeUp8 PU; PU S; S.A = (const char*)(a.ws + WS_X8); S.ldbB = 1024; S.nt = 8;
#else
    typedef PMoeUp PU; PU S; S.A = L ? (const char*)(a.ws + WS_SB) : (const char*)a.out; S.ldb = 1024; S.nt = 16;
#endif
    S.rgtab = rgtab; S.B = (const char*)(a.ws + ws_wgu(L)); S.HID = (bf16*)(a.ws + WS_HID); S.rstd = (const float*)(a.ws + WS_RSTD1); S.gates = (const float*)(a.ws + WS_GATES);
    S.tb = tb; S.rowtab = rowtab; S.G = G; S.c = (int)blockIdx.x; S.ctr = (unsigned*)(a.ws + WS_CTL) + CW_RT + 8192 * L;
    {   const int* LIST = (const int*)(a.ws + WS_LIST); PU::Unit u;
        for (int i = 0; i < 6 && S.next(i, u); ++i)
            if (threadIdx.x < 256) { int rr = u.rt * 256 + (int)threadIdx.x; rr = rr < u.cnt ? rr : u.cnt - 1; const int tok = LIST[(size_t)u.bk * T + rr]; rowtab[i * 256 + threadIdx.x] = tok;
                rgtab[(i * 256 + threadIdx.x) * 2] = S.rstd[tok]; rgtab[(i * 256 + threadIdx.x) * 2 + 1] = S.gates[(size_t)tok * 2 + u.ek]; }
        __syncthreads();
    }
#if MOE_UP_F8
    pg8::gemm_phase_f8<PU, true>(lds, S);
#else
    pg8::gemm_phase<PU, true>(lds, S);
#endif
}
struct PMoeDown {
    static constexpr bool PERM = true;
    struct EpiRegs {};
    template <class U_> __device__ __forceinline__ void epi_pre(const U_&, EpiRegs&, int, int, int, int) const {}
    struct Unit { int bk, rt, cnt, off, elo, ehi, pn, ui, rti; };
    const char* A; const char* B; bf16* HB; bf16* HBo; float* SSQ; const LAS int* tb; const LAS int* rowtab; unsigned* ctr; unsigned* err; int G, c, i0; int ldb, nt;
    __device__ __forceinline__ bool next(int i, Unit& u) const {
        const int Ld = (i0 + i) * G + c - 8 * tb[2 * NBK + NBK]; BkInfo o; if (!bk_find(tb, Ld >> 2, o)) return false;
        u.bk = o.bk; u.rt = o.rt; u.cnt = o.cnt; u.off = o.off; u.pn = Ld & 3; u.ui = i; u.rti = Ld >> 2; bk_experts(o.bk, u.elo, u.ehi); return true;
    }
    __device__ __forceinline__ void avoff(const Unit& u, const int (&RA)[2], const int (&CA)[2], unsigned (&v)[4]) const {
#pragma unroll
        for (int h = 0; h < 2; ++h)
#pragma unroll
            for (int i = 0; i < 2; ++i) { const int row = u.off + u.rt * 256 + h * 128 + RA[i]; v[h * 2 + i] = (unsigned)(row * 1024 + CA[i]) * 2u; }
    }
    __device__ __forceinline__ const char* abase(const Unit&) const { return A; }
    __device__ __forceinline__ const char* btile(const Unit& u, int t) const { return B + ((size_t)((t < 8 ? u.elo : u.ehi) * 1024 + u.pn * 256) * 512 + (size_t)(t & 7) * 64) * 2; }
    __device__ __forceinline__ void khook(int, pg8::Acc&, const Unit&, LAS unsigned char*, int, int, int, int) const {}
    __device__ __forceinline__ void a_ready(const Unit& u) const {
        if (threadIdx.x < 64) {
            unsigned spins = 0;
            while ((unsigned)__builtin_amdgcn_readfirstlane(__hip_atomic_load(ctr + 32 * u.rti, __ATOMIC_RELAXED, __HIP_MEMORY_SCOPE_AGENT)) < 64u) {
                __builtin_amdgcn_s_sleep(2);
                if (++spins > (1u << 22)) { if (threadIdx.x == 0) __hip_atomic_store(err, 1u, __ATOMIC_RELAXED, __HIP_MEMORY_SCOPE_AGENT); break; } }
            __builtin_amdgcn_fence(__ATOMIC_ACQUIRE, "agent");
            asm volatile("s_waitcnt vmcnt(0)" ::: "memory");
        }
        asm volatile("" ::: "memory"); __builtin_amdgcn_s_barrier(); asm volatile("" ::: "memory");
    }
    __device__ __forceinline__ void done(const Unit&) const {}
    __device__ __forceinline__ void epi(const pg8::Acc& acc, const Unit& u, const EpiRegs&, int wr, int wc, int fr, int fq) const {
        const int r0 = wr * 64 + fr, col0 = u.pn * 256 + wc * 32 + 8 * fq;
        int tok[8];
#pragma unroll
        for (int g8 = 0; g8 < 8; ++g8) tok[g8] = rowtab[u.ui * 256 + r0 + (g8 >> 2) * 128 + (g8 & 3) * 16];
#pragma unroll
        for (int hf = 0; hf < 2; ++hf) {
            v4u res[4][2];
#pragma unroll
            for (int g4 = 0; g4 < 4; ++g4)
#pragma unroll
                for (int bj = 0; bj < 2; ++bj) res[g4][bj] = *(const v4u*)(HB + (size_t)tok[hf * 4 + g4] * D + col0 + bj * 128);
#pragma unroll
            for (int g4 = 0; g4 < 4; ++g4) {
                const int g8 = hf * 4 + g4, ai = g8 >> 2, m = g8 & 3;
                const int rr = u.rt * 256 + r0 + ai * 128 + m * 16;
                float sq = 0.f;
#pragma unroll
                for (int bj = 0; bj < 2; ++bj) { f32x4 h0v, h1v; unpack8v(res[g4][bj], h0v, h1v);
                    const f32x4 v0 = acc[ai][bj][m][0] + h0v, v1 = acc[ai][bj][m][1] + h1v;
                    sq += (v0[0] * v0[0] + v0[1] * v0[1] + v0[2] * v0[2] + v0[3] * v0[3]) + (v1[0] * v1[0] + v1[1] * v1[1] + v1[2] * v1[2] + v1[3] * v1[3]);
                    if (rr < u.cnt) hb_store8(HBo, tok[g8], col0 + bj * 128, v0, v1); }
                sq += __shfl_xor(sq, 16); sq += __shfl_xor(sq, 32);
                if (rr < u.cnt && fq == 0) SSQ[(size_t)tok[g8] * 16 + u.pn * 4 + wc] = sq;
            }
        }
    }
};
struct PMoeDown8 {
    static constexpr bool VA_LDS = false;
    static constexpr bool PERM = true;
    struct EpiRegs {};
    template <class U_> __device__ __forceinline__ void epi_pre(const U_&, EpiRegs&, int, int, int, int) const {}
    struct Unit { int bk, rt, cnt, off, elo, ehi, pn, ui, rti; };
    const char* A; const char* B; bf16* HB; bf16* HBo; float* SSQ; const LAS int* tb; const LAS int* rowtab; unsigned* ctr; unsigned* err; int G, c, i0; int ldbB, nt;
    __device__ __forceinline__ bool next(int i, Unit& u) const {
        const int Ld = (i0 + i) * G + c - 8 * tb[2 * NBK + NBK]; BkInfo o; if (!bk_find(tb, Ld >> 2, o)) return false;
        u.bk = o.bk; u.rt = o.rt; u.cnt = o.cnt; u.off = o.off; u.pn = Ld & 3; u.ui = i; u.rti = Ld >> 2; bk_experts(o.bk, u.elo, u.ehi); return true;
    }
    __device__ __forceinline__ void avoff(const Unit& u, const int (&RA)[2], const int (&CA)[2], unsigned (&v)[4]) const {
#pragma unroll
        for (int h = 0; h < 2; ++h)
#pragma unroll
            for (int i = 0; i < 2; ++i) { const int row = u.off + u.rt * 256 + h * 128 + RA[i]; v[h * 2 + i] = (unsigned)(row * 1024 + CA[i] * 2); }
    }
    __device__ __forceinline__ const char* abase(const Unit&) const { return A; }
    __device__ __forceinline__ const char* btile(const Unit& u, int t) const { return B + (size_t)((t < 4 ? u.elo : u.ehi) * 1024 + u.pn * 256) * 512 + (size_t)(t & 3) * 128; }
    __device__ __forceinline__ void khook(int, pg8::Acc&, const Unit&, LAS unsigned char*, int, int, int, int) const {}
    __device__ __forceinline__ void a_ready(const Unit& u) const {
        if (threadIdx.x < 64) {
            unsigned spins = 0;
            while ((unsigned)__builtin_amdgcn_readfirstlane(__hip_atomic_load(ctr + 32 * u.rti, __ATOMIC_RELAXED, __HIP_MEMORY_SCOPE_AGENT)) < 64u) {
                __builtin_amdgcn_s_sleep(2);
                if (++spins > (1u << 22)) { if (threadIdx.x == 0) __hip_atomic_store(err, 1u, __ATOMIC_RELAXED, __HIP_MEMORY_SCOPE_AGENT); break; } }
            __builtin_amdgcn_fence(__ATOMIC_ACQUIRE, "agent");
            asm volatile("s_waitcnt vmcnt(0)" ::: "memory");
        }
        asm volatile("" ::: "memory"); __builtin_amdgcn_s_barrier(); asm volatile("" ::: "memory");
    }
    __device__ __forceinline__ void done(const Unit&) const {}
    __device__ __forceinline__ void epi(const pg8::Acc& acc, const Unit& u, const EpiRegs&, int wr, int wc, int, int) const {
        int l_ = threadIdx.x; asm volatile("" : "+v"(l_));
        const int fr = l_ & 15, fq = (l_ >> 4) & 3;
        const int r0 = wr * 64 + fr, col0 = u.pn * 256 + wc * 32 + 8 * fq;
        int tok[8];
#pragma unroll
        for (int g8 = 0; g8 < 8; ++g8) tok[g8] = rowtab[u.ui * 256 + r0 + (g8 >> 2) * 128 + (g8 & 3) * 16];
        v4u cur[2], nxt[2];
#pragma unroll
        for (int bj = 0; bj < 2; ++bj) cur[bj] = *(const v4u*)(HB + (size_t)tok[0] * D + col0 + bj * 128);
#pragma unroll
        for (int g8 = 0; g8 < 8; ++g8) {
            const int ai = g8 >> 2, m = g8 & 3;
            if (g8 < 7) {
#pragma unroll
                for (int bj = 0; bj < 2; ++bj) nxt[bj] = *(const v4u*)(HB + (size_t)tok[g8 + 1] * D + col0 + bj * 128); }
            const int rr = u.rt * 256 + r0 + ai * 128 + m * 16;
            float sq = 0.f;
#pragma unroll
            for (int bj = 0; bj < 2; ++bj) { f32x4 h0v, h1v; unpack8v(cur[bj], h0v, h1v);
                const f32x4 v0 = acc[ai][bj][m][0] * 0.00390625f + h0v, v1 = acc[ai][bj][m][1] * 0.00390625f + h1v;
                sq += (v0[0] * v0[0] + v0[1] * v0[1] + v0[2] * v0[2] + v0[3] * v0[3]) + (v1[0] * v1[0] + v1[1] * v1[1] + v1[2] * v1[2] + v1[3] * v1[3]);
                if (rr < u.cnt) hb_store8(HBo, tok[g8], col0 + bj * 128, v0, v1); }
            sq += __shfl_xor(sq, 16); sq += __shfl_xor(sq, 32);
            if (rr < u.cnt && fq == 0) SSQ[(size_t)tok[g8] * 16 + u.pn * 4 + wc] = sq;
#pragma unroll
            for (int bj = 0; bj < 2; ++bj) cur[bj] = nxt[bj];
        }
    }
};
__device__ __forceinline__ void ph_moe_down_pg8(const Args& a, LAS unsigned char* lds, int L, int G) {
    bk_table256(a, lds, L);
    const LAS int* tb = (const LAS int*)(lds + LDS_TAB); LAS int* rowtab = (LAS int*)(lds + LDS_TAB + 1024);
#if MOE_DOWN_F8
    typedef PMoeDown8 PD; PD S; S.ldbB = 512; S.nt = 8;
#else
    typedef PMoeDown PD; PD S; S.ldb = 512; S.nt = 16;
#endif
    S.A = (const char*)(a.ws + WS_HID); S.B = (const char*)(a.ws + ws_wd(L)); S.SSQ = (float*)(a.ws + WS_SSDSQ); S.HB = L ? (bf16*)(a.ws + WS_SB) : (bf16*)a.out; S.HBo = L ? (bf16*)(a.ws + WS_SC) : (bf16*)a.out;
    S.tb = tb; S.rowtab = rowtab; S.G = G; S.c = (int)blockIdx.x; S.ctr = (unsigned*)(a.ws + WS_CTL) + CW_RT + 8192 * L; S.err = (unsigned*)(a.ws + WS_CTL) + 16;
    { const int nup = 8 * tb[2 * NBK + NBK]; S.i0 = nup > S.c ? (nup - S.c + G - 1) / G : 0; }
    {   const int* LIST = (const int*)(a.ws + WS_LIST); PD::Unit u;
        for (int i = 0; i < 4 && S.next(i, u); ++i)
            if (threadIdx.x < 256) { int rr = u.rt * 256 + (int)threadIdx.x; rr = rr < u.cnt ? rr : u.cnt - 1; rowtab[i * 256 + threadIdx.x] = LIST[(size_t)u.bk * T + rr]; }
        __syncthreads();
    }
#if MOE_DOWN_F8
    pg8::gemm_phase_f8<PD, true>(lds, S);
#else
    pg8::gemm_phase<PD, true>(lds, S);
#endif
    if (L == 0) {
        const int wave = __builtin_amdgcn_readfirstlane((int)threadIdx.x >> 6), lane = (int)threadIdx.x & 63;
        const int ntot = 12 * tb[2 * NBK + NBK], n_more = ntot % G;
        __syncthreads();
        (void)wave; (void)lane; (void)n_more;
        convert_experts_dyn(a, 1, lds, (unsigned*)(a.ws + WS_CTL) + 64);
    }
}
struct PPool {
    static constexpr bool PERM = true;
    struct EpiRegs {};
    template <class U_> __device__ __forceinline__ void epi_pre(const U_&, EpiRegs&, int, int, int, int) const {}
    struct Unit { int pm, pn; };
    const char* A; const char* B; bf16* HB; const float* pb; const float* ps; int G, c; int ldb, nt;
    __device__ __forceinline__ bool next(int i, Unit& u) const { return pg8::static_order(65, 4, G, c, i, u.pm, u.pn); }
    __device__ __forceinline__ void avoff(const Unit& u, const int (&RA)[2], const int (&CA)[2], unsigned (&v)[4]) const {
#pragma unroll
        for (int h = 0; h < 2; ++h)
#pragma unroll
            for (int i = 0; i < 2; ++i) { int row = u.pm * 256 + h * 128 + RA[i]; row = row < T ? row : T - 1; v[h * 2 + i] = (unsigned)(row * D + CA[i]) * 2u; }
    }
    __device__ __forceinline__ const char* abase(const Unit& u) const { return A + (size_t)u.pn * 256 * 2; }
    __device__ __forceinline__ const char* btile(const Unit& u, int t) const { return B + ((size_t)u.pn * 256 * 256 + (size_t)t * 64) * 2; }
    __device__ __forceinline__ void khook(int, pg8::Acc&, const Unit&, LAS unsigned char*, int, int, int, int) const {}
    __device__ __forceinline__ void a_ready(const Unit&) const {}
    __device__ __forceinline__ void done(const Unit&) const {}
    __device__ __forceinline__ void epi(const pg8::Acc& acc, const Unit& u, const EpiRegs&, int wr, int wc, int fr, int fq) const {
        const int row0 = u.pm * 256 + wr * 64 + fr, col0 = u.pn * 256 + wc * 32 + 8 * fq;
        v4u cur[2], nxt[2];
        { const int rc = row0 < T ? row0 : T - 1;
#pragma unroll
          for (int bj = 0; bj < 2; ++bj) cur[bj] = *(const v4u*)(HB + (size_t)rc * D + col0 + bj * 128); }
#pragma unroll
        for (int g8 = 0; g8 < 8; ++g8) {
            const int ai = g8 >> 2, m = g8 & 3, row = row0 + ai * 128 + m * 16;
            if (g8 < 7) { const int rn = row0 + ((g8 + 1) >> 2) * 128 + ((g8 + 1) & 3) * 16, rc = rn < T ? rn : T - 1;
#pragma unroll
                for (int bj = 0; bj < 2; ++bj) nxt[bj] = *(const v4u*)(HB + (size_t)rc * D + col0 + bj * 128); }
            if (row < T) {
#pragma unroll
                for (int bj = 0; bj < 2; ++bj) { const int cc = col0 + bj * 128; f32x4 h0v, h1v; unpack8v(cur[bj], h0v, h1v);
                    hb_store8(HB, row, cc, h0v + (acc[ai][bj][m][0] + *(const f32x4*)(pb + cc)) * *(const f32x4*)(ps + cc),
                                           h1v + (acc[ai][bj][m][1] + *(const f32x4*)(pb + cc + 4)) * *(const f32x4*)(ps + cc + 4)); } }
#pragma unroll
            for (int bj = 0; bj < 2; ++bj) cur[bj] = nxt[bj];
        }
    }
};
__device__ __forceinline__ void ph_poolgemm_pg8(const Args& a, LAS unsigned char* lds, int G) {
    PPool S; S.A = (const char*)(a.ws + WS_POOLED); S.B = (const char*)(a.ws + WS_WPOOL); S.HB = (bf16*)a.out; S.pb = a.in[I_PB]; S.ps = a.in[I_PS];
    S.G = G; S.c = (int)blockIdx.x; S.ldb = 256; S.nt = 4;
    pg8::gemm_phase<PPool, true>(lds, S);
}

constexpr int PF_RS_ROW = 528;
constexpr int PF_RAW = 0, PF_RS = 112 * PF_RS_ROW, PF_A = PF_RS + 512, PF_END = PF_A + 96 * PF_RS_ROW;
static_assert(PF_END <= LDS_BYTES - 256, "pool lds");
__device__ __forceinline__ void ph_pool_fused(const Args& a, LAS unsigned char* lds, int wk, int nwk) {
    int tid_o = threadIdx.x; asm volatile("" : "+v"(tid_o));
    const int tid = tid_o, lane = tid & 63, w = __builtin_amdgcn_readfirstlane(tid >> 6), fr = lane & 15, fq = lane >> 4;
    const bf16* SA = (const bf16*)a.out; bf16* SB = (bf16*)(a.ws + WS_SB); const float* SSQ = (const float*)(a.ws + WS_SSDSQ); const bf16* WPOOL = (const bf16*)(a.ws + WS_WPOOL);
    LAS float* rs = (LAS float*)(lds + PF_RS);
    v4u rp[7]; f32x4 sq4[4];
#define POOL_PREFETCH(U) do { const int rt_ = (U) >> 2, g_ = (U) & 3, t0_ = rt_ * 96; \
        _Pragma("unroll") for (int i = 0; i < 7; ++i) { const int q = tid + 512 * i, row = q >> 5, pc = q & 31; int gr = t0_ - 16 + row; gr = gr < 0 ? 0 : gr; \
            rp[i] = *(const v4u*)(SA + (size_t)gr * D + g_ * 256 + pc * 8); } \
        if (tid < 112) { int gr = t0_ - 16 + tid; gr = gr < 0 ? 0 : gr; const f32x4* q = (const f32x4*)(SSQ + (size_t)gr * 16); sq4[0] = q[0]; sq4[1] = q[1]; sq4[2] = q[2]; sq4[3] = q[3]; } } while (0)
    if (wk < 172 * 4) POOL_PREFETCH(wk);
    for (int u = wk; u < 172 * 4; u += nwk) {
        const int rt = u >> 2, g = u & 3, t0 = rt * 96, win = 2 << g;
        const bf16* wrow = WPOOL + (size_t)(g * 256 + 32 * w + fr) * 256 + 8 * fq;
        bf16x8 bfr[8][2];
#pragma unroll
        for (int ks = 0; ks < 8; ++ks) { bfr[ks][0] = *(const bf16x8*)(wrow + 32 * ks); bfr[ks][1] = *(const bf16x8*)(wrow + 16 * 256 + 32 * ks); }
        __syncthreads();
#pragma unroll
        for (int i = 0; i < 7; ++i) { const int q = tid + 512 * i, row = q >> 5, pc = q & 31; *(LAS v4u*)(lds + PF_RAW + row * PF_RS_ROW + pc * 16) = rp[i]; }
        if (tid < 112) { const f32x4 sv = (sq4[0] + sq4[1]) + (sq4[2] + sq4[3]); rs[tid] = rsqrtf((sv[0] + sv[1] + sv[2] + sv[3]) * (1.f / D) + EPS); }
        __syncthreads();
        if (u + nwk < 172 * 4) POOL_PREFETCH(u + nwk);
        {   const int c4 = tid & 63, r0 = (tid >> 6) * 12;
            const LAS unsigned char* rawc = lds + PF_RAW + 16 * PF_RS_ROW + c4 * 8;
            int l = (t0 + r0) % LSEQ;
            f32x4 Sb = (f32x4){0.f, 0.f, 0.f, 0.f};
            for (int j = 1; j < win; ++j) if (l - j >= 0) { const v2u q = *(const LAS v2u*)(rawc + (r0 - j) * PF_RS_ROW); const float rr = rs[16 + r0 - j];
                Sb[0] += __uint_as_float(q.x << 16) * rr; Sb[1] += __uint_as_float(q.x & 0xffff0000u) * rr; Sb[2] += __uint_as_float(q.y << 16) * rr; Sb[3] += __uint_as_float(q.y & 0xffff0000u) * rr; }
#pragma unroll 4
            for (int r = r0; r < r0 + 12; ++r) {
                if (l == 0) Sb = (f32x4){0.f, 0.f, 0.f, 0.f};
                const v2u q = *(const LAS v2u*)(rawc + r * PF_RS_ROW); const float rr = rs[16 + r];
                f32x4 hv; hv[0] = __uint_as_float(q.x << 16) * rr; hv[1] = __uint_as_float(q.x & 0xffff0000u) * rr; hv[2] = __uint_as_float(q.y << 16) * rr; hv[3] = __uint_as_float(q.y & 0xffff0000u) * rr;
                const f32x4 full = Sb + hv;
                const int n = (l + 1) < win ? (l + 1) : win;
                const f32x4 o = full * (1.f / (float)n) - hv;
                v2u wv; wv.x = pk2(o[0], o[1]); wv.y = pk2(o[2], o[3]);
                *(LAS v2u*)(lds + PF_A + r * PF_RS_ROW + c4 * 8) = wv;
                Sb = full;
                if (l + 1 >= win) { const v2u qo = *(const LAS v2u*)(rawc + (r - win + 1) * PF_RS_ROW); const float ro = rs[16 + r - win + 1];
                    Sb[0] -= __uint_as_float(qo.x << 16) * ro; Sb[1] -= __uint_as_float(qo.x & 0xffff0000u) * ro; Sb[2] -= __uint_as_float(qo.y << 16) * ro; Sb[3] -= __uint_as_float(qo.y & 0xffff0000u) * ro; }
                l = (l + 1 == LSEQ) ? 0 : l + 1;
            }
        }
        __syncthreads();
        f32x4 acc[6][2];
#pragma unroll
        for (int m = 0; m < 6; ++m) { acc[m][0] = (f32x4){0.f, 0.f, 0.f, 0.f}; acc[m][1] = acc[m][0]; }
#pragma unroll
        for (int ks = 0; ks < 8; ++ks) {
            bf16x8 af[6];
#pragma unroll
            for (int m = 0; m < 6; ++m) af[m] = *(const LAS bf16x8*)(lds + PF_A + (16 * m + fr) * PF_RS_ROW + (32 * ks + 8 * fq) * 2);
#pragma unroll
            for (int m = 0; m < 6; ++m) { acc[m][0] = mfma16(bfr[ks][0], af[m], acc[m][0]); acc[m][1] = mfma16(bfr[ks][1], af[m], acc[m][1]); }
        }
#pragma unroll
        for (int j = 0; j < 2; ++j) { const int col = g * 256 + 32 * w + 16 * j + 4 * fq; const f32x4 pbv = *(const f32x4*)(a.in[I_PB] + col), psv = *(const f32x4*)(a.in[I_PS] + col);
#pragma unroll
            for (int m = 0; m < 6; ++m) {
                LAS v2u* hp = (LAS v2u*)(lds + PF_RAW + (16 + 16 * m + fr) * PF_RS_ROW + (32 * w + 16 * j + 4 * fq) * 2);
                const v2u hq = *hp;
                f32x4 hv; hv[0] = __uint_as_float(hq.x << 16); hv[1] = __uint_as_float(hq.x & 0xffff0000u); hv[2] = __uint_as_float(hq.y << 16); hv[3] = __uint_as_float(hq.y & 0xffff0000u);
                const f32x4 o = hv + (acc[m][j] + pbv) * psv;
                v2u wv; wv.x = pg8::cvt_pk_bf16(o[0], o[1]); wv.y = pg8::cvt_pk_bf16(o[2], o[3]); *hp = wv; } }
        __syncthreads();
#pragma unroll
        for (int i = 0; i < 6; ++i) { const int q = tid + 512 * i, row = q >> 5, pc = q & 31;
            const v4u ov = *(const LAS v4u*)(lds + PF_RAW + (16 + row) * PF_RS_ROW + pc * 16); *(v4u*)(SB + (size_t)(t0 + row) * D + g * 256 + pc * 8) = ov;
            if (MOE_UP_F8) { f32x4 o0, o1; unpack8v(ov, o0, o1); x8_store8(a.ws + WS_X8, t0 + row, g * 256 + pc * 8, o0, o1); } }
    }
#undef POOL_PREFETCH
}
__device__ __forceinline__ void ph_pooled(const Args& a, LAS unsigned char* lds, int wk, int nwk) {
    const int tid = threadIdx.x, qt = tid >> 7, c8 = tid & 127, c = c8 * 8, g = c >> 8, w = 2 << g;
    const bf16* HBr = (const bf16*)a.out; const float* SSQ = (const float*)(a.ws + WS_SSDSQ); bf16* PO = (bf16*)(a.ws + WS_POOLED);
    LAS float* rs = (LAS float*)lds + qt * 64;
    for (int pr = wk; pr < 172; pr += nwk) {
        const int task = pr * 4 + qt, b = task / 86, t0 = (task % 86) * 24;
        const size_t rb = (size_t)b * LSEQ;
        __syncthreads();
        if (c8 < 40) { const int l = t0 - 16 + c8; float r = 0.f;
            if (l >= 0) { const f32x4* q = (const f32x4*)(SSQ + (rb + l) * 16); const f32x4 sv = (q[0] + q[1]) + (q[2] + q[3]); r = rsqrtf((sv[0] + sv[1] + sv[2] + sv[3]) * (1.f / D) + EPS); }
            rs[c8] = r; }
        __syncthreads();
        f32x4 S0 = (f32x4){0.f, 0.f, 0.f, 0.f}, S1 = S0;
        for (int j = 1; j <= w; ++j) { const int l = t0 - j; if (l >= 0) { f32x4 x0, x1; unpack8v(*(const v4u*)(HBr + (rb + l) * D + c), x0, x1); S0 += x0 * rs[16 - j]; S1 += x1 * rs[16 - j]; } }
#pragma unroll 4
        for (int t = 0; t < 24; ++t) {
            const int l = t0 + t;
            f32x4 h0v, h1v; unpack8v(*(const v4u*)(HBr + (rb + l) * D + c), h0v, h1v); h0v *= rs[16 + t]; h1v *= rs[16 + t];
            const int lo = l - w, loc = lo >= 0 ? lo : 0; const float rl = lo >= 0 ? rs[16 + t - w] : 0.f;
            f32x4 s0v, s1v; unpack8v(*(const v4u*)(HBr + (rb + loc) * D + c), s0v, s1v);
            S0 += h0v; S0 -= s0v * rl; S1 += h1v; S1 -= s1v * rl;
            const int n = (l + 1) < w ? (l + 1) : w; const float inv = 1.f / (float)n;
            const f32x4 o0 = S0 * inv - h0v, o1 = S1 * inv - h1v;
            v4u wv; wv.x = pk2(o0[0], o0[1]); wv.y = pk2(o0[2], o0[3]); wv.z = pk2(o1[0], o1[1]); wv.w = pk2(o1[2], o1[3]); *(v4u*)(PO + (rb + l) * D + c) = wv;
        }
    }
}
__device__ __forceinline__ void ph_poolgemm(const Args& a, int wk, int nwk) {
    const int tid = threadIdx.x, lane = tid & 63, wave = __builtin_amdgcn_readfirstlane(tid >> 6), fr = lane & 15, fq = lane >> 4;
    const int gw = wk * NWAVES + wave, NGW = nwk * NWAVES;
    const bf16* PO = (const bf16*)(a.ws + WS_POOLED); const bf16* WPOOL = (const bf16*)(a.ws + WS_WPOOL);
    float* H = (float*)(a.ws + WS_H); bf16* HB = (bf16*)a.out;
    for (int u = gw; u < 258 * 16; u += NGW) {
        const int rt = u / 16, ct = u % 16, g = ct >> 2;
        const bf16* arow[4];
#pragma unroll
        for (int mi = 0; mi < 4; ++mi) arow[mi] = PO + (size_t)(rt * 64 + 16 * mi + fr) * D + g * 256;
        f32x4 acc[4][4]; zero_acc(acc);
        sg_kloop<4>(256, arow, [=](int n, int k0) { return WPOOL + (size_t)(ct * 64 + n) * 256 + k0; }, NoKS(), acc, fr, fq);
#pragma unroll
        for (int mi = 0; mi < 4; ++mi) { const int row = rt * 64 + 16 * mi + fr;
#pragma unroll
            for (int nj = 0; nj < 4; ++nj) { const int c = ct * 64 + 16 * nj + 4 * fq; float* hp = H + (size_t)row * D + c;
                const f32x4 v = *(const f32x4*)hp + (acc[mi][nj] + *(const f32x4*)(a.in[I_PB] + c)) * *(const f32x4*)(a.in[I_PS] + c); *(f32x4*)hp = v;
                v2u w; w.x = pk2(v.x, v.y); w.y = pk2(v.z, v.w); *(v2u*)(HB + (size_t)row * D + c) = w; } }
    }
}
__device__ __forceinline__ void ph_final(const Args& a, int wk, int nwk) {
    const int tid = threadIdx.x, lane = tid & 63, wave = __builtin_amdgcn_readfirstlane(tid >> 6);
    const int gw = wk * NWAVES + wave, NGW = nwk * NWAVES;
    const f32x4* gn = (const f32x4*)a.in[I_NORMF] + lane;
    const bf16* HF = (const bf16*)(a.ws + WS_SC);
    for (int orow = gw; orow < NB * SEQ; orow += NGW) {
        const int b = orow / SEQ, l = orow - b * SEQ, row = b * LSEQ + NMETA + l;
        const v2u* xr = (const v2u*)(HF + (size_t)row * D) + lane; f32x4 v[4]; float ss = 0.f;
#pragma unroll
        for (int j = 0; j < 4; ++j) { const v2u q = xr[64 * j]; v[j][0] = __uint_as_float(q.x << 16); v[j][1] = __uint_as_float(q.x & 0xffff0000u); v[j][2] = __uint_as_float(q.y << 16); v[j][3] = __uint_as_float(q.y & 0xffff0000u);
            ss += v[j].x * v[j].x + v[j].y * v[j].y + v[j].z * v[j].z + v[j].w * v[j].w; }
        ss = wave_sum(ss);
        const float rstd = rsqrtf(ss * (1.f / D) + EPS);
        f32x4* o = (f32x4*)(a.out + (size_t)orow * D) + lane;
#ifdef PROBE_T
        const unsigned long long* ts = (const unsigned long long*)(a.ws + WS_CTL + 2048);
        const float tA = (float)(ts[PROBE_A_HI] - ts[PROBE_A_LO]) * 0.01f, tB = (float)(ts[PROBE_B_HI] - ts[PROBE_B_LO]) * 0.01f;
#pragma unroll
        for (int j = 0; j < 4; ++j) { f32x4 r = v[j] * rstd * gn[64 * j] + tB * 0.01f; if (orow == 0 && lane == 0 && j == 0) r.x += tA; o[64 * j] = r; }
#else
#pragma unroll
        for (int j = 0; j < 4; ++j) o[64 * j] = v[j] * rstd * gn[64 * j];
#endif
    }
}

__global__ void __launch_bounds__(NWAVES * 64, 2) fwd_kernel(Args a) {
    extern __shared__ __attribute__((aligned(16))) unsigned char lds_raw[];
    LAS unsigned char* lds = (LAS unsigned char*)lds_raw;
    volatile LAS unsigned* MISC = (volatile LAS unsigned*)(lds + LDS_BYTES - 256);
    const int tid = threadIdx.x;
    const int G = gridDim.x; const int bx = blockIdx.x;
    const int wk = (G % 8 == 0) ? (bx % 8) * (G / 8) + bx / 8 : bx;
    if (tid < 64) MISC[tid] = 0u;
    __syncthreads();
    XcdBarrier bar; bar.bar = (unsigned*)(a.ws + WS_CTL) + CW_BAR; bar.x = 0; bar.st = nullptr;
    if (N_LAUNCHES == 1) bar = xcd_barrier_post((unsigned*)(a.ws + WS_CTL) + CW_BAR, MISC + 8);
    const int lo = a.ph_lo, hi = a.ph_hi;
#ifndef PH_MASK
#define PH_MASK 0xFFFF
#endif
#define IN(k) (((PH_MASK >> (k)) & 1) && lo <= (k) && (k) < hi)
#ifdef PROBE_T
#define STAMP(k) do { if (blockIdx.x == 0 && tid == 0) ((unsigned long long*)(a.ws + WS_CTL + 2048))[k] = __builtin_amdgcn_s_memrealtime(); } while (0)
#else
#define STAMP(k) do { } while (0)
#endif
#ifdef PROBE_K
    volatile LAS unsigned long long* pkt = (volatile LAS unsigned long long*)(lds + LDS_BYTES - 128);
#define PSTAMP(k) do { if (blockIdx.x == 0 && tid == 0) { if ((k) == PROBE_K) pkt[0] = __builtin_amdgcn_s_memrealtime(); if ((k) == PROBE_K + 1) pkt[1] = __builtin_amdgcn_s_memrealtime(); } } while (0)
#else
#define PSTAMP(k) do { } while (0)
#endif
#define SEAM(k) do { if (IN(k) && IN((k) + 1)) xcd_barrier(bar); STAMP((k) + 1); PSTAMP((k) + 1); } while (0)
    STAMP(0); PSTAMP(0);
    if (IN(0)) { ph_prep(a, lds, wk, G); } SEAM(0);
    if (IN(1)) { ph_gemm1_pg8(a, lds, G); } SEAM(1);
    if (IN(2)) { ph_conv(a, wk, G); } SEAM(2);
    if (IN(3)) { ph_mixers3(a, lds, wk, G); } SEAM(3);
    if (IN(4)) { ph_gemm2_pg8(a, lds, wk, G); } SEAM(4);
    if (IN(5)) { ph_router(a, lds, 0, wk, G); } SEAM(5);
    if (IN(6)) { ph_moe_up_pg8(a, lds, 0, G); ph_moe_down_pg8(a, lds, 0, G); } SEAM(6);
    STAMP(8); PSTAMP(8);
    if (IN(8)) { ph_pool_fused(a, lds, wk, G); } SEAM(8);
    STAMP(10); PSTAMP(10);
    if (IN(10)) { ph_router(a, lds, 1, wk, G); } SEAM(10);
    if (IN(11)) { ph_moe_up_pg8(a, lds, 1, G); ph_moe_down_pg8(a, lds, 1, G); } SEAM(11);
    STAMP(13); PSTAMP(13);
    if (IN(13)) { ph_final(a, wk, G); }
#ifdef PROBE_K
    if (blockIdx.x == 0 && tid == 0) {
        asm volatile("s_waitcnt vmcnt(0)" ::: "memory");
        if (PROBE_K == 13) pkt[1] = __builtin_amdgcn_s_memrealtime();
        const unsigned long long tend = __builtin_amdgcn_s_memrealtime() + 4ull * (pkt[1] - pkt[0]);
        while (__builtin_amdgcn_s_memrealtime() < tend) __builtin_amdgcn_s_sleep(16);
    }
#endif
#undef IN
#undef SEAM
}

extern "C" void kernel_launch(void* const* d_in, const int* in_sizes, int n_in, void* d_out, int out_size, void* d_ws, size_t ws_size, hipStream_t stream) {
    static int grid = 0;
    if (grid == 0) {
        if (n_in != 31 || out_size != NB * SEQ * D || ws_size < WS_END) { fprintf(stderr, "kernel_launch: unexpected shapes (n_in %d out %d ws %zu)\n", n_in, out_size, ws_size); grid = -1; return; }
        int dev = 0, cus = 0;
        if (hipGetDevice(&dev) != hipSuccess || hipDeviceGetAttribute(&cus, hipDeviceAttributeMultiprocessorCount, dev) != hipSuccess) { grid = -1; return; }
        if (hipFuncSetAttribute((const void*)fwd_kernel, hipFuncAttributeMaxDynamicSharedMemorySize, LDS_BYTES) != hipSuccess) { grid = -1; return; }
        grid = cus;
    }
    if (grid < 0) return;
    (void)hipMemsetAsync((char*)d_ws + WS_CTL, 0, CTL_ZERO_BYTES, stream);
    Args a{};
    for (int i = 0; i < 31; ++i) a.in[i] = (const float*)d_in[i];
    a.out = (float*)d_out; a.ws = (unsigned char*)d_ws;
    if (N_LAUNCHES == 1) { a.ph_lo = 0; a.ph_hi = NPH; hipLaunchKernelGGL(fwd_kernel, dim3(grid), dim3(NWAVES * 64), LDS_BYTES, stream, a); }
    else for (int p = 0; p < NPH; ++p) { a.ph_lo = p; a.ph_hi = p + 1; hipLaunchKernelGGL(fwd_kernel, dim3(grid), dim3(NWAVES * 64), LDS_BYTES, stream, a); }
}
```
